# Optimizing an MI355X kernel written in HIP

```python
import jax, jax.numpy as jnp
from jax import lax
import numpy as np

D_MODEL = 1024
BATCH = 8
SEQ = 4096
DEPTH = 2

HEAD_DIM = 64
CONV_WIDTH = D_MODEL // 4
RET_WIDTH = D_MODEL // 4
ATT_WIDTH = D_MODEL // 2
MIX_WIDTH = CONV_WIDTH + RET_WIDTH + ATT_WIDTH
RET_HEADS = RET_WIDTH // HEAD_DIM
ATT_HEADS = ATT_WIDTH // HEAD_DIM
CONV_K = 31
RET_CHUNK = 128
MOBA_BLOCK = 256
MOBA_TOPK = 3
Q_CHUNK = 32
RMS_EPS = 1e-6
LN_EPS = 1e-5
NEG = -1e30
IN_SIZES = (CONV_WIDTH, CONV_WIDTH, CONV_WIDTH,
            RET_WIDTH, RET_WIDTH, RET_WIDTH, RET_WIDTH,
            ATT_WIDTH, ATT_WIDTH, ATT_WIDTH, ATT_WIDTH)
IN_WIDTH = sum(IN_SIZES)
SPLIT_POINTS = tuple(int(s) for s in np.cumsum(IN_SIZES)[:-1])

kernel_name = "hymba_conv_retention_moba_hybrid"


def rmsnorm(x, g):
    xf = x.astype(jnp.float32)
    y = xf * lax.rsqrt(jnp.mean(xf * xf, axis=-1, keepdims=True) + RMS_EPS)
    return (y * g.astype(jnp.float32)).astype(x.dtype)


def split_heads(t, n_heads):
    b, s, _ = t.shape
    return t.reshape(b, s, n_heads, -1).transpose(0, 2, 1, 3)


def merge_heads(t):
    b, n, s, d = t.shape
    return t.transpose(0, 2, 1, 3).reshape(b, s, n * d)


def conformer_conv(val, glu_gate, conv_w, conv_b, ln_g, ln_b, pw_w, pw_b):
    u = val * jax.nn.sigmoid(glu_gate)
    y = lax.conv_general_dilated(u, conv_w[:, None, :], window_strides=(1,),
                                 padding=[(CONV_K - 1, 0)],
                                 dimension_numbers=('NWC', 'WIO', 'NWC'),
                                 feature_group_count=CONV_WIDTH) + conv_b
    yf = y.astype(jnp.float32)
    mu = jnp.mean(yf, axis=-1, keepdims=True)
    var = jnp.mean(jnp.square(yf - mu), axis=-1, keepdims=True)
    yn = ((yf - mu) * lax.rsqrt(var + LN_EPS) * ln_g + ln_b).astype(val.dtype)
    return jax.nn.silu(yn) @ pw_w + pw_b


def retention(q, k, v):
    out_dtype = q.dtype
    q, k, v = (t.astype(jnp.float32) for t in (q, k, v))
    b, h, s, d = q.shape
    c = RET_CHUNK
    n = s // c
    k = k * (d ** -0.5)
    log_g = jnp.log(1.0 - jnp.exp2(-5.0 - jnp.arange(h, dtype=jnp.float32)))
    i = jnp.arange(c, dtype=jnp.float32)
    diff = i[:, None] - i[None, :]
    dec = jnp.where(diff >= 0, jnp.exp(log_g[:, None, None] * jnp.maximum(diff, 0.0)), 0.0)
    qc = q.reshape(b, h, n, c, d)
    kc = k.reshape(b, h, n, c, d)
    vc = v.reshape(b, h, n, c, d)
    scores = jnp.einsum('bhnid,bhnjd->bhnij', qc, kc) * dec[None, :, None]
    intra = jnp.einsum('bhnij,bhnje->bhnie', scores, vc)
    zeta = jnp.exp(log_g[:, None] * (c - 1 - i))
    kv = jnp.einsum('bhnjd,bhnje->nbhde', kc * zeta[None, :, None, :, None], vc)
    g_chunk = jnp.exp(log_g * c)[None, :, None, None]

    def step(state, kv_n):
        return kv_n + g_chunk * state, state

    _, r_prev = lax.scan(step, jnp.zeros((b, h, d, d), jnp.float32), kv)
    xi = jnp.exp(log_g[:, None] * (i + 1.0))
    cross = jnp.einsum('bhnid,nbhde->bhnie', qc, r_prev) * xi[None, :, None, :, None]
    o = (intra + cross).reshape(b, h, s, d)
    mu = jnp.mean(o, axis=-1, keepdims=True)
    var = jnp.mean(jnp.square(o - mu), axis=-1, keepdims=True)
    return ((o - mu) * lax.rsqrt(var + LN_EPS)).astype(out_dtype)


def moba_attention(q, k, v):
    out_dtype = q.dtype
    q, k, v = (t.astype(jnp.float32) for t in (q, k, v))
    b, h, s, d = q.shape
    blk = MOBA_BLOCK
    nblk = -(-s // blk)
    sp = nblk * blk
    kpad = jnp.pad(k, ((0, 0), (0, 0), (0, sp - s), (0, 0)))
    vpad = jnp.pad(v, ((0, 0), (0, 0), (0, sp - s), (0, 0)))
    kb = kpad.reshape(b, h, nblk, blk, d)
    vb = vpad.reshape(b, h, nblk, blk, d)
    scale = d ** -0.5
    slopes = jnp.exp2(-8.0 * (jnp.arange(h, dtype=jnp.float32) + 1.0) / h)
    k_mean = jnp.mean(kb, axis=3)
    gate = jnp.einsum('bhsd,bhnd->bhsn', q, k_mean)
    q_blk = jnp.arange(s) // blk
    past = jnp.arange(nblk)[None, :] < q_blk[:, None]
    gate = jnp.where(past[None, None], gate, NEG)
    topk = min(MOBA_TOPK, nblk)
    _, sel = lax.top_k(gate, topk)
    bi = jnp.arange(b)[:, None, None, None]
    hi = jnp.arange(h)[None, :, None, None]
    n_chunks = s // Q_CHUNK

    def body(ci):
        t0 = ci * Q_CHUNK
        qc = lax.dynamic_slice_in_dim(q, t0, Q_CHUNK, axis=2)
        ic = lax.dynamic_slice_in_dim(sel, t0, Q_CHUNK, axis=2)
        t = (t0 + jnp.arange(Q_CHUNK)).astype(jnp.float32)
        j = t0 // blk
        k_sel = kb[bi, hi, ic]
        v_sel = vb[bi, hi, ic]
        s_sel = jnp.einsum('bhcd,bhckld->bhckl', qc, k_sel) * scale
        pos_sel = (ic[..., None] * blk + jnp.arange(blk)).astype(jnp.float32)
        bias_sel = -slopes[None, :, None, None, None] * (t[None, None, :, None, None] - pos_sel)
        valid = (ic < j)[..., None]
        l_sel = jnp.where(valid, s_sel + bias_sel, NEG).reshape(b, h, Q_CHUNK, topk * blk)
        k_own = lax.dynamic_slice_in_dim(kpad, j * blk, blk, axis=2)
        v_own = lax.dynamic_slice_in_dim(vpad, j * blk, blk, axis=2)
        s_own = jnp.einsum('bhcd,bhld->bhcl', qc, k_own) * scale
        pos_own = (j * blk + jnp.arange(blk)).astype(jnp.float32)
        dist = t[:, None] - pos_own[None, :]
        l_own = jnp.where((dist >= 0)[None, None],
                          s_own - slopes[None, :, None, None] * dist[None, None], NEG)
        p = jax.nn.softmax(jnp.concatenate([l_sel, l_own], axis=-1), axis=-1)
        p_sel = p[..., :topk * blk].reshape(b, h, Q_CHUNK, topk, blk)
        p_own = p[..., topk * blk:]
        return (jnp.einsum('bhckl,bhckld->bhcd', p_sel, v_sel)
                + jnp.einsum('bhcl,bhld->bhcd', p_own, v_own))

    out = lax.map(body, jnp.arange(n_chunks))
    out = out.transpose(1, 2, 0, 3, 4).reshape(b, h, s, d)
    return out.astype(out_dtype)


def setup_inputs(seed: int = 0) -> dict:
    key = jax.random.key(seed)
    ks = jax.random.split(key, 12)
    f32 = jnp.float32
    x = jax.random.normal(ks[0], (BATCH, SEQ, D_MODEL), f32)
    norm_g = 1.0 + 0.05 * jax.random.normal(ks[1], (DEPTH, D_MODEL), f32)
    w_in = jax.random.normal(ks[2], (DEPTH, D_MODEL, IN_WIDTH), f32) * D_MODEL ** -0.5
    conv_w = jax.random.normal(ks[3], (DEPTH, CONV_K, CONV_WIDTH), f32) * CONV_K ** -0.5
    conv_b = 0.02 * jax.random.normal(ks[4], (DEPTH, CONV_WIDTH), f32)
    conv_ln_g = 1.0 + 0.05 * jax.random.normal(ks[5], (DEPTH, CONV_WIDTH), f32)
    conv_ln_b = 0.02 * jax.random.normal(ks[6], (DEPTH, CONV_WIDTH), f32)
    conv_pw_w = jax.random.normal(ks[7], (DEPTH, CONV_WIDTH, CONV_WIDTH), f32) * CONV_WIDTH ** -0.5
    conv_pw_b = 0.02 * jax.random.normal(ks[8], (DEPTH, CONV_WIDTH), f32)
    w_out = jax.random.normal(ks[9], (DEPTH, MIX_WIDTH, D_MODEL), f32) * MIX_WIDTH ** -0.5
    final_g = 1.0 + 0.05 * jax.random.normal(ks[10], (D_MODEL,), f32)
    return {"x": x, "norm_g": norm_g, "w_in": w_in, "conv_w": conv_w, "conv_b": conv_b,
            "conv_ln_g": conv_ln_g, "conv_ln_b": conv_ln_b, "conv_pw_w": conv_pw_w,
            "conv_pw_b": conv_pw_b, "w_out": w_out, "final_g": final_g}


def reference(x, norm_g, w_in, conv_w, conv_b, conv_ln_g, conv_ln_b, conv_pw_w, conv_pw_b,
              w_out, final_g):
    for layer in range(DEPTH):
        hn = rmsnorm(x, norm_g[layer])
        proj = hn @ w_in[layer]
        (a_val, a_glu, a_gate, r_q, r_k, r_v, r_gate,
         m_q, m_k, m_v, m_gate) = jnp.split(proj, SPLIT_POINTS, axis=-1)
        y_a = conformer_conv(a_val, a_glu, conv_w[layer], conv_b[layer], conv_ln_g[layer],
                             conv_ln_b[layer], conv_pw_w[layer], conv_pw_b[layer])
        y_a = y_a * jax.nn.silu(a_gate)
        y_r = merge_heads(retention(split_heads(r_q, RET_HEADS), split_heads(r_k, RET_HEADS),
                                    split_heads(r_v, RET_HEADS)))
        y_r = y_r * jax.nn.silu(r_gate)
        y_m = merge_heads(moba_attention(split_heads(m_q, ATT_HEADS), split_heads(m_k, ATT_HEADS),
                                         split_heads(m_v, ATT_HEADS)))
        y_m = y_m * jax.nn.silu(m_gate)
        y = jnp.concatenate([y_a, y_r, y_m], axis=-1) @ w_out[layer]
        x = x + y
    return rmsnorm(x, final_g)
```

```cpp
#include <hip/hip_runtime.h>
#include <hip/hip_cooperative_groups.h>
#include <cstdio>
#include <cstdint>
namespace cg = cooperative_groups;

#ifndef ONE_LAUNCH
#define ONE_LAUNCH 0
#endif

typedef _Float16 h16;
typedef _Float16 h16x8 __attribute__((ext_vector_type(8)));
typedef _Float16 h16x4 __attribute__((ext_vector_type(4)));
typedef float f32x16 __attribute__((ext_vector_type(16)));
typedef float f32x4 __attribute__((ext_vector_type(4)));

constexpr int BATCH = 8, SEQ = 4096, DM = 1024, MROWS = BATCH * SEQ, NIN = 3840, DEPTH = 2;
constexpr int C_AVAL = 0, C_AGLU = 256, C_AGATE = 512, C_RQ = 768, C_RK = 1024, C_RV = 1280, C_RGATE = 1536, C_MQ = 1792, C_MK = 2304, C_MV = 2816, C_MGATE = 3328;
constexpr int NPART = 8;
constexpr int NTHREADS = 512;
constexpr int LDS_BYTES = 147456;
constexpr int NPHASES = 10;

constexpr size_t MiB = 1u << 20;
constexpr size_t WS_XH = 0, WS_PROJ = 64 * MiB, WS_MIX = 304 * MiB, WS_WIN = 368 * MiB, WS_WOUT = 383 * MiB, WS_WPW = 387 * MiB,
                 WS_KV = 388 * MiB, WS_KMEAN = 404 * MiB, WS_ROWSS = 405 * MiB, WS_END = 406 * MiB;

struct Params {
    const float *x, *norm_g, *w_in, *conv_w, *conv_b, *ln_g, *ln_b, *pw_w, *pw_b, *w_out, *final_g;
    float* out; unsigned char* ws;
    int ph_lo, ph_hi;
};

__device__ __forceinline__ float silu_f(float v) { return v / (1.0f + __expf(-v)); }
__device__ __forceinline__ int crow(int r, int h) { return (r & 3) + 8 * (r >> 2) + 4 * h; }
__device__ __forceinline__ float wave_sum(float v) {
#pragma unroll
    for (int o = 1; o < 64; o <<= 1) v += __shfl_xor(v, o);
    return v;
}

__device__ __forceinline__ void transpose_unit(const float* W, int K, int N, h16* WT, const float* g, int k0, int n0, float* tile) {
    const int tid = threadIdx.x;
    __syncthreads();
#pragma unroll
    for (int i = 0; i < 8; ++i) { const int k = i * 8 + (tid >> 6), n = tid & 63; float v = W[(size_t)(k0 + k) * N + n0 + n]; if (g) v *= g[k0 + k]; tile[k * 65 + n] = v; }
    __syncthreads();
#pragma unroll
    for (int i = 0; i < 8; ++i) { const int n = i * 8 + (tid >> 6), k = tid & 63; WT[(size_t)(n0 + n) * K + k0 + k] = (h16)tile[k * 65 + n]; }
}

__device__ __forceinline__ void phase_prologue(const Params& p, unsigned char* lds) {
    float* tile = (float*)lds;
    h16* win = (h16*)(p.ws + WS_WIN); h16* wout = (h16*)(p.ws + WS_WOUT); h16* wpw = (h16*)(p.ws + WS_WPW);
    constexpr int U_IN = 16 * 60, U_OUT = 16 * 16, U_PW = 4 * 4, U_L = U_IN + U_OUT + U_PW;
    for (int u = blockIdx.x; u < DEPTH * U_L; u += gridDim.x) {
        const int layer = u / U_L; int r = u % U_L;
        if (r < U_IN) { transpose_unit(p.w_in + (size_t)layer * DM * NIN, DM, NIN, win + (size_t)layer * NIN * DM, p.norm_g + layer * DM, (r / 60) * 64, (r % 60) * 64, tile); continue; }
        r -= U_IN;
        if (r < U_OUT) { transpose_unit(p.w_out + (size_t)layer * DM * DM, DM, DM, wout + (size_t)layer * DM * DM, nullptr, (r / 16) * 64, (r % 16) * 64, tile); continue; }
        r -= U_OUT;
        transpose_unit(p.pw_w + (size_t)layer * 256 * 256, 256, 256, wpw + (size_t)layer * 256 * 256, nullptr, (r / 4) * 64, (r % 4) * 64, tile);
    }
    h16* xh = (h16*)(p.ws + WS_XH); float* rowss = (float*)(p.ws + WS_ROWSS);
    const int lane = threadIdx.x & 63, wid = threadIdx.x >> 6;
    for (int row = blockIdx.x * 8 + wid; row < MROWS; row += gridDim.x * 8) {
        const f32x4* xr = (const f32x4*)(p.x + (size_t)row * DM) + lane;
        float ss = 0.f;
#pragma unroll
        for (int j = 0; j < 4; ++j) { const f32x4 v = xr[64 * j]; ss += v.x * v.x + v.y * v.y + v.z * v.z + v.w * v.w;
            h16x4 o; o.x = (h16)v.x; o.y = (h16)v.y; o.z = (h16)v.z; o.w = (h16)v.w; *((h16x4*)(xh + (size_t)row * DM) + lane + 64 * j) = o; }
        ss = wave_sum(ss);
        if (lane < NPART) rowss[(size_t)row * NPART + lane] = (lane == 0) ? ss : 0.f;
    }
}

template <int EPI> __device__ __forceinline__ void gemm_phase(const Params& p, int layer, unsigned char* lds) {
    constexpr int K = DM, N = (EPI == 1) ? NIN : DM, nN = N / 128, nM = MROWS / 256, LDSTR = 40;
    const h16* A = (EPI == 1) ? (const h16*)(p.ws + WS_XH) : (const h16*)(p.ws + WS_MIX);
    const h16* Bt = (EPI == 1) ? (const h16*)(p.ws + WS_WIN) + (size_t)layer * NIN * DM : (const h16*)(p.ws + WS_WOUT) + (size_t)layer * DM * DM;
    h16* As = (h16*)lds; h16* Bs = As + 256 * LDSTR; float* ssq = (float*)(lds + 32768);
    const int tid = threadIdx.x, lane = tid & 63, wid = tid >> 6, wm = wid >> 1, wn = wid & 1, r = lane & 31, h = lane >> 5;
    float* rowss = (float*)(p.ws + WS_ROWSS);
    for (int tile = blockIdx.x; tile < nM * nN; tile += gridDim.x) {
        const int pm = tile / nN, pn = tile % nN;
        f32x16 acc[2][2];
#pragma unroll
        for (int a = 0; a < 2; ++a)
#pragma unroll
            for (int b = 0; b < 2; ++b)
#pragma unroll
                for (int i = 0; i < 16; ++i) acc[a][b][i] = 0.f;
        const h16* ga0 = A + (size_t)(pm * 256 + (tid >> 2)) * K + (tid & 3) * 8;
        const h16* ga1 = ga0 + (size_t)128 * K;
        const h16* gb = Bt + (size_t)(pn * 128 + (tid >> 2)) * K + (tid & 3) * 8;
        uint4 ra0 = *(const uint4*)ga0, ra1 = *(const uint4*)ga1, rb = *(const uint4*)gb;
        for (int kt = 0; kt < K / 32; ++kt) {
            __syncthreads();
            *(uint4*)(As + (tid >> 2) * LDSTR + (tid & 3) * 8) = ra0;
            *(uint4*)(As + (128 + (tid >> 2)) * LDSTR + (tid & 3) * 8) = ra1;
            *(uint4*)(Bs + (tid >> 2) * LDSTR + (tid & 3) * 8) = rb;
            __syncthreads();
            if (kt + 1 < K / 32) { ra0 = *(const uint4*)(ga0 + (kt + 1) * 32); ra1 = *(const uint4*)(ga1 + (kt + 1) * 32); rb = *(const uint4*)(gb + (kt + 1) * 32); }
#pragma unroll
            for (int s = 0; s < 2; ++s) {
                h16x8 af[2], bf[2];
#pragma unroll
                for (int mb = 0; mb < 2; ++mb) af[mb] = *(const h16x8*)(As + (wm * 64 + mb * 32 + r) * LDSTR + s * 16 + h * 8);
#pragma unroll
                for (int nb = 0; nb < 2; ++nb) bf[nb] = *(const h16x8*)(Bs + (wn * 64 + nb * 32 + r) * LDSTR + s * 16 + h * 8);
#pragma unroll
                for (int mb = 0; mb < 2; ++mb)
#pragma unroll
                    for (int nb = 0; nb < 2; ++nb) acc[mb][nb] = __builtin_amdgcn_mfma_f32_32x32x16_f16(af[mb], bf[nb], acc[mb][nb], 0, 0, 0);
            }
        }
        if (EPI == 1) {
            h16* proj = (h16*)(p.ws + WS_PROJ);
#pragma unroll
            for (int mb = 0; mb < 2; ++mb)
#pragma unroll
                for (int i = 0; i < 16; ++i) {
                    const int row = pm * 256 + wm * 64 + mb * 32 + crow(i, h);
                    const f32x4 s0 = *(const f32x4*)(rowss + (size_t)row * NPART), s1 = *(const f32x4*)(rowss + (size_t)row * NPART + 4);
                    const float rstd = rsqrtf(((s0.x + s0.y) + (s0.z + s0.w) + (s1.x + s1.y) + (s1.z + s1.w)) * (1.0f / DM) + 1e-6f);
#pragma unroll
                    for (int nb = 0; nb < 2; ++nb) proj[(size_t)row * NIN + pn * 128 + wn * 64 + nb * 32 + r] = (h16)(acc[mb][nb][i] * rstd);
                }
        } else {
            const float* xold = (layer == 0) ? p.x : p.out; h16* xh = (h16*)(p.ws + WS_XH);
#pragma unroll
            for (int mb = 0; mb < 2; ++mb)
#pragma unroll
                for (int i = 0; i < 16; ++i) {
                    const int rl = wm * 64 + mb * 32 + crow(i, h); const size_t row = (size_t)pm * 256 + rl;
                    float ss = 0.f;
#pragma unroll
                    for (int nb = 0; nb < 2; ++nb) { const int col = pn * 128 + wn * 64 + nb * 32 + r; const float v = xold[row * DM + col] + acc[mb][nb][i];
                        p.out[row * DM + col] = v; xh[row * DM + col] = (h16)v; ss += v * v; }
#pragma unroll
                    for (int o = 1; o < 32; o <<= 1) ss += __shfl_xor(ss, o);
                    if (r == 0) ssq[wn * 256 + rl] = ss;
                }
            __syncthreads();
            if (tid < 256) rowss[((size_t)pm * 256 + tid) * NPART + pn] = ssq[tid] + ssq[256 + tid];
        }
    }
}

__device__ __forceinline__ void phase_stats(const Params& p, unsigned char* lds) {
    const h16* proj = (const h16*)(p.ws + WS_PROJ); float* kmean = (float*)(p.ws + WS_KMEAN); float* kv = (float*)(p.ws + WS_KV);
    const int tid = threadIdx.x;
    float* ks = (float*)lds; float* vs = ks + 128 * 64;
    for (int u = blockIdx.x; u < 128 + 1024; u += gridDim.x) {
        if (u < 128) {
            const int b = u >> 4, n = u & 15; float s = 0.f;
            const h16* src = proj + (size_t)(b * SEQ + n * 256) * NIN + C_MK + tid;
            for (int rr = 0; rr < 256; ++rr) s += (float)src[(size_t)rr * NIN];
            kmean[((size_t)(b * 8 + (tid >> 6)) * 16 + n) * 64 + (tid & 63)] = s * (1.0f / 256.0f);
        } else {
            const int v = u - 128, b = v >> 7, hh = (v >> 5) & 3, n = v & 31;
            const float log_g = logf(1.0f - exp2f(-5.0f - (float)hh));
            __syncthreads();
#pragma unroll 2
            for (int i = 0; i < 16; ++i) { const int e = tid + i * 512, jj = e >> 6, d = e & 63; const size_t row = (size_t)(b * SEQ + n * 128 + jj);
                ks[e] = (float)proj[row * NIN + C_RK + hh * 64 + d] * 0.125f * expf(log_g * (float)(127 - jj));
                vs[e] = (float)proj[row * NIN + C_RV + hh * 64 + d]; }
            __syncthreads();
            const int d = tid >> 3, e0 = (tid & 7) * 8; float o[8];
#pragma unroll
            for (int i = 0; i < 8; ++i) o[i] = 0.f;
            for (int jj = 0; jj < 128; ++jj) { const float kk = ks[jj * 64 + d];
#pragma unroll
                for (int i = 0; i < 8; ++i) o[i] += kk * vs[jj * 64 + e0 + i]; }
            float* dst = kv + ((size_t)((b * 4 + hh) * 32 + n)) * 4096 + d * 64 + e0;
#pragma unroll
            for (int i = 0; i < 8; ++i) dst[i] = o[i];
        }
    }
}

__device__ __forceinline__ void conv_unit(const Params& p, int layer, int b, int tt, unsigned char* lds) {
    const h16* proj = (const h16*)(p.ws + WS_PROJ); h16* mix = (h16*)(p.ws + WS_MIX);
    float* us = (float*)lds; float* ys = us + 62 * 256;
    const int tid = threadIdx.x, c = tid & 255, th = tid >> 8, t0 = tt * 32, lane = tid & 63, wid = tid >> 6;
    __syncthreads();
    for (int rr = th; rr < 62; rr += 2) { const int t = t0 - 30 + rr; float u = 0.f;
        if (t >= 0) { const size_t row = (size_t)(b * SEQ + t); const float a = (float)proj[row * NIN + C_AVAL + c], g = (float)proj[row * NIN + C_AGLU + c]; u = a / (1.0f + __expf(-g)); }
        us[rr * 256 + c] = u; }
    __syncthreads();
    {
        float w[31];
#pragma unroll
        for (int jj = 0; jj < 31; ++jj) w[jj] = p.conv_w[((size_t)layer * 31 + jj) * 256 + c];
        const float cb = p.conv_b[layer * 256 + c];
#pragma unroll 1
        for (int tl = th * 16; tl < th * 16 + 16; ++tl) { float y = cb;
#pragma unroll
            for (int jj = 0; jj < 31; ++jj) y += w[jj] * us[(tl + jj) * 256 + c];
            ys[tl * 256 + c] = y; }
    }
    __syncthreads();
    {
        const f32x4 lg = *(const f32x4*)(p.ln_g + layer * 256 + lane * 4), lb = *(const f32x4*)(p.ln_b + layer * 256 + lane * 4);
        for (int k = 0; k < 4; ++k) { const int tl = wid * 4 + k; f32x4 v = *(const f32x4*)(ys + tl * 256 + lane * 4);
            const float mu = wave_sum((v.x + v.y) + (v.z + v.w)) * (1.0f / 256.0f);
            v = v - mu; const float var = wave_sum((v.x * v.x + v.y * v.y) + (v.z * v.z + v.w * v.w)) * (1.0f / 256.0f); const float rs = rsqrtf(var + 1e-5f);
            f32x4 o; o.x = silu_f(v.x * rs * lg.x + lb.x); o.y = silu_f(v.y * rs * lg.y + lb.y); o.z = silu_f(v.z * rs * lg.z + lb.z); o.w = silu_f(v.w * rs * lg.w + lb.w);
            *(f32x4*)(ys + tl * 256 + lane * 4) = o; }
    }
    __syncthreads();
    {
        float acc[16]; const float pb = p.pw_b[layer * 256 + c];
#pragma unroll
        for (int k = 0; k < 16; ++k) acc[k] = pb;
        const float* pw = p.pw_w + (size_t)layer * 65536 + c;
#pragma unroll 2
        for (int cc = 0; cc < 256; ++cc) { const float w = pw[(size_t)cc * 256];
#pragma unroll
            for (int k = 0; k < 16; ++k) acc[k] += ys[(th * 16 + k) * 256 + cc] * w; }
#pragma unroll
        for (int k = 0; k < 16; ++k) { const size_t row = (size_t)(b * SEQ + t0 + th * 16 + k);
            mix[row * DM + c] = (h16)(acc[k] * silu_f((float)proj[row * NIN + C_AGATE + c])); }
    }
}

__device__ __forceinline__ void ret_unit(const Params& p, int b, int hh, int n, unsigned char* lds) {
    const h16* proj = (const h16*)(p.ws + WS_PROJ); h16* mix = (h16*)(p.ws + WS_MIX); const float* kv = (const float*)(p.ws + WS_KV);
    float* Rs = (float*)lds; float* ks = Rs + 4096; float* vs = ks + 8192; float* qs = vs + 8192; float* dect = qs + 128 * 65; float* os = ks;
    const int tid = threadIdx.x, i = tid & 127, eg = tid >> 7;
    const float log_g = logf(1.0f - exp2f(-5.0f - (float)hh)); const float g_chunk = expf(log_g * 128.0f);
    __syncthreads();
    {
        const float* kvb = kv + ((size_t)(b * 4 + hh) * 32) * 4096;
#pragma unroll 1
        for (int k = 0; k < 8; ++k) { const int e = tid + k * 512; float rr = 0.f; for (int m = 0; m < n; ++m) rr = rr * g_chunk + kvb[(size_t)m * 4096 + e]; Rs[e] = rr; }
#pragma unroll 1
        for (int k = 0; k < 16; ++k) { const int e = tid + k * 512, jj = e >> 6, d = e & 63; const size_t row = (size_t)(b * SEQ + n * 128 + jj);
            ks[e] = (float)proj[row * NIN + C_RK + hh * 64 + d] * 0.125f; vs[e] = (float)proj[row * NIN + C_RV + hh * 64 + d];
            qs[jj * 65 + d] = (float)proj[row * NIN + C_RQ + hh * 64 + d]; }
        if (tid < 129) dect[tid] = expf(log_g * (float)tid);
    }
    const size_t rowi = (size_t)(b * SEQ + n * 128 + i);
    __syncthreads();
    float o[16];
#pragma unroll
    for (int e = 0; e < 16; ++e) o[e] = 0.f;
#pragma unroll 1
    for (int j = 0; j < 128; ++j) {
        if (j <= i) {
            float s = 0.f;
#pragma unroll 4
            for (int d = 0; d < 64; ++d) s += qs[i * 65 + d] * ks[j * 64 + d];
            s *= dect[i - j];
#pragma unroll
            for (int e = 0; e < 16; ++e) o[e] += s * vs[j * 64 + eg * 16 + e];
        }
    }
    {
        const float xi = dect[i + 1];
#pragma unroll 2
        for (int d = 0; d < 64; ++d) { const float qd = qs[i * 65 + d] * xi;
#pragma unroll
            for (int e = 0; e < 16; ++e) o[e] += qd * Rs[d * 64 + eg * 16 + e]; }
    }
    __syncthreads();
#pragma unroll
    for (int e = 0; e < 16; ++e) os[i * 65 + eg * 16 + e] = o[e];
    __syncthreads();
    float mu = 0.f;
#pragma unroll 4
    for (int e = 0; e < 64; ++e) mu += os[i * 65 + e];
    mu *= (1.0f / 64.0f);
    float var = 0.f;
#pragma unroll 4
    for (int e = 0; e < 64; ++e) { const float dlt = os[i * 65 + e] - mu; var += dlt * dlt; }
    const float rs = rsqrtf(var * (1.0f / 64.0f) + 1e-5f);
#pragma unroll
    for (int e = 0; e < 16; ++e) { const int col = hh * 64 + eg * 16 + e;
        mix[rowi * DM + 256 + col] = (h16)((o[e] - mu) * rs * silu_f((float)proj[rowi * NIN + C_RGATE + col])); }
}

__device__ __forceinline__ void moba_unit(const Params& p, int b, int hh, int j, unsigned char* lds) {
    const h16* proj = (const h16*)(p.ws + WS_PROJ); h16* mix = (h16*)(p.ws + WS_MIX); const float* kmean = (const float*)(p.ws + WS_KMEAN);
    const int tid = threadIdx.x, q = tid & 255, dh = tid >> 8;
    const size_t rowq = (size_t)(b * SEQ + j * 256 + q);
    float qv[64];
    {
        const h16x8* qp = (const h16x8*)(proj + rowq * NIN + C_MQ + hh * 64);
#pragma unroll
        for (int k = 0; k < 8; ++k) { const h16x8 v = qp[k];
#pragma unroll
            for (int d = 0; d < 8; ++d) qv[k * 8 + d] = (float)v[d] * 0.125f; }
    }
    unsigned selmask = 0u;
    if (j <= 3) selmask = (1u << j) - 1u;
    else {
        float g0 = -3.0e38f, g1 = -3.0e38f, g2 = -3.0e38f; int i0 = 0, i1 = 0, i2 = 0;
        const float* km = kmean + ((size_t)(b * 8 + hh) * 16) * 64;
#pragma unroll 1
        for (int n = 0; n < j; ++n) { float s = 0.f;
#pragma unroll
            for (int d = 0; d < 64; ++d) s += qv[d] * km[n * 64 + d];
            if (s > g0) { g2 = g1; i2 = i1; g1 = g0; i1 = i0; g0 = s; i0 = n; }
            else if (s > g1) { g2 = g1; i2 = i1; g1 = s; i1 = n; }
            else if (s > g2) { g2 = s; i2 = n; } }
        selmask = (1u << i0) | (1u << i1) | (1u << i2);
    }
    float m = -1.0e30f, l = 0.f, o[32];
#pragma unroll
    for (int d = 0; d < 32; ++d) o[d] = 0.f;
    h16* Ks = (h16*)lds; h16* Vs = Ks + 256 * 64;
    const float slope = exp2f(-(float)(hh + 1));
    const int tq = j * 256 + q;
#pragma unroll 1
    for (int nb = j; nb >= 0; --nb) {
        __syncthreads();
#pragma unroll 1
        for (int i = 0; i < 4; ++i) { const int c = tid + i * 512; const size_t row = (size_t)(b * SEQ + nb * 256 + (c >> 3));
            *(uint4*)(Ks + (c >> 3) * 64 + (c & 7) * 8) = *(const uint4*)(proj + row * NIN + C_MK + hh * 64 + (c & 7) * 8);
            *(uint4*)(Vs + (c >> 3) * 64 + (c & 7) * 8) = *(const uint4*)(proj + row * NIN + C_MV + hh * 64 + (c & 7) * 8); }
        __syncthreads();
        const bool use = (nb == j) || ((selmask >> nb) & 1u);
        if (use) {
#pragma unroll 1
            for (int key = 255; key >= 0; --key) {
                if (nb == j && key > q) continue;
                float s = 0.f;
#pragma unroll
                for (int k = 0; k < 8; ++k) { const h16x8 kvv = *(const h16x8*)(Ks + key * 64 + k * 8);
#pragma unroll
                    for (int d = 0; d < 8; ++d) s += qv[k * 8 + d] * (float)kvv[d]; }
                s -= slope * (float)(tq - (nb * 256 + key));
                if (s > m) { const float a = __expf(m - s); l *= a;
#pragma unroll
                    for (int d = 0; d < 32; ++d) o[d] *= a;
                    m = s; }
                const float pe = __expf(s - m); l += pe;
#pragma unroll
                for (int k = 0; k < 4; ++k) { const h16x8 vv = *(const h16x8*)(Vs + key * 64 + dh * 32 + k * 8);
#pragma unroll
                    for (int d = 0; d < 8; ++d) o[k * 8 + d] += pe * (float)vv[d]; }
            }
        }
    }
    {
        const float inv = 1.0f / l;
        const h16* gp = proj + rowq * NIN + C_MGATE + hh * 64 + dh * 32; h16* dst = mix + rowq * DM + 512 + hh * 64 + dh * 32;
#pragma unroll
        for (int k = 0; k < 4; ++k) { const h16x8 gv = *(const h16x8*)(gp + k * 8); h16x8 ov;
#pragma unroll
            for (int d = 0; d < 8; ++d) ov[d] = (h16)(o[k * 8 + d] * inv * silu_f((float)gv[d]));
            *(h16x8*)(dst + k * 8) = ov; }
    }
}

__device__ __forceinline__ void phase_mixers(const Params& p, int layer, unsigned char* lds) {
#pragma unroll 1
    for (int u = blockIdx.x; u < 1024; u += gridDim.x) { const int j = 15 - (u >> 6), bh = u & 63; moba_unit(p, bh >> 3, bh & 7, j, lds); }
#pragma unroll 1
    for (int v = blockIdx.x; v < 1024; v += gridDim.x) ret_unit(p, v >> 7, (v >> 5) & 3, v & 31, lds);
#pragma unroll 1
    for (int v = blockIdx.x; v < 1024; v += gridDim.x) conv_unit(p, layer, v >> 7, v & 127, lds);
}

__device__ __forceinline__ void phase_final(const Params& p) {
    const float* rowss = (const float*)(p.ws + WS_ROWSS);
    const int lane = threadIdx.x & 63, wid = threadIdx.x >> 6;
    f32x4 g[4];
#pragma unroll
    for (int j = 0; j < 4; ++j) g[j] = *((const f32x4*)p.final_g + lane + 64 * j);
    for (int row = blockIdx.x * 8 + wid; row < MROWS; row += gridDim.x * 8) {
        const f32x4 s0 = *(const f32x4*)(rowss + (size_t)row * NPART), s1 = *(const f32x4*)(rowss + (size_t)row * NPART + 4);
        const float rstd = rsqrtf(((s0.x + s0.y) + (s0.z + s0.w) + (s1.x + s1.y) + (s1.z + s1.w)) * (1.0f / DM) + 1e-6f);
        f32x4* xr = (f32x4*)(p.out + (size_t)row * DM) + lane;
#pragma unroll
        for (int j = 0; j < 4; ++j) { f32x4 v = xr[64 * j]; v = v * rstd * g[j]; xr[64 * j] = v; }
    }
}

__global__ void __launch_bounds__(NTHREADS) hymba_fwd(Params p) {
    extern __shared__ __attribute__((aligned(16))) unsigned char lds[];
    cg::grid_group grid = cg::this_grid();
#define RUN_PHASE(k, body) do { if (p.ph_lo <= (k) && (k) < p.ph_hi) { body; if ((k) + 1 < p.ph_hi) grid.sync(); } } while (0)
    RUN_PHASE(0, phase_prologue(p, lds));
    RUN_PHASE(1, gemm_phase<1>(p, 0, lds));
    RUN_PHASE(2, phase_stats(p, lds));
    RUN_PHASE(3, phase_mixers(p, 0, lds));
    RUN_PHASE(4, gemm_phase<2>(p, 0, lds));
    RUN_PHASE(5, gemm_phase<1>(p, 1, lds));
    RUN_PHASE(6, phase_stats(p, lds));
    RUN_PHASE(7, phase_mixers(p, 1, lds));
    RUN_PHASE(8, gemm_phase<2>(p, 1, lds));
    RUN_PHASE(9, phase_final(p));
#undef RUN_PHASE
}

extern "C" void kernel_launch(void* const* d_in, const int* in_sizes, int n_in, void* d_out, int out_size, void* d_ws, size_t ws_size, hipStream_t stream) {
    static int grid_blocks = 0;
    if (!grid_blocks) {
        int dev = 0, cus = 0, per_cu = 0;
        hipGetDevice(&dev);
        hipDeviceGetAttribute(&cus, hipDeviceAttributeMultiprocessorCount, dev);
        hipFuncSetAttribute((const void*)hymba_fwd, hipFuncAttributeMaxDynamicSharedMemorySize, LDS_BYTES);
        hipOccupancyMaxActiveBlocksPerMultiprocessor(&per_cu, (const void*)hymba_fwd, NTHREADS, LDS_BYTES);
        if (per_cu < 1) per_cu = 1;
        grid_blocks = cus * per_cu;
        if (ws_size < WS_END) fprintf(stderr, "kernel_launch: workspace too small (%zu < %zu)\n", ws_size, (size_t)WS_END);
    }
    Params p{};
    p.x = (const float*)d_in[0]; p.norm_g = (const float*)d_in[1]; p.w_in = (const float*)d_in[2]; p.conv_w = (const float*)d_in[3]; p.conv_b = (const float*)d_in[4];
    p.ln_g = (const float*)d_in[5]; p.ln_b = (const float*)d_in[6]; p.pw_w = (const float*)d_in[7]; p.pw_b = (const float*)d_in[8]; p.w_out = (const float*)d_in[9];
    p.final_g = (const float*)d_in[10]; p.out = (float*)d_out; p.ws = (unsigned char*)d_ws;
#if ONE_LAUNCH
    p.ph_lo = 0; p.ph_hi = NPHASES;
    { void* args[] = {&p};
      hipError_t e = hipLaunchCooperativeKernel((const void*)hymba_fwd, dim3(grid_blocks), dim3(NTHREADS), args, LDS_BYTES, stream);
      if (e != hipSuccess) fprintf(stderr, "cooperative launch failed: %s (grid %d)\n", hipGetErrorString(e), grid_blocks); }
#else
    for (int ph = 0; ph < NPHASES; ++ph) {
        p.ph_lo = ph; p.ph_hi = ph + 1; void* args[] = {&p};
        hipError_t e = hipLaunchCooperativeKernel((const void*)hymba_fwd, dim3(grid_blocks), dim3(NTHREADS), args, LDS_BYTES, stream);
        if (e != hipSuccess) { fprintf(stderr, "cooperative launch failed: %s (grid %d, phase %d)\n", hipGetErrorString(e), grid_blocks, ph); break; }
    }
#endif
}
```

```cpp
#include <hip/hip_runtime.h>
#include <hip/hip_cooperative_groups.h>
#include <cstdio>
#include <cstdint>
namespace cg = cooperative_groups;

#ifndef ONE_LAUNCH
#define ONE_LAUNCH 1
#endif

typedef _Float16 h16;
typedef _Float16 h16x8 __attribute__((ext_vector_type(8)));
typedef _Float16 h16x4 __attribute__((ext_vector_type(4)));
typedef float f32x16 __attribute__((ext_vector_type(16)));
typedef float f32x4 __attribute__((ext_vector_type(4)));

constexpr int BATCH = 8, SEQ = 4096, DM = 1024, MROWS = BATCH * SEQ, NIN = 3840, DEPTH = 2;
constexpr int C_AVAL = 0, C_AGLU = 256, C_AGATE = 512, C_RQ = 768, C_RK = 1024, C_RV = 1280, C_RGATE = 1536, C_MQ = 1792, C_MK = 2304, C_MV = 2816, C_MGATE = 3328;
constexpr int NPART = 8;
constexpr int NTHREADS = 512;
constexpr int LDS_BYTES = 147456;
constexpr int NPHASES = 10;

constexpr size_t MiB = 1u << 20;
constexpr size_t WS_XH = 0, WS_PROJ = 64 * MiB, WS_MIX = 304 * MiB, WS_WIN = 368 * MiB, WS_WOUT = 383 * MiB, WS_WPW = 387 * MiB,
                 WS_KV = 388 * MiB, WS_KMEAN = 404 * MiB, WS_ROWSS = 405 * MiB, WS_END = 406 * MiB;

struct Params {
    const float *x, *norm_g, *w_in, *conv_w, *conv_b, *ln_g, *ln_b, *pw_w, *pw_b, *w_out, *final_g;
    float* out; unsigned char* ws;
    int ph_lo, ph_hi;
};

__device__ __forceinline__ float silu_f(float v) { return v / (1.0f + __expf(-v)); }
__device__ __forceinline__ int crow(int r, int h) { return (r & 3) + 8 * (r >> 2) + 4 * h; }
__device__ __forceinline__ float wave_sum(float v) {
#pragma unroll
    for (int o = 1; o < 64; o <<= 1) v += __shfl_xor(v, o);
    return v;
}

__device__ __forceinline__ void transpose_unit(const float* W, int K, int N, h16* WT, const float* g, int k0, int n0, float* tile) {
    const int tid = threadIdx.x;
    __syncthreads();
#pragma unroll
    for (int i = 0; i < 8; ++i) { const int k = i * 8 + (tid >> 6), n = tid & 63; float v = W[(size_t)(k0 + k) * N + n0 + n]; if (g) v *= g[k0 + k]; tile[k * 65 + n] = v; }
    __syncthreads();
#pragma unroll
    for (int i = 0; i < 8; ++i) { const int n = i * 8 + (tid >> 6), k = tid & 63; WT[(size_t)(n0 + n) * K + k0 + k] = (h16)tile[k * 65 + n]; }
}

__device__ __forceinline__ void phase_prologue(const Params& p, unsigned char* lds) {
    float* tile = (float*)lds;
    h16* win = (h16*)(p.ws + WS_WIN); h16* wout = (h16*)(p.ws + WS_WOUT); h16* wpw = (h16*)(p.ws + WS_WPW);
    constexpr int U_IN = 16 * 60, U_OUT = 16 * 16, U_PW = 4 * 4, U_L = U_IN + U_OUT + U_PW;
    for (int u = blockIdx.x; u < DEPTH * U_L; u += gridDim.x) {
        const int layer = u / U_L; int r = u % U_L;
        if (r < U_IN) { transpose_unit(p.w_in + (size_t)layer * DM * NIN, DM, NIN, win + (size_t)layer * NIN * DM, p.norm_g + layer * DM, (r / 60) * 64, (r % 60) * 64, tile); continue; }
        r -= U_IN;
        if (r < U_OUT) { transpose_unit(p.w_out + (size_t)layer * DM * DM, DM, DM, wout + (size_t)layer * DM * DM, nullptr, (r / 16) * 64, (r % 16) * 64, tile); continue; }
        r -= U_OUT;
        transpose_unit(p.pw_w + (size_t)layer * 256 * 256, 256, 256, wpw + (size_t)layer * 256 * 256, nullptr, (r / 4) * 64, (r % 4) * 64, tile);
    }
    h16* xh = (h16*)(p.ws + WS_XH); float* rowss = (float*)(p.ws + WS_ROWSS);
    const int lane = threadIdx.x & 63, wid = threadIdx.x >> 6;
    for (int row = blockIdx.x * 8 + wid; row < MROWS; row += gridDim.x * 8) {
        const f32x4* xr = (const f32x4*)(p.x + (size_t)row * DM) + lane;
        float ss = 0.f;
#pragma unroll
        for (int j = 0; j < 4; ++j) { const f32x4 v = xr[64 * j]; ss += v.x * v.x + v.y * v.y + v.z * v.z + v.w * v.w;
            h16x4 o; o.x = (h16)v.x; o.y = (h16)v.y; o.z = (h16)v.z; o.w = (h16)v.w; *((h16x4*)(xh + (size_t)row * DM) + lane + 64 * j) = o; }
        ss = wave_sum(ss);
        if (lane < NPART) rowss[(size_t)row * NPART + lane] = (lane == 0) ? ss : 0.f;
    }
}

template <int EPI> __device__ __forceinline__ void gemm_phase(const Params& p, int layer, unsigned char* lds) {
    constexpr int K = DM, N = (EPI == 1) ? NIN : DM, nN = N / 128, nM = MROWS / 256, LDSTR = 40;
    const h16* A = (EPI == 1) ? (const h16*)(p.ws + WS_XH) : (const h16*)(p.ws + WS_MIX);
    const h16* Bt = (EPI == 1) ? (const h16*)(p.ws + WS_WIN) + (size_t)layer * NIN * DM : (const h16*)(p.ws + WS_WOUT) + (size_t)layer * DM * DM;
    h16* As = (h16*)lds; h16* Bs = As + 256 * LDSTR; float* ssq = (float*)(lds + 32768);
    const int tid = threadIdx.x, lane = tid & 63, wid = tid >> 6, wm = wid >> 1, wn = wid & 1, r = lane & 31, h = lane >> 5;
    float* rowss = (float*)(p.ws + WS_ROWSS);
    for (int tile = blockIdx.x; tile < nM * nN; tile += gridDim.x) {
        const int pm = tile / nN, pn = tile % nN;
        f32x16 acc[2][2];
#pragma unroll
        for (int a = 0; a < 2; ++a)
#pragma unroll
            for (int b = 0; b < 2; ++b)
#pragma unroll
                for (int i = 0; i < 16; ++i) acc[a][b][i] = 0.f;
        const h16* ga0 = A + (size_t)(pm * 256 + (tid >> 2)) * K + (tid & 3) * 8;
        const h16* ga1 = ga0 + (size_t)128 * K;
        const h16* gb = Bt + (size_t)(pn * 128 + (tid >> 2)) * K + (tid & 3) * 8;
        uint4 ra0 = *(const uint4*)ga0, ra1 = *(const uint4*)ga1, rb = *(const uint4*)gb;
        for (int kt = 0; kt < K / 32; ++kt) {
            __syncthreads();
            *(uint4*)(As + (tid >> 2) * LDSTR + (tid & 3) * 8) = ra0;
            *(uint4*)(As + (128 + (tid >> 2)) * LDSTR + (tid & 3) * 8) = ra1;
            *(uint4*)(Bs + (tid >> 2) * LDSTR + (tid & 3) * 8) = rb;
            __syncthreads();
            if (kt + 1 < K / 32) { ra0 = *(const uint4*)(ga0 + (kt + 1) * 32); ra1 = *(const uint4*)(ga1 + (kt + 1) * 32); rb = *(const uint4*)(gb + (kt + 1) * 32); }
#pragma unroll
            for (int s = 0; s < 2; ++s) {
                h16x8 af[2], bf[2];
#pragma unroll
                for (int mb = 0; mb < 2; ++mb) af[mb] = *(const h16x8*)(As + (wm * 64 + mb * 32 + r) * LDSTR + s * 16 + h * 8);
#pragma unroll
                for (int nb = 0; nb < 2; ++nb) bf[nb] = *(const h16x8*)(Bs + (wn * 64 + nb * 32 + r) * LDSTR + s * 16 + h * 8);
#pragma unroll
                for (int mb = 0; mb < 2; ++mb)
#pragma unroll
                    for (int nb = 0; nb < 2; ++nb) acc[mb][nb] = __builtin_amdgcn_mfma_f32_32x32x16_f16(af[mb], bf[nb], acc[mb][nb], 0, 0, 0);
            }
        }
        if (EPI == 1) {
            h16* proj = (h16*)(p.ws + WS_PROJ);
#pragma unroll
            for (int mb = 0; mb < 2; ++mb)
#pragma unroll
                for (int i = 0; i < 16; ++i) {
                    const int row = pm * 256 + wm * 64 + mb * 32 + crow(i, h);
                    const f32x4 s0 = *(const f32x4*)(rowss + (size_t)row * NPART), s1 = *(const f32x4*)(rowss + (size_t)row * NPART + 4);
                    const float rstd = rsqrtf(((s0.x + s0.y) + (s0.z + s0.w) + (s1.x + s1.y) + (s1.z + s1.w)) * (1.0f / DM) + 1e-6f);
#pragma unroll
                    for (int nb = 0; nb < 2; ++nb) proj[(size_t)row * NIN + pn * 128 + wn * 64 + nb * 32 + r] = (h16)(acc[mb][nb][i] * rstd);
                }
        } else {
            const float* xold = (layer == 0) ? p.x : p.out; h16* xh = (h16*)(p.ws + WS_XH);
#pragma unroll
            for (int mb = 0; mb < 2; ++mb)
#pragma unroll
                for (int i = 0; i < 16; ++i) {
                    const int rl = wm * 64 + mb * 32 + crow(i, h); const size_t row = (size_t)pm * 256 + rl;
                    float ss = 0.f;
#pragma unroll
                    for (int nb = 0; nb < 2; ++nb) { const int col = pn * 128 + wn * 64 + nb * 32 + r; const float v = xold[row * DM + col] + acc[mb][nb][i];
                        p.out[row * DM + col] = v; xh[row * DM + col] = (h16)v; ss += v * v; }
#pragma unroll
                    for (int o = 1; o < 32; o <<= 1) ss += __shfl_xor(ss, o);
                    if (r == 0) ssq[wn * 256 + rl] = ss;
                }
            __syncthreads();
            if (tid < 256) rowss[((size_t)pm * 256 + tid) * NPART + pn] = ssq[tid] + ssq[256 + tid];
        }
    }
}

__device__ __forceinline__ void phase_stats(const Params& p, unsigned char* lds) {
    const h16* proj = (const h16*)(p.ws + WS_PROJ); float* kmean = (float*)(p.ws + WS_KMEAN); float* kv = (float*)(p.ws + WS_KV);
    const int tid = threadIdx.x;
    float* ks = (float*)lds; float* vs = ks + 128 * 64;
    for (int u = blockIdx.x; u < 128 + 1024; u += gridDim.x) {
        if (u < 128) {
            const int b = u >> 4, n = u & 15; float s = 0.f;
            const h16* src = proj + (size_t)(b * SEQ + n * 256) * NIN + C_MK + tid;
            for (int rr = 0; rr < 256; ++rr) s += (float)src[(size_t)rr * NIN];
            kmean[((size_t)(b * 8 + (tid >> 6)) * 16 + n) * 64 + (tid & 63)] = s * (1.0f / 256.0f);
        } else {
            const int v = u - 128, b = v >> 7, hh = (v >> 5) & 3, n = v & 31;
            const float log_g = logf(1.0f - exp2f(-5.0f - (float)hh));
            __syncthreads();
#pragma unroll 2
            for (int i = 0; i < 16; ++i) { const int e = tid + i * 512, jj = e >> 6, d = e & 63; const size_t row = (size_t)(b * SEQ + n * 128 + jj);
                ks[e] = (float)proj[row * NIN + C_RK + hh * 64 + d] * 0.125f * expf(log_g * (float)(127 - jj));
                vs[e] = (float)proj[row * NIN + C_RV + hh * 64 + d]; }
            __syncthreads();
            const int d = tid >> 3, e0 = (tid & 7) * 8; float o[8];
#pragma unroll
            for (int i = 0; i < 8; ++i) o[i] = 0.f;
            for (int jj = 0; jj < 128; ++jj) { const float kk = ks[jj * 64 + d];
#pragma unroll
                for (int i = 0; i < 8; ++i) o[i] += kk * vs[jj * 64 + e0 + i]; }
            float* dst = kv + ((size_t)((b * 4 + hh) * 32 + n)) * 4096 + d * 64 + e0;
#pragma unroll
            for (int i = 0; i < 8; ++i) dst[i] = o[i];
        }
    }
}

__device__ __forceinline__ void conv_unit(const Params& p, int layer, int b, int tt, unsigned char* lds) {
    const h16* proj = (const h16*)(p.ws + WS_PROJ); h16* mix = (h16*)(p.ws + WS_MIX);
    float* us = (float*)lds; float* ys = us + 62 * 256;
    const int tid = threadIdx.x, c = tid & 255, th = tid >> 8, t0 = tt * 32, lane = tid & 63, wid = tid >> 6;
    __syncthreads();
    for (int rr = th; rr < 62; rr += 2) { const int t = t0 - 30 + rr; float u = 0.f;
        if (t >= 0) { const size_t row = (size_t)(b * SEQ + t); const float a = (float)proj[row * NIN + C_AVAL + c], g = (float)proj[row * NIN + C_AGLU + c]; u = a / (1.0f + __expf(-g)); }
        us[rr * 256 + c] = u; }
    __syncthreads();
    {
        float w[31];
#pragma unroll
        for (int jj = 0; jj < 31; ++jj) w[jj] = p.conv_w[((size_t)layer * 31 + jj) * 256 + c];
        const float cb = p.conv_b[layer * 256 + c];
#pragma unroll 1
        for (int tl = th * 16; tl < th * 16 + 16; ++tl) { float y = cb;
#pragma unroll
            for (int jj = 0; jj < 31; ++jj) y += w[jj] * us[(tl + jj) * 256 + c];
            ys[tl * 256 + c] = y; }
    }
    __syncthreads();
    {
        const f32x4 lg = *(const f32x4*)(p.ln_g + layer * 256 + lane * 4), lb = *(const f32x4*)(p.ln_b + layer * 256 + lane * 4);
        for (int k = 0; k < 4; ++k) { const int tl = wid * 4 + k; f32x4 v = *(const f32x4*)(ys + tl * 256 + lane * 4);
            const float mu = wave_sum((v.x + v.y) + (v.z + v.w)) * (1.0f / 256.0f);
            v = v - mu; const float var = wave_sum((v.x * v.x + v.y * v.y) + (v.z * v.z + v.w * v.w)) * (1.0f / 256.0f); const float rs = rsqrtf(var + 1e-5f);
            f32x4 o; o.x = silu_f(v.x * rs * lg.x + lb.x); o.y = silu_f(v.y * rs * lg.y + lb.y); o.z = silu_f(v.z * rs * lg.z + lb.z); o.w = silu_f(v.w * rs * lg.w + lb.w);
            *(f32x4*)(ys + tl * 256 + lane * 4) = o; }
    }
    __syncthreads();
    {
        float acc[16]; const float pb = p.pw_b[layer * 256 + c];
#pragma unroll
        for (int k = 0; k < 16; ++k) acc[k] = pb;
        const float* pw = p.pw_w + (size_t)layer * 65536 + c;
#pragma unroll 2
        for (int cc = 0; cc < 256; ++cc) { const float w = pw[(size_t)cc * 256];
#pragma unroll
            for (int k = 0; k < 16; ++k) acc[k] += ys[(th * 16 + k) * 256 + cc] * w; }
#pragma unroll
        for (int k = 0; k < 16; ++k) { const size_t row = (size_t)(b * SEQ + t0 + th * 16 + k);
            mix[row * DM + c] = (h16)(acc[k] * silu_f((float)proj[row * NIN + C_AGATE + c])); }
    }
}

__device__ __forceinline__ void ret_unit(const Params& p, int b, int hh, int n, unsigned char* lds) {
    const h16* proj = (const h16*)(p.ws + WS_PROJ); h16* mix = (h16*)(p.ws + WS_MIX); const float* kv = (const float*)(p.ws + WS_KV);
    float* Rs = (float*)lds; float* ks = Rs + 4096; float* vs = ks + 8192; float* qs = vs + 8192; float* dect = qs + 128 * 65; float* os = ks;
    const int tid = threadIdx.x, i = tid & 127, eg = tid >> 7;
    const float log_g = logf(1.0f - exp2f(-5.0f - (float)hh)); const float g_chunk = expf(log_g * 128.0f);
    __syncthreads();
    {
        const float* kvb = kv + ((size_t)(b * 4 + hh) * 32) * 4096;
#pragma unroll 1
        for (int k = 0; k < 8; ++k) { const int e = tid + k * 512; float rr = 0.f; for (int m = 0; m < n; ++m) rr = rr * g_chunk + kvb[(size_t)m * 4096 + e]; Rs[e] = rr; }
#pragma unroll 1
        for (int k = 0; k < 16; ++k) { const int e = tid + k * 512, jj = e >> 6, d = e & 63; const size_t row = (size_t)(b * SEQ + n * 128 + jj);
            ks[e] = (float)proj[row * NIN + C_RK + hh * 64 + d] * 0.125f; vs[e] = (float)proj[row * NIN + C_RV + hh * 64 + d];
            qs[jj * 65 + d] = (float)proj[row * NIN + C_RQ + hh * 64 + d]; }
        if (tid < 129) dect[tid] = expf(log_g * (float)tid);
    }
    const size_t rowi = (size_t)(b * SEQ + n * 128 + i);
    __syncthreads();
    float o[16];
#pragma unroll
    for (int e = 0; e < 16; ++e) o[e] = 0.f;
#pragma unroll 1
    for (int j = 0; j < 128; ++j) {
        if (j <= i) {
            float s = 0.f;
#pragma unroll 4
            for (int d = 0; d < 64; ++d) s += qs[i * 65 + d] * ks[j * 64 + d];
            s *= dect[i - j];
#pragma unroll
            for (int e = 0; e < 16; ++e) o[e] += s * vs[j * 64 + eg * 16 + e];
        }
    }
    {
        const float xi = dect[i + 1];
#pragma unroll 2
        for (int d = 0; d < 64; ++d) { const float qd = qs[i * 65 + d] * xi;
#pragma unroll
            for (int e = 0; e < 16; ++e) o[e] += qd * Rs[d * 64 + eg * 16 + e]; }
    }
    __syncthreads();
#pragma unroll
    for (int e = 0; e < 16; ++e) os[i * 65 + eg * 16 + e] = o[e];
    __syncthreads();
    float mu = 0.f;
#pragma unroll 4
    for (int e = 0; e < 64; ++e) mu += os[i * 65 + e];
    mu *= (1.0f / 64.0f);
    float var = 0.f;
#pragma unroll 4
    for (int e = 0; e < 64; ++e) { const float dlt = os[i * 65 + e] - mu; var += dlt * dlt; }
    const float rs = rsqrtf(var * (1.0f / 64.0f) + 1e-5f);
#pragma unroll
    for (int e = 0; e < 16; ++e) { const int col = hh * 64 + eg * 16 + e;
        mix[rowi * DM + 256 + col] = (h16)((o[e] - mu) * rs * silu_f((float)proj[rowi * NIN + C_RGATE + col])); }
}

__device__ __forceinline__ void moba_unit(const Params& p, int b, int hh, int j, unsigned char* lds) {
    const h16* proj = (const h16*)(p.ws + WS_PROJ); h16* mix = (h16*)(p.ws + WS_MIX); const float* kmean = (const float*)(p.ws + WS_KMEAN);
    const int tid = threadIdx.x, q = tid & 255, dh = tid >> 8;
    const size_t rowq = (size_t)(b * SEQ + j * 256 + q);
    float qv[64];
    {
        const h16x8* qp = (const h16x8*)(proj + rowq * NIN + C_MQ + hh * 64);
#pragma unroll
        for (int k = 0; k < 8; ++k) { const h16x8 v = qp[k];
#pragma unroll
            for (int d = 0; d < 8; ++d) qv[k * 8 + d] = (float)v[d] * 0.125f; }
    }
    unsigned selmask = 0u;
    if (j <= 3) selmask = (1u << j) - 1u;
    else {
        float g0 = -3.0e38f, g1 = -3.0e38f, g2 = -3.0e38f; int i0 = 0, i1 = 0, i2 = 0;
        const float* km = kmean + ((size_t)(b * 8 + hh) * 16) * 64;
#pragma unroll 1
        for (int n = 0; n < j; ++n) { float s = 0.f;
#pragma unroll
            for (int d = 0; d < 64; ++d) s += qv[d] * km[n * 64 + d];
            if (s > g0) { g2 = g1; i2 = i1; g1 = g0; i1 = i0; g0 = s; i0 = n; }
            else if (s > g1) { g2 = g1; i2 = i1; g1 = s; i1 = n; }
            else if (s > g2) { g2 = s; i2 = n; } }
        selmask = (1u << i0) | (1u << i1) | (1u << i2);
    }
    float m = -1.0e30f, l = 0.f, o[32];
#pragma unroll
    for (int d = 0; d < 32; ++d) o[d] = 0.f;
    h16* Ks = (h16*)lds; h16* Vs = Ks + 256 * 64;
    const float slope = exp2f(-(float)(hh + 1));
    const int tq = j * 256 + q;
#pragma unroll 1
    for (int nb = j; nb >= 0; --nb) {
        __syncthreads();
#pragma unroll 1
        for (int i = 0; i < 4; ++i) { const int c = tid + i * 512; const size_t row = (size_t)(b * SEQ + nb * 256 + (c >> 3));
            *(uint4*)(Ks + (c >> 3) * 64 + (c & 7) * 8) = *(const uint4*)(proj + row * NIN + C_MK + hh * 64 + (c & 7) * 8);
            *(uint4*)(Vs + (c >> 3) * 64 + (c & 7) * 8) = *(const uint4*)(proj + row * NIN + C_MV + hh * 64 + (c & 7) * 8); }
        __syncthreads();
        const bool use = (nb == j) || ((selmask >> nb) & 1u);
        if (use) {
#pragma unroll 1
            for (int key = 255; key >= 0; --key) {
                if (nb == j && key > q) continue;
                float s = 0.f;
#pragma unroll
                for (int k = 0; k < 8; ++k) { const h16x8 kvv = *(const h16x8*)(Ks + key * 64 + k * 8);
#pragma unroll
                    for (int d = 0; d < 8; ++d) s += qv[k * 8 + d] * (float)kvv[d]; }
                s -= slope * (float)(tq - (nb * 256 + key));
                if (s > m) { const float a = __expf(m - s); l *= a;
#pragma unroll
                    for (int d = 0; d < 32; ++d) o[d] *= a;
                    m = s; }
                const float pe = __expf(s - m); l += pe;
#pragma unroll
                for (int k = 0; k < 4; ++k) { const h16x8 vv = *(const h16x8*)(Vs + key * 64 + dh * 32 + k * 8);
#pragma unroll
                    for (int d = 0; d < 8; ++d) o[k * 8 + d] += pe * (float)vv[d]; }
            }
        }
    }
    {
        const float inv = 1.0f / l;
        const h16* gp = proj + rowq * NIN + C_MGATE + hh * 64 + dh * 32; h16* dst = mix + rowq * DM + 512 + hh * 64 + dh * 32;
#pragma unroll
        for (int k = 0; k < 4; ++k) { const h16x8 gv = *(const h16x8*)(gp + k * 8); h16x8 ov;
#pragma unroll
            for (int d = 0; d < 8; ++d) ov[d] = (h16)(o[k * 8 + d] * inv * silu_f((float)gv[d]));
            *(h16x8*)(dst + k * 8) = ov; }
    }
}

__device__ __forceinline__ void phase_mixers(const Params& p, int layer, unsigned char* lds) {
#pragma unroll 1
    for (int u = blockIdx.x; u < 1024; u += gridDim.x) { const int j = 15 - (u >> 6), bh = u & 63; moba_unit(p, bh >> 3, bh & 7, j, lds); }
#pragma unroll 1
    for (int v = blockIdx.x; v < 1024; v += gridDim.x) ret_unit(p, v >> 7, (v >> 5) & 3, v & 31, lds);
#pragma unroll 1
    for (int v = blockIdx.x; v < 1024; v += gridDim.x) conv_unit(p, layer, v >> 7, v & 127, lds);
}

__device__ __forceinline__ void phase_final(const Params& p) {
    const float* rowss = (const float*)(p.ws + WS_ROWSS);
    const int lane = threadIdx.x & 63, wid = threadIdx.x >> 6;
    f32x4 g[4];
#pragma unroll
    for (int j = 0; j < 4; ++j) g[j] = *((const f32x4*)p.final_g + lane + 64 * j);
    for (int row = blockIdx.x * 8 + wid; row < MROWS; row += gridDim.x * 8) {
        const f32x4 s0 = *(const f32x4*)(rowss + (size_t)row * NPART), s1 = *(const f32x4*)(rowss + (size_t)row * NPART + 4);
        const float rstd = rsqrtf(((s0.x + s0.y) + (s0.z + s0.w) + (s1.x + s1.y) + (s1.z + s1.w)) * (1.0f / DM) + 1e-6f);
        f32x4* xr = (f32x4*)(p.out + (size_t)row * DM) + lane;
#pragma unroll
        for (int j = 0; j < 4; ++j) { f32x4 v = xr[64 * j]; v = v * rstd * g[j]; xr[64 * j] = v; }
    }
}

__global__ void __launch_bounds__(NTHREADS) hymba_fwd(Params p) {
    extern __shared__ __attribute__((aligned(16))) unsigned char lds[];
    cg::grid_group grid = cg::this_grid();
#define RUN_PHASE(k, body) do { if (p.ph_lo <= (k) && (k) < p.ph_hi) { body; if ((k) + 1 < p.ph_hi) grid.sync(); } } while (0)
    RUN_PHASE(0, phase_prologue(p, lds));
    RUN_PHASE(1, gemm_phase<1>(p, 0, lds));
    RUN_PHASE(2, phase_stats(p, lds));
    RUN_PHASE(3, phase_mixers(p, 0, lds));
    RUN_PHASE(4, gemm_phase<2>(p, 0, lds));
    RUN_PHASE(5, gemm_phase<1>(p, 1, lds));
    RUN_PHASE(6, phase_stats(p, lds));
    RUN_PHASE(7, phase_mixers(p, 1, lds));
    RUN_PHASE(8, gemm_phase<2>(p, 1, lds));
    RUN_PHASE(9, phase_final(p));
#undef RUN_PHASE
}

extern "C" void kernel_launch(void* const* d_in, const int* in_sizes, int n_in, void* d_out, int out_size, void* d_ws, size_t ws_size, hipStream_t stream) {
    static int grid_blocks = 0;
    if (!grid_blocks) {
        int dev = 0, cus = 0, per_cu = 0;
        hipGetDevice(&dev);
        hipDeviceGetAttribute(&cus, hipDeviceAttributeMultiprocessorCount, dev);
        hipFuncSetAttribute((const void*)hymba_fwd, hipFuncAttributeMaxDynamicSharedMemorySize, LDS_BYTES);
        hipOccupancyMaxActiveBlocksPerMultiprocessor(&per_cu, (const void*)hymba_fwd, NTHREADS, LDS_BYTES);
        if (per_cu < 1) per_cu = 1;
        grid_blocks = cus * per_cu;
        if (ws_size < WS_END) fprintf(stderr, "kernel_launch: workspace too small (%zu < %zu)\n", ws_size, (size_t)WS_END);
    }
    Params p{};
    p.x = (const float*)d_in[0]; p.norm_g = (const float*)d_in[1]; p.w_in = (const float*)d_in[2]; p.conv_w = (const float*)d_in[3]; p.conv_b = (const float*)d_in[4];
    p.ln_g = (const float*)d_in[5]; p.ln_b = (const float*)d_in[6]; p.pw_w = (const float*)d_in[7]; p.pw_b = (const float*)d_in[8]; p.w_out = (const float*)d_in[9];
    p.final_g = (const float*)d_in[10]; p.out = (float*)d_out; p.ws = (unsigned char*)d_ws;
#if ONE_LAUNCH
    p.ph_lo = 0; p.ph_hi = NPHASES;
    { void* args[] = {&p};
      hipError_t e = hipLaunchCooperativeKernel((const void*)hymba_fwd, dim3(grid_blocks), dim3(NTHREADS), args, LDS_BYTES, stream);
      if (e != hipSuccess) fprintf(stderr, "cooperative launch failed: %s (grid %d)\n", hipGetErrorString(e), grid_blocks); }
#else
    for (int ph = 0; ph < NPHASES; ++ph) {
        p.ph_lo = ph; p.ph_hi = ph + 1; void* args[] = {&p};
        hipError_t e = hipLaunchCooperativeKernel((const void*)hymba_fwd, dim3(grid_blocks), dim3(NTHREADS), args, LDS_BYTES, stream);
        if (e != hipSuccess) { fprintf(stderr, "cooperative launch failed: %s (grid %d, phase %d)\n", hipGetErrorString(e), grid_blocks, ph); break; }
    }
#endif
}
```

```cpp
#include <hip/hip_runtime.h>
#include <hip/hip_cooperative_groups.h>
#include <cstdio>
#include <cstdint>
namespace cg = cooperative_groups;

#ifndef ONE_LAUNCH
#define ONE_LAUNCH 1
#endif

typedef _Float16 h16;
typedef _Float16 h16x8 __attribute__((ext_vector_type(8)));
typedef _Float16 h16x4 __attribute__((ext_vector_type(4)));
typedef float f32x16 __attribute__((ext_vector_type(16)));
typedef float f32x4 __attribute__((ext_vector_type(4)));
typedef unsigned u32x4 __attribute__((ext_vector_type(4)));

constexpr int BATCH = 8, SEQ = 4096, DM = 1024, MROWS = BATCH * SEQ, NIN = 3840, DEPTH = 2;
constexpr int C_AVAL = 0, C_AGLU = 256, C_AGATE = 512, C_RQ = 768, C_RK = 1024, C_RV = 1280, C_RGATE = 1536, C_MQ = 1792, C_MK = 2304, C_MV = 2816, C_MGATE = 3328;
constexpr int NPART = 8;
constexpr int NTHREADS = 512;
constexpr int LDS_BYTES = 147456;
constexpr int NPHASES = 10;

constexpr size_t MiB = 1u << 20;
constexpr size_t WS_XH = 0, WS_PROJ = 64 * MiB, WS_MIX = 304 * MiB, WS_WIN = 368 * MiB, WS_WOUT = 383 * MiB, WS_WPW = 387 * MiB,
                 WS_KV = 388 * MiB, WS_KMEAN = 404 * MiB, WS_ROWSS = 405 * MiB, WS_END = 406 * MiB;

struct Params {
    const float *x, *norm_g, *w_in, *conv_w, *conv_b, *ln_g, *ln_b, *pw_w, *pw_b, *w_out, *final_g;
    float* out; unsigned char* ws;
    int ph_lo, ph_hi;
};

__device__ __forceinline__ float silu_f(float v) { return v / (1.0f + __expf(-v)); }
__device__ __forceinline__ int crow(int r, int h) { return (r & 3) + 8 * (r >> 2) + 4 * h; }
__device__ __forceinline__ float wave_sum(float v) {
#pragma unroll
    for (int o = 1; o < 64; o <<= 1) v += __shfl_xor(v, o);
    return v;
}

__device__ __forceinline__ void transpose_unit(const float* W, int K, int N, h16* WT, const float* g, int k0, int n0, float* tile) {
    const int tid = threadIdx.x;
    __syncthreads();
#pragma unroll
    for (int i = 0; i < 8; ++i) { const int k = i * 8 + (tid >> 6), n = tid & 63; float v = W[(size_t)(k0 + k) * N + n0 + n]; if (g) v *= g[k0 + k]; tile[k * 65 + n] = v; }
    __syncthreads();
#pragma unroll
    for (int i = 0; i < 8; ++i) { const int n = i * 8 + (tid >> 6), k = tid & 63; WT[(size_t)(n0 + n) * K + k0 + k] = (h16)tile[k * 65 + n]; }
}

__device__ __forceinline__ void phase_prologue(const Params& p, unsigned char* lds) {
    float* tile = (float*)lds;
    h16* win = (h16*)(p.ws + WS_WIN); h16* wout = (h16*)(p.ws + WS_WOUT); h16* wpw = (h16*)(p.ws + WS_WPW);
    constexpr int U_IN = 16 * 60, U_OUT = 16 * 16, U_PW = 4 * 4, U_L = U_IN + U_OUT + U_PW;
    for (int u = blockIdx.x; u < DEPTH * U_L; u += gridDim.x) {
        const int layer = u / U_L; int r = u % U_L;
        if (r < U_IN) { transpose_unit(p.w_in + (size_t)layer * DM * NIN, DM, NIN, win + (size_t)layer * NIN * DM, p.norm_g + layer * DM, (r / 60) * 64, (r % 60) * 64, tile); continue; }
        r -= U_IN;
        if (r < U_OUT) { transpose_unit(p.w_out + (size_t)layer * DM * DM, DM, DM, wout + (size_t)layer * DM * DM, nullptr, (r / 16) * 64, (r % 16) * 64, tile); continue; }
        r -= U_OUT;
        transpose_unit(p.pw_w + (size_t)layer * 256 * 256, 256, 256, wpw + (size_t)layer * 256 * 256, nullptr, (r / 4) * 64, (r % 4) * 64, tile);
    }
    h16* xh = (h16*)(p.ws + WS_XH); float* rowss = (float*)(p.ws + WS_ROWSS);
    const int lane = threadIdx.x & 63, wid = threadIdx.x >> 6;
    for (int row = blockIdx.x * 8 + wid; row < MROWS; row += gridDim.x * 8) {
        const f32x4* xr = (const f32x4*)(p.x + (size_t)row * DM) + lane;
        float ss = 0.f;
#pragma unroll
        for (int j = 0; j < 4; ++j) { const f32x4 v = xr[64 * j]; ss += v.x * v.x + v.y * v.y + v.z * v.z + v.w * v.w;
            h16x4 o; o.x = (h16)v.x; o.y = (h16)v.y; o.z = (h16)v.z; o.w = (h16)v.w; *((h16x4*)(xh + (size_t)row * DM) + lane + 64 * j) = o; }
        ss = wave_sum(ss);
        if (lane < NPART) rowss[(size_t)row * NPART + lane] = (lane == 0) ? ss : 0.f;
    }
}

template <int EPI> __device__ __forceinline__ void gemm_phase(const Params& p, int layer, unsigned char* lds) {
    constexpr int K = DM, N = (EPI == 1) ? NIN : DM, nN = N / 128, nM = MROWS / 256, LDSTR = 40;
    const h16* A = (EPI == 1) ? (const h16*)(p.ws + WS_XH) : (const h16*)(p.ws + WS_MIX);
    const h16* Bt = (EPI == 1) ? (const h16*)(p.ws + WS_WIN) + (size_t)layer * NIN * DM : (const h16*)(p.ws + WS_WOUT) + (size_t)layer * DM * DM;
    h16* As = (h16*)lds; h16* Bs = As + 256 * LDSTR; float* ssq = (float*)(lds + 32768);
    const int tid = threadIdx.x, lane = tid & 63, wid = tid >> 6, wm = wid >> 1, wn = wid & 1, r = lane & 31, h = lane >> 5;
    float* rowss = (float*)(p.ws + WS_ROWSS);
    for (int tile = blockIdx.x; tile < nM * nN; tile += gridDim.x) {
        const int pm = tile / nN, pn = tile % nN;
        f32x16 acc[2][2];
#pragma unroll
        for (int a = 0; a < 2; ++a)
#pragma unroll
            for (int b = 0; b < 2; ++b)
#pragma unroll
                for (int i = 0; i < 16; ++i) acc[a][b][i] = 0.f;
        const h16* ga0 = A + (size_t)(pm * 256 + (tid >> 2)) * K + (tid & 3) * 8;
        const h16* ga1 = ga0 + (size_t)128 * K;
        const h16* gb = Bt + (size_t)(pn * 128 + (tid >> 2)) * K + (tid & 3) * 8;
        uint4 ra0 = *(const uint4*)ga0, ra1 = *(const uint4*)ga1, rb = *(const uint4*)gb;
        for (int kt = 0; kt < K / 32; ++kt) {
            __syncthreads();
            *(uint4*)(As + (tid >> 2) * LDSTR + (tid & 3) * 8) = ra0;
            *(uint4*)(As + (128 + (tid >> 2)) * LDSTR + (tid & 3) * 8) = ra1;
            *(uint4*)(Bs + (tid >> 2) * LDSTR + (tid & 3) * 8) = rb;
            __syncthreads();
            if (kt + 1 < K / 32) { ra0 = *(const uint4*)(ga0 + (kt + 1) * 32); ra1 = *(const uint4*)(ga1 + (kt + 1) * 32); rb = *(const uint4*)(gb + (kt + 1) * 32); }
#pragma unroll
            for (int s = 0; s < 2; ++s) {
                h16x8 af[2], bf[2];
#pragma unroll
                for (int mb = 0; mb < 2; ++mb) af[mb] = *(const h16x8*)(As + (wm * 64 + mb * 32 + r) * LDSTR + s * 16 + h * 8);
#pragma unroll
                for (int nb = 0; nb < 2; ++nb) bf[nb] = *(const h16x8*)(Bs + (wn * 64 + nb * 32 + r) * LDSTR + s * 16 + h * 8);
#pragma unroll
                for (int mb = 0; mb < 2; ++mb)
#pragma unroll
                    for (int nb = 0; nb < 2; ++nb) acc[mb][nb] = __builtin_amdgcn_mfma_f32_32x32x16_f16(af[mb], bf[nb], acc[mb][nb], 0, 0, 0);
            }
        }
        if (EPI == 1) {
            h16* proj = (h16*)(p.ws + WS_PROJ);
#pragma unroll
            for (int mb = 0; mb < 2; ++mb)
#pragma unroll
                for (int i = 0; i < 16; ++i) {
                    const int row = pm * 256 + wm * 64 + mb * 32 + crow(i, h);
                    const f32x4 s0 = *(const f32x4*)(rowss + (size_t)row * NPART), s1 = *(const f32x4*)(rowss + (size_t)row * NPART + 4);
                    const float rstd = rsqrtf(((s0.x + s0.y) + (s0.z + s0.w) + (s1.x + s1.y) + (s1.z + s1.w)) * (1.0f / DM) + 1e-6f);
#pragma unroll
                    for (int nb = 0; nb < 2; ++nb) proj[(size_t)row * NIN + pn * 128 + wn * 64 + nb * 32 + r] = (h16)(acc[mb][nb][i] * rstd);
                }
        } else {
            const float* xold = (layer == 0) ? p.x : p.out; h16* xh = (h16*)(p.ws + WS_XH);
#pragma unroll
            for (int mb = 0; mb < 2; ++mb)
#pragma unroll
                for (int i = 0; i < 16; ++i) {
                    const int rl = wm * 64 + mb * 32 + crow(i, h); const size_t row = (size_t)pm * 256 + rl;
                    float ss = 0.f;
#pragma unroll
                    for (int nb = 0; nb < 2; ++nb) { const int col = pn * 128 + wn * 64 + nb * 32 + r; const float v = xold[row * DM + col] + acc[mb][nb][i];
                        p.out[row * DM + col] = v; xh[row * DM + col] = (h16)v; ss += v * v; }
#pragma unroll
                    for (int o = 1; o < 32; o <<= 1) ss += __shfl_xor(ss, o);
                    if (r == 0) ssq[wn * 256 + rl] = ss;
                }
            __syncthreads();
            if (tid < 256) rowss[((size_t)pm * 256 + tid) * NPART + pn] = ssq[tid] + ssq[256 + tid];
        }
    }
}

__device__ __forceinline__ void phase_stats(const Params& p, unsigned char* lds) {
    const h16* proj = (const h16*)(p.ws + WS_PROJ); float* kmean = (float*)(p.ws + WS_KMEAN); float* kv = (float*)(p.ws + WS_KV);
    const int tid = threadIdx.x;
    float* ks = (float*)lds; float* vs = ks + 128 * 64;
    for (int u = blockIdx.x; u < 128 + 1024; u += gridDim.x) {
        if (u < 128) {
            const int b = u >> 4, n = u & 15; float s = 0.f;
            const h16* src = proj + (size_t)(b * SEQ + n * 256) * NIN + C_MK + tid;
            for (int rr = 0; rr < 256; ++rr) s += (float)src[(size_t)rr * NIN];
            kmean[((size_t)(b * 8 + (tid >> 6)) * 16 + n) * 64 + (tid & 63)] = s * (1.0f / 256.0f);
        } else {
            const int v = u - 128, b = v >> 7, hh = (v >> 5) & 3, n = v & 31;
            const float log_g = logf(1.0f - exp2f(-5.0f - (float)hh));
            __syncthreads();
#pragma unroll 2
            for (int i = 0; i < 16; ++i) { const int e = tid + i * 512, jj = e >> 6, d = e & 63; const size_t row = (size_t)(b * SEQ + n * 128 + jj);
                ks[e] = (float)proj[row * NIN + C_RK + hh * 64 + d] * 0.125f * expf(log_g * (float)(127 - jj));
                vs[e] = (float)proj[row * NIN + C_RV + hh * 64 + d]; }
            __syncthreads();
            const int d = tid >> 3, e0 = (tid & 7) * 8; float o[8];
#pragma unroll
            for (int i = 0; i < 8; ++i) o[i] = 0.f;
            for (int jj = 0; jj < 128; ++jj) { const float kk = ks[jj * 64 + d];
#pragma unroll
                for (int i = 0; i < 8; ++i) o[i] += kk * vs[jj * 64 + e0 + i]; }
            float* dst = kv + ((size_t)((b * 4 + hh) * 32 + n)) * 4096 + d * 64 + e0;
#pragma unroll
            for (int i = 0; i < 8; ++i) dst[i] = o[i];
        }
    }
}

__device__ __forceinline__ void conv_unit(const Params& p, int layer, int b, int tt, unsigned char* lds) {
    const h16* proj = (const h16*)(p.ws + WS_PROJ); h16* mix = (h16*)(p.ws + WS_MIX);
    float* us = (float*)lds; float* ys = us + 62 * 256;
    const int tid = threadIdx.x, c = tid & 255, th = tid >> 8, t0 = tt * 32, lane = tid & 63, wid = tid >> 6;
    __syncthreads();
    for (int rr = th; rr < 62; rr += 2) { const int t = t0 - 30 + rr; float u = 0.f;
        if (t >= 0) { const size_t row = (size_t)(b * SEQ + t); const float a = (float)proj[row * NIN + C_AVAL + c], g = (float)proj[row * NIN + C_AGLU + c]; u = a / (1.0f + __expf(-g)); }
        us[rr * 256 + c] = u; }
    __syncthreads();
    {
        float w[31];
#pragma unroll
        for (int jj = 0; jj < 31; ++jj) w[jj] = p.conv_w[((size_t)layer * 31 + jj) * 256 + c];
        const float cb = p.conv_b[layer * 256 + c];
#pragma unroll 1
        for (int tl = th * 16; tl < th * 16 + 16; ++tl) { float y = cb;
#pragma unroll
            for (int jj = 0; jj < 31; ++jj) y += w[jj] * us[(tl + jj) * 256 + c];
            ys[tl * 256 + c] = y; }
    }
    __syncthreads();
    {
        const f32x4 lg = *(const f32x4*)(p.ln_g + layer * 256 + lane * 4), lb = *(const f32x4*)(p.ln_b + layer * 256 + lane * 4);
        for (int k = 0; k < 4; ++k) { const int tl = wid * 4 + k; f32x4 v = *(const f32x4*)(ys + tl * 256 + lane * 4);
            const float mu = wave_sum((v.x + v.y) + (v.z + v.w)) * (1.0f / 256.0f);
            v = v - mu; const float var = wave_sum((v.x * v.x + v.y * v.y) + (v.z * v.z + v.w * v.w)) * (1.0f / 256.0f); const float rs = rsqrtf(var + 1e-5f);
            f32x4 o; o.x = silu_f(v.x * rs * lg.x + lb.x); o.y = silu_f(v.y * rs * lg.y + lb.y); o.z = silu_f(v.z * rs * lg.z + lb.z); o.w = silu_f(v.w * rs * lg.w + lb.w);
            *(f32x4*)(ys + tl * 256 + lane * 4) = o; }
    }
    __syncthreads();
    {
        float acc[16]; const float pb = p.pw_b[layer * 256 + c];
#pragma unroll
        for (int k = 0; k < 16; ++k) acc[k] = pb;
        const float* pw = p.pw_w + (size_t)layer * 65536 + c;
#pragma unroll 2
        for (int cc = 0; cc < 256; ++cc) { const float w = pw[(size_t)cc * 256];
#pragma unroll
            for (int k = 0; k < 16; ++k) acc[k] += ys[(th * 16 + k) * 256 + cc] * w; }
#pragma unroll
        for (int k = 0; k < 16; ++k) { const size_t row = (size_t)(b * SEQ + t0 + th * 16 + k);
            mix[row * DM + c] = (h16)(acc[k] * silu_f((float)proj[row * NIN + C_AGATE + c])); }
    }
}

__device__ __forceinline__ void ret_unit(const Params& p, int b, int hh, int n, unsigned char* lds) {
    const h16* proj = (const h16*)(p.ws + WS_PROJ); h16* mix = (h16*)(p.ws + WS_MIX); const float* kv = (const float*)(p.ws + WS_KV);
    float* Rs = (float*)lds; float* ks = Rs + 4096; float* vs = ks + 8192; float* qs = vs + 8192; float* dect = qs + 128 * 65; float* os = ks;
    const int tid = threadIdx.x, i = tid & 127, eg = tid >> 7;
    const float log_g = logf(1.0f - exp2f(-5.0f - (float)hh)); const float g_chunk = expf(log_g * 128.0f);
    __syncthreads();
    {
        const float* kvb = kv + ((size_t)(b * 4 + hh) * 32) * 4096;
#pragma unroll 1
        for (int k = 0; k < 8; ++k) { const int e = tid + k * 512; float rr = 0.f; for (int m = 0; m < n; ++m) rr = rr * g_chunk + kvb[(size_t)m * 4096 + e]; Rs[e] = rr; }
#pragma unroll 1
        for (int k = 0; k < 16; ++k) { const int e = tid + k * 512, jj = e >> 6, d = e & 63; const size_t row = (size_t)(b * SEQ + n * 128 + jj);
            ks[e] = (float)proj[row * NIN + C_RK + hh * 64 + d] * 0.125f; vs[e] = (float)proj[row * NIN + C_RV + hh * 64 + d];
            qs[jj * 65 + d] = (float)proj[row * NIN + C_RQ + hh * 64 + d]; }
        if (tid < 129) dect[tid] = expf(log_g * (float)tid);
    }
    const size_t rowi = (size_t)(b * SEQ + n * 128 + i);
    __syncthreads();
    float o[16];
#pragma unroll
    for (int e = 0; e < 16; ++e) o[e] = 0.f;
#pragma unroll 1
    for (int j = 0; j < 128; ++j) {
        if (j <= i) {
            float s = 0.f;
#pragma unroll 4
            for (int d = 0; d < 64; ++d) s += qs[i * 65 + d] * ks[j * 64 + d];
            s *= dect[i - j];
#pragma unroll
            for (int e = 0; e < 16; ++e) o[e] += s * vs[j * 64 + eg * 16 + e];
        }
    }
    {
        const float xi = dect[i + 1];
#pragma unroll 2
        for (int d = 0; d < 64; ++d) { const float qd = qs[i * 65 + d] * xi;
#pragma unroll
            for (int e = 0; e < 16; ++e) o[e] += qd * Rs[d * 64 + eg * 16 + e]; }
    }
    __syncthreads();
#pragma unroll
    for (int e = 0; e < 16; ++e) os[i * 65 + eg * 16 + e] = o[e];
    __syncthreads();
    float mu = 0.f;
#pragma unroll 4
    for (int e = 0; e < 64; ++e) mu += os[i * 65 + e];
    mu *= (1.0f / 64.0f);
    float var = 0.f;
#pragma unroll 4
    for (int e = 0; e < 64; ++e) { const float dlt = os[i * 65 + e] - mu; var += dlt * dlt; }
    const float rs = rsqrtf(var * (1.0f / 64.0f) + 1e-5f);
#pragma unroll
    for (int e = 0; e < 16; ++e) { const int col = hh * 64 + eg * 16 + e;
        mix[rowi * DM + 256 + col] = (h16)((o[e] - mu) * rs * silu_f((float)proj[rowi * NIN + C_RGATE + col])); }
}

typedef short s16x4 __attribute__((ext_vector_type(4)));
#define LAS __attribute__((address_space(3)))
__device__ __forceinline__ float xhalf_max(float v) { auto rr = __builtin_amdgcn_permlane32_swap(__float_as_uint(v), __float_as_uint(v), false, false); return fmaxf(__uint_as_float(rr[0]), __uint_as_float(rr[1])); }
__device__ __forceinline__ float xhalf_sum(float v) { auto rr = __builtin_amdgcn_permlane32_swap(__float_as_uint(v), __float_as_uint(v), false, false); return __uint_as_float(rr[0]) + __uint_as_float(rr[1]); }
__device__ __forceinline__ h16x8 tr_frag(const LAS unsigned char* a) {
    const s16x4 lo = __builtin_amdgcn_ds_read_tr16_b64_v4i16((LAS s16x4*)a), hi = __builtin_amdgcn_ds_read_tr16_b64_v4i16((LAS s16x4*)(a + 512));
    typedef short s16x8 __attribute__((ext_vector_type(8)));
    const s16x8 v = __builtin_shufflevector(lo, hi, 0, 1, 2, 3, 4, 5, 6, 7);
    return __builtin_bit_cast(h16x8, v);
}
#define CROW0(i) (((i) & 3) + 8 * ((i) >> 2))
constexpr float MOBA_THR = 8.0f;
__device__ __forceinline__ void moba_unit(const Params& p, int b, int hh, int j, unsigned char* lds_g) {
    LAS unsigned char* lds = (LAS unsigned char*)lds_g;
    const int tid = threadIdx.x, lane = tid & 63, wid = __builtin_amdgcn_readfirstlane(tid >> 6), r = lane & 31, hi = lane >> 5;
    const h16* projb = (const h16*)(p.ws + WS_PROJ) + (size_t)b * SEQ * NIN; h16* mix = (h16*)(p.ws + WS_MIX);
    const int qrow = j * 256 + wid * 32 + r;
    h16x8 qf[4];
#pragma unroll
    for (int s = 0; s < 4; ++s) qf[s] = *(const h16x8*)(projb + (size_t)qrow * NIN + C_MQ + hh * 64 + 16 * s + 8 * hi);
    unsigned selmask = 0u;
    if (j <= 3) selmask = (1u << j) - 1u;
    else {
        float g0 = -3.0e38f, g1 = -3.0e38f, g2 = -3.0e38f; int i0 = 0, i1 = 0, i2 = 0;
        const float* km = (const float*)(p.ws + WS_KMEAN) + ((size_t)(b * 8 + hh) * 16) * 64 + 8 * hi;
#pragma unroll 1
        for (int n = 0; n < j; ++n) { float s = 0.f;
#pragma unroll
            for (int ss = 0; ss < 4; ++ss) { const f32x4 k0 = *(const f32x4*)(km + n * 64 + 16 * ss), k1 = *(const f32x4*)(km + n * 64 + 16 * ss + 4);
                s += (float)qf[ss][0] * k0.x + (float)qf[ss][1] * k0.y + (float)qf[ss][2] * k0.z + (float)qf[ss][3] * k0.w
                   + (float)qf[ss][4] * k1.x + (float)qf[ss][5] * k1.y + (float)qf[ss][6] * k1.z + (float)qf[ss][7] * k1.w; }
            s = xhalf_sum(s);
            if (s > g0) { g2 = g1; i2 = i1; g1 = g0; i1 = i0; g0 = s; i0 = n; }
            else if (s > g1) { g2 = g1; i2 = i1; g1 = s; i1 = n; }
            else if (s > g2) { g2 = s; i2 = n; } }
        selmask = (1u << i0) | (1u << i1) | (1u << i2);
    }
    constexpr float C2 = 0.125f * 1.4426950408889634f;
#pragma unroll
    for (int s = 0; s < 4; ++s)
#pragma unroll
        for (int k = 0; k < 8; ++k) qf[s][k] = (h16)((float)qf[s][k] * C2);
    const float slope2 = exp2f(-(float)(hh + 1)) * 1.4426950408889634f;
    f32x16 o0, o1;
#pragma unroll
    for (int i = 0; i < 16; ++i) { o0[i] = 0.f; o1[i] = 0.f; }
    float mref = 0.f, lsum = 0.f; bool first = true;
    const int skey = tid >> 3, sch = tid & 7;
    const h16* gk = projb + (size_t)skey * NIN + C_MK + hh * 64 + sch * 8;
    const int wK = skey * 128 + ((sch ^ ((skey >> 1) & 7)) << 4);
    const int wV = 8192 + (sch >> 2) * 4096 + (skey >> 4) * 1024 + (skey & 15) * 64 + (sch & 3) * 16;
    const int rK = r * 128, rsw = (r >> 1) & 7;
    const int rV = 8192 + (4 * hi + ((lane & 15) >> 2)) * 64 + ((lane >> 4) & 1) * 32 + (lane & 3) * 8;
    const int nt = 4 * (j + 1);
    int kp = j * 256 + 192;
    u32x4 rk = *(const u32x4*)(gk + (size_t)kp * NIN), rv = *(const u32x4*)(gk + (size_t)kp * NIN + (C_MV - C_MK));
    __syncthreads();
    *(LAS u32x4*)(lds + wK) = rk; *(LAS u32x4*)(lds + wV) = rv;
    __syncthreads();
#pragma unroll 1
    for (int tt = 0; tt < nt; ++tt) {
        const LAS unsigned char* buf = lds + (tt & 1) * 16384;
        if (tt + 1 < nt) { rk = *(const u32x4*)(gk + (size_t)(kp - 64) * NIN); rv = *(const u32x4*)(gk + (size_t)(kp - 64) * NIN + (C_MV - C_MK)); }
        const int nblk = kp >> 8; const bool own = (nblk == j); const int tloc = (kp >> 6) & 3;
        bool valid = true, act, diag = false;
        if (own) { act = tloc <= (wid >> 1); diag = tloc == (wid >> 1); }
        else { valid = (selmask >> nblk) & 1u; act = __any(valid); }
        if (act) {
            const float tbh = valid ? (slope2 * (float)(kp - qrow + 4 * hi) - mref) : -INFINITY;
            f32x16 c0, c1;
#pragma unroll
            for (int i = 0; i < 16; ++i) { c0[i] = fmaf(slope2, (float)CROW0(i), tbh); c1[i] = fmaf(slope2, (float)(CROW0(i) + 32), tbh); }
            if (diag) { const int lim2 = 32 * wid - 64 * tloc + r - 4 * hi;
#pragma unroll
                for (int i = 0; i < 16; ++i) { if (CROW0(i) > lim2) c0[i] = -INFINITY; if (CROW0(i) + 32 > lim2) c1[i] = -INFINITY; } }
#pragma unroll
            for (int s = 0; s < 4; ++s) {
                const h16x8 k0 = *(const LAS h16x8*)(buf + rK + (((2 * s + hi) ^ rsw) << 4)), k1 = *(const LAS h16x8*)(buf + rK + 4096 + (((2 * s + hi) ^ rsw) << 4));
                c0 = __builtin_amdgcn_mfma_f32_32x32x16_f16(k0, qf[s], c0, 0, 0, 0);
                c1 = __builtin_amdgcn_mfma_f32_32x32x16_f16(k1, qf[s], c1, 0, 0, 0);
            }
            float rm = fmaxf(c0[0], c1[0]);
#pragma unroll
            for (int i = 1; i < 16; ++i) rm = fmaxf(rm, fmaxf(c0[i], c1[i]));
            rm = xhalf_max(rm);
            if (first) { first = false; mref = rm;
#pragma unroll
                for (int i = 0; i < 16; ++i) { c0[i] -= rm; c1[i] -= rm; } }
            else if (__any(rm > MOBA_THR)) { const float dl = fmaxf(rm, 0.f); mref += dl; const float f = __builtin_amdgcn_exp2f(-dl); lsum *= f;
#pragma unroll
                for (int i = 0; i < 16; ++i) { c0[i] -= dl; c1[i] -= dl; o0[i] *= f; o1[i] *= f; } }
            float ps = 0.f;
#pragma unroll
            for (int i = 0; i < 16; ++i) { c0[i] = __builtin_amdgcn_exp2f(c0[i]); c1[i] = __builtin_amdgcn_exp2f(c1[i]); ps += c0[i] + c1[i]; }
            lsum += ps;
            h16x8 pf[4];
#pragma unroll
            for (int k = 0; k < 8; ++k) { pf[0][k] = (h16)c0[k]; pf[1][k] = (h16)c0[8 + k]; pf[2][k] = (h16)c1[k]; pf[3][k] = (h16)c1[8 + k]; }
#pragma unroll
            for (int t = 0; t < 4; ++t) {
                const h16x8 v0 = tr_frag(buf + rV + t * 1024), v1 = tr_frag(buf + rV + 4096 + t * 1024);
                o0 = __builtin_amdgcn_mfma_f32_32x32x16_f16(v0, pf[t], o0, 0, 0, 0);
                o1 = __builtin_amdgcn_mfma_f32_32x32x16_f16(v1, pf[t], o1, 0, 0, 0);
            }
        }
        if (tt + 1 < nt) { LAS unsigned char* nb = lds + ((tt + 1) & 1) * 16384; *(LAS u32x4*)(nb + wK) = rk; *(LAS u32x4*)(nb + wV) = rv; }
        __syncthreads();
        kp -= 64;
    }
    {
        const float inv = 1.0f / xhalf_sum(lsum);
        const h16* gp = projb + (size_t)qrow * NIN + C_MGATE + hh * 64 + 4 * hi; h16* dst = mix + ((size_t)b * SEQ + qrow) * DM + 512 + hh * 64 + 4 * hi;
#pragma unroll
        for (int g = 0; g < 4; ++g) {
            const h16x4 ga = *(const h16x4*)(gp + 8 * g), gb = *(const h16x4*)(gp + 32 + 8 * g); h16x4 oa, ob;
#pragma unroll
            for (int k = 0; k < 4; ++k) { oa[k] = (h16)(o0[4 * g + k] * inv * silu_f((float)ga[k])); ob[k] = (h16)(o1[4 * g + k] * inv * silu_f((float)gb[k])); }
            *(h16x4*)(dst + 8 * g) = oa; *(h16x4*)(dst + 32 + 8 * g) = ob;
        }
    }
}

__device__ __forceinline__ void phase_mixers(const Params& p, int layer, unsigned char* lds) {
#pragma unroll 1
    for (int u = blockIdx.x; u < 1024; u += gridDim.x) { const int j = 15 - (u >> 6), bh = u & 63; moba_unit(p, bh >> 3, bh & 7, j, lds); }
#pragma unroll 1
    for (int v = blockIdx.x; v < 1024; v += gridDim.x) ret_unit(p, v >> 7, (v >> 5) & 3, v & 31, lds);
#pragma unroll 1
    for (int v = blockIdx.x; v < 1024; v += gridDim.x) conv_unit(p, layer, v >> 7, v & 127, lds);
}

__device__ __forceinline__ void phase_final(const Params& p) {
    const float* rowss = (const float*)(p.ws + WS_ROWSS);
    const int lane = threadIdx.x & 63, wid = threadIdx.x >> 6;
    f32x4 g[4];
#pragma unroll
    for (int j = 0; j < 4; ++j) g[j] = *((const f32x4*)p.final_g + lane + 64 * j);
    for (int row = blockIdx.x * 8 + wid; row < MROWS; row += gridDim.x * 8) {
        const f32x4 s0 = *(const f32x4*)(rowss + (size_t)row * NPART), s1 = *(const f32x4*)(rowss + (size_t)row * NPART + 4);
        const float rstd = rsqrtf(((s0.x + s0.y) + (s0.z + s0.w) + (s1.x + s1.y) + (s1.z + s1.w)) * (1.0f / DM) + 1e-6f);
        f32x4* xr = (f32x4*)(p.out + (size_t)row * DM) + lane;
#pragma unroll
        for (int j = 0; j < 4; ++j) { f32x4 v = xr[64 * j]; v = v * rstd * g[j]; xr[64 * j] = v; }
    }
}

__global__ void __launch_bounds__(NTHREADS) hymba_fwd(Params p) {
    extern __shared__ __attribute__((aligned(16))) unsigned char lds[];
    cg::grid_group grid = cg::this_grid();
#define RUN_PHASE(k, body) do { if (p.ph_lo <= (k) && (k) < p.ph_hi) { body; if ((k) + 1 < p.ph_hi) grid.sync(); } } while (0)
    RUN_PHASE(0, phase_prologue(p, lds));
    RUN_PHASE(1, gemm_phase<1>(p, 0, lds));
    RUN_PHASE(2, phase_stats(p, lds));
    RUN_PHASE(3, phase_mixers(p, 0, lds));
    RUN_PHASE(4, gemm_phase<2>(p, 0, lds));
    RUN_PHASE(5, gemm_phase<1>(p, 1, lds));
    RUN_PHASE(6, phase_stats(p, lds));
    RUN_PHASE(7, phase_mixers(p, 1, lds));
    RUN_PHASE(8, gemm_phase<2>(p, 1, lds));
    RUN_PHASE(9, phase_final(p));
#undef RUN_PHASE
}

extern "C" void kernel_launch(void* const* d_in, const int* in_sizes, int n_in, void* d_out, int out_size, void* d_ws, size_t ws_size, hipStream_t stream) {
    static int grid_blocks = 0;
    if (!grid_blocks) {
        int dev = 0, cus = 0, per_cu = 0;
        hipGetDevice(&dev);
        hipDeviceGetAttribute(&cus, hipDeviceAttributeMultiprocessorCount, dev);
        hipFuncSetAttribute((const void*)hymba_fwd, hipFuncAttributeMaxDynamicSharedMemorySize, LDS_BYTES);
        hipOccupancyMaxActiveBlocksPerMultiprocessor(&per_cu, (const void*)hymba_fwd, NTHREADS, LDS_BYTES);
        if (per_cu < 1) per_cu = 1;
        grid_blocks = cus * per_cu;
        if (ws_size < WS_END) fprintf(stderr, "kernel_launch: workspace too small (%zu < %zu)\n", ws_size, (size_t)WS_END);
    }
    Params p{};
    p.x = (const float*)d_in[0]; p.norm_g = (const float*)d_in[1]; p.w_in = (const float*)d_in[2]; p.conv_w = (const float*)d_in[3]; p.conv_b = (const float*)d_in[4];
    p.ln_g = (const float*)d_in[5]; p.ln_b = (const float*)d_in[6]; p.pw_w = (const float*)d_in[7]; p.pw_b = (const float*)d_in[8]; p.w_out = (const float*)d_in[9];
    p.final_g = (const float*)d_in[10]; p.out = (float*)d_out; p.ws = (unsigned char*)d_ws;
#if ONE_LAUNCH
    p.ph_lo = 0; p.ph_hi = NPHASES;
    { void* args[] = {&p};
      hipError_t e = hipLaunchCooperativeKernel((const void*)hymba_fwd, dim3(grid_blocks), dim3(NTHREADS), args, LDS_BYTES, stream);
      if (e != hipSuccess) fprintf(stderr, "cooperative launch failed: %s (grid %d)\n", hipGetErrorString(e), grid_blocks); }
#else
    for (int ph = 0; ph < NPHASES; ++ph) {
        p.ph_lo = ph; p.ph_hi = ph + 1; void* args[] = {&p};
        hipError_t e = hipLaunchCooperativeKernel((const void*)hymba_fwd, dim3(grid_blocks), dim3(NTHREADS), args, LDS_BYTES, stream);
        if (e != hipSuccess) { fprintf(stderr, "cooperative launch failed: %s (grid %d, phase %d)\n", hipGetErrorString(e), grid_blocks, ph); break; }
    }
#endif
}
```

```cpp
#include <hip/hip_runtime.h>
#include <hip/hip_cooperative_groups.h>
#include <cstdio>
#include <cstdint>
namespace cg = cooperative_groups;

#ifndef ONE_LAUNCH
#define ONE_LAUNCH 1
#endif

typedef _Float16 h16;
typedef _Float16 h16x8 __attribute__((ext_vector_type(8)));
typedef _Float16 h16x4 __attribute__((ext_vector_type(4)));
typedef float f32x16 __attribute__((ext_vector_type(16)));
typedef float f32x4 __attribute__((ext_vector_type(4)));
typedef unsigned u32x4 __attribute__((ext_vector_type(4)));

constexpr int BATCH = 8, SEQ = 4096, DM = 1024, MROWS = BATCH * SEQ, NIN = 3840, DEPTH = 2;
constexpr int C_AVAL = 0, C_AGLU = 256, C_AGATE = 512, C_RQ = 768, C_RK = 1024, C_RV = 1280, C_RGATE = 1536, C_MQ = 1792, C_MK = 2304, C_MV = 2816, C_MGATE = 3328;
constexpr int NPART = 16;
constexpr int NTHREADS = 512;
constexpr int LDS_BYTES = 147456;
constexpr int NPHASES = 10;

constexpr size_t MiB = 1u << 20;
constexpr size_t WS_XH = 0, WS_PROJ = 64 * MiB, WS_MIX = 304 * MiB, WS_WIN = 368 * MiB, WS_WOUT = 383 * MiB, WS_WPW = 387 * MiB,
                 WS_KV = 388 * MiB, WS_KMEAN = 404 * MiB, WS_ROWSS = 405 * MiB, WS_END = 408 * MiB;

struct Params {
    const float *x, *norm_g, *w_in, *conv_w, *conv_b, *ln_g, *ln_b, *pw_w, *pw_b, *w_out, *final_g;
    float* out; unsigned char* ws;
    int ph_lo, ph_hi;
};

__device__ __forceinline__ float silu_f(float v) { return v / (1.0f + __expf(-v)); }
__device__ __forceinline__ int crow(int r, int h) { return (r & 3) + 8 * (r >> 2) + 4 * h; }
__device__ __forceinline__ float wave_sum(float v) {
#pragma unroll
    for (int o = 1; o < 64; o <<= 1) v += __shfl_xor(v, o);
    return v;
}

__device__ __forceinline__ void transpose_unit(const float* W, int K, int N, h16* WT, const float* g, int k0, int n0, float* tile) {
    const int tid = threadIdx.x;
    __syncthreads();
#pragma unroll
    for (int i = 0; i < 8; ++i) { const int k = i * 8 + (tid >> 6), n = tid & 63; float v = W[(size_t)(k0 + k) * N + n0 + n]; if (g) v *= g[k0 + k]; tile[k * 65 + n] = v; }
    __syncthreads();
#pragma unroll
    for (int i = 0; i < 8; ++i) { const int n = i * 8 + (tid >> 6), k = tid & 63; WT[(size_t)(n0 + n) * K + k0 + k] = (h16)tile[k * 65 + n]; }
}

__device__ __forceinline__ void phase_prologue(const Params& p, unsigned char* lds) {
    float* tile = (float*)lds;
    h16* win = (h16*)(p.ws + WS_WIN); h16* wout = (h16*)(p.ws + WS_WOUT); h16* wpw = (h16*)(p.ws + WS_WPW);
    constexpr int U_IN = 16 * 60, U_OUT = 16 * 16, U_PW = 4 * 4, U_L = U_IN + U_OUT + U_PW;
    for (int u = blockIdx.x; u < DEPTH * U_L; u += gridDim.x) {
        const int layer = u / U_L; int r = u % U_L;
        if (r < U_IN) { transpose_unit(p.w_in + (size_t)layer * DM * NIN, DM, NIN, win + (size_t)layer * NIN * DM, p.norm_g + layer * DM, (r / 60) * 64, (r % 60) * 64, tile); continue; }
        r -= U_IN;
        if (r < U_OUT) { transpose_unit(p.w_out + (size_t)layer * DM * DM, DM, DM, wout + (size_t)layer * DM * DM, nullptr, (r / 16) * 64, (r % 16) * 64, tile); continue; }
        r -= U_OUT;
        transpose_unit(p.pw_w + (size_t)layer * 256 * 256, 256, 256, wpw + (size_t)layer * 256 * 256, nullptr, (r / 4) * 64, (r % 4) * 64, tile);
    }
    h16* xh = (h16*)(p.ws + WS_XH); float* rowss = (float*)(p.ws + WS_ROWSS);
    const int lane = threadIdx.x & 63, wid = threadIdx.x >> 6;
    for (int row = blockIdx.x * 8 + wid; row < MROWS; row += gridDim.x * 8) {
        const f32x4* xr = (const f32x4*)(p.x + (size_t)row * DM) + lane;
        float ss = 0.f;
#pragma unroll
        for (int j = 0; j < 4; ++j) { const f32x4 v = xr[64 * j]; ss += v.x * v.x + v.y * v.y + v.z * v.z + v.w * v.w;
            h16x4 o; o.x = (h16)v.x; o.y = (h16)v.y; o.z = (h16)v.z; o.w = (h16)v.w; *((h16x4*)(xh + (size_t)row * DM) + lane + 64 * j) = o; }
        ss = wave_sum(ss);
        if (lane < NPART) rowss[(size_t)row * NPART + lane] = (lane == 0) ? ss : 0.f;
    }
}

namespace pg8 {
#define PG8_LAS __attribute__((address_space(3)))
typedef _Float16 bf16_t;
typedef _Float16 bf16x8 __attribute__((ext_vector_type(8)));
typedef float f32x4 __attribute__((ext_vector_type(4)));
typedef unsigned u32x4 __attribute__((ext_vector_type(4)));
constexpr int BM = 256, BK = 64, HALF = 128, HTB = HALF * BK * 2  , STAGE_BYTES = 8 * HTB, NXCD = 8, WGM = 8;

__host__ __device__ __forceinline__ int lds_byte(int r, int c) { const int st = (r >> 4) * 2 + (c >> 5), rr = r & 15, cc = c & 31, ob = rr * 64 + cc * 2; return st * 1024 + (ob ^ (((ob >> 9) & 1) << 5)); }
__host__ __device__ __forceinline__ void stage_rc(int b, int& R, int& C) { const int st = b / 1024, sb = b % 1024, swz = sb ^ (((sb >> 9) & 1) << 5); R = (st >> 1) * 16 + swz / 64; C = (st & 1) * 32 + (swz % 64) / 2; }
__host__ __device__ __forceinline__ int perm32(int rho) { const int n = rho >> 4, i = rho & 15; return 8 * (i >> 2) + 4 * n + (i & 3); }

struct Unit { int pm, pn; };
struct Gemm { const bf16_t* A; const bf16_t* Bt; int M, N, K; };

struct StaticOrder {
    int nM, nN, nwg, G, c;
    __host__ __device__ void init(int M, int N, int G_, int c_) { nM = M / BM; nN = N / BM; nwg = nM * nN; G = G_; c = c_; }
    __host__ __device__ bool next(int i, Unit& u) const {
        const long L = (long)i * G + c; if (L >= nwg) return false;
        int wgid = (int)L; { const int q = nwg / NXCD, r = nwg % NXCD, xcd = wgid % NXCD, off = wgid / NXCD; wgid = (xcd < r ? xcd * (q + 1) : r * (q + 1) + (xcd - r) * q) + off; }
        const int nig = WGM * nN, gid = wgid / nig, fm = gid * WGM, gsz = (nM - fm) < WGM ? (nM - fm) : WGM;
        u.pm = fm + ((wgid % nig) % gsz); u.pn = (wgid % nig) / gsz; return true;
    }
    __device__ __forceinline__ void a_ready(const Unit&) const {}
    __device__ __forceinline__ void done(const Unit&) const {}
};

template <class Epi, class Sched, bool ALIGN_EPI = false, bool SP2 = false>
__device__ __forceinline__ void gemm_phase(PG8_LAS unsigned char* lds, const Gemm g, const Sched& S, const Epi& E) {
    const int tid = threadIdx.x, wid = __builtin_amdgcn_readfirstlane(tid >> 6), lane = tid & 63, wr = wid >> 2, wc = wid & 3, fr = lane & 15, fq = lane >> 4;
    const int K = g.K, nt = K / BK;
    unsigned voffA[2], voffB[2];
#pragma unroll
    for (int i = 0; i < 2; ++i) { int R, C; stage_rc(tid * 16 + i * 8192, R, C); const int Rb = Epi::PERM ? ((R & ~31) + perm32(R & 31)) : R;
        voffA[i] = (unsigned)(R * K + C) * 2u; voffB[i] = (unsigned)(Rb * K + C) * 2u; }
    const size_t kstep = (size_t)(BK * 2);
    const size_t hstep = (size_t)HALF * K * 2;
    const size_t tstep = 2 * hstep;
    const unsigned ldsw = (unsigned)wid * 1024u;
    const int aoff = lds_byte(wr * 64 + fr, fq * 8), boff = lds_byte(wc * 32 + fr, fq * 8);
#define PG8_SA(b, h) (((b) * 2 + (h)) * HTB)
#define PG8_SB(b, h) ((4 + (b) * 2 + (h)) * HTB)
#define PG8_STAGE(bufoff, gbase, voff) do { _Pragma("unroll") for (int _i = 0; _i < 2; ++_i) \
        __builtin_amdgcn_global_load_lds((const unsigned*)((const char*)(gbase) + (voff)[_i]), (PG8_LAS unsigned*)(lds + (bufoff) + ldsw + _i * 8192), 16, 0, 0); } while (0)
#define PG8_LDA(dst, b, h) do { _Pragma("unroll") for (int m = 0; m < 4; ++m) _Pragma("unroll") for (int k = 0; k < 2; ++k) dst[m][k] = *(const PG8_LAS bf16x8*)(lds + PG8_SA(b, h) + aoff + m * 2048 + k * 1024); } while (0)
#define PG8_LDB(dst, b, h) do { _Pragma("unroll") for (int n = 0; n < 2; ++n) _Pragma("unroll") for (int k = 0; k < 2; ++k) dst[n][k] = *(const PG8_LAS bf16x8*)(lds + PG8_SB(b, h) + boff + n * 2048 + k * 1024); } while (0)
#define PG8_MMA(ai, bj, At, Bt) do { __builtin_amdgcn_s_setprio(1); _Pragma("unroll") for (int m = 0; m < 4; ++m) _Pragma("unroll") for (int n = 0; n < 2; ++n) _Pragma("unroll") for (int k = 0; k < 2; ++k) \
        acc[ai][bj][m][n] = __builtin_amdgcn_mfma_f32_16x16x32_f16(Bt[n][k], At[m][k], acc[ai][bj][m][n], 0, 0, 0); __builtin_amdgcn_s_setprio(0); } while (0)
#define PG8_WAIT_V(n) asm volatile("s_waitcnt vmcnt(" #n ")" ::: "memory")
#define PG8_WAIT_L(n) asm volatile("s_waitcnt lgkmcnt(" #n ")" ::: "memory")
#define PG8_BAR __builtin_amdgcn_s_barrier()
#define PG8_SCHED __builtin_amdgcn_sched_barrier(0)
    Unit cur, nxt; int ui = 0;
    if (!S.next(0, cur)) return;
    f32x4 acc[2][2][4][2];
#pragma unroll
    for (int a = 0; a < 2; ++a)
#pragma unroll
        for (int b = 0; b < 2; ++b)
#pragma unroll
            for (int m = 0; m < 4; ++m)
#pragma unroll
                for (int n = 0; n < 2; ++n) acc[a][b][m][n] = (f32x4){0.f, 0.f, 0.f, 0.f};
    bf16x8 At[4][2], B0[2][2], B1[2][2];
    const char* cA = (const char*)g.A + (size_t)cur.pm * tstep; const char* cB = (const char*)g.Bt + (size_t)cur.pn * tstep;
    S.a_ready(cur);
    if constexpr (SP2) {
        PG8_STAGE(PG8_SB(0, 0), cB, voffB); PG8_STAGE(PG8_SB(0, 1), cB + hstep, voffB); PG8_STAGE(PG8_SA(0, 0), cA, voffA); PG8_STAGE(PG8_SA(0, 1), cA + hstep, voffA);
        if (wr == 1) PG8_BAR;
        PG8_WAIT_V(2); PG8_BAR;
        PG8_STAGE(PG8_SB(1, 0), cB + kstep, voffB); PG8_STAGE(PG8_SA(1, 0), cA + kstep, voffA); PG8_STAGE(PG8_SB(1, 1), cB + hstep + kstep, voffB);
        PG8_WAIT_V(6); PG8_BAR;
    } else {
        PG8_STAGE(PG8_SB(0, 0), cB, voffB); PG8_STAGE(PG8_SA(0, 0), cA, voffA); PG8_STAGE(PG8_SB(0, 1), cB + hstep, voffB); PG8_STAGE(PG8_SA(0, 1), cA + hstep, voffA);
        if (wr == 1) PG8_BAR;
        PG8_WAIT_V(4); PG8_BAR;
        PG8_STAGE(PG8_SB(1, 0), cB + kstep, voffB); PG8_STAGE(PG8_SA(1, 0), cA + kstep, voffA); PG8_STAGE(PG8_SB(1, 1), cB + hstep + kstep, voffB);
        PG8_WAIT_V(6); PG8_BAR;
    }
    for (;;) {
        const bool has_next = S.next(ui + 1, nxt);
        const char* nA = has_next ? (const char*)g.A + (size_t)nxt.pm * tstep : cA; const char* nB = has_next ? (const char*)g.Bt + (size_t)nxt.pn * tstep : cB;
        for (int t = 0; t < nt; t += 2) {
            const bool last = (t == nt - 2);
            const char* a1 = cA + (size_t)(t + 1) * kstep;
            const char* a2 = last ? nA : cA + (size_t)(t + 2) * kstep; const char* b2 = last ? nB : cB + (size_t)(t + 2) * kstep;
            const char* a3 = a2 + kstep; const char* b3 = b2 + kstep;
            if (last && has_next) S.a_ready(nxt);
            if constexpr (SP2) {
            PG8_LDB(B0, 0, 0); PG8_LDB(B1, 0, 1); PG8_SCHED; PG8_LDA(At, 0, 0); PG8_STAGE(PG8_SA(1, 1), a1 + hstep, voffA);
            PG8_WAIT_V(8); PG8_WAIT_L(0); PG8_BAR; PG8_MMA(0, 0, At, B0); PG8_MMA(0, 1, At, B1); PG8_BAR; PG8_SCHED;
            PG8_LDA(At, 0, 1); PG8_STAGE(PG8_SB(0, 0), b2, voffB); PG8_STAGE(PG8_SB(0, 1), b2 + hstep, voffB); PG8_STAGE(PG8_SA(0, 0), a2, voffA);
            PG8_WAIT_V(8); PG8_WAIT_L(0); PG8_BAR; PG8_MMA(1, 0, At, B0); PG8_MMA(1, 1, At, B1); PG8_BAR; PG8_SCHED;
            PG8_LDB(B0, 1, 0); PG8_LDB(B1, 1, 1); PG8_SCHED; PG8_LDA(At, 1, 0); PG8_STAGE(PG8_SA(0, 1), a2 + hstep, voffA);
            PG8_WAIT_V(8); PG8_WAIT_L(0); PG8_BAR; PG8_MMA(0, 0, At, B0); PG8_MMA(0, 1, At, B1); PG8_BAR; PG8_SCHED;
            PG8_LDA(At, 1, 1); PG8_STAGE(PG8_SB(1, 0), b3, voffB); PG8_STAGE(PG8_SB(1, 1), b3 + hstep, voffB); PG8_STAGE(PG8_SA(1, 0), a3, voffA);
            PG8_WAIT_V(8); PG8_WAIT_L(0); PG8_BAR; PG8_MMA(1, 0, At, B0); PG8_MMA(1, 1, At, B1); PG8_BAR; PG8_SCHED;
            } else {
            PG8_LDB(B0, 0, 0); PG8_SCHED; PG8_LDA(At, 0, 0); PG8_STAGE(PG8_SA(1, 1), a1 + hstep, voffA);
            PG8_WAIT_L(8); PG8_BAR; PG8_WAIT_L(0); PG8_MMA(0, 0, At, B0); PG8_BAR; PG8_SCHED;
            PG8_LDB(B1, 0, 1); PG8_STAGE(PG8_SB(0, 0), b2, voffB);
            PG8_BAR; PG8_WAIT_L(0); PG8_MMA(0, 1, At, B1); PG8_BAR;
            PG8_LDA(At, 0, 1); PG8_STAGE(PG8_SA(0, 0), a2, voffA);
            PG8_BAR; PG8_WAIT_L(0); PG8_MMA(1, 0, At, B0); PG8_BAR; PG8_SCHED;
            PG8_STAGE(PG8_SB(0, 1), b2 + hstep, voffB);
            PG8_WAIT_V(6); PG8_BAR; PG8_MMA(1, 1, At, B1); PG8_BAR;
            PG8_LDB(B0, 1, 0); PG8_SCHED; PG8_LDA(At, 1, 0); PG8_STAGE(PG8_SA(0, 1), a2 + hstep, voffA);
            PG8_WAIT_L(8); PG8_BAR; PG8_WAIT_L(0); PG8_MMA(0, 0, At, B0); PG8_BAR; PG8_SCHED;
            PG8_LDB(B1, 1, 1); PG8_STAGE(PG8_SB(1, 0), b3, voffB);
            PG8_BAR; PG8_WAIT_L(0); PG8_MMA(0, 1, At, B1); PG8_BAR;
            PG8_LDA(At, 1, 1); PG8_STAGE(PG8_SA(1, 0), a3, voffA);
            PG8_BAR; PG8_WAIT_L(0); PG8_MMA(1, 0, At, B0); PG8_BAR; PG8_SCHED;
            PG8_STAGE(PG8_SB(1, 1), b3 + hstep, voffB);
            PG8_WAIT_V(6); PG8_BAR; PG8_MMA(1, 1, At, B1); PG8_BAR;
            }
        }
        if constexpr (ALIGN_EPI) { if (wr == 0) PG8_BAR; }
        if constexpr (!Epi::AFTER_DRAIN) { E(acc, cur, wr, wc, fr, fq); S.done(cur); }
        if (!has_next) break;
#pragma unroll
        for (int a = 0; a < 2; ++a)
#pragma unroll
            for (int b = 0; b < 2; ++b)
#pragma unroll
                for (int m = 0; m < 4; ++m)
#pragma unroll
                    for (int n = 0; n < 2; ++n) acc[a][b][m][n] = (f32x4){0.f, 0.f, 0.f, 0.f};
        cur = nxt; cA = nA; cB = nB; ++ui;
        if constexpr (ALIGN_EPI) { if (wr == 1) PG8_BAR; }
    }
    PG8_WAIT_V(0);
    if constexpr (!ALIGN_EPI) { if (wr == 0) PG8_BAR; }
    PG8_BAR;
    if constexpr (Epi::AFTER_DRAIN) { E.fused(acc, cur, wr, wc, fr, fq, lds, wid, lane); S.done(cur); }
#undef PG8_SA
#undef PG8_SB
#undef PG8_STAGE
#undef PG8_LDA
#undef PG8_LDB
#undef PG8_MMA
#undef PG8_WAIT_V
#undef PG8_WAIT_L
#undef PG8_BAR
#undef PG8_SCHED
}

struct EpiProj {
    static constexpr bool PERM = true, AFTER_DRAIN = false;
    bf16_t* O; const float* rowss;
    __device__ __forceinline__ void operator()(const f32x4 (&acc)[2][2][4][2], const Unit& u, int wr, int wc, int fr, int fq) const {
        const int row0 = u.pm * BM + wr * 64 + fr, col0 = u.pn * BM + wc * 32 + 8 * fq;
#pragma unroll
        for (int ai = 0; ai < 2; ++ai)
#pragma unroll
            for (int m = 0; m < 4; ++m) { const size_t row = (size_t)(row0 + ai * HALF + m * 16);
                const f32x4* rs = (const f32x4*)(rowss + row * 16); const f32x4 s0 = rs[0], s1 = rs[1], s2 = rs[2], s3 = rs[3];
                const float tot = ((s0[0] + s0[1]) + (s0[2] + s0[3])) + ((s1[0] + s1[1]) + (s1[2] + s1[3])) + ((s2[0] + s2[1]) + (s2[2] + s2[3])) + ((s3[0] + s3[1]) + (s3[2] + s3[3]));
                const float rstd = rsqrtf(tot * (1.0f / 1024.0f) + 1e-6f);
                bf16_t* rowp = O + row * 3840 + col0;
#pragma unroll
                for (int bj = 0; bj < 2; ++bj) { const f32x4 v0 = acc[ai][bj][m][0] * rstd, v1 = acc[ai][bj][m][1] * rstd; bf16x8 w;
                    w[0] = (bf16_t)v0[0]; w[1] = (bf16_t)v0[1]; w[2] = (bf16_t)v0[2]; w[3] = (bf16_t)v0[3]; w[4] = (bf16_t)v1[0]; w[5] = (bf16_t)v1[1]; w[6] = (bf16_t)v1[2]; w[7] = (bf16_t)v1[3];
                    *(bf16x8*)(rowp + bj * HALF) = w; } }
    }
};
struct EpiRes {
    static constexpr bool PERM = true, AFTER_DRAIN = false;
    const float* xold; float* xnew; bf16_t* xh; float* rowss;
    __device__ __forceinline__ void operator()(const f32x4 (&acc)[2][2][4][2], const Unit& u, int wr, int wc, int fr, int fq) const {
        const int row0 = u.pm * BM + wr * 64 + fr, col0 = u.pn * BM + wc * 32 + 8 * fq;
#pragma unroll
        for (int ai = 0; ai < 2; ++ai)
#pragma unroll
            for (int m = 0; m < 4; ++m) { const size_t row = (size_t)(row0 + ai * HALF + m * 16); float ss = 0.f;
#pragma unroll
                for (int bj = 0; bj < 2; ++bj) { const size_t off = row * 1024 + col0 + bj * HALF;
                    const f32x4 v0 = *(const f32x4*)(xold + off) + acc[ai][bj][m][0], v1 = *(const f32x4*)(xold + off + 4) + acc[ai][bj][m][1];
                    *(f32x4*)(xnew + off) = v0; *(f32x4*)(xnew + off + 4) = v1; bf16x8 w;
                    w[0] = (bf16_t)v0[0]; w[1] = (bf16_t)v0[1]; w[2] = (bf16_t)v0[2]; w[3] = (bf16_t)v0[3]; w[4] = (bf16_t)v1[0]; w[5] = (bf16_t)v1[1]; w[6] = (bf16_t)v1[2]; w[7] = (bf16_t)v1[3];
                    *(bf16x8*)(xh + off) = w;
                    ss += ((v0[0] * v0[0] + v0[1] * v0[1]) + (v0[2] * v0[2] + v0[3] * v0[3])) + ((v1[0] * v1[0] + v1[1] * v1[1]) + (v1[2] * v1[2] + v1[3] * v1[3])); }
                ss += __shfl_xor(ss, 16); ss += __shfl_xor(ss, 32);
                if (fq == 0) rowss[row * 16 + u.pn * 4 + wc] = ss; }
    }
};
}


__device__ __forceinline__ void gemm_in(const Params& p, int layer, unsigned char* lds) {
    pg8::Gemm g{(const h16*)(p.ws + WS_XH), (const h16*)(p.ws + WS_WIN) + (size_t)layer * NIN * DM, MROWS, NIN, DM};
    pg8::StaticOrder S; S.init(MROWS, NIN, (int)gridDim.x, (int)blockIdx.x);
    pg8::EpiProj E{(h16*)(p.ws + WS_PROJ), (const float*)(p.ws + WS_ROWSS)};
    pg8::gemm_phase<pg8::EpiProj, pg8::StaticOrder, true, true>((PG8_LAS unsigned char*)lds, g, S, E);
}
__device__ __forceinline__ void gemm_out(const Params& p, int layer, unsigned char* lds) {
    pg8::Gemm g{(const h16*)(p.ws + WS_MIX), (const h16*)(p.ws + WS_WOUT) + (size_t)layer * DM * DM, MROWS, DM, DM};
    pg8::StaticOrder S; S.init(MROWS, DM, (int)gridDim.x, (int)blockIdx.x);
    pg8::EpiRes E{(layer == 0) ? p.x : p.out, p.out, (h16*)(p.ws + WS_XH), (float*)(p.ws + WS_ROWSS)};
    pg8::gemm_phase<pg8::EpiRes, pg8::StaticOrder, true, true>((PG8_LAS unsigned char*)lds, g, S, E);
}

__device__ __forceinline__ void phase_stats(const Params& p, unsigned char* lds) {
    const h16* proj = (const h16*)(p.ws + WS_PROJ); float* kmean = (float*)(p.ws + WS_KMEAN); float* kv = (float*)(p.ws + WS_KV);
    const int tid = threadIdx.x;
    float* ks = (float*)lds; float* vs = ks + 128 * 64;
    for (int u = blockIdx.x; u < 128 + 1024; u += gridDim.x) {
        if (u < 128) {
            const int b = u >> 4, n = u & 15; float s = 0.f;
            const h16* src = proj + (size_t)(b * SEQ + n * 256) * NIN + C_MK + tid;
            for (int rr = 0; rr < 256; ++rr) s += (float)src[(size_t)rr * NIN];
            kmean[((size_t)(b * 8 + (tid >> 6)) * 16 + n) * 64 + (tid & 63)] = s * (1.0f / 256.0f);
        } else {
            const int v = u - 128, b = v >> 7, hh = (v >> 5) & 3, n = v & 31;
            const float log_g = logf(1.0f - exp2f(-5.0f - (float)hh));
            __syncthreads();
#pragma unroll 2
            for (int i = 0; i < 16; ++i) { const int e = tid + i * 512, jj = e >> 6, d = e & 63; const size_t row = (size_t)(b * SEQ + n * 128 + jj);
                ks[e] = (float)proj[row * NIN + C_RK + hh * 64 + d] * 0.125f * expf(log_g * (float)(127 - jj));
                vs[e] = (float)proj[row * NIN + C_RV + hh * 64 + d]; }
            __syncthreads();
            const int d = tid >> 3, e0 = (tid & 7) * 8; float o[8];
#pragma unroll
            for (int i = 0; i < 8; ++i) o[i] = 0.f;
            for (int jj = 0; jj < 128; ++jj) { const float kk = ks[jj * 64 + d];
#pragma unroll
                for (int i = 0; i < 8; ++i) o[i] += kk * vs[jj * 64 + e0 + i]; }
            float* dst = kv + ((size_t)((b * 4 + hh) * 32 + n)) * 4096 + d * 64 + e0;
#pragma unroll
            for (int i = 0; i < 8; ++i) dst[i] = o[i];
        }
    }
}

__device__ __forceinline__ void conv_unit(const Params& p, int layer, int b, int tt, unsigned char* lds) {
    const h16* proj = (const h16*)(p.ws + WS_PROJ); h16* mix = (h16*)(p.ws + WS_MIX);
    float* us = (float*)lds; float* ys = us + 62 * 256;
    const int tid = threadIdx.x, c = tid & 255, th = tid >> 8, t0 = tt * 32, lane = tid & 63, wid = tid >> 6;
    __syncthreads();
    for (int rr = th; rr < 62; rr += 2) { const int t = t0 - 30 + rr; float u = 0.f;
        if (t >= 0) { const size_t row = (size_t)(b * SEQ + t); const float a = (float)proj[row * NIN + C_AVAL + c], g = (float)proj[row * NIN + C_AGLU + c]; u = a / (1.0f + __expf(-g)); }
        us[rr * 256 + c] = u; }
    __syncthreads();
    {
        float w[31];
#pragma unroll
        for (int jj = 0; jj < 31; ++jj) w[jj] = p.conv_w[((size_t)layer * 31 + jj) * 256 + c];
        const float cb = p.conv_b[layer * 256 + c];
#pragma unroll 1
        for (int tl = th * 16; tl < th * 16 + 16; ++tl) { float y = cb;
#pragma unroll
            for (int jj = 0; jj < 31; ++jj) y += w[jj] * us[(tl + jj) * 256 + c];
            ys[tl * 256 + c] = y; }
    }
    __syncthreads();
    {
        const f32x4 lg = *(const f32x4*)(p.ln_g + layer * 256 + lane * 4), lb = *(const f32x4*)(p.ln_b + layer * 256 + lane * 4);
        for (int k = 0; k < 4; ++k) { const int tl = wid * 4 + k; f32x4 v = *(const f32x4*)(ys + tl * 256 + lane * 4);
            const float mu = wave_sum((v.x + v.y) + (v.z + v.w)) * (1.0f / 256.0f);
            v = v - mu; const float var = wave_sum((v.x * v.x + v.y * v.y) + (v.z * v.z + v.w * v.w)) * (1.0f / 256.0f); const float rs = rsqrtf(var + 1e-5f);
            f32x4 o; o.x = silu_f(v.x * rs * lg.x + lb.x); o.y = silu_f(v.y * rs * lg.y + lb.y); o.z = silu_f(v.z * rs * lg.z + lb.z); o.w = silu_f(v.w * rs * lg.w + lb.w);
            *(f32x4*)(ys + tl * 256 + lane * 4) = o; }
    }
    __syncthreads();
    {
        float acc[16]; const float pb = p.pw_b[layer * 256 + c];
#pragma unroll
        for (int k = 0; k < 16; ++k) acc[k] = pb;
        const float* pw = p.pw_w + (size_t)layer * 65536 + c;
#pragma unroll 2
        for (int cc = 0; cc < 256; ++cc) { const float w = pw[(size_t)cc * 256];
#pragma unroll
            for (int k = 0; k < 16; ++k) acc[k] += ys[(th * 16 + k) * 256 + cc] * w; }
#pragma unroll
        for (int k = 0; k < 16; ++k) { const size_t row = (size_t)(b * SEQ + t0 + th * 16 + k);
            mix[row * DM + c] = (h16)(acc[k] * silu_f((float)proj[row * NIN + C_AGATE + c])); }
    }
}

__device__ __forceinline__ void ret_unit(const Params& p, int b, int hh, int n, unsigned char* lds) {
    const h16* proj = (const h16*)(p.ws + WS_PROJ); h16* mix = (h16*)(p.ws + WS_MIX); const float* kv = (const float*)(p.ws + WS_KV);
    float* Rs = (float*)lds; float* ks = Rs + 4096; float* vs = ks + 8192; float* qs = vs + 8192; float* dect = qs + 128 * 65; float* os = ks;
    const int tid = threadIdx.x, i = tid & 127, eg = tid >> 7;
    const float log_g = logf(1.0f - exp2f(-5.0f - (float)hh)); const float g_chunk = expf(log_g * 128.0f);
    __syncthreads();
    {
        const float* kvb = kv + ((size_t)(b * 4 + hh) * 32) * 4096;
#pragma unroll 1
        for (int k = 0; k < 8; ++k) { const int e = tid + k * 512; float rr = 0.f; for (int m = 0; m < n; ++m) rr = rr * g_chunk + kvb[(size_t)m * 4096 + e]; Rs[e] = rr; }
#pragma unroll 1
        for (int k = 0; k < 16; ++k) { const int e = tid + k * 512, jj = e >> 6, d = e & 63; const size_t row = (size_t)(b * SEQ + n * 128 + jj);
            ks[e] = (float)proj[row * NIN + C_RK + hh * 64 + d] * 0.125f; vs[e] = (float)proj[row * NIN + C_RV + hh * 64 + d];
            qs[jj * 65 + d] = (float)proj[row * NIN + C_RQ + hh * 64 + d]; }
        if (tid < 129) dect[tid] = expf(log_g * (float)tid);
    }
    const size_t rowi = (size_t)(b * SEQ + n * 128 + i);
    __syncthreads();
    float o[16];
#pragma unroll
    for (int e = 0; e < 16; ++e) o[e] = 0.f;
#pragma unroll 1
    for (int j = 0; j < 128; ++j) {
        if (j <= i) {
            float s = 0.f;
#pragma unroll 4
            for (int d = 0; d < 64; ++d) s += qs[i * 65 + d] * ks[j * 64 + d];
            s *= dect[i - j];
#pragma unroll
            for (int e = 0; e < 16; ++e) o[e] += s * vs[j * 64 + eg * 16 + e];
        }
    }
    {
        const float xi = dect[i + 1];
#pragma unroll 2
        for (int d = 0; d < 64; ++d) { const float qd = qs[i * 65 + d] * xi;
#pragma unroll
            for (int e = 0; e < 16; ++e) o[e] += qd * Rs[d * 64 + eg * 16 + e]; }
    }
    __syncthreads();
#pragma unroll
    for (int e = 0; e < 16; ++e) os[i * 65 + eg * 16 + e] = o[e];
    __syncthreads();
    float mu = 0.f;
#pragma unroll 4
    for (int e = 0; e < 64; ++e) mu += os[i * 65 + e];
    mu *= (1.0f / 64.0f);
    float var = 0.f;
#pragma unroll 4
    for (int e = 0; e < 64; ++e) { const float dlt = os[i * 65 + e] - mu; var += dlt * dlt; }
    const float rs = rsqrtf(var * (1.0f / 64.0f) + 1e-5f);
#pragma unroll
    for (int e = 0; e < 16; ++e) { const int col = hh * 64 + eg * 16 + e;
        mix[rowi * DM + 256 + col] = (h16)((o[e] - mu) * rs * silu_f((float)proj[rowi * NIN + C_RGATE + col])); }
}

typedef short s16x4 __attribute__((ext_vector_type(4)));
#define LAS __attribute__((address_space(3)))
__device__ __forceinline__ float xhalf_max(float v) { auto rr = __builtin_amdgcn_permlane32_swap(__float_as_uint(v), __float_as_uint(v), false, false); return fmaxf(__uint_as_float(rr[0]), __uint_as_float(rr[1])); }
__device__ __forceinline__ float xhalf_sum(float v) { auto rr = __builtin_amdgcn_permlane32_swap(__float_as_uint(v), __float_as_uint(v), false, false); return __uint_as_float(rr[0]) + __uint_as_float(rr[1]); }
__device__ __forceinline__ h16x8 tr_frag(const LAS unsigned char* a) {
    const s16x4 lo = __builtin_amdgcn_ds_read_tr16_b64_v4i16((LAS s16x4*)a), hi = __builtin_amdgcn_ds_read_tr16_b64_v4i16((LAS s16x4*)(a + 512));
    typedef short s16x8 __attribute__((ext_vector_type(8)));
    const s16x8 v = __builtin_shufflevector(lo, hi, 0, 1, 2, 3, 4, 5, 6, 7);
    return __builtin_bit_cast(h16x8, v);
}
#define CROW0(i) (((i) & 3) + 8 * ((i) >> 2))
constexpr float MOBA_THR = 8.0f;
__device__ __forceinline__ void moba_unit(const Params& p, int b, int hh, int j, unsigned char* lds_g) {
    LAS unsigned char* lds = (LAS unsigned char*)lds_g;
    const int tid = threadIdx.x, lane = tid & 63, wid = __builtin_amdgcn_readfirstlane(tid >> 6), r = lane & 31, hi = lane >> 5;
    const h16* projb = (const h16*)(p.ws + WS_PROJ) + (size_t)b * SEQ * NIN; h16* mix = (h16*)(p.ws + WS_MIX);
    const int qrow = j * 256 + wid * 32 + r;
    h16x8 qf[4];
#pragma unroll
    for (int s = 0; s < 4; ++s) qf[s] = *(const h16x8*)(projb + (size_t)qrow * NIN + C_MQ + hh * 64 + 16 * s + 8 * hi);
    unsigned selmask = 0u;
    if (j <= 3) selmask = (1u << j) - 1u;
    else {
        float g0 = -3.0e38f, g1 = -3.0e38f, g2 = -3.0e38f; int i0 = 0, i1 = 0, i2 = 0;
        const float* km = (const float*)(p.ws + WS_KMEAN) + ((size_t)(b * 8 + hh) * 16) * 64 + 8 * hi;
#pragma unroll 1
        for (int n = 0; n < j; ++n) { float s = 0.f;
#pragma unroll
            for (int ss = 0; ss < 4; ++ss) { const f32x4 k0 = *(const f32x4*)(km + n * 64 + 16 * ss), k1 = *(const f32x4*)(km + n * 64 + 16 * ss + 4);
                s += (float)qf[ss][0] * k0.x + (float)qf[ss][1] * k0.y + (float)qf[ss][2] * k0.z + (float)qf[ss][3] * k0.w
                   + (float)qf[ss][4] * k1.x + (float)qf[ss][5] * k1.y + (float)qf[ss][6] * k1.z + (float)qf[ss][7] * k1.w; }
            s = xhalf_sum(s);
            if (s > g0) { g2 = g1; i2 = i1; g1 = g0; i1 = i0; g0 = s; i0 = n; }
            else if (s > g1) { g2 = g1; i2 = i1; g1 = s; i1 = n; }
            else if (s > g2) { g2 = s; i2 = n; } }
        selmask = (1u << i0) | (1u << i1) | (1u << i2);
    }
    constexpr float C2 = 0.125f * 1.4426950408889634f;
#pragma unroll
    for (int s = 0; s < 4; ++s)
#pragma unroll
        for (int k = 0; k < 8; ++k) qf[s][k] = (h16)((float)qf[s][k] * C2);
    const float slope2 = exp2f(-(float)(hh + 1)) * 1.4426950408889634f;
    f32x16 o0, o1;
#pragma unroll
    for (int i = 0; i < 16; ++i) { o0[i] = 0.f; o1[i] = 0.f; }
    float mref = 0.f, lsum = 0.f; bool first = true;
    const int skey = tid >> 3, sch = tid & 7;
    const h16* gk = projb + (size_t)skey * NIN + C_MK + hh * 64 + sch * 8;
    const int wK = skey * 128 + ((sch ^ ((skey >> 1) & 7)) << 4);
    const int wV = 8192 + (sch >> 2) * 4096 + (skey >> 4) * 1024 + (skey & 15) * 64 + (sch & 3) * 16;
    const int rK = r * 128, rsw = (r >> 1) & 7;
    const int rV = 8192 + (4 * hi + ((lane & 15) >> 2)) * 64 + ((lane >> 4) & 1) * 32 + (lane & 3) * 8;
    const int nt = 4 * (j + 1);
    int kp = j * 256 + 192;
    u32x4 rk = *(const u32x4*)(gk + (size_t)kp * NIN), rv = *(const u32x4*)(gk + (size_t)kp * NIN + (C_MV - C_MK));
    __syncthreads();
    *(LAS u32x4*)(lds + wK) = rk; *(LAS u32x4*)(lds + wV) = rv;
    __syncthreads();
#pragma unroll 1
    for (int tt = 0; tt < nt; ++tt) {
        const LAS unsigned char* buf = lds + (tt & 1) * 16384;
        if (tt + 1 < nt) { rk = *(const u32x4*)(gk + (size_t)(kp - 64) * NIN); rv = *(const u32x4*)(gk + (size_t)(kp - 64) * NIN + (C_MV - C_MK)); }
        const int nblk = kp >> 8; const bool own = (nblk == j); const int tloc = (kp >> 6) & 3;
        bool valid = true, act, diag = false;
        if (own) { act = tloc <= (wid >> 1); diag = tloc == (wid >> 1); }
        else { valid = (selmask >> nblk) & 1u; act = __any(valid); }
        if (act) {
            const float tbh = valid ? (slope2 * (float)(kp - qrow + 4 * hi) - mref) : -INFINITY;
            f32x16 c0, c1;
#pragma unroll
            for (int i = 0; i < 16; ++i) { c0[i] = fmaf(slope2, (float)CROW0(i), tbh); c1[i] = fmaf(slope2, (float)(CROW0(i) + 32), tbh); }
            if (diag) { const int lim2 = 32 * wid - 64 * tloc + r - 4 * hi;
#pragma unroll
                for (int i = 0; i < 16; ++i) { if (CROW0(i) > lim2) c0[i] = -INFINITY; if (CROW0(i) + 32 > lim2) c1[i] = -INFINITY; } }
#pragma unroll
            for (int s = 0; s < 4; ++s) {
                const h16x8 k0 = *(const LAS h16x8*)(buf + rK + (((2 * s + hi) ^ rsw) << 4)), k1 = *(const LAS h16x8*)(buf + rK + 4096 + (((2 * s + hi) ^ rsw) << 4));
                c0 = __builtin_amdgcn_mfma_f32_32x32x16_f16(k0, qf[s], c0, 0, 0, 0);
                c1 = __builtin_amdgcn_mfma_f32_32x32x16_f16(k1, qf[s], c1, 0, 0, 0);
            }
            float rm = fmaxf(c0[0], c1[0]);
#pragma unroll
            for (int i = 1; i < 16; ++i) rm = fmaxf(rm, fmaxf(c0[i], c1[i]));
            rm = xhalf_max(rm);
            if (first) { first = false; mref = rm;
#pragma unroll
                for (int i = 0; i < 16; ++i) { c0[i] -= rm; c1[i] -= rm; } }
            else if (__any(rm > MOBA_THR)) { const float dl = fmaxf(rm, 0.f); mref += dl; const float f = __builtin_amdgcn_exp2f(-dl); lsum *= f;
#pragma unroll
                for (int i = 0; i < 16; ++i) { c0[i] -= dl; c1[i] -= dl; o0[i] *= f; o1[i] *= f; } }
            float ps = 0.f;
#pragma unroll
            for (int i = 0; i < 16; ++i) { c0[i] = __builtin_amdgcn_exp2f(c0[i]); c1[i] = __builtin_amdgcn_exp2f(c1[i]); ps += c0[i] + c1[i]; }
            lsum += ps;
            h16x8 pf[4];
#pragma unroll
            for (int k = 0; k < 8; ++k) { pf[0][k] = (h16)c0[k]; pf[1][k] = (h16)c0[8 + k]; pf[2][k] = (h16)c1[k]; pf[3][k] = (h16)c1[8 + k]; }
#pragma unroll
            for (int t = 0; t < 4; ++t) {
                const h16x8 v0 = tr_frag(buf + rV + t * 1024), v1 = tr_frag(buf + rV + 4096 + t * 1024);
                o0 = __builtin_amdgcn_mfma_f32_32x32x16_f16(v0, pf[t], o0, 0, 0, 0);
                o1 = __builtin_amdgcn_mfma_f32_32x32x16_f16(v1, pf[t], o1, 0, 0, 0);
            }
        }
        if (tt + 1 < nt) { LAS unsigned char* nb = lds + ((tt + 1) & 1) * 16384; *(LAS u32x4*)(nb + wK) = rk; *(LAS u32x4*)(nb + wV) = rv; }
        __syncthreads();
        kp -= 64;
    }
    {
        const float inv = 1.0f / xhalf_sum(lsum);
        const h16* gp = projb + (size_t)qrow * NIN + C_MGATE + hh * 64 + 4 * hi; h16* dst = mix + ((size_t)b * SEQ + qrow) * DM + 512 + hh * 64 + 4 * hi;
#pragma unroll
        for (int g = 0; g < 4; ++g) {
            const h16x4 ga = *(const h16x4*)(gp + 8 * g), gb = *(const h16x4*)(gp + 32 + 8 * g); h16x4 oa, ob;
#pragma unroll
            for (int k = 0; k < 4; ++k) { oa[k] = (h16)(o0[4 * g + k] * inv * silu_f((float)ga[k])); ob[k] = (h16)(o1[4 * g + k] * inv * silu_f((float)gb[k])); }
            *(h16x4*)(dst + 8 * g) = oa; *(h16x4*)(dst + 32 + 8 * g) = ob;
        }
    }
}

__device__ __forceinline__ void phase_mixers(const Params& p, int layer, unsigned char* lds) {
#pragma unroll 1
    for (int u = blockIdx.x; u < 1024; u += gridDim.x) { const int j = 15 - (u >> 6), bh = u & 63; moba_unit(p, bh >> 3, bh & 7, j, lds); }
#pragma unroll 1
    for (int v = blockIdx.x; v < 1024; v += gridDim.x) ret_unit(p, v >> 7, (v >> 5) & 3, v & 31, lds);
#pragma unroll 1
    for (int v = blockIdx.x; v < 1024; v += gridDim.x) conv_unit(p, layer, v >> 7, v & 127, lds);
}

__device__ __forceinline__ void phase_final(const Params& p) {
    const float* rowss = (const float*)(p.ws + WS_ROWSS);
    const int lane = threadIdx.x & 63, wid = threadIdx.x >> 6;
    f32x4 g[4];
#pragma unroll
    for (int j = 0; j < 4; ++j) g[j] = *((const f32x4*)p.final_g + lane + 64 * j);
    for (int row = blockIdx.x * 8 + wid; row < MROWS; row += gridDim.x * 8) {
        const f32x4* rs = (const f32x4*)(rowss + (size_t)row * NPART); const f32x4 s0 = rs[0], s1 = rs[1], s2 = rs[2], s3 = rs[3];
        const float tot = ((s0[0] + s0[1]) + (s0[2] + s0[3])) + ((s1[0] + s1[1]) + (s1[2] + s1[3])) + ((s2[0] + s2[1]) + (s2[2] + s2[3])) + ((s3[0] + s3[1]) + (s3[2] + s3[3]));
        const float rstd = rsqrtf(tot * (1.0f / DM) + 1e-6f);
        f32x4* xr = (f32x4*)(p.out + (size_t)row * DM) + lane;
#pragma unroll
        for (int j = 0; j < 4; ++j) { f32x4 v = xr[64 * j]; v = v * rstd * g[j]; xr[64 * j] = v; }
    }
}

__global__ void __launch_bounds__(NTHREADS) hymba_fwd(Params p) {
    extern __shared__ __attribute__((aligned(16))) unsigned char lds[];
    cg::grid_group grid = cg::this_grid();
#define RUN_PHASE(k, body) do { if (p.ph_lo <= (k) && (k) < p.ph_hi) { body; if ((k) + 1 < p.ph_hi) grid.sync(); } } while (0)
    RUN_PHASE(0, phase_prologue(p, lds));
    RUN_PHASE(1, gemm_in(p, 0, lds));
    RUN_PHASE(2, phase_stats(p, lds));
    RUN_PHASE(3, phase_mixers(p, 0, lds));
    RUN_PHASE(4, gemm_out(p, 0, lds));
    RUN_PHASE(5, gemm_in(p, 1, lds));
    RUN_PHASE(6, phase_stats(p, lds));
    RUN_PHASE(7, phase_mixers(p, 1, lds));
    RUN_PHASE(8, gemm_out(p, 1, lds));
    RUN_PHASE(9, phase_final(p));
#undef RUN_PHASE
}

extern "C" void kernel_launch(void* const* d_in, const int* in_sizes, int n_in, void* d_out, int out_size, void* d_ws, size_t ws_size, hipStream_t stream) {
    static int grid_blocks = 0;
    if (!grid_blocks) {
        int dev = 0, cus = 0, per_cu = 0;
        hipGetDevice(&dev);
        hipDeviceGetAttribute(&cus, hipDeviceAttributeMultiprocessorCount, dev);
        hipFuncSetAttribute((const void*)hymba_fwd, hipFuncAttributeMaxDynamicSharedMemorySize, LDS_BYTES);
        hipOccupancyMaxActiveBlocksPerMultiprocessor(&per_cu, (const void*)hymba_fwd, NTHREADS, LDS_BYTES);
        if (per_cu < 1) per_cu = 1;
        grid_blocks = cus * per_cu;
        if (ws_size < WS_END) fprintf(stderr, "kernel_launch: workspace too small (%zu < %zu)\n", ws_size, (size_t)WS_END);
    }
    Params p{};
    p.x = (const float*)d_in[0]; p.norm_g = (const float*)d_in[1]; p.w_in = (const float*)d_in[2]; p.conv_w = (const float*)d_in[3]; p.conv_b = (const float*)d_in[4];
    p.ln_g = (const float*)d_in[5]; p.ln_b = (const float*)d_in[6]; p.pw_w = (const float*)d_in[7]; p.pw_b = (const float*)d_in[8]; p.w_out = (const float*)d_in[9];
    p.final_g = (const float*)d_in[10]; p.out = (float*)d_out; p.ws = (unsigned char*)d_ws;
#if ONE_LAUNCH
    p.ph_lo = 0; p.ph_hi = NPHASES;
    { void* args[] = {&p};
      hipError_t e = hipLaunchCooperativeKernel((const void*)hymba_fwd, dim3(grid_blocks), dim3(NTHREADS), args, LDS_BYTES, stream);
      if (e != hipSuccess) fprintf(stderr, "cooperative launch failed: %s (grid %d)\n", hipGetErrorString(e), grid_blocks); }
#else
    for (int ph = 0; ph < NPHASES; ++ph) {
        p.ph_lo = ph; p.ph_hi = ph + 1; void* args[] = {&p};
        hipError_t e = hipLaunchCooperativeKernel((const void*)hymba_fwd, dim3(grid_blocks), dim3(NTHREADS), args, LDS_BYTES, stream);
        if (e != hipSuccess) { fprintf(stderr, "cooperative launch failed: %s (grid %d, phase %d)\n", hipGetErrorString(e), grid_blocks, ph); break; }
    }
#endif
}
```

```cpp
#include <hip/hip_runtime.h>
#include <hip/hip_cooperative_groups.h>
#include <cstdio>
#include <cstdint>
namespace cg = cooperative_groups;

#ifndef ONE_LAUNCH
#define ONE_LAUNCH 1
#endif

typedef _Float16 h16;
typedef _Float16 h16x8 __attribute__((ext_vector_type(8)));
typedef _Float16 h16x4 __attribute__((ext_vector_type(4)));
typedef float f32x16 __attribute__((ext_vector_type(16)));
typedef float f32x4 __attribute__((ext_vector_type(4)));
typedef unsigned u32x4 __attribute__((ext_vector_type(4)));

constexpr int BATCH = 8, SEQ = 4096, DM = 1024, MROWS = BATCH * SEQ, NIN = 3840, DEPTH = 2;
constexpr int C_AVAL = 0, C_AGLU = 256, C_AGATE = 512, C_RQ = 768, C_RK = 1024, C_RV = 1280, C_RGATE = 1536, C_MQ = 1792, C_MK = 2304, C_MV = 2816, C_MGATE = 3328;
constexpr int NPART = 16;
constexpr int NTHREADS = 512;
constexpr int LDS_BYTES = 147456;
constexpr int NPHASES = 10;

constexpr size_t MiB = 1u << 20;
constexpr size_t WS_XH = 0, WS_PROJ = 64 * MiB, WS_MIX = 304 * MiB, WS_WIN = 368 * MiB, WS_WOUT = 383 * MiB, WS_WPW = 387 * MiB,
                 WS_KV = 388 * MiB, WS_KMEAN = 404 * MiB  , WS_ROWSS = 405 * MiB, WS_END = 408 * MiB;

struct Params {
    const float *x, *norm_g, *w_in, *conv_w, *conv_b, *ln_g, *ln_b, *pw_w, *pw_b, *w_out, *final_g;
    float* out; unsigned char* ws;
    int ph_lo, ph_hi;
};

__device__ __forceinline__ float silu_f(float v) { return v / (1.0f + __expf(-v)); }
__device__ __forceinline__ int crow(int r, int h) { return (r & 3) + 8 * (r >> 2) + 4 * h; }
__device__ __forceinline__ float wave_sum(float v) {
#pragma unroll
    for (int o = 1; o < 64; o <<= 1) v += __shfl_xor(v, o);
    return v;
}

__device__ __forceinline__ void transpose_unit(const float* W, int K, int N, h16* WT, const float* g, int k0, int n0, float* tile) {
    const int tid = threadIdx.x;
    __syncthreads();
#pragma unroll
    for (int i = 0; i < 8; ++i) { const int k = i * 8 + (tid >> 6), n = tid & 63; float v = W[(size_t)(k0 + k) * N + n0 + n]; if (g) v *= g[k0 + k]; tile[k * 65 + n] = v; }
    __syncthreads();
#pragma unroll
    for (int i = 0; i < 8; ++i) { const int n = i * 8 + (tid >> 6), k = tid & 63; WT[(size_t)(n0 + n) * K + k0 + k] = (h16)tile[k * 65 + n]; }
}

__device__ __forceinline__ void phase_prologue(const Params& p, unsigned char* lds) {
    float* tile = (float*)lds;
    h16* win = (h16*)(p.ws + WS_WIN); h16* wout = (h16*)(p.ws + WS_WOUT); h16* wpw = (h16*)(p.ws + WS_WPW);
    constexpr int U_IN = 16 * 60, U_OUT = 16 * 16, U_PW = 4 * 4, U_L = U_IN + U_OUT + U_PW;
    for (int u = blockIdx.x; u < DEPTH * U_L; u += gridDim.x) {
        const int layer = u / U_L; int r = u % U_L;
        if (r < U_IN) { transpose_unit(p.w_in + (size_t)layer * DM * NIN, DM, NIN, win + (size_t)layer * NIN * DM, p.norm_g + layer * DM, (r / 60) * 64, (r % 60) * 64, tile); continue; }
        r -= U_IN;
        if (r < U_OUT) { transpose_unit(p.w_out + (size_t)layer * DM * DM, DM, DM, wout + (size_t)layer * DM * DM, nullptr, (r / 16) * 64, (r % 16) * 64, tile); continue; }
        r -= U_OUT;
        transpose_unit(p.pw_w + (size_t)layer * 256 * 256, 256, 256, wpw + (size_t)layer * 256 * 256, nullptr, (r / 4) * 64, (r % 4) * 64, tile);
    }
    h16* xh = (h16*)(p.ws + WS_XH); float* rowss = (float*)(p.ws + WS_ROWSS);
    const int lane = threadIdx.x & 63, wid = threadIdx.x >> 6;
    for (int row = blockIdx.x * 8 + wid; row < MROWS; row += gridDim.x * 8) {
        const f32x4* xr = (const f32x4*)(p.x + (size_t)row * DM) + lane;
        float ss = 0.f;
#pragma unroll
        for (int j = 0; j < 4; ++j) { const f32x4 v = xr[64 * j]; ss += v.x * v.x + v.y * v.y + v.z * v.z + v.w * v.w;
            h16x4 o; o.x = (h16)v.x; o.y = (h16)v.y; o.z = (h16)v.z; o.w = (h16)v.w; *((h16x4*)(xh + (size_t)row * DM) + lane + 64 * j) = o; }
        ss = wave_sum(ss);
        if (lane < NPART) rowss[(size_t)row * NPART + lane] = (lane == 0) ? ss : 0.f;
    }
}

typedef short s16x4 __attribute__((ext_vector_type(4)));
#define LAS __attribute__((address_space(3)))
__device__ __forceinline__ float xhalf_max(float v) { auto rr = __builtin_amdgcn_permlane32_swap(__float_as_uint(v), __float_as_uint(v), false, false); return fmaxf(__uint_as_float(rr[0]), __uint_as_float(rr[1])); }
__device__ __forceinline__ float xhalf_sum(float v) { auto rr = __builtin_amdgcn_permlane32_swap(__float_as_uint(v), __float_as_uint(v), false, false); return __uint_as_float(rr[0]) + __uint_as_float(rr[1]); }
__device__ __forceinline__ h16x8 tr_frag(const LAS unsigned char* a) {
    const s16x4 lo = __builtin_amdgcn_ds_read_tr16_b64_v4i16((LAS s16x4*)a), hi = __builtin_amdgcn_ds_read_tr16_b64_v4i16((LAS s16x4*)(a + 512));
    typedef short s16x8 __attribute__((ext_vector_type(8)));
    const s16x8 v = __builtin_shufflevector(lo, hi, 0, 1, 2, 3, 4, 5, 6, 7);
    return __builtin_bit_cast(h16x8, v);
}
#define CROW0(i) (((i) & 3) + 8 * ((i) >> 2))

namespace pg8 {
#define PG8_LAS __attribute__((address_space(3)))
typedef _Float16 bf16_t;
typedef _Float16 bf16x8 __attribute__((ext_vector_type(8)));
typedef float f32x4 __attribute__((ext_vector_type(4)));
typedef unsigned u32x4 __attribute__((ext_vector_type(4)));
constexpr int BM = 256, BK = 64, HALF = 128, HTB = HALF * BK * 2  , STAGE_BYTES = 8 * HTB, NXCD = 8, WGM = 8;

__host__ __device__ __forceinline__ int lds_byte(int r, int c) { const int st = (r >> 4) * 2 + (c >> 5), rr = r & 15, cc = c & 31, ob = rr * 64 + cc * 2; return st * 1024 + (ob ^ (((ob >> 9) & 1) << 5)); }
__host__ __device__ __forceinline__ void stage_rc(int b, int& R, int& C) { const int st = b / 1024, sb = b % 1024, swz = sb ^ (((sb >> 9) & 1) << 5); R = (st >> 1) * 16 + swz / 64; C = (st & 1) * 32 + (swz % 64) / 2; }
__host__ __device__ __forceinline__ int perm32(int rho) { const int n = rho >> 4, i = rho & 15; return 8 * (i >> 2) + 4 * n + (i & 3); }

struct Unit { int pm, pn; };
struct Gemm { const bf16_t* A; const bf16_t* Bt; int M, N, K; };

struct StaticOrder {
    int nM, nN, nwg, G, c;
    __host__ __device__ void init(int M, int N, int G_, int c_) { nM = M / BM; nN = N / BM; nwg = nM * nN; G = G_; c = c_; }
    __host__ __device__ bool next(int i, Unit& u) const {
        const long L = (long)i * G + c; if (L >= nwg) return false;
        int wgid = (int)L; { const int q = nwg / NXCD, r = nwg % NXCD, xcd = wgid % NXCD, off = wgid / NXCD; wgid = (xcd < r ? xcd * (q + 1) : r * (q + 1) + (xcd - r) * q) + off; }
        const int nig = WGM * nN, gid = wgid / nig, fm = gid * WGM, gsz = (nM - fm) < WGM ? (nM - fm) : WGM;
        u.pm = fm + ((wgid % nig) % gsz); u.pn = (wgid % nig) / gsz; return true;
    }
    __device__ __forceinline__ void a_ready(const Unit&) const {}
    __device__ __forceinline__ void done(const Unit&) const {}
};

template <class Epi, class Sched, bool ALIGN_EPI = false, bool SP2 = false>
__device__ __forceinline__ void gemm_phase(PG8_LAS unsigned char* lds, const Gemm g, const Sched& S, const Epi& E) {
    const int tid = threadIdx.x, wid = __builtin_amdgcn_readfirstlane(tid >> 6), lane = tid & 63, wr = wid >> 2, wc = wid & 3, fr = lane & 15, fq = lane >> 4;
    const int K = g.K, nt = K / BK;
    unsigned voffA[2], voffB[2];
#pragma unroll
    for (int i = 0; i < 2; ++i) { int R, C; stage_rc(tid * 16 + i * 8192, R, C); const int Rb = Epi::PERM ? ((R & ~31) + perm32(R & 31)) : R;
        voffA[i] = (unsigned)(R * K + C) * 2u; voffB[i] = (unsigned)(Rb * K + C) * 2u; }
    const size_t kstep = (size_t)(BK * 2);
    const size_t hstep = (size_t)HALF * K * 2;
    const size_t tstep = 2 * hstep;
    const unsigned ldsw = (unsigned)wid * 1024u;
    const int aoff = lds_byte(wr * 64 + fr, fq * 8), boff = lds_byte(wc * 32 + fr, fq * 8);
#define PG8_SA(b, h) (((b) * 2 + (h)) * HTB)
#define PG8_SB(b, h) ((4 + (b) * 2 + (h)) * HTB)
#define PG8_STAGE(bufoff, gbase, voff) do { _Pragma("unroll") for (int _i = 0; _i < 2; ++_i) \
        __builtin_amdgcn_global_load_lds((const unsigned*)((const char*)(gbase) + (voff)[_i]), (PG8_LAS unsigned*)(lds + (bufoff) + ldsw + _i * 8192), 16, 0, 0); } while (0)
#define PG8_LDA(dst, b, h) do { _Pragma("unroll") for (int m = 0; m < 4; ++m) _Pragma("unroll") for (int k = 0; k < 2; ++k) dst[m][k] = *(const PG8_LAS bf16x8*)(lds + PG8_SA(b, h) + aoff + m * 2048 + k * 1024); } while (0)
#define PG8_LDB(dst, b, h) do { _Pragma("unroll") for (int n = 0; n < 2; ++n) _Pragma("unroll") for (int k = 0; k < 2; ++k) dst[n][k] = *(const PG8_LAS bf16x8*)(lds + PG8_SB(b, h) + boff + n * 2048 + k * 1024); } while (0)
#define PG8_MMA(ai, bj, At, Bt) do { __builtin_amdgcn_s_setprio(1); _Pragma("unroll") for (int m = 0; m < 4; ++m) _Pragma("unroll") for (int n = 0; n < 2; ++n) _Pragma("unroll") for (int k = 0; k < 2; ++k) \
        acc[ai][bj][m][n] = __builtin_amdgcn_mfma_f32_16x16x32_f16(Bt[n][k], At[m][k], acc[ai][bj][m][n], 0, 0, 0); __builtin_amdgcn_s_setprio(0); } while (0)
#define PG8_WAIT_V(n) asm volatile("s_waitcnt vmcnt(" #n ")" ::: "memory")
#define PG8_WAIT_L(n) asm volatile("s_waitcnt lgkmcnt(" #n ")" ::: "memory")
#define PG8_BAR __builtin_amdgcn_s_barrier()
#define PG8_SCHED __builtin_amdgcn_sched_barrier(0)
    Unit cur, nxt; int ui = 0;
    if (!S.next(0, cur)) return;
    f32x4 acc[2][2][4][2];
#pragma unroll
    for (int a = 0; a < 2; ++a)
#pragma unroll
        for (int b = 0; b < 2; ++b)
#pragma unroll
            for (int m = 0; m < 4; ++m)
#pragma unroll
                for (int n = 0; n < 2; ++n) acc[a][b][m][n] = (f32x4){0.f, 0.f, 0.f, 0.f};
    bf16x8 At[4][2], B0[2][2], B1[2][2];
    const char* cA = (const char*)g.A + (size_t)cur.pm * tstep; const char* cB = (const char*)g.Bt + (size_t)cur.pn * tstep;
    S.a_ready(cur);
    if constexpr (SP2) {
        PG8_STAGE(PG8_SB(0, 0), cB, voffB); PG8_STAGE(PG8_SB(0, 1), cB + hstep, voffB); PG8_STAGE(PG8_SA(0, 0), cA, voffA); PG8_STAGE(PG8_SA(0, 1), cA + hstep, voffA);
        if (wr == 1) PG8_BAR;
        PG8_WAIT_V(2); PG8_BAR;
        PG8_STAGE(PG8_SB(1, 0), cB + kstep, voffB); PG8_STAGE(PG8_SA(1, 0), cA + kstep, voffA); PG8_STAGE(PG8_SB(1, 1), cB + hstep + kstep, voffB);
        PG8_WAIT_V(6); PG8_BAR;
    } else {
        PG8_STAGE(PG8_SB(0, 0), cB, voffB); PG8_STAGE(PG8_SA(0, 0), cA, voffA); PG8_STAGE(PG8_SB(0, 1), cB + hstep, voffB); PG8_STAGE(PG8_SA(0, 1), cA + hstep, voffA);
        if (wr == 1) PG8_BAR;
        PG8_WAIT_V(4); PG8_BAR;
        PG8_STAGE(PG8_SB(1, 0), cB + kstep, voffB); PG8_STAGE(PG8_SA(1, 0), cA + kstep, voffA); PG8_STAGE(PG8_SB(1, 1), cB + hstep + kstep, voffB);
        PG8_WAIT_V(6); PG8_BAR;
    }
    for (;;) {
        const bool has_next = S.next(ui + 1, nxt);
        const char* nA = has_next ? (const char*)g.A + (size_t)nxt.pm * tstep : cA; const char* nB = has_next ? (const char*)g.Bt + (size_t)nxt.pn * tstep : cB;
        for (int t = 0; t < nt; t += 2) {
            const bool last = (t == nt - 2);
            const char* a1 = cA + (size_t)(t + 1) * kstep;
            const char* a2 = last ? nA : cA + (size_t)(t + 2) * kstep; const char* b2 = last ? nB : cB + (size_t)(t + 2) * kstep;
            const char* a3 = a2 + kstep; const char* b3 = b2 + kstep;
            if (last && has_next) S.a_ready(nxt);
            if constexpr (SP2) {
            PG8_LDB(B0, 0, 0); PG8_LDB(B1, 0, 1); PG8_SCHED; PG8_LDA(At, 0, 0); PG8_STAGE(PG8_SA(1, 1), a1 + hstep, voffA);
            PG8_WAIT_V(8); PG8_WAIT_L(0); PG8_BAR; PG8_MMA(0, 0, At, B0); PG8_MMA(0, 1, At, B1); PG8_BAR; PG8_SCHED;
            PG8_LDA(At, 0, 1); PG8_STAGE(PG8_SB(0, 0), b2, voffB); PG8_STAGE(PG8_SB(0, 1), b2 + hstep, voffB); PG8_STAGE(PG8_SA(0, 0), a2, voffA);
            PG8_WAIT_V(8); PG8_WAIT_L(0); PG8_BAR; PG8_MMA(1, 0, At, B0); PG8_MMA(1, 1, At, B1); PG8_BAR; PG8_SCHED;
            PG8_LDB(B0, 1, 0); PG8_LDB(B1, 1, 1); PG8_SCHED; PG8_LDA(At, 1, 0); PG8_STAGE(PG8_SA(0, 1), a2 + hstep, voffA);
            PG8_WAIT_V(8); PG8_WAIT_L(0); PG8_BAR; PG8_MMA(0, 0, At, B0); PG8_MMA(0, 1, At, B1); PG8_BAR; PG8_SCHED;
            PG8_LDA(At, 1, 1); PG8_STAGE(PG8_SB(1, 0), b3, voffB); PG8_STAGE(PG8_SB(1, 1), b3 + hstep, voffB); PG8_STAGE(PG8_SA(1, 0), a3, voffA);
            PG8_WAIT_V(8); PG8_WAIT_L(0); PG8_BAR; PG8_MMA(1, 0, At, B0); PG8_MMA(1, 1, At, B1); PG8_BAR; PG8_SCHED;
            } else {
            PG8_LDB(B0, 0, 0); PG8_SCHED; PG8_LDA(At, 0, 0); PG8_STAGE(PG8_SA(1, 1), a1 + hstep, voffA);
            PG8_WAIT_L(8); PG8_BAR; PG8_WAIT_L(0); PG8_MMA(0, 0, At, B0); PG8_BAR; PG8_SCHED;
            PG8_LDB(B1, 0, 1); PG8_STAGE(PG8_SB(0, 0), b2, voffB);
            PG8_BAR; PG8_WAIT_L(0); PG8_MMA(0, 1, At, B1); PG8_BAR;
            PG8_LDA(At, 0, 1); PG8_STAGE(PG8_SA(0, 0), a2, voffA);
            PG8_BAR; PG8_WAIT_L(0); PG8_MMA(1, 0, At, B0); PG8_BAR; PG8_SCHED;
            PG8_STAGE(PG8_SB(0, 1), b2 + hstep, voffB);
            PG8_WAIT_V(6); PG8_BAR; PG8_MMA(1, 1, At, B1); PG8_BAR;
            PG8_LDB(B0, 1, 0); PG8_SCHED; PG8_LDA(At, 1, 0); PG8_STAGE(PG8_SA(0, 1), a2 + hstep, voffA);
            PG8_WAIT_L(8); PG8_BAR; PG8_WAIT_L(0); PG8_MMA(0, 0, At, B0); PG8_BAR; PG8_SCHED;
            PG8_LDB(B1, 1, 1); PG8_STAGE(PG8_SB(1, 0), b3, voffB);
            PG8_BAR; PG8_WAIT_L(0); PG8_MMA(0, 1, At, B1); PG8_BAR;
            PG8_LDA(At, 1, 1); PG8_STAGE(PG8_SA(1, 0), a3, voffA);
            PG8_BAR; PG8_WAIT_L(0); PG8_MMA(1, 0, At, B0); PG8_BAR; PG8_SCHED;
            PG8_STAGE(PG8_SB(1, 1), b3 + hstep, voffB);
            PG8_WAIT_V(6); PG8_BAR; PG8_MMA(1, 1, At, B1); PG8_BAR;
            }
        }
        if constexpr (ALIGN_EPI) { if (wr == 0) PG8_BAR; }
        if constexpr (!Epi::AFTER_DRAIN) { E(acc, cur, wr, wc, fr, fq); S.done(cur); }
        if (!has_next) break;
#pragma unroll
        for (int a = 0; a < 2; ++a)
#pragma unroll
            for (int b = 0; b < 2; ++b)
#pragma unroll
                for (int m = 0; m < 4; ++m)
#pragma unroll
                    for (int n = 0; n < 2; ++n) acc[a][b][m][n] = (f32x4){0.f, 0.f, 0.f, 0.f};
        cur = nxt; cA = nA; cB = nB; ++ui;
        if constexpr (ALIGN_EPI) { if (wr == 1) PG8_BAR; }
    }
    PG8_WAIT_V(0);
    if constexpr (!ALIGN_EPI) { if (wr == 0) PG8_BAR; }
    PG8_BAR;
    if constexpr (Epi::AFTER_DRAIN) { E.fused(acc, cur, wr, wc, fr, fq, lds, wid, lane); S.done(cur); }
#undef PG8_SA
#undef PG8_SB
#undef PG8_STAGE
#undef PG8_LDA
#undef PG8_LDB
#undef PG8_MMA
#undef PG8_WAIT_V
#undef PG8_WAIT_L
#undef PG8_BAR
#undef PG8_SCHED
}

struct EpiProj {
    static constexpr bool PERM = true, AFTER_DRAIN = false;
    bf16_t* O; const float* rowss; float* kmpart;
    __device__ __forceinline__ void operator()(const f32x4 (&acc)[2][2][4][2], const Unit& u, int wr, int wc, int fr, int fq) const {
        const int row0 = u.pm * BM + wr * 64 + fr, col0 = u.pn * BM + wc * 32 + 8 * fq;
        const bool want_km = (u.pn == 9) || (u.pn == 10);
        f32x4 cs[2][2];
#pragma unroll
        for (int bj = 0; bj < 2; ++bj)
#pragma unroll
            for (int n = 0; n < 2; ++n) cs[bj][n] = (f32x4){0.f, 0.f, 0.f, 0.f};
#pragma unroll
        for (int ai = 0; ai < 2; ++ai)
#pragma unroll
            for (int m = 0; m < 4; ++m) { const size_t row = (size_t)(row0 + ai * HALF + m * 16);
                const f32x4* rs = (const f32x4*)(rowss + row * 16); const f32x4 s0 = rs[0], s1 = rs[1], s2 = rs[2], s3 = rs[3];
                const float tot = ((s0[0] + s0[1]) + (s0[2] + s0[3])) + ((s1[0] + s1[1]) + (s1[2] + s1[3])) + ((s2[0] + s2[1]) + (s2[2] + s2[3])) + ((s3[0] + s3[1]) + (s3[2] + s3[3]));
                const float rstd = rsqrtf(tot * (1.0f / 1024.0f) + 1e-6f);
                bf16_t* rowp = O + row * 3840 + col0;
#pragma unroll
                for (int bj = 0; bj < 2; ++bj) { const f32x4 v0 = acc[ai][bj][m][0] * rstd, v1 = acc[ai][bj][m][1] * rstd; bf16x8 w;
                    w[0] = (bf16_t)v0[0]; w[1] = (bf16_t)v0[1]; w[2] = (bf16_t)v0[2]; w[3] = (bf16_t)v0[3]; w[4] = (bf16_t)v1[0]; w[5] = (bf16_t)v1[1]; w[6] = (bf16_t)v1[2]; w[7] = (bf16_t)v1[3];
                    *(bf16x8*)(rowp + bj * HALF) = w; cs[bj][0] += v0; cs[bj][1] += v1; } }
        if (want_km) {
#pragma unroll
            for (int bj = 0; bj < 2; ++bj)
#pragma unroll
                for (int n = 0; n < 2; ++n)
#pragma unroll
                    for (int k = 0; k < 4; ++k) { float v = cs[bj][n][k]; v += __shfl_xor(v, 1); v += __shfl_xor(v, 2); v += __shfl_xor(v, 4); v += __shfl_xor(v, 8); cs[bj][n][k] = v * (1.0f / 256.0f); }
            if (fr == 0) {
#pragma unroll
                for (int bj = 0; bj < 2; ++bj)
#pragma unroll
                    for (int n = 0; n < 2; ++n) { const int cm = col0 + bj * HALF + 4 * n - 2304;
                        *(f32x4*)(kmpart + ((size_t)((wr * 8 + (u.pm >> 4)) * 8 + (cm >> 6)) * 16 + (u.pm & 15)) * 64 + (cm & 63)) = cs[bj][n]; }
            }
        }
    }
};
struct EpiRes {
    static constexpr bool PERM = true, AFTER_DRAIN = false;
    const float* xold; float* xnew; bf16_t* xh; float* rowss;
    __device__ __forceinline__ void operator()(const f32x4 (&acc)[2][2][4][2], const Unit& u, int wr, int wc, int fr, int fq) const {
        const int row0 = u.pm * BM + wr * 64 + fr, col0 = u.pn * BM + wc * 32 + 8 * fq;
#pragma unroll
        for (int ai = 0; ai < 2; ++ai)
#pragma unroll
            for (int m = 0; m < 4; ++m) { const size_t row = (size_t)(row0 + ai * HALF + m * 16); float ss = 0.f;
#pragma unroll
                for (int bj = 0; bj < 2; ++bj) { const size_t off = row * 1024 + col0 + bj * HALF;
                    const f32x4 v0 = *(const f32x4*)(xold + off) + acc[ai][bj][m][0], v1 = *(const f32x4*)(xold + off + 4) + acc[ai][bj][m][1];
                    *(f32x4*)(xnew + off) = v0; *(f32x4*)(xnew + off + 4) = v1; bf16x8 w;
                    w[0] = (bf16_t)v0[0]; w[1] = (bf16_t)v0[1]; w[2] = (bf16_t)v0[2]; w[3] = (bf16_t)v0[3]; w[4] = (bf16_t)v1[0]; w[5] = (bf16_t)v1[1]; w[6] = (bf16_t)v1[2]; w[7] = (bf16_t)v1[3];
                    *(bf16x8*)(xh + off) = w;
                    ss += ((v0[0] * v0[0] + v0[1] * v0[1]) + (v0[2] * v0[2] + v0[3] * v0[3])) + ((v1[0] * v1[0] + v1[1] * v1[1]) + (v1[2] * v1[2] + v1[3] * v1[3])); }
                ss += __shfl_xor(ss, 16); ss += __shfl_xor(ss, 32);
                if (fq == 0) rowss[row * 16 + u.pn * 4 + wc] = ss; }
    }
};
}


__device__ __forceinline__ void gemm_in(const Params& p, int layer, unsigned char* lds) {
    pg8::Gemm g{(const h16*)(p.ws + WS_XH), (const h16*)(p.ws + WS_WIN) + (size_t)layer * NIN * DM, MROWS, NIN, DM};
    pg8::StaticOrder S; S.init(MROWS, NIN, (int)gridDim.x, (int)blockIdx.x);
    pg8::EpiProj E{(h16*)(p.ws + WS_PROJ), (const float*)(p.ws + WS_ROWSS), (float*)(p.ws + WS_KMEAN)};
    pg8::gemm_phase<pg8::EpiProj, pg8::StaticOrder, true, true>((PG8_LAS unsigned char*)lds, g, S, E);
}
__device__ __forceinline__ void gemm_out(const Params& p, int layer, unsigned char* lds) {
    pg8::Gemm g{(const h16*)(p.ws + WS_MIX), (const h16*)(p.ws + WS_WOUT) + (size_t)layer * DM * DM, MROWS, DM, DM};
    pg8::StaticOrder S; S.init(MROWS, DM, (int)gridDim.x, (int)blockIdx.x);
    pg8::EpiRes E{(layer == 0) ? p.x : p.out, p.out, (h16*)(p.ws + WS_XH), (float*)(p.ws + WS_ROWSS)};
    pg8::gemm_phase<pg8::EpiRes, pg8::StaticOrder, true, true>((PG8_LAS unsigned char*)lds, g, S, E);
}

__device__ __forceinline__ void phase_stats(const Params& p, unsigned char* lds_g) {
    LAS unsigned char* lds = (LAS unsigned char*)lds_g;
    const h16* proj = (const h16*)(p.ws + WS_PROJ); float* kv = (float*)(p.ws + WS_KV);
    const int tid = threadIdx.x, lane = tid & 63, wid = __builtin_amdgcn_readfirstlane(tid >> 6), r = lane & 31, hi = lane >> 5;
    const int lanepart = (4 * hi + ((lane & 15) >> 2)) * 64 + ((lane >> 4) & 1) * 32 + (lane & 3) * 8;
#pragma unroll 1
    for (int u = blockIdx.x; u < 512; u += gridDim.x) {
        const int b = u >> 6, hh = (u >> 4) & 3, np = u & 15;
        const float log_g = logf(1.0f - exp2f(-5.0f - (float)hh));
        __syncthreads();
#pragma unroll
        for (int it = 0; it < 4; ++it) {
            const int pc = tid + 512 * it, cn = pc >> 10, key = (pc >> 3) & 127, ch = pc & 7;
            const h16* src = proj + (size_t)(b * SEQ + (2 * np + cn) * 128 + key) * NIN + hh * 64 + ch * 8;
            h16x8 kk = *(const h16x8*)(src + C_RK); const h16x8 vv = *(const h16x8*)(src + C_RV);
            const float z = __expf(log_g * (float)(127 - key)) * 0.125f;
#pragma unroll
            for (int k = 0; k < 8; ++k) kk[k] = (h16)((float)kk[k] * z);
            const int off = cn * 32768 + (ch >> 2) * 8192 + (key >> 4) * 1024 + (key & 15) * 64 + (ch & 3) * 16;
            *(LAS h16x8*)(lds + off) = kk; *(LAS h16x8*)(lds + off + 16384) = vv;
        }
        __syncthreads();
        const int cn = wid >> 2, eb = (wid >> 1) & 1, dbk = wid & 1;
        const LAS unsigned char* kimg = lds + cn * 32768 + dbk * 8192 + lanepart; const LAS unsigned char* vimg = lds + cn * 32768 + 16384 + eb * 8192 + lanepart;
        f32x16 acc;
#pragma unroll
        for (int i = 0; i < 16; ++i) acc[i] = 0.f;
#pragma unroll
        for (int ks = 0; ks < 8; ++ks) acc = __builtin_amdgcn_mfma_f32_32x32x16_f16(tr_frag(vimg + ks * 1024), tr_frag(kimg + ks * 1024), acc, 0, 0, 0);
        float* dst = kv + ((size_t)((b * 4 + hh) * 32 + 2 * np + cn)) * 4096 + (32 * eb + 4 * hi) * 64 + 32 * dbk + r;
#pragma unroll
        for (int i = 0; i < 16; ++i) dst[CROW0(i) * 64] = acc[i];
    }
}

__device__ __forceinline__ void conv_unit(const Params& p, int layer, int b, int tt, unsigned char* lds) {
    const h16* proj = (const h16*)(p.ws + WS_PROJ); h16* mix = (h16*)(p.ws + WS_MIX);
    float* us = (float*)lds; float* ys = us + 62 * 256;
    const int tid = threadIdx.x, c = tid & 255, th = tid >> 8, t0 = tt * 32, lane = tid & 63, wid = tid >> 6;
    __syncthreads();
    for (int rr = th; rr < 62; rr += 2) { const int t = t0 - 30 + rr; float u = 0.f;
        if (t >= 0) { const size_t row = (size_t)(b * SEQ + t); const float a = (float)proj[row * NIN + C_AVAL + c], g = (float)proj[row * NIN + C_AGLU + c]; u = a / (1.0f + __expf(-g)); }
        us[rr * 256 + c] = u; }
    __syncthreads();
    {
        float w[31];
#pragma unroll
        for (int jj = 0; jj < 31; ++jj) w[jj] = p.conv_w[((size_t)layer * 31 + jj) * 256 + c];
        const float cb = p.conv_b[layer * 256 + c];
#pragma unroll 1
        for (int tl = th * 16; tl < th * 16 + 16; ++tl) { float y = cb;
#pragma unroll
            for (int jj = 0; jj < 31; ++jj) y += w[jj] * us[(tl + jj) * 256 + c];
            ys[tl * 256 + c] = y; }
    }
    __syncthreads();
    {
        const f32x4 lg = *(const f32x4*)(p.ln_g + layer * 256 + lane * 4), lb = *(const f32x4*)(p.ln_b + layer * 256 + lane * 4);
        for (int k = 0; k < 4; ++k) { const int tl = wid * 4 + k; f32x4 v = *(const f32x4*)(ys + tl * 256 + lane * 4);
            const float mu = wave_sum((v.x + v.y) + (v.z + v.w)) * (1.0f / 256.0f);
            v = v - mu; const float var = wave_sum((v.x * v.x + v.y * v.y) + (v.z * v.z + v.w * v.w)) * (1.0f / 256.0f); const float rs = rsqrtf(var + 1e-5f);
            f32x4 o; o.x = silu_f(v.x * rs * lg.x + lb.x); o.y = silu_f(v.y * rs * lg.y + lb.y); o.z = silu_f(v.z * rs * lg.z + lb.z); o.w = silu_f(v.w * rs * lg.w + lb.w);
            *(f32x4*)(ys + tl * 256 + lane * 4) = o; }
    }
    __syncthreads();
    {
        float acc[16]; const float pb = p.pw_b[layer * 256 + c];
#pragma unroll
        for (int k = 0; k < 16; ++k) acc[k] = pb;
        const float* pw = p.pw_w + (size_t)layer * 65536 + c;
#pragma unroll 2
        for (int cc = 0; cc < 256; ++cc) { const float w = pw[(size_t)cc * 256];
#pragma unroll
            for (int k = 0; k < 16; ++k) acc[k] += ys[(th * 16 + k) * 256 + cc] * w; }
#pragma unroll
        for (int k = 0; k < 16; ++k) { const size_t row = (size_t)(b * SEQ + t0 + th * 16 + k);
            mix[row * DM + c] = (h16)(acc[k] * silu_f((float)proj[row * NIN + C_AGATE + c])); }
    }
}

__device__ __forceinline__ void ret_unit(const Params& p, int b, int hh, int n, unsigned char* lds_g) {
    LAS unsigned char* lds = (LAS unsigned char*)lds_g;
    const h16* projb = (const h16*)(p.ws + WS_PROJ) + (size_t)(b * SEQ + n * 128) * NIN; h16* mix = (h16*)(p.ws + WS_MIX); const float* kv = (const float*)(p.ws + WS_KV);
    const int tid = threadIdx.x, lane = tid & 63, wid = __builtin_amdgcn_readfirstlane(tid >> 6), r = lane & 31, hi = lane >> 5, g4 = wid & 3, eh = wid >> 2;
    const float log_g = logf(1.0f - exp2f(-5.0f - (float)hh)); const float g_chunk = expf(log_g * 128.0f), gam = 1.0f - exp2f(-5.0f - (float)hh);
    constexpr int KIMG = 0, VIMG = 16384, RIMG = 32768, XS = 40960;
    f32x4 ra = (f32x4){0.f, 0.f, 0.f, 0.f}, rb = (f32x4){0.f, 0.f, 0.f, 0.f};
    {
        const float* kvb = kv + ((size_t)(b * 4 + hh) * 32) * 4096 + tid * 8;
#pragma unroll 4
        for (int m = 0; m < n; ++m) { ra = ra * g_chunk + *(const f32x4*)(kvb + (size_t)m * 4096); rb = rb * g_chunk + *(const f32x4*)(kvb + (size_t)m * 4096 + 4); }
    }
    __syncthreads();
    {
        h16x8 rr;
#pragma unroll
        for (int k = 0; k < 4; ++k) { rr[k] = (h16)(ra[k] * gam); rr[4 + k] = (h16)(rb[k] * gam); }
        const int e = tid >> 3, ch = tid & 7;
        *(LAS h16x8*)(lds + RIMG + e * 128 + ((ch ^ ((e >> 1) & 7)) << 4)) = rr;
#pragma unroll
        for (int it = 0; it < 2; ++it) {
            const int key = (tid >> 3) + 64 * it;
            h16x8 kk = *(const h16x8*)(projb + (size_t)key * NIN + C_RK + hh * 64 + ch * 8); const h16x8 vv = *(const h16x8*)(projb + (size_t)key * NIN + C_RV + hh * 64 + ch * 8);
            const float z = __expf(-log_g * (float)key) * 0.125f;
#pragma unroll
            for (int k = 0; k < 8; ++k) kk[k] = (h16)((float)kk[k] * z);
            *(LAS h16x8*)(lds + KIMG + key * 128 + ((ch ^ ((key >> 1) & 7)) << 4)) = kk;
            *(LAS h16x8*)(lds + VIMG + (ch >> 2) * 8192 + (key >> 4) * 1024 + (key & 15) * 64 + (ch & 3) * 16) = vv;
        }
    }
    const int qi = 32 * g4 + r;
    h16x8 qf[4];
    {
        const float zq = __expf(log_g * (float)qi);
#pragma unroll
        for (int s = 0; s < 4; ++s) { qf[s] = *(const h16x8*)(projb + (size_t)qi * NIN + C_RQ + hh * 64 + 16 * s + 8 * hi);
#pragma unroll
            for (int k = 0; k < 8; ++k) qf[s][k] = (h16)((float)qf[s][k] * zq); }
    }
    __syncthreads();
    const int rsw = (r >> 1) & 7;
    const int lanepart = (4 * hi + ((lane & 15) >> 2)) * 64 + ((lane >> 4) & 1) * 32 + (lane & 3) * 8;
    f32x16 o;
#pragma unroll
    for (int i = 0; i < 16; ++i) o[i] = 0.f;
#pragma unroll 1
    for (int jb = 0; jb <= g4; ++jb) {
        f32x16 c;
#pragma unroll
        for (int i = 0; i < 16; ++i) c[i] = 0.f;
#pragma unroll
        for (int s = 0; s < 4; ++s) c = __builtin_amdgcn_mfma_f32_32x32x16_f16(*(const LAS h16x8*)(lds + KIMG + (32 * jb + r) * 128 + (((2 * s + hi) ^ rsw) << 4)), qf[s], c, 0, 0, 0);
        if (jb == g4) {
#pragma unroll
            for (int i = 0; i < 16; ++i) if (CROW0(i) + 4 * hi > r) c[i] = 0.f;
        }
        h16x8 pf0, pf1;
#pragma unroll
        for (int k = 0; k < 8; ++k) { pf0[k] = (h16)c[k]; pf1[k] = (h16)c[8 + k]; }
        o = __builtin_amdgcn_mfma_f32_32x32x16_f16(tr_frag(lds + VIMG + eh * 8192 + (2 * jb) * 1024 + lanepart), pf0, o, 0, 0, 0);
        o = __builtin_amdgcn_mfma_f32_32x32x16_f16(tr_frag(lds + VIMG + eh * 8192 + (2 * jb + 1) * 1024 + lanepart), pf1, o, 0, 0, 0);
    }
#pragma unroll
    for (int s = 0; s < 4; ++s) o = __builtin_amdgcn_mfma_f32_32x32x16_f16(*(const LAS h16x8*)(lds + RIMG + (32 * eh + r) * 128 + (((2 * s + hi) ^ rsw) << 4)), qf[s], o, 0, 0, 0);
    float s1 = 0.f, s2 = 0.f;
#pragma unroll
    for (int i = 0; i < 16; ++i) { s1 += o[i]; s2 += o[i] * o[i]; }
    s1 = xhalf_sum(s1); s2 = xhalf_sum(s2);
    LAS float* xs = (LAS float*)(lds + XS);
    if (hi == 0) { xs[(wid * 32 + r) * 2] = s1; xs[(wid * 32 + r) * 2 + 1] = s2; }
    __syncthreads();
    {
        const float t1 = xs[((wid ^ 4) * 32 + r) * 2], t2 = xs[((wid ^ 4) * 32 + r) * 2 + 1];
        const float a1 = (eh == 0) ? (s1 + t1) : (t1 + s1), a2 = (eh == 0) ? (s2 + t2) : (t2 + s2);
        const float mu = a1 * (1.0f / 64.0f); const float var = fmaxf(a2 * (1.0f / 64.0f) - mu * mu, 0.f); const float rs = rsqrtf(var + 1e-5f);
        const int col = hh * 64 + 32 * eh + 4 * hi;
        const h16* gp = projb + (size_t)qi * NIN + C_RGATE + col; h16* dst = mix + ((size_t)(b * SEQ + n * 128 + qi)) * DM + 256 + col;
#pragma unroll
        for (int g = 0; g < 4; ++g) { const h16x4 ga = *(const h16x4*)(gp + 8 * g); h16x4 oa;
#pragma unroll
            for (int k = 0; k < 4; ++k) oa[k] = (h16)((o[4 * g + k] - mu) * rs * silu_f((float)ga[k]));
            *(h16x4*)(dst + 8 * g) = oa; }
    }
}

constexpr float MOBA_THR = 8.0f;
__device__ __forceinline__ void moba_unit(const Params& p, int b, int hh, int j, unsigned char* lds_g) {
    LAS unsigned char* lds = (LAS unsigned char*)lds_g;
    const int tid = threadIdx.x, lane = tid & 63, wid = __builtin_amdgcn_readfirstlane(tid >> 6), r = lane & 31, hi = lane >> 5;
    const h16* projb = (const h16*)(p.ws + WS_PROJ) + (size_t)b * SEQ * NIN; h16* mix = (h16*)(p.ws + WS_MIX);
    const int qrow = j * 256 + wid * 32 + r;
    h16x8 qf[4];
#pragma unroll
    for (int s = 0; s < 4; ++s) qf[s] = *(const h16x8*)(projb + (size_t)qrow * NIN + C_MQ + hh * 64 + 16 * s + 8 * hi);
    unsigned selmask = 0u;
    if (j <= 3) selmask = (1u << j) - 1u;
    else {
        float g0 = -3.0e38f, g1 = -3.0e38f, g2 = -3.0e38f; int i0 = 0, i1 = 0, i2 = 0;
        const float* km = (const float*)(p.ws + WS_KMEAN) + ((size_t)(b * 8 + hh) * 16) * 64 + 8 * hi;
#pragma unroll 1
        for (int n = 0; n < j; ++n) { float s = 0.f;
#pragma unroll
            for (int ss = 0; ss < 4; ++ss) { const f32x4 k0 = *(const f32x4*)(km + n * 64 + 16 * ss) + *(const f32x4*)(km + 65536 + n * 64 + 16 * ss),
                                                             k1 = *(const f32x4*)(km + n * 64 + 16 * ss + 4) + *(const f32x4*)(km + 65536 + n * 64 + 16 * ss + 4);
                s += (float)qf[ss][0] * k0.x + (float)qf[ss][1] * k0.y + (float)qf[ss][2] * k0.z + (float)qf[ss][3] * k0.w
                   + (float)qf[ss][4] * k1.x + (float)qf[ss][5] * k1.y + (float)qf[ss][6] * k1.z + (float)qf[ss][7] * k1.w; }
            s = xhalf_sum(s);
            if (s > g0) { g2 = g1; i2 = i1; g1 = g0; i1 = i0; g0 = s; i0 = n; }
            else if (s > g1) { g2 = g1; i2 = i1; g1 = s; i1 = n; }
            else if (s > g2) { g2 = s; i2 = n; } }
        selmask = (1u << i0) | (1u << i1) | (1u << i2);
    }
    constexpr float C2 = 0.125f * 1.4426950408889634f;
#pragma unroll
    for (int s = 0; s < 4; ++s)
#pragma unroll
        for (int k = 0; k < 8; ++k) qf[s][k] = (h16)((float)qf[s][k] * C2);
    const float slope2 = exp2f(-(float)(hh + 1)) * 1.4426950408889634f;
    f32x16 o0, o1;
#pragma unroll
    for (int i = 0; i < 16; ++i) { o0[i] = 0.f; o1[i] = 0.f; }
    float mref = 0.f, lsum = 0.f; bool first = true;
    const int skey = tid >> 3, sch = tid & 7;
    const h16* gk = projb + (size_t)skey * NIN + C_MK + hh * 64 + sch * 8;
    const int wK = skey * 128 + ((sch ^ ((skey >> 1) & 7)) << 4);
    const int wV = 8192 + (sch >> 2) * 4096 + (skey >> 4) * 1024 + (skey & 15) * 64 + (sch & 3) * 16;
    const int rK = r * 128, rsw = (r >> 1) & 7;
    const int rV = 8192 + (4 * hi + ((lane & 15) >> 2)) * 64 + ((lane >> 4) & 1) * 32 + (lane & 3) * 8;
    const int nt = 4 * (j + 1);
    int kp = j * 256 + 192;
    u32x4 rk = *(const u32x4*)(gk + (size_t)kp * NIN), rv = *(const u32x4*)(gk + (size_t)kp * NIN + (C_MV - C_MK));
    __syncthreads();
    *(LAS u32x4*)(lds + wK) = rk; *(LAS u32x4*)(lds + wV) = rv;
    __syncthreads();
#pragma unroll 1
    for (int tt = 0; tt < nt; ++tt) {
        const LAS unsigned char* buf = lds + (tt & 1) * 16384;
        if (tt + 1 < nt) { rk = *(const u32x4*)(gk + (size_t)(kp - 64) * NIN); rv = *(const u32x4*)(gk + (size_t)(kp - 64) * NIN + (C_MV - C_MK)); }
        const int nblk = kp >> 8; const bool own = (nblk == j); const int tloc = (kp >> 6) & 3;
        bool valid = true, act, diag = false;
        if (own) { act = tloc <= (wid >> 1); diag = tloc == (wid >> 1); }
        else { valid = (selmask >> nblk) & 1u; act = __any(valid); }
        if (act) {
            const float tbh = valid ? (slope2 * (float)(kp - qrow + 4 * hi) - mref) : -INFINITY;
            f32x16 c0, c1;
#pragma unroll
            for (int i = 0; i < 16; ++i) { c0[i] = fmaf(slope2, (float)CROW0(i), tbh); c1[i] = fmaf(slope2, (float)(CROW0(i) + 32), tbh); }
            if (diag) { const int lim2 = 32 * wid - 64 * tloc + r - 4 * hi;
#pragma unroll
                for (int i = 0; i < 16; ++i) { if (CROW0(i) > lim2) c0[i] = -INFINITY; if (CROW0(i) + 32 > lim2) c1[i] = -INFINITY; } }
#pragma unroll
            for (int s = 0; s < 4; ++s) {
                const h16x8 k0 = *(const LAS h16x8*)(buf + rK + (((2 * s + hi) ^ rsw) << 4)), k1 = *(const LAS h16x8*)(buf + rK + 4096 + (((2 * s + hi) ^ rsw) << 4));
                c0 = __builtin_amdgcn_mfma_f32_32x32x16_f16(k0, qf[s], c0, 0, 0, 0);
                c1 = __builtin_amdgcn_mfma_f32_32x32x16_f16(k1, qf[s], c1, 0, 0, 0);
            }
            float rm = fmaxf(c0[0], c1[0]);
#pragma unroll
            for (int i = 1; i < 16; ++i) rm = fmaxf(rm, fmaxf(c0[i], c1[i]));
            rm = xhalf_max(rm);
            if (first) { first = false; mref = rm;
#pragma unroll
                for (int i = 0; i < 16; ++i) { c0[i] -= rm; c1[i] -= rm; } }
            else if (__any(rm > MOBA_THR)) { const float dl = fmaxf(rm, 0.f); mref += dl; const float f = __builtin_amdgcn_exp2f(-dl); lsum *= f;
#pragma unroll
                for (int i = 0; i < 16; ++i) { c0[i] -= dl; c1[i] -= dl; o0[i] *= f; o1[i] *= f; } }
            float ps = 0.f;
#pragma unroll
            for (int i = 0; i < 16; ++i) { c0[i] = __builtin_amdgcn_exp2f(c0[i]); c1[i] = __builtin_amdgcn_exp2f(c1[i]); ps += c0[i] + c1[i]; }
            lsum += ps;
            h16x8 pf[4];
#pragma unroll
            for (int k = 0; k < 8; ++k) { pf[0][k] = (h16)c0[k]; pf[1][k] = (h16)c0[8 + k]; pf[2][k] = (h16)c1[k]; pf[3][k] = (h16)c1[8 + k]; }
#pragma unroll
            for (int t = 0; t < 4; ++t) {
                const h16x8 v0 = tr_frag(buf + rV + t * 1024), v1 = tr_frag(buf + rV + 4096 + t * 1024);
                o0 = __builtin_amdgcn_mfma_f32_32x32x16_f16(v0, pf[t], o0, 0, 0, 0);
                o1 = __builtin_amdgcn_mfma_f32_32x32x16_f16(v1, pf[t], o1, 0, 0, 0);
            }
        }
        if (tt + 1 < nt) { LAS unsigned char* nb = lds + ((tt + 1) & 1) * 16384; *(LAS u32x4*)(nb + wK) = rk; *(LAS u32x4*)(nb + wV) = rv; }
        __syncthreads();
        kp -= 64;
    }
    {
        const float inv = 1.0f / xhalf_sum(lsum);
        const h16* gp = projb + (size_t)qrow * NIN + C_MGATE + hh * 64 + 4 * hi; h16* dst = mix + ((size_t)b * SEQ + qrow) * DM + 512 + hh * 64 + 4 * hi;
#pragma unroll
        for (int g = 0; g < 4; ++g) {
            const h16x4 ga = *(const h16x4*)(gp + 8 * g), gb = *(const h16x4*)(gp + 32 + 8 * g); h16x4 oa, ob;
#pragma unroll
            for (int k = 0; k < 4; ++k) { oa[k] = (h16)(o0[4 * g + k] * inv * silu_f((float)ga[k])); ob[k] = (h16)(o1[4 * g + k] * inv * silu_f((float)gb[k])); }
            *(h16x4*)(dst + 8 * g) = oa; *(h16x4*)(dst + 32 + 8 * g) = ob;
        }
    }
}

__device__ __forceinline__ void phase_mixers(const Params& p, int layer, unsigned char* lds) {
#pragma unroll 1
    for (int u = blockIdx.x; u < 1024; u += gridDim.x) { const int j = 15 - (u >> 6), bh = u & 63; moba_unit(p, bh >> 3, bh & 7, j, lds); }
#pragma unroll 1
    for (int v = blockIdx.x; v < 1024; v += gridDim.x) ret_unit(p, v >> 7, (v >> 5) & 3, v & 31, lds);
#pragma unroll 1
    for (int v = blockIdx.x; v < 1024; v += gridDim.x) conv_unit(p, layer, v >> 7, v & 127, lds);
}

__device__ __forceinline__ void phase_final(const Params& p) {
    const float* rowss = (const float*)(p.ws + WS_ROWSS);
    const int lane = threadIdx.x & 63, wid = threadIdx.x >> 6;
    f32x4 g[4];
#pragma unroll
    for (int j = 0; j < 4; ++j) g[j] = *((const f32x4*)p.final_g + lane + 64 * j);
    for (int row = blockIdx.x * 8 + wid; row < MROWS; row += gridDim.x * 8) {
        const f32x4* rs = (const f32x4*)(rowss + (size_t)row * NPART); const f32x4 s0 = rs[0], s1 = rs[1], s2 = rs[2], s3 = rs[3];
        const float tot = ((s0[0] + s0[1]) + (s0[2] + s0[3])) + ((s1[0] + s1[1]) + (s1[2] + s1[3])) + ((s2[0] + s2[1]) + (s2[2] + s2[3])) + ((s3[0] + s3[1]) + (s3[2] + s3[3]));
        const float rstd = rsqrtf(tot * (1.0f / DM) + 1e-6f);
        f32x4* xr = (f32x4*)(p.out + (size_t)row * DM) + lane;
#pragma unroll
        for (int j = 0; j < 4; ++j) { f32x4 v = xr[64 * j]; v = v * rstd * g[j]; xr[64 * j] = v; }
    }
}

__global__ void __launch_bounds__(NTHREADS) hymba_fwd(Params p) {
    extern __shared__ __attribute__((aligned(16))) unsigned char lds[];
    cg::grid_group grid = cg::this_grid();
#define RUN_PHASE(k, body) do { if (p.ph_lo <= (k) && (k) < p.ph_hi) { body; if ((k) + 1 < p.ph_hi) grid.sync(); } } while (0)
    RUN_PHASE(0, phase_prologue(p, lds));
    RUN_PHASE(1, gemm_in(p, 0, lds));
    RUN_PHASE(2, phase_stats(p, lds));
    RUN_PHASE(3, phase_mixers(p, 0, lds));
    RUN_PHASE(4, gemm_out(p, 0, lds));
    RUN_PHASE(5, gemm_in(p, 1, lds));
    RUN_PHASE(6, phase_stats(p, lds));
    RUN_PHASE(7, phase_mixers(p, 1, lds));
    RUN_PHASE(8, gemm_out(p, 1, lds));
    RUN_PHASE(9, phase_final(p));
#undef RUN_PHASE
}

extern "C" void kernel_launch(void* const* d_in, const int* in_sizes, int n_in, void* d_out, int out_size, void* d_ws, size_t ws_size, hipStream_t stream) {
    static int grid_blocks = 0;
    if (!grid_blocks) {
        int dev = 0, cus = 0, per_cu = 0;
        hipGetDevice(&dev);
        hipDeviceGetAttribute(&cus, hipDeviceAttributeMultiprocessorCount, dev);
        hipFuncSetAttribute((const void*)hymba_fwd, hipFuncAttributeMaxDynamicSharedMemorySize, LDS_BYTES);
        hipOccupancyMaxActiveBlocksPerMultiprocessor(&per_cu, (const void*)hymba_fwd, NTHREADS, LDS_BYTES);
        if (per_cu < 1) per_cu = 1;
        grid_blocks = cus * per_cu;
        if (ws_size < WS_END) fprintf(stderr, "kernel_launch: workspace too small (%zu < %zu)\n", ws_size, (size_t)WS_END);
    }
    Params p{};
    p.x = (const float*)d_in[0]; p.norm_g = (const float*)d_in[1]; p.w_in = (const float*)d_in[2]; p.conv_w = (const float*)d_in[3]; p.conv_b = (const float*)d_in[4];
    p.ln_g = (const float*)d_in[5]; p.ln_b = (const float*)d_in[6]; p.pw_w = (const float*)d_in[7]; p.pw_b = (const float*)d_in[8]; p.w_out = (const float*)d_in[9];
    p.final_g = (const float*)d_in[10]; p.out = (float*)d_out; p.ws = (unsigned char*)d_ws;
#if ONE_LAUNCH
    p.ph_lo = 0; p.ph_hi = NPHASES;
    { void* args[] = {&p};
      hipError_t e = hipLaunchCooperativeKernel((const void*)hymba_fwd, dim3(grid_blocks), dim3(NTHREADS), args, LDS_BYTES, stream);
      if (e != hipSuccess) fprintf(stderr, "cooperative launch failed: %s (grid %d)\n", hipGetErrorString(e), grid_blocks); }
#else
    for (int ph = 0; ph < NPHASES; ++ph) {
        p.ph_lo = ph; p.ph_hi = ph + 1; void* args[] = {&p};
        hipError_t e = hipLaunchCooperativeKernel((const void*)hymba_fwd, dim3(grid_blocks), dim3(NTHREADS), args, LDS_BYTES, stream);
        if (e != hipSuccess) { fprintf(stderr, "cooperative launch failed: %s (grid %d, phase %d)\n", hipGetErrorString(e), grid_blocks, ph); break; }
    }
#endif
}
```

```cpp
#include <hip/hip_runtime.h>
#include <hip/hip_cooperative_groups.h>
#include <cstdio>
#include <cstdint>
namespace cg = cooperative_groups;

#ifndef ONE_LAUNCH
#define ONE_LAUNCH 1
#endif

typedef _Float16 h16;
typedef _Float16 h16x8 __attribute__((ext_vector_type(8)));
typedef _Float16 h16x4 __attribute__((ext_vector_type(4)));
typedef float f32x16 __attribute__((ext_vector_type(16)));
typedef float f32x4 __attribute__((ext_vector_type(4)));
typedef unsigned u32x4 __attribute__((ext_vector_type(4)));

constexpr int BATCH = 8, SEQ = 4096, DM = 1024, MROWS = BATCH * SEQ, NIN = 3840, DEPTH = 2;
constexpr int C_AVAL = 0, C_AGLU = 256, C_AGATE = 512, C_RQ = 768, C_RK = 1024, C_RV = 1280, C_RGATE = 1536, C_MQ = 1792, C_MK = 2304, C_MV = 2816, C_MGATE = 3328;
constexpr int NPART = 16;
constexpr int NTHREADS = 512;
constexpr int LDS_BYTES = 147456;
constexpr int NPHASES = 10;

constexpr size_t MiB = 1u << 20;
constexpr size_t WS_XH = 0, WS_PROJ = 64 * MiB, WS_MIX = 304 * MiB, WS_WIN = 368 * MiB, WS_WOUT = 383 * MiB, WS_WPW = 387 * MiB,
                 WS_KV = 388 * MiB, WS_KMEAN = 404 * MiB  , WS_ROWSS = 405 * MiB, WS_END = 408 * MiB;

struct Params {
    const float *x, *norm_g, *w_in, *conv_w, *conv_b, *ln_g, *ln_b, *pw_w, *pw_b, *w_out, *final_g;
    float* out; unsigned char* ws;
    int ph_lo, ph_hi;
};

__device__ __forceinline__ float silu_f(float v) { return v / (1.0f + __expf(-v)); }
__device__ __forceinline__ int crow(int r, int h) { return (r & 3) + 8 * (r >> 2) + 4 * h; }
__device__ __forceinline__ float wave_sum(float v) {
#pragma unroll
    for (int o = 1; o < 64; o <<= 1) v += __shfl_xor(v, o);
    return v;
}

__device__ __forceinline__ void transpose_unit(const float* W, int K, int N, h16* WT, const float* g, int k0, int n0, float* tile) {
    const int tid = threadIdx.x;
    __syncthreads();
#pragma unroll
    for (int i = 0; i < 8; ++i) { const int k = i * 8 + (tid >> 6), n = tid & 63; float v = W[(size_t)(k0 + k) * N + n0 + n]; if (g) v *= g[k0 + k]; tile[k * 65 + n] = v; }
    __syncthreads();
#pragma unroll
    for (int i = 0; i < 8; ++i) { const int n = i * 8 + (tid >> 6), k = tid & 63; WT[(size_t)(n0 + n) * K + k0 + k] = (h16)tile[k * 65 + n]; }
}

__device__ __forceinline__ void phase_prologue(const Params& p, unsigned char* lds) {
    float* tile = (float*)lds;
    h16* win = (h16*)(p.ws + WS_WIN); h16* wout = (h16*)(p.ws + WS_WOUT); h16* wpw = (h16*)(p.ws + WS_WPW);
    constexpr int U_IN = 16 * 60, U_OUT = 16 * 16, U_PW = 4 * 4, U_L = U_IN + U_OUT + U_PW;
    for (int u = blockIdx.x; u < DEPTH * U_L; u += gridDim.x) {
        const int layer = u / U_L; int r = u % U_L;
        if (r < U_IN) { transpose_unit(p.w_in + (size_t)layer * DM * NIN, DM, NIN, win + (size_t)layer * NIN * DM, p.norm_g + layer * DM, (r / 60) * 64, (r % 60) * 64, tile); continue; }
        r -= U_IN;
        if (r < U_OUT) { transpose_unit(p.w_out + (size_t)layer * DM * DM, DM, DM, wout + (size_t)layer * DM * DM, nullptr, (r / 16) * 64, (r % 16) * 64, tile); continue; }
        r -= U_OUT;
        transpose_unit(p.pw_w + (size_t)layer * 256 * 256, 256, 256, wpw + (size_t)layer * 256 * 256, nullptr, (r / 4) * 64, (r % 4) * 64, tile);
    }
    h16* xh = (h16*)(p.ws + WS_XH); float* rowss = (float*)(p.ws + WS_ROWSS);
    const int lane = threadIdx.x & 63, wid = threadIdx.x >> 6;
    for (int row = blockIdx.x * 8 + wid; row < MROWS; row += gridDim.x * 8) {
        const f32x4* xr = (const f32x4*)(p.x + (size_t)row * DM) + lane;
        float ss = 0.f;
#pragma unroll
        for (int j = 0; j < 4; ++j) { const f32x4 v = xr[64 * j]; ss += v.x * v.x + v.y * v.y + v.z * v.z + v.w * v.w;
            h16x4 o; o.x = (h16)v.x; o.y = (h16)v.y; o.z = (h16)v.z; o.w = (h16)v.w; *((h16x4*)(xh + (size_t)row * DM) + lane + 64 * j) = o; }
        ss = wave_sum(ss);
        if (lane < NPART) rowss[(size_t)row * NPART + lane] = (lane == 0) ? ss : 0.f;
    }
}

typedef short s16x4 __attribute__((ext_vector_type(4)));
#define LAS __attribute__((address_space(3)))
__device__ __forceinline__ float xhalf_max(float v) { auto rr = __builtin_amdgcn_permlane32_swap(__float_as_uint(v), __float_as_uint(v), false, false); return fmaxf(__uint_as_float(rr[0]), __uint_as_float(rr[1])); }
__device__ __forceinline__ float xhalf_sum(float v) { auto rr = __builtin_amdgcn_permlane32_swap(__float_as_uint(v), __float_as_uint(v), false, false); return __uint_as_float(rr[0]) + __uint_as_float(rr[1]); }
__device__ __forceinline__ h16x8 tr_frag(const LAS unsigned char* a) {
    const s16x4 lo = __builtin_amdgcn_ds_read_tr16_b64_v4i16((LAS s16x4*)a), hi = __builtin_amdgcn_ds_read_tr16_b64_v4i16((LAS s16x4*)(a + 512));
    typedef short s16x8 __attribute__((ext_vector_type(8)));
    const s16x8 v = __builtin_shufflevector(lo, hi, 0, 1, 2, 3, 4, 5, 6, 7);
    return __builtin_bit_cast(h16x8, v);
}
#define CROW0(i) (((i) & 3) + 8 * ((i) >> 2))

namespace pg8 {
#define PG8_LAS __attribute__((address_space(3)))
typedef _Float16 bf16_t;
typedef _Float16 bf16x8 __attribute__((ext_vector_type(8)));
typedef float f32x4 __attribute__((ext_vector_type(4)));
typedef unsigned u32x4 __attribute__((ext_vector_type(4)));
constexpr int BM = 256, BK = 64, HALF = 128, HTB = HALF * BK * 2  , STAGE_BYTES = 8 * HTB, NXCD = 8, WGM = 8;

__host__ __device__ __forceinline__ int lds_byte(int r, int c) { const int st = (r >> 4) * 2 + (c >> 5), rr = r & 15, cc = c & 31, ob = rr * 64 + cc * 2; return st * 1024 + (ob ^ (((ob >> 9) & 1) << 5)); }
__host__ __device__ __forceinline__ void stage_rc(int b, int& R, int& C) { const int st = b / 1024, sb = b % 1024, swz = sb ^ (((sb >> 9) & 1) << 5); R = (st >> 1) * 16 + swz / 64; C = (st & 1) * 32 + (swz % 64) / 2; }
__host__ __device__ __forceinline__ int perm32(int rho) { const int n = rho >> 4, i = rho & 15; return 8 * (i >> 2) + 4 * n + (i & 3); }

struct Unit { int pm, pn; };
struct Gemm { const bf16_t* A; const bf16_t* Bt; int M, N, K; };

struct StaticOrder {
    int nM, nN, nwg, G, c;
    __host__ __device__ void init(int M, int N, int G_, int c_) { nM = M / BM; nN = N / BM; nwg = nM * nN; G = G_; c = c_; }
    __host__ __device__ bool next(int i, Unit& u) const {
        const long L = (long)i * G + c; if (L >= nwg) return false;
        int wgid = (int)L; { const int q = nwg / NXCD, r = nwg % NXCD, xcd = wgid % NXCD, off = wgid / NXCD; wgid = (xcd < r ? xcd * (q + 1) : r * (q + 1) + (xcd - r) * q) + off; }
        const int nig = WGM * nN, gid = wgid / nig, fm = gid * WGM, gsz = (nM - fm) < WGM ? (nM - fm) : WGM;
        u.pm = fm + ((wgid % nig) % gsz); u.pn = (wgid % nig) / gsz; return true;
    }
    __device__ __forceinline__ void a_ready(const Unit&) const {}
    __device__ __forceinline__ void done(const Unit&) const {}
};

template <class Epi, class Sched, bool ALIGN_EPI = false, bool SP2 = false>
__device__ __forceinline__ void gemm_phase(PG8_LAS unsigned char* lds, const Gemm g, const Sched& S, const Epi& E) {
    const int tid = threadIdx.x, wid = __builtin_amdgcn_readfirstlane(tid >> 6), lane = tid & 63, wr = wid >> 2, wc = wid & 3, fr = lane & 15, fq = lane >> 4;
    const int K = g.K, nt = K / BK;
    unsigned voffA[2], voffB[2];
#pragma unroll
    for (int i = 0; i < 2; ++i) { int R, C; stage_rc(tid * 16 + i * 8192, R, C); const int Rb = Epi::PERM ? ((R & ~31) + perm32(R & 31)) : R;
        voffA[i] = (unsigned)(R * K + C) * 2u; voffB[i] = (unsigned)(Rb * K + C) * 2u; }
    const size_t kstep = (size_t)(BK * 2);
    const size_t hstep = (size_t)HALF * K * 2;
    const size_t tstep = 2 * hstep;
    const unsigned ldsw = (unsigned)wid * 1024u;
    const int aoff = lds_byte(wr * 64 + fr, fq * 8), boff = lds_byte(wc * 32 + fr, fq * 8);
#define PG8_SA(b, h) (((b) * 2 + (h)) * HTB)
#define PG8_SB(b, h) ((4 + (b) * 2 + (h)) * HTB)
#define PG8_STAGE(bufoff, gbase, voff) do { _Pragma("unroll") for (int _i = 0; _i < 2; ++_i) \
        __builtin_amdgcn_global_load_lds((const unsigned*)((const char*)(gbase) + (voff)[_i]), (PG8_LAS unsigned*)(lds + (bufoff) + ldsw + _i * 8192), 16, 0, 0); } while (0)
#define PG8_LDA(dst, b, h) do { _Pragma("unroll") for (int m = 0; m < 4; ++m) _Pragma("unroll") for (int k = 0; k < 2; ++k) dst[m][k] = *(const PG8_LAS bf16x8*)(lds + PG8_SA(b, h) + aoff + m * 2048 + k * 1024); } while (0)
#define PG8_LDB(dst, b, h) do { _Pragma("unroll") for (int n = 0; n < 2; ++n) _Pragma("unroll") for (int k = 0; k < 2; ++k) dst[n][k] = *(const PG8_LAS bf16x8*)(lds + PG8_SB(b, h) + boff + n * 2048 + k * 1024); } while (0)
#define PG8_MMA(ai, bj, At, Bt) do { __builtin_amdgcn_s_setprio(1); _Pragma("unroll") for (int m = 0; m < 4; ++m) _Pragma("unroll") for (int n = 0; n < 2; ++n) _Pragma("unroll") for (int k = 0; k < 2; ++k) \
        acc[ai][bj][m][n] = __builtin_amdgcn_mfma_f32_16x16x32_f16(Bt[n][k], At[m][k], acc[ai][bj][m][n], 0, 0, 0); __builtin_amdgcn_s_setprio(0); } while (0)
#define PG8_WAIT_V(n) asm volatile("s_waitcnt vmcnt(" #n ")" ::: "memory")
#define PG8_WAIT_L(n) asm volatile("s_waitcnt lgkmcnt(" #n ")" ::: "memory")
#define PG8_BAR __builtin_amdgcn_s_barrier()
#define PG8_SCHED __builtin_amdgcn_sched_barrier(0)
    Unit cur, nxt; int ui = 0;
    if (!S.next(0, cur)) return;
    f32x4 acc[2][2][4][2];
#pragma unroll
    for (int a = 0; a < 2; ++a)
#pragma unroll
        for (int b = 0; b < 2; ++b)
#pragma unroll
            for (int m = 0; m < 4; ++m)
#pragma unroll
                for (int n = 0; n < 2; ++n) acc[a][b][m][n] = (f32x4){0.f, 0.f, 0.f, 0.f};
    bf16x8 At[4][2], B0[2][2], B1[2][2];
    const char* cA = (const char*)g.A + (size_t)cur.pm * tstep; const char* cB = (const char*)g.Bt + (size_t)cur.pn * tstep;
    S.a_ready(cur);
    if constexpr (SP2) {
        PG8_STAGE(PG8_SB(0, 0), cB, voffB); PG8_STAGE(PG8_SB(0, 1), cB + hstep, voffB); PG8_STAGE(PG8_SA(0, 0), cA, voffA); PG8_STAGE(PG8_SA(0, 1), cA + hstep, voffA);
        if (wr == 1) PG8_BAR;
        PG8_WAIT_V(2); PG8_BAR;
        PG8_STAGE(PG8_SB(1, 0), cB + kstep, voffB); PG8_STAGE(PG8_SA(1, 0), cA + kstep, voffA); PG8_STAGE(PG8_SB(1, 1), cB + hstep + kstep, voffB);
        PG8_WAIT_V(6); PG8_BAR;
    } else {
        PG8_STAGE(PG8_SB(0, 0), cB, voffB); PG8_STAGE(PG8_SA(0, 0), cA, voffA); PG8_STAGE(PG8_SB(0, 1), cB + hstep, voffB); PG8_STAGE(PG8_SA(0, 1), cA + hstep, voffA);
        if (wr == 1) PG8_BAR;
        PG8_WAIT_V(4); PG8_BAR;
        PG8_STAGE(PG8_SB(1, 0), cB + kstep, voffB); PG8_STAGE(PG8_SA(1, 0), cA + kstep, voffA); PG8_STAGE(PG8_SB(1, 1), cB + hstep + kstep, voffB);
        PG8_WAIT_V(6); PG8_BAR;
    }
    for (;;) {
        const bool has_next = S.next(ui + 1, nxt);
        const char* nA = has_next ? (const char*)g.A + (size_t)nxt.pm * tstep : cA; const char* nB = has_next ? (const char*)g.Bt + (size_t)nxt.pn * tstep : cB;
        for (int t = 0; t < nt; t += 2) {
            const bool last = (t == nt - 2);
            const char* a1 = cA + (size_t)(t + 1) * kstep;
            const char* a2 = last ? nA : cA + (size_t)(t + 2) * kstep; const char* b2 = last ? nB : cB + (size_t)(t + 2) * kstep;
            const char* a3 = a2 + kstep; const char* b3 = b2 + kstep;
            if (last && has_next) S.a_ready(nxt);
            if constexpr (SP2) {
            PG8_LDB(B0, 0, 0); PG8_LDB(B1, 0, 1); PG8_SCHED; PG8_LDA(At, 0, 0); PG8_STAGE(PG8_SA(1, 1), a1 + hstep, voffA);
            PG8_WAIT_V(8); PG8_WAIT_L(0); PG8_BAR; PG8_MMA(0, 0, At, B0); PG8_MMA(0, 1, At, B1); PG8_BAR; PG8_SCHED;
            PG8_LDA(At, 0, 1); PG8_STAGE(PG8_SB(0, 0), b2, voffB); PG8_STAGE(PG8_SB(0, 1), b2 + hstep, voffB); PG8_STAGE(PG8_SA(0, 0), a2, voffA);
            PG8_WAIT_V(8); PG8_WAIT_L(0); PG8_BAR; PG8_MMA(1, 0, At, B0); PG8_MMA(1, 1, At, B1); PG8_BAR; PG8_SCHED;
            PG8_LDB(B0, 1, 0); PG8_LDB(B1, 1, 1); PG8_SCHED; PG8_LDA(At, 1, 0); PG8_STAGE(PG8_SA(0, 1), a2 + hstep, voffA);
            PG8_WAIT_V(8); PG8_WAIT_L(0); PG8_BAR; PG8_MMA(0, 0, At, B0); PG8_MMA(0, 1, At, B1); PG8_BAR; PG8_SCHED;
            PG8_LDA(At, 1, 1); PG8_STAGE(PG8_SB(1, 0), b3, voffB); PG8_STAGE(PG8_SB(1, 1), b3 + hstep, voffB); PG8_STAGE(PG8_SA(1, 0), a3, voffA);
            PG8_WAIT_V(8); PG8_WAIT_L(0); PG8_BAR; PG8_MMA(1, 0, At, B0); PG8_MMA(1, 1, At, B1); PG8_BAR; PG8_SCHED;
            } else {
            PG8_LDB(B0, 0, 0); PG8_SCHED; PG8_LDA(At, 0, 0); PG8_STAGE(PG8_SA(1, 1), a1 + hstep, voffA);
            PG8_WAIT_L(8); PG8_BAR; PG8_WAIT_L(0); PG8_MMA(0, 0, At, B0); PG8_BAR; PG8_SCHED;
            PG8_LDB(B1, 0, 1); PG8_STAGE(PG8_SB(0, 0), b2, voffB);
            PG8_BAR; PG8_WAIT_L(0); PG8_MMA(0, 1, At, B1); PG8_BAR;
            PG8_LDA(At, 0, 1); PG8_STAGE(PG8_SA(0, 0), a2, voffA);
            PG8_BAR; PG8_WAIT_L(0); PG8_MMA(1, 0, At, B0); PG8_BAR; PG8_SCHED;
            PG8_STAGE(PG8_SB(0, 1), b2 + hstep, voffB);
            PG8_WAIT_V(6); PG8_BAR; PG8_MMA(1, 1, At, B1); PG8_BAR;
            PG8_LDB(B0, 1, 0); PG8_SCHED; PG8_LDA(At, 1, 0); PG8_STAGE(PG8_SA(0, 1), a2 + hstep, voffA);
            PG8_WAIT_L(8); PG8_BAR; PG8_WAIT_L(0); PG8_MMA(0, 0, At, B0); PG8_BAR; PG8_SCHED;
            PG8_LDB(B1, 1, 1); PG8_STAGE(PG8_SB(1, 0), b3, voffB);
            PG8_BAR; PG8_WAIT_L(0); PG8_MMA(0, 1, At, B1); PG8_BAR;
            PG8_LDA(At, 1, 1); PG8_STAGE(PG8_SA(1, 0), a3, voffA);
            PG8_BAR; PG8_WAIT_L(0); PG8_MMA(1, 0, At, B0); PG8_BAR; PG8_SCHED;
            PG8_STAGE(PG8_SB(1, 1), b3 + hstep, voffB);
            PG8_WAIT_V(6); PG8_BAR; PG8_MMA(1, 1, At, B1); PG8_BAR;
            }
        }
        if constexpr (ALIGN_EPI) { if (wr == 0) PG8_BAR; }
        if constexpr (!Epi::AFTER_DRAIN) { E(acc, cur, wr, wc, fr, fq); S.done(cur); }
        if (!has_next) break;
#pragma unroll
        for (int a = 0; a < 2; ++a)
#pragma unroll
            for (int b = 0; b < 2; ++b)
#pragma unroll
                for (int m = 0; m < 4; ++m)
#pragma unroll
                    for (int n = 0; n < 2; ++n) acc[a][b][m][n] = (f32x4){0.f, 0.f, 0.f, 0.f};
        cur = nxt; cA = nA; cB = nB; ++ui;
        if constexpr (ALIGN_EPI) { if (wr == 1) PG8_BAR; }
    }
    PG8_WAIT_V(0);
    if constexpr (!ALIGN_EPI) { if (wr == 0) PG8_BAR; }
    PG8_BAR;
    if constexpr (Epi::AFTER_DRAIN) { E.fused(acc, cur, wr, wc, fr, fq, lds, wid, lane); S.done(cur); }
#undef PG8_SA
#undef PG8_SB
#undef PG8_STAGE
#undef PG8_LDA
#undef PG8_LDB
#undef PG8_MMA
#undef PG8_WAIT_V
#undef PG8_WAIT_L
#undef PG8_BAR
#undef PG8_SCHED
}

struct EpiProj {
    static constexpr bool PERM = true, AFTER_DRAIN = false;
    bf16_t* O; const float* rowss; float* kmpart;
    __device__ __forceinline__ void operator()(const f32x4 (&acc)[2][2][4][2], const Unit& u, int wr, int wc, int fr, int fq) const {
        const int row0 = u.pm * BM + wr * 64 + fr, col0 = u.pn * BM + wc * 32 + 8 * fq;
        const bool want_km = (u.pn == 9) || (u.pn == 10);
        f32x4 cs[2][2];
#pragma unroll
        for (int bj = 0; bj < 2; ++bj)
#pragma unroll
            for (int n = 0; n < 2; ++n) cs[bj][n] = (f32x4){0.f, 0.f, 0.f, 0.f};
#pragma unroll
        for (int ai = 0; ai < 2; ++ai)
#pragma unroll
            for (int m = 0; m < 4; ++m) { const size_t row = (size_t)(row0 + ai * HALF + m * 16);
                const f32x4* rs = (const f32x4*)(rowss + row * 16); const f32x4 s0 = rs[0], s1 = rs[1], s2 = rs[2], s3 = rs[3];
                const float tot = ((s0[0] + s0[1]) + (s0[2] + s0[3])) + ((s1[0] + s1[1]) + (s1[2] + s1[3])) + ((s2[0] + s2[1]) + (s2[2] + s2[3])) + ((s3[0] + s3[1]) + (s3[2] + s3[3]));
                const float rstd = rsqrtf(tot * (1.0f / 1024.0f) + 1e-6f);
                bf16_t* rowp = O + row * 3840 + col0;
#pragma unroll
                for (int bj = 0; bj < 2; ++bj) { const f32x4 v0 = acc[ai][bj][m][0] * rstd, v1 = acc[ai][bj][m][1] * rstd; bf16x8 w;
                    w[0] = (bf16_t)v0[0]; w[1] = (bf16_t)v0[1]; w[2] = (bf16_t)v0[2]; w[3] = (bf16_t)v0[3]; w[4] = (bf16_t)v1[0]; w[5] = (bf16_t)v1[1]; w[6] = (bf16_t)v1[2]; w[7] = (bf16_t)v1[3];
                    *(bf16x8*)(rowp + bj * HALF) = w; cs[bj][0] += v0; cs[bj][1] += v1; } }
        if (want_km) {
#pragma unroll
            for (int bj = 0; bj < 2; ++bj)
#pragma unroll
                for (int n = 0; n < 2; ++n)
#pragma unroll
                    for (int k = 0; k < 4; ++k) { float v = cs[bj][n][k]; v += __shfl_xor(v, 1); v += __shfl_xor(v, 2); v += __shfl_xor(v, 4); v += __shfl_xor(v, 8); cs[bj][n][k] = v * (1.0f / 256.0f); }
            if (fr == 0) {
#pragma unroll
                for (int bj = 0; bj < 2; ++bj)
#pragma unroll
                    for (int n = 0; n < 2; ++n) { const int cm = col0 + bj * HALF + 4 * n - 2304;
                        *(f32x4*)(kmpart + ((size_t)((wr * 8 + (u.pm >> 4)) * 8 + (cm >> 6)) * 16 + (u.pm & 15)) * 64 + (cm & 63)) = cs[bj][n]; }
            }
        }
    }
};
struct EpiRes {
    static constexpr bool PERM = true, AFTER_DRAIN = false;
    const float* xold; float* xnew; bf16_t* xh; float* rowss;
    __device__ __forceinline__ void operator()(const f32x4 (&acc)[2][2][4][2], const Unit& u, int wr, int wc, int fr, int fq) const {
        const int row0 = u.pm * BM + wr * 64 + fr, col0 = u.pn * BM + wc * 32 + 8 * fq;
#pragma unroll
        for (int ai = 0; ai < 2; ++ai)
#pragma unroll
            for (int m = 0; m < 4; ++m) { const size_t row = (size_t)(row0 + ai * HALF + m * 16); float ss = 0.f;
#pragma unroll
                for (int bj = 0; bj < 2; ++bj) { const size_t off = row * 1024 + col0 + bj * HALF;
                    const f32x4 v0 = *(const f32x4*)(xold + off) + acc[ai][bj][m][0], v1 = *(const f32x4*)(xold + off + 4) + acc[ai][bj][m][1];
                    *(f32x4*)(xnew + off) = v0; *(f32x4*)(xnew + off + 4) = v1; bf16x8 w;
                    w[0] = (bf16_t)v0[0]; w[1] = (bf16_t)v0[1]; w[2] = (bf16_t)v0[2]; w[3] = (bf16_t)v0[3]; w[4] = (bf16_t)v1[0]; w[5] = (bf16_t)v1[1]; w[6] = (bf16_t)v1[2]; w[7] = (bf16_t)v1[3];
                    *(bf16x8*)(xh + off) = w;
                    ss += ((v0[0] * v0[0] + v0[1] * v0[1]) + (v0[2] * v0[2] + v0[3] * v0[3])) + ((v1[0] * v1[0] + v1[1] * v1[1]) + (v1[2] * v1[2] + v1[3] * v1[3])); }
                ss += __shfl_xor(ss, 16); ss += __shfl_xor(ss, 32);
                if (fq == 0) rowss[row * 16 + u.pn * 4 + wc] = ss; }
    }
};
}


__device__ __forceinline__ void gemm_in(const Params& p, int layer, unsigned char* lds) {
    pg8::Gemm g{(const h16*)(p.ws + WS_XH), (const h16*)(p.ws + WS_WIN) + (size_t)layer * NIN * DM, MROWS, NIN, DM};
    pg8::StaticOrder S; S.init(MROWS, NIN, (int)gridDim.x, (int)blockIdx.x);
    pg8::EpiProj E{(h16*)(p.ws + WS_PROJ), (const float*)(p.ws + WS_ROWSS), (float*)(p.ws + WS_KMEAN)};
    pg8::gemm_phase<pg8::EpiProj, pg8::StaticOrder, true, true>((PG8_LAS unsigned char*)lds, g, S, E);
}
__device__ __forceinline__ void gemm_out(const Params& p, int layer, unsigned char* lds) {
    pg8::Gemm g{(const h16*)(p.ws + WS_MIX), (const h16*)(p.ws + WS_WOUT) + (size_t)layer * DM * DM, MROWS, DM, DM};
    pg8::StaticOrder S; S.init(MROWS, DM, (int)gridDim.x, (int)blockIdx.x);
    pg8::EpiRes E{(layer == 0) ? p.x : p.out, p.out, (h16*)(p.ws + WS_XH), (float*)(p.ws + WS_ROWSS)};
    pg8::gemm_phase<pg8::EpiRes, pg8::StaticOrder, true, true>((PG8_LAS unsigned char*)lds, g, S, E);
}

__device__ __forceinline__ void phase_stats(const Params& p, unsigned char* lds_g) {
    LAS unsigned char* lds = (LAS unsigned char*)lds_g;
    const h16* proj = (const h16*)(p.ws + WS_PROJ); float* kv = (float*)(p.ws + WS_KV);
    const int tid = threadIdx.x, lane = tid & 63, wid = __builtin_amdgcn_readfirstlane(tid >> 6), r = lane & 31, hi = lane >> 5;
    const int lanepart = (4 * hi + ((lane & 15) >> 2)) * 64 + ((lane >> 4) & 1) * 32 + (lane & 3) * 8;
#pragma unroll 1
    for (int u = blockIdx.x; u < 512; u += gridDim.x) {
        const int b = u >> 6, hh = (u >> 4) & 3, np = u & 15;
        const float log_g = logf(1.0f - exp2f(-5.0f - (float)hh));
        __syncthreads();
#pragma unroll
        for (int it = 0; it < 4; ++it) {
            const int pc = tid + 512 * it, cn = pc >> 10, key = (pc >> 3) & 127, ch = pc & 7;
            const h16* src = proj + (size_t)(b * SEQ + (2 * np + cn) * 128 + key) * NIN + hh * 64 + ch * 8;
            h16x8 kk = *(const h16x8*)(src + C_RK); const h16x8 vv = *(const h16x8*)(src + C_RV);
            const float z = __expf(log_g * (float)(127 - key)) * 0.125f;
#pragma unroll
            for (int k = 0; k < 8; ++k) kk[k] = (h16)((float)kk[k] * z);
            const int off = cn * 32768 + (ch >> 2) * 8192 + (key >> 4) * 1024 + (key & 15) * 64 + (ch & 3) * 16;
            *(LAS h16x8*)(lds + off) = kk; *(LAS h16x8*)(lds + off + 16384) = vv;
        }
        __syncthreads();
        const int cn = wid >> 2, eb = (wid >> 1) & 1, dbk = wid & 1;
        const LAS unsigned char* kimg = lds + cn * 32768 + dbk * 8192 + lanepart; const LAS unsigned char* vimg = lds + cn * 32768 + 16384 + eb * 8192 + lanepart;
        f32x16 acc;
#pragma unroll
        for (int i = 0; i < 16; ++i) acc[i] = 0.f;
#pragma unroll
        for (int ks = 0; ks < 8; ++ks) acc = __builtin_amdgcn_mfma_f32_32x32x16_f16(tr_frag(vimg + ks * 1024), tr_frag(kimg + ks * 1024), acc, 0, 0, 0);
        float* dst = kv + ((size_t)((b * 4 + hh) * 32 + 2 * np + cn)) * 4096 + (32 * eb + 4 * hi) * 64 + 32 * dbk + r;
#pragma unroll
        for (int i = 0; i < 16; ++i) dst[CROW0(i) * 64] = acc[i];
    }
}

typedef _Float16 h16x2 __attribute__((ext_vector_type(2)));
typedef float f32x2 __attribute__((ext_vector_type(2)));
__device__ __forceinline__ void conv_unit(const Params& p, int layer, int b, int tt, unsigned char* lds_g) {
    LAS unsigned char* lds = (LAS unsigned char*)lds_g;
    const h16* projb = (const h16*)(p.ws + WS_PROJ) + (size_t)b * SEQ * NIN; h16* mix = (h16*)(p.ws + WS_MIX);
    const int tid = threadIdx.x, lane = tid & 63, wid = __builtin_amdgcn_readfirstlane(tid >> 6), r = lane & 31, hi = lane >> 5;
    const int cp = tid & 127, tg = __builtin_amdgcn_readfirstlane(tid >> 7), t0 = tt * 64, tb0 = t0 + 16 * tg - 30;
    constexpr int YS = 0, SIMG = 65536;
    float y0[16], y1[16];
    {
        float w0[31], w1[31]; const float* cw = p.conv_w + (size_t)layer * 31 * 256 + 2 * cp;
#pragma unroll
        for (int jj = 0; jj < 31; ++jj) { const f32x2 wv = *(const f32x2*)(cw + jj * 256); w0[jj] = wv[0]; w1[jj] = wv[1]; }
        const f32x2 cbv = *(const f32x2*)(p.conv_b + layer * 256 + 2 * cp);
#pragma unroll
        for (int tl = 0; tl < 16; ++tl) { y0[tl] = cbv[0]; y1[tl] = cbv[1]; }
#pragma unroll
        for (int rr = 0; rr < 46; ++rr) {
            const int t = tb0 + rr; float a0 = 0.f, a1 = 0.f;
            if (t >= 0) { const h16x2 av = *(const h16x2*)(projb + (size_t)t * NIN + C_AVAL + 2 * cp), gv = *(const h16x2*)(projb + (size_t)t * NIN + C_AGLU + 2 * cp);
                a0 = (float)av[0] / (1.0f + __expf(-(float)gv[0])); a1 = (float)av[1] / (1.0f + __expf(-(float)gv[1])); }
#pragma unroll
            for (int tl = 0; tl < 16; ++tl) { const int jj = rr - tl; if (jj >= 0 && jj < 31) { y0[tl] += w0[jj] * a0; y1[tl] += w1[jj] * a1; } }
        }
    }
    __syncthreads();
#pragma unroll
    for (int tl = 0; tl < 16; ++tl) *(LAS f32x2*)(lds + YS + ((16 * tg + tl) * 256 + 2 * cp) * 4) = (f32x2){y0[tl], y1[tl]};
    h16x8 wf[16];
    {
        const h16* wp = (const h16*)(p.ws + WS_WPW) + (size_t)layer * 65536 + (size_t)(32 * wid + r) * 256 + 8 * hi;
#pragma unroll
        for (int ks = 0; ks < 16; ++ks) wf[ks] = *(const h16x8*)(wp + 16 * ks);
    }
    __syncthreads();
    {
        const f32x4 lg = *(const f32x4*)(p.ln_g + layer * 256 + lane * 4), lb = *(const f32x4*)(p.ln_b + layer * 256 + lane * 4);
#pragma unroll 2
        for (int k = 0; k < 8; ++k) { const int t = wid * 8 + k; f32x4 v = *(const LAS f32x4*)(lds + YS + (t * 256 + lane * 4) * 4);
            const float mu = wave_sum((v[0] + v[1]) + (v[2] + v[3])) * (1.0f / 256.0f);
            v = v - mu; const float var = wave_sum((v[0] * v[0] + v[1] * v[1]) + (v[2] * v[2] + v[3] * v[3])) * (1.0f / 256.0f); const float rs = rsqrtf(var + 1e-5f);
            h16x4 o; o[0] = (h16)silu_f(v[0] * rs * lg[0] + lb[0]); o[1] = (h16)silu_f(v[1] * rs * lg[1] + lb[1]); o[2] = (h16)silu_f(v[2] * rs * lg[2] + lb[2]); o[3] = (h16)silu_f(v[3] * rs * lg[3] + lb[3]);
            *(LAS h16x4*)(lds + SIMG + t * 512 + (((lane >> 1) ^ (t & 15)) << 4) + 8 * (lane & 1)) = o; }
    }
    __syncthreads();
#pragma unroll
    for (int tb = 0; tb < 2; ++tb) {
        f32x16 acc;
#pragma unroll
        for (int i = 0; i < 16; ++i) acc[i] = 0.f;
#pragma unroll
        for (int ks = 0; ks < 16; ++ks) acc = __builtin_amdgcn_mfma_f32_32x32x16_f16(wf[ks], *(const LAS h16x8*)(lds + SIMG + (32 * tb + r) * 512 + (((2 * ks + hi) ^ (r & 15)) << 4)), acc, 0, 0, 0);
        const int t = t0 + 32 * tb + r, n0 = 32 * wid + 4 * hi;
        const h16* gp = projb + (size_t)t * NIN + C_AGATE + n0; h16* dst = mix + ((size_t)b * SEQ + t) * DM + n0; const float* pb = p.pw_b + layer * 256 + n0;
#pragma unroll
        for (int g = 0; g < 4; ++g) { const h16x4 ga = *(const h16x4*)(gp + 8 * g); const f32x4 bb = *(const f32x4*)(pb + 8 * g); h16x4 oa;
#pragma unroll
            for (int k = 0; k < 4; ++k) oa[k] = (h16)((acc[4 * g + k] + bb[k]) * silu_f((float)ga[k]));
            *(h16x4*)(dst + 8 * g) = oa; }
    }
}

__device__ __forceinline__ void ret_unit(const Params& p, int b, int hh, int n, unsigned char* lds_g) {
    LAS unsigned char* lds = (LAS unsigned char*)lds_g;
    const h16* projb = (const h16*)(p.ws + WS_PROJ) + (size_t)(b * SEQ + n * 128) * NIN; h16* mix = (h16*)(p.ws + WS_MIX); const float* kv = (const float*)(p.ws + WS_KV);
    const int tid = threadIdx.x, lane = tid & 63, wid = __builtin_amdgcn_readfirstlane(tid >> 6), r = lane & 31, hi = lane >> 5, g4 = wid & 3, eh = wid >> 2;
    const float log_g = logf(1.0f - exp2f(-5.0f - (float)hh)); const float g_chunk = expf(log_g * 128.0f), gam = 1.0f - exp2f(-5.0f - (float)hh);
    constexpr int KIMG = 0, VIMG = 16384, RIMG = 32768, XS = 40960;
    f32x4 ra = (f32x4){0.f, 0.f, 0.f, 0.f}, rb = (f32x4){0.f, 0.f, 0.f, 0.f};
    {
        const float* kvb = kv + ((size_t)(b * 4 + hh) * 32) * 4096 + tid * 8;
#pragma unroll 4
        for (int m = 0; m < n; ++m) { ra = ra * g_chunk + *(const f32x4*)(kvb + (size_t)m * 4096); rb = rb * g_chunk + *(const f32x4*)(kvb + (size_t)m * 4096 + 4); }
    }
    __syncthreads();
    {
        h16x8 rr;
#pragma unroll
        for (int k = 0; k < 4; ++k) { rr[k] = (h16)(ra[k] * gam); rr[4 + k] = (h16)(rb[k] * gam); }
        const int e = tid >> 3, ch = tid & 7;
        *(LAS h16x8*)(lds + RIMG + e * 128 + ((ch ^ ((e >> 1) & 7)) << 4)) = rr;
#pragma unroll
        for (int it = 0; it < 2; ++it) {
            const int key = (tid >> 3) + 64 * it;
            h16x8 kk = *(const h16x8*)(projb + (size_t)key * NIN + C_RK + hh * 64 + ch * 8); const h16x8 vv = *(const h16x8*)(projb + (size_t)key * NIN + C_RV + hh * 64 + ch * 8);
            const float z = __expf(-log_g * (float)key) * 0.125f;
#pragma unroll
            for (int k = 0; k < 8; ++k) kk[k] = (h16)((float)kk[k] * z);
            *(LAS h16x8*)(lds + KIMG + key * 128 + ((ch ^ ((key >> 1) & 7)) << 4)) = kk;
            *(LAS h16x8*)(lds + VIMG + (ch >> 2) * 8192 + (key >> 4) * 1024 + (key & 15) * 64 + (ch & 3) * 16) = vv;
        }
    }
    const int qi = 32 * g4 + r;
    h16x8 qf[4];
    {
        const float zq = __expf(log_g * (float)qi);
#pragma unroll
        for (int s = 0; s < 4; ++s) { qf[s] = *(const h16x8*)(projb + (size_t)qi * NIN + C_RQ + hh * 64 + 16 * s + 8 * hi);
#pragma unroll
            for (int k = 0; k < 8; ++k) qf[s][k] = (h16)((float)qf[s][k] * zq); }
    }
    __syncthreads();
    const int rsw = (r >> 1) & 7;
    const int lanepart = (4 * hi + ((lane & 15) >> 2)) * 64 + ((lane >> 4) & 1) * 32 + (lane & 3) * 8;
    f32x16 o;
#pragma unroll
    for (int i = 0; i < 16; ++i) o[i] = 0.f;
#pragma unroll 1
    for (int jb = 0; jb <= g4; ++jb) {
        f32x16 c;
#pragma unroll
        for (int i = 0; i < 16; ++i) c[i] = 0.f;
#pragma unroll
        for (int s = 0; s < 4; ++s) c = __builtin_amdgcn_mfma_f32_32x32x16_f16(*(const LAS h16x8*)(lds + KIMG + (32 * jb + r) * 128 + (((2 * s + hi) ^ rsw) << 4)), qf[s], c, 0, 0, 0);
        if (jb == g4) {
#pragma unroll
            for (int i = 0; i < 16; ++i) if (CROW0(i) + 4 * hi > r) c[i] = 0.f;
        }
        h16x8 pf0, pf1;
#pragma unroll
        for (int k = 0; k < 8; ++k) { pf0[k] = (h16)c[k]; pf1[k] = (h16)c[8 + k]; }
        o = __builtin_amdgcn_mfma_f32_32x32x16_f16(tr_frag(lds + VIMG + eh * 8192 + (2 * jb) * 1024 + lanepart), pf0, o, 0, 0, 0);
        o = __builtin_amdgcn_mfma_f32_32x32x16_f16(tr_frag(lds + VIMG + eh * 8192 + (2 * jb + 1) * 1024 + lanepart), pf1, o, 0, 0, 0);
    }
#pragma unroll
    for (int s = 0; s < 4; ++s) o = __builtin_amdgcn_mfma_f32_32x32x16_f16(*(const LAS h16x8*)(lds + RIMG + (32 * eh + r) * 128 + (((2 * s + hi) ^ rsw) << 4)), qf[s], o, 0, 0, 0);
    float s1 = 0.f, s2 = 0.f;
#pragma unroll
    for (int i = 0; i < 16; ++i) { s1 += o[i]; s2 += o[i] * o[i]; }
    s1 = xhalf_sum(s1); s2 = xhalf_sum(s2);
    LAS float* xs = (LAS float*)(lds + XS);
    if (hi == 0) { xs[(wid * 32 + r) * 2] = s1; xs[(wid * 32 + r) * 2 + 1] = s2; }
    __syncthreads();
    {
        const float t1 = xs[((wid ^ 4) * 32 + r) * 2], t2 = xs[((wid ^ 4) * 32 + r) * 2 + 1];
        const float a1 = (eh == 0) ? (s1 + t1) : (t1 + s1), a2 = (eh == 0) ? (s2 + t2) : (t2 + s2);
        const float mu = a1 * (1.0f / 64.0f); const float var = fmaxf(a2 * (1.0f / 64.0f) - mu * mu, 0.f); const float rs = rsqrtf(var + 1e-5f);
        const int col = hh * 64 + 32 * eh + 4 * hi;
        const h16* gp = projb + (size_t)qi * NIN + C_RGATE + col; h16* dst = mix + ((size_t)(b * SEQ + n * 128 + qi)) * DM + 256 + col;
#pragma unroll
        for (int g = 0; g < 4; ++g) { const h16x4 ga = *(const h16x4*)(gp + 8 * g); h16x4 oa;
#pragma unroll
            for (int k = 0; k < 4; ++k) oa[k] = (h16)((o[4 * g + k] - mu) * rs * silu_f((float)ga[k]));
            *(h16x4*)(dst + 8 * g) = oa; }
    }
}

constexpr float MOBA_THR = 8.0f;
__device__ __forceinline__ void moba_unit(const Params& p, int b, int hh, int j, unsigned char* lds_g) {
    LAS unsigned char* lds = (LAS unsigned char*)lds_g;
    const int tid = threadIdx.x, lane = tid & 63, wid = __builtin_amdgcn_readfirstlane(tid >> 6), r = lane & 31, hi = lane >> 5;
    const h16* projb = (const h16*)(p.ws + WS_PROJ) + (size_t)b * SEQ * NIN; h16* mix = (h16*)(p.ws + WS_MIX);
    const int qrow = j * 256 + wid * 32 + r;
    h16x8 qf[4];
#pragma unroll
    for (int s = 0; s < 4; ++s) qf[s] = *(const h16x8*)(projb + (size_t)qrow * NIN + C_MQ + hh * 64 + 16 * s + 8 * hi);
    unsigned selmask = 0u;
    if (j <= 3) selmask = (1u << j) - 1u;
    else {
        float g0 = -3.0e38f, g1 = -3.0e38f, g2 = -3.0e38f; int i0 = 0, i1 = 0, i2 = 0;
        const float* km = (const float*)(p.ws + WS_KMEAN) + ((size_t)(b * 8 + hh) * 16) * 64 + 8 * hi;
#pragma unroll 1
        for (int n = 0; n < j; ++n) { float s = 0.f;
#pragma unroll
            for (int ss = 0; ss < 4; ++ss) { const f32x4 k0 = *(const f32x4*)(km + n * 64 + 16 * ss) + *(const f32x4*)(km + 65536 + n * 64 + 16 * ss),
                                                             k1 = *(const f32x4*)(km + n * 64 + 16 * ss + 4) + *(const f32x4*)(km + 65536 + n * 64 + 16 * ss + 4);
                s += (float)qf[ss][0] * k0.x + (float)qf[ss][1] * k0.y + (float)qf[ss][2] * k0.z + (float)qf[ss][3] * k0.w
                   + (float)qf[ss][4] * k1.x + (float)qf[ss][5] * k1.y + (float)qf[ss][6] * k1.z + (float)qf[ss][7] * k1.w; }
            s = xhalf_sum(s);
            if (s > g0) { g2 = g1; i2 = i1; g1 = g0; i1 = i0; g0 = s; i0 = n; }
            else if (s > g1) { g2 = g1; i2 = i1; g1 = s; i1 = n; }
            else if (s > g2) { g2 = s; i2 = n; } }
        selmask = (1u << i0) | (1u << i1) | (1u << i2);
    }
    constexpr float C2 = 0.125f * 1.4426950408889634f;
#pragma unroll
    for (int s = 0; s < 4; ++s)
#pragma unroll
        for (int k = 0; k < 8; ++k) qf[s][k] = (h16)((float)qf[s][k] * C2);
    const float slope2 = exp2f(-(float)(hh + 1)) * 1.4426950408889634f;
    f32x16 o0, o1;
#pragma unroll
    for (int i = 0; i < 16; ++i) { o0[i] = 0.f; o1[i] = 0.f; }
    float mref = 0.f, lsum = 0.f; bool first = true;
    const int skey = tid >> 3, sch = tid & 7;
    const h16* gk = projb + (size_t)skey * NIN + C_MK + hh * 64 + sch * 8;
    const int wK = skey * 128 + ((sch ^ ((skey >> 1) & 7)) << 4);
    const int wV = 8192 + (sch >> 2) * 4096 + (skey >> 4) * 1024 + (skey & 15) * 64 + (sch & 3) * 16;
    const int rK = r * 128, rsw = (r >> 1) & 7;
    const int rV = 8192 + (4 * hi + ((lane & 15) >> 2)) * 64 + ((lane >> 4) & 1) * 32 + (lane & 3) * 8;
    const int nt = 4 * (j + 1);
    int kp = j * 256 + 192;
    u32x4 rk = *(const u32x4*)(gk + (size_t)kp * NIN), rv = *(const u32x4*)(gk + (size_t)kp * NIN + (C_MV - C_MK));
    __syncthreads();
    *(LAS u32x4*)(lds + wK) = rk; *(LAS u32x4*)(lds + wV) = rv;
    __syncthreads();
#pragma unroll 1
    for (int tt = 0; tt < nt; ++tt) {
        const LAS unsigned char* buf = lds + (tt & 1) * 16384;
        if (tt + 1 < nt) { rk = *(const u32x4*)(gk + (size_t)(kp - 64) * NIN); rv = *(const u32x4*)(gk + (size_t)(kp - 64) * NIN + (C_MV - C_MK)); }
        const int nblk = kp >> 8; const bool own = (nblk == j); const int tloc = (kp >> 6) & 3;
        bool valid = true, act, diag = false;
        if (own) { act = tloc <= (wid >> 1); diag = tloc == (wid >> 1); }
        else { valid = (selmask >> nblk) & 1u; act = __any(valid); }
        if (act) {
            const float tbh = valid ? (slope2 * (float)(kp - qrow + 4 * hi) - mref) : -INFINITY;
            f32x16 c0, c1;
#pragma unroll
            for (int i = 0; i < 16; ++i) { c0[i] = fmaf(slope2, (float)CROW0(i), tbh); c1[i] = fmaf(slope2, (float)(CROW0(i) + 32), tbh); }
            if (diag) { const int lim2 = 32 * wid - 64 * tloc + r - 4 * hi;
#pragma unroll
                for (int i = 0; i < 16; ++i) { if (CROW0(i) > lim2) c0[i] = -INFINITY; if (CROW0(i) + 32 > lim2) c1[i] = -INFINITY; } }
#pragma unroll
            for (int s = 0; s < 4; ++s) {
                const h16x8 k0 = *(const LAS h16x8*)(buf + rK + (((2 * s + hi) ^ rsw) << 4)), k1 = *(const LAS h16x8*)(buf + rK + 4096 + (((2 * s + hi) ^ rsw) << 4));
                c0 = __builtin_amdgcn_mfma_f32_32x32x16_f16(k0, qf[s], c0, 0, 0, 0);
                c1 = __builtin_amdgcn_mfma_f32_32x32x16_f16(k1, qf[s], c1, 0, 0, 0);
            }
            float rm = fmaxf(c0[0], c1[0]);
#pragma unroll
            for (int i = 1; i < 16; ++i) rm = fmaxf(rm, fmaxf(c0[i], c1[i]));
            rm = xhalf_max(rm);
            if (first) { first = false; mref = rm;
#pragma unroll
                for (int i = 0; i < 16; ++i) { c0[i] -= rm; c1[i] -= rm; } }
            else if (__any(rm > MOBA_THR)) { const float dl = fmaxf(rm, 0.f); mref += dl; const float f = __builtin_amdgcn_exp2f(-dl); lsum *= f;
#pragma unroll
                for (int i = 0; i < 16; ++i) { c0[i] -= dl; c1[i] -= dl; o0[i] *= f; o1[i] *= f; } }
            float ps = 0.f;
#pragma unroll
            for (int i = 0; i < 16; ++i) { c0[i] = __builtin_amdgcn_exp2f(c0[i]); c1[i] = __builtin_amdgcn_exp2f(c1[i]); ps += c0[i] + c1[i]; }
            lsum += ps;
            h16x8 pf[4];
#pragma unroll
            for (int k = 0; k < 8; ++k) { pf[0][k] = (h16)c0[k]; pf[1][k] = (h16)c0[8 + k]; pf[2][k] = (h16)c1[k]; pf[3][k] = (h16)c1[8 + k]; }
#pragma unroll
            for (int t = 0; t < 4; ++t) {
                const h16x8 v0 = tr_frag(buf + rV + t * 1024), v1 = tr_frag(buf + rV + 4096 + t * 1024);
                o0 = __builtin_amdgcn_mfma_f32_32x32x16_f16(v0, pf[t], o0, 0, 0, 0);
                o1 = __builtin_amdgcn_mfma_f32_32x32x16_f16(v1, pf[t], o1, 0, 0, 0);
            }
        }
        if (tt + 1 < nt) { LAS unsigned char* nb = lds + ((tt + 1) & 1) * 16384; *(LAS u32x4*)(nb + wK) = rk; *(LAS u32x4*)(nb + wV) = rv; }
        __syncthreads();
        kp -= 64;
    }
    {
        const float inv = 1.0f / xhalf_sum(lsum);
        const h16* gp = projb + (size_t)qrow * NIN + C_MGATE + hh * 64 + 4 * hi; h16* dst = mix + ((size_t)b * SEQ + qrow) * DM + 512 + hh * 64 + 4 * hi;
#pragma unroll
        for (int g = 0; g < 4; ++g) {
            const h16x4 ga = *(const h16x4*)(gp + 8 * g), gb = *(const h16x4*)(gp + 32 + 8 * g); h16x4 oa, ob;
#pragma unroll
            for (int k = 0; k < 4; ++k) { oa[k] = (h16)(o0[4 * g + k] * inv * silu_f((float)ga[k])); ob[k] = (h16)(o1[4 * g + k] * inv * silu_f((float)gb[k])); }
            *(h16x4*)(dst + 8 * g) = oa; *(h16x4*)(dst + 32 + 8 * g) = ob;
        }
    }
}

__device__ __forceinline__ void phase_mixers(const Params& p, int layer, unsigned char* lds) {
#pragma unroll 1
    for (int u = blockIdx.x; u < 1024; u += gridDim.x) { const int j = 15 - (u >> 6), bh = u & 63; moba_unit(p, bh >> 3, bh & 7, j, lds); }
#pragma unroll 1
    for (int v = blockIdx.x; v < 1024; v += gridDim.x) ret_unit(p, v >> 7, (v >> 5) & 3, v & 31, lds);
#pragma unroll 1
    for (int v = blockIdx.x; v < 512; v += gridDim.x) conv_unit(p, layer, v >> 6, v & 63, lds);
}

__device__ __forceinline__ void phase_final(const Params& p) {
    const float* rowss = (const float*)(p.ws + WS_ROWSS);
    const int lane = threadIdx.x & 63, wid = threadIdx.x >> 6;
    f32x4 g[4];
#pragma unroll
    for (int j = 0; j < 4; ++j) g[j] = *((const f32x4*)p.final_g + lane + 64 * j);
    for (int row = blockIdx.x * 8 + wid; row < MROWS; row += gridDim.x * 8) {
        const f32x4* rs = (const f32x4*)(rowss + (size_t)row * NPART); const f32x4 s0 = rs[0], s1 = rs[1], s2 = rs[2], s3 = rs[3];
        const float tot = ((s0[0] + s0[1]) + (s0[2] + s0[3])) + ((s1[0] + s1[1]) + (s1[2] + s1[3])) + ((s2[0] + s2[1]) + (s2[2] + s2[3])) + ((s3[0] + s3[1]) + (s3[2] + s3[3]));
        const float rstd = rsqrtf(tot * (1.0f / DM) + 1e-6f);
        f32x4* xr = (f32x4*)(p.out + (size_t)row * DM) + lane;
#pragma unroll
        for (int j = 0; j < 4; ++j) { f32x4 v = xr[64 * j]; v = v * rstd * g[j]; xr[64 * j] = v; }
    }
}

__global__ void __launch_bounds__(NTHREADS) hymba_fwd(Params p) {
    extern __shared__ __attribute__((aligned(16))) unsigned char lds[];
    cg::grid_group grid = cg::this_grid();
#define RUN_PHASE(k, body) do { if (p.ph_lo <= (k) && (k) < p.ph_hi) { body; if ((k) + 1 < p.ph_hi) grid.sync(); } } while (0)
    RUN_PHASE(0, phase_prologue(p, lds));
    RUN_PHASE(1, gemm_in(p, 0, lds));
    RUN_PHASE(2, phase_stats(p, lds));
    RUN_PHASE(3, phase_mixers(p, 0, lds));
    RUN_PHASE(4, gemm_out(p, 0, lds));
    RUN_PHASE(5, gemm_in(p, 1, lds));
    RUN_PHASE(6, phase_stats(p, lds));
    RUN_PHASE(7, phase_mixers(p, 1, lds));
    RUN_PHASE(8, gemm_out(p, 1, lds));
    RUN_PHASE(9, phase_final(p));
#undef RUN_PHASE
}

extern "C" void kernel_launch(void* const* d_in, const int* in_sizes, int n_in, void* d_out, int out_size, void* d_ws, size_t ws_size, hipStream_t stream) {
    static int grid_blocks = 0;
    if (!grid_blocks) {
        int dev = 0, cus = 0, per_cu = 0;
        hipGetDevice(&dev);
        hipDeviceGetAttribute(&cus, hipDeviceAttributeMultiprocessorCount, dev);
        hipFuncSetAttribute((const void*)hymba_fwd, hipFuncAttributeMaxDynamicSharedMemorySize, LDS_BYTES);
        hipOccupancyMaxActiveBlocksPerMultiprocessor(&per_cu, (const void*)hymba_fwd, NTHREADS, LDS_BYTES);
        if (per_cu < 1) per_cu = 1;
        grid_blocks = cus * per_cu;
        if (ws_size < WS_END) fprintf(stderr, "kernel_launch: workspace too small (%zu < %zu)\n", ws_size, (size_t)WS_END);
    }
    Params p{};
    p.x = (const float*)d_in[0]; p.norm_g = (const float*)d_in[1]; p.w_in = (const float*)d_in[2]; p.conv_w = (const float*)d_in[3]; p.conv_b = (const float*)d_in[4];
    p.ln_g = (const float*)d_in[5]; p.ln_b = (const float*)d_in[6]; p.pw_w = (const float*)d_in[7]; p.pw_b = (const float*)d_in[8]; p.w_out = (const float*)d_in[9];
    p.final_g = (const float*)d_in[10]; p.out = (float*)d_out; p.ws = (unsigned char*)d_ws;
#if ONE_LAUNCH
    p.ph_lo = 0; p.ph_hi = NPHASES;
    { void* args[] = {&p};
      hipError_t e = hipLaunchCooperativeKernel((const void*)hymba_fwd, dim3(grid_blocks), dim3(NTHREADS), args, LDS_BYTES, stream);
      if (e != hipSuccess) fprintf(stderr, "cooperative launch failed: %s (grid %d)\n", hipGetErrorString(e), grid_blocks); }
#else
    for (int ph = 0; ph < NPHASES; ++ph) {
        p.ph_lo = ph; p.ph_hi = ph + 1; void* args[] = {&p};
        hipError_t e = hipLaunchCooperativeKernel((const void*)hymba_fwd, dim3(grid_blocks), dim3(NTHREADS), args, LDS_BYTES, stream);
        if (e != hipSuccess) { fprintf(stderr, "cooperative launch failed: %s (grid %d, phase %d)\n", hipGetErrorString(e), grid_blocks, ph); break; }
    }
#endif
}
```

```cpp
#include <hip/hip_runtime.h>
#include <hip/hip_cooperative_groups.h>
#include <cstdio>
#include <cstdint>
namespace cg = cooperative_groups;

#ifndef ONE_LAUNCH
#define ONE_LAUNCH 1
#endif

typedef _Float16 h16;
typedef _Float16 h16x8 __attribute__((ext_vector_type(8)));
typedef _Float16 h16x4 __attribute__((ext_vector_type(4)));
typedef float f32x16 __attribute__((ext_vector_type(16)));
typedef float f32x4 __attribute__((ext_vector_type(4)));
typedef unsigned u32x4 __attribute__((ext_vector_type(4)));

constexpr int BATCH = 8, SEQ = 4096, DM = 1024, MROWS = BATCH * SEQ, NIN = 3840, DEPTH = 2;
constexpr int C_AVAL = 0, C_AGLU = 256, C_AGATE = 512, C_RQ = 768, C_RK = 1024, C_RV = 1280, C_RGATE = 1536, C_MQ = 1792, C_MK = 2304, C_MV = 2816, C_MGATE = 3328;
constexpr int NPART = 16;
constexpr int NTHREADS = 512;
constexpr int LDS_BYTES = 147456;
constexpr int NPHASES = 10;

constexpr size_t MiB = 1u << 20;
constexpr size_t WS_XH = 0, WS_PROJ = 64 * MiB, WS_MIX = 304 * MiB, WS_WIN = 368 * MiB, WS_WOUT = 383 * MiB, WS_WPW = 387 * MiB,
                 WS_KV = 388 * MiB, WS_KMEAN = 404 * MiB  , WS_ROWSS = 405 * MiB, WS_CTL = 408 * MiB  , WS_END = 409 * MiB;
constexpr int BAR_LDS_OFF = LDS_BYTES - 64;

struct Params {
    const float *x, *norm_g, *w_in, *conv_w, *conv_b, *ln_g, *ln_b, *pw_w, *pw_b, *w_out, *final_g;
    float* out; unsigned char* ws;
    int ph_lo, ph_hi;
};

__device__ __forceinline__ float silu_f(float v) { return v / (1.0f + __expf(-v)); }
__device__ __forceinline__ int crow(int r, int h) { return (r & 3) + 8 * (r >> 2) + 4 * h; }
__device__ __forceinline__ float wave_sum(float v) {
#pragma unroll
    for (int o = 1; o < 64; o <<= 1) v += __shfl_xor(v, o);
    return v;
}

__device__ __forceinline__ void transpose_unit(const float* W, int K, int N, h16* WT, const float* g, int k0, int n0, float* tile) {
    const int tid = threadIdx.x;
    __syncthreads();
#pragma unroll
    for (int i = 0; i < 8; ++i) { const int k = i * 8 + (tid >> 6), n = tid & 63; float v = W[(size_t)(k0 + k) * N + n0 + n]; if (g) v *= g[k0 + k]; tile[k * 65 + n] = v; }
    __syncthreads();
#pragma unroll
    for (int i = 0; i < 8; ++i) { const int n = i * 8 + (tid >> 6), k = tid & 63; WT[(size_t)(n0 + n) * K + k0 + k] = (h16)tile[k * 65 + n]; }
}

__device__ __forceinline__ void phase_prologue(const Params& p, unsigned char* lds) {
    float* tile = (float*)lds;
    h16* win = (h16*)(p.ws + WS_WIN); h16* wout = (h16*)(p.ws + WS_WOUT); h16* wpw = (h16*)(p.ws + WS_WPW);
    constexpr int U_IN = 16 * 60, U_OUT = 16 * 16, U_PW = 4 * 4, U_L = U_IN + U_OUT + U_PW;
    for (int u = blockIdx.x; u < DEPTH * U_L; u += gridDim.x) {
        const int layer = u / U_L; int r = u % U_L;
        if (r < U_IN) { transpose_unit(p.w_in + (size_t)layer * DM * NIN, DM, NIN, win + (size_t)layer * NIN * DM, p.norm_g + layer * DM, (r / 60) * 64, (r % 60) * 64, tile); continue; }
        r -= U_IN;
        if (r < U_OUT) { transpose_unit(p.w_out + (size_t)layer * DM * DM, DM, DM, wout + (size_t)layer * DM * DM, nullptr, (r / 16) * 64, (r % 16) * 64, tile); continue; }
        r -= U_OUT;
        transpose_unit(p.pw_w + (size_t)layer * 256 * 256, 256, 256, wpw + (size_t)layer * 256 * 256, nullptr, (r / 4) * 64, (r % 4) * 64, tile);
    }
    h16* xh = (h16*)(p.ws + WS_XH); float* rowss = (float*)(p.ws + WS_ROWSS);
    const int lane = threadIdx.x & 63, wid = threadIdx.x >> 6;
    for (int row = blockIdx.x * 8 + wid; row < MROWS; row += gridDim.x * 8) {
        const f32x4* xr = (const f32x4*)(p.x + (size_t)row * DM) + lane;
        float ss = 0.f;
#pragma unroll
        for (int j = 0; j < 4; ++j) { const f32x4 v = xr[64 * j]; ss += v.x * v.x + v.y * v.y + v.z * v.z + v.w * v.w;
            h16x4 o; o.x = (h16)v.x; o.y = (h16)v.y; o.z = (h16)v.z; o.w = (h16)v.w; *((h16x4*)(xh + (size_t)row * DM) + lane + 64 * j) = o; }
        ss = wave_sum(ss);
        if (lane < NPART) rowss[(size_t)row * NPART + lane] = (lane == 0) ? ss : 0.f;
    }
}

typedef short s16x4 __attribute__((ext_vector_type(4)));
#define LAS __attribute__((address_space(3)))
__device__ __forceinline__ float xhalf_max(float v) { auto rr = __builtin_amdgcn_permlane32_swap(__float_as_uint(v), __float_as_uint(v), false, false); return fmaxf(__uint_as_float(rr[0]), __uint_as_float(rr[1])); }
__device__ __forceinline__ float xhalf_sum(float v) { auto rr = __builtin_amdgcn_permlane32_swap(__float_as_uint(v), __float_as_uint(v), false, false); return __uint_as_float(rr[0]) + __uint_as_float(rr[1]); }
__device__ __forceinline__ h16x8 tr_frag(const LAS unsigned char* a) {
    const s16x4 lo = __builtin_amdgcn_ds_read_tr16_b64_v4i16((LAS s16x4*)a), hi = __builtin_amdgcn_ds_read_tr16_b64_v4i16((LAS s16x4*)(a + 512));
    typedef short s16x8 __attribute__((ext_vector_type(8)));
    const s16x8 v = __builtin_shufflevector(lo, hi, 0, 1, 2, 3, 4, 5, 6, 7);
    return __builtin_bit_cast(h16x8, v);
}
#define CROW0(i) (((i) & 3) + 8 * ((i) >> 2))

namespace pg8 {
#define PG8_LAS __attribute__((address_space(3)))
typedef _Float16 bf16_t;
typedef _Float16 bf16x8 __attribute__((ext_vector_type(8)));
typedef float f32x4 __attribute__((ext_vector_type(4)));
typedef unsigned u32x4 __attribute__((ext_vector_type(4)));
constexpr int BM = 256, BK = 64, HALF = 128, HTB = HALF * BK * 2  , STAGE_BYTES = 8 * HTB, NXCD = 8, WGM = 8;

__host__ __device__ __forceinline__ int lds_byte(int r, int c) { const int st = (r >> 4) * 2 + (c >> 5), rr = r & 15, cc = c & 31, ob = rr * 64 + cc * 2; return st * 1024 + (ob ^ (((ob >> 9) & 1) << 5)); }
__host__ __device__ __forceinline__ void stage_rc(int b, int& R, int& C) { const int st = b / 1024, sb = b % 1024, swz = sb ^ (((sb >> 9) & 1) << 5); R = (st >> 1) * 16 + swz / 64; C = (st & 1) * 32 + (swz % 64) / 2; }
__host__ __device__ __forceinline__ int perm32(int rho) { const int n = rho >> 4, i = rho & 15; return 8 * (i >> 2) + 4 * n + (i & 3); }

struct Unit { int pm, pn; };
struct Gemm { const bf16_t* A; const bf16_t* Bt; int M, N, K; };

struct StaticOrder {
    int nM, nN, nwg, G, c;
    __host__ __device__ void init(int M, int N, int G_, int c_) { nM = M / BM; nN = N / BM; nwg = nM * nN; G = G_; c = c_; }
    __host__ __device__ bool next(int i, Unit& u) const {
        const long L = (long)i * G + c; if (L >= nwg) return false;
        int wgid = (int)L; { const int q = nwg / NXCD, r = nwg % NXCD, xcd = wgid % NXCD, off = wgid / NXCD; wgid = (xcd < r ? xcd * (q + 1) : r * (q + 1) + (xcd - r) * q) + off; }
        const int nig = WGM * nN, gid = wgid / nig, fm = gid * WGM, gsz = (nM - fm) < WGM ? (nM - fm) : WGM;
        u.pm = fm + ((wgid % nig) % gsz); u.pn = (wgid % nig) / gsz; return true;
    }
    __device__ __forceinline__ void a_ready(const Unit&) const {}
    __device__ __forceinline__ void done(const Unit&) const {}
};

template <class Epi, class Sched, bool ALIGN_EPI = false, bool SP2 = false>
__device__ __forceinline__ void gemm_phase(PG8_LAS unsigned char* lds, const Gemm g, const Sched& S, const Epi& E) {
    const int tid = threadIdx.x, wid = __builtin_amdgcn_readfirstlane(tid >> 6), lane = tid & 63, wr = wid >> 2, wc = wid & 3, fr = lane & 15, fq = lane >> 4;
    const int K = g.K, nt = K / BK;
    unsigned voffA[2], voffB[2];
#pragma unroll
    for (int i = 0; i < 2; ++i) { int R, C; stage_rc(tid * 16 + i * 8192, R, C); const int Rb = Epi::PERM ? ((R & ~31) + perm32(R & 31)) : R;
        voffA[i] = (unsigned)(R * K + C) * 2u; voffB[i] = (unsigned)(Rb * K + C) * 2u; }
    const size_t kstep = (size_t)(BK * 2);
    const size_t hstep = (size_t)HALF * K * 2;
    const size_t tstep = 2 * hstep;
    const unsigned ldsw = (unsigned)wid * 1024u;
    const int aoff = lds_byte(wr * 64 + fr, fq * 8), boff = lds_byte(wc * 32 + fr, fq * 8);
#define PG8_SA(b, h) (((b) * 2 + (h)) * HTB)
#define PG8_SB(b, h) ((4 + (b) * 2 + (h)) * HTB)
#define PG8_STAGE(bufoff, gbase, voff) do { _Pragma("unroll") for (int _i = 0; _i < 2; ++_i) \
        __builtin_amdgcn_global_load_lds((const unsigned*)((const char*)(gbase) + (voff)[_i]), (PG8_LAS unsigned*)(lds + (bufoff) + ldsw + _i * 8192), 16, 0, 0); } while (0)
#define PG8_LDA(dst, b, h) do { _Pragma("unroll") for (int m = 0; m < 4; ++m) _Pragma("unroll") for (int k = 0; k < 2; ++k) dst[m][k] = *(const PG8_LAS bf16x8*)(lds + PG8_SA(b, h) + aoff + m * 2048 + k * 1024); } while (0)
#define PG8_LDB(dst, b, h) do { _Pragma("unroll") for (int n = 0; n < 2; ++n) _Pragma("unroll") for (int k = 0; k < 2; ++k) dst[n][k] = *(const PG8_LAS bf16x8*)(lds + PG8_SB(b, h) + boff + n * 2048 + k * 1024); } while (0)
#define PG8_MMA(ai, bj, At, Bt) do { __builtin_amdgcn_s_setprio(1); _Pragma("unroll") for (int m = 0; m < 4; ++m) _Pragma("unroll") for (int n = 0; n < 2; ++n) _Pragma("unroll") for (int k = 0; k < 2; ++k) \
        acc[ai][bj][m][n] = __builtin_amdgcn_mfma_f32_16x16x32_f16(Bt[n][k], At[m][k], acc[ai][bj][m][n], 0, 0, 0); __builtin_amdgcn_s_setprio(0); } while (0)
#define PG8_WAIT_V(n) asm volatile("s_waitcnt vmcnt(" #n ")" ::: "memory")
#define PG8_WAIT_L(n) asm volatile("s_waitcnt lgkmcnt(" #n ")" ::: "memory")
#define PG8_BAR __builtin_amdgcn_s_barrier()
#define PG8_SCHED __builtin_amdgcn_sched_barrier(0)
    Unit cur, nxt; int ui = 0;
    if (!S.next(0, cur)) return;
    f32x4 acc[2][2][4][2];
#pragma unroll
    for (int a = 0; a < 2; ++a)
#pragma unroll
        for (int b = 0; b < 2; ++b)
#pragma unroll
            for (int m = 0; m < 4; ++m)
#pragma unroll
                for (int n = 0; n < 2; ++n) acc[a][b][m][n] = (f32x4){0.f, 0.f, 0.f, 0.f};
    bf16x8 At[4][2], B0[2][2], B1[2][2];
    const char* cA = (const char*)g.A + (size_t)cur.pm * tstep; const char* cB = (const char*)g.Bt + (size_t)cur.pn * tstep;
    S.a_ready(cur);
    if constexpr (SP2) {
        PG8_STAGE(PG8_SB(0, 0), cB, voffB); PG8_STAGE(PG8_SB(0, 1), cB + hstep, voffB); PG8_STAGE(PG8_SA(0, 0), cA, voffA); PG8_STAGE(PG8_SA(0, 1), cA + hstep, voffA);
        if (wr == 1) PG8_BAR;
        PG8_WAIT_V(2); PG8_BAR;
        PG8_STAGE(PG8_SB(1, 0), cB + kstep, voffB); PG8_STAGE(PG8_SA(1, 0), cA + kstep, voffA); PG8_STAGE(PG8_SB(1, 1), cB + hstep + kstep, voffB);
        PG8_WAIT_V(6); PG8_BAR;
    } else {
        PG8_STAGE(PG8_SB(0, 0), cB, voffB); PG8_STAGE(PG8_SA(0, 0), cA, voffA); PG8_STAGE(PG8_SB(0, 1), cB + hstep, voffB); PG8_STAGE(PG8_SA(0, 1), cA + hstep, voffA);
        if (wr == 1) PG8_BAR;
        PG8_WAIT_V(4); PG8_BAR;
        PG8_STAGE(PG8_SB(1, 0), cB + kstep, voffB); PG8_STAGE(PG8_SA(1, 0), cA + kstep, voffA); PG8_STAGE(PG8_SB(1, 1), cB + hstep + kstep, voffB);
        PG8_WAIT_V(6); PG8_BAR;
    }
    for (;;) {
        const bool has_next = S.next(ui + 1, nxt);
        const char* nA = has_next ? (const char*)g.A + (size_t)nxt.pm * tstep : cA; const char* nB = has_next ? (const char*)g.Bt + (size_t)nxt.pn * tstep : cB;
        for (int t = 0; t < nt; t += 2) {
            const bool last = (t == nt - 2);
            const char* a1 = cA + (size_t)(t + 1) * kstep;
            const char* a2 = last ? nA : cA + (size_t)(t + 2) * kstep; const char* b2 = last ? nB : cB + (size_t)(t + 2) * kstep;
            const char* a3 = a2 + kstep; const char* b3 = b2 + kstep;
            if (last && has_next) S.a_ready(nxt);
            if constexpr (SP2) {
            PG8_LDB(B0, 0, 0); PG8_LDB(B1, 0, 1); PG8_SCHED; PG8_LDA(At, 0, 0); PG8_STAGE(PG8_SA(1, 1), a1 + hstep, voffA);
            PG8_WAIT_V(8); PG8_WAIT_L(0); PG8_BAR; PG8_MMA(0, 0, At, B0); PG8_MMA(0, 1, At, B1); PG8_BAR; PG8_SCHED;
            PG8_LDA(At, 0, 1); PG8_STAGE(PG8_SB(0, 0), b2, voffB); PG8_STAGE(PG8_SB(0, 1), b2 + hstep, voffB); PG8_STAGE(PG8_SA(0, 0), a2, voffA);
            PG8_WAIT_V(8); PG8_WAIT_L(0); PG8_BAR; PG8_MMA(1, 0, At, B0); PG8_MMA(1, 1, At, B1); PG8_BAR; PG8_SCHED;
            PG8_LDB(B0, 1, 0); PG8_LDB(B1, 1, 1); PG8_SCHED; PG8_LDA(At, 1, 0); PG8_STAGE(PG8_SA(0, 1), a2 + hstep, voffA);
            PG8_WAIT_V(8); PG8_WAIT_L(0); PG8_BAR; PG8_MMA(0, 0, At, B0); PG8_MMA(0, 1, At, B1); PG8_BAR; PG8_SCHED;
            PG8_LDA(At, 1, 1); PG8_STAGE(PG8_SB(1, 0), b3, voffB); PG8_STAGE(PG8_SB(1, 1), b3 + hstep, voffB); PG8_STAGE(PG8_SA(1, 0), a3, voffA);
            PG8_WAIT_V(8); PG8_WAIT_L(0); PG8_BAR; PG8_MMA(1, 0, At, B0); PG8_MMA(1, 1, At, B1); PG8_BAR; PG8_SCHED;
            } else {
            PG8_LDB(B0, 0, 0); PG8_SCHED; PG8_LDA(At, 0, 0); PG8_STAGE(PG8_SA(1, 1), a1 + hstep, voffA);
            PG8_WAIT_L(8); PG8_BAR; PG8_WAIT_L(0); PG8_MMA(0, 0, At, B0); PG8_BAR; PG8_SCHED;
            PG8_LDB(B1, 0, 1); PG8_STAGE(PG8_SB(0, 0), b2, voffB);
            PG8_BAR; PG8_WAIT_L(0); PG8_MMA(0, 1, At, B1); PG8_BAR;
            PG8_LDA(At, 0, 1); PG8_STAGE(PG8_SA(0, 0), a2, voffA);
            PG8_BAR; PG8_WAIT_L(0); PG8_MMA(1, 0, At, B0); PG8_BAR; PG8_SCHED;
            PG8_STAGE(PG8_SB(0, 1), b2 + hstep, voffB);
            PG8_WAIT_V(6); PG8_BAR; PG8_MMA(1, 1, At, B1); PG8_BAR;
            PG8_LDB(B0, 1, 0); PG8_SCHED; PG8_LDA(At, 1, 0); PG8_STAGE(PG8_SA(0, 1), a2 + hstep, voffA);
            PG8_WAIT_L(8); PG8_BAR; PG8_WAIT_L(0); PG8_MMA(0, 0, At, B0); PG8_BAR; PG8_SCHED;
            PG8_LDB(B1, 1, 1); PG8_STAGE(PG8_SB(1, 0), b3, voffB);
            PG8_BAR; PG8_WAIT_L(0); PG8_MMA(0, 1, At, B1); PG8_BAR;
            PG8_LDA(At, 1, 1); PG8_STAGE(PG8_SA(1, 0), a3, voffA);
            PG8_BAR; PG8_WAIT_L(0); PG8_MMA(1, 0, At, B0); PG8_BAR; PG8_SCHED;
            PG8_STAGE(PG8_SB(1, 1), b3 + hstep, voffB);
            PG8_WAIT_V(6); PG8_BAR; PG8_MMA(1, 1, At, B1); PG8_BAR;
            }
        }
        if constexpr (ALIGN_EPI) { if (wr == 0) PG8_BAR; }
        if constexpr (!Epi::AFTER_DRAIN) { E(acc, cur, wr, wc, fr, fq); S.done(cur); }
        if (!has_next) break;
#pragma unroll
        for (int a = 0; a < 2; ++a)
#pragma unroll
            for (int b = 0; b < 2; ++b)
#pragma unroll
                for (int m = 0; m < 4; ++m)
#pragma unroll
                    for (int n = 0; n < 2; ++n) acc[a][b][m][n] = (f32x4){0.f, 0.f, 0.f, 0.f};
        cur = nxt; cA = nA; cB = nB; ++ui;
        if constexpr (ALIGN_EPI) { if (wr == 1) PG8_BAR; }
    }
    PG8_WAIT_V(0);
    if constexpr (!ALIGN_EPI) { if (wr == 0) PG8_BAR; }
    PG8_BAR;
    if constexpr (Epi::AFTER_DRAIN) { E.fused(acc, cur, wr, wc, fr, fq, lds, wid, lane); S.done(cur); }
#undef PG8_SA
#undef PG8_SB
#undef PG8_STAGE
#undef PG8_LDA
#undef PG8_LDB
#undef PG8_MMA
#undef PG8_WAIT_V
#undef PG8_WAIT_L
#undef PG8_BAR
#undef PG8_SCHED
}

struct EpiProj {
    static constexpr bool PERM = true, AFTER_DRAIN = false;
    bf16_t* O; const float* rowss; float* kmpart;
    __device__ __forceinline__ void operator()(const f32x4 (&acc)[2][2][4][2], const Unit& u, int wr, int wc, int fr, int fq) const {
        const int row0 = u.pm * BM + wr * 64 + fr, col0 = u.pn * BM + wc * 32 + 8 * fq;
        const bool want_km = (u.pn == 9) || (u.pn == 10);
        f32x4 cs[2][2];
#pragma unroll
        for (int bj = 0; bj < 2; ++bj)
#pragma unroll
            for (int n = 0; n < 2; ++n) cs[bj][n] = (f32x4){0.f, 0.f, 0.f, 0.f};
#pragma unroll
        for (int ai = 0; ai < 2; ++ai)
#pragma unroll
            for (int m = 0; m < 4; ++m) { const size_t row = (size_t)(row0 + ai * HALF + m * 16);
                const f32x4* rs = (const f32x4*)(rowss + row * 16); const f32x4 s0 = rs[0], s1 = rs[1], s2 = rs[2], s3 = rs[3];
                const float tot = ((s0[0] + s0[1]) + (s0[2] + s0[3])) + ((s1[0] + s1[1]) + (s1[2] + s1[3])) + ((s2[0] + s2[1]) + (s2[2] + s2[3])) + ((s3[0] + s3[1]) + (s3[2] + s3[3]));
                const float rstd = rsqrtf(tot * (1.0f / 1024.0f) + 1e-6f);
                bf16_t* rowp = O + row * 3840 + col0;
#pragma unroll
                for (int bj = 0; bj < 2; ++bj) { const f32x4 v0 = acc[ai][bj][m][0] * rstd, v1 = acc[ai][bj][m][1] * rstd; bf16x8 w;
                    w[0] = (bf16_t)v0[0]; w[1] = (bf16_t)v0[1]; w[2] = (bf16_t)v0[2]; w[3] = (bf16_t)v0[3]; w[4] = (bf16_t)v1[0]; w[5] = (bf16_t)v1[1]; w[6] = (bf16_t)v1[2]; w[7] = (bf16_t)v1[3];
                    *(bf16x8*)(rowp + bj * HALF) = w; cs[bj][0] += v0; cs[bj][1] += v1; } }
        if (want_km) {
#pragma unroll
            for (int bj = 0; bj < 2; ++bj)
#pragma unroll
                for (int n = 0; n < 2; ++n)
#pragma unroll
                    for (int k = 0; k < 4; ++k) { float v = cs[bj][n][k]; v += __shfl_xor(v, 1); v += __shfl_xor(v, 2); v += __shfl_xor(v, 4); v += __shfl_xor(v, 8); cs[bj][n][k] = v * (1.0f / 256.0f); }
            if (fr == 0) {
#pragma unroll
                for (int bj = 0; bj < 2; ++bj)
#pragma unroll
                    for (int n = 0; n < 2; ++n) { const int cm = col0 + bj * HALF + 4 * n - 2304;
                        *(f32x4*)(kmpart + ((size_t)((wr * 8 + (u.pm >> 4)) * 8 + (cm >> 6)) * 16 + (u.pm & 15)) * 64 + (cm & 63)) = cs[bj][n]; }
            }
        }
    }
};
struct EpiRes {
    static constexpr bool PERM = true, AFTER_DRAIN = false;
    const float* xold; float* xnew; bf16_t* xh; float* rowss;
    __device__ __forceinline__ void operator()(const f32x4 (&acc)[2][2][4][2], const Unit& u, int wr, int wc, int fr, int fq) const {
        const int row0 = u.pm * BM + wr * 64 + fr, col0 = u.pn * BM + wc * 32 + 8 * fq;
#pragma unroll
        for (int ai = 0; ai < 2; ++ai)
#pragma unroll
            for (int m = 0; m < 4; ++m) { const size_t row = (size_t)(row0 + ai * HALF + m * 16); float ss = 0.f;
#pragma unroll
                for (int bj = 0; bj < 2; ++bj) { const size_t off = row * 1024 + col0 + bj * HALF;
                    const f32x4 v0 = *(const f32x4*)(xold + off) + acc[ai][bj][m][0], v1 = *(const f32x4*)(xold + off + 4) + acc[ai][bj][m][1];
                    *(f32x4*)(xnew + off) = v0; *(f32x4*)(xnew + off + 4) = v1; bf16x8 w;
                    w[0] = (bf16_t)v0[0]; w[1] = (bf16_t)v0[1]; w[2] = (bf16_t)v0[2]; w[3] = (bf16_t)v0[3]; w[4] = (bf16_t)v1[0]; w[5] = (bf16_t)v1[1]; w[6] = (bf16_t)v1[2]; w[7] = (bf16_t)v1[3];
                    *(bf16x8*)(xh + off) = w;
                    ss += ((v0[0] * v0[0] + v0[1] * v0[1]) + (v0[2] * v0[2] + v0[3] * v0[3])) + ((v1[0] * v1[0] + v1[1] * v1[1]) + (v1[2] * v1[2] + v1[3] * v1[3])); }
                ss += __shfl_xor(ss, 16); ss += __shfl_xor(ss, 32);
                if (fq == 0) rowss[row * 16 + u.pn * 4 + wc] = ss; }
    }
};
}


__device__ __forceinline__ void gemm_in(const Params& p, int layer, unsigned char* lds) {
    pg8::Gemm g{(const h16*)(p.ws + WS_XH), (const h16*)(p.ws + WS_WIN) + (size_t)layer * NIN * DM, MROWS, NIN, DM};
    pg8::StaticOrder S; S.init(MROWS, NIN, (int)gridDim.x, (int)blockIdx.x);
    pg8::EpiProj E{(h16*)(p.ws + WS_PROJ), (const float*)(p.ws + WS_ROWSS), (float*)(p.ws + WS_KMEAN)};
    pg8::gemm_phase<pg8::EpiProj, pg8::StaticOrder, true, true>((PG8_LAS unsigned char*)lds, g, S, E);
}
__device__ __forceinline__ void gemm_out(const Params& p, int layer, unsigned char* lds) {
    pg8::Gemm g{(const h16*)(p.ws + WS_MIX), (const h16*)(p.ws + WS_WOUT) + (size_t)layer * DM * DM, MROWS, DM, DM};
    pg8::StaticOrder S; S.init(MROWS, DM, (int)gridDim.x, (int)blockIdx.x);
    pg8::EpiRes E{(layer == 0) ? p.x : p.out, p.out, (h16*)(p.ws + WS_XH), (float*)(p.ws + WS_ROWSS)};
    pg8::gemm_phase<pg8::EpiRes, pg8::StaticOrder, true, true>((PG8_LAS unsigned char*)lds, g, S, E);
}

__device__ __forceinline__ void phase_stats(const Params& p, unsigned char* lds_g) {
    LAS unsigned char* lds = (LAS unsigned char*)lds_g;
    const h16* proj = (const h16*)(p.ws + WS_PROJ); float* kv = (float*)(p.ws + WS_KV);
    const int tid = threadIdx.x, lane = tid & 63, wid = __builtin_amdgcn_readfirstlane(tid >> 6), r = lane & 31, hi = lane >> 5;
    const int lanepart = (4 * hi + ((lane & 15) >> 2)) * 64 + ((lane >> 4) & 1) * 32 + (lane & 3) * 8;
#pragma unroll 1
    for (int u = blockIdx.x; u < 512; u += gridDim.x) {
        const int b = u >> 6, hh = (u >> 4) & 3, np = u & 15;
        const float log_g = logf(1.0f - exp2f(-5.0f - (float)hh));
        __syncthreads();
#pragma unroll
        for (int it = 0; it < 4; ++it) {
            const int pc = tid + 512 * it, cn = pc >> 10, key = (pc >> 3) & 127, ch = pc & 7;
            const h16* src = proj + (size_t)(b * SEQ + (2 * np + cn) * 128 + key) * NIN + hh * 64 + ch * 8;
            h16x8 kk = *(const h16x8*)(src + C_RK); const h16x8 vv = *(const h16x8*)(src + C_RV);
            const float z = __expf(log_g * (float)(127 - key)) * 0.125f;
#pragma unroll
            for (int k = 0; k < 8; ++k) kk[k] = (h16)((float)kk[k] * z);
            const int off = cn * 32768 + (ch >> 2) * 8192 + (key >> 4) * 1024 + (key & 15) * 64 + (ch & 3) * 16;
            *(LAS h16x8*)(lds + off) = kk; *(LAS h16x8*)(lds + off + 16384) = vv;
        }
        __syncthreads();
        const int cn = wid >> 2, eb = (wid >> 1) & 1, dbk = wid & 1;
        const LAS unsigned char* kimg = lds + cn * 32768 + dbk * 8192 + lanepart; const LAS unsigned char* vimg = lds + cn * 32768 + 16384 + eb * 8192 + lanepart;
        f32x16 acc;
#pragma unroll
        for (int i = 0; i < 16; ++i) acc[i] = 0.f;
#pragma unroll
        for (int ks = 0; ks < 8; ++ks) acc = __builtin_amdgcn_mfma_f32_32x32x16_f16(tr_frag(vimg + ks * 1024), tr_frag(kimg + ks * 1024), acc, 0, 0, 0);
        float* dst = kv + ((size_t)((b * 4 + hh) * 32 + 2 * np + cn)) * 4096 + (32 * eb + 4 * hi) * 64 + 32 * dbk + r;
#pragma unroll
        for (int i = 0; i < 16; ++i) dst[CROW0(i) * 64] = acc[i];
    }
}

typedef _Float16 h16x2 __attribute__((ext_vector_type(2)));
typedef float f32x2 __attribute__((ext_vector_type(2)));
__device__ __forceinline__ void conv_unit(const Params& p, int layer, int b, int tt, unsigned char* lds_g) {
    LAS unsigned char* lds = (LAS unsigned char*)lds_g;
    const h16* projb = (const h16*)(p.ws + WS_PROJ) + (size_t)b * SEQ * NIN; h16* mix = (h16*)(p.ws + WS_MIX);
    const int tid = threadIdx.x, lane = tid & 63, wid = __builtin_amdgcn_readfirstlane(tid >> 6), r = lane & 31, hi = lane >> 5;
    const int cp = tid & 127, tg = __builtin_amdgcn_readfirstlane(tid >> 7), t0 = tt * 64, tb0 = t0 + 16 * tg - 30;
    constexpr int YS = 0, SIMG = 65536;
    float y0[16], y1[16];
    {
        float w0[31], w1[31]; const float* cw = p.conv_w + (size_t)layer * 31 * 256 + 2 * cp;
#pragma unroll
        for (int jj = 0; jj < 31; ++jj) { const f32x2 wv = *(const f32x2*)(cw + jj * 256); w0[jj] = wv[0]; w1[jj] = wv[1]; }
        const f32x2 cbv = *(const f32x2*)(p.conv_b + layer * 256 + 2 * cp);
#pragma unroll
        for (int tl = 0; tl < 16; ++tl) { y0[tl] = cbv[0]; y1[tl] = cbv[1]; }
#pragma unroll
        for (int rr = 0; rr < 46; ++rr) {
            const int t = tb0 + rr; float a0 = 0.f, a1 = 0.f;
            if (t >= 0) { const h16x2 av = *(const h16x2*)(projb + (size_t)t * NIN + C_AVAL + 2 * cp), gv = *(const h16x2*)(projb + (size_t)t * NIN + C_AGLU + 2 * cp);
                a0 = (float)av[0] / (1.0f + __expf(-(float)gv[0])); a1 = (float)av[1] / (1.0f + __expf(-(float)gv[1])); }
#pragma unroll
            for (int tl = 0; tl < 16; ++tl) { const int jj = rr - tl; if (jj >= 0 && jj < 31) { y0[tl] += w0[jj] * a0; y1[tl] += w1[jj] * a1; } }
        }
    }
    __syncthreads();
#pragma unroll
    for (int tl = 0; tl < 16; ++tl) *(LAS f32x2*)(lds + YS + ((16 * tg + tl) * 256 + 2 * cp) * 4) = (f32x2){y0[tl], y1[tl]};
    h16x8 wf[16];
    {
        const h16* wp = (const h16*)(p.ws + WS_WPW) + (size_t)layer * 65536 + (size_t)(32 * wid + r) * 256 + 8 * hi;
#pragma unroll
        for (int ks = 0; ks < 16; ++ks) wf[ks] = *(const h16x8*)(wp + 16 * ks);
    }
    __syncthreads();
    {
        const f32x4 lg = *(const f32x4*)(p.ln_g + layer * 256 + lane * 4), lb = *(const f32x4*)(p.ln_b + layer * 256 + lane * 4);
#pragma unroll 2
        for (int k = 0; k < 8; ++k) { const int t = wid * 8 + k; f32x4 v = *(const LAS f32x4*)(lds + YS + (t * 256 + lane * 4) * 4);
            const float mu = wave_sum((v[0] + v[1]) + (v[2] + v[3])) * (1.0f / 256.0f);
            v = v - mu; const float var = wave_sum((v[0] * v[0] + v[1] * v[1]) + (v[2] * v[2] + v[3] * v[3])) * (1.0f / 256.0f); const float rs = rsqrtf(var + 1e-5f);
            h16x4 o; o[0] = (h16)silu_f(v[0] * rs * lg[0] + lb[0]); o[1] = (h16)silu_f(v[1] * rs * lg[1] + lb[1]); o[2] = (h16)silu_f(v[2] * rs * lg[2] + lb[2]); o[3] = (h16)silu_f(v[3] * rs * lg[3] + lb[3]);
            *(LAS h16x4*)(lds + SIMG + t * 512 + (((lane >> 1) ^ (t & 15)) << 4) + 8 * (lane & 1)) = o; }
    }
    __syncthreads();
#pragma unroll
    for (int tb = 0; tb < 2; ++tb) {
        f32x16 acc;
#pragma unroll
        for (int i = 0; i < 16; ++i) acc[i] = 0.f;
#pragma unroll
        for (int ks = 0; ks < 16; ++ks) acc = __builtin_amdgcn_mfma_f32_32x32x16_f16(wf[ks], *(const LAS h16x8*)(lds + SIMG + (32 * tb + r) * 512 + (((2 * ks + hi) ^ (r & 15)) << 4)), acc, 0, 0, 0);
        const int t = t0 + 32 * tb + r, n0 = 32 * wid + 4 * hi;
        const h16* gp = projb + (size_t)t * NIN + C_AGATE + n0; h16* dst = mix + ((size_t)b * SEQ + t) * DM + n0; const float* pb = p.pw_b + layer * 256 + n0;
#pragma unroll
        for (int g = 0; g < 4; ++g) { const h16x4 ga = *(const h16x4*)(gp + 8 * g); const f32x4 bb = *(const f32x4*)(pb + 8 * g); h16x4 oa;
#pragma unroll
            for (int k = 0; k < 4; ++k) oa[k] = (h16)((acc[4 * g + k] + bb[k]) * silu_f((float)ga[k]));
            *(h16x4*)(dst + 8 * g) = oa; }
    }
}

__device__ __forceinline__ void ret_unit(const Params& p, int b, int hh, int n, unsigned char* lds_g) {
    LAS unsigned char* lds = (LAS unsigned char*)lds_g;
    const h16* projb = (const h16*)(p.ws + WS_PROJ) + (size_t)(b * SEQ + n * 128) * NIN; h16* mix = (h16*)(p.ws + WS_MIX); const float* kv = (const float*)(p.ws + WS_KV);
    const int tid = threadIdx.x, lane = tid & 63, wid = __builtin_amdgcn_readfirstlane(tid >> 6), r = lane & 31, hi = lane >> 5, g4 = wid & 3, eh = wid >> 2;
    const float log_g = logf(1.0f - exp2f(-5.0f - (float)hh)); const float g_chunk = expf(log_g * 128.0f), gam = 1.0f - exp2f(-5.0f - (float)hh);
    constexpr int KIMG = 0, VIMG = 16384, RIMG = 32768, XS = 40960;
    f32x4 ra = (f32x4){0.f, 0.f, 0.f, 0.f}, rb = (f32x4){0.f, 0.f, 0.f, 0.f};
    {
        const float* kvb = kv + ((size_t)(b * 4 + hh) * 32) * 4096 + tid * 8;
#pragma unroll 4
        for (int m = 0; m < n; ++m) { ra = ra * g_chunk + *(const f32x4*)(kvb + (size_t)m * 4096); rb = rb * g_chunk + *(const f32x4*)(kvb + (size_t)m * 4096 + 4); }
    }
    __syncthreads();
    {
        h16x8 rr;
#pragma unroll
        for (int k = 0; k < 4; ++k) { rr[k] = (h16)(ra[k] * gam); rr[4 + k] = (h16)(rb[k] * gam); }
        const int e = tid >> 3, ch = tid & 7;
        *(LAS h16x8*)(lds + RIMG + e * 128 + ((ch ^ ((e >> 1) & 7)) << 4)) = rr;
#pragma unroll
        for (int it = 0; it < 2; ++it) {
            const int key = (tid >> 3) + 64 * it;
            h16x8 kk = *(const h16x8*)(projb + (size_t)key * NIN + C_RK + hh * 64 + ch * 8); const h16x8 vv = *(const h16x8*)(projb + (size_t)key * NIN + C_RV + hh * 64 + ch * 8);
            const float z = __expf(-log_g * (float)key) * 0.125f;
#pragma unroll
            for (int k = 0; k < 8; ++k) kk[k] = (h16)((float)kk[k] * z);
            *(LAS h16x8*)(lds + KIMG + key * 128 + ((ch ^ ((key >> 1) & 7)) << 4)) = kk;
            *(LAS h16x8*)(lds + VIMG + (ch >> 2) * 8192 + (key >> 4) * 1024 + (key & 15) * 64 + (ch & 3) * 16) = vv;
        }
    }
    const int qi = 32 * g4 + r;
    h16x8 qf[4];
    {
        const float zq = __expf(log_g * (float)qi);
#pragma unroll
        for (int s = 0; s < 4; ++s) { qf[s] = *(const h16x8*)(projb + (size_t)qi * NIN + C_RQ + hh * 64 + 16 * s + 8 * hi);
#pragma unroll
            for (int k = 0; k < 8; ++k) qf[s][k] = (h16)((float)qf[s][k] * zq); }
    }
    __syncthreads();
    const int rsw = (r >> 1) & 7;
    const int lanepart = (4 * hi + ((lane & 15) >> 2)) * 64 + ((lane >> 4) & 1) * 32 + (lane & 3) * 8;
    f32x16 o;
#pragma unroll
    for (int i = 0; i < 16; ++i) o[i] = 0.f;
#pragma unroll 1
    for (int jb = 0; jb <= g4; ++jb) {
        f32x16 c;
#pragma unroll
        for (int i = 0; i < 16; ++i) c[i] = 0.f;
#pragma unroll
        for (int s = 0; s < 4; ++s) c = __builtin_amdgcn_mfma_f32_32x32x16_f16(*(const LAS h16x8*)(lds + KIMG + (32 * jb + r) * 128 + (((2 * s + hi) ^ rsw) << 4)), qf[s], c, 0, 0, 0);
        if (jb == g4) {
#pragma unroll
            for (int i = 0; i < 16; ++i) if (CROW0(i) + 4 * hi > r) c[i] = 0.f;
        }
        h16x8 pf0, pf1;
#pragma unroll
        for (int k = 0; k < 8; ++k) { pf0[k] = (h16)c[k]; pf1[k] = (h16)c[8 + k]; }
        o = __builtin_amdgcn_mfma_f32_32x32x16_f16(tr_frag(lds + VIMG + eh * 8192 + (2 * jb) * 1024 + lanepart), pf0, o, 0, 0, 0);
        o = __builtin_amdgcn_mfma_f32_32x32x16_f16(tr_frag(lds + VIMG + eh * 8192 + (2 * jb + 1) * 1024 + lanepart), pf1, o, 0, 0, 0);
    }
#pragma unroll
    for (int s = 0; s < 4; ++s) o = __builtin_amdgcn_mfma_f32_32x32x16_f16(*(const LAS h16x8*)(lds + RIMG + (32 * eh + r) * 128 + (((2 * s + hi) ^ rsw) << 4)), qf[s], o, 0, 0, 0);
    float s1 = 0.f, s2 = 0.f;
#pragma unroll
    for (int i = 0; i < 16; ++i) { s1 += o[i]; s2 += o[i] * o[i]; }
    s1 = xhalf_sum(s1); s2 = xhalf_sum(s2);
    LAS float* xs = (LAS float*)(lds + XS);
    if (hi == 0) { xs[(wid * 32 + r) * 2] = s1; xs[(wid * 32 + r) * 2 + 1] = s2; }
    __syncthreads();
    {
        const float t1 = xs[((wid ^ 4) * 32 + r) * 2], t2 = xs[((wid ^ 4) * 32 + r) * 2 + 1];
        const float a1 = (eh == 0) ? (s1 + t1) : (t1 + s1), a2 = (eh == 0) ? (s2 + t2) : (t2 + s2);
        const float mu = a1 * (1.0f / 64.0f); const float var = fmaxf(a2 * (1.0f / 64.0f) - mu * mu, 0.f); const float rs = rsqrtf(var + 1e-5f);
        const int col = hh * 64 + 32 * eh + 4 * hi;
        const h16* gp = projb + (size_t)qi * NIN + C_RGATE + col; h16* dst = mix + ((size_t)(b * SEQ + n * 128 + qi)) * DM + 256 + col;
#pragma unroll
        for (int g = 0; g < 4; ++g) { const h16x4 ga = *(const h16x4*)(gp + 8 * g); h16x4 oa;
#pragma unroll
            for (int k = 0; k < 4; ++k) oa[k] = (h16)((o[4 * g + k] - mu) * rs * silu_f((float)ga[k]));
            *(h16x4*)(dst + 8 * g) = oa; }
    }
}

constexpr float MOBA_THR = 8.0f;
__device__ __forceinline__ void moba_unit(const Params& p, int b, int hh, int j, unsigned char* lds_g) {
    LAS unsigned char* lds = (LAS unsigned char*)lds_g;
    const int tid = threadIdx.x, lane = tid & 63, wid = __builtin_amdgcn_readfirstlane(tid >> 6), r = lane & 31, hi = lane >> 5;
    const h16* projb = (const h16*)(p.ws + WS_PROJ) + (size_t)b * SEQ * NIN; h16* mix = (h16*)(p.ws + WS_MIX);
    const int qrow = j * 256 + wid * 32 + r;
    h16x8 qf[4];
#pragma unroll
    for (int s = 0; s < 4; ++s) qf[s] = *(const h16x8*)(projb + (size_t)qrow * NIN + C_MQ + hh * 64 + 16 * s + 8 * hi);
    unsigned selmask = 0u;
    if (j <= 3) selmask = (1u << j) - 1u;
    else {
        float g0 = -3.0e38f, g1 = -3.0e38f, g2 = -3.0e38f; int i0 = 0, i1 = 0, i2 = 0;
        const float* km = (const float*)(p.ws + WS_KMEAN) + ((size_t)(b * 8 + hh) * 16) * 64 + 8 * hi;
#pragma unroll 1
        for (int n = 0; n < j; ++n) { float s = 0.f;
#pragma unroll
            for (int ss = 0; ss < 4; ++ss) { const f32x4 k0 = *(const f32x4*)(km + n * 64 + 16 * ss) + *(const f32x4*)(km + 65536 + n * 64 + 16 * ss),
                                                             k1 = *(const f32x4*)(km + n * 64 + 16 * ss + 4) + *(const f32x4*)(km + 65536 + n * 64 + 16 * ss + 4);
                s += (float)qf[ss][0] * k0.x + (float)qf[ss][1] * k0.y + (float)qf[ss][2] * k0.z + (float)qf[ss][3] * k0.w
                   + (float)qf[ss][4] * k1.x + (float)qf[ss][5] * k1.y + (float)qf[ss][6] * k1.z + (float)qf[ss][7] * k1.w; }
            s = xhalf_sum(s);
            if (s > g0) { g2 = g1; i2 = i1; g1 = g0; i1 = i0; g0 = s; i0 = n; }
            else if (s > g1) { g2 = g1; i2 = i1; g1 = s; i1 = n; }
            else if (s > g2) { g2 = s; i2 = n; } }
        selmask = (1u << i0) | (1u << i1) | (1u << i2);
    }
    constexpr float C2 = 0.125f * 1.4426950408889634f;
#pragma unroll
    for (int s = 0; s < 4; ++s)
#pragma unroll
        for (int k = 0; k < 8; ++k) qf[s][k] = (h16)((float)qf[s][k] * C2);
    const float slope2 = exp2f(-(float)(hh + 1)) * 1.4426950408889634f;
    f32x16 o0, o1;
#pragma unroll
    for (int i = 0; i < 16; ++i) { o0[i] = 0.f; o1[i] = 0.f; }
    float mref = 0.f, lsum = 0.f; bool first = true;
    const int skey = tid >> 3, sch = tid & 7;
    const h16* gk = projb + (size_t)skey * NIN + C_MK + hh * 64 + sch * 8;
    const int wK = skey * 128 + ((sch ^ ((skey >> 1) & 7)) << 4);
    const int wV = 8192 + (sch >> 2) * 4096 + (skey >> 4) * 1024 + (skey & 15) * 64 + (sch & 3) * 16;
    const int rK = r * 128, rsw = (r >> 1) & 7;
    const int rV = 8192 + (4 * hi + ((lane & 15) >> 2)) * 64 + ((lane >> 4) & 1) * 32 + (lane & 3) * 8;
    const int nt = 4 * (j + 1);
    int kp = j * 256 + 192;
    u32x4 rk = *(const u32x4*)(gk + (size_t)kp * NIN), rv = *(const u32x4*)(gk + (size_t)kp * NIN + (C_MV - C_MK));
    __syncthreads();
    *(LAS u32x4*)(lds + wK) = rk; *(LAS u32x4*)(lds + wV) = rv;
    __syncthreads();
#pragma unroll 1
    for (int tt = 0; tt < nt; ++tt) {
        const LAS unsigned char* buf = lds + (tt & 1) * 16384;
        if (tt + 1 < nt) { rk = *(const u32x4*)(gk + (size_t)(kp - 64) * NIN); rv = *(const u32x4*)(gk + (size_t)(kp - 64) * NIN + (C_MV - C_MK)); }
        const int nblk = kp >> 8; const bool own = (nblk == j); const int tloc = (kp >> 6) & 3;
        bool valid = true, act, diag = false;
        if (own) { act = tloc <= (wid >> 1); diag = tloc == (wid >> 1); }
        else { valid = (selmask >> nblk) & 1u; act = __any(valid); }
        if (act) {
            const float tbh = valid ? (slope2 * (float)(kp - qrow + 4 * hi) - mref) : -INFINITY;
            f32x16 c0, c1;
#pragma unroll
            for (int i = 0; i < 16; ++i) { c0[i] = fmaf(slope2, (float)CROW0(i), tbh); c1[i] = fmaf(slope2, (float)(CROW0(i) + 32), tbh); }
            if (diag) { const int lim2 = 32 * wid - 64 * tloc + r - 4 * hi;
#pragma unroll
                for (int i = 0; i < 16; ++i) { if (CROW0(i) > lim2) c0[i] = -INFINITY; if (CROW0(i) + 32 > lim2) c1[i] = -INFINITY; } }
#pragma unroll
            for (int s = 0; s < 4; ++s) {
                const h16x8 k0 = *(const LAS h16x8*)(buf + rK + (((2 * s + hi) ^ rsw) << 4)), k1 = *(const LAS h16x8*)(buf + rK + 4096 + (((2 * s + hi) ^ rsw) << 4));
                c0 = __builtin_amdgcn_mfma_f32_32x32x16_f16(k0, qf[s], c0, 0, 0, 0);
                c1 = __builtin_amdgcn_mfma_f32_32x32x16_f16(k1, qf[s], c1, 0, 0, 0);
            }
            float rm = fmaxf(c0[0], c1[0]);
#pragma unroll
            for (int i = 1; i < 16; ++i) rm = fmaxf(rm, fmaxf(c0[i], c1[i]));
            rm = xhalf_max(rm);
            if (first) { first = false; mref = rm;
#pragma unroll
                for (int i = 0; i < 16; ++i) { c0[i] -= rm; c1[i] -= rm; } }
            else if (__any(rm > MOBA_THR)) { const float dl = fmaxf(rm, 0.f); mref += dl; const float f = __builtin_amdgcn_exp2f(-dl); lsum *= f;
#pragma unroll
                for (int i = 0; i < 16; ++i) { c0[i] -= dl; c1[i] -= dl; o0[i] *= f; o1[i] *= f; } }
            float ps = 0.f;
#pragma unroll
            for (int i = 0; i < 16; ++i) { c0[i] = __builtin_amdgcn_exp2f(c0[i]); c1[i] = __builtin_amdgcn_exp2f(c1[i]); ps += c0[i] + c1[i]; }
            lsum += ps;
            h16x8 pf[4];
#pragma unroll
            for (int k = 0; k < 8; ++k) { pf[0][k] = (h16)c0[k]; pf[1][k] = (h16)c0[8 + k]; pf[2][k] = (h16)c1[k]; pf[3][k] = (h16)c1[8 + k]; }
#pragma unroll
            for (int t = 0; t < 4; ++t) {
                const h16x8 v0 = tr_frag(buf + rV + t * 1024), v1 = tr_frag(buf + rV + 4096 + t * 1024);
                o0 = __builtin_amdgcn_mfma_f32_32x32x16_f16(v0, pf[t], o0, 0, 0, 0);
                o1 = __builtin_amdgcn_mfma_f32_32x32x16_f16(v1, pf[t], o1, 0, 0, 0);
            }
        }
        if (tt + 1 < nt) { LAS unsigned char* nb = lds + ((tt + 1) & 1) * 16384; *(LAS u32x4*)(nb + wK) = rk; *(LAS u32x4*)(nb + wV) = rv; }
        __syncthreads();
        kp -= 64;
    }
    {
        const float inv = 1.0f / xhalf_sum(lsum);
        const h16* gp = projb + (size_t)qrow * NIN + C_MGATE + hh * 64 + 4 * hi; h16* dst = mix + ((size_t)b * SEQ + qrow) * DM + 512 + hh * 64 + 4 * hi;
#pragma unroll
        for (int g = 0; g < 4; ++g) {
            const h16x4 ga = *(const h16x4*)(gp + 8 * g), gb = *(const h16x4*)(gp + 32 + 8 * g); h16x4 oa, ob;
#pragma unroll
            for (int k = 0; k < 4; ++k) { oa[k] = (h16)(o0[4 * g + k] * inv * silu_f((float)ga[k])); ob[k] = (h16)(o1[4 * g + k] * inv * silu_f((float)gb[k])); }
            *(h16x4*)(dst + 8 * g) = oa; *(h16x4*)(dst + 32 + 8 * g) = ob;
        }
    }
}

__device__ __forceinline__ void phase_mixers(const Params& p, int layer, unsigned char* lds) {
#pragma unroll 1
    for (int u = blockIdx.x; u < 1024; u += gridDim.x) { const int j = 15 - (u >> 6), bh = u & 63; moba_unit(p, bh >> 3, bh & 7, j, lds); }
#pragma unroll 1
    for (int v = blockIdx.x; v < 1024; v += gridDim.x) ret_unit(p, v >> 7, (v >> 5) & 3, v & 31, lds);
#pragma unroll 1
    for (int v = blockIdx.x; v < 512; v += gridDim.x) conv_unit(p, layer, v >> 6, v & 63, lds);
}

__device__ __forceinline__ void phase_final(const Params& p) {
    const float* rowss = (const float*)(p.ws + WS_ROWSS);
    const int lane = threadIdx.x & 63, wid = threadIdx.x >> 6;
    f32x4 g[4];
#pragma unroll
    for (int j = 0; j < 4; ++j) g[j] = *((const f32x4*)p.final_g + lane + 64 * j);
    for (int row = blockIdx.x * 8 + wid; row < MROWS; row += gridDim.x * 8) {
        const f32x4* rs = (const f32x4*)(rowss + (size_t)row * NPART); const f32x4 s0 = rs[0], s1 = rs[1], s2 = rs[2], s3 = rs[3];
        const float tot = ((s0[0] + s0[1]) + (s0[2] + s0[3])) + ((s1[0] + s1[1]) + (s1[2] + s1[3])) + ((s2[0] + s2[1]) + (s2[2] + s2[3])) + ((s3[0] + s3[1]) + (s3[2] + s3[3]));
        const float rstd = rsqrtf(tot * (1.0f / DM) + 1e-6f);
        f32x4* xr = (f32x4*)(p.out + (size_t)row * DM) + lane;
#pragma unroll
        for (int j = 0; j < 4; ++j) { f32x4 v = xr[64 * j]; v = v * rstd * g[j]; xr[64 * j] = v; }
    }
}

#define XB_TMO      128
#define XB_XCNT(j)  (256  + 64 * (j))
#define XB_XSUB(j)  (1280 + 64 * (j))
#define XB_XGEN(j)  (2304 + 64 * (j))
#define XB_TOP      3328
#define XB_TOPGEN   3392
#define XCD_BAR_WORDS 3456
#define XB_SPIN_CAP (1u << 18)

__device__ __forceinline__ unsigned xb_ld(unsigned* p)              { return __hip_atomic_load(p, __ATOMIC_RELAXED, __HIP_MEMORY_SCOPE_AGENT); }
__device__ __forceinline__ unsigned xb_add(unsigned* p, unsigned v) { return __hip_atomic_fetch_add(p, v, __ATOMIC_RELAXED, __HIP_MEMORY_SCOPE_AGENT); }
__device__ __forceinline__ unsigned xb_xcc_id() { return (unsigned)__builtin_amdgcn_s_getreg((3 << 11) | 20) & 0xFu; }
#define XB_SPIN(cond, bar) do { unsigned _sp = 0; while (cond) { __builtin_amdgcn_s_sleep(1); \
    if ((++_sp & 255u) == 0u) { if (xb_ld(&(bar)[XB_TMO])) break; if (_sp > XB_SPIN_CAP) { atomicAdd(&(bar)[XB_TMO], 1u); break; } } } } while (0)

struct XcdBarrier {
    unsigned* bar; unsigned x;
    volatile LAS unsigned* st;
};

__device__ __forceinline__ XcdBarrier xcd_barrier_post(unsigned* bar, volatile LAS unsigned* st) {
    XcdBarrier b; b.bar = bar; b.x = xb_xcc_id(); b.st = st;
    if (threadIdx.x == 0) (void)xb_add(&bar[XB_XCNT(b.x)], 1u);
    return b;
}
__device__ __forceinline__ void xcd_barrier_complete(unsigned* bar, unsigned x, unsigned& nloc, unsigned& nx) {
    const unsigned G = gridDim.x * gridDim.y * gridDim.z;
    unsigned sum, cnt, mine, sp = 0u;
    for (;;) {
        sum = 0u; cnt = 0u; mine = 0u;
#pragma unroll
        for (unsigned j = 0; j < 16; ++j) { const unsigned c = xb_ld(&bar[XB_XCNT(j)]); sum += c; cnt += (c > 0u) ? 1u : 0u; mine = (j == x) ? c : mine; }
        if (sum == G) break;
        __builtin_amdgcn_s_sleep(1);
        if ((++sp & 255u) == 0u) { if (xb_ld(&bar[XB_TMO])) break; if (sp > XB_SPIN_CAP) { atomicAdd(&bar[XB_TMO], 1u); break; } }
    }
    nloc = mine > 0u ? mine : 1u; nx = cnt > 0u ? cnt : 1u;
}

__device__ __forceinline__ void xcd_barrier(const XcdBarrier& b) {
    asm volatile("s_waitcnt vmcnt(0)" ::: "memory");
    __syncthreads();
    if (threadIdx.x == 0) {
        unsigned* bar = b.bar;
        __builtin_amdgcn_s_waitcnt(0);
        unsigned nloc = b.st[0], nx = b.st[1];
        if (nloc == 0u) { xcd_barrier_complete(bar, b.x, nloc, nx); b.st[0] = nloc; b.st[1] = nx; }
        const unsigned old = xb_add(&bar[XB_XSUB(b.x)], 1u);
        const unsigned gen = old / nloc;
        if (old + 1u == (gen + 1u) * nloc) {
            __builtin_amdgcn_fence(__ATOMIC_RELEASE, "agent");
            asm volatile("s_waitcnt vmcnt(0)" ::: "memory");
            const unsigned og = xb_add(&bar[XB_TOP], 1u);
            const unsigned tg = og / nx;
            if (og + 1u == (tg + 1u) * nx) xb_add(&bar[XB_TOPGEN], 1u);
            else XB_SPIN(xb_ld(&bar[XB_TOPGEN]) == tg, bar);
            __builtin_amdgcn_fence(__ATOMIC_ACQUIRE, "agent");
            xb_add(&bar[XB_XGEN(b.x)], 1u);
            asm volatile("s_waitcnt vmcnt(0)" ::: "memory");
        } else {
            XB_SPIN(xb_ld(&bar[XB_XGEN(b.x)]) == gen, bar);
            __builtin_amdgcn_fence(__ATOMIC_ACQUIRE, "agent");
            asm volatile("s_waitcnt vmcnt(0)" ::: "memory");
        }
    }
    __syncthreads();
}


__global__ void __launch_bounds__(NTHREADS) hymba_fwd(Params p) {
    extern __shared__ __attribute__((aligned(16))) unsigned char lds[];
    cg::grid_group grid = cg::this_grid();
    volatile LAS unsigned* bst = (volatile LAS unsigned*)((LAS unsigned char*)lds + BAR_LDS_OFF);
    if (threadIdx.x < 2) bst[threadIdx.x] = 0u;
    __syncthreads();
    XcdBarrier xbar = xcd_barrier_post((unsigned*)(p.ws + WS_CTL), bst);
#define RUN_PHASE(k, body) do { if (p.ph_lo <= (k) && (k) < p.ph_hi) { body; if ((k) + 1 < p.ph_hi) { if ((k) == 0) grid.sync(); else xcd_barrier(xbar); } } } while (0)
    RUN_PHASE(0, phase_prologue(p, lds));
    RUN_PHASE(1, gemm_in(p, 0, lds));
    RUN_PHASE(2, phase_stats(p, lds));
    RUN_PHASE(3, phase_mixers(p, 0, lds));
    RUN_PHASE(4, gemm_out(p, 0, lds));
    RUN_PHASE(5, gemm_in(p, 1, lds));
    RUN_PHASE(6, phase_stats(p, lds));
    RUN_PHASE(7, phase_mixers(p, 1, lds));
    RUN_PHASE(8, gemm_out(p, 1, lds));
    RUN_PHASE(9, phase_final(p));
#undef RUN_PHASE
}

extern "C" void kernel_launch(void* const* d_in, const int* in_sizes, int n_in, void* d_out, int out_size, void* d_ws, size_t ws_size, hipStream_t stream) {
    static int grid_blocks = 0;
    if (!grid_blocks) {
        int dev = 0, cus = 0, per_cu = 0;
        hipGetDevice(&dev);
        hipDeviceGetAttribute(&cus, hipDeviceAttributeMultiprocessorCount, dev);
        hipFuncSetAttribute((const void*)hymba_fwd, hipFuncAttributeMaxDynamicSharedMemorySize, LDS_BYTES);
        hipOccupancyMaxActiveBlocksPerMultiprocessor(&per_cu, (const void*)hymba_fwd, NTHREADS, LDS_BYTES);
        if (per_cu < 1) per_cu = 1;
        grid_blocks = cus * per_cu;
        if (ws_size < WS_END) fprintf(stderr, "kernel_launch: workspace too small (%zu < %zu)\n", ws_size, (size_t)WS_END);
    }
    Params p{};
    p.x = (const float*)d_in[0]; p.norm_g = (const float*)d_in[1]; p.w_in = (const float*)d_in[2]; p.conv_w = (const float*)d_in[3]; p.conv_b = (const float*)d_in[4];
    p.ln_g = (const float*)d_in[5]; p.ln_b = (const float*)d_in[6]; p.pw_w = (const float*)d_in[7]; p.pw_b = (const float*)d_in[8]; p.w_out = (const float*)d_in[9];
    p.final_g = (const float*)d_in[10]; p.out = (float*)d_out; p.ws = (unsigned char*)d_ws;
    (void)hipMemsetAsync((char*)d_ws + WS_CTL, 0, 16384, stream);
#if ONE_LAUNCH
    p.ph_lo = 0; p.ph_hi = NPHASES;
    { void* args[] = {&p};
      hipError_t e = hipLaunchCooperativeKernel((const void*)hymba_fwd, dim3(grid_blocks), dim3(NTHREADS), args, LDS_BYTES, stream);
      if (e != hipSuccess) fprintf(stderr, "cooperative launch failed: %s (grid %d)\n", hipGetErrorString(e), grid_blocks); }
#else
    for (int ph = 0; ph < NPHASES; ++ph) {
        p.ph_lo = ph; p.ph_hi = ph + 1; void* args[] = {&p};
        hipError_t e = hipLaunchCooperativeKernel((const void*)hymba_fwd, dim3(grid_blocks), dim3(NTHREADS), args, LDS_BYTES, stream);
        if (e != hipSuccess) { fprintf(stderr, "cooperative launch failed: %s (grid %d, phase %d)\n", hipGetErrorString(e), grid_blocks, ph); break; }
    }
#endif
}
```

```cpp
#include <hip/hip_runtime.h>
#include <hip/hip_cooperative_groups.h>
#include <cstdio>
#include <cstdint>
namespace cg = cooperative_groups;

#ifndef ONE_LAUNCH
#define ONE_LAUNCH 1
#endif

typedef _Float16 h16;
typedef _Float16 h16x8 __attribute__((ext_vector_type(8)));
typedef _Float16 h16x4 __attribute__((ext_vector_type(4)));
typedef float f32x16 __attribute__((ext_vector_type(16)));
typedef float f32x4 __attribute__((ext_vector_type(4)));
typedef unsigned u32x4 __attribute__((ext_vector_type(4)));

constexpr int BATCH = 8, SEQ = 4096, DM = 1024, MROWS = BATCH * SEQ, NIN = 3840, DEPTH = 2;
constexpr int C_AVAL = 0, C_AGLU = 256, C_AGATE = 512, C_RQ = 768, C_RK = 1024, C_RV = 1280, C_RGATE = 1536, C_MQ = 1792, C_MK = 2304, C_MV = 2816, C_MGATE = 3328;
constexpr int NPART = 16;
constexpr int NTHREADS = 512;
constexpr int LDS_BYTES = 147456;
constexpr int NPHASES = 10;

constexpr size_t MiB = 1u << 20;
constexpr size_t WS_XH = 0, WS_PROJ = 64 * MiB, WS_MIX = 304 * MiB, WS_WIN = 368 * MiB, WS_WOUT = 383 * MiB, WS_WPW = 387 * MiB,
                 WS_KV = 388 * MiB, WS_KMEAN = 404 * MiB  , WS_ROWSS = 405 * MiB, WS_CTL = 408 * MiB  , WS_RST = 409 * MiB  , WS_END = 417 * MiB;
constexpr int BAR_LDS_OFF = LDS_BYTES - 64;

struct Params {
    const float *x, *norm_g, *w_in, *conv_w, *conv_b, *ln_g, *ln_b, *pw_w, *pw_b, *w_out, *final_g;
    float* out; unsigned char* ws;
    int ph_lo, ph_hi;
};

__device__ __forceinline__ float silu_f(float v) { return v * __builtin_amdgcn_rcpf(1.0f + __expf(-v)); }
__device__ __forceinline__ int crow(int r, int h) { return (r & 3) + 8 * (r >> 2) + 4 * h; }
__device__ __forceinline__ float wave_sum(float v) {
#pragma unroll
    for (int o = 1; o < 64; o <<= 1) v += __shfl_xor(v, o);
    return v;
}

__device__ __forceinline__ void transpose_unit(const float* W, int K, int N, h16* WT, const float* g, int k0, int n0, float* tile) {
    const int tid = threadIdx.x;
    __syncthreads();
#pragma unroll
    for (int i = 0; i < 8; ++i) { const int k = i * 8 + (tid >> 6), n = tid & 63; float v = W[(size_t)(k0 + k) * N + n0 + n]; if (g) v *= g[k0 + k]; tile[k * 65 + n] = v; }
    __syncthreads();
#pragma unroll
    for (int i = 0; i < 8; ++i) { const int n = i * 8 + (tid >> 6), k = tid & 63; WT[(size_t)(n0 + n) * K + k0 + k] = (h16)tile[k * 65 + n]; }
}

__device__ __forceinline__ void phase_prologue(const Params& p, unsigned char* lds) {
    float* tile = (float*)lds;
    h16* win = (h16*)(p.ws + WS_WIN); h16* wout = (h16*)(p.ws + WS_WOUT); h16* wpw = (h16*)(p.ws + WS_WPW);
    constexpr int U_IN = 16 * 60, U_OUT = 16 * 16, U_PW = 4 * 4, U_L = U_IN + U_OUT + U_PW;
    for (int u = blockIdx.x; u < DEPTH * U_L; u += gridDim.x) {
        const int layer = u / U_L; int r = u % U_L;
        if (r < U_IN) { transpose_unit(p.w_in + (size_t)layer * DM * NIN, DM, NIN, win + (size_t)layer * NIN * DM, p.norm_g + layer * DM, (r / 60) * 64, (r % 60) * 64, tile); continue; }
        r -= U_IN;
        if (r < U_OUT) { transpose_unit(p.w_out + (size_t)layer * DM * DM, DM, DM, wout + (size_t)layer * DM * DM, nullptr, (r / 16) * 64, (r % 16) * 64, tile); continue; }
        r -= U_OUT;
        transpose_unit(p.pw_w + (size_t)layer * 256 * 256, 256, 256, wpw + (size_t)layer * 256 * 256, nullptr, (r / 4) * 64, (r % 4) * 64, tile);
    }
    h16* xh = (h16*)(p.ws + WS_XH); float* rowss = (float*)(p.ws + WS_ROWSS);
    const int lane = threadIdx.x & 63, wid = threadIdx.x >> 6;
    for (int row = blockIdx.x * 8 + wid; row < MROWS; row += gridDim.x * 8) {
        const f32x4* xr = (const f32x4*)(p.x + (size_t)row * DM) + lane;
        float ss = 0.f;
#pragma unroll
        for (int j = 0; j < 4; ++j) { const f32x4 v = xr[64 * j]; ss += v.x * v.x + v.y * v.y + v.z * v.z + v.w * v.w;
            h16x4 o; o.x = (h16)v.x; o.y = (h16)v.y; o.z = (h16)v.z; o.w = (h16)v.w; *((h16x4*)(xh + (size_t)row * DM) + lane + 64 * j) = o; }
        ss = wave_sum(ss);
        if (lane < NPART) rowss[(size_t)row * NPART + lane] = (lane == 0) ? ss : 0.f;
    }
}

typedef short s16x4 __attribute__((ext_vector_type(4)));
#define LAS __attribute__((address_space(3)))
__device__ __forceinline__ float xhalf_max(float v) { auto rr = __builtin_amdgcn_permlane32_swap(__float_as_uint(v), __float_as_uint(v), false, false); return fmaxf(__uint_as_float(rr[0]), __uint_as_float(rr[1])); }
__device__ __forceinline__ float xhalf_sum(float v) { auto rr = __builtin_amdgcn_permlane32_swap(__float_as_uint(v), __float_as_uint(v), false, false); return __uint_as_float(rr[0]) + __uint_as_float(rr[1]); }
__device__ __forceinline__ h16x8 tr_frag(const LAS unsigned char* a) {
    const s16x4 lo = __builtin_amdgcn_ds_read_tr16_b64_v4i16((LAS s16x4*)a), hi = __builtin_amdgcn_ds_read_tr16_b64_v4i16((LAS s16x4*)(a + 512));
    typedef short s16x8 __attribute__((ext_vector_type(8)));
    const s16x8 v = __builtin_shufflevector(lo, hi, 0, 1, 2, 3, 4, 5, 6, 7);
    return __builtin_bit_cast(h16x8, v);
}
#define CROW0(i) (((i) & 3) + 8 * ((i) >> 2))
__device__ __forceinline__ void glds16(const void* gsrc, unsigned lds_dst) { unsigned keep;
    asm volatile("s_mov_b32 %0, m0\n\ts_mov_b32 m0, %2\n\ts_nop 0\n\tglobal_load_lds_dwordx4 %1, off\n\ts_mov_b32 m0, %0" : "=&s"(keep) : "v"(gsrc), "s"(lds_dst) : "memory"); }

namespace pg8 {
#define PG8_LAS __attribute__((address_space(3)))
typedef _Float16 bf16_t;
typedef _Float16 bf16x8 __attribute__((ext_vector_type(8)));
typedef float f32x4 __attribute__((ext_vector_type(4)));
typedef unsigned u32x4 __attribute__((ext_vector_type(4)));
constexpr int BM = 256, BK = 64, HALF = 128, HTB = HALF * BK * 2  , STAGE_BYTES = 8 * HTB, NXCD = 8, WGM = 8;

__host__ __device__ __forceinline__ int lds_byte(int r, int c) { const int st = (r >> 4) * 2 + (c >> 5), rr = r & 15, cc = c & 31, ob = rr * 64 + cc * 2; return st * 1024 + (ob ^ (((ob >> 9) & 1) << 5)); }
__host__ __device__ __forceinline__ void stage_rc(int b, int& R, int& C) { const int st = b / 1024, sb = b % 1024, swz = sb ^ (((sb >> 9) & 1) << 5); R = (st >> 1) * 16 + swz / 64; C = (st & 1) * 32 + (swz % 64) / 2; }
__host__ __device__ __forceinline__ int perm32(int rho) { const int n = rho >> 4, i = rho & 15; return 8 * (i >> 2) + 4 * n + (i & 3); }

struct Unit { int pm, pn; };
struct Gemm { const bf16_t* A; const bf16_t* Bt; int M, N, K; };

struct StaticOrder {
    int nM, nN, nwg, G, c;
    __host__ __device__ void init(int M, int N, int G_, int c_) { nM = M / BM; nN = N / BM; nwg = nM * nN; G = G_; c = c_; }
    __host__ __device__ bool next(int i, Unit& u) const {
        const long L = (long)i * G + c; if (L >= nwg) return false;
        int wgid = (int)L; { const int q = nwg / NXCD, r = nwg % NXCD, xcd = wgid % NXCD, off = wgid / NXCD; wgid = (xcd < r ? xcd * (q + 1) : r * (q + 1) + (xcd - r) * q) + off; }
        const int nig = WGM * nN, gid = wgid / nig, fm = gid * WGM, gsz = (nM - fm) < WGM ? (nM - fm) : WGM;
        u.pm = fm + ((wgid % nig) % gsz); u.pn = (wgid % nig) / gsz; return true;
    }
    __device__ __forceinline__ void a_ready(const Unit&) const {}
    __device__ __forceinline__ void done(const Unit&) const {}
};

template <class Epi, class Sched, bool ALIGN_EPI = false, bool SP2 = false>
__device__ __forceinline__ void gemm_phase(PG8_LAS unsigned char* lds, const Gemm g, const Sched& S, const Epi& E) {
    const int tid = threadIdx.x, wid = __builtin_amdgcn_readfirstlane(tid >> 6), lane = tid & 63, wr = wid >> 2, wc = wid & 3, fr = lane & 15, fq = lane >> 4;
    const int K = g.K, nt = K / BK;
    unsigned voffA[2], voffB[2];
#pragma unroll
    for (int i = 0; i < 2; ++i) { int R, C; stage_rc(tid * 16 + i * 8192, R, C); const int Rb = Epi::PERM ? ((R & ~31) + perm32(R & 31)) : R;
        voffA[i] = (unsigned)(R * K + C) * 2u; voffB[i] = (unsigned)(Rb * K + C) * 2u; }
    const size_t kstep = (size_t)(BK * 2);
    const size_t hstep = (size_t)HALF * K * 2;
    const size_t tstep = 2 * hstep;
    const unsigned ldsw = (unsigned)wid * 1024u;
    const int aoff = lds_byte(wr * 64 + fr, fq * 8), boff = lds_byte(wc * 32 + fr, fq * 8);
#define PG8_SA(b, h) (((b) * 2 + (h)) * HTB)
#define PG8_SB(b, h) ((4 + (b) * 2 + (h)) * HTB)
#define PG8_STAGE(bufoff, gbase, voff) do { _Pragma("unroll") for (int _i = 0; _i < 2; ++_i) \
        __builtin_amdgcn_global_load_lds((const unsigned*)((const char*)(gbase) + (voff)[_i]), (PG8_LAS unsigned*)(lds + (bufoff) + ldsw + _i * 8192), 16, 0, 0); } while (0)
#define PG8_LDA(dst, b, h) do { _Pragma("unroll") for (int m = 0; m < 4; ++m) _Pragma("unroll") for (int k = 0; k < 2; ++k) dst[m][k] = *(const PG8_LAS bf16x8*)(lds + PG8_SA(b, h) + aoff + m * 2048 + k * 1024); } while (0)
#define PG8_LDB(dst, b, h) do { _Pragma("unroll") for (int n = 0; n < 2; ++n) _Pragma("unroll") for (int k = 0; k < 2; ++k) dst[n][k] = *(const PG8_LAS bf16x8*)(lds + PG8_SB(b, h) + boff + n * 2048 + k * 1024); } while (0)
#define PG8_MMA(ai, bj, At, Bt) do { __builtin_amdgcn_s_setprio(1); _Pragma("unroll") for (int m = 0; m < 4; ++m) _Pragma("unroll") for (int n = 0; n < 2; ++n) _Pragma("unroll") for (int k = 0; k < 2; ++k) \
        acc[ai][bj][m][n] = __builtin_amdgcn_mfma_f32_16x16x32_f16(Bt[n][k], At[m][k], acc[ai][bj][m][n], 0, 0, 0); __builtin_amdgcn_s_setprio(0); } while (0)
#define PG8_WAIT_V(n) asm volatile("s_waitcnt vmcnt(" #n ")" ::: "memory")
#define PG8_WAIT_L(n) asm volatile("s_waitcnt lgkmcnt(" #n ")" ::: "memory")
#define PG8_BAR __builtin_amdgcn_s_barrier()
#define PG8_SCHED __builtin_amdgcn_sched_barrier(0)
    Unit cur, nxt; int ui = 0;
    if (!S.next(0, cur)) return;
    f32x4 acc[2][2][4][2];
#pragma unroll
    for (int a = 0; a < 2; ++a)
#pragma unroll
        for (int b = 0; b < 2; ++b)
#pragma unroll
            for (int m = 0; m < 4; ++m)
#pragma unroll
                for (int n = 0; n < 2; ++n) acc[a][b][m][n] = (f32x4){0.f, 0.f, 0.f, 0.f};
    bf16x8 At[4][2], B0[2][2], B1[2][2];
    const char* cA = (const char*)g.A + (size_t)cur.pm * tstep; const char* cB = (const char*)g.Bt + (size_t)cur.pn * tstep;
    S.a_ready(cur);
    if constexpr (SP2) {
        PG8_STAGE(PG8_SB(0, 0), cB, voffB); PG8_STAGE(PG8_SB(0, 1), cB + hstep, voffB); PG8_STAGE(PG8_SA(0, 0), cA, voffA); PG8_STAGE(PG8_SA(0, 1), cA + hstep, voffA);
        if (wr == 1) PG8_BAR;
        PG8_WAIT_V(2); PG8_BAR;
        PG8_STAGE(PG8_SB(1, 0), cB + kstep, voffB); PG8_STAGE(PG8_SA(1, 0), cA + kstep, voffA); PG8_STAGE(PG8_SB(1, 1), cB + hstep + kstep, voffB);
        PG8_WAIT_V(6); PG8_BAR;
    } else {
        PG8_STAGE(PG8_SB(0, 0), cB, voffB); PG8_STAGE(PG8_SA(0, 0), cA, voffA); PG8_STAGE(PG8_SB(0, 1), cB + hstep, voffB); PG8_STAGE(PG8_SA(0, 1), cA + hstep, voffA);
        if (wr == 1) PG8_BAR;
        PG8_WAIT_V(4); PG8_BAR;
        PG8_STAGE(PG8_SB(1, 0), cB + kstep, voffB); PG8_STAGE(PG8_SA(1, 0), cA + kstep, voffA); PG8_STAGE(PG8_SB(1, 1), cB + hstep + kstep, voffB);
        PG8_WAIT_V(6); PG8_BAR;
    }
    for (;;) {
        const bool has_next = S.next(ui + 1, nxt);
        const char* nA = has_next ? (const char*)g.A + (size_t)nxt.pm * tstep : cA; const char* nB = has_next ? (const char*)g.Bt + (size_t)nxt.pn * tstep : cB;
        for (int t = 0; t < nt; t += 2) {
            const bool last = (t == nt - 2);
            const char* a1 = cA + (size_t)(t + 1) * kstep;
            const char* a2 = last ? nA : cA + (size_t)(t + 2) * kstep; const char* b2 = last ? nB : cB + (size_t)(t + 2) * kstep;
            const char* a3 = a2 + kstep; const char* b3 = b2 + kstep;
            if (last && has_next) S.a_ready(nxt);
            if constexpr (SP2) {
            PG8_LDB(B0, 0, 0); PG8_LDB(B1, 0, 1); PG8_SCHED; PG8_LDA(At, 0, 0); PG8_STAGE(PG8_SA(1, 1), a1 + hstep, voffA);
            PG8_WAIT_V(8); PG8_WAIT_L(0); PG8_BAR; PG8_MMA(0, 0, At, B0); PG8_MMA(0, 1, At, B1); PG8_BAR; PG8_SCHED;
            PG8_LDA(At, 0, 1); PG8_STAGE(PG8_SB(0, 0), b2, voffB); PG8_STAGE(PG8_SB(0, 1), b2 + hstep, voffB); PG8_STAGE(PG8_SA(0, 0), a2, voffA);
            PG8_WAIT_V(8); PG8_WAIT_L(0); PG8_BAR; PG8_MMA(1, 0, At, B0); PG8_MMA(1, 1, At, B1); PG8_BAR; PG8_SCHED;
            PG8_LDB(B0, 1, 0); PG8_LDB(B1, 1, 1); PG8_SCHED; PG8_LDA(At, 1, 0); PG8_STAGE(PG8_SA(0, 1), a2 + hstep, voffA);
            PG8_WAIT_V(8); PG8_WAIT_L(0); PG8_BAR; PG8_MMA(0, 0, At, B0); PG8_MMA(0, 1, At, B1); PG8_BAR; PG8_SCHED;
            PG8_LDA(At, 1, 1); PG8_STAGE(PG8_SB(1, 0), b3, voffB); PG8_STAGE(PG8_SB(1, 1), b3 + hstep, voffB); PG8_STAGE(PG8_SA(1, 0), a3, voffA);
            PG8_WAIT_V(8); PG8_WAIT_L(0); PG8_BAR; PG8_MMA(1, 0, At, B0); PG8_MMA(1, 1, At, B1); PG8_BAR; PG8_SCHED;
            } else {
            PG8_LDB(B0, 0, 0); PG8_SCHED; PG8_LDA(At, 0, 0); PG8_STAGE(PG8_SA(1, 1), a1 + hstep, voffA);
            PG8_WAIT_L(8); PG8_BAR; PG8_WAIT_L(0); PG8_MMA(0, 0, At, B0); PG8_BAR; PG8_SCHED;
            PG8_LDB(B1, 0, 1); PG8_STAGE(PG8_SB(0, 0), b2, voffB);
            PG8_BAR; PG8_WAIT_L(0); PG8_MMA(0, 1, At, B1); PG8_BAR;
            PG8_LDA(At, 0, 1); PG8_STAGE(PG8_SA(0, 0), a2, voffA);
            PG8_BAR; PG8_WAIT_L(0); PG8_MMA(1, 0, At, B0); PG8_BAR; PG8_SCHED;
            PG8_STAGE(PG8_SB(0, 1), b2 + hstep, voffB);
            PG8_WAIT_V(6); PG8_BAR; PG8_MMA(1, 1, At, B1); PG8_BAR;
            PG8_LDB(B0, 1, 0); PG8_SCHED; PG8_LDA(At, 1, 0); PG8_STAGE(PG8_SA(0, 1), a2 + hstep, voffA);
            PG8_WAIT_L(8); PG8_BAR; PG8_WAIT_L(0); PG8_MMA(0, 0, At, B0); PG8_BAR; PG8_SCHED;
            PG8_LDB(B1, 1, 1); PG8_STAGE(PG8_SB(1, 0), b3, voffB);
            PG8_BAR; PG8_WAIT_L(0); PG8_MMA(0, 1, At, B1); PG8_BAR;
            PG8_LDA(At, 1, 1); PG8_STAGE(PG8_SA(1, 0), a3, voffA);
            PG8_BAR; PG8_WAIT_L(0); PG8_MMA(1, 0, At, B0); PG8_BAR; PG8_SCHED;
            PG8_STAGE(PG8_SB(1, 1), b3 + hstep, voffB);
            PG8_WAIT_V(6); PG8_BAR; PG8_MMA(1, 1, At, B1); PG8_BAR;
            }
        }
        if constexpr (ALIGN_EPI) { if (wr == 0) PG8_BAR; }
        if constexpr (!Epi::AFTER_DRAIN) { E(acc, cur, wr, wc, fr, fq); S.done(cur); }
        if (!has_next) break;
#pragma unroll
        for (int a = 0; a < 2; ++a)
#pragma unroll
            for (int b = 0; b < 2; ++b)
#pragma unroll
                for (int m = 0; m < 4; ++m)
#pragma unroll
                    for (int n = 0; n < 2; ++n) acc[a][b][m][n] = (f32x4){0.f, 0.f, 0.f, 0.f};
        cur = nxt; cA = nA; cB = nB; ++ui;
        if constexpr (ALIGN_EPI) { if (wr == 1) PG8_BAR; }
    }
    PG8_WAIT_V(0);
    if constexpr (!ALIGN_EPI) { if (wr == 0) PG8_BAR; }
    PG8_BAR;
    if constexpr (Epi::AFTER_DRAIN) { E.fused(acc, cur, wr, wc, fr, fq, lds, wid, lane); S.done(cur); }
#undef PG8_SA
#undef PG8_SB
#undef PG8_STAGE
#undef PG8_LDA
#undef PG8_LDB
#undef PG8_MMA
#undef PG8_WAIT_V
#undef PG8_WAIT_L
#undef PG8_BAR
#undef PG8_SCHED
}

struct EpiProj {
    static constexpr bool PERM = true, AFTER_DRAIN = false;
    bf16_t* O; const float* rowss; float* kmpart;
    __device__ __forceinline__ void operator()(const f32x4 (&acc)[2][2][4][2], const Unit& u, int wr, int wc, int fr, int fq) const {
        const int row0 = u.pm * BM + wr * 64 + fr, col0 = u.pn * BM + wc * 32 + 8 * fq;
        const bool want_km = (u.pn == 9) || (u.pn == 10);
        f32x4 cs[2][2];
#pragma unroll
        for (int bj = 0; bj < 2; ++bj)
#pragma unroll
            for (int n = 0; n < 2; ++n) cs[bj][n] = (f32x4){0.f, 0.f, 0.f, 0.f};
#pragma unroll
        for (int ai = 0; ai < 2; ++ai)
#pragma unroll
            for (int m = 0; m < 4; ++m) { const size_t row = (size_t)(row0 + ai * HALF + m * 16);
                const f32x4* rs = (const f32x4*)(rowss + row * 16); const f32x4 s0 = rs[0], s1 = rs[1], s2 = rs[2], s3 = rs[3];
                const float tot = ((s0[0] + s0[1]) + (s0[2] + s0[3])) + ((s1[0] + s1[1]) + (s1[2] + s1[3])) + ((s2[0] + s2[1]) + (s2[2] + s2[3])) + ((s3[0] + s3[1]) + (s3[2] + s3[3]));
                const float rstd = rsqrtf(tot * (1.0f / 1024.0f) + 1e-6f);
                bf16_t* rowp = O + row * 3840 + col0;
#pragma unroll
                for (int bj = 0; bj < 2; ++bj) { const f32x4 v0 = acc[ai][bj][m][0] * rstd, v1 = acc[ai][bj][m][1] * rstd; bf16x8 w;
                    w[0] = (bf16_t)v0[0]; w[1] = (bf16_t)v0[1]; w[2] = (bf16_t)v0[2]; w[3] = (bf16_t)v0[3]; w[4] = (bf16_t)v1[0]; w[5] = (bf16_t)v1[1]; w[6] = (bf16_t)v1[2]; w[7] = (bf16_t)v1[3];
                    *(bf16x8*)(rowp + bj * HALF) = w; cs[bj][0] += v0; cs[bj][1] += v1; } }
        if (want_km) {
#pragma unroll
            for (int bj = 0; bj < 2; ++bj)
#pragma unroll
                for (int n = 0; n < 2; ++n)
#pragma unroll
                    for (int k = 0; k < 4; ++k) { float v = cs[bj][n][k]; v += __shfl_xor(v, 1); v += __shfl_xor(v, 2); v += __shfl_xor(v, 4); v += __shfl_xor(v, 8); cs[bj][n][k] = v * (1.0f / 256.0f); }
            if (fr == 0) {
#pragma unroll
                for (int bj = 0; bj < 2; ++bj)
#pragma unroll
                    for (int n = 0; n < 2; ++n) { const int cm = col0 + bj * HALF + 4 * n - 2304;
                        *(f32x4*)(kmpart + ((size_t)((wr * 8 + (u.pm >> 4)) * 8 + (cm >> 6)) * 16 + (u.pm & 15)) * 64 + (cm & 63)) = cs[bj][n]; }
            }
        }
    }
};
template <int LAYER> struct EpiRes {
    static constexpr bool PERM = true, AFTER_DRAIN = false;
    const float* x0; float* xout; bf16_t* xh; float* rowss;
    __device__ __forceinline__ void operator()(const f32x4 (&acc)[2][2][4][2], const Unit& u, int wr, int wc, int fr, int fq) const {
        const int row0 = u.pm * BM + wr * 64 + fr, col0 = u.pn * BM + wc * 32 + 8 * fq;
#pragma unroll
        for (int ai = 0; ai < 2; ++ai)
#pragma unroll
            for (int m = 0; m < 4; ++m) { const size_t row = (size_t)(row0 + ai * HALF + m * 16); float ss = 0.f;
#pragma unroll
                for (int bj = 0; bj < 2; ++bj) { const size_t off = row * 1024 + col0 + bj * HALF; f32x4 v0, v1;
                    if (LAYER == 0) { v0 = *(const f32x4*)(x0 + off) + acc[ai][bj][m][0]; v1 = *(const f32x4*)(x0 + off + 4) + acc[ai][bj][m][1];
                        bf16x8 w; w[0] = (bf16_t)v0[0]; w[1] = (bf16_t)v0[1]; w[2] = (bf16_t)v0[2]; w[3] = (bf16_t)v0[3]; w[4] = (bf16_t)v1[0]; w[5] = (bf16_t)v1[1]; w[6] = (bf16_t)v1[2]; w[7] = (bf16_t)v1[3];
                        *(bf16x8*)(xh + off) = w; }
                    else { const bf16x8 xp = *(const bf16x8*)(xh + off);
                        v0 = (f32x4){(float)xp[0], (float)xp[1], (float)xp[2], (float)xp[3]} + acc[ai][bj][m][0]; v1 = (f32x4){(float)xp[4], (float)xp[5], (float)xp[6], (float)xp[7]} + acc[ai][bj][m][1];
                        *(f32x4*)(xout + off) = v0; *(f32x4*)(xout + off + 4) = v1; }
                    ss += ((v0[0] * v0[0] + v0[1] * v0[1]) + (v0[2] * v0[2] + v0[3] * v0[3])) + ((v1[0] * v1[0] + v1[1] * v1[1]) + (v1[2] * v1[2] + v1[3] * v1[3])); }
                ss += __shfl_xor(ss, 16); ss += __shfl_xor(ss, 32);
                if (fq == 0) rowss[row * 16 + u.pn * 4 + wc] = ss; }
    }
};
}


__device__ __forceinline__ void gemm_in(const Params& p, int layer, unsigned char* lds) {
    pg8::Gemm g{(const h16*)(p.ws + WS_XH), (const h16*)(p.ws + WS_WIN) + (size_t)layer * NIN * DM, MROWS, NIN, DM};
    pg8::StaticOrder S; S.init(MROWS, NIN, (int)gridDim.x, (int)blockIdx.x);
    pg8::EpiProj E{(h16*)(p.ws + WS_PROJ), (const float*)(p.ws + WS_ROWSS), (float*)(p.ws + WS_KMEAN)};
    pg8::gemm_phase<pg8::EpiProj, pg8::StaticOrder, true, true>((PG8_LAS unsigned char*)lds, g, S, E);
}
template <int LAYER> __device__ __forceinline__ void gemm_out(const Params& p, unsigned char* lds) {
    pg8::Gemm g{(const h16*)(p.ws + WS_MIX), (const h16*)(p.ws + WS_WOUT) + (size_t)LAYER * DM * DM, MROWS, DM, DM};
    pg8::StaticOrder S; S.init(MROWS, DM, (int)gridDim.x, (int)blockIdx.x);
    pg8::EpiRes<LAYER> E{p.x, p.out, (h16*)(p.ws + WS_XH), (float*)(p.ws + WS_ROWSS)};
    pg8::gemm_phase<pg8::EpiRes<LAYER>, pg8::StaticOrder, true, true>((PG8_LAS unsigned char*)lds, g, S, E);
}

__device__ __forceinline__ void phase_stats(const Params& p, unsigned char* lds_g) {
    LAS unsigned char* lds = (LAS unsigned char*)lds_g;
    const h16* proj = (const h16*)(p.ws + WS_PROJ); float* kv = (float*)(p.ws + WS_KV);
    const int tid = threadIdx.x, lane = tid & 63, wid = __builtin_amdgcn_readfirstlane(tid >> 6), r = lane & 31, hi = lane >> 5;
    const int lanepart = (4 * hi + ((lane & 15) >> 2)) * 64 + ((lane >> 4) & 1) * 32 + (lane & 3) * 8;
#pragma unroll 1
    for (int u = blockIdx.x; u < 512; u += gridDim.x) {
        const int b = u >> 6, hh = (u >> 4) & 3, np = u & 15;
        const float log_g = logf(1.0f - exp2f(-5.0f - (float)hh));
        __syncthreads();
#pragma unroll
        for (int it = 0; it < 4; ++it) {
            const int pc = tid + 512 * it, cn = pc >> 10, key = (pc >> 3) & 127, ch = pc & 7;
            const h16* src = proj + (size_t)(b * SEQ + (2 * np + cn) * 128 + key) * NIN + hh * 64 + ch * 8;
            h16x8 kk = *(const h16x8*)(src + C_RK); const h16x8 vv = *(const h16x8*)(src + C_RV);
            const float z = __expf(log_g * (float)(127 - key)) * 0.125f;
#pragma unroll
            for (int k = 0; k < 8; ++k) kk[k] = (h16)((float)kk[k] * z);
            const int off = cn * 32768 + (ch >> 2) * 8192 + (key >> 4) * 1024 + (key & 15) * 64 + (ch & 3) * 16;
            *(LAS h16x8*)(lds + off) = kk; *(LAS h16x8*)(lds + off + 16384) = vv;
        }
        __syncthreads();
        const int cn = wid >> 2, eb = (wid >> 1) & 1, dbk = wid & 1;
        const LAS unsigned char* kimg = lds + cn * 32768 + dbk * 8192 + lanepart; const LAS unsigned char* vimg = lds + cn * 32768 + 16384 + eb * 8192 + lanepart;
        f32x16 acc;
#pragma unroll
        for (int i = 0; i < 16; ++i) acc[i] = 0.f;
#pragma unroll
        for (int ks = 0; ks < 8; ++ks) acc = __builtin_amdgcn_mfma_f32_32x32x16_f16(tr_frag(vimg + ks * 1024), tr_frag(kimg + ks * 1024), acc, 0, 0, 0);
        float* dst = kv + ((size_t)((b * 4 + hh) * 32 + 2 * np + cn)) * 4096 + (32 * eb + 4 * hi) * 64 + 32 * dbk + r;
#pragma unroll
        for (int i = 0; i < 16; ++i) dst[CROW0(i) * 64] = acc[i];
    }
}

typedef _Float16 h16x2 __attribute__((ext_vector_type(2)));
typedef float f32x2 __attribute__((ext_vector_type(2)));
__device__ __forceinline__ void conv_unit(const Params& p, int layer, int b, int tt, unsigned char* lds_g) {
    LAS unsigned char* lds = (LAS unsigned char*)lds_g;
    const h16* projb = (const h16*)(p.ws + WS_PROJ) + (size_t)b * SEQ * NIN; h16* mix = (h16*)(p.ws + WS_MIX);
    const int tid = threadIdx.x, lane = tid & 63, wid = __builtin_amdgcn_readfirstlane(tid >> 6), r = lane & 31, hi = lane >> 5;
    const int cp = tid & 127, tg = __builtin_amdgcn_readfirstlane(tid >> 7), t0 = tt * 64, tb0 = t0 + 16 * tg - 30;
    constexpr int YS = 0, SIMG = 65536;
    float y0[16], y1[16];
    {
        float w0[31], w1[31]; const float* cw = p.conv_w + (size_t)layer * 31 * 256 + 2 * cp;
#pragma unroll
        for (int jj = 0; jj < 31; ++jj) { const f32x2 wv = *(const f32x2*)(cw + jj * 256); w0[jj] = wv[0]; w1[jj] = wv[1]; }
        const f32x2 cbv = *(const f32x2*)(p.conv_b + layer * 256 + 2 * cp);
#pragma unroll
        for (int tl = 0; tl < 16; ++tl) { y0[tl] = cbv[0]; y1[tl] = cbv[1]; }
#pragma unroll
        for (int rr = 0; rr < 46; ++rr) {
            const int t = tb0 + rr; float a0 = 0.f, a1 = 0.f;
            if (t >= 0) { const h16x2 av = *(const h16x2*)(projb + (size_t)t * NIN + C_AVAL + 2 * cp), gv = *(const h16x2*)(projb + (size_t)t * NIN + C_AGLU + 2 * cp);
                a0 = (float)av[0] * __builtin_amdgcn_rcpf(1.0f + __expf(-(float)gv[0])); a1 = (float)av[1] * __builtin_amdgcn_rcpf(1.0f + __expf(-(float)gv[1])); }
#pragma unroll
            for (int tl = 0; tl < 16; ++tl) { const int jj = rr - tl; if (jj >= 0 && jj < 31) { y0[tl] += w0[jj] * a0; y1[tl] += w1[jj] * a1; } }
        }
    }
    __syncthreads();
#pragma unroll
    for (int tl = 0; tl < 16; ++tl) *(LAS f32x2*)(lds + YS + ((16 * tg + tl) * 256 + 2 * cp) * 4) = (f32x2){y0[tl], y1[tl]};
    h16x8 wf[16];
    {
        const h16* wp = (const h16*)(p.ws + WS_WPW) + (size_t)layer * 65536 + (size_t)(32 * wid + r) * 256 + 8 * hi;
#pragma unroll
        for (int ks = 0; ks < 16; ++ks) wf[ks] = *(const h16x8*)(wp + 16 * ks);
    }
    __syncthreads();
    {
        const f32x4 lg = *(const f32x4*)(p.ln_g + layer * 256 + lane * 4), lb = *(const f32x4*)(p.ln_b + layer * 256 + lane * 4);
#pragma unroll 1
        for (int kb = 0; kb < 8; kb += 4) {
        f32x4 v[4]; float s1[4], s2[4];
#pragma unroll
        for (int k = 0; k < 4; ++k) { v[k] = *(const LAS f32x4*)(lds + YS + ((wid * 8 + kb + k) * 256 + lane * 4) * 4);
            s1[k] = (v[k][0] + v[k][1]) + (v[k][2] + v[k][3]); s2[k] = (v[k][0] * v[k][0] + v[k][1] * v[k][1]) + (v[k][2] * v[k][2] + v[k][3] * v[k][3]); }
#pragma unroll
        for (int o = 1; o < 64; o <<= 1)
#pragma unroll
            for (int k = 0; k < 4; ++k) { s1[k] += __shfl_xor(s1[k], o); s2[k] += __shfl_xor(s2[k], o); }
#pragma unroll
        for (int k = 0; k < 4; ++k) { const int t = wid * 8 + kb + k; const float mu = s1[k] * (1.0f / 256.0f); const float var = fmaxf(s2[k] * (1.0f / 256.0f) - mu * mu, 0.f); const float rs = rsqrtf(var + 1e-5f);
            h16x4 o; o[0] = (h16)silu_f((v[k][0] - mu) * rs * lg[0] + lb[0]); o[1] = (h16)silu_f((v[k][1] - mu) * rs * lg[1] + lb[1]); o[2] = (h16)silu_f((v[k][2] - mu) * rs * lg[2] + lb[2]); o[3] = (h16)silu_f((v[k][3] - mu) * rs * lg[3] + lb[3]);
            *(LAS h16x4*)(lds + SIMG + t * 512 + (((lane >> 1) ^ (t & 15)) << 4) + 8 * (lane & 1)) = o; }
        }
    }
    __syncthreads();
#pragma unroll
    for (int tb = 0; tb < 2; ++tb) {
        f32x16 acc;
#pragma unroll
        for (int i = 0; i < 16; ++i) acc[i] = 0.f;
#pragma unroll
        for (int ks = 0; ks < 16; ++ks) acc = __builtin_amdgcn_mfma_f32_32x32x16_f16(wf[ks], *(const LAS h16x8*)(lds + SIMG + (32 * tb + r) * 512 + (((2 * ks + hi) ^ (r & 15)) << 4)), acc, 0, 0, 0);
        const int t = t0 + 32 * tb + r, n0 = 32 * wid + 4 * hi;
        const h16* gp = projb + (size_t)t * NIN + C_AGATE + n0; h16* dst = mix + ((size_t)b * SEQ + t) * DM + n0; const float* pb = p.pw_b + layer * 256 + n0;
#pragma unroll
        for (int g = 0; g < 4; ++g) { const h16x4 ga = *(const h16x4*)(gp + 8 * g); const f32x4 bb = *(const f32x4*)(pb + 8 * g); h16x4 oa;
#pragma unroll
            for (int k = 0; k < 4; ++k) oa[k] = (h16)((acc[4 * g + k] + bb[k]) * silu_f((float)ga[k]));
            *(h16x4*)(dst + 8 * g) = oa; }
    }
}

__device__ __forceinline__ void ret_unit(const Params& p, int b, int hh, int n, unsigned char* lds_g) {
    LAS unsigned char* lds = (LAS unsigned char*)lds_g;
    const h16* projb = (const h16*)(p.ws + WS_PROJ) + (size_t)(b * SEQ + n * 128) * NIN; h16* mix = (h16*)(p.ws + WS_MIX); const float* kv = (const float*)(p.ws + WS_KV);
    const int tid = threadIdx.x, lane = tid & 63, wid = __builtin_amdgcn_readfirstlane(tid >> 6), r = lane & 31, hi = lane >> 5, g4 = wid & 3, eh = wid >> 2;
    const float log_g = logf(1.0f - exp2f(-5.0f - (float)hh));
    constexpr int KIMG = 0, VIMG = 16384, RIMG = 32768, XS = 40960;
    const h16x8 rr = *(const h16x8*)((const h16*)(p.ws + WS_RST) + ((size_t)((b * 4 + hh) * 32 + n)) * 4096 + tid * 8);
    __syncthreads();
    {
        const int e = tid >> 3, ch = tid & 7;
        *(LAS h16x8*)(lds + RIMG + e * 128 + ((ch ^ ((e >> 1) & 7)) << 4)) = rr;
#pragma unroll
        for (int it = 0; it < 2; ++it) {
            const int key = (tid >> 3) + 64 * it;
            h16x8 kk = *(const h16x8*)(projb + (size_t)key * NIN + C_RK + hh * 64 + ch * 8); const h16x8 vv = *(const h16x8*)(projb + (size_t)key * NIN + C_RV + hh * 64 + ch * 8);
            const float z = __expf(-log_g * (float)key) * 0.125f;
#pragma unroll
            for (int k = 0; k < 8; ++k) kk[k] = (h16)((float)kk[k] * z);
            *(LAS h16x8*)(lds + KIMG + key * 128 + ((ch ^ ((key >> 1) & 7)) << 4)) = kk;
            *(LAS h16x8*)(lds + VIMG + (ch >> 2) * 8192 + (key >> 4) * 1024 + (key & 15) * 64 + (ch & 3) * 16) = vv;
        }
    }
    const int qi = 32 * g4 + r;
    h16x8 qf[4];
    {
        const float zq = __expf(log_g * (float)qi);
#pragma unroll
        for (int s = 0; s < 4; ++s) { qf[s] = *(const h16x8*)(projb + (size_t)qi * NIN + C_RQ + hh * 64 + 16 * s + 8 * hi);
#pragma unroll
            for (int k = 0; k < 8; ++k) qf[s][k] = (h16)((float)qf[s][k] * zq); }
    }
    __syncthreads();
    const int rsw = (r >> 1) & 7;
    const int lanepart = (4 * hi + ((lane & 15) >> 2)) * 64 + ((lane >> 4) & 1) * 32 + (lane & 3) * 8;
    f32x16 o;
#pragma unroll
    for (int i = 0; i < 16; ++i) o[i] = 0.f;
#pragma unroll 1
    for (int jb = 0; jb <= g4; ++jb) {
        f32x16 c;
#pragma unroll
        for (int i = 0; i < 16; ++i) c[i] = 0.f;
#pragma unroll
        for (int s = 0; s < 4; ++s) c = __builtin_amdgcn_mfma_f32_32x32x16_f16(*(const LAS h16x8*)(lds + KIMG + (32 * jb + r) * 128 + (((2 * s + hi) ^ rsw) << 4)), qf[s], c, 0, 0, 0);
        if (jb == g4) {
#pragma unroll
            for (int i = 0; i < 16; ++i) if (CROW0(i) + 4 * hi > r) c[i] = 0.f;
        }
        h16x8 pf0, pf1;
#pragma unroll
        for (int k = 0; k < 8; ++k) { pf0[k] = (h16)c[k]; pf1[k] = (h16)c[8 + k]; }
        o = __builtin_amdgcn_mfma_f32_32x32x16_f16(tr_frag(lds + VIMG + eh * 8192 + (2 * jb) * 1024 + lanepart), pf0, o, 0, 0, 0);
        o = __builtin_amdgcn_mfma_f32_32x32x16_f16(tr_frag(lds + VIMG + eh * 8192 + (2 * jb + 1) * 1024 + lanepart), pf1, o, 0, 0, 0);
    }
#pragma unroll
    for (int s = 0; s < 4; ++s) o = __builtin_amdgcn_mfma_f32_32x32x16_f16(*(const LAS h16x8*)(lds + RIMG + (32 * eh + r) * 128 + (((2 * s + hi) ^ rsw) << 4)), qf[s], o, 0, 0, 0);
    float s1 = 0.f, s2 = 0.f;
#pragma unroll
    for (int i = 0; i < 16; ++i) { s1 += o[i]; s2 += o[i] * o[i]; }
    s1 = xhalf_sum(s1); s2 = xhalf_sum(s2);
    LAS float* xs = (LAS float*)(lds + XS);
    if (hi == 0) { xs[(wid * 32 + r) * 2] = s1; xs[(wid * 32 + r) * 2 + 1] = s2; }
    __syncthreads();
    {
        const float t1 = xs[((wid ^ 4) * 32 + r) * 2], t2 = xs[((wid ^ 4) * 32 + r) * 2 + 1];
        const float a1 = (eh == 0) ? (s1 + t1) : (t1 + s1), a2 = (eh == 0) ? (s2 + t2) : (t2 + s2);
        const float mu = a1 * (1.0f / 64.0f); const float var = fmaxf(a2 * (1.0f / 64.0f) - mu * mu, 0.f); const float rs = rsqrtf(var + 1e-5f);
        const int col = hh * 64 + 32 * eh + 4 * hi;
        const h16* gp = projb + (size_t)qi * NIN + C_RGATE + col; h16* dst = mix + ((size_t)(b * SEQ + n * 128 + qi)) * DM + 256 + col;
#pragma unroll
        for (int g = 0; g < 4; ++g) { const h16x4 ga = *(const h16x4*)(gp + 8 * g); h16x4 oa;
#pragma unroll
            for (int k = 0; k < 4; ++k) oa[k] = (h16)((o[4 * g + k] - mu) * rs * silu_f((float)ga[k]));
            *(h16x4*)(dst + 8 * g) = oa; }
    }
}

constexpr float MOBA_THR = 8.0f;
__device__ __forceinline__ void moba_unit(const Params& p, int b, int hh, int j, unsigned char* lds_g) {
    LAS unsigned char* lds = (LAS unsigned char*)lds_g;
    const int tid = threadIdx.x, lane = tid & 63, wid = __builtin_amdgcn_readfirstlane(tid >> 6), r = lane & 31, hi = lane >> 5;
    const h16* projb = (const h16*)(p.ws + WS_PROJ) + (size_t)b * SEQ * NIN; h16* mix = (h16*)(p.ws + WS_MIX);
    const int qrow = j * 256 + wid * 32 + r;
    h16x8 qf[4];
#pragma unroll
    for (int s = 0; s < 4; ++s) qf[s] = *(const h16x8*)(projb + (size_t)qrow * NIN + C_MQ + hh * 64 + 16 * s + 8 * hi);
    unsigned selmask = 0u;
    if (j <= 3) selmask = (1u << j) - 1u;
    else {
        float g0 = -3.0e38f, g1 = -3.0e38f, g2 = -3.0e38f; int i0 = 0, i1 = 0, i2 = 0;
        const float* km = (const float*)(p.ws + WS_KMEAN) + ((size_t)(b * 8 + hh) * 16) * 64 + 8 * hi;
#pragma unroll 1
        for (int n = 0; n < j; ++n) { float s = 0.f;
#pragma unroll
            for (int ss = 0; ss < 4; ++ss) { const f32x4 k0 = *(const f32x4*)(km + n * 64 + 16 * ss) + *(const f32x4*)(km + 65536 + n * 64 + 16 * ss),
                                                             k1 = *(const f32x4*)(km + n * 64 + 16 * ss + 4) + *(const f32x4*)(km + 65536 + n * 64 + 16 * ss + 4);
                s += (float)qf[ss][0] * k0.x + (float)qf[ss][1] * k0.y + (float)qf[ss][2] * k0.z + (float)qf[ss][3] * k0.w
                   + (float)qf[ss][4] * k1.x + (float)qf[ss][5] * k1.y + (float)qf[ss][6] * k1.z + (float)qf[ss][7] * k1.w; }
            s = xhalf_sum(s);
            if (s > g0) { g2 = g1; i2 = i1; g1 = g0; i1 = i0; g0 = s; i0 = n; }
            else if (s > g1) { g2 = g1; i2 = i1; g1 = s; i1 = n; }
            else if (s > g2) { g2 = s; i2 = n; } }
        selmask = (1u << i0) | (1u << i1) | (1u << i2);
    }
    constexpr float C2 = 0.125f * 1.4426950408889634f;
#pragma unroll
    for (int s = 0; s < 4; ++s)
#pragma unroll
        for (int k = 0; k < 8; ++k) qf[s][k] = (h16)((float)qf[s][k] * C2);
    const float slope2 = exp2f(-(float)(hh + 1)) * 1.4426950408889634f;
    f32x16 o0, o1;
#pragma unroll
    for (int i = 0; i < 16; ++i) { o0[i] = 0.f; o1[i] = 0.f; }
    float mref = 0.f, lsum = 0.f; bool first = true;
    const unsigned lds0 = (unsigned)(__UINTPTR_TYPE__)lds;
    const int dkey = 8 * wid + (lane >> 3);
    const h16* ksrc = projb + (size_t)dkey * NIN + C_MK + hh * 64 + (((lane & 7) ^ ((dkey >> 1) & 7)) << 3);
    const h16* vsrc = projb + (size_t)(16 * (wid & 3) + (lane >> 2)) * NIN + C_MV + hh * 64 + (wid >> 2) * 32 + (lane & 3) * 8;
    const unsigned kdst = lds0 + wid * 1024, vdst = lds0 + 8192 + (wid >> 2) * 4096 + (wid & 3) * 1024;
#define MOBA_DMA(tile) do { const int kp_ = j * 256 + 192 - 64 * (tile); const unsigned so_ = (unsigned)(((tile) & 3) * 16384); \
        glds16(ksrc + (size_t)kp_ * NIN, (unsigned)__builtin_amdgcn_readfirstlane(kdst + so_)); glds16(vsrc + (size_t)kp_ * NIN, (unsigned)__builtin_amdgcn_readfirstlane(vdst + so_)); } while (0)
#define MOBA_WAIT_BAR(N) asm volatile("s_waitcnt vmcnt(" #N ") lgkmcnt(0)\n\ts_barrier" ::: "memory")
    const int rK = r * 128, rsw = (r >> 1) & 7;
    const int rV = 8192 + (4 * hi + ((lane & 15) >> 2)) * 64 + ((lane >> 4) & 1) * 32 + (lane & 3) * 8;
    const int nt = 4 * (j + 1);
    const int wdiag = wid >> 1;
#define MOBA_CIN(T, C0, C1) do { const int kp_ = j * 256 + 192 - 64 * (T); const int nb_ = kp_ >> 8, tl_ = (kp_ >> 6) & 3; const bool own_ = (nb_ == j); \
        const bool val_ = own_ ? true : (((selmask >> (nb_ & 31)) & 1u) != 0u); \
        const float tbh_ = val_ ? (slope2 * (float)(kp_ - qrow + 4 * hi) - mref) : -INFINITY; \
        _Pragma("unroll") for (int i = 0; i < 16; ++i) { C0[i] = fmaf(slope2, (float)CROW0(i), tbh_); C1[i] = fmaf(slope2, (float)(CROW0(i) + 32), tbh_); } \
        if (own_ && tl_ >= wdiag) { const int lim2_ = 32 * wid - 64 * tl_ + r - 4 * hi; \
            _Pragma("unroll") for (int i = 0; i < 16; ++i) { if (CROW0(i) > lim2_) C0[i] = -INFINITY; if (CROW0(i) + 32 > lim2_) C1[i] = -INFINITY; } } } while (0)
#define MOBA_QK(T, C0, C1) do { const LAS unsigned char* kb_ = lds + ((T) & 3) * 16384 + rK; \
        _Pragma("unroll") for (int s = 0; s < 4; ++s) { \
            const h16x8 k0_ = *(const LAS h16x8*)(kb_ + (((2 * s + hi) ^ rsw) << 4)), k1_ = *(const LAS h16x8*)(kb_ + 4096 + (((2 * s + hi) ^ rsw) << 4)); \
            C0 = __builtin_amdgcn_mfma_f32_32x32x16_f16(k0_, qf[s], C0, 0, 0, 0); C1 = __builtin_amdgcn_mfma_f32_32x32x16_f16(k1_, qf[s], C1, 0, 0, 0); } } while (0)
#define MOBA_DECIDE(T, C0, C1) do { float m_ = __builtin_fmaxf(C0[0], C1[0]); \
        _Pragma("unroll") for (int i = 1; i < 16; ++i) m_ = __builtin_fmaxf(__builtin_fmaxf(m_, C0[i]), C1[i]); \
        m_ = xhalf_max(m_); \
        const int kp_ = j * 256 + 192 - 64 * (T); const bool fst_ = ((kp_ >> 8) == j) && (((kp_ >> 6) & 3) == wdiag); \
        if (fst_ || __any(m_ > MOBA_THR)) { const float dl_ = fst_ ? m_ : __builtin_fmaxf(m_, 0.f); const float f_ = fst_ ? 1.0f : __builtin_amdgcn_exp2f(-dl_); mref += dl_; lsum *= f_; \
            _Pragma("unroll") for (int i = 0; i < 16; ++i) { C0[i] -= dl_; C1[i] -= dl_; o0[i] *= f_; o1[i] *= f_; } } } while (0)
#define MOBA_STEP(T, P0, P1, N0, N1) do { \
        if ((T) + 3 < nt) MOBA_DMA((T) + 3); \
        MOBA_CIN((T) + 1, N0, N1); MOBA_QK((T) + 1, N0, N1); \
        float ps_ = 0.f; \
        _Pragma("unroll") for (int i = 0; i < 16; ++i) { P0[i] = __builtin_amdgcn_exp2f(P0[i]); P1[i] = __builtin_amdgcn_exp2f(P1[i]); ps_ += P0[i] + P1[i]; } \
        lsum += ps_; \
        h16x8 pf_[4]; \
        _Pragma("unroll") for (int k = 0; k < 8; ++k) { pf_[0][k] = (h16)P0[k]; pf_[1][k] = (h16)P0[8 + k]; pf_[2][k] = (h16)P1[k]; pf_[3][k] = (h16)P1[8 + k]; } \
        { const LAS unsigned char* vb_ = lds + ((T) & 3) * 16384 + rV; \
          _Pragma("unroll") for (int t = 0; t < 4; ++t) { const h16x8 v0_ = tr_frag(vb_ + t * 1024), v1_ = tr_frag(vb_ + 4096 + t * 1024); \
            o0 = __builtin_amdgcn_mfma_f32_32x32x16_f16(v0_, pf_[t], o0, 0, 0, 0); o1 = __builtin_amdgcn_mfma_f32_32x32x16_f16(v1_, pf_[t], o1, 0, 0, 0); } } \
        if ((T) + 1 < nt) MOBA_DECIDE((T) + 1, N0, N1); \
        if ((T) + 3 < nt) MOBA_WAIT_BAR(2); else MOBA_WAIT_BAR(0); } while (0)
    MOBA_WAIT_BAR(0);
    MOBA_DMA(0); MOBA_DMA(1); MOBA_DMA(2);
    MOBA_WAIT_BAR(2);
    f32x16 cA0, cA1, cB0, cB1;
    MOBA_CIN(0, cA0, cA1); MOBA_QK(0, cA0, cA1); MOBA_DECIDE(0, cA0, cA1);
#pragma unroll 1
    for (int tt = 0; tt < nt; tt += 2) {
        MOBA_STEP(tt, cA0, cA1, cB0, cB1);
        MOBA_STEP(tt + 1, cB0, cB1, cA0, cA1);
    }
#undef MOBA_CIN
#undef MOBA_QK
#undef MOBA_DECIDE
#undef MOBA_STEP
#undef MOBA_DMA
#undef MOBA_WAIT_BAR
    {
        const float inv = 1.0f / xhalf_sum(lsum);
        const h16* gp = projb + (size_t)qrow * NIN + C_MGATE + hh * 64 + 4 * hi; h16* dst = mix + ((size_t)b * SEQ + qrow) * DM + 512 + hh * 64 + 4 * hi;
#pragma unroll
        for (int g = 0; g < 4; ++g) {
            const h16x4 ga = *(const h16x4*)(gp + 8 * g), gb = *(const h16x4*)(gp + 32 + 8 * g); h16x4 oa, ob;
#pragma unroll
            for (int k = 0; k < 4; ++k) { oa[k] = (h16)(o0[4 * g + k] * inv * silu_f((float)ga[k])); ob[k] = (h16)(o1[4 * g + k] * inv * silu_f((float)gb[k])); }
            *(h16x4*)(dst + 8 * g) = oa; *(h16x4*)(dst + 32 + 8 * g) = ob;
        }
    }
}

__device__ __forceinline__ void ret_scan_shares(const Params& p, int layer) {
    const float* kv = (const float*)(p.ws + WS_KV); h16* rst = (h16*)(p.ws + WS_RST);
    const int tid = threadIdx.x; unsigned done = 0u;
#pragma unroll 1
    for (int s = blockIdx.x; s < 256; s += gridDim.x) {
        const int bh = s >> 3, e = (s & 7) * 512 + tid, hh = bh & 3;
        const float gam = 1.0f - exp2f(-5.0f - (float)hh); const float g = expf(logf(gam) * 128.0f);
        const float* kvb = kv + (size_t)bh * 32 * 4096 + e; h16* rb = rst + (size_t)bh * 32 * 4096 + e;
        float r = 0.f; rb[0] = (h16)0.f;
#pragma unroll 1
        for (int m0 = 0; m0 < 31; m0 += 8) {
            float kvv[8];
#pragma unroll
            for (int k = 0; k < 8; ++k) kvv[k] = (m0 + k < 31) ? kvb[(size_t)(m0 + k) * 4096] : 0.f;
#pragma unroll
            for (int k = 0; k < 8; ++k) if (m0 + k < 31) { r = r * g + kvv[k]; rb[(size_t)(m0 + k + 1) * 4096] = (h16)(r * gam); }
        }
        ++done;
    }
    asm volatile("s_waitcnt vmcnt(0)" ::: "memory");
    __syncthreads();
    if (tid == 0) { __builtin_amdgcn_fence(__ATOMIC_RELEASE, "agent"); asm volatile("s_waitcnt vmcnt(0)" ::: "memory");
        __hip_atomic_fetch_add((unsigned*)(p.ws + WS_CTL + 16384) + 64 * layer, done, __ATOMIC_RELAXED, __HIP_MEMORY_SCOPE_AGENT); }
}
__device__ __forceinline__ void ret_scan_wait(const Params& p, int layer) {
    if (threadIdx.x == 0) {
        unsigned* c = (unsigned*)(p.ws + WS_CTL + 16384) + 64 * layer; unsigned sp = 0u;
        while (__hip_atomic_load(c, __ATOMIC_RELAXED, __HIP_MEMORY_SCOPE_AGENT) < 256u) { __builtin_amdgcn_s_sleep(2); if (++sp > (1u << 22)) break; }
        __builtin_amdgcn_fence(__ATOMIC_ACQUIRE, "agent"); asm volatile("s_waitcnt vmcnt(0)" ::: "memory");
    }
    __syncthreads();
}

__device__ __forceinline__ void phase_mixers(const Params& p, int layer, unsigned char* lds) {
    ret_scan_shares(p, layer);
#pragma unroll 1
    for (int u = blockIdx.x; u < 1024; u += gridDim.x) {
        const bool bal = (gridDim.x == 256); const int i = u >> 8, w = u & 255, k = (w >> 6) & 3, bh = u & 63;
        const int j = bal ? ((i == 0) ? 15 - k : (i == 1) ? 11 - k : (i == 2) ? 4 + k : k) : 15 - (u >> 6);
        moba_unit(p, bh >> 3, bh & 7, j, lds); }
    ret_scan_wait(p, layer);
#pragma unroll 1
    for (int v = blockIdx.x; v < 1024; v += gridDim.x) ret_unit(p, v >> 7, (v >> 5) & 3, v & 31, lds);
#pragma unroll 1
    for (int v = blockIdx.x; v < 512; v += gridDim.x) conv_unit(p, layer, v >> 6, v & 63, lds);
}

__device__ __forceinline__ void phase_final(const Params& p) {
    const float* rowss = (const float*)(p.ws + WS_ROWSS);
    const int lane = threadIdx.x & 63, wid = threadIdx.x >> 6;
    f32x4 g[4];
#pragma unroll
    for (int j = 0; j < 4; ++j) g[j] = *((const f32x4*)p.final_g + lane + 64 * j);
    for (int row = blockIdx.x * 8 + wid; row < MROWS; row += gridDim.x * 8) {
        const f32x4* rs = (const f32x4*)(rowss + (size_t)row * NPART); const f32x4 s0 = rs[0], s1 = rs[1], s2 = rs[2], s3 = rs[3];
        const float tot = ((s0[0] + s0[1]) + (s0[2] + s0[3])) + ((s1[0] + s1[1]) + (s1[2] + s1[3])) + ((s2[0] + s2[1]) + (s2[2] + s2[3])) + ((s3[0] + s3[1]) + (s3[2] + s3[3]));
        const float rstd = rsqrtf(tot * (1.0f / DM) + 1e-6f);
        f32x4* xr = (f32x4*)(p.out + (size_t)row * DM) + lane;
#pragma unroll
        for (int j = 0; j < 4; ++j) { f32x4 v = xr[64 * j]; v = v * rstd * g[j]; xr[64 * j] = v; }
    }
}

#define XB_TMO      128
#define XB_XCNT(j)  (256  + 64 * (j))
#define XB_XSUB(j)  (1280 + 64 * (j))
#define XB_XGEN(j)  (2304 + 64 * (j))
#define XB_TOP      3328
#define XB_TOPGEN   3392
#define XCD_BAR_WORDS 3456
#define XB_SPIN_CAP (1u << 18)

__device__ __forceinline__ unsigned xb_ld(unsigned* p)              { return __hip_atomic_load(p, __ATOMIC_RELAXED, __HIP_MEMORY_SCOPE_AGENT); }
__device__ __forceinline__ unsigned xb_add(unsigned* p, unsigned v) { return __hip_atomic_fetch_add(p, v, __ATOMIC_RELAXED, __HIP_MEMORY_SCOPE_AGENT); }
__device__ __forceinline__ unsigned xb_xcc_id() { return (unsigned)__builtin_amdgcn_s_getreg((3 << 11) | 20) & 0xFu; }
#define XB_SPIN(cond, bar) do { unsigned _sp = 0; while (cond) { __builtin_amdgcn_s_sleep(1); \
    if ((++_sp & 255u) == 0u) { if (xb_ld(&(bar)[XB_TMO])) break; if (_sp > XB_SPIN_CAP) { atomicAdd(&(bar)[XB_TMO], 1u); break; } } } } while (0)

struct XcdBarrier {
    unsigned* bar; unsigned x;
    volatile LAS unsigned* st;
};

__device__ __forceinline__ XcdBarrier xcd_barrier_post(unsigned* bar, volatile LAS unsigned* st) {
    XcdBarrier b; b.bar = bar; b.x = xb_xcc_id(); b.st = st;
    if (threadIdx.x == 0) (void)xb_add(&bar[XB_XCNT(b.x)], 1u);
    return b;
}
__device__ __forceinline__ void xcd_barrier_complete(unsigned* bar, unsigned x, unsigned& nloc, unsigned& nx) {
    const unsigned G = gridDim.x * gridDim.y * gridDim.z;
    unsigned sum, cnt, mine, sp = 0u;
    for (;;) {
        sum = 0u; cnt = 0u; mine = 0u;
#pragma unroll
        for (unsigned j = 0; j < 16; ++j) { const unsigned c = xb_ld(&bar[XB_XCNT(j)]); sum += c; cnt += (c > 0u) ? 1u : 0u; mine = (j == x) ? c : mine; }
        if (sum == G) break;
        __builtin_amdgcn_s_sleep(1);
        if ((++sp & 255u) == 0u) { if (xb_ld(&bar[XB_TMO])) break; if (sp > XB_SPIN_CAP) { atomicAdd(&bar[XB_TMO], 1u); break; } }
    }
    nloc = mine > 0u ? mine : 1u; nx = cnt > 0u ? cnt : 1u;
}

__device__ __forceinline__ void xcd_barrier(const XcdBarrier& b) {
    asm volatile("s_waitcnt vmcnt(0)" ::: "memory");
    __syncthreads();
    if (threadIdx.x == 0) {
        unsigned* bar = b.bar;
        __builtin_amdgcn_s_waitcnt(0);
        unsigned nloc = b.st[0], nx = b.st[1];
        if (nloc == 0u) { xcd_barrier_complete(bar, b.x, nloc, nx); b.st[0] = nloc; b.st[1] = nx; }
        const unsigned old = xb_add(&bar[XB_XSUB(b.x)], 1u);
        const unsigned gen = old / nloc;
        if (old + 1u == (gen + 1u) * nloc) {
            __builtin_amdgcn_fence(__ATOMIC_RELEASE, "agent");
            asm volatile("s_waitcnt vmcnt(0)" ::: "memory");
            const unsigned og = xb_add(&bar[XB_TOP], 1u);
            const unsigned tg = og / nx;
            if (og + 1u == (tg + 1u) * nx) xb_add(&bar[XB_TOPGEN], 1u);
            else XB_SPIN(xb_ld(&bar[XB_TOPGEN]) == tg, bar);
            __builtin_amdgcn_fence(__ATOMIC_ACQUIRE, "agent");
            xb_add(&bar[XB_XGEN(b.x)], 1u);
            asm volatile("s_waitcnt vmcnt(0)" ::: "memory");
        } else {
            XB_SPIN(xb_ld(&bar[XB_XGEN(b.x)]) == gen, bar);
            __builtin_amdgcn_fence(__ATOMIC_ACQUIRE, "agent");
            asm volatile("s_waitcnt vmcnt(0)" ::: "memory");
        }
    }
    __syncthreads();
}


__global__ void __launch_bounds__(NTHREADS) hymba_fwd(Params p) {
    extern __shared__ __attribute__((aligned(16))) unsigned char lds[];
    cg::grid_group grid = cg::this_grid();
    volatile LAS unsigned* bst = (volatile LAS unsigned*)((LAS unsigned char*)lds + BAR_LDS_OFF);
    if (threadIdx.x < 2) bst[threadIdx.x] = 0u;
    __syncthreads();
    XcdBarrier xbar = xcd_barrier_post((unsigned*)(p.ws + WS_CTL), bst);
#define RUN_PHASE(k, body) do { if (p.ph_lo <= (k) && (k) < p.ph_hi) { body; if ((k) + 1 < p.ph_hi) { if ((k) == 0) grid.sync(); else xcd_barrier(xbar); } } } while (0)
    RUN_PHASE(0, phase_prologue(p, lds));
    RUN_PHASE(1, gemm_in(p, 0, lds));
    RUN_PHASE(2, phase_stats(p, lds));
    RUN_PHASE(3, phase_mixers(p, 0, lds));
    RUN_PHASE(4, gemm_out<0>(p, lds));
    RUN_PHASE(5, gemm_in(p, 1, lds));
    RUN_PHASE(6, phase_stats(p, lds));
    RUN_PHASE(7, phase_mixers(p, 1, lds));
    RUN_PHASE(8, gemm_out<1>(p, lds));
    RUN_PHASE(9, phase_final(p));
#undef RUN_PHASE
}

extern "C" void kernel_launch(void* const* d_in, const int* in_sizes, int n_in, void* d_out, int out_size, void* d_ws, size_t ws_size, hipStream_t stream) {
    static int grid_blocks = 0;
    if (!grid_blocks) {
        int dev = 0, cus = 0, per_cu = 0;
        hipGetDevice(&dev);
        hipDeviceGetAttribute(&cus, hipDeviceAttributeMultiprocessorCount, dev);
        hipFuncSetAttribute((const void*)hymba_fwd, hipFuncAttributeMaxDynamicSharedMemorySize, LDS_BYTES);
        hipOccupancyMaxActiveBlocksPerMultiprocessor(&per_cu, (const void*)hymba_fwd, NTHREADS, LDS_BYTES);
        if (per_cu < 1) per_cu = 1;
        grid_blocks = cus * per_cu;
        if (ws_size < WS_END) fprintf(stderr, "kernel_launch: workspace too small (%zu < %zu)\n", ws_size, (size_t)WS_END);
    }
    Params p{};
    p.x = (const float*)d_in[0]; p.norm_g = (const float*)d_in[1]; p.w_in = (const float*)d_in[2]; p.conv_w = (const float*)d_in[3]; p.conv_b = (const float*)d_in[4];
    p.ln_g = (const float*)d_in[5]; p.ln_b = (const float*)d_in[6]; p.pw_w = (const float*)d_in[7]; p.pw_b = (const float*)d_in[8]; p.w_out = (const float*)d_in[9];
    p.final_g = (const float*)d_in[10]; p.out = (float*)d_out; p.ws = (unsigned char*)d_ws;
    (void)hipMemsetAsync((char*)d_ws + WS_CTL, 0, 32768, stream);
#if ONE_LAUNCH
    p.ph_lo = 0; p.ph_hi = NPHASES;
    { void* args[] = {&p};
      hipError_t e = hipLaunchCooperativeKernel((const void*)hymba_fwd, dim3(grid_blocks), dim3(NTHREADS), args, LDS_BYTES, stream);
      if (e != hipSuccess) fprintf(stderr, "cooperative launch failed: %s (grid %d)\n", hipGetErrorString(e), grid_blocks); }
#else
    for (int ph = 0; ph < NPHASES; ++ph) {
        p.ph_lo = ph; p.ph_hi = ph + 1; void* args[] = {&p};
        hipError_t e = hipLaunchCooperativeKernel((const void*)hymba_fwd, dim3(grid_blocks), dim3(NTHREADS), args, LDS_BYTES, stream);
        if (e != hipSuccess) { fprintf(stderr, "cooperative launch failed: %s (grid %d, phase %d)\n", hipGetErrorString(e), grid_blocks, ph); break; }
    }
#endif
}
```

```cpp
#include <hip/hip_runtime.h>
#include <hip/hip_cooperative_groups.h>
#include <cstdio>
#include <cstdint>
namespace cg = cooperative_groups;

#ifndef ONE_LAUNCH
#define ONE_LAUNCH 1
#endif

typedef _Float16 h16;
typedef _Float16 h16x8 __attribute__((ext_vector_type(8)));
typedef _Float16 h16x4 __attribute__((ext_vector_type(4)));
typedef float f32x16 __attribute__((ext_vector_type(16)));
typedef float f32x4 __attribute__((ext_vector_type(4)));
typedef unsigned u32x4 __attribute__((ext_vector_type(4)));

constexpr int BATCH = 8, SEQ = 4096, DM = 1024, MROWS = BATCH * SEQ, NIN = 3840, DEPTH = 2;
constexpr int C_AVAL = 0, C_AGLU = 256, C_AGATE = 512, C_RQ = 768, C_RK = 1024, C_RV = 1280, C_RGATE = 1536, C_MQ = 1792, C_MK = 2304, C_MV = 2816, C_MGATE = 3328;
constexpr int NPART = 16;
constexpr int NTHREADS = 512;
constexpr int LDS_BYTES = 147456;
constexpr int NPHASES = 10;

constexpr size_t MiB = 1u << 20;
constexpr size_t WS_XH = 0, WS_PROJ = 64 * MiB, WS_MIX = 304 * MiB, WS_WIN = 368 * MiB, WS_WOUT = 383 * MiB, WS_WPW = 387 * MiB,
                 WS_KV = 388 * MiB, WS_KMEAN = 404 * MiB  , WS_ROWSS = 405 * MiB, WS_CTL = 408 * MiB  , WS_RST = 409 * MiB  , WS_END = 417 * MiB;
constexpr int BAR_LDS_OFF = LDS_BYTES - 64;

struct Params {
    const float *x, *norm_g, *w_in, *conv_w, *conv_b, *ln_g, *ln_b, *pw_w, *pw_b, *w_out, *final_g;
    float* out; unsigned char* ws;
    int ph_lo, ph_hi;
};

__device__ __forceinline__ float silu_f(float v) { return v * __builtin_amdgcn_rcpf(1.0f + __expf(-v)); }
__device__ __forceinline__ int crow(int r, int h) { return (r & 3) + 8 * (r >> 2) + 4 * h; }
__device__ __forceinline__ float wave_sum(float v) {
#pragma unroll
    for (int o = 1; o < 64; o <<= 1) v += __shfl_xor(v, o);
    return v;
}

__device__ __forceinline__ void transpose_unit(const float* W, int K, int N, h16* WT, const float* g, int k0, int n0, float* tile) {
    const int tid = threadIdx.x;
    __syncthreads();
#pragma unroll
    for (int i = 0; i < 8; ++i) { const int k = i * 8 + (tid >> 6), n = tid & 63; float v = W[(size_t)(k0 + k) * N + n0 + n]; if (g) v *= g[k0 + k]; tile[k * 65 + n] = v; }
    __syncthreads();
    { const int n = tid >> 3, kc = tid & 7; h16x8 w;
#pragma unroll
        for (int i = 0; i < 8; ++i) w[i] = (h16)tile[(kc * 8 + i) * 65 + n];
        *(h16x8*)(WT + (size_t)(n0 + n) * K + k0 + kc * 8) = w; }
}

__device__ __forceinline__ void phase_prologue(const Params& p, unsigned char* lds) {
    float* tile = (float*)lds;
    h16* win = (h16*)(p.ws + WS_WIN); h16* wout = (h16*)(p.ws + WS_WOUT); h16* wpw = (h16*)(p.ws + WS_WPW);
    constexpr int U_IN = 16 * 60, U_OUT = 16 * 16, U_PW = 4 * 4, U_L = U_IN + U_OUT + U_PW;
    for (int u = blockIdx.x; u < DEPTH * U_L; u += gridDim.x) {
        const int layer = u / U_L; int r = u % U_L;
        if (r < U_IN) { transpose_unit(p.w_in + (size_t)layer * DM * NIN, DM, NIN, win + (size_t)layer * NIN * DM, p.norm_g + layer * DM, (r / 60) * 64, (r % 60) * 64, tile); continue; }
        r -= U_IN;
        if (r < U_OUT) { transpose_unit(p.w_out + (size_t)layer * DM * DM, DM, DM, wout + (size_t)layer * DM * DM, nullptr, (r / 16) * 64, (r % 16) * 64, tile); continue; }
        r -= U_OUT;
        transpose_unit(p.pw_w + (size_t)layer * 256 * 256, 256, 256, wpw + (size_t)layer * 256 * 256, nullptr, (r / 4) * 64, (r % 4) * 64, tile);
    }
    h16* xh = (h16*)(p.ws + WS_XH); float* rowss = (float*)(p.ws + WS_ROWSS);
    const int lane = threadIdx.x & 63, wid = threadIdx.x >> 6;
    for (int row = blockIdx.x * 8 + wid; row < MROWS; row += gridDim.x * 8) {
        const f32x4* xr = (const f32x4*)(p.x + (size_t)row * DM) + lane;
        float ss = 0.f;
#pragma unroll
        for (int j = 0; j < 4; ++j) { const f32x4 v = xr[64 * j]; ss += v.x * v.x + v.y * v.y + v.z * v.z + v.w * v.w;
            h16x4 o; o.x = (h16)v.x; o.y = (h16)v.y; o.z = (h16)v.z; o.w = (h16)v.w; *((h16x4*)(xh + (size_t)row * DM) + lane + 64 * j) = o; }
        ss = wave_sum(ss);
        if (lane < NPART) rowss[(size_t)row * NPART + lane] = (lane == 0) ? ss : 0.f;
    }
}

typedef short s16x4 __attribute__((ext_vector_type(4)));
#define LAS __attribute__((address_space(3)))
__device__ __forceinline__ float xhalf_max(float v) { auto rr = __builtin_amdgcn_permlane32_swap(__float_as_uint(v), __float_as_uint(v), false, false); return fmaxf(__uint_as_float(rr[0]), __uint_as_float(rr[1])); }
__device__ __forceinline__ float xhalf_sum(float v) { auto rr = __builtin_amdgcn_permlane32_swap(__float_as_uint(v), __float_as_uint(v), false, false); return __uint_as_float(rr[0]) + __uint_as_float(rr[1]); }
__device__ __forceinline__ h16x8 tr_frag(const LAS unsigned char* a) {
    const s16x4 lo = __builtin_amdgcn_ds_read_tr16_b64_v4i16((LAS s16x4*)a), hi = __builtin_amdgcn_ds_read_tr16_b64_v4i16((LAS s16x4*)(a + 512));
    typedef short s16x8 __attribute__((ext_vector_type(8)));
    const s16x8 v = __builtin_shufflevector(lo, hi, 0, 1, 2, 3, 4, 5, 6, 7);
    return __builtin_bit_cast(h16x8, v);
}
#define CROW0(i) (((i) & 3) + 8 * ((i) >> 2))
__device__ __forceinline__ void glds16(const void* gsrc, unsigned lds_dst) { unsigned keep;
    asm volatile("s_mov_b32 %0, m0\n\ts_mov_b32 m0, %2\n\ts_nop 0\n\tglobal_load_lds_dwordx4 %1, off\n\ts_mov_b32 m0, %0" : "=&s"(keep) : "v"(gsrc), "s"(lds_dst) : "memory"); }

namespace pg8 {
#define PG8_LAS __attribute__((address_space(3)))
typedef _Float16 bf16_t;
typedef _Float16 bf16x8 __attribute__((ext_vector_type(8)));
typedef float f32x4 __attribute__((ext_vector_type(4)));
typedef unsigned u32x4 __attribute__((ext_vector_type(4)));
constexpr int BM = 256, BK = 64, HALF = 128, HTB = HALF * BK * 2  , STAGE_BYTES = 8 * HTB, NXCD = 8, WGM = 8;

__host__ __device__ __forceinline__ int lds_byte(int r, int c) { const int st = (r >> 4) * 2 + (c >> 5), rr = r & 15, cc = c & 31, ob = rr * 64 + cc * 2; return st * 1024 + (ob ^ (((ob >> 9) & 1) << 5)); }
__host__ __device__ __forceinline__ void stage_rc(int b, int& R, int& C) { const int st = b / 1024, sb = b % 1024, swz = sb ^ (((sb >> 9) & 1) << 5); R = (st >> 1) * 16 + swz / 64; C = (st & 1) * 32 + (swz % 64) / 2; }
__host__ __device__ __forceinline__ int perm32(int rho) { const int n = rho >> 4, i = rho & 15; return 8 * (i >> 2) + 4 * n + (i & 3); }

struct Unit { int pm, pn; };
struct Gemm { const bf16_t* A; const bf16_t* Bt; int M, N, K; };

struct StaticOrder {
    int nM, nN, nwg, G, c;
    __host__ __device__ void init(int M, int N, int G_, int c_) { nM = M / BM; nN = N / BM; nwg = nM * nN; G = G_; c = c_; }
    __host__ __device__ bool next(int i, Unit& u) const {
        const long L = (long)i * G + c; if (L >= nwg) return false;
        int wgid = (int)L; { const int q = nwg / NXCD, r = nwg % NXCD, xcd = wgid % NXCD, off = wgid / NXCD; wgid = (xcd < r ? xcd * (q + 1) : r * (q + 1) + (xcd - r) * q) + off; }
        const int nig = WGM * nN, gid = wgid / nig, fm = gid * WGM, gsz = (nM - fm) < WGM ? (nM - fm) : WGM;
        u.pm = fm + ((wgid % nig) % gsz); u.pn = (wgid % nig) / gsz; return true;
    }
    __device__ __forceinline__ void a_ready(const Unit&) const {}
    __device__ __forceinline__ void done(const Unit&) const {}
};

template <class Epi, class Sched, bool ALIGN_EPI = false, bool SP2 = false>
__device__ __forceinline__ void gemm_phase(PG8_LAS unsigned char* lds, const Gemm g, const Sched& S, const Epi& E) {
    const int tid = threadIdx.x, wid = __builtin_amdgcn_readfirstlane(tid >> 6), lane = tid & 63, wr = wid >> 2, wc = wid & 3, fr = lane & 15, fq = lane >> 4;
    const int K = g.K, nt = K / BK;
    unsigned voffA[2], voffB[2];
#pragma unroll
    for (int i = 0; i < 2; ++i) { int R, C; stage_rc(tid * 16 + i * 8192, R, C); const int Rb = Epi::PERM ? ((R & ~31) + perm32(R & 31)) : R;
        voffA[i] = (unsigned)(R * K + C) * 2u; voffB[i] = (unsigned)(Rb * K + C) * 2u; }
    const size_t kstep = (size_t)(BK * 2);
    const size_t hstep = (size_t)HALF * K * 2;
    const size_t tstep = 2 * hstep;
    const unsigned ldsw = (unsigned)wid * 1024u;
    const int aoff = lds_byte(wr * 64 + fr, fq * 8), boff = lds_byte(wc * 32 + fr, fq * 8);
#define PG8_SA(b, h) (((b) * 2 + (h)) * HTB)
#define PG8_SB(b, h) ((4 + (b) * 2 + (h)) * HTB)
#define PG8_STAGE(bufoff, gbase, voff) do { _Pragma("unroll") for (int _i = 0; _i < 2; ++_i) \
        __builtin_amdgcn_global_load_lds((const unsigned*)((const char*)(gbase) + (voff)[_i]), (PG8_LAS unsigned*)(lds + (bufoff) + ldsw + _i * 8192), 16, 0, 0); } while (0)
#define PG8_LDA(dst, b, h) do { _Pragma("unroll") for (int m = 0; m < 4; ++m) _Pragma("unroll") for (int k = 0; k < 2; ++k) dst[m][k] = *(const PG8_LAS bf16x8*)(lds + PG8_SA(b, h) + aoff + m * 2048 + k * 1024); } while (0)
#define PG8_LDB(dst, b, h) do { _Pragma("unroll") for (int n = 0; n < 2; ++n) _Pragma("unroll") for (int k = 0; k < 2; ++k) dst[n][k] = *(const PG8_LAS bf16x8*)(lds + PG8_SB(b, h) + boff + n * 2048 + k * 1024); } while (0)
#define PG8_MMA(ai, bj, At, Bt) do { __builtin_amdgcn_s_setprio(1); _Pragma("unroll") for (int m = 0; m < 4; ++m) _Pragma("unroll") for (int n = 0; n < 2; ++n) _Pragma("unroll") for (int k = 0; k < 2; ++k) \
        acc[ai][bj][m][n] = __builtin_amdgcn_mfma_f32_16x16x32_f16(Bt[n][k], At[m][k], acc[ai][bj][m][n], 0, 0, 0); __builtin_amdgcn_s_setprio(0); } while (0)
#define PG8_WAIT_V(n) asm volatile("s_waitcnt vmcnt(" #n ")" ::: "memory")
#define PG8_WAIT_L(n) asm volatile("s_waitcnt lgkmcnt(" #n ")" ::: "memory")
#define PG8_BAR __builtin_amdgcn_s_barrier()
#define PG8_SCHED __builtin_amdgcn_sched_barrier(0)
    Unit cur, nxt; int ui = 0;
    if (!S.next(0, cur)) return;
    f32x4 acc[2][2][4][2];
#pragma unroll
    for (int a = 0; a < 2; ++a)
#pragma unroll
        for (int b = 0; b < 2; ++b)
#pragma unroll
            for (int m = 0; m < 4; ++m)
#pragma unroll
                for (int n = 0; n < 2; ++n) acc[a][b][m][n] = (f32x4){0.f, 0.f, 0.f, 0.f};
    bf16x8 At[4][2], B0[2][2], B1[2][2];
    const char* cA = (const char*)g.A + (size_t)cur.pm * tstep; const char* cB = (const char*)g.Bt + (size_t)cur.pn * tstep;
    S.a_ready(cur);
    if constexpr (SP2) {
        PG8_STAGE(PG8_SB(0, 0), cB, voffB); PG8_STAGE(PG8_SB(0, 1), cB + hstep, voffB); PG8_STAGE(PG8_SA(0, 0), cA, voffA); PG8_STAGE(PG8_SA(0, 1), cA + hstep, voffA);
        if (wr == 1) PG8_BAR;
        PG8_WAIT_V(2); PG8_BAR;
        PG8_STAGE(PG8_SB(1, 0), cB + kstep, voffB); PG8_STAGE(PG8_SA(1, 0), cA + kstep, voffA); PG8_STAGE(PG8_SB(1, 1), cB + hstep + kstep, voffB);
        PG8_WAIT_V(6); PG8_BAR;
    } else {
        PG8_STAGE(PG8_SB(0, 0), cB, voffB); PG8_STAGE(PG8_SA(0, 0), cA, voffA); PG8_STAGE(PG8_SB(0, 1), cB + hstep, voffB); PG8_STAGE(PG8_SA(0, 1), cA + hstep, voffA);
        if (wr == 1) PG8_BAR;
        PG8_WAIT_V(4); PG8_BAR;
        PG8_STAGE(PG8_SB(1, 0), cB + kstep, voffB); PG8_STAGE(PG8_SA(1, 0), cA + kstep, voffA); PG8_STAGE(PG8_SB(1, 1), cB + hstep + kstep, voffB);
        PG8_WAIT_V(6); PG8_BAR;
    }
    for (;;) {
        const bool has_next = S.next(ui + 1, nxt);
        const char* nA = has_next ? (const char*)g.A + (size_t)nxt.pm * tstep : cA; const char* nB = has_next ? (const char*)g.Bt + (size_t)nxt.pn * tstep : cB;
        for (int t = 0; t < nt; t += 2) {
            const bool last = (t == nt - 2);
            const char* a1 = cA + (size_t)(t + 1) * kstep;
            const char* a2 = last ? nA : cA + (size_t)(t + 2) * kstep; const char* b2 = last ? nB : cB + (size_t)(t + 2) * kstep;
            const char* a3 = a2 + kstep; const char* b3 = b2 + kstep;
            if (last && has_next) S.a_ready(nxt);
            if constexpr (SP2) {
            PG8_LDB(B0, 0, 0); PG8_LDB(B1, 0, 1); PG8_SCHED; PG8_LDA(At, 0, 0); PG8_STAGE(PG8_SA(1, 1), a1 + hstep, voffA);
            PG8_WAIT_V(8); PG8_WAIT_L(0); PG8_BAR; PG8_MMA(0, 0, At, B0); PG8_MMA(0, 1, At, B1); PG8_BAR; PG8_SCHED;
            PG8_LDA(At, 0, 1); PG8_STAGE(PG8_SB(0, 0), b2, voffB); PG8_STAGE(PG8_SB(0, 1), b2 + hstep, voffB); PG8_STAGE(PG8_SA(0, 0), a2, voffA);
            PG8_WAIT_V(8); PG8_WAIT_L(0); PG8_BAR; PG8_MMA(1, 0, At, B0); PG8_MMA(1, 1, At, B1); PG8_BAR; PG8_SCHED;
            PG8_LDB(B0, 1, 0); PG8_LDB(B1, 1, 1); PG8_SCHED; PG8_LDA(At, 1, 0); PG8_STAGE(PG8_SA(0, 1), a2 + hstep, voffA);
            PG8_WAIT_V(8); PG8_WAIT_L(0); PG8_BAR; PG8_MMA(0, 0, At, B0); PG8_MMA(0, 1, At, B1); PG8_BAR; PG8_SCHED;
            PG8_LDA(At, 1, 1); PG8_STAGE(PG8_SB(1, 0), b3, voffB); PG8_STAGE(PG8_SB(1, 1), b3 + hstep, voffB); PG8_STAGE(PG8_SA(1, 0), a3, voffA);
            PG8_WAIT_V(8); PG8_WAIT_L(0); PG8_BAR; PG8_MMA(1, 0, At, B0); PG8_MMA(1, 1, At, B1); PG8_BAR; PG8_SCHED;
            } else {
            PG8_LDB(B0, 0, 0); PG8_SCHED; PG8_LDA(At, 0, 0); PG8_STAGE(PG8_SA(1, 1), a1 + hstep, voffA);
            PG8_WAIT_L(8); PG8_BAR; PG8_WAIT_L(0); PG8_MMA(0, 0, At, B0); PG8_BAR; PG8_SCHED;
            PG8_LDB(B1, 0, 1); PG8_STAGE(PG8_SB(0, 0), b2, voffB);
            PG8_BAR; PG8_WAIT_L(0); PG8_MMA(0, 1, At, B1); PG8_BAR;
            PG8_LDA(At, 0, 1); PG8_STAGE(PG8_SA(0, 0), a2, voffA);
            PG8_BAR; PG8_WAIT_L(0); PG8_MMA(1, 0, At, B0); PG8_BAR; PG8_SCHED;
            PG8_STAGE(PG8_SB(0, 1), b2 + hstep, voffB);
            PG8_WAIT_V(6); PG8_BAR; PG8_MMA(1, 1, At, B1); PG8_BAR;
            PG8_LDB(B0, 1, 0); PG8_SCHED; PG8_LDA(At, 1, 0); PG8_STAGE(PG8_SA(0, 1), a2 + hstep, voffA);
            PG8_WAIT_L(8); PG8_BAR; PG8_WAIT_L(0); PG8_MMA(0, 0, At, B0); PG8_BAR; PG8_SCHED;
            PG8_LDB(B1, 1, 1); PG8_STAGE(PG8_SB(1, 0), b3, voffB);
            PG8_BAR; PG8_WAIT_L(0); PG8_MMA(0, 1, At, B1); PG8_BAR;
            PG8_LDA(At, 1, 1); PG8_STAGE(PG8_SA(1, 0), a3, voffA);
            PG8_BAR; PG8_WAIT_L(0); PG8_MMA(1, 0, At, B0); PG8_BAR; PG8_SCHED;
            PG8_STAGE(PG8_SB(1, 1), b3 + hstep, voffB);
            PG8_WAIT_V(6); PG8_BAR; PG8_MMA(1, 1, At, B1); PG8_BAR;
            }
        }
        if constexpr (ALIGN_EPI) { if (wr == 0) PG8_BAR; }
        if constexpr (!Epi::AFTER_DRAIN) { E(acc, cur, wr, wc, fr, fq); S.done(cur); }
        if (!has_next) break;
#pragma unroll
        for (int a = 0; a < 2; ++a)
#pragma unroll
            for (int b = 0; b < 2; ++b)
#pragma unroll
                for (int m = 0; m < 4; ++m)
#pragma unroll
                    for (int n = 0; n < 2; ++n) acc[a][b][m][n] = (f32x4){0.f, 0.f, 0.f, 0.f};
        cur = nxt; cA = nA; cB = nB; ++ui;
        if constexpr (ALIGN_EPI) { if (wr == 1) PG8_BAR; }
    }
    PG8_WAIT_V(0);
    if constexpr (!ALIGN_EPI) { if (wr == 0) PG8_BAR; }
    PG8_BAR;
    if constexpr (Epi::AFTER_DRAIN) { E.fused(acc, cur, wr, wc, fr, fq, lds, wid, lane); S.done(cur); }
#undef PG8_SA
#undef PG8_SB
#undef PG8_STAGE
#undef PG8_LDA
#undef PG8_LDB
#undef PG8_MMA
#undef PG8_WAIT_V
#undef PG8_WAIT_L
#undef PG8_BAR
#undef PG8_SCHED
}

struct EpiProj {
    static constexpr bool PERM = true, AFTER_DRAIN = false;
    bf16_t* O; const float* rowss; float* kmpart;
    __device__ __forceinline__ void operator()(const f32x4 (&acc)[2][2][4][2], const Unit& u, int wr, int wc, int fr, int fq) const {
        const int row0 = u.pm * BM + wr * 64 + fr, col0 = u.pn * BM + wc * 32 + 8 * fq;
        const bool want_km = (u.pn == 9) || (u.pn == 10);
        f32x4 cs[2][2];
#pragma unroll
        for (int bj = 0; bj < 2; ++bj)
#pragma unroll
            for (int n = 0; n < 2; ++n) cs[bj][n] = (f32x4){0.f, 0.f, 0.f, 0.f};
#pragma unroll
        for (int ai = 0; ai < 2; ++ai)
#pragma unroll
            for (int m = 0; m < 4; ++m) { const size_t row = (size_t)(row0 + ai * HALF + m * 16);
                const f32x4* rs = (const f32x4*)(rowss + row * 16); const f32x4 s0 = rs[0], s1 = rs[1], s2 = rs[2], s3 = rs[3];
                const float tot = ((s0[0] + s0[1]) + (s0[2] + s0[3])) + ((s1[0] + s1[1]) + (s1[2] + s1[3])) + ((s2[0] + s2[1]) + (s2[2] + s2[3])) + ((s3[0] + s3[1]) + (s3[2] + s3[3]));
                const float rstd = rsqrtf(tot * (1.0f / 1024.0f) + 1e-6f);
                bf16_t* rowp = O + row * 3840 + col0;
#pragma unroll
                for (int bj = 0; bj < 2; ++bj) { const f32x4 v0 = acc[ai][bj][m][0] * rstd, v1 = acc[ai][bj][m][1] * rstd; bf16x8 w;
                    w[0] = (bf16_t)v0[0]; w[1] = (bf16_t)v0[1]; w[2] = (bf16_t)v0[2]; w[3] = (bf16_t)v0[3]; w[4] = (bf16_t)v1[0]; w[5] = (bf16_t)v1[1]; w[6] = (bf16_t)v1[2]; w[7] = (bf16_t)v1[3];
                    *(bf16x8*)(rowp + bj * HALF) = w; cs[bj][0] += v0; cs[bj][1] += v1; } }
        if (want_km) {
#pragma unroll
            for (int bj = 0; bj < 2; ++bj)
#pragma unroll
                for (int n = 0; n < 2; ++n)
#pragma unroll
                    for (int k = 0; k < 4; ++k) { float v = cs[bj][n][k]; v += __shfl_xor(v, 1); v += __shfl_xor(v, 2); v += __shfl_xor(v, 4); v += __shfl_xor(v, 8); cs[bj][n][k] = v * (1.0f / 256.0f); }
            if (fr == 0) {
#pragma unroll
                for (int bj = 0; bj < 2; ++bj)
#pragma unroll
                    for (int n = 0; n < 2; ++n) { const int cm = col0 + bj * HALF + 4 * n - 2304;
                        *(f32x4*)(kmpart + ((size_t)((wr * 8 + (u.pm >> 4)) * 8 + (cm >> 6)) * 16 + (u.pm & 15)) * 64 + (cm & 63)) = cs[bj][n]; }
            }
        }
    }
};
template <int LAYER> struct EpiRes {
    static constexpr bool PERM = true, AFTER_DRAIN = false;
    const float* x0; float* xout; bf16_t* xh; float* rowss;
    __device__ __forceinline__ void operator()(const f32x4 (&acc)[2][2][4][2], const Unit& u, int wr, int wc, int fr, int fq) const {
        const int row0 = u.pm * BM + wr * 64 + fr, col0 = u.pn * BM + wc * 32 + 8 * fq;
#pragma unroll
        for (int ai = 0; ai < 2; ++ai)
#pragma unroll
            for (int m = 0; m < 4; ++m) { const size_t row = (size_t)(row0 + ai * HALF + m * 16); float ss = 0.f;
#pragma unroll
                for (int bj = 0; bj < 2; ++bj) { const size_t off = row * 1024 + col0 + bj * HALF; f32x4 v0, v1;
                    if (LAYER == 0) { v0 = *(const f32x4*)(x0 + off) + acc[ai][bj][m][0]; v1 = *(const f32x4*)(x0 + off + 4) + acc[ai][bj][m][1];
                        bf16x8 w; w[0] = (bf16_t)v0[0]; w[1] = (bf16_t)v0[1]; w[2] = (bf16_t)v0[2]; w[3] = (bf16_t)v0[3]; w[4] = (bf16_t)v1[0]; w[5] = (bf16_t)v1[1]; w[6] = (bf16_t)v1[2]; w[7] = (bf16_t)v1[3];
                        *(bf16x8*)(xh + off) = w; }
                    else { const bf16x8 xp = *(const bf16x8*)(xh + off);
                        v0 = (f32x4){(float)xp[0], (float)xp[1], (float)xp[2], (float)xp[3]} + acc[ai][bj][m][0]; v1 = (f32x4){(float)xp[4], (float)xp[5], (float)xp[6], (float)xp[7]} + acc[ai][bj][m][1];
                        *(f32x4*)(xout + off) = v0; *(f32x4*)(xout + off + 4) = v1; }
                    ss += ((v0[0] * v0[0] + v0[1] * v0[1]) + (v0[2] * v0[2] + v0[3] * v0[3])) + ((v1[0] * v1[0] + v1[1] * v1[1]) + (v1[2] * v1[2] + v1[3] * v1[3])); }
                ss += __shfl_xor(ss, 16); ss += __shfl_xor(ss, 32);
                if (fq == 0) rowss[row * 16 + u.pn * 4 + wc] = ss; }
    }
};
}


__device__ __forceinline__ void gemm_in(const Params& p, int layer, unsigned char* lds) {
    pg8::Gemm g{(const h16*)(p.ws + WS_XH), (const h16*)(p.ws + WS_WIN) + (size_t)layer * NIN * DM, MROWS, NIN, DM};
    pg8::StaticOrder S; S.init(MROWS, NIN, (int)gridDim.x, (int)blockIdx.x);
    pg8::EpiProj E{(h16*)(p.ws + WS_PROJ), (const float*)(p.ws + WS_ROWSS), (float*)(p.ws + WS_KMEAN)};
    pg8::gemm_phase<pg8::EpiProj, pg8::StaticOrder, true, true>((PG8_LAS unsigned char*)lds, g, S, E);
}
template <int LAYER> __device__ __forceinline__ void gemm_out(const Params& p, unsigned char* lds) {
    pg8::Gemm g{(const h16*)(p.ws + WS_MIX), (const h16*)(p.ws + WS_WOUT) + (size_t)LAYER * DM * DM, MROWS, DM, DM};
    pg8::StaticOrder S; S.init(MROWS, DM, (int)gridDim.x, (int)blockIdx.x);
    pg8::EpiRes<LAYER> E{p.x, p.out, (h16*)(p.ws + WS_XH), (float*)(p.ws + WS_ROWSS)};
    pg8::gemm_phase<pg8::EpiRes<LAYER>, pg8::StaticOrder, true, true>((PG8_LAS unsigned char*)lds, g, S, E);
}

__device__ __forceinline__ void phase_stats(const Params& p, int layer, unsigned char* lds_g) {
    LAS unsigned char* lds = (LAS unsigned char*)lds_g;
    const h16* proj = (const h16*)(p.ws + WS_PROJ); float* kv = (float*)(p.ws + WS_KV);
    const int tid = threadIdx.x, lane = tid & 63, wid = __builtin_amdgcn_readfirstlane(tid >> 6), r = lane & 31, hi = lane >> 5;
    const int lanepart = (4 * hi + ((lane & 15) >> 2)) * 64 + ((lane >> 4) & 1) * 32 + (lane & 3) * 8;
#pragma unroll 1
    for (int u = blockIdx.x; u < 512; u += gridDim.x) {
        const int b = u >> 6, hh = (u >> 4) & 3, np = u & 15;
        const float log_g = logf(1.0f - exp2f(-5.0f - (float)hh));
        __syncthreads();
#pragma unroll
        for (int it = 0; it < 4; ++it) {
            const int pc = tid + 512 * it, cn = pc >> 10, key = (pc >> 3) & 127, ch = pc & 7;
            const h16* src = proj + (size_t)(b * SEQ + (2 * np + cn) * 128 + key) * NIN + hh * 64 + ch * 8;
            h16x8 kk = *(const h16x8*)(src + C_RK); const h16x8 vv = *(const h16x8*)(src + C_RV);
            const float z = __expf(log_g * (float)(127 - key)) * 0.125f;
#pragma unroll
            for (int k = 0; k < 8; ++k) kk[k] = (h16)((float)kk[k] * z);
            const int off = cn * 32768 + (ch >> 2) * 8192 + (key >> 4) * 1024 + (key & 15) * 64 + (ch & 3) * 16;
            *(LAS h16x8*)(lds + off) = kk; *(LAS h16x8*)(lds + off + 16384) = vv;
        }
        __syncthreads();
        const int cn = wid >> 2, eb = (wid >> 1) & 1, dbk = wid & 1;
        const LAS unsigned char* kimg = lds + cn * 32768 + dbk * 8192 + lanepart; const LAS unsigned char* vimg = lds + cn * 32768 + 16384 + eb * 8192 + lanepart;
        f32x16 acc;
#pragma unroll
        for (int i = 0; i < 16; ++i) acc[i] = 0.f;
#pragma unroll
        for (int ks = 0; ks < 8; ++ks) acc = __builtin_amdgcn_mfma_f32_32x32x16_f16(tr_frag(vimg + ks * 1024), tr_frag(kimg + ks * 1024), acc, 0, 0, 0);
        float* dst = kv + ((size_t)((b * 4 + hh) * 32 + 2 * np + cn)) * 4096 + (32 * eb + 4 * hi) * 64 + 32 * dbk + r;
#pragma unroll
        for (int i = 0; i < 16; ++i) dst[CROW0(i) * 64] = acc[i];
    }
#pragma unroll 1
    for (int u = blockIdx.x; u < 1024; u += gridDim.x) {
        const int b = u >> 7, row = (u & 127) * 32 + (tid >> 4), part = tid & 15;
        const h16* src = proj + (size_t)(b * SEQ + row) * NIN + C_MK + part * 32;
        float ss = 0.f;
#pragma unroll
        for (int k = 0; k < 4; ++k) { const h16x8 kk = *(const h16x8*)(src + k * 8);
#pragma unroll
            for (int d = 0; d < 8; ++d) ss += (float)kk[d] * (float)kk[d]; }
        ss += __shfl_xor(ss, 1);
        ss = fmaxf(ss, __shfl_xor(ss, 16)); ss = fmaxf(ss, __shfl_xor(ss, 32));
        if ((lane & 0x31) == 0) atomicMax((unsigned*)(p.ws + WS_CTL + 20480) + layer * 64 + b * 8 + (part >> 1), __float_as_uint(ss));
    }
}

typedef _Float16 h16x2 __attribute__((ext_vector_type(2)));
typedef float f32x2 __attribute__((ext_vector_type(2)));
__device__ __forceinline__ void conv_unit(const Params& p, int layer, int b, int tt, unsigned char* lds_g) {
    LAS unsigned char* lds = (LAS unsigned char*)lds_g;
    const h16* projb = (const h16*)(p.ws + WS_PROJ) + (size_t)b * SEQ * NIN; h16* mix = (h16*)(p.ws + WS_MIX);
    const int tid = threadIdx.x, lane = tid & 63, wid = __builtin_amdgcn_readfirstlane(tid >> 6), r = lane & 31, hi = lane >> 5;
    const int cp = tid & 127, tg = __builtin_amdgcn_readfirstlane(tid >> 7), t0 = tt * 64, tb0 = t0 + 16 * tg - 30;
    constexpr int YS = 0, SIMG = 65536;
    float y0[16], y1[16];
    {
        float w0[31], w1[31]; const float* cw = p.conv_w + (size_t)layer * 31 * 256 + 2 * cp;
#pragma unroll
        for (int jj = 0; jj < 31; ++jj) { const f32x2 wv = *(const f32x2*)(cw + jj * 256); w0[jj] = wv[0]; w1[jj] = wv[1]; }
        const f32x2 cbv = *(const f32x2*)(p.conv_b + layer * 256 + 2 * cp);
#pragma unroll
        for (int tl = 0; tl < 16; ++tl) { y0[tl] = cbv[0]; y1[tl] = cbv[1]; }
#pragma unroll
        for (int rr = 0; rr < 46; ++rr) {
            const int t = tb0 + rr; float a0 = 0.f, a1 = 0.f;
            if (t >= 0) { const h16x2 av = *(const h16x2*)(projb + (size_t)t * NIN + C_AVAL + 2 * cp), gv = *(const h16x2*)(projb + (size_t)t * NIN + C_AGLU + 2 * cp);
                a0 = (float)av[0] * __builtin_amdgcn_rcpf(1.0f + __expf(-(float)gv[0])); a1 = (float)av[1] * __builtin_amdgcn_rcpf(1.0f + __expf(-(float)gv[1])); }
#pragma unroll
            for (int tl = 0; tl < 16; ++tl) { const int jj = rr - tl; if (jj >= 0 && jj < 31) { y0[tl] += w0[jj] * a0; y1[tl] += w1[jj] * a1; } }
        }
    }
    __syncthreads();
#pragma unroll
    for (int tl = 0; tl < 16; ++tl) *(LAS f32x2*)(lds + YS + ((16 * tg + tl) * 256 + 2 * cp) * 4) = (f32x2){y0[tl], y1[tl]};
    h16x8 wf[16];
    {
        const h16* wp = (const h16*)(p.ws + WS_WPW) + (size_t)layer * 65536 + (size_t)(32 * wid + r) * 256 + 8 * hi;
#pragma unroll
        for (int ks = 0; ks < 16; ++ks) wf[ks] = *(const h16x8*)(wp + 16 * ks);
    }
    __syncthreads();
    {
        const f32x4 lg = *(const f32x4*)(p.ln_g + layer * 256 + lane * 4), lb = *(const f32x4*)(p.ln_b + layer * 256 + lane * 4);
#pragma unroll 1
        for (int kb = 0; kb < 8; kb += 4) {
        f32x4 v[4]; float s1[4], s2[4];
#pragma unroll
        for (int k = 0; k < 4; ++k) { v[k] = *(const LAS f32x4*)(lds + YS + ((wid * 8 + kb + k) * 256 + lane * 4) * 4);
            s1[k] = (v[k][0] + v[k][1]) + (v[k][2] + v[k][3]); s2[k] = (v[k][0] * v[k][0] + v[k][1] * v[k][1]) + (v[k][2] * v[k][2] + v[k][3] * v[k][3]); }
#pragma unroll
        for (int o = 1; o < 64; o <<= 1)
#pragma unroll
            for (int k = 0; k < 4; ++k) { s1[k] += __shfl_xor(s1[k], o); s2[k] += __shfl_xor(s2[k], o); }
#pragma unroll
        for (int k = 0; k < 4; ++k) { const int t = wid * 8 + kb + k; const float mu = s1[k] * (1.0f / 256.0f); const float var = fmaxf(s2[k] * (1.0f / 256.0f) - mu * mu, 0.f); const float rs = rsqrtf(var + 1e-5f);
            h16x4 o; o[0] = (h16)silu_f((v[k][0] - mu) * rs * lg[0] + lb[0]); o[1] = (h16)silu_f((v[k][1] - mu) * rs * lg[1] + lb[1]); o[2] = (h16)silu_f((v[k][2] - mu) * rs * lg[2] + lb[2]); o[3] = (h16)silu_f((v[k][3] - mu) * rs * lg[3] + lb[3]);
            *(LAS h16x4*)(lds + SIMG + t * 512 + (((lane >> 1) ^ (t & 15)) << 4) + 8 * (lane & 1)) = o; }
        }
    }
    __syncthreads();
#pragma unroll
    for (int tb = 0; tb < 2; ++tb) {
        f32x16 acc;
#pragma unroll
        for (int i = 0; i < 16; ++i) acc[i] = 0.f;
#pragma unroll
        for (int ks = 0; ks < 16; ++ks) acc = __builtin_amdgcn_mfma_f32_32x32x16_f16(wf[ks], *(const LAS h16x8*)(lds + SIMG + (32 * tb + r) * 512 + (((2 * ks + hi) ^ (r & 15)) << 4)), acc, 0, 0, 0);
        const int t = t0 + 32 * tb + r, n0 = 32 * wid + 4 * hi;
        const h16* gp = projb + (size_t)t * NIN + C_AGATE + n0; h16* dst = mix + ((size_t)b * SEQ + t) * DM + n0; const float* pb = p.pw_b + layer * 256 + n0;
#pragma unroll
        for (int g = 0; g < 4; ++g) { const h16x4 ga = *(const h16x4*)(gp + 8 * g); const f32x4 bb = *(const f32x4*)(pb + 8 * g); h16x4 oa;
#pragma unroll
            for (int k = 0; k < 4; ++k) oa[k] = (h16)((acc[4 * g + k] + bb[k]) * silu_f((float)ga[k]));
            *(h16x4*)(dst + 8 * g) = oa; }
    }
}

__device__ __forceinline__ void ret_unit(const Params& p, int b, int hh, int n, unsigned char* lds_g) {
    LAS unsigned char* lds = (LAS unsigned char*)lds_g;
    const h16* projb = (const h16*)(p.ws + WS_PROJ) + (size_t)(b * SEQ + n * 128) * NIN; h16* mix = (h16*)(p.ws + WS_MIX); const float* kv = (const float*)(p.ws + WS_KV);
    const int tid = threadIdx.x, lane = tid & 63, wid = __builtin_amdgcn_readfirstlane(tid >> 6), r = lane & 31, hi = lane >> 5, g4 = wid & 3, eh = wid >> 2;
    const float log_g = logf(1.0f - exp2f(-5.0f - (float)hh));
    constexpr int KIMG = 0, VIMG = 16384, RIMG = 32768, XS = 40960;
    const h16x8 rr = *(const h16x8*)((const h16*)(p.ws + WS_RST) + ((size_t)((b * 4 + hh) * 32 + n)) * 4096 + tid * 8);
    __syncthreads();
    {
        const int e = tid >> 3, ch = tid & 7;
        *(LAS h16x8*)(lds + RIMG + e * 128 + ((ch ^ ((e >> 1) & 7)) << 4)) = rr;
#pragma unroll
        for (int it = 0; it < 2; ++it) {
            const int key = (tid >> 3) + 64 * it;
            h16x8 kk = *(const h16x8*)(projb + (size_t)key * NIN + C_RK + hh * 64 + ch * 8); const h16x8 vv = *(const h16x8*)(projb + (size_t)key * NIN + C_RV + hh * 64 + ch * 8);
            const float z = __expf(-log_g * (float)key) * 0.125f;
#pragma unroll
            for (int k = 0; k < 8; ++k) kk[k] = (h16)((float)kk[k] * z);
            *(LAS h16x8*)(lds + KIMG + key * 128 + ((ch ^ ((key >> 1) & 7)) << 4)) = kk;
            *(LAS h16x8*)(lds + VIMG + (ch >> 2) * 8192 + (key >> 4) * 1024 + (key & 15) * 64 + (ch & 3) * 16) = vv;
        }
    }
    const int qi = 32 * g4 + r;
    h16x8 qf[4];
    {
        const float zq = __expf(log_g * (float)qi);
#pragma unroll
        for (int s = 0; s < 4; ++s) { qf[s] = *(const h16x8*)(projb + (size_t)qi * NIN + C_RQ + hh * 64 + 16 * s + 8 * hi);
#pragma unroll
            for (int k = 0; k < 8; ++k) qf[s][k] = (h16)((float)qf[s][k] * zq); }
    }
    __syncthreads();
    const int rsw = (r >> 1) & 7;
    const int lanepart = (4 * hi + ((lane & 15) >> 2)) * 64 + ((lane >> 4) & 1) * 32 + (lane & 3) * 8;
    f32x16 o;
#pragma unroll
    for (int i = 0; i < 16; ++i) o[i] = 0.f;
#pragma unroll 1
    for (int jb = 0; jb <= g4; ++jb) {
        f32x16 c;
#pragma unroll
        for (int i = 0; i < 16; ++i) c[i] = 0.f;
#pragma unroll
        for (int s = 0; s < 4; ++s) c = __builtin_amdgcn_mfma_f32_32x32x16_f16(*(const LAS h16x8*)(lds + KIMG + (32 * jb + r) * 128 + (((2 * s + hi) ^ rsw) << 4)), qf[s], c, 0, 0, 0);
        if (jb == g4) {
#pragma unroll
            for (int i = 0; i < 16; ++i) if (CROW0(i) + 4 * hi > r) c[i] = 0.f;
        }
        h16x8 pf0, pf1;
#pragma unroll
        for (int k = 0; k < 8; ++k) { pf0[k] = (h16)c[k]; pf1[k] = (h16)c[8 + k]; }
        o = __builtin_amdgcn_mfma_f32_32x32x16_f16(tr_frag(lds + VIMG + eh * 8192 + (2 * jb) * 1024 + lanepart), pf0, o, 0, 0, 0);
        o = __builtin_amdgcn_mfma_f32_32x32x16_f16(tr_frag(lds + VIMG + eh * 8192 + (2 * jb + 1) * 1024 + lanepart), pf1, o, 0, 0, 0);
    }
#pragma unroll
    for (int s = 0; s < 4; ++s) o = __builtin_amdgcn_mfma_f32_32x32x16_f16(*(const LAS h16x8*)(lds + RIMG + (32 * eh + r) * 128 + (((2 * s + hi) ^ rsw) << 4)), qf[s], o, 0, 0, 0);
    float s1 = 0.f, s2 = 0.f;
#pragma unroll
    for (int i = 0; i < 16; ++i) { s1 += o[i]; s2 += o[i] * o[i]; }
    s1 = xhalf_sum(s1); s2 = xhalf_sum(s2);
    LAS float* xs = (LAS float*)(lds + XS);
    if (hi == 0) { xs[(wid * 32 + r) * 2] = s1; xs[(wid * 32 + r) * 2 + 1] = s2; }
    __syncthreads();
    {
        const float t1 = xs[((wid ^ 4) * 32 + r) * 2], t2 = xs[((wid ^ 4) * 32 + r) * 2 + 1];
        const float a1 = (eh == 0) ? (s1 + t1) : (t1 + s1), a2 = (eh == 0) ? (s2 + t2) : (t2 + s2);
        const float mu = a1 * (1.0f / 64.0f); const float var = fmaxf(a2 * (1.0f / 64.0f) - mu * mu, 0.f); const float rs = rsqrtf(var + 1e-5f);
        const int col = hh * 64 + 32 * eh + 4 * hi;
        const h16* gp = projb + (size_t)qi * NIN + C_RGATE + col; h16* dst = mix + ((size_t)(b * SEQ + n * 128 + qi)) * DM + 256 + col;
#pragma unroll
        for (int g = 0; g < 4; ++g) { const h16x4 ga = *(const h16x4*)(gp + 8 * g); h16x4 oa;
#pragma unroll
            for (int k = 0; k < 4; ++k) oa[k] = (h16)((o[4 * g + k] - mu) * rs * silu_f((float)ga[k]));
            *(h16x4*)(dst + 8 * g) = oa; }
    }
}

constexpr float MOBA_THR = 8.0f;
__device__ __forceinline__ void moba_unit(const Params& p, int layer, int b, int hh, int j, unsigned char* lds_g) {
    LAS unsigned char* lds = (LAS unsigned char*)lds_g;
    const int tid = threadIdx.x, lane = tid & 63, wid = __builtin_amdgcn_readfirstlane(tid >> 6), r = lane & 31, hi = lane >> 5;
    const h16* projb = (const h16*)(p.ws + WS_PROJ) + (size_t)b * SEQ * NIN; h16* mix = (h16*)(p.ws + WS_MIX);
    const int qrow = j * 256 + wid * 32 + r;
    h16x8 qf[4];
#pragma unroll
    for (int s = 0; s < 4; ++s) qf[s] = *(const h16x8*)(projb + (size_t)qrow * NIN + C_MQ + hh * 64 + 16 * s + 8 * hi);
    unsigned selmask = 0u;
    if (j <= 3) selmask = (1u << j) - 1u;
    else {
        const float* km = (const float*)(p.ws + WS_KMEAN) + ((size_t)(b * 8 + hh) * 16 + (r & 15)) * 64 + 8 * hi;
        f32x16 g;
#pragma unroll
        for (int i = 0; i < 16; ++i) g[i] = 0.f;
#pragma unroll
        for (int s = 0; s < 4; ++s) {
            f32x4 a0 = (f32x4){0.f, 0.f, 0.f, 0.f}, a1 = a0;
            if (r < j) { a0 = *(const f32x4*)(km + 16 * s) + *(const f32x4*)(km + 65536 + 16 * s); a1 = *(const f32x4*)(km + 16 * s + 4) + *(const f32x4*)(km + 65536 + 16 * s + 4); }
            h16x8 ah, al;
#pragma unroll
            for (int k = 0; k < 4; ++k) { const h16 h0 = (h16)a0[k], h1 = (h16)a1[k]; ah[k] = h0; ah[4 + k] = h1; al[k] = (h16)(a0[k] - (float)h0); al[4 + k] = (h16)(a1[k] - (float)h1); }
            g = __builtin_amdgcn_mfma_f32_32x32x16_f16(ah, qf[s], g, 0, 0, 0);
            g = __builtin_amdgcn_mfma_f32_32x32x16_f16(al, qf[s], g, 0, 0, 0);
        }
        float gate[16];
#pragma unroll
        for (int i = 0; i < 8; ++i) { auto rr = __builtin_amdgcn_permlane32_swap(__float_as_uint(g[i]), __float_as_uint(g[i]), false, false);
            gate[(i & 3) + 8 * (i >> 2)] = __uint_as_float(rr[0]); gate[(i & 3) + 8 * (i >> 2) + 4] = __uint_as_float(rr[1]); }
        float g0 = -3.0e38f, g1 = -3.0e38f, g2 = -3.0e38f; int i0 = 0, i1 = 0, i2 = 0;
#pragma unroll
        for (int n = 0; n < 15; ++n) { const float s = (n < j) ? gate[n] : -3.0e38f;
            if (s > g0) { g2 = g1; i2 = i1; g1 = g0; i1 = i0; g0 = s; i0 = n; }
            else if (s > g1) { g2 = g1; i2 = i1; g1 = s; i1 = n; }
            else if (s > g2) { g2 = s; i2 = n; } }
        selmask = (1u << i0) | (1u << i1) | (1u << i2);
    }
    constexpr float C2 = 0.125f * 1.4426950408889634f;
    float qn2 = 0.f;
#pragma unroll
    for (int s = 0; s < 4; ++s)
#pragma unroll
        for (int k = 0; k < 8; ++k) { qf[s][k] = (h16)((float)qf[s][k] * C2); qn2 += (float)qf[s][k] * (float)qf[s][k]; }
    const float qbound = sqrtf(xhalf_sum(qn2)) * sqrtf(__uint_as_float(__hip_atomic_load((const unsigned*)(p.ws + WS_CTL + 20480) + layer * 64 + b * 8 + hh, __ATOMIC_RELAXED, __HIP_MEMORY_SCOPE_AGENT))) * 1.001f;
    const float slope2 = exp2f(-(float)(hh + 1)) * 1.4426950408889634f;
    f32x16 o0, o1;
#pragma unroll
    for (int i = 0; i < 16; ++i) { o0[i] = 0.f; o1[i] = 0.f; }
    float mref = 0.f, lsum = 0.f; bool first = true;
    const unsigned lds0 = (unsigned)(__UINTPTR_TYPE__)lds;
    const int dkey = 8 * wid + (lane >> 3);
    const h16* ksrc = projb + (size_t)dkey * NIN + C_MK + hh * 64 + (((lane & 7) ^ ((dkey >> 1) & 7)) << 3);
    const h16* vsrc = projb + (size_t)(16 * (wid & 3) + (lane >> 2)) * NIN + C_MV + hh * 64 + (wid >> 2) * 32 + (lane & 3) * 8;
    const unsigned kdst = lds0 + wid * 1024, vdst = lds0 + 8192 + (wid >> 2) * 4096 + (wid & 3) * 1024;
#define MOBA_DMA(tile) do { const int kp_ = j * 256 + 192 - 64 * (tile); const unsigned so_ = (unsigned)(((tile) & 3) * 16384); \
        glds16(ksrc + (size_t)kp_ * NIN, (unsigned)__builtin_amdgcn_readfirstlane(kdst + so_)); glds16(vsrc + (size_t)kp_ * NIN, (unsigned)__builtin_amdgcn_readfirstlane(vdst + so_)); } while (0)
#define MOBA_WAIT_BAR(N) asm volatile("s_waitcnt vmcnt(" #N ") lgkmcnt(0)\n\ts_barrier" ::: "memory")
    const int rK = r * 128, rsw = (r >> 1) & 7;
    const int rV = 8192 + (4 * hi + ((lane & 15) >> 2)) * 64 + ((lane >> 4) & 1) * 32 + (lane & 3) * 8;
    const int nt = 4 * (j + 1);
    const int wdiag = wid >> 1;
#define MOBA_CIN(T, C0, C1) do { const int kp_ = j * 256 + 192 - 64 * (T); const int nb_ = kp_ >> 8, tl_ = (kp_ >> 6) & 3; const bool own_ = (nb_ == j); \
        const bool val_ = own_ ? true : (((selmask >> (nb_ & 31)) & 1u) != 0u); \
        const float tbh_ = val_ ? (slope2 * (float)(kp_ - qrow + 4 * hi) - mref) : -INFINITY; \
        _Pragma("unroll") for (int i = 0; i < 16; ++i) { C0[i] = fmaf(slope2, (float)CROW0(i), tbh_); C1[i] = fmaf(slope2, (float)(CROW0(i) + 32), tbh_); } \
        if (own_ && tl_ >= wdiag) { const int lim2_ = 32 * wid - 64 * tl_ + r - 4 * hi; \
            _Pragma("unroll") for (int i = 0; i < 16; ++i) { if (CROW0(i) > lim2_) C0[i] = -INFINITY; if (CROW0(i) + 32 > lim2_) C1[i] = -INFINITY; } } } while (0)
#define MOBA_QK(T, C0, C1) do { const LAS unsigned char* kb_ = lds + ((T) & 3) * 16384 + rK; \
        _Pragma("unroll") for (int s = 0; s < 4; ++s) { \
            const h16x8 k0_ = *(const LAS h16x8*)(kb_ + (((2 * s + hi) ^ rsw) << 4)), k1_ = *(const LAS h16x8*)(kb_ + 4096 + (((2 * s + hi) ^ rsw) << 4)); \
            C0 = __builtin_amdgcn_mfma_f32_32x32x16_f16(k0_, qf[s], C0, 0, 0, 0); C1 = __builtin_amdgcn_mfma_f32_32x32x16_f16(k1_, qf[s], C1, 0, 0, 0); } } while (0)
#define MOBA_DECIDE(T, C0, C1) do { float m_ = __builtin_fmaxf(C0[0], C1[0]); \
        _Pragma("unroll") for (int i = 1; i < 16; ++i) m_ = __builtin_fmaxf(__builtin_fmaxf(m_, C0[i]), C1[i]); \
        m_ = xhalf_max(m_); \
        const int kp_ = j * 256 + 192 - 64 * (T); const bool fst_ = ((kp_ >> 8) == j) && (((kp_ >> 6) & 3) == wdiag); \
        if (fst_ || __any(m_ > MOBA_THR)) { const float dl_ = fst_ ? m_ : __builtin_fmaxf(m_, 0.f); const float f_ = fst_ ? 1.0f : __builtin_amdgcn_exp2f(-dl_); mref += dl_; lsum *= f_; \
            _Pragma("unroll") for (int i = 0; i < 16; ++i) { C0[i] -= dl_; C1[i] -= dl_; o0[i] *= f_; o1[i] *= f_; } } } while (0)
#define MOBA_STEP(T, TE, P0, P1, N0, N1) do { \
        if ((T) + 3 < (TE)) MOBA_DMA((T) + 3); \
        MOBA_CIN((T) + 1, N0, N1); MOBA_QK((T) + 1, N0, N1); \
        float ps_ = 0.f; \
        _Pragma("unroll") for (int i = 0; i < 16; ++i) { P0[i] = __builtin_amdgcn_exp2f(P0[i]); P1[i] = __builtin_amdgcn_exp2f(P1[i]); ps_ += P0[i] + P1[i]; } \
        lsum += ps_; \
        h16x8 pf_[4]; \
        _Pragma("unroll") for (int k = 0; k < 8; ++k) { pf_[0][k] = (h16)P0[k]; pf_[1][k] = (h16)P0[8 + k]; pf_[2][k] = (h16)P1[k]; pf_[3][k] = (h16)P1[8 + k]; } \
        { const LAS unsigned char* vb_ = lds + ((T) & 3) * 16384 + rV; \
          _Pragma("unroll") for (int t = 0; t < 4; ++t) { const h16x8 v0_ = tr_frag(vb_ + t * 1024), v1_ = tr_frag(vb_ + 4096 + t * 1024); \
            o0 = __builtin_amdgcn_mfma_f32_32x32x16_f16(v0_, pf_[t], o0, 0, 0, 0); o1 = __builtin_amdgcn_mfma_f32_32x32x16_f16(v1_, pf_[t], o1, 0, 0, 0); } } \
        if ((T) + 1 < (TE)) MOBA_DECIDE((T) + 1, N0, N1); \
        if ((T) + 3 < (TE)) MOBA_WAIT_BAR(2); else MOBA_WAIT_BAR(0); } while (0)
    f32x16 cA0, cA1, cB0, cB1;
    int te = nt;
    MOBA_WAIT_BAR(0);
    MOBA_DMA(0); MOBA_DMA(1); MOBA_DMA(2);
    MOBA_WAIT_BAR(2);
    MOBA_CIN(0, cA0, cA1); MOBA_QK(0, cA0, cA1); MOBA_DECIDE(0, cA0, cA1);
    MOBA_STEP(0, te, cA0, cA1, cB0, cB1); MOBA_STEP(1, te, cB0, cB1, cA0, cA1); MOBA_STEP(2, te, cA0, cA1, cB0, cB1);
    if (j > 0) {
        float marg = qbound - mref;
#pragma unroll
        for (int o = 1; o < 64; o <<= 1) marg = fmaxf(marg, __shfl_xor(marg, o));
        LAS float* xs = (LAS float*)(lds + 65536);
        if (lane == 0) xs[wid] = marg;
        MOBA_WAIT_BAR(2);
        float M = xs[0];
#pragma unroll
        for (int k = 1; k < 8; ++k) M = fmaxf(M, xs[k]);
        const float num = M + 50.0f - slope2;
        int cnt = (num >= 0.f) ? ((int)(num / (64.0f * slope2)) + 1) : 0;
        cnt = max(min(cnt, 4 * j), 2); cnt = (cnt + 1) & ~1;
        te = 4 + __builtin_amdgcn_readfirstlane(cnt);
    }
    MOBA_STEP(3, te, cB0, cB1, cA0, cA1);
#pragma unroll 1
    for (int tt = 4; tt < te; tt += 2) { MOBA_STEP(tt, te, cA0, cA1, cB0, cB1); MOBA_STEP(tt + 1, te, cB0, cB1, cA0, cA1); }
    MOBA_WAIT_BAR(0);
#undef MOBA_RUN
#undef MOBA_CIN
#undef MOBA_QK
#undef MOBA_DECIDE
#undef MOBA_STEP
#undef MOBA_DMA
#undef MOBA_WAIT_BAR
    {
        const float inv = 1.0f / xhalf_sum(lsum);
        const h16* gp = projb + (size_t)qrow * NIN + C_MGATE + hh * 64 + 4 * hi; h16* dst = mix + ((size_t)b * SEQ + qrow) * DM + 512 + hh * 64 + 4 * hi;
#pragma unroll
        for (int g = 0; g < 4; ++g) {
            const h16x4 ga = *(const h16x4*)(gp + 8 * g), gb = *(const h16x4*)(gp + 32 + 8 * g); h16x4 oa, ob;
#pragma unroll
            for (int k = 0; k < 4; ++k) { oa[k] = (h16)(o0[4 * g + k] * inv * silu_f((float)ga[k])); ob[k] = (h16)(o1[4 * g + k] * inv * silu_f((float)gb[k])); }
            *(h16x4*)(dst + 8 * g) = oa; *(h16x4*)(dst + 32 + 8 * g) = ob;
        }
    }
}

__device__ __forceinline__ void ret_scan_shares(const Params& p, int layer) {
    const float* kv = (const float*)(p.ws + WS_KV); h16* rst = (h16*)(p.ws + WS_RST);
    const int tid = threadIdx.x; unsigned done = 0u;
#pragma unroll 1
    for (int s = blockIdx.x; s < 256; s += gridDim.x) {
        const int bh = s >> 3, e = (s & 7) * 512 + tid, hh = bh & 3;
        const float gam = 1.0f - exp2f(-5.0f - (float)hh); const float g = expf(logf(gam) * 128.0f);
        const float* kvb = kv + (size_t)bh * 32 * 4096 + e; h16* rb = rst + (size_t)bh * 32 * 4096 + e;
        float r = 0.f; rb[0] = (h16)0.f;
#pragma unroll 1
        for (int m0 = 0; m0 < 31; m0 += 8) {
            float kvv[8];
#pragma unroll
            for (int k = 0; k < 8; ++k) kvv[k] = (m0 + k < 31) ? kvb[(size_t)(m0 + k) * 4096] : 0.f;
#pragma unroll
            for (int k = 0; k < 8; ++k) if (m0 + k < 31) { r = r * g + kvv[k]; rb[(size_t)(m0 + k + 1) * 4096] = (h16)(r * gam); }
        }
        ++done;
    }
    asm volatile("s_waitcnt vmcnt(0)" ::: "memory");
    __syncthreads();
    if (tid == 0) { __builtin_amdgcn_fence(__ATOMIC_RELEASE, "agent"); asm volatile("s_waitcnt vmcnt(0)" ::: "memory");
        __hip_atomic_fetch_add((unsigned*)(p.ws + WS_CTL + 16384) + 64 * layer, done, __ATOMIC_RELAXED, __HIP_MEMORY_SCOPE_AGENT); }
}
__device__ __forceinline__ void ret_scan_wait(const Params& p, int layer) {
    if (threadIdx.x == 0) {
        unsigned* c = (unsigned*)(p.ws + WS_CTL + 16384) + 64 * layer; unsigned sp = 0u;
        while (__hip_atomic_load(c, __ATOMIC_RELAXED, __HIP_MEMORY_SCOPE_AGENT) < 256u) { __builtin_amdgcn_s_sleep(2); if (++sp > (1u << 22)) break; }
        __builtin_amdgcn_fence(__ATOMIC_ACQUIRE, "agent"); asm volatile("s_waitcnt vmcnt(0)" ::: "memory");
    }
    __syncthreads();
}

__device__ __forceinline__ int queue_pop(unsigned* counter, LAS unsigned* slot) {
    __syncthreads();
    if (threadIdx.x == 0) slot[0] = __hip_atomic_fetch_add(counter, 1u, __ATOMIC_RELAXED, __HIP_MEMORY_SCOPE_AGENT);
    __syncthreads();
    return (int)slot[0];
}
__device__ __forceinline__ void phase_mixers(const Params& p, int layer, unsigned char* lds) {
    static constexpr unsigned char MOBA_ORDER[128] = {111,127,110,126,109,125,93,94,95,92,108,124,91,107,123,90,106,122,89,105,121,88,104,120,87,103,119,71,72,73,74,75,76,77,78,79,70,86,102,118,69,85,101,117,68,84,100,116,52,53,54,55,56,57,58,59,60,61,62,63,51,67,83,99,115,50,66,82,98,114,34,35,36,37,38,39,40,41,42,43,44,45,46,47,17,18,19,20,21,22,23,24,25,26,27,28,29,30,31,33,49,65,81,97,113,1,2,3,4,5,6,7,8,9,10,11,12,13,14,15,0,16,32,48,64,80,96,112};
    unsigned* qc = (unsigned*)(p.ws + WS_CTL + 24576) + layer * 256;
    LAS unsigned* slot = (LAS unsigned*)((LAS unsigned char*)lds + BAR_LDS_OFF + 16);
    ret_scan_shares(p, layer);
#define QUEUE_LOOP(CNT, N, BODY) do { int cur = queue_pop(CNT, slot); \
        _Pragma("unroll 1") while (cur < (N)) { unsigned nxt_ = 0u; if (threadIdx.x == 0) nxt_ = __hip_atomic_fetch_add(CNT, 1u, __ATOMIC_RELAXED, __HIP_MEMORY_SCOPE_AGENT); \
            { BODY; } \
            __syncthreads(); if (threadIdx.x == 0) slot[0] = nxt_; __syncthreads(); cur = (int)slot[0]; } } while (0)
    QUEUE_LOOP(qc, 1024, const int hj = MOBA_ORDER[cur >> 3]; moba_unit(p, layer, cur & 7, hj >> 4, hj & 15, lds));
    ret_scan_wait(p, layer);
    QUEUE_LOOP(qc + 64, 1024, ret_unit(p, cur >> 7, (cur >> 5) & 3, cur & 31, lds));
    QUEUE_LOOP(qc + 128, 512, conv_unit(p, layer, cur >> 6, cur & 63, lds));
#undef QUEUE_LOOP
}

__device__ __forceinline__ void phase_final(const Params& p) {
    const float* rowss = (const float*)(p.ws + WS_ROWSS);
    const int lane = threadIdx.x & 63, wid = threadIdx.x >> 6;
    f32x4 g[4];
#pragma unroll
    for (int j = 0; j < 4; ++j) g[j] = *((const f32x4*)p.final_g + lane + 64 * j);
    for (int row = blockIdx.x * 8 + wid; row < MROWS; row += gridDim.x * 8) {
        const f32x4* rs = (const f32x4*)(rowss + (size_t)row * NPART); const f32x4 s0 = rs[0], s1 = rs[1], s2 = rs[2], s3 = rs[3];
        const float tot = ((s0[0] + s0[1]) + (s0[2] + s0[3])) + ((s1[0] + s1[1]) + (s1[2] + s1[3])) + ((s2[0] + s2[1]) + (s2[2] + s2[3])) + ((s3[0] + s3[1]) + (s3[2] + s3[3]));
        const float rstd = rsqrtf(tot * (1.0f / DM) + 1e-6f);
        f32x4* xr = (f32x4*)(p.out + (size_t)row * DM) + lane;
#pragma unroll
        for (int j = 0; j < 4; ++j) { f32x4 v = xr[64 * j]; v = v * rstd * g[j]; xr[64 * j] = v; }
    }
}

#define XB_TMO      128
#define XB_XCNT(j)  (256  + 64 * (j))
#define XB_XSUB(j)  (1280 + 64 * (j))
#define XB_XGEN(j)  (2304 + 64 * (j))
#define XB_TOP      3328
#define XB_TOPGEN   3392
#define XCD_BAR_WORDS 3456
#define XB_SPIN_CAP (1u << 18)

__device__ __forceinline__ unsigned xb_ld(unsigned* p)              { return __hip_atomic_load(p, __ATOMIC_RELAXED, __HIP_MEMORY_SCOPE_AGENT); }
__device__ __forceinline__ unsigned xb_add(unsigned* p, unsigned v) { return __hip_atomic_fetch_add(p, v, __ATOMIC_RELAXED, __HIP_MEMORY_SCOPE_AGENT); }
__device__ __forceinline__ unsigned xb_xcc_id() { return (unsigned)__builtin_amdgcn_s_getreg((3 << 11) | 20) & 0xFu; }
#define XB_SPIN(cond, bar) do { unsigned _sp = 0; while (cond) { __builtin_amdgcn_s_sleep(1); \
    if ((++_sp & 255u) == 0u) { if (xb_ld(&(bar)[XB_TMO])) break; if (_sp > XB_SPIN_CAP) { atomicAdd(&(bar)[XB_TMO], 1u); break; } } } } while (0)

struct XcdBarrier {
    unsigned* bar; unsigned x;
    volatile LAS unsigned* st;
};

__device__ __forceinline__ XcdBarrier xcd_barrier_post(unsigned* bar, volatile LAS unsigned* st) {
    XcdBarrier b; b.bar = bar; b.x = xb_xcc_id(); b.st = st;
    if (threadIdx.x == 0) (void)xb_add(&bar[XB_XCNT(b.x)], 1u);
    return b;
}
__device__ __forceinline__ void xcd_barrier_complete(unsigned* bar, unsigned x, unsigned& nloc, unsigned& nx) {
    const unsigned G = gridDim.x * gridDim.y * gridDim.z;
    unsigned sum, cnt, mine, sp = 0u;
    for (;;) {
        sum = 0u; cnt = 0u; mine = 0u;
#pragma unroll
        for (unsigned j = 0; j < 16; ++j) { const unsigned c = xb_ld(&bar[XB_XCNT(j)]); sum += c; cnt += (c > 0u) ? 1u : 0u; mine = (j == x) ? c : mine; }
        if (sum == G) break;
        __builtin_amdgcn_s_sleep(1);
        if ((++sp & 255u) == 0u) { if (xb_ld(&bar[XB_TMO])) break; if (sp > XB_SPIN_CAP) { atomicAdd(&bar[XB_TMO], 1u); break; } }
    }
    nloc = mine > 0u ? mine : 1u; nx = cnt > 0u ? cnt : 1u;
}

__device__ __forceinline__ void xcd_barrier(const XcdBarrier& b) {
    asm volatile("s_waitcnt vmcnt(0)" ::: "memory");
    __syncthreads();
    if (threadIdx.x == 0) {
        unsigned* bar = b.bar;
        __builtin_amdgcn_s_waitcnt(0);
        unsigned nloc = b.st[0], nx = b.st[1];
        if (nloc == 0u) { xcd_barrier_complete(bar, b.x, nloc, nx); b.st[0] = nloc; b.st[1] = nx; }
        const unsigned old = xb_add(&bar[XB_XSUB(b.x)], 1u);
        const unsigned gen = old / nloc;
        if (old + 1u == (gen + 1u) * nloc) {
            __builtin_amdgcn_fence(__ATOMIC_RELEASE, "agent");
            asm volatile("s_waitcnt vmcnt(0)" ::: "memory");
            const unsigned og = xb_add(&bar[XB_TOP], 1u);
            const unsigned tg = og / nx;
            if (og + 1u == (tg + 1u) * nx) xb_add(&bar[XB_TOPGEN], 1u);
            else XB_SPIN(xb_ld(&bar[XB_TOPGEN]) == tg, bar);
            __builtin_amdgcn_fence(__ATOMIC_ACQUIRE, "agent");
            xb_add(&bar[XB_XGEN(b.x)], 1u);
            asm volatile("s_waitcnt vmcnt(0)" ::: "memory");
        } else {
            XB_SPIN(xb_ld(&bar[XB_XGEN(b.x)]) == gen, bar);
            __builtin_amdgcn_fence(__ATOMIC_ACQUIRE, "agent");
            asm volatile("s_waitcnt vmcnt(0)" ::: "memory");
        }
    }
    __syncthreads();
}


__global__ void __launch_bounds__(NTHREADS) hymba_fwd(Params p) {
    extern __shared__ __attribute__((aligned(16))) unsigned char lds[];
    cg::grid_group grid = cg::this_grid();
    volatile LAS unsigned* bst = (volatile LAS unsigned*)((LAS unsigned char*)lds + BAR_LDS_OFF);
    if (threadIdx.x < 2) bst[threadIdx.x] = 0u;
    __syncthreads();
    XcdBarrier xbar = xcd_barrier_post((unsigned*)(p.ws + WS_CTL), bst);
#define RUN_PHASE(k, body) do { if (p.ph_lo <= (k) && (k) < p.ph_hi) { body; if ((k) + 1 < p.ph_hi) { if ((k) == 0) grid.sync(); else xcd_barrier(xbar); } } } while (0)
    RUN_PHASE(0, phase_prologue(p, lds));
    RUN_PHASE(1, gemm_in(p, 0, lds));
    RUN_PHASE(2, phase_stats(p, 0, lds));
    RUN_PHASE(3, phase_mixers(p, 0, lds));
    RUN_PHASE(4, gemm_out<0>(p, lds));
    RUN_PHASE(5, gemm_in(p, 1, lds));
    RUN_PHASE(6, phase_stats(p, 1, lds));
    RUN_PHASE(7, phase_mixers(p, 1, lds));
    RUN_PHASE(8, gemm_out<1>(p, lds));
    RUN_PHASE(9, phase_final(p));
#undef RUN_PHASE
}

extern "C" void kernel_launch(void* const* d_in, const int* in_sizes, int n_in, void* d_out, int out_size, void* d_ws, size_t ws_size, hipStream_t stream) {
    static int grid_blocks = 0;
    if (!grid_blocks) {
        int dev = 0, cus = 0, per_cu = 0;
        hipGetDevice(&dev);
        hipDeviceGetAttribute(&cus, hipDeviceAttributeMultiprocessorCount, dev);
        hipFuncSetAttribute((const void*)hymba_fwd, hipFuncAttributeMaxDynamicSharedMemorySize, LDS_BYTES);
        hipOccupancyMaxActiveBlocksPerMultiprocessor(&per_cu, (const void*)hymba_fwd, NTHREADS, LDS_BYTES);
        if (per_cu < 1) per_cu = 1;
        grid_blocks = cus * per_cu;
        if (ws_size < WS_END) fprintf(stderr, "kernel_launch: workspace too small (%zu < %zu)\n", ws_size, (size_t)WS_END);
    }
    Params p{};
    p.x = (const float*)d_in[0]; p.norm_g = (const float*)d_in[1]; p.w_in = (const float*)d_in[2]; p.conv_w = (const float*)d_in[3]; p.conv_b = (const float*)d_in[4];
    p.ln_g = (const float*)d_in[5]; p.ln_b = (const float*)d_in[6]; p.pw_w = (const float*)d_in[7]; p.pw_b = (const float*)d_in[8]; p.w_out = (const float*)d_in[9];
    p.final_g = (const float*)d_in[10]; p.out = (float*)d_out; p.ws = (unsigned char*)d_ws;
    (void)hipMemsetAsync((char*)d_ws + WS_CTL, 0, 32768, stream);
#if ONE_LAUNCH
    p.ph_lo = 0; p.ph_hi = NPHASES;
    { void* args[] = {&p};
      hipError_t e = hipLaunchCooperativeKernel((const void*)hymba_fwd, dim3(grid_blocks), dim3(NTHREADS), args, LDS_BYTES, stream);
      if (e != hipSuccess) fprintf(stderr, "cooperative launch failed: %s (grid %d)\n", hipGetErrorString(e), grid_blocks); }
#else
    for (int ph = 0; ph < NPHASES; ++ph) {
        p.ph_lo = ph; p.ph_hi = ph + 1; void* args[] = {&p};
        hipError_t e = hipLaunchCooperativeKernel((const void*)hymba_fwd, dim3(grid_blocks), dim3(NTHREADS), args, LDS_BYTES, stream);
        if (e != hipSuccess) { fprintf(stderr, "cooperative launch failed: %s (grid %d, phase %d)\n", hipGetErrorString(e), grid_blocks, ph); break; }
    }
#endif
}
```

```cpp
#include <hip/hip_runtime.h>
#include <hip/hip_cooperative_groups.h>
#include <cstdio>
#include <cstdint>
namespace cg = cooperative_groups;

#ifndef ONE_LAUNCH
#define ONE_LAUNCH 1
#endif

typedef _Float16 h16;
typedef _Float16 h16x8 __attribute__((ext_vector_type(8)));
typedef _Float16 h16x4 __attribute__((ext_vector_type(4)));
typedef float f32x16 __attribute__((ext_vector_type(16)));
typedef float f32x4 __attribute__((ext_vector_type(4)));
typedef unsigned u32x4 __attribute__((ext_vector_type(4)));

constexpr int BATCH = 8, SEQ = 4096, DM = 1024, MROWS = BATCH * SEQ, NIN = 3840, DEPTH = 2;
constexpr int C_AVAL = 0, C_AGLU = 256, C_AGATE = 512, C_RQ = 768, C_RK = 1024, C_RV = 1280, C_RGATE = 1536, C_MQ = 1792, C_MK = 2304, C_MV = 2816, C_MGATE = 3328;
constexpr int NPART = 16;
constexpr int NTHREADS = 512;
constexpr int LDS_BYTES = 147456;
constexpr int NPHASES = 9;

constexpr size_t MiB = 1u << 20;
constexpr size_t WS_XH = 0, WS_PROJ = 64 * MiB, WS_MIX = 304 * MiB, WS_WIN = 368 * MiB, WS_WOUT = 383 * MiB, WS_WPW = 387 * MiB,
                 WS_KV = 388 * MiB, WS_KMEAN = 404 * MiB  , WS_ROWSS = 405 * MiB, WS_CTL = 408 * MiB  , WS_RST = 409 * MiB  , WS_END = 417 * MiB;
constexpr int BAR_LDS_OFF = LDS_BYTES - 64;

struct Params {
    const float *x, *norm_g, *w_in, *conv_w, *conv_b, *ln_g, *ln_b, *pw_w, *pw_b, *w_out, *final_g;
    float* out; unsigned char* ws;
    int ph_lo, ph_hi;
};

__device__ __forceinline__ float silu_f(float v) { return v * __builtin_amdgcn_rcpf(1.0f + __expf(-v)); }
__device__ __forceinline__ int crow(int r, int h) { return (r & 3) + 8 * (r >> 2) + 4 * h; }
__device__ __forceinline__ float wave_sum(float v) {
#pragma unroll
    for (int o = 1; o < 64; o <<= 1) v += __shfl_xor(v, o);
    return v;
}

__device__ __forceinline__ void transpose_unit(const float* W, int K, int N, h16* WT, const float* g, int k0, int n0, float* tile) {
    const int tid = threadIdx.x;
    __syncthreads();
#pragma unroll
    for (int i = 0; i < 8; ++i) { const int k = i * 8 + (tid >> 6), n = tid & 63; float v = W[(size_t)(k0 + k) * N + n0 + n]; if (g) v *= g[k0 + k]; tile[k * 65 + n] = v; }
    __syncthreads();
    { const int n = tid >> 3, kc = tid & 7; h16x8 w;
#pragma unroll
        for (int i = 0; i < 8; ++i) w[i] = (h16)tile[(kc * 8 + i) * 65 + n];
        *(h16x8*)(WT + (size_t)(n0 + n) * K + k0 + kc * 8) = w; }
}

__device__ __forceinline__ void phase_prologue(const Params& p, unsigned char* lds) {
    float* tile = (float*)lds;
    h16* win = (h16*)(p.ws + WS_WIN); h16* wout = (h16*)(p.ws + WS_WOUT); h16* wpw = (h16*)(p.ws + WS_WPW);
    constexpr int U_IN = 16 * 60, U_OUT = 16 * 16, U_PW = 4 * 4, U_L = U_IN + U_OUT + U_PW;
    for (int u = blockIdx.x; u < DEPTH * U_L; u += gridDim.x) {
        const int layer = u / U_L; int r = u % U_L;
        if (r < U_IN) { transpose_unit(p.w_in + (size_t)layer * DM * NIN, DM, NIN, win + (size_t)layer * NIN * DM, p.norm_g + layer * DM, (r / 60) * 64, (r % 60) * 64, tile); continue; }
        r -= U_IN;
        if (r < U_OUT) { transpose_unit(p.w_out + (size_t)layer * DM * DM, DM, DM, wout + (size_t)layer * DM * DM, nullptr, (r / 16) * 64, (r % 16) * 64, tile); continue; }
        r -= U_OUT;
        transpose_unit(p.pw_w + (size_t)layer * 256 * 256, 256, 256, wpw + (size_t)layer * 256 * 256, nullptr, (r / 4) * 64, (r % 4) * 64, tile);
    }
    h16* xh = (h16*)(p.ws + WS_XH); float* rowss = (float*)(p.ws + WS_ROWSS);
    const int lane = threadIdx.x & 63, wid = threadIdx.x >> 6;
    for (int row = blockIdx.x * 8 + wid; row < MROWS; row += gridDim.x * 8) {
        const f32x4* xr = (const f32x4*)(p.x + (size_t)row * DM) + lane;
        float ss = 0.f;
#pragma unroll
        for (int j = 0; j < 4; ++j) { const f32x4 v = xr[64 * j]; ss += v.x * v.x + v.y * v.y + v.z * v.z + v.w * v.w;
            h16x4 o; o.x = (h16)v.x; o.y = (h16)v.y; o.z = (h16)v.z; o.w = (h16)v.w; *((h16x4*)(xh + (size_t)row * DM) + lane + 64 * j) = o; }
        ss = wave_sum(ss);
        if (lane < NPART) rowss[(size_t)row * NPART + lane] = (lane == 0) ? ss : 0.f;
    }
}

typedef short s16x4 __attribute__((ext_vector_type(4)));
#define LAS __attribute__((address_space(3)))
__device__ __forceinline__ float xhalf_max(float v) { auto rr = __builtin_amdgcn_permlane32_swap(__float_as_uint(v), __float_as_uint(v), false, false); return fmaxf(__uint_as_float(rr[0]), __uint_as_float(rr[1])); }
__device__ __forceinline__ float xhalf_sum(float v) { auto rr = __builtin_amdgcn_permlane32_swap(__float_as_uint(v), __float_as_uint(v), false, false); return __uint_as_float(rr[0]) + __uint_as_float(rr[1]); }
__device__ __forceinline__ h16x8 tr_frag(const LAS unsigned char* a) {
    const s16x4 lo = __builtin_amdgcn_ds_read_tr16_b64_v4i16((LAS s16x4*)a), hi = __builtin_amdgcn_ds_read_tr16_b64_v4i16((LAS s16x4*)(a + 512));
    typedef short s16x8 __attribute__((ext_vector_type(8)));
    const s16x8 v = __builtin_shufflevector(lo, hi, 0, 1, 2, 3, 4, 5, 6, 7);
    return __builtin_bit_cast(h16x8, v);
}
#define CROW0(i) (((i) & 3) + 8 * ((i) >> 2))
__device__ __forceinline__ void glds16(const void* gsrc, unsigned lds_dst) { unsigned keep;
    asm volatile("s_mov_b32 %0, m0\n\ts_mov_b32 m0, %2\n\ts_nop 0\n\tglobal_load_lds_dwordx4 %1, off\n\ts_mov_b32 m0, %0" : "=&s"(keep) : "v"(gsrc), "s"(lds_dst) : "memory"); }

namespace pg8 {
#define PG8_LAS __attribute__((address_space(3)))
typedef _Float16 bf16_t;
typedef _Float16 bf16x8 __attribute__((ext_vector_type(8)));
typedef float f32x4 __attribute__((ext_vector_type(4)));
typedef unsigned u32x4 __attribute__((ext_vector_type(4)));
constexpr int BM = 256, BK = 64, HALF = 128, HTB = HALF * BK * 2  , STAGE_BYTES = 8 * HTB, NXCD = 8, WGM = 8;

__host__ __device__ __forceinline__ int lds_byte(int r, int c) { const int st = (r >> 4) * 2 + (c >> 5), rr = r & 15, cc = c & 31, ob = rr * 64 + cc * 2; return st * 1024 + (ob ^ (((ob >> 9) & 1) << 5)); }
__host__ __device__ __forceinline__ void stage_rc(int b, int& R, int& C) { const int st = b / 1024, sb = b % 1024, swz = sb ^ (((sb >> 9) & 1) << 5); R = (st >> 1) * 16 + swz / 64; C = (st & 1) * 32 + (swz % 64) / 2; }
__host__ __device__ __forceinline__ int perm32(int rho) { const int n = rho >> 4, i = rho & 15; return 8 * (i >> 2) + 4 * n + (i & 3); }

struct Unit { int pm, pn; };
struct Gemm { const bf16_t* A; const bf16_t* Bt; int M, N, K; };

struct StaticOrder {
    int nM, nN, nwg, G, c;
    __host__ __device__ void init(int M, int N, int G_, int c_) { nM = M / BM; nN = N / BM; nwg = nM * nN; G = G_; c = c_; }
    __host__ __device__ bool next(int i, Unit& u) const {
        const long L = (long)i * G + c; if (L >= nwg) return false;
        int wgid = (int)L; { const int q = nwg / NXCD, r = nwg % NXCD, xcd = wgid % NXCD, off = wgid / NXCD; wgid = (xcd < r ? xcd * (q + 1) : r * (q + 1) + (xcd - r) * q) + off; }
        const int nig = WGM * nN, gid = wgid / nig, fm = gid * WGM, gsz = (nM - fm) < WGM ? (nM - fm) : WGM;
        u.pm = fm + ((wgid % nig) % gsz); u.pn = (wgid % nig) / gsz; return true;
    }
    __device__ __forceinline__ void a_ready(const Unit&) const {}
    __device__ __forceinline__ void done(const Unit&) const {}
};

template <class Epi, class Sched, bool ALIGN_EPI = false, bool SP2 = false>
__device__ __forceinline__ void gemm_phase(PG8_LAS unsigned char* lds, const Gemm g, const Sched& S, const Epi& E) {
    const int tid = threadIdx.x, wid = __builtin_amdgcn_readfirstlane(tid >> 6), lane = tid & 63, wr = wid >> 2, wc = wid & 3, fr = lane & 15, fq = lane >> 4;
    const int K = g.K, nt = K / BK;
    unsigned voffA[2], voffB[2];
#pragma unroll
    for (int i = 0; i < 2; ++i) { int R, C; stage_rc(tid * 16 + i * 8192, R, C); const int Rb = Epi::PERM ? ((R & ~31) + perm32(R & 31)) : R;
        voffA[i] = (unsigned)(R * K + C) * 2u; voffB[i] = (unsigned)(Rb * K + C) * 2u; }
    const size_t kstep = (size_t)(BK * 2);
    const size_t hstep = (size_t)HALF * K * 2;
    const size_t tstep = 2 * hstep;
    const unsigned ldsw = (unsigned)wid * 1024u;
    const int aoff = lds_byte(wr * 64 + fr, fq * 8), boff = lds_byte(wc * 32 + fr, fq * 8);
#define PG8_SA(b, h) (((b) * 2 + (h)) * HTB)
#define PG8_SB(b, h) ((4 + (b) * 2 + (h)) * HTB)
#define PG8_STAGE(bufoff, gbase, voff) do { _Pragma("unroll") for (int _i = 0; _i < 2; ++_i) \
        __builtin_amdgcn_global_load_lds((const unsigned*)((const char*)(gbase) + (voff)[_i]), (PG8_LAS unsigned*)(lds + (bufoff) + ldsw + _i * 8192), 16, 0, 0); } while (0)
#define PG8_LDA(dst, b, h) do { _Pragma("unroll") for (int m = 0; m < 4; ++m) _Pragma("unroll") for (int k = 0; k < 2; ++k) dst[m][k] = *(const PG8_LAS bf16x8*)(lds + PG8_SA(b, h) + aoff + m * 2048 + k * 1024); } while (0)
#define PG8_LDB(dst, b, h) do { _Pragma("unroll") for (int n = 0; n < 2; ++n) _Pragma("unroll") for (int k = 0; k < 2; ++k) dst[n][k] = *(const PG8_LAS bf16x8*)(lds + PG8_SB(b, h) + boff + n * 2048 + k * 1024); } while (0)
#define PG8_MMA(ai, bj, At, Bt) do { __builtin_amdgcn_s_setprio(1); _Pragma("unroll") for (int m = 0; m < 4; ++m) _Pragma("unroll") for (int n = 0; n < 2; ++n) _Pragma("unroll") for (int k = 0; k < 2; ++k) \
        acc[ai][bj][m][n] = __builtin_amdgcn_mfma_f32_16x16x32_f16(Bt[n][k], At[m][k], acc[ai][bj][m][n], 0, 0, 0); __builtin_amdgcn_s_setprio(0); } while (0)
#define PG8_WAIT_V(n) asm volatile("s_waitcnt vmcnt(" #n ")" ::: "memory")
#define PG8_WAIT_L(n) asm volatile("s_waitcnt lgkmcnt(" #n ")" ::: "memory")
#define PG8_BAR __builtin_amdgcn_s_barrier()
#define PG8_SCHED __builtin_amdgcn_sched_barrier(0)
    Unit cur, nxt; int ui = 0;
    if (!S.next(0, cur)) return;
    f32x4 acc[2][2][4][2];
#pragma unroll
    for (int a = 0; a < 2; ++a)
#pragma unroll
        for (int b = 0; b < 2; ++b)
#pragma unroll
            for (int m = 0; m < 4; ++m)
#pragma unroll
                for (int n = 0; n < 2; ++n) acc[a][b][m][n] = (f32x4){0.f, 0.f, 0.f, 0.f};
    bf16x8 At[4][2], B0[2][2], B1[2][2];
    const char* cA = (const char*)g.A + (size_t)cur.pm * tstep; const char* cB = (const char*)g.Bt + (size_t)cur.pn * tstep;
    S.a_ready(cur);
    if constexpr (SP2) {
        PG8_STAGE(PG8_SB(0, 0), cB, voffB); PG8_STAGE(PG8_SB(0, 1), cB + hstep, voffB); PG8_STAGE(PG8_SA(0, 0), cA, voffA); PG8_STAGE(PG8_SA(0, 1), cA + hstep, voffA);
        if (wr == 1) PG8_BAR;
        PG8_WAIT_V(2); PG8_BAR;
        PG8_STAGE(PG8_SB(1, 0), cB + kstep, voffB); PG8_STAGE(PG8_SA(1, 0), cA + kstep, voffA); PG8_STAGE(PG8_SB(1, 1), cB + hstep + kstep, voffB);
        PG8_WAIT_V(6); PG8_BAR;
    } else {
        PG8_STAGE(PG8_SB(0, 0), cB, voffB); PG8_STAGE(PG8_SA(0, 0), cA, voffA); PG8_STAGE(PG8_SB(0, 1), cB + hstep, voffB); PG8_STAGE(PG8_SA(0, 1), cA + hstep, voffA);
        if (wr == 1) PG8_BAR;
        PG8_WAIT_V(4); PG8_BAR;
        PG8_STAGE(PG8_SB(1, 0), cB + kstep, voffB); PG8_STAGE(PG8_SA(1, 0), cA + kstep, voffA); PG8_STAGE(PG8_SB(1, 1), cB + hstep + kstep, voffB);
        PG8_WAIT_V(6); PG8_BAR;
    }
    for (;;) {
        const bool has_next = S.next(ui + 1, nxt);
        const char* nA = has_next ? (const char*)g.A + (size_t)nxt.pm * tstep : cA; const char* nB = has_next ? (const char*)g.Bt + (size_t)nxt.pn * tstep : cB;
        for (int t = 0; t < nt; t += 2) {
            const bool last = (t == nt - 2);
            const char* a1 = cA + (size_t)(t + 1) * kstep;
            const char* a2 = last ? nA : cA + (size_t)(t + 2) * kstep; const char* b2 = last ? nB : cB + (size_t)(t + 2) * kstep;
            const char* a3 = a2 + kstep; const char* b3 = b2 + kstep;
            if (last && has_next) S.a_ready(nxt);
            if constexpr (SP2) {
            PG8_LDB(B0, 0, 0); PG8_LDB(B1, 0, 1); PG8_SCHED; PG8_LDA(At, 0, 0); PG8_STAGE(PG8_SA(1, 1), a1 + hstep, voffA);
            PG8_WAIT_V(8); PG8_WAIT_L(0); PG8_BAR; PG8_MMA(0, 0, At, B0); PG8_MMA(0, 1, At, B1); PG8_BAR; PG8_SCHED;
            PG8_LDA(At, 0, 1); PG8_STAGE(PG8_SB(0, 0), b2, voffB); PG8_STAGE(PG8_SB(0, 1), b2 + hstep, voffB); PG8_STAGE(PG8_SA(0, 0), a2, voffA);
            PG8_WAIT_V(8); PG8_WAIT_L(0); PG8_BAR; PG8_MMA(1, 0, At, B0); PG8_MMA(1, 1, At, B1); PG8_BAR; PG8_SCHED;
            PG8_LDB(B0, 1, 0); PG8_LDB(B1, 1, 1); PG8_SCHED; PG8_LDA(At, 1, 0); PG8_STAGE(PG8_SA(0, 1), a2 + hstep, voffA);
            PG8_WAIT_V(8); PG8_WAIT_L(0); PG8_BAR; PG8_MMA(0, 0, At, B0); PG8_MMA(0, 1, At, B1); PG8_BAR; PG8_SCHED;
            PG8_LDA(At, 1, 1); PG8_STAGE(PG8_SB(1, 0), b3, voffB); PG8_STAGE(PG8_SB(1, 1), b3 + hstep, voffB); PG8_STAGE(PG8_SA(1, 0), a3, voffA);
            PG8_WAIT_V(8); PG8_WAIT_L(0); PG8_BAR; PG8_MMA(1, 0, At, B0); PG8_MMA(1, 1, At, B1); PG8_BAR; PG8_SCHED;
            } else {
            PG8_LDB(B0, 0, 0); PG8_SCHED; PG8_LDA(At, 0, 0); PG8_STAGE(PG8_SA(1, 1), a1 + hstep, voffA);
            PG8_WAIT_L(8); PG8_BAR; PG8_WAIT_L(0); PG8_MMA(0, 0, At, B0); PG8_BAR; PG8_SCHED;
            PG8_LDB(B1, 0, 1); PG8_STAGE(PG8_SB(0, 0), b2, voffB);
            PG8_BAR; PG8_WAIT_L(0); PG8_MMA(0, 1, At, B1); PG8_BAR;
            PG8_LDA(At, 0, 1); PG8_STAGE(PG8_SA(0, 0), a2, voffA);
            PG8_BAR; PG8_WAIT_L(0); PG8_MMA(1, 0, At, B0); PG8_BAR; PG8_SCHED;
            PG8_STAGE(PG8_SB(0, 1), b2 + hstep, voffB);
            PG8_WAIT_V(6); PG8_BAR; PG8_MMA(1, 1, At, B1); PG8_BAR;
            PG8_LDB(B0, 1, 0); PG8_SCHED; PG8_LDA(At, 1, 0); PG8_STAGE(PG8_SA(0, 1), a2 + hstep, voffA);
            PG8_WAIT_L(8); PG8_BAR; PG8_WAIT_L(0); PG8_MMA(0, 0, At, B0); PG8_BAR; PG8_SCHED;
            PG8_LDB(B1, 1, 1); PG8_STAGE(PG8_SB(1, 0), b3, voffB);
            PG8_BAR; PG8_WAIT_L(0); PG8_MMA(0, 1, At, B1); PG8_BAR;
            PG8_LDA(At, 1, 1); PG8_STAGE(PG8_SA(1, 0), a3, voffA);
            PG8_BAR; PG8_WAIT_L(0); PG8_MMA(1, 0, At, B0); PG8_BAR; PG8_SCHED;
            PG8_STAGE(PG8_SB(1, 1), b3 + hstep, voffB);
            PG8_WAIT_V(6); PG8_BAR; PG8_MMA(1, 1, At, B1); PG8_BAR;
            }
        }
        if constexpr (ALIGN_EPI) { if (wr == 0) PG8_BAR; }
        if constexpr (!Epi::AFTER_DRAIN) { E(acc, cur, wr, wc, fr, fq); S.done(cur); }
        if (!has_next) break;
#pragma unroll
        for (int a = 0; a < 2; ++a)
#pragma unroll
            for (int b = 0; b < 2; ++b)
#pragma unroll
                for (int m = 0; m < 4; ++m)
#pragma unroll
                    for (int n = 0; n < 2; ++n) acc[a][b][m][n] = (f32x4){0.f, 0.f, 0.f, 0.f};
        cur = nxt; cA = nA; cB = nB; ++ui;
        if constexpr (ALIGN_EPI) { if (wr == 1) PG8_BAR; }
    }
    PG8_WAIT_V(0);
    if constexpr (!ALIGN_EPI) { if (wr == 0) PG8_BAR; }
    PG8_BAR;
    if constexpr (Epi::AFTER_DRAIN) { E.fused(acc, cur, wr, wc, fr, fq, lds, wid, lane); S.done(cur); }
#undef PG8_SA
#undef PG8_SB
#undef PG8_STAGE
#undef PG8_LDA
#undef PG8_LDB
#undef PG8_MMA
#undef PG8_WAIT_V
#undef PG8_WAIT_L
#undef PG8_BAR
#undef PG8_SCHED
}

struct EpiProj {
    static constexpr bool PERM = true, AFTER_DRAIN = false;
    bf16_t* O; const float* rowss; float* kmpart;
    __device__ __forceinline__ void operator()(const f32x4 (&acc)[2][2][4][2], const Unit& u, int wr, int wc, int fr, int fq) const {
        const int row0 = u.pm * BM + wr * 64 + fr, col0 = u.pn * BM + wc * 32 + 8 * fq;
        const bool want_km = (u.pn == 9) || (u.pn == 10);
        f32x4 cs[2][2];
#pragma unroll
        for (int bj = 0; bj < 2; ++bj)
#pragma unroll
            for (int n = 0; n < 2; ++n) cs[bj][n] = (f32x4){0.f, 0.f, 0.f, 0.f};
#pragma unroll
        for (int ai = 0; ai < 2; ++ai)
#pragma unroll
            for (int m = 0; m < 4; ++m) { const size_t row = (size_t)(row0 + ai * HALF + m * 16);
                const f32x4* rs = (const f32x4*)(rowss + row * 16); const f32x4 s0 = rs[0], s1 = rs[1], s2 = rs[2], s3 = rs[3];
                const float tot = ((s0[0] + s0[1]) + (s0[2] + s0[3])) + ((s1[0] + s1[1]) + (s1[2] + s1[3])) + ((s2[0] + s2[1]) + (s2[2] + s2[3])) + ((s3[0] + s3[1]) + (s3[2] + s3[3]));
                const float rstd = rsqrtf(tot * (1.0f / 1024.0f) + 1e-6f);
                bf16_t* rowp = O + row * 3840 + col0;
#pragma unroll
                for (int bj = 0; bj < 2; ++bj) { const f32x4 v0 = acc[ai][bj][m][0] * rstd, v1 = acc[ai][bj][m][1] * rstd; bf16x8 w;
                    w[0] = (bf16_t)v0[0]; w[1] = (bf16_t)v0[1]; w[2] = (bf16_t)v0[2]; w[3] = (bf16_t)v0[3]; w[4] = (bf16_t)v1[0]; w[5] = (bf16_t)v1[1]; w[6] = (bf16_t)v1[2]; w[7] = (bf16_t)v1[3];
                    *(bf16x8*)(rowp + bj * HALF) = w; cs[bj][0] += v0; cs[bj][1] += v1; } }
        if (want_km) {
#pragma unroll
            for (int bj = 0; bj < 2; ++bj)
#pragma unroll
                for (int n = 0; n < 2; ++n)
#pragma unroll
                    for (int k = 0; k < 4; ++k) { float v = cs[bj][n][k]; v += __shfl_xor(v, 1); v += __shfl_xor(v, 2); v += __shfl_xor(v, 4); v += __shfl_xor(v, 8); cs[bj][n][k] = v * (1.0f / 256.0f); }
            if (fr == 0) {
#pragma unroll
                for (int bj = 0; bj < 2; ++bj)
#pragma unroll
                    for (int n = 0; n < 2; ++n) { const int cm = col0 + bj * HALF + 4 * n - 2304;
                        *(f32x4*)(kmpart + ((size_t)((wr * 8 + (u.pm >> 4)) * 8 + (cm >> 6)) * 16 + (u.pm & 15)) * 64 + (cm & 63)) = cs[bj][n]; }
            }
        }
    }
};
template <int LAYER> struct EpiRes {
    static constexpr bool PERM = true, AFTER_DRAIN = false;
    const float* x0; float* xout; bf16_t* xh; float* rowss; const float* fg; unsigned* cnt;
    __device__ __forceinline__ void operator()(f32x4 (&acc)[2][2][4][2], const Unit& u, int wr, int wc, int fr, int fq) const {
        const int row0 = u.pm * BM + wr * 64 + fr, col0 = u.pn * BM + wc * 32 + 8 * fq;
#pragma unroll
        for (int ai = 0; ai < 2; ++ai)
#pragma unroll
            for (int m = 0; m < 4; ++m) { const size_t row = (size_t)(row0 + ai * HALF + m * 16); float ss = 0.f;
#pragma unroll
                for (int bj = 0; bj < 2; ++bj) { const size_t off = row * 1024 + col0 + bj * HALF; f32x4 v0, v1;
                    if (LAYER == 0) { v0 = *(const f32x4*)(x0 + off) + acc[ai][bj][m][0]; v1 = *(const f32x4*)(x0 + off + 4) + acc[ai][bj][m][1];
                        bf16x8 w; w[0] = (bf16_t)v0[0]; w[1] = (bf16_t)v0[1]; w[2] = (bf16_t)v0[2]; w[3] = (bf16_t)v0[3]; w[4] = (bf16_t)v1[0]; w[5] = (bf16_t)v1[1]; w[6] = (bf16_t)v1[2]; w[7] = (bf16_t)v1[3];
                        *(bf16x8*)(xh + off) = w; }
                    else { const bf16x8 xp = *(const bf16x8*)(xh + off);
                        v0 = (f32x4){(float)xp[0], (float)xp[1], (float)xp[2], (float)xp[3]} + acc[ai][bj][m][0]; v1 = (f32x4){(float)xp[4], (float)xp[5], (float)xp[6], (float)xp[7]} + acc[ai][bj][m][1];
                        acc[ai][bj][m][0] = v0; acc[ai][bj][m][1] = v1; }
                    ss += ((v0[0] * v0[0] + v0[1] * v0[1]) + (v0[2] * v0[2] + v0[3] * v0[3])) + ((v1[0] * v1[0] + v1[1] * v1[1]) + (v1[2] * v1[2] + v1[3] * v1[3])); }
                ss += __shfl_xor(ss, 16); ss += __shfl_xor(ss, 32);
                if (fq == 0) { if (LAYER == 0) rowss[row * 16 + u.pn * 4 + wc] = ss;
                               else __hip_atomic_store(rowss + row * 16 + u.pn * 4 + wc, ss, __ATOMIC_RELAXED, __HIP_MEMORY_SCOPE_AGENT); } }
        if (LAYER == 1) {
            unsigned* c = cnt + (u.pm * 2 + wr) * 64;
            asm volatile("s_waitcnt vmcnt(0)" ::: "memory");
            if (__builtin_amdgcn_readfirstlane(threadIdx.x & 63) == (threadIdx.x & 63)) __hip_atomic_fetch_add(c, 1u, __ATOMIC_RELAXED, __HIP_MEMORY_SCOPE_AGENT);
            { unsigned sp = 0u; while ((unsigned)__builtin_amdgcn_readfirstlane(__hip_atomic_load(c, __ATOMIC_RELAXED, __HIP_MEMORY_SCOPE_AGENT)) < 16u) { __builtin_amdgcn_s_sleep(1); if (++sp > (1u << 22)) break; } }
            __builtin_amdgcn_fence(__ATOMIC_ACQUIRE, "agent");
            f32x4 gv[2][2];
#pragma unroll
            for (int bj = 0; bj < 2; ++bj) { gv[bj][0] = *(const f32x4*)(fg + col0 + bj * HALF); gv[bj][1] = *(const f32x4*)(fg + col0 + bj * HALF + 4); }
#pragma unroll
            for (int ai = 0; ai < 2; ++ai)
#pragma unroll
                for (int m = 0; m < 4; ++m) { const size_t row = (size_t)(row0 + ai * HALF + m * 16); float tot = 0.f;
#pragma unroll
                    for (int k = 0; k < 16; ++k) tot += __hip_atomic_load(rowss + row * 16 + k, __ATOMIC_RELAXED, __HIP_MEMORY_SCOPE_AGENT);
                    const float rstd = rsqrtf(tot * (1.0f / 1024.0f) + 1e-6f);
#pragma unroll
                    for (int bj = 0; bj < 2; ++bj) { const size_t off = row * 1024 + col0 + bj * HALF;
                        *(f32x4*)(xout + off) = acc[ai][bj][m][0] * rstd * gv[bj][0]; *(f32x4*)(xout + off + 4) = acc[ai][bj][m][1] * rstd * gv[bj][1]; } }
        }
    }
};
}


__device__ __forceinline__ void gemm_in(const Params& p, int layer, unsigned char* lds) {
    pg8::Gemm g{(const h16*)(p.ws + WS_XH), (const h16*)(p.ws + WS_WIN) + (size_t)layer * NIN * DM, MROWS, NIN, DM};
    pg8::StaticOrder S; S.init(MROWS, NIN, (int)gridDim.x, (int)blockIdx.x);
    pg8::EpiProj E{(h16*)(p.ws + WS_PROJ), (const float*)(p.ws + WS_ROWSS), (float*)(p.ws + WS_KMEAN)};
    pg8::gemm_phase<pg8::EpiProj, pg8::StaticOrder, true, true>((PG8_LAS unsigned char*)lds, g, S, E);
}
template <int LAYER> __device__ __forceinline__ void gemm_out(const Params& p, unsigned char* lds) {
    pg8::Gemm g{(const h16*)(p.ws + WS_MIX), (const h16*)(p.ws + WS_WOUT) + (size_t)LAYER * DM * DM, MROWS, DM, DM};
    pg8::StaticOrder S; S.init(MROWS, DM, (int)gridDim.x, (int)blockIdx.x);
    pg8::EpiRes<LAYER> E{p.x, p.out, (h16*)(p.ws + WS_XH), (float*)(p.ws + WS_ROWSS), p.final_g, (unsigned*)(p.ws + WS_CTL + 65536)};
    pg8::gemm_phase<pg8::EpiRes<LAYER>, pg8::StaticOrder, true, true>((PG8_LAS unsigned char*)lds, g, S, E);
}

__device__ __forceinline__ void phase_stats(const Params& p, int layer, unsigned char* lds_g) {
    LAS unsigned char* lds = (LAS unsigned char*)lds_g;
    const h16* proj = (const h16*)(p.ws + WS_PROJ); float* kv = (float*)(p.ws + WS_KV);
    const int tid = threadIdx.x, lane = tid & 63, wid = __builtin_amdgcn_readfirstlane(tid >> 6), r = lane & 31, hi = lane >> 5;
    const int lanepart = (4 * hi + ((lane & 15) >> 2)) * 64 + ((lane >> 4) & 1) * 32 + (lane & 3) * 8;
#pragma unroll 1
    for (int u = blockIdx.x; u < 512; u += gridDim.x) {
        const int b = u >> 6, hh = (u >> 4) & 3, np = u & 15;
        const float log_g = logf(1.0f - exp2f(-5.0f - (float)hh));
        __syncthreads();
#pragma unroll
        for (int it = 0; it < 4; ++it) {
            const int pc = tid + 512 * it, cn = pc >> 10, key = (pc >> 3) & 127, ch = pc & 7;
            const h16* src = proj + (size_t)(b * SEQ + (2 * np + cn) * 128 + key) * NIN + hh * 64 + ch * 8;
            h16x8 kk = *(const h16x8*)(src + C_RK); const h16x8 vv = *(const h16x8*)(src + C_RV);
            const float z = __expf(log_g * (float)(127 - key)) * 0.125f;
#pragma unroll
            for (int k = 0; k < 8; ++k) kk[k] = (h16)((float)kk[k] * z);
            const int off = cn * 32768 + (ch >> 2) * 8192 + (key >> 4) * 1024 + (key & 15) * 64 + (ch & 3) * 16;
            *(LAS h16x8*)(lds + off) = kk; *(LAS h16x8*)(lds + off + 16384) = vv;
        }
        __syncthreads();
        const int cn = wid >> 2, eb = (wid >> 1) & 1, dbk = wid & 1;
        const LAS unsigned char* kimg = lds + cn * 32768 + dbk * 8192 + lanepart; const LAS unsigned char* vimg = lds + cn * 32768 + 16384 + eb * 8192 + lanepart;
        f32x16 acc;
#pragma unroll
        for (int i = 0; i < 16; ++i) acc[i] = 0.f;
#pragma unroll
        for (int ks = 0; ks < 8; ++ks) acc = __builtin_amdgcn_mfma_f32_32x32x16_f16(tr_frag(vimg + ks * 1024), tr_frag(kimg + ks * 1024), acc, 0, 0, 0);
        float* dst = kv + ((size_t)((b * 4 + hh) * 32 + 2 * np + cn)) * 4096 + (32 * eb + 4 * hi) * 64 + 32 * dbk + r;
#pragma unroll
        for (int i = 0; i < 16; ++i) dst[CROW0(i) * 64] = acc[i];
    }
#pragma unroll 1
    for (int u = blockIdx.x; u < 1024; u += gridDim.x) {
        const int b = u >> 7, row = (u & 127) * 32 + (tid >> 4), part = tid & 15;
        const h16* src = proj + (size_t)(b * SEQ + row) * NIN + C_MK + part * 32;
        float ss = 0.f;
#pragma unroll
        for (int k = 0; k < 4; ++k) { const h16x8 kk = *(const h16x8*)(src + k * 8);
#pragma unroll
            for (int d = 0; d < 8; ++d) ss += (float)kk[d] * (float)kk[d]; }
        ss += __shfl_xor(ss, 1);
        ss = fmaxf(ss, __shfl_xor(ss, 16)); ss = fmaxf(ss, __shfl_xor(ss, 32));
        if ((lane & 0x31) == 0) atomicMax((unsigned*)(p.ws + WS_CTL + 20480) + layer * 64 + b * 8 + (part >> 1), __float_as_uint(ss));
    }
}

typedef _Float16 h16x2 __attribute__((ext_vector_type(2)));
typedef float f32x2 __attribute__((ext_vector_type(2)));
__device__ __forceinline__ void conv_unit(const Params& p, int layer, int b, int tt, unsigned char* lds_g) {
    LAS unsigned char* lds = (LAS unsigned char*)lds_g;
    const h16* projb = (const h16*)(p.ws + WS_PROJ) + (size_t)b * SEQ * NIN; h16* mix = (h16*)(p.ws + WS_MIX);
    const int tid = threadIdx.x, lane = tid & 63, wid = __builtin_amdgcn_readfirstlane(tid >> 6), r = lane & 31, hi = lane >> 5;
    const int cp = tid & 127, tg = __builtin_amdgcn_readfirstlane(tid >> 7), t0 = tt * 64, tb0 = t0 + 16 * tg - 30;
    constexpr int YS = 0, SIMG = 65536;
    float y0[16], y1[16];
    {
        float w0[31], w1[31]; const float* cw = p.conv_w + (size_t)layer * 31 * 256 + 2 * cp;
#pragma unroll
        for (int jj = 0; jj < 31; ++jj) { const f32x2 wv = *(const f32x2*)(cw + jj * 256); w0[jj] = wv[0]; w1[jj] = wv[1]; }
        const f32x2 cbv = *(const f32x2*)(p.conv_b + layer * 256 + 2 * cp);
#pragma unroll
        for (int tl = 0; tl < 16; ++tl) { y0[tl] = cbv[0]; y1[tl] = cbv[1]; }
#pragma unroll
        for (int rr = 0; rr < 46; ++rr) {
            const int t = tb0 + rr; float a0 = 0.f, a1 = 0.f;
            if (t >= 0) { const h16x2 av = *(const h16x2*)(projb + (size_t)t * NIN + C_AVAL + 2 * cp), gv = *(const h16x2*)(projb + (size_t)t * NIN + C_AGLU + 2 * cp);
                a0 = (float)av[0] * __builtin_amdgcn_rcpf(1.0f + __expf(-(float)gv[0])); a1 = (float)av[1] * __builtin_amdgcn_rcpf(1.0f + __expf(-(float)gv[1])); }
#pragma unroll
            for (int tl = 0; tl < 16; ++tl) { const int jj = rr - tl; if (jj >= 0 && jj < 31) { y0[tl] += w0[jj] * a0; y1[tl] += w1[jj] * a1; } }
        }
    }
    __syncthreads();
#pragma unroll
    for (int tl = 0; tl < 16; ++tl) *(LAS f32x2*)(lds + YS + ((16 * tg + tl) * 256 + 2 * cp) * 4) = (f32x2){y0[tl], y1[tl]};
    h16x8 wf[16];
    {
        const h16* wp = (const h16*)(p.ws + WS_WPW) + (size_t)layer * 65536 + (size_t)(32 * wid + r) * 256 + 8 * hi;
#pragma unroll
        for (int ks = 0; ks < 16; ++ks) wf[ks] = *(const h16x8*)(wp + 16 * ks);
    }
    __syncthreads();
    {
        const f32x4 lg = *(const f32x4*)(p.ln_g + layer * 256 + lane * 4), lb = *(const f32x4*)(p.ln_b + layer * 256 + lane * 4);
#pragma unroll 1
        for (int kb = 0; kb < 8; kb += 4) {
        f32x4 v[4]; float s1[4], s2[4];
#pragma unroll
        for (int k = 0; k < 4; ++k) { v[k] = *(const LAS f32x4*)(lds + YS + ((wid * 8 + kb + k) * 256 + lane * 4) * 4);
            s1[k] = (v[k][0] + v[k][1]) + (v[k][2] + v[k][3]); s2[k] = (v[k][0] * v[k][0] + v[k][1] * v[k][1]) + (v[k][2] * v[k][2] + v[k][3] * v[k][3]); }
#pragma unroll
        for (int o = 1; o < 64; o <<= 1)
#pragma unroll
            for (int k = 0; k < 4; ++k) { s1[k] += __shfl_xor(s1[k], o); s2[k] += __shfl_xor(s2[k], o); }
#pragma unroll
        for (int k = 0; k < 4; ++k) { const int t = wid * 8 + kb + k; const float mu = s1[k] * (1.0f / 256.0f); const float var = fmaxf(s2[k] * (1.0f / 256.0f) - mu * mu, 0.f); const float rs = rsqrtf(var + 1e-5f);
            h16x4 o; o[0] = (h16)silu_f((v[k][0] - mu) * rs * lg[0] + lb[0]); o[1] = (h16)silu_f((v[k][1] - mu) * rs * lg[1] + lb[1]); o[2] = (h16)silu_f((v[k][2] - mu) * rs * lg[2] + lb[2]); o[3] = (h16)silu_f((v[k][3] - mu) * rs * lg[3] + lb[3]);
            *(LAS h16x4*)(lds + SIMG + t * 512 + (((lane >> 1) ^ (t & 15)) << 4) + 8 * (lane & 1)) = o; }
        }
    }
    __syncthreads();
#pragma unroll
    for (int tb = 0; tb < 2; ++tb) {
        f32x16 acc;
#pragma unroll
        for (int i = 0; i < 16; ++i) acc[i] = 0.f;
#pragma unroll
        for (int ks = 0; ks < 16; ++ks) acc = __builtin_amdgcn_mfma_f32_32x32x16_f16(wf[ks], *(const LAS h16x8*)(lds + SIMG + (32 * tb + r) * 512 + (((2 * ks + hi) ^ (r & 15)) << 4)), acc, 0, 0, 0);
        const int t = t0 + 32 * tb + r, n0 = 32 * wid + 4 * hi;
        const h16* gp = projb + (size_t)t * NIN + C_AGATE + n0; h16* dst = mix + ((size_t)b * SEQ + t) * DM + n0; const float* pb = p.pw_b + layer * 256 + n0;
#pragma unroll
        for (int g = 0; g < 4; ++g) { const h16x4 ga = *(const h16x4*)(gp + 8 * g); const f32x4 bb = *(const f32x4*)(pb + 8 * g); h16x4 oa;
#pragma unroll
            for (int k = 0; k < 4; ++k) oa[k] = (h16)((acc[4 * g + k] + bb[k]) * silu_f((float)ga[k]));
            *(h16x4*)(dst + 8 * g) = oa; }
    }
}

__device__ __forceinline__ void ret_unit(const Params& p, int b, int hh, int n, unsigned char* lds_g) {
    LAS unsigned char* lds = (LAS unsigned char*)lds_g;
    const h16* projb = (const h16*)(p.ws + WS_PROJ) + (size_t)(b * SEQ + n * 128) * NIN; h16* mix = (h16*)(p.ws + WS_MIX); const float* kv = (const float*)(p.ws + WS_KV);
    const int tid = threadIdx.x, lane = tid & 63, wid = __builtin_amdgcn_readfirstlane(tid >> 6), r = lane & 31, hi = lane >> 5, g4 = wid & 3, eh = wid >> 2;
    const float log_g = logf(1.0f - exp2f(-5.0f - (float)hh));
    constexpr int KIMG = 0, VIMG = 16384, RIMG = 32768, XS = 40960;
    const h16x8 rr = *(const h16x8*)((const h16*)(p.ws + WS_RST) + ((size_t)((b * 4 + hh) * 32 + n)) * 4096 + tid * 8);
    __syncthreads();
    {
        const int e = tid >> 3, ch = tid & 7;
        *(LAS h16x8*)(lds + RIMG + e * 128 + ((ch ^ ((e >> 1) & 7)) << 4)) = rr;
#pragma unroll
        for (int it = 0; it < 2; ++it) {
            const int key = (tid >> 3) + 64 * it;
            h16x8 kk = *(const h16x8*)(projb + (size_t)key * NIN + C_RK + hh * 64 + ch * 8); const h16x8 vv = *(const h16x8*)(projb + (size_t)key * NIN + C_RV + hh * 64 + ch * 8);
            const float z = __expf(-log_g * (float)key) * 0.125f;
#pragma unroll
            for (int k = 0; k < 8; ++k) kk[k] = (h16)((float)kk[k] * z);
            *(LAS h16x8*)(lds + KIMG + key * 128 + ((ch ^ ((key >> 1) & 7)) << 4)) = kk;
            *(LAS h16x8*)(lds + VIMG + (ch >> 2) * 8192 + (key >> 4) * 1024 + (key & 15) * 64 + (ch & 3) * 16) = vv;
        }
    }
    const int qi = 32 * g4 + r;
    h16x8 qf[4];
    {
        const float zq = __expf(log_g * (float)qi);
#pragma unroll
        for (int s = 0; s < 4; ++s) { qf[s] = *(const h16x8*)(projb + (size_t)qi * NIN + C_RQ + hh * 64 + 16 * s + 8 * hi);
#pragma unroll
            for (int k = 0; k < 8; ++k) qf[s][k] = (h16)((float)qf[s][k] * zq); }
    }
    __syncthreads();
    const int rsw = (r >> 1) & 7;
    const int lanepart = (4 * hi + ((lane & 15) >> 2)) * 64 + ((lane >> 4) & 1) * 32 + (lane & 3) * 8;
    f32x16 o;
#pragma unroll
    for (int i = 0; i < 16; ++i) o[i] = 0.f;
#pragma unroll 1
    for (int jb = 0; jb <= g4; ++jb) {
        f32x16 c;
#pragma unroll
        for (int i = 0; i < 16; ++i) c[i] = 0.f;
#pragma unroll
        for (int s = 0; s < 4; ++s) c = __builtin_amdgcn_mfma_f32_32x32x16_f16(*(const LAS h16x8*)(lds + KIMG + (32 * jb + r) * 128 + (((2 * s + hi) ^ rsw) << 4)), qf[s], c, 0, 0, 0);
        if (jb == g4) {
#pragma unroll
            for (int i = 0; i < 16; ++i) if (CROW0(i) + 4 * hi > r) c[i] = 0.f;
        }
        h16x8 pf0, pf1;
#pragma unroll
        for (int k = 0; k < 8; ++k) { pf0[k] = (h16)c[k]; pf1[k] = (h16)c[8 + k]; }
        o = __builtin_amdgcn_mfma_f32_32x32x16_f16(tr_frag(lds + VIMG + eh * 8192 + (2 * jb) * 1024 + lanepart), pf0, o, 0, 0, 0);
        o = __builtin_amdgcn_mfma_f32_32x32x16_f16(tr_frag(lds + VIMG + eh * 8192 + (2 * jb + 1) * 1024 + lanepart), pf1, o, 0, 0, 0);
    }
#pragma unroll
    for (int s = 0; s < 4; ++s) o = __builtin_amdgcn_mfma_f32_32x32x16_f16(*(const LAS h16x8*)(lds + RIMG + (32 * eh + r) * 128 + (((2 * s + hi) ^ rsw) << 4)), qf[s], o, 0, 0, 0);
    float s1 = 0.f, s2 = 0.f;
#pragma unroll
    for (int i = 0; i < 16; ++i) { s1 += o[i]; s2 += o[i] * o[i]; }
    s1 = xhalf_sum(s1); s2 = xhalf_sum(s2);
    LAS float* xs = (LAS float*)(lds + XS);
    if (hi == 0) { xs[(wid * 32 + r) * 2] = s1; xs[(wid * 32 + r) * 2 + 1] = s2; }
    __syncthreads();
    {
        const float t1 = xs[((wid ^ 4) * 32 + r) * 2], t2 = xs[((wid ^ 4) * 32 + r) * 2 + 1];
        const float a1 = (eh == 0) ? (s1 + t1) : (t1 + s1), a2 = (eh == 0) ? (s2 + t2) : (t2 + s2);
        const float mu = a1 * (1.0f / 64.0f); const float var = fmaxf(a2 * (1.0f / 64.0f) - mu * mu, 0.f); const float rs = rsqrtf(var + 1e-5f);
        const int col = hh * 64 + 32 * eh + 4 * hi;
        const h16* gp = projb + (size_t)qi * NIN + C_RGATE + col; h16* dst = mix + ((size_t)(b * SEQ + n * 128 + qi)) * DM + 256 + col;
#pragma unroll
        for (int g = 0; g < 4; ++g) { const h16x4 ga = *(const h16x4*)(gp + 8 * g); h16x4 oa;
#pragma unroll
            for (int k = 0; k < 4; ++k) oa[k] = (h16)((o[4 * g + k] - mu) * rs * silu_f((float)ga[k]));
            *(h16x4*)(dst + 8 * g) = oa; }
    }
}

constexpr float MOBA_THR = 8.0f;
__device__ __forceinline__ void moba_unit(const Params& p, int layer, int b, int hh, int j, unsigned char* lds_g) {
    LAS unsigned char* lds = (LAS unsigned char*)lds_g;
    const int tid = threadIdx.x, lane = tid & 63, wid = __builtin_amdgcn_readfirstlane(tid >> 6), r = lane & 31, hi = lane >> 5;
    const h16* projb = (const h16*)(p.ws + WS_PROJ) + (size_t)b * SEQ * NIN; h16* mix = (h16*)(p.ws + WS_MIX);
    const int qrow = j * 256 + wid * 32 + r;
    h16x8 qf[4];
#pragma unroll
    for (int s = 0; s < 4; ++s) qf[s] = *(const h16x8*)(projb + (size_t)qrow * NIN + C_MQ + hh * 64 + 16 * s + 8 * hi);
    unsigned selmask = 0u;
    if (j <= 3) selmask = (1u << j) - 1u;
    else {
        const float* km = (const float*)(p.ws + WS_KMEAN) + ((size_t)(b * 8 + hh) * 16 + (r & 15)) * 64 + 8 * hi;
        f32x16 g;
#pragma unroll
        for (int i = 0; i < 16; ++i) g[i] = 0.f;
#pragma unroll
        for (int s = 0; s < 4; ++s) {
            f32x4 a0 = (f32x4){0.f, 0.f, 0.f, 0.f}, a1 = a0;
            if (r < j) { a0 = *(const f32x4*)(km + 16 * s) + *(const f32x4*)(km + 65536 + 16 * s); a1 = *(const f32x4*)(km + 16 * s + 4) + *(const f32x4*)(km + 65536 + 16 * s + 4); }
            h16x8 ah, al;
#pragma unroll
            for (int k = 0; k < 4; ++k) { const h16 h0 = (h16)a0[k], h1 = (h16)a1[k]; ah[k] = h0; ah[4 + k] = h1; al[k] = (h16)(a0[k] - (float)h0); al[4 + k] = (h16)(a1[k] - (float)h1); }
            g = __builtin_amdgcn_mfma_f32_32x32x16_f16(ah, qf[s], g, 0, 0, 0);
            g = __builtin_amdgcn_mfma_f32_32x32x16_f16(al, qf[s], g, 0, 0, 0);
        }
        float gate[16];
#pragma unroll
        for (int i = 0; i < 8; ++i) { auto rr = __builtin_amdgcn_permlane32_swap(__float_as_uint(g[i]), __float_as_uint(g[i]), false, false);
            gate[(i & 3) + 8 * (i >> 2)] = __uint_as_float(rr[0]); gate[(i & 3) + 8 * (i >> 2) + 4] = __uint_as_float(rr[1]); }
        float g0 = -3.0e38f, g1 = -3.0e38f, g2 = -3.0e38f; int i0 = 0, i1 = 0, i2 = 0;
#pragma unroll
        for (int n = 0; n < 15; ++n) { const float s = (n < j) ? gate[n] : -3.0e38f;
            if (s > g0) { g2 = g1; i2 = i1; g1 = g0; i1 = i0; g0 = s; i0 = n; }
            else if (s > g1) { g2 = g1; i2 = i1; g1 = s; i1 = n; }
            else if (s > g2) { g2 = s; i2 = n; } }
        selmask = (1u << i0) | (1u << i1) | (1u << i2);
    }
    constexpr float C2 = 0.125f * 1.4426950408889634f;
    float qn2 = 0.f;
#pragma unroll
    for (int s = 0; s < 4; ++s)
#pragma unroll
        for (int k = 0; k < 8; ++k) { qf[s][k] = (h16)((float)qf[s][k] * C2); qn2 += (float)qf[s][k] * (float)qf[s][k]; }
    const float qbound = sqrtf(xhalf_sum(qn2)) * sqrtf(__uint_as_float(__hip_atomic_load((const unsigned*)(p.ws + WS_CTL + 20480) + layer * 64 + b * 8 + hh, __ATOMIC_RELAXED, __HIP_MEMORY_SCOPE_AGENT))) * 1.001f;
    const float slope2 = exp2f(-(float)(hh + 1)) * 1.4426950408889634f;
    f32x16 o0, o1;
#pragma unroll
    for (int i = 0; i < 16; ++i) { o0[i] = 0.f; o1[i] = 0.f; }
    float mref = 0.f, lsum = 0.f; bool first = true;
    const unsigned lds0 = (unsigned)(__UINTPTR_TYPE__)lds;
    const int dkey = 8 * wid + (lane >> 3);
    const h16* ksrc = projb + (size_t)dkey * NIN + C_MK + hh * 64 + (((lane & 7) ^ ((dkey >> 1) & 7)) << 3);
    const h16* vsrc = projb + (size_t)(16 * (wid & 3) + (lane >> 2)) * NIN + C_MV + hh * 64 + (wid >> 2) * 32 + (lane & 3) * 8;
    const unsigned kdst = lds0 + wid * 1024, vdst = lds0 + 8192 + (wid >> 2) * 4096 + (wid & 3) * 1024;
#define MOBA_DMA(tile) do { const int kp_ = j * 256 + 192 - 64 * (tile); const unsigned so_ = (unsigned)(((tile) & 3) * 16384); \
        glds16(ksrc + (size_t)kp_ * NIN, (unsigned)__builtin_amdgcn_readfirstlane(kdst + so_)); glds16(vsrc + (size_t)kp_ * NIN, (unsigned)__builtin_amdgcn_readfirstlane(vdst + so_)); } while (0)
#define MOBA_WAIT_BAR(N) asm volatile("s_waitcnt vmcnt(" #N ") lgkmcnt(0)\n\ts_barrier" ::: "memory")
    const int rK = r * 128, rsw = (r >> 1) & 7;
    const int rV = 8192 + (4 * hi + ((lane & 15) >> 2)) * 64 + ((lane >> 4) & 1) * 32 + (lane & 3) * 8;
    const int nt = 4 * (j + 1);
    const int wdiag = wid >> 1;
#define MOBA_CIN(T, C0, C1) do { const int kp_ = j * 256 + 192 - 64 * (T); const int nb_ = kp_ >> 8, tl_ = (kp_ >> 6) & 3; const bool own_ = (nb_ == j); \
        const bool val_ = own_ ? true : (((selmask >> (nb_ & 31)) & 1u) != 0u); \
        const float tbh_ = val_ ? (slope2 * (float)(kp_ - qrow + 4 * hi) - mref) : -INFINITY; \
        _Pragma("unroll") for (int i = 0; i < 16; ++i) { C0[i] = fmaf(slope2, (float)CROW0(i), tbh_); C1[i] = fmaf(slope2, (float)(CROW0(i) + 32), tbh_); } \
        if (own_ && tl_ >= wdiag) { const int lim2_ = 32 * wid - 64 * tl_ + r - 4 * hi; \
            _Pragma("unroll") for (int i = 0; i < 16; ++i) { if (CROW0(i) > lim2_) C0[i] = -INFINITY; if (CROW0(i) + 32 > lim2_) C1[i] = -INFINITY; } } } while (0)
#define MOBA_QK(T, C0, C1) do { const LAS unsigned char* kb_ = lds + ((T) & 3) * 16384 + rK; \
        _Pragma("unroll") for (int s = 0; s < 4; ++s) { \
            const h16x8 k0_ = *(const LAS h16x8*)(kb_ + (((2 * s + hi) ^ rsw) << 4)), k1_ = *(const LAS h16x8*)(kb_ + 4096 + (((2 * s + hi) ^ rsw) << 4)); \
            C0 = __builtin_amdgcn_mfma_f32_32x32x16_f16(k0_, qf[s], C0, 0, 0, 0); C1 = __builtin_amdgcn_mfma_f32_32x32x16_f16(k1_, qf[s], C1, 0, 0, 0); } } while (0)
#define MOBA_DECIDE(T, C0, C1) do { float m_ = __builtin_fmaxf(C0[0], C1[0]); \
        _Pragma("unroll") for (int i = 1; i < 16; ++i) m_ = __builtin_fmaxf(__builtin_fmaxf(m_, C0[i]), C1[i]); \
        m_ = xhalf_max(m_); \
        const int kp_ = j * 256 + 192 - 64 * (T); const bool fst_ = ((kp_ >> 8) == j) && (((kp_ >> 6) & 3) == wdiag); \
        if (fst_ || __any(m_ > MOBA_THR)) { const float dl_ = fst_ ? m_ : __builtin_fmaxf(m_, 0.f); const float f_ = fst_ ? 1.0f : __builtin_amdgcn_exp2f(-dl_); mref += dl_; lsum *= f_; \
            _Pragma("unroll") for (int i = 0; i < 16; ++i) { C0[i] -= dl_; C1[i] -= dl_; o0[i] *= f_; o1[i] *= f_; } } } while (0)
#define MOBA_STEP(T, TE, P0, P1, N0, N1) do { \
        if ((T) + 3 < (TE)) MOBA_DMA((T) + 3); \
        MOBA_CIN((T) + 1, N0, N1); MOBA_QK((T) + 1, N0, N1); \
        float ps_ = 0.f; \
        _Pragma("unroll") for (int i = 0; i < 16; ++i) { P0[i] = __builtin_amdgcn_exp2f(P0[i]); P1[i] = __builtin_amdgcn_exp2f(P1[i]); ps_ += P0[i] + P1[i]; } \
        lsum += ps_; \
        h16x8 pf_[4]; \
        _Pragma("unroll") for (int k = 0; k < 8; ++k) { pf_[0][k] = (h16)P0[k]; pf_[1][k] = (h16)P0[8 + k]; pf_[2][k] = (h16)P1[k]; pf_[3][k] = (h16)P1[8 + k]; } \
        { const LAS unsigned char* vb_ = lds + ((T) & 3) * 16384 + rV; \
          _Pragma("unroll") for (int t = 0; t < 4; ++t) { const h16x8 v0_ = tr_frag(vb_ + t * 1024), v1_ = tr_frag(vb_ + 4096 + t * 1024); \
            o0 = __builtin_amdgcn_mfma_f32_32x32x16_f16(v0_, pf_[t], o0, 0, 0, 0); o1 = __builtin_amdgcn_mfma_f32_32x32x16_f16(v1_, pf_[t], o1, 0, 0, 0); } } \
        if ((T) + 1 < (TE)) MOBA_DECIDE((T) + 1, N0, N1); \
        if ((T) + 3 < (TE)) MOBA_WAIT_BAR(2); else MOBA_WAIT_BAR(0); } while (0)
    f32x16 cA0, cA1, cB0, cB1;
    int te = nt;
    MOBA_WAIT_BAR(0);
    MOBA_DMA(0); MOBA_DMA(1); MOBA_DMA(2);
    MOBA_WAIT_BAR(2);
    MOBA_CIN(0, cA0, cA1); MOBA_QK(0, cA0, cA1); MOBA_DECIDE(0, cA0, cA1);
    MOBA_STEP(0, te, cA0, cA1, cB0, cB1); MOBA_STEP(1, te, cB0, cB1, cA0, cA1); MOBA_STEP(2, te, cA0, cA1, cB0, cB1);
    if (j > 0) {
        float marg = qbound - mref;
#pragma unroll
        for (int o = 1; o < 64; o <<= 1) marg = fmaxf(marg, __shfl_xor(marg, o));
        LAS float* xs = (LAS float*)(lds + 65536);
        if (lane == 0) xs[wid] = marg;
        MOBA_WAIT_BAR(2);
        float M = xs[0];
#pragma unroll
        for (int k = 1; k < 8; ++k) M = fmaxf(M, xs[k]);
        const float num = M + 50.0f - slope2;
        int cnt = (num >= 0.f) ? ((int)(num / (64.0f * slope2)) + 1) : 0;
        cnt = max(min(cnt, 4 * j), 2); cnt = (cnt + 1) & ~1;
        te = 4 + __builtin_amdgcn_readfirstlane(cnt);
    }
    MOBA_STEP(3, te, cB0, cB1, cA0, cA1);
#pragma unroll 1
    for (int tt = 4; tt < te; tt += 2) { MOBA_STEP(tt, te, cA0, cA1, cB0, cB1); MOBA_STEP(tt + 1, te, cB0, cB1, cA0, cA1); }
    MOBA_WAIT_BAR(0);
#undef MOBA_RUN
#undef MOBA_CIN
#undef MOBA_QK
#undef MOBA_DECIDE
#undef MOBA_STEP
#undef MOBA_DMA
#undef MOBA_WAIT_BAR
    {
        const float inv = 1.0f / xhalf_sum(lsum);
        const h16* gp = projb + (size_t)qrow * NIN + C_MGATE + hh * 64 + 4 * hi; h16* dst = mix + ((size_t)b * SEQ + qrow) * DM + 512 + hh * 64 + 4 * hi;
#pragma unroll
        for (int g = 0; g < 4; ++g) {
            const h16x4 ga = *(const h16x4*)(gp + 8 * g), gb = *(const h16x4*)(gp + 32 + 8 * g); h16x4 oa, ob;
#pragma unroll
            for (int k = 0; k < 4; ++k) { oa[k] = (h16)(o0[4 * g + k] * inv * silu_f((float)ga[k])); ob[k] = (h16)(o1[4 * g + k] * inv * silu_f((float)gb[k])); }
            *(h16x4*)(dst + 8 * g) = oa; *(h16x4*)(dst + 32 + 8 * g) = ob;
        }
    }
}

__device__ __forceinline__ void ret_scan_shares(const Params& p, int layer) {
    const float* kv = (const float*)(p.ws + WS_KV); h16* rst = (h16*)(p.ws + WS_RST);
    const int tid = threadIdx.x; unsigned done = 0u;
#pragma unroll 1
    for (int s = blockIdx.x; s < 256; s += gridDim.x) {
        const int bh = s >> 3, e = (s & 7) * 512 + tid, hh = bh & 3;
        const float gam = 1.0f - exp2f(-5.0f - (float)hh); const float g = expf(logf(gam) * 128.0f);
        const float* kvb = kv + (size_t)bh * 32 * 4096 + e; h16* rb = rst + (size_t)bh * 32 * 4096 + e;
        float r = 0.f; rb[0] = (h16)0.f;
#pragma unroll 1
        for (int m0 = 0; m0 < 31; m0 += 8) {
            float kvv[8];
#pragma unroll
            for (int k = 0; k < 8; ++k) kvv[k] = (m0 + k < 31) ? kvb[(size_t)(m0 + k) * 4096] : 0.f;
#pragma unroll
            for (int k = 0; k < 8; ++k) if (m0 + k < 31) { r = r * g + kvv[k]; rb[(size_t)(m0 + k + 1) * 4096] = (h16)(r * gam); }
        }
        ++done;
    }
    asm volatile("s_waitcnt vmcnt(0)" ::: "memory");
    __syncthreads();
    if (tid == 0) { __builtin_amdgcn_fence(__ATOMIC_RELEASE, "agent"); asm volatile("s_waitcnt vmcnt(0)" ::: "memory");
        __hip_atomic_fetch_add((unsigned*)(p.ws + WS_CTL + 16384) + 64 * layer, done, __ATOMIC_RELAXED, __HIP_MEMORY_SCOPE_AGENT); }
}
__device__ __forceinline__ void ret_scan_wait(const Params& p, int layer) {
    if (threadIdx.x == 0) {
        unsigned* c = (unsigned*)(p.ws + WS_CTL + 16384) + 64 * layer; unsigned sp = 0u;
        while (__hip_atomic_load(c, __ATOMIC_RELAXED, __HIP_MEMORY_SCOPE_AGENT) < 256u) { __builtin_amdgcn_s_sleep(2); if (++sp > (1u << 22)) break; }
        __builtin_amdgcn_fence(__ATOMIC_ACQUIRE, "agent"); asm volatile("s_waitcnt vmcnt(0)" ::: "memory");
    }
    __syncthreads();
}

__device__ __forceinline__ int queue_pop(unsigned* counter, LAS unsigned* slot) {
    __syncthreads();
    if (threadIdx.x == 0) slot[0] = __hip_atomic_fetch_add(counter, 1u, __ATOMIC_RELAXED, __HIP_MEMORY_SCOPE_AGENT);
    __syncthreads();
    return (int)slot[0];
}
__device__ __forceinline__ void phase_mixers(const Params& p, int layer, unsigned char* lds) {
    static constexpr unsigned char MOBA_ORDER[128] = {111,127,110,126,109,125,93,94,95,92,108,124,91,107,123,90,106,122,89,105,121,88,104,120,87,103,119,71,72,73,74,75,76,77,78,79,70,86,102,118,69,85,101,117,68,84,100,116,52,53,54,55,56,57,58,59,60,61,62,63,51,67,83,99,115,50,66,82,98,114,34,35,36,37,38,39,40,41,42,43,44,45,46,47,17,18,19,20,21,22,23,24,25,26,27,28,29,30,31,33,49,65,81,97,113,1,2,3,4,5,6,7,8,9,10,11,12,13,14,15,0,16,32,48,64,80,96,112};
    unsigned* qc = (unsigned*)(p.ws + WS_CTL + 24576) + layer * 256;
    LAS unsigned* slot = (LAS unsigned*)((LAS unsigned char*)lds + BAR_LDS_OFF + 16);
    ret_scan_shares(p, layer);
#define QUEUE_LOOP(CNT, N, BODY) do { int cur = queue_pop(CNT, slot); \
        _Pragma("unroll 1") while (cur < (N)) { unsigned nxt_ = 0u; if (threadIdx.x == 0) nxt_ = __hip_atomic_fetch_add(CNT, 1u, __ATOMIC_RELAXED, __HIP_MEMORY_SCOPE_AGENT); \
            { BODY; } \
            __syncthreads(); if (threadIdx.x == 0) slot[0] = nxt_; __syncthreads(); cur = (int)slot[0]; } } while (0)
    QUEUE_LOOP(qc, 1024, const int hj = MOBA_ORDER[cur >> 3]; moba_unit(p, layer, cur & 7, hj >> 4, hj & 15, lds));
    ret_scan_wait(p, layer);
    QUEUE_LOOP(qc + 64, 1024, ret_unit(p, cur >> 7, (cur >> 5) & 3, cur & 31, lds));
    QUEUE_LOOP(qc + 128, 512, conv_unit(p, layer, cur >> 6, cur & 63, lds));
#undef QUEUE_LOOP
}

__device__ __forceinline__ void phase_final(const Params& p) {
    const float* rowss = (const float*)(p.ws + WS_ROWSS);
    const int lane = threadIdx.x & 63, wid = threadIdx.x >> 6;
    f32x4 g[4];
#pragma unroll
    for (int j = 0; j < 4; ++j) g[j] = *((const f32x4*)p.final_g + lane + 64 * j);
    for (int row = blockIdx.x * 8 + wid; row < MROWS; row += gridDim.x * 8) {
        const f32x4* rs = (const f32x4*)(rowss + (size_t)row * NPART); const f32x4 s0 = rs[0], s1 = rs[1], s2 = rs[2], s3 = rs[3];
        const float tot = ((s0[0] + s0[1]) + (s0[2] + s0[3])) + ((s1[0] + s1[1]) + (s1[2] + s1[3])) + ((s2[0] + s2[1]) + (s2[2] + s2[3])) + ((s3[0] + s3[1]) + (s3[2] + s3[3]));
        const float rstd = rsqrtf(tot * (1.0f / DM) + 1e-6f);
        f32x4* xr = (f32x4*)(p.out + (size_t)row * DM) + lane;
#pragma unroll
        for (int j = 0; j < 4; ++j) { f32x4 v = xr[64 * j]; v = v * rstd * g[j]; xr[64 * j] = v; }
    }
}

#define XB_TMO      128
#define XB_XCNT(j)  (256  + 64 * (j))
#define XB_XSUB(j)  (1280 + 64 * (j))
#define XB_XGEN(j)  (2304 + 64 * (j))
#define XB_TOP      3328
#define XB_TOPGEN   3392
#define XCD_BAR_WORDS 3456
#define XB_SPIN_CAP (1u << 18)

__device__ __forceinline__ unsigned xb_ld(unsigned* p)              { return __hip_atomic_load(p, __ATOMIC_RELAXED, __HIP_MEMORY_SCOPE_AGENT); }
__device__ __forceinline__ unsigned xb_add(unsigned* p, unsigned v) { return __hip_atomic_fetch_add(p, v, __ATOMIC_RELAXED, __HIP_MEMORY_SCOPE_AGENT); }
__device__ __forceinline__ unsigned xb_xcc_id() { return (unsigned)__builtin_amdgcn_s_getreg((3 << 11) | 20) & 0xFu; }
#define XB_SPIN(cond, bar) do { unsigned _sp = 0; while (cond) { __builtin_amdgcn_s_sleep(1); \
    if ((++_sp & 255u) == 0u) { if (xb_ld(&(bar)[XB_TMO])) break; if (_sp > XB_SPIN_CAP) { atomicAdd(&(bar)[XB_TMO], 1u); break; } } } } while (0)

struct XcdBarrier {
    unsigned* bar; unsigned x;
    volatile LAS unsigned* st;
};

__device__ __forceinline__ XcdBarrier xcd_barrier_post(unsigned* bar, volatile LAS unsigned* st) {
    XcdBarrier b; b.bar = bar; b.x = xb_xcc_id(); b.st = st;
    if (threadIdx.x == 0) (void)xb_add(&bar[XB_XCNT(b.x)], 1u);
    return b;
}
__device__ __forceinline__ void xcd_barrier_complete(unsigned* bar, unsigned x, unsigned& nloc, unsigned& nx) {
    const unsigned G = gridDim.x * gridDim.y * gridDim.z;
    unsigned sum, cnt, mine, sp = 0u;
    for (;;) {
        sum = 0u; cnt = 0u; mine = 0u;
#pragma unroll
        for (unsigned j = 0; j < 16; ++j) { const unsigned c = xb_ld(&bar[XB_XCNT(j)]); sum += c; cnt += (c > 0u) ? 1u : 0u; mine = (j == x) ? c : mine; }
        if (sum == G) break;
        __builtin_amdgcn_s_sleep(1);
        if ((++sp & 255u) == 0u) { if (xb_ld(&bar[XB_TMO])) break; if (sp > XB_SPIN_CAP) { atomicAdd(&bar[XB_TMO], 1u); break; } }
    }
    nloc = mine > 0u ? mine : 1u; nx = cnt > 0u ? cnt : 1u;
}

__device__ __forceinline__ void xcd_barrier(const XcdBarrier& b) {
    asm volatile("s_waitcnt vmcnt(0)" ::: "memory");
    __syncthreads();
    if (threadIdx.x == 0) {
        unsigned* bar = b.bar;
        __builtin_amdgcn_s_waitcnt(0);
        unsigned nloc = b.st[0], nx = b.st[1];
        if (nloc == 0u) { xcd_barrier_complete(bar, b.x, nloc, nx); b.st[0] = nloc; b.st[1] = nx; }
        const unsigned old = xb_add(&bar[XB_XSUB(b.x)], 1u);
        const unsigned gen = old / nloc;
        if (old + 1u == (gen + 1u) * nloc) {
            __builtin_amdgcn_fence(__ATOMIC_RELEASE, "agent");
            asm volatile("s_waitcnt vmcnt(0)" ::: "memory");
            const unsigned og = xb_add(&bar[XB_TOP], 1u);
            const unsigned tg = og / nx;
            if (og + 1u == (tg + 1u) * nx) xb_add(&bar[XB_TOPGEN], 1u);
            else XB_SPIN(xb_ld(&bar[XB_TOPGEN]) == tg, bar);
            __builtin_amdgcn_fence(__ATOMIC_ACQUIRE, "agent");
            xb_add(&bar[XB_XGEN(b.x)], 1u);
            asm volatile("s_waitcnt vmcnt(0)" ::: "memory");
        } else {
            XB_SPIN(xb_ld(&bar[XB_XGEN(b.x)]) == gen, bar);
            __builtin_amdgcn_fence(__ATOMIC_ACQUIRE, "agent");
            asm volatile("s_waitcnt vmcnt(0)" ::: "memory");
        }
    }
    __syncthreads();
}


__global__ void __launch_bounds__(NTHREADS) hymba_fwd(Params p) {
    extern __shared__ __attribute__((aligned(16))) unsigned char lds[];
    cg::grid_group grid = cg::this_grid();
    volatile LAS unsigned* bst = (volatile LAS unsigned*)((LAS unsigned char*)lds + BAR_LDS_OFF);
    if (threadIdx.x < 2) bst[threadIdx.x] = 0u;
    __syncthreads();
    XcdBarrier xbar = xcd_barrier_post((unsigned*)(p.ws + WS_CTL), bst);
#define RUN_PHASE(k, body) do { if (p.ph_lo <= (k) && (k) < p.ph_hi) { body; if ((k) + 1 < p.ph_hi) { if ((k) == 0) grid.sync(); else xcd_barrier(xbar); } } } while (0)
    RUN_PHASE(0, phase_prologue(p, lds));
    RUN_PHASE(1, gemm_in(p, 0, lds));
    RUN_PHASE(2, phase_stats(p, 0, lds));
    RUN_PHASE(3, phase_mixers(p, 0, lds));
    RUN_PHASE(4, gemm_out<0>(p, lds));
    RUN_PHASE(5, gemm_in(p, 1, lds));
    RUN_PHASE(6, phase_stats(p, 1, lds));
    RUN_PHASE(7, phase_mixers(p, 1, lds));
    RUN_PHASE(8, gemm_out<1>(p, lds));
#undef RUN_PHASE
}

extern "C" void kernel_launch(void* const* d_in, const int* in_sizes, int n_in, void* d_out, int out_size, void* d_ws, size_t ws_size, hipStream_t stream) {
    static int grid_blocks = 0;
    if (!grid_blocks) {
        int dev = 0, cus = 0, per_cu = 0;
        hipGetDevice(&dev);
        hipDeviceGetAttribute(&cus, hipDeviceAttributeMultiprocessorCount, dev);
        hipFuncSetAttribute((const void*)hymba_fwd, hipFuncAttributeMaxDynamicSharedMemorySize, LDS_BYTES);
        hipOccupancyMaxActiveBlocksPerMultiprocessor(&per_cu, (const void*)hymba_fwd, NTHREADS, LDS_BYTES);
        if (per_cu < 1) per_cu = 1;
        grid_blocks = cus * per_cu;
        if (ws_size < WS_END) fprintf(stderr, "kernel_launch: workspace too small (%zu < %zu)\n", ws_size, (size_t)WS_END);
    }
    Params p{};
    p.x = (const float*)d_in[0]; p.norm_g = (const float*)d_in[1]; p.w_in = (const float*)d_in[2]; p.conv_w = (const float*)d_in[3]; p.conv_b = (const float*)d_in[4];
    p.ln_g = (const float*)d_in[5]; p.ln_b = (const float*)d_in[6]; p.pw_w = (const float*)d_in[7]; p.pw_b = (const float*)d_in[8]; p.w_out = (const float*)d_in[9];
    p.final_g = (const float*)d_in[10]; p.out = (float*)d_out; p.ws = (unsigned char*)d_ws;
    (void)hipMemsetAsync((char*)d_ws + WS_CTL, 0, 131072, stream);
#if ONE_LAUNCH
    p.ph_lo = 0; p.ph_hi = NPHASES;
    { void* args[] = {&p};
      hipError_t e = hipLaunchCooperativeKernel((const void*)hymba_fwd, dim3(grid_blocks), dim3(NTHREADS), args, LDS_BYTES, stream);
      if (e != hipSuccess) fprintf(stderr, "cooperative launch failed: %s (grid %d)\n", hipGetErrorString(e), grid_blocks); }
#else
    for (int ph = 0; ph < NPHASES; ++ph) {
        p.ph_lo = ph; p.ph_hi = ph + 1; void* args[] = {&p};
        hipError_t e = hipLaunchCooperativeKernel((const void*)hymba_fwd, dim3(grid_blocks), dim3(NTHREADS), args, LDS_BYTES, stream);
        if (e != hipSuccess) { fprintf(stderr, "cooperative launch failed: %s (grid %d, phase %d)\n", hipGetErrorString(e), grid_blocks, ph); break; }
    }
#endif
}
```

```cpp
#include <hip/hip_runtime.h>
#include <hip/hip_cooperative_groups.h>
#include <cstdio>
#include <cstdint>
namespace cg = cooperative_groups;

#ifndef ONE_LAUNCH
#define ONE_LAUNCH 1
#endif

typedef _Float16 h16;
typedef _Float16 h16x8 __attribute__((ext_vector_type(8)));
typedef _Float16 h16x4 __attribute__((ext_vector_type(4)));
typedef float f32x16 __attribute__((ext_vector_type(16)));
typedef float f32x4 __attribute__((ext_vector_type(4)));
typedef unsigned u32x4 __attribute__((ext_vector_type(4)));

constexpr int BATCH = 8, SEQ = 4096, DM = 1024, MROWS = BATCH * SEQ, NIN = 3840, DEPTH = 2;
constexpr int C_AVAL = 0, C_AGLU = 256, C_AGATE = 512, C_RQ = 768, C_RK = 1024, C_RV = 1280, C_RGATE = 1536, C_MQ = 1792, C_MK = 2304, C_MV = 2816, C_MGATE = 3328;
constexpr int NPART = 16;
constexpr int NTHREADS = 512;
constexpr int LDS_BYTES = 147456;
constexpr int NPHASES = 10;

constexpr size_t MiB = 1u << 20;
constexpr size_t WS_XH = 0, WS_PROJ = 64 * MiB, WS_MIX = 304 * MiB, WS_WIN = 368 * MiB, WS_WOUT = 383 * MiB, WS_WPW = 387 * MiB,
                 WS_KV = 388 * MiB, WS_KMEAN = 404 * MiB  , WS_ROWSS = 405 * MiB, WS_CTL = 408 * MiB  , WS_RST = 409 * MiB  , WS_END = 417 * MiB;
constexpr int BAR_LDS_OFF = LDS_BYTES - 64;

struct Params {
    const float *x, *norm_g, *w_in, *conv_w, *conv_b, *ln_g, *ln_b, *pw_w, *pw_b, *w_out, *final_g;
    float* out; unsigned char* ws;
    int ph_lo, ph_hi;
};

__device__ __forceinline__ float silu_f(float v) { return v * __builtin_amdgcn_rcpf(1.0f + __expf(-v)); }
__device__ __forceinline__ int crow(int r, int h) { return (r & 3) + 8 * (r >> 2) + 4 * h; }
__device__ __forceinline__ float wave_sum(float v) {
#pragma unroll
    for (int o = 1; o < 64; o <<= 1) v += __shfl_xor(v, o);
    return v;
}

__device__ __forceinline__ void transpose_unit(const float* W, int K, int N, h16* WT, const float* g, int k0, int n0, float* tile) {
    const int tid = threadIdx.x;
    __syncthreads();
#pragma unroll
    for (int i = 0; i < 8; ++i) { const int k = i * 8 + (tid >> 6), n = tid & 63; float v = W[(size_t)(k0 + k) * N + n0 + n]; if (g) v *= g[k0 + k]; tile[k * 65 + n] = v; }
    __syncthreads();
    { const int n = tid >> 3, kc = tid & 7; h16x8 w;
#pragma unroll
        for (int i = 0; i < 8; ++i) w[i] = (h16)tile[(kc * 8 + i) * 65 + n];
        *(h16x8*)(WT + (size_t)(n0 + n) * K + k0 + kc * 8) = w; }
}

__device__ __forceinline__ void phase_prologue(const Params& p, unsigned char* lds) {
    float* tile = (float*)lds;
    h16* win = (h16*)(p.ws + WS_WIN);
    constexpr int U_IN = 16 * 60;
    for (int r = blockIdx.x; r < U_IN; r += gridDim.x)
        transpose_unit(p.w_in, DM, NIN, win, p.norm_g, (r / 60) * 64, (r % 60) * 64, tile);
    h16* xh = (h16*)(p.ws + WS_XH); float* rowss = (float*)(p.ws + WS_ROWSS);
    const int lane = threadIdx.x & 63, wid = threadIdx.x >> 6;
    for (int row = blockIdx.x * 8 + wid; row < MROWS; row += gridDim.x * 8) {
        const f32x4* xr = (const f32x4*)(p.x + (size_t)row * DM) + lane;
        float ss = 0.f;
#pragma unroll
        for (int j = 0; j < 4; ++j) { const f32x4 v = xr[64 * j]; ss += v.x * v.x + v.y * v.y + v.z * v.z + v.w * v.w;
            h16x4 o; o.x = (h16)v.x; o.y = (h16)v.y; o.z = (h16)v.z; o.w = (h16)v.w; *((h16x4*)(xh + (size_t)row * DM) + lane + 64 * j) = o; }
        ss = wave_sum(ss);
        if (lane < NPART) rowss[(size_t)row * NPART + lane] = (lane == 0) ? ss : 0.f;
    }
}

typedef short s16x4 __attribute__((ext_vector_type(4)));
#define LAS __attribute__((address_space(3)))
__device__ __forceinline__ float xhalf_max(float v) { auto rr = __builtin_amdgcn_permlane32_swap(__float_as_uint(v), __float_as_uint(v), false, false); return fmaxf(__uint_as_float(rr[0]), __uint_as_float(rr[1])); }
__device__ __forceinline__ float xhalf_sum(float v) { auto rr = __builtin_amdgcn_permlane32_swap(__float_as_uint(v), __float_as_uint(v), false, false); return __uint_as_float(rr[0]) + __uint_as_float(rr[1]); }
__device__ __forceinline__ h16x8 tr_frag(const LAS unsigned char* a) {
    const s16x4 lo = __builtin_amdgcn_ds_read_tr16_b64_v4i16((LAS s16x4*)a), hi = __builtin_amdgcn_ds_read_tr16_b64_v4i16((LAS s16x4*)(a + 512));
    typedef short s16x8 __attribute__((ext_vector_type(8)));
    const s16x8 v = __builtin_shufflevector(lo, hi, 0, 1, 2, 3, 4, 5, 6, 7);
    return __builtin_bit_cast(h16x8, v);
}
#define CROW0(i) (((i) & 3) + 8 * ((i) >> 2))
__device__ __forceinline__ void glds16(const void* gsrc, unsigned lds_dst) { unsigned keep;
    asm volatile("s_mov_b32 %0, m0\n\ts_mov_b32 m0, %2\n\ts_nop 0\n\tglobal_load_lds_dwordx4 %1, off\n\ts_mov_b32 m0, %0" : "=&s"(keep) : "v"(gsrc), "s"(lds_dst) : "memory"); }

namespace pg8 {
#define PG8_LAS __attribute__((address_space(3)))
typedef _Float16 bf16_t;
typedef _Float16 bf16x8 __attribute__((ext_vector_type(8)));
typedef float f32x4 __attribute__((ext_vector_type(4)));
typedef unsigned u32x4 __attribute__((ext_vector_type(4)));
constexpr int BM = 256, BK = 64, HALF = 128, HTB = HALF * BK * 2  , STAGE_BYTES = 8 * HTB, NXCD = 8, WGM = 8;

__host__ __device__ __forceinline__ int lds_byte(int r, int c) { const int st = (r >> 4) * 2 + (c >> 5), rr = r & 15, cc = c & 31, ob = rr * 64 + cc * 2; return st * 1024 + (ob ^ (((ob >> 9) & 1) << 5)); }
__host__ __device__ __forceinline__ void stage_rc(int b, int& R, int& C) { const int st = b / 1024, sb = b % 1024, swz = sb ^ (((sb >> 9) & 1) << 5); R = (st >> 1) * 16 + swz / 64; C = (st & 1) * 32 + (swz % 64) / 2; }
__host__ __device__ __forceinline__ int perm32(int rho) { const int n = rho >> 4, i = rho & 15; return 8 * (i >> 2) + 4 * n + (i & 3); }

struct Unit { int pm, pn; };
struct Gemm { const bf16_t* A; const bf16_t* Bt; int M, N, K; };

struct StaticOrder {
    int nM, nN, nwg, G, c;
    __host__ __device__ void init(int M, int N, int G_, int c_) { nM = M / BM; nN = N / BM; nwg = nM * nN; G = G_; c = c_; }
    __host__ __device__ bool next(int i, Unit& u) const {
        const long L = (long)i * G + c; if (L >= nwg) return false;
        int wgid = (int)L; { const int q = nwg / NXCD, r = nwg % NXCD, xcd = wgid % NXCD, off = wgid / NXCD; wgid = (xcd < r ? xcd * (q + 1) : r * (q + 1) + (xcd - r) * q) + off; }
        const int nig = WGM * nN, gid = wgid / nig, fm = gid * WGM, gsz = (nM - fm) < WGM ? (nM - fm) : WGM;
        u.pm = fm + ((wgid % nig) % gsz); u.pn = (wgid % nig) / gsz; return true;
    }
    __device__ __forceinline__ void a_ready(const Unit&) const {}
    __device__ __forceinline__ void done(const Unit&) const {}
};

template <class Epi, class Sched, bool ALIGN_EPI = false, bool SP2 = false>
__device__ __forceinline__ void gemm_phase(PG8_LAS unsigned char* lds, const Gemm g, const Sched& S, const Epi& E) {
    const int tid = threadIdx.x, wid = __builtin_amdgcn_readfirstlane(tid >> 6), lane = tid & 63, wr = wid >> 2, wc = wid & 3, fr = lane & 15, fq = lane >> 4;
    const int K = g.K, nt = K / BK;
    unsigned voffA[2], voffB[2];
#pragma unroll
    for (int i = 0; i < 2; ++i) { int R, C; stage_rc(tid * 16 + i * 8192, R, C); const int Rb = Epi::PERM ? ((R & ~31) + perm32(R & 31)) : R;
        voffA[i] = (unsigned)(R * K + C) * 2u; voffB[i] = (unsigned)(Rb * K + C) * 2u; }
    const size_t kstep = (size_t)(BK * 2);
    const size_t hstep = (size_t)HALF * K * 2;
    const size_t tstep = 2 * hstep;
    const unsigned ldsw = (unsigned)wid * 1024u;
    const int aoff = lds_byte(wr * 64 + fr, fq * 8), boff = lds_byte(wc * 32 + fr, fq * 8);
#define PG8_SA(b, h) (((b) * 2 + (h)) * HTB)
#define PG8_SB(b, h) ((4 + (b) * 2 + (h)) * HTB)
#define PG8_STAGE(bufoff, gbase, voff) do { _Pragma("unroll") for (int _i = 0; _i < 2; ++_i) \
        __builtin_amdgcn_global_load_lds((const unsigned*)((const char*)(gbase) + (voff)[_i]), (PG8_LAS unsigned*)(lds + (bufoff) + ldsw + _i * 8192), 16, 0, 0); } while (0)
#define PG8_LDA(dst, b, h) do { _Pragma("unroll") for (int m = 0; m < 4; ++m) _Pragma("unroll") for (int k = 0; k < 2; ++k) dst[m][k] = *(const PG8_LAS bf16x8*)(lds + PG8_SA(b, h) + aoff + m * 2048 + k * 1024); } while (0)
#define PG8_LDB(dst, b, h) do { _Pragma("unroll") for (int n = 0; n < 2; ++n) _Pragma("unroll") for (int k = 0; k < 2; ++k) dst[n][k] = *(const PG8_LAS bf16x8*)(lds + PG8_SB(b, h) + boff + n * 2048 + k * 1024); } while (0)
#define PG8_MMA(ai, bj, At, Bt) do { __builtin_amdgcn_s_setprio(1); _Pragma("unroll") for (int m = 0; m < 4; ++m) _Pragma("unroll") for (int n = 0; n < 2; ++n) _Pragma("unroll") for (int k = 0; k < 2; ++k) \
        acc[ai][bj][m][n] = __builtin_amdgcn_mfma_f32_16x16x32_f16(Bt[n][k], At[m][k], acc[ai][bj][m][n], 0, 0, 0); __builtin_amdgcn_s_setprio(0); } while (0)
#define PG8_WAIT_V(n) asm volatile("s_waitcnt vmcnt(" #n ")" ::: "memory")
#define PG8_WAIT_L(n) asm volatile("s_waitcnt lgkmcnt(" #n ")" ::: "memory")
#define PG8_BAR __builtin_amdgcn_s_barrier()
#define PG8_SCHED __builtin_amdgcn_sched_barrier(0)
    Unit cur, nxt; int ui = 0;
    if (!S.next(0, cur)) return;
    f32x4 acc[2][2][4][2];
#pragma unroll
    for (int a = 0; a < 2; ++a)
#pragma unroll
        for (int b = 0; b < 2; ++b)
#pragma unroll
            for (int m = 0; m < 4; ++m)
#pragma unroll
                for (int n = 0; n < 2; ++n) acc[a][b][m][n] = (f32x4){0.f, 0.f, 0.f, 0.f};
    bf16x8 At[4][2], B0[2][2], B1[2][2];
    const char* cA = (const char*)g.A + (size_t)cur.pm * tstep; const char* cB = (const char*)g.Bt + (size_t)cur.pn * tstep;
    S.a_ready(cur);
    if constexpr (SP2) {
        PG8_STAGE(PG8_SB(0, 0), cB, voffB); PG8_STAGE(PG8_SB(0, 1), cB + hstep, voffB); PG8_STAGE(PG8_SA(0, 0), cA, voffA); PG8_STAGE(PG8_SA(0, 1), cA + hstep, voffA);
        if (wr == 1) PG8_BAR;
        PG8_WAIT_V(2); PG8_BAR;
        PG8_STAGE(PG8_SB(1, 0), cB + kstep, voffB); PG8_STAGE(PG8_SA(1, 0), cA + kstep, voffA); PG8_STAGE(PG8_SB(1, 1), cB + hstep + kstep, voffB);
        PG8_WAIT_V(6); PG8_BAR;
    } else {
        PG8_STAGE(PG8_SB(0, 0), cB, voffB); PG8_STAGE(PG8_SA(0, 0), cA, voffA); PG8_STAGE(PG8_SB(0, 1), cB + hstep, voffB); PG8_STAGE(PG8_SA(0, 1), cA + hstep, voffA);
        if (wr == 1) PG8_BAR;
        PG8_WAIT_V(4); PG8_BAR;
        PG8_STAGE(PG8_SB(1, 0), cB + kstep, voffB); PG8_STAGE(PG8_SA(1, 0), cA + kstep, voffA); PG8_STAGE(PG8_SB(1, 1), cB + hstep + kstep, voffB);
        PG8_WAIT_V(6); PG8_BAR;
    }
    for (;;) {
        const bool has_next = S.next(ui + 1, nxt);
        const char* nA = has_next ? (const char*)g.A + (size_t)nxt.pm * tstep : cA; const char* nB = has_next ? (const char*)g.Bt + (size_t)nxt.pn * tstep : cB;
        for (int t = 0; t < nt; t += 2) {
            const bool last = (t == nt - 2);
            const char* a1 = cA + (size_t)(t + 1) * kstep;
            const char* a2 = last ? nA : cA + (size_t)(t + 2) * kstep; const char* b2 = last ? nB : cB + (size_t)(t + 2) * kstep;
            const char* a3 = a2 + kstep; const char* b3 = b2 + kstep;
            if (last && has_next) S.a_ready(nxt);
            if constexpr (SP2) {
            PG8_LDB(B0, 0, 0); PG8_LDB(B1, 0, 1); PG8_SCHED; PG8_LDA(At, 0, 0); PG8_STAGE(PG8_SA(1, 1), a1 + hstep, voffA);
            PG8_WAIT_V(8); PG8_WAIT_L(0); PG8_BAR; PG8_MMA(0, 0, At, B0); PG8_MMA(0, 1, At, B1); PG8_BAR; PG8_SCHED;
            PG8_LDA(At, 0, 1); PG8_STAGE(PG8_SB(0, 0), b2, voffB); PG8_STAGE(PG8_SB(0, 1), b2 + hstep, voffB); PG8_STAGE(PG8_SA(0, 0), a2, voffA);
            PG8_WAIT_V(8); PG8_WAIT_L(0); PG8_BAR; PG8_MMA(1, 0, At, B0); PG8_MMA(1, 1, At, B1); PG8_BAR; PG8_SCHED;
            PG8_LDB(B0, 1, 0); PG8_LDB(B1, 1, 1); PG8_SCHED; PG8_LDA(At, 1, 0); PG8_STAGE(PG8_SA(0, 1), a2 + hstep, voffA);
            PG8_WAIT_V(8); PG8_WAIT_L(0); PG8_BAR; PG8_MMA(0, 0, At, B0); PG8_MMA(0, 1, At, B1); PG8_BAR; PG8_SCHED;
            PG8_LDA(At, 1, 1); PG8_STAGE(PG8_SB(1, 0), b3, voffB); PG8_STAGE(PG8_SB(1, 1), b3 + hstep, voffB); PG8_STAGE(PG8_SA(1, 0), a3, voffA);
            PG8_WAIT_V(8); PG8_WAIT_L(0); PG8_BAR; PG8_MMA(1, 0, At, B0); PG8_MMA(1, 1, At, B1); PG8_BAR; PG8_SCHED;
            } else {
            PG8_LDB(B0, 0, 0); PG8_SCHED; PG8_LDA(At, 0, 0); PG8_STAGE(PG8_SA(1, 1), a1 + hstep, voffA);
            PG8_WAIT_L(8); PG8_BAR; PG8_WAIT_L(0); PG8_MMA(0, 0, At, B0); PG8_BAR; PG8_SCHED;
            PG8_LDB(B1, 0, 1); PG8_STAGE(PG8_SB(0, 0), b2, voffB);
            PG8_BAR; PG8_WAIT_L(0); PG8_MMA(0, 1, At, B1); PG8_BAR;
            PG8_LDA(At, 0, 1); PG8_STAGE(PG8_SA(0, 0), a2, voffA);
            PG8_BAR; PG8_WAIT_L(0); PG8_MMA(1, 0, At, B0); PG8_BAR; PG8_SCHED;
            PG8_STAGE(PG8_SB(0, 1), b2 + hstep, voffB);
            PG8_WAIT_V(6); PG8_BAR; PG8_MMA(1, 1, At, B1); PG8_BAR;
            PG8_LDB(B0, 1, 0); PG8_SCHED; PG8_LDA(At, 1, 0); PG8_STAGE(PG8_SA(0, 1), a2 + hstep, voffA);
            PG8_WAIT_L(8); PG8_BAR; PG8_WAIT_L(0); PG8_MMA(0, 0, At, B0); PG8_BAR; PG8_SCHED;
            PG8_LDB(B1, 1, 1); PG8_STAGE(PG8_SB(1, 0), b3, voffB);
            PG8_BAR; PG8_WAIT_L(0); PG8_MMA(0, 1, At, B1); PG8_BAR;
            PG8_LDA(At, 1, 1); PG8_STAGE(PG8_SA(1, 0), a3, voffA);
            PG8_BAR; PG8_WAIT_L(0); PG8_MMA(1, 0, At, B0); PG8_BAR; PG8_SCHED;
            PG8_STAGE(PG8_SB(1, 1), b3 + hstep, voffB);
            PG8_WAIT_V(6); PG8_BAR; PG8_MMA(1, 1, At, B1); PG8_BAR;
            }
        }
        if constexpr (ALIGN_EPI) { if (wr == 0) PG8_BAR; }
        if constexpr (!Epi::AFTER_DRAIN) { E(acc, cur, wr, wc, fr, fq); S.done(cur); }
        if (!has_next) break;
#pragma unroll
        for (int a = 0; a < 2; ++a)
#pragma unroll
            for (int b = 0; b < 2; ++b)
#pragma unroll
                for (int m = 0; m < 4; ++m)
#pragma unroll
                    for (int n = 0; n < 2; ++n) acc[a][b][m][n] = (f32x4){0.f, 0.f, 0.f, 0.f};
        cur = nxt; cA = nA; cB = nB; ++ui;
        if constexpr (ALIGN_EPI) { if (wr == 1) PG8_BAR; }
    }
    PG8_WAIT_V(0);
    if constexpr (!ALIGN_EPI) { if (wr == 0) PG8_BAR; }
    PG8_BAR;
    if constexpr (Epi::AFTER_DRAIN) { E.fused(acc, cur, wr, wc, fr, fq, lds, wid, lane); S.done(cur); }
#undef PG8_SA
#undef PG8_SB
#undef PG8_STAGE
#undef PG8_LDA
#undef PG8_LDB
#undef PG8_MMA
#undef PG8_WAIT_V
#undef PG8_WAIT_L
#undef PG8_BAR
#undef PG8_SCHED
}

struct EpiProj {
    static constexpr bool PERM = true, AFTER_DRAIN = false;
    bf16_t* O; const float* rowss; float* kmpart;
    __device__ __forceinline__ void operator()(const f32x4 (&acc)[2][2][4][2], const Unit& u, int wr, int wc, int fr, int fq) const {
        const int row0 = u.pm * BM + wr * 64 + fr, col0 = u.pn * BM + wc * 32 + 8 * fq;
        const bool want_km = (u.pn == 9) || (u.pn == 10);
        f32x4 cs[2][2];
#pragma unroll
        for (int bj = 0; bj < 2; ++bj)
#pragma unroll
            for (int n = 0; n < 2; ++n) cs[bj][n] = (f32x4){0.f, 0.f, 0.f, 0.f};
#pragma unroll
        for (int ai = 0; ai < 2; ++ai)
#pragma unroll
            for (int m = 0; m < 4; ++m) { const size_t row = (size_t)(row0 + ai * HALF + m * 16);
                const f32x4* rs = (const f32x4*)(rowss + row * 16); const f32x4 s0 = rs[0], s1 = rs[1], s2 = rs[2], s3 = rs[3];
                const float tot = ((s0[0] + s0[1]) + (s0[2] + s0[3])) + ((s1[0] + s1[1]) + (s1[2] + s1[3])) + ((s2[0] + s2[1]) + (s2[2] + s2[3])) + ((s3[0] + s3[1]) + (s3[2] + s3[3]));
                const float rstd = rsqrtf(tot * (1.0f / 1024.0f) + 1e-6f);
                bf16_t* rowp = O + row * 3840 + col0;
#pragma unroll
                for (int bj = 0; bj < 2; ++bj) { const f32x4 v0 = acc[ai][bj][m][0] * rstd, v1 = acc[ai][bj][m][1] * rstd; bf16x8 w;
                    w[0] = (bf16_t)v0[0]; w[1] = (bf16_t)v0[1]; w[2] = (bf16_t)v0[2]; w[3] = (bf16_t)v0[3]; w[4] = (bf16_t)v1[0]; w[5] = (bf16_t)v1[1]; w[6] = (bf16_t)v1[2]; w[7] = (bf16_t)v1[3];
                    *(bf16x8*)(rowp + bj * HALF) = w; cs[bj][0] += v0; cs[bj][1] += v1; } }
        if (want_km) {
#pragma unroll
            for (int bj = 0; bj < 2; ++bj)
#pragma unroll
                for (int n = 0; n < 2; ++n)
#pragma unroll
                    for (int k = 0; k < 4; ++k) { float v = cs[bj][n][k]; v += __shfl_xor(v, 1); v += __shfl_xor(v, 2); v += __shfl_xor(v, 4); v += __shfl_xor(v, 8); cs[bj][n][k] = v * (1.0f / 256.0f); }
            if (fr == 0) {
#pragma unroll
                for (int bj = 0; bj < 2; ++bj)
#pragma unroll
                    for (int n = 0; n < 2; ++n) { const int cm = col0 + bj * HALF + 4 * n - 2304;
                        *(f32x4*)(kmpart + ((size_t)((wr * 8 + (u.pm >> 4)) * 8 + (cm >> 6)) * 16 + (u.pm & 15)) * 64 + (cm & 63)) = cs[bj][n]; }
            }
        }
    }
};
template <int LAYER> struct EpiRes {
    static constexpr bool PERM = true, AFTER_DRAIN = false;
    const float* x0; float* xout; bf16_t* xh; float* rowss;
    __device__ __forceinline__ void operator()(const f32x4 (&acc)[2][2][4][2], const Unit& u, int wr, int wc, int fr, int fq) const {
        const int row0 = u.pm * BM + wr * 64 + fr, col0 = u.pn * BM + wc * 32 + 8 * fq;
#pragma unroll
        for (int ai = 0; ai < 2; ++ai)
#pragma unroll
            for (int m = 0; m < 4; ++m) { const size_t row = (size_t)(row0 + ai * HALF + m * 16); float ss = 0.f;
#pragma unroll
                for (int bj = 0; bj < 2; ++bj) { const size_t off = row * 1024 + col0 + bj * HALF; f32x4 v0, v1;
                    if (LAYER == 0) { v0 = *(const f32x4*)(x0 + off) + acc[ai][bj][m][0]; v1 = *(const f32x4*)(x0 + off + 4) + acc[ai][bj][m][1];
                        bf16x8 w; w[0] = (bf16_t)v0[0]; w[1] = (bf16_t)v0[1]; w[2] = (bf16_t)v0[2]; w[3] = (bf16_t)v0[3]; w[4] = (bf16_t)v1[0]; w[5] = (bf16_t)v1[1]; w[6] = (bf16_t)v1[2]; w[7] = (bf16_t)v1[3];
                        *(bf16x8*)(xh + off) = w; }
                    else { const bf16x8 xp = *(const bf16x8*)(xh + off);
                        v0 = (f32x4){(float)xp[0], (float)xp[1], (float)xp[2], (float)xp[3]} + acc[ai][bj][m][0]; v1 = (f32x4){(float)xp[4], (float)xp[5], (float)xp[6], (float)xp[7]} + acc[ai][bj][m][1];
                        *(f32x4*)(xout + off) = v0; *(f32x4*)(xout + off + 4) = v1; }
                    ss += ((v0[0] * v0[0] + v0[1] * v0[1]) + (v0[2] * v0[2] + v0[3] * v0[3])) + ((v1[0] * v1[0] + v1[1] * v1[1]) + (v1[2] * v1[2] + v1[3] * v1[3])); }
                ss += __shfl_xor(ss, 16); ss += __shfl_xor(ss, 32);
                if (fq == 0) rowss[row * 16 + u.pn * 4 + wc] = ss; }
    }
};
}


__device__ __forceinline__ void deferred_transposes(const Params& p, unsigned char* lds, int id, int n) {
    float* tile = (float*)lds;
    h16* win = (h16*)(p.ws + WS_WIN); h16* wout = (h16*)(p.ws + WS_WOUT); h16* wpw = (h16*)(p.ws + WS_WPW);
    constexpr int U_IN = 16 * 60, U_OUT = 16 * 16, U_PW = 4 * 4;
    for (int u = id; u < U_IN + 2 * U_OUT + 2 * U_PW; u += n) {
        int r = u;
        if (r < U_IN) { transpose_unit(p.w_in + (size_t)DM * NIN, DM, NIN, win + (size_t)NIN * DM, p.norm_g + DM, (r / 60) * 64, (r % 60) * 64, tile); continue; }
        r -= U_IN;
        if (r < 2 * U_OUT) { const int layer = r / U_OUT; r %= U_OUT; transpose_unit(p.w_out + (size_t)layer * DM * DM, DM, DM, wout + (size_t)layer * DM * DM, nullptr, (r / 16) * 64, (r % 16) * 64, tile); continue; }
        r -= 2 * U_OUT;
        { const int layer = r / U_PW; r %= U_PW; transpose_unit(p.pw_w + (size_t)layer * 256 * 256, 256, 256, wpw + (size_t)layer * 256 * 256, nullptr, (r / 4) * 64, (r % 4) * 64, tile); }
    }
}

__device__ __forceinline__ void gemm_in(const Params& p, int layer, unsigned char* lds) {
    pg8::Gemm g{(const h16*)(p.ws + WS_XH), (const h16*)(p.ws + WS_WIN) + (size_t)layer * NIN * DM, MROWS, NIN, DM};
    pg8::StaticOrder S; S.init(MROWS, NIN, (int)gridDim.x, (int)blockIdx.x);
    pg8::EpiProj E{(h16*)(p.ws + WS_PROJ), (const float*)(p.ws + WS_ROWSS), (float*)(p.ws + WS_KMEAN)};
    pg8::gemm_phase<pg8::EpiProj, pg8::StaticOrder, true, true>((PG8_LAS unsigned char*)lds, g, S, E);
    if (layer == 0) { const int G = (int)gridDim.x, nfull = (MROWS / 256) * (NIN / 256) % G;
        if (nfull == 0) deferred_transposes(p, lds, (int)blockIdx.x, G); else if ((int)blockIdx.x >= nfull) deferred_transposes(p, lds, (int)blockIdx.x - nfull, G - nfull); }
}
template <int LAYER> __device__ __forceinline__ void gemm_out(const Params& p, unsigned char* lds) {
    pg8::Gemm g{(const h16*)(p.ws + WS_MIX), (const h16*)(p.ws + WS_WOUT) + (size_t)LAYER * DM * DM, MROWS, DM, DM};
    pg8::StaticOrder S; S.init(MROWS, DM, (int)gridDim.x, (int)blockIdx.x);
    pg8::EpiRes<LAYER> E{p.x, p.out, (h16*)(p.ws + WS_XH), (float*)(p.ws + WS_ROWSS)};
    pg8::gemm_phase<pg8::EpiRes<LAYER>, pg8::StaticOrder, true, true>((PG8_LAS unsigned char*)lds, g, S, E);
}

__device__ __forceinline__ void phase_stats(const Params& p, int layer, unsigned char* lds_g) {
    LAS unsigned char* lds = (LAS unsigned char*)lds_g;
    const h16* proj = (const h16*)(p.ws + WS_PROJ); float* kv = (float*)(p.ws + WS_KV);
    const int tid = threadIdx.x, lane = tid & 63, wid = __builtin_amdgcn_readfirstlane(tid >> 6), r = lane & 31, hi = lane >> 5;
    const int lanepart = (4 * hi + ((lane & 15) >> 2)) * 64 + ((lane >> 4) & 1) * 32 + (lane & 3) * 8;
#pragma unroll 1
    for (int u = blockIdx.x; u < 512; u += gridDim.x) {
        const int b = u >> 6, hh = (u >> 4) & 3, np = u & 15;
        const float log_g = logf(1.0f - exp2f(-5.0f - (float)hh));
        __syncthreads();
#pragma unroll
        for (int it = 0; it < 4; ++it) {
            const int pc = tid + 512 * it, cn = pc >> 10, key = (pc >> 3) & 127, ch = pc & 7;
            const h16* src = proj + (size_t)(b * SEQ + (2 * np + cn) * 128 + key) * NIN + hh * 64 + ch * 8;
            h16x8 kk = *(const h16x8*)(src + C_RK); const h16x8 vv = *(const h16x8*)(src + C_RV);
            const float z = __expf(log_g * (float)(127 - key)) * 0.125f;
#pragma unroll
            for (int k = 0; k < 8; ++k) kk[k] = (h16)((float)kk[k] * z);
            const int off = cn * 32768 + (ch >> 2) * 8192 + (key >> 4) * 1024 + (key & 15) * 64 + (ch & 3) * 16;
            *(LAS h16x8*)(lds + off) = kk; *(LAS h16x8*)(lds + off + 16384) = vv;
        }
        __syncthreads();
        const int cn = wid >> 2, eb = (wid >> 1) & 1, dbk = wid & 1;
        const LAS unsigned char* kimg = lds + cn * 32768 + dbk * 8192 + lanepart; const LAS unsigned char* vimg = lds + cn * 32768 + 16384 + eb * 8192 + lanepart;
        f32x16 acc;
#pragma unroll
        for (int i = 0; i < 16; ++i) acc[i] = 0.f;
#pragma unroll
        for (int ks = 0; ks < 8; ++ks) acc = __builtin_amdgcn_mfma_f32_32x32x16_f16(tr_frag(vimg + ks * 1024), tr_frag(kimg + ks * 1024), acc, 0, 0, 0);
        float* dst = kv + ((size_t)((b * 4 + hh) * 32 + 2 * np + cn)) * 4096 + (32 * eb + 4 * hi) * 64 + 32 * dbk + r;
#pragma unroll
        for (int i = 0; i < 16; ++i) dst[CROW0(i) * 64] = acc[i];
    }
#pragma unroll 1
    for (int u = blockIdx.x; u < 1024; u += gridDim.x) {
        const int b = u >> 7, row = (u & 127) * 32 + (tid >> 4), part = tid & 15;
        const h16* src = proj + (size_t)(b * SEQ + row) * NIN + C_MK + part * 32;
        float ss = 0.f;
#pragma unroll
        for (int k = 0; k < 4; ++k) { const h16x8 kk = *(const h16x8*)(src + k * 8);
#pragma unroll
            for (int d = 0; d < 8; ++d) ss += (float)kk[d] * (float)kk[d]; }
        ss += __shfl_xor(ss, 1);
        ss = fmaxf(ss, __shfl_xor(ss, 16)); ss = fmaxf(ss, __shfl_xor(ss, 32));
        if ((lane & 0x31) == 0) atomicMax((unsigned*)(p.ws + WS_CTL + 20480) + layer * 64 + b * 8 + (part >> 1), __float_as_uint(ss));
    }
}

typedef _Float16 h16x2 __attribute__((ext_vector_type(2)));
typedef float f32x2 __attribute__((ext_vector_type(2)));
__device__ __forceinline__ void conv_unit(const Params& p, int layer, int b, int tt, unsigned char* lds_g) {
    LAS unsigned char* lds = (LAS unsigned char*)lds_g;
    const h16* projb = (const h16*)(p.ws + WS_PROJ) + (size_t)b * SEQ * NIN; h16* mix = (h16*)(p.ws + WS_MIX);
    const int tid = threadIdx.x, lane = tid & 63, wid = __builtin_amdgcn_readfirstlane(tid >> 6), r = lane & 31, hi = lane >> 5;
    const int cp = tid & 127, tg = __builtin_amdgcn_readfirstlane(tid >> 7), t0 = tt * 64, tb0 = t0 + 16 * tg - 30;
    constexpr int YS = 0, SIMG = 65536;
    float y0[16], y1[16];
    {
        float w0[31], w1[31]; const float* cw = p.conv_w + (size_t)layer * 31 * 256 + 2 * cp;
#pragma unroll
        for (int jj = 0; jj < 31; ++jj) { const f32x2 wv = *(const f32x2*)(cw + jj * 256); w0[jj] = wv[0]; w1[jj] = wv[1]; }
        const f32x2 cbv = *(const f32x2*)(p.conv_b + layer * 256 + 2 * cp);
#pragma unroll
        for (int tl = 0; tl < 16; ++tl) { y0[tl] = cbv[0]; y1[tl] = cbv[1]; }
#pragma unroll
        for (int rr = 0; rr < 46; ++rr) {
            const int t = tb0 + rr; float a0 = 0.f, a1 = 0.f;
            if (t >= 0) { const h16x2 av = *(const h16x2*)(projb + (size_t)t * NIN + C_AVAL + 2 * cp), gv = *(const h16x2*)(projb + (size_t)t * NIN + C_AGLU + 2 * cp);
                a0 = (float)av[0] * __builtin_amdgcn_rcpf(1.0f + __expf(-(float)gv[0])); a1 = (float)av[1] * __builtin_amdgcn_rcpf(1.0f + __expf(-(float)gv[1])); }
#pragma unroll
            for (int tl = 0; tl < 16; ++tl) { const int jj = rr - tl; if (jj >= 0 && jj < 31) { y0[tl] += w0[jj] * a0; y1[tl] += w1[jj] * a1; } }
        }
    }
    __syncthreads();
#pragma unroll
    for (int tl = 0; tl < 16; ++tl) *(LAS f32x2*)(lds + YS + ((16 * tg + tl) * 256 + 2 * cp) * 4) = (f32x2){y0[tl], y1[tl]};
    h16x8 wf[16];
    {
        const h16* wp = (const h16*)(p.ws + WS_WPW) + (size_t)layer * 65536 + (size_t)(32 * wid + r) * 256 + 8 * hi;
#pragma unroll
        for (int ks = 0; ks < 16; ++ks) wf[ks] = *(const h16x8*)(wp + 16 * ks);
    }
    __syncthreads();
    {
        const f32x4 lg = *(const f32x4*)(p.ln_g + layer * 256 + lane * 4), lb = *(const f32x4*)(p.ln_b + layer * 256 + lane * 4);
#pragma unroll 1
        for (int kb = 0; kb < 8; kb += 4) {
        f32x4 v[4]; float s1[4], s2[4];
#pragma unroll
        for (int k = 0; k < 4; ++k) { v[k] = *(const LAS f32x4*)(lds + YS + ((wid * 8 + kb + k) * 256 + lane * 4) * 4);
            s1[k] = (v[k][0] + v[k][1]) + (v[k][2] + v[k][3]); s2[k] = (v[k][0] * v[k][0] + v[k][1] * v[k][1]) + (v[k][2] * v[k][2] + v[k][3] * v[k][3]); }
#pragma unroll
        for (int o = 1; o < 64; o <<= 1)
#pragma unroll
            for (int k = 0; k < 4; ++k) { s1[k] += __shfl_xor(s1[k], o); s2[k] += __shfl_xor(s2[k], o); }
#pragma unroll
        for (int k = 0; k < 4; ++k) { const int t = wid * 8 + kb + k; const float mu = s1[k] * (1.0f / 256.0f); const float var = fmaxf(s2[k] * (1.0f / 256.0f) - mu * mu, 0.f); const float rs = rsqrtf(var + 1e-5f);
            h16x4 o; o[0] = (h16)silu_f((v[k][0] - mu) * rs * lg[0] + lb[0]); o[1] = (h16)silu_f((v[k][1] - mu) * rs * lg[1] + lb[1]); o[2] = (h16)silu_f((v[k][2] - mu) * rs * lg[2] + lb[2]); o[3] = (h16)silu_f((v[k][3] - mu) * rs * lg[3] + lb[3]);
            *(LAS h16x4*)(lds + SIMG + t * 512 + (((lane >> 1) ^ (t & 15)) << 4) + 8 * (lane & 1)) = o; }
        }
    }
    __syncthreads();
#pragma unroll
    for (int tb = 0; tb < 2; ++tb) {
        f32x16 acc;
#pragma unroll
        for (int i = 0; i < 16; ++i) acc[i] = 0.f;
#pragma unroll
        for (int ks = 0; ks < 16; ++ks) acc = __builtin_amdgcn_mfma_f32_32x32x16_f16(wf[ks], *(const LAS h16x8*)(lds + SIMG + (32 * tb + r) * 512 + (((2 * ks + hi) ^ (r & 15)) << 4)), acc, 0, 0, 0);
        const int t = t0 + 32 * tb + r, n0 = 32 * wid + 4 * hi;
        const h16* gp = projb + (size_t)t * NIN + C_AGATE + n0; h16* dst = mix + ((size_t)b * SEQ + t) * DM + n0; const float* pb = p.pw_b + layer * 256 + n0;
#pragma unroll
        for (int g = 0; g < 4; ++g) { const h16x4 ga = *(const h16x4*)(gp + 8 * g); const f32x4 bb = *(const f32x4*)(pb + 8 * g); h16x4 oa;
#pragma unroll
            for (int k = 0; k < 4; ++k) oa[k] = (h16)((acc[4 * g + k] + bb[k]) * silu_f((float)ga[k]));
            *(h16x4*)(dst + 8 * g) = oa; }
    }
}

__device__ __forceinline__ void ret_unit(const Params& p, int b, int hh, int n, unsigned char* lds_g) {
    LAS unsigned char* lds = (LAS unsigned char*)lds_g;
    const h16* projb = (const h16*)(p.ws + WS_PROJ) + (size_t)(b * SEQ + n * 128) * NIN; h16* mix = (h16*)(p.ws + WS_MIX); const float* kv = (const float*)(p.ws + WS_KV);
    const int tid = threadIdx.x, lane = tid & 63, wid = __builtin_amdgcn_readfirstlane(tid >> 6), r = lane & 31, hi = lane >> 5, g4 = wid & 3, eh = wid >> 2;
    const float log_g = logf(1.0f - exp2f(-5.0f - (float)hh));
    constexpr int KIMG = 0, VIMG = 16384, RIMG = 32768, XS = 40960;
    const h16x8 rr = *(const h16x8*)((const h16*)(p.ws + WS_RST) + ((size_t)((b * 4 + hh) * 32 + n)) * 4096 + tid * 8);
    __syncthreads();
    {
        const int e = tid >> 3, ch = tid & 7;
        *(LAS h16x8*)(lds + RIMG + e * 128 + ((ch ^ ((e >> 1) & 7)) << 4)) = rr;
#pragma unroll
        for (int it = 0; it < 2; ++it) {
            const int key = (tid >> 3) + 64 * it;
            h16x8 kk = *(const h16x8*)(projb + (size_t)key * NIN + C_RK + hh * 64 + ch * 8); const h16x8 vv = *(const h16x8*)(projb + (size_t)key * NIN + C_RV + hh * 64 + ch * 8);
            const float z = __expf(-log_g * (float)key) * 0.125f;
#pragma unroll
            for (int k = 0; k < 8; ++k) kk[k] = (h16)((float)kk[k] * z);
            *(LAS h16x8*)(lds + KIMG + key * 128 + ((ch ^ ((key >> 1) & 7)) << 4)) = kk;
            *(LAS h16x8*)(lds + VIMG + (ch >> 2) * 8192 + (key >> 4) * 1024 + (key & 15) * 64 + (ch & 3) * 16) = vv;
        }
    }
    const int qi = 32 * g4 + r;
    h16x8 qf[4];
    {
        const float zq = __expf(log_g * (float)qi);
#pragma unroll
        for (int s = 0; s < 4; ++s) { qf[s] = *(const h16x8*)(projb + (size_t)qi * NIN + C_RQ + hh * 64 + 16 * s + 8 * hi);
#pragma unroll
            for (int k = 0; k < 8; ++k) qf[s][k] = (h16)((float)qf[s][k] * zq); }
    }
    __syncthreads();
    const int rsw = (r >> 1) & 7;
    const int lanepart = (4 * hi + ((lane & 15) >> 2)) * 64 + ((lane >> 4) & 1) * 32 + (lane & 3) * 8;
    f32x16 o;
#pragma unroll
    for (int i = 0; i < 16; ++i) o[i] = 0.f;
#pragma unroll 1
    for (int jb = 0; jb <= g4; ++jb) {
        f32x16 c;
#pragma unroll
        for (int i = 0; i < 16; ++i) c[i] = 0.f;
#pragma unroll
        for (int s = 0; s < 4; ++s) c = __builtin_amdgcn_mfma_f32_32x32x16_f16(*(const LAS h16x8*)(lds + KIMG + (32 * jb + r) * 128 + (((2 * s + hi) ^ rsw) << 4)), qf[s], c, 0, 0, 0);
        if (jb == g4) {
#pragma unroll
            for (int i = 0; i < 16; ++i) if (CROW0(i) + 4 * hi > r) c[i] = 0.f;
        }
        h16x8 pf0, pf1;
#pragma unroll
        for (int k = 0; k < 8; ++k) { pf0[k] = (h16)c[k]; pf1[k] = (h16)c[8 + k]; }
        o = __builtin_amdgcn_mfma_f32_32x32x16_f16(tr_frag(lds + VIMG + eh * 8192 + (2 * jb) * 1024 + lanepart), pf0, o, 0, 0, 0);
        o = __builtin_amdgcn_mfma_f32_32x32x16_f16(tr_frag(lds + VIMG + eh * 8192 + (2 * jb + 1) * 1024 + lanepart), pf1, o, 0, 0, 0);
    }
#pragma unroll
    for (int s = 0; s < 4; ++s) o = __builtin_amdgcn_mfma_f32_32x32x16_f16(*(const LAS h16x8*)(lds + RIMG + (32 * eh + r) * 128 + (((2 * s + hi) ^ rsw) << 4)), qf[s], o, 0, 0, 0);
    float s1 = 0.f, s2 = 0.f;
#pragma unroll
    for (int i = 0; i < 16; ++i) { s1 += o[i]; s2 += o[i] * o[i]; }
    s1 = xhalf_sum(s1); s2 = xhalf_sum(s2);
    LAS float* xs = (LAS float*)(lds + XS);
    if (hi == 0) { xs[(wid * 32 + r) * 2] = s1; xs[(wid * 32 + r) * 2 + 1] = s2; }
    __syncthreads();
    {
        const float t1 = xs[((wid ^ 4) * 32 + r) * 2], t2 = xs[((wid ^ 4) * 32 + r) * 2 + 1];
        const float a1 = (eh == 0) ? (s1 + t1) : (t1 + s1), a2 = (eh == 0) ? (s2 + t2) : (t2 + s2);
        const float mu = a1 * (1.0f / 64.0f); const float var = fmaxf(a2 * (1.0f / 64.0f) - mu * mu, 0.f); const float rs = rsqrtf(var + 1e-5f);
        const int col = hh * 64 + 32 * eh + 4 * hi;
        const h16* gp = projb + (size_t)qi * NIN + C_RGATE + col; h16* dst = mix + ((size_t)(b * SEQ + n * 128 + qi)) * DM + 256 + col;
#pragma unroll
        for (int g = 0; g < 4; ++g) { const h16x4 ga = *(const h16x4*)(gp + 8 * g); h16x4 oa;
#pragma unroll
            for (int k = 0; k < 4; ++k) oa[k] = (h16)((o[4 * g + k] - mu) * rs * silu_f((float)ga[k]));
            *(h16x4*)(dst + 8 * g) = oa; }
    }
}

constexpr float MOBA_THR = 8.0f;
__device__ __forceinline__ void moba_unit(const Params& p, int layer, int b, int hh, int j, unsigned char* lds_g) {
    LAS unsigned char* lds = (LAS unsigned char*)lds_g;
    const int tid = threadIdx.x, lane = tid & 63, wid = __builtin_amdgcn_readfirstlane(tid >> 6), r = lane & 31, hi = lane >> 5;
    const h16* projb = (const h16*)(p.ws + WS_PROJ) + (size_t)b * SEQ * NIN; h16* mix = (h16*)(p.ws + WS_MIX);
    const int qrow = j * 256 + wid * 32 + r;
    h16x8 qf[4];
#pragma unroll
    for (int s = 0; s < 4; ++s) qf[s] = *(const h16x8*)(projb + (size_t)qrow * NIN + C_MQ + hh * 64 + 16 * s + 8 * hi);
    unsigned selmask = 0u;
    if (j <= 3) selmask = (1u << j) - 1u;
    else {
        const float* km = (const float*)(p.ws + WS_KMEAN) + ((size_t)(b * 8 + hh) * 16 + (r & 15)) * 64 + 8 * hi;
        f32x16 g;
#pragma unroll
        for (int i = 0; i < 16; ++i) g[i] = 0.f;
#pragma unroll
        for (int s = 0; s < 4; ++s) {
            f32x4 a0 = (f32x4){0.f, 0.f, 0.f, 0.f}, a1 = a0;
            if (r < j) { a0 = *(const f32x4*)(km + 16 * s) + *(const f32x4*)(km + 65536 + 16 * s); a1 = *(const f32x4*)(km + 16 * s + 4) + *(const f32x4*)(km + 65536 + 16 * s + 4); }
            h16x8 ah, al;
#pragma unroll
            for (int k = 0; k < 4; ++k) { const h16 h0 = (h16)a0[k], h1 = (h16)a1[k]; ah[k] = h0; ah[4 + k] = h1; al[k] = (h16)(a0[k] - (float)h0); al[4 + k] = (h16)(a1[k] - (float)h1); }
            g = __builtin_amdgcn_mfma_f32_32x32x16_f16(ah, qf[s], g, 0, 0, 0);
            g = __builtin_amdgcn_mfma_f32_32x32x16_f16(al, qf[s], g, 0, 0, 0);
        }
        float gate[16];
#pragma unroll
        for (int i = 0; i < 8; ++i) { auto rr = __builtin_amdgcn_permlane32_swap(__float_as_uint(g[i]), __float_as_uint(g[i]), false, false);
            gate[(i & 3) + 8 * (i >> 2)] = __uint_as_float(rr[0]); gate[(i & 3) + 8 * (i >> 2) + 4] = __uint_as_float(rr[1]); }
        float g0 = -3.0e38f, g1 = -3.0e38f, g2 = -3.0e38f; int i0 = 0, i1 = 0, i2 = 0;
#pragma unroll
        for (int n = 0; n < 15; ++n) { const float s = (n < j) ? gate[n] : -3.0e38f;
            if (s > g0) { g2 = g1; i2 = i1; g1 = g0; i1 = i0; g0 = s; i0 = n; }
            else if (s > g1) { g2 = g1; i2 = i1; g1 = s; i1 = n; }
            else if (s > g2) { g2 = s; i2 = n; } }
        selmask = (1u << i0) | (1u << i1) | (1u << i2);
    }
    constexpr float C2 = 0.125f * 1.4426950408889634f;
    float qn2 = 0.f;
#pragma unroll
    for (int s = 0; s < 4; ++s)
#pragma unroll
        for (int k = 0; k < 8; ++k) { qf[s][k] = (h16)((float)qf[s][k] * C2); qn2 += (float)qf[s][k] * (float)qf[s][k]; }
    const float qbound = sqrtf(xhalf_sum(qn2)) * sqrtf(__uint_as_float(__hip_atomic_load((const unsigned*)(p.ws + WS_CTL + 20480) + layer * 64 + b * 8 + hh, __ATOMIC_RELAXED, __HIP_MEMORY_SCOPE_AGENT))) * 1.001f;
    const float slope2 = exp2f(-(float)(hh + 1)) * 1.4426950408889634f;
    f32x16 o0, o1;
#pragma unroll
    for (int i = 0; i < 16; ++i) { o0[i] = 0.f; o1[i] = 0.f; }
    float mref = 0.f, lsum = 0.f; bool first = true;
    const unsigned lds0 = (unsigned)(__UINTPTR_TYPE__)lds;
    const int dkey = 8 * wid + (lane >> 3);
    const h16* ksrc = projb + (size_t)dkey * NIN + C_MK + hh * 64 + (((lane & 7) ^ ((dkey >> 1) & 7)) << 3);
    const h16* vsrc = projb + (size_t)(16 * (wid & 3) + (lane >> 2)) * NIN + C_MV + hh * 64 + (wid >> 2) * 32 + (lane & 3) * 8;
    const unsigned kdst = lds0 + wid * 1024, vdst = lds0 + 8192 + (wid >> 2) * 4096 + (wid & 3) * 1024;
#define MOBA_DMA(tile) do { const int kp_ = j * 256 + 192 - 64 * (tile); const unsigned so_ = (unsigned)(((tile) & 3) * 16384); \
        glds16(ksrc + (size_t)kp_ * NIN, (unsigned)__builtin_amdgcn_readfirstlane(kdst + so_)); glds16(vsrc + (size_t)kp_ * NIN, (unsigned)__builtin_amdgcn_readfirstlane(vdst + so_)); } while (0)
#define MOBA_WAIT_BAR(N) asm volatile("s_waitcnt vmcnt(" #N ") lgkmcnt(0)\n\ts_barrier" ::: "memory")
    const int rK = r * 128, rsw = (r >> 1) & 7;
    const int rV = 8192 + (4 * hi + ((lane & 15) >> 2)) * 64 + ((lane >> 4) & 1) * 32 + (lane & 3) * 8;
    const int nt = 4 * (j + 1);
    const int wdiag = wid >> 1;
#define MOBA_CIN(T, C0, C1) do { const int kp_ = j * 256 + 192 - 64 * (T); const int nb_ = kp_ >> 8, tl_ = (kp_ >> 6) & 3; const bool own_ = (nb_ == j); \
        const bool val_ = own_ ? true : (((selmask >> (nb_ & 31)) & 1u) != 0u); \
        const float tbh_ = val_ ? (slope2 * (float)(kp_ - qrow + 4 * hi) - mref) : -INFINITY; \
        _Pragma("unroll") for (int i = 0; i < 16; ++i) { C0[i] = fmaf(slope2, (float)CROW0(i), tbh_); C1[i] = fmaf(slope2, (float)(CROW0(i) + 32), tbh_); } \
        if (own_ && tl_ >= wdiag) { const int lim2_ = 32 * wid - 64 * tl_ + r - 4 * hi; \
            _Pragma("unroll") for (int i = 0; i < 16; ++i) { if (CROW0(i) > lim2_) C0[i] = -INFINITY; if (CROW0(i) + 32 > lim2_) C1[i] = -INFINITY; } } } while (0)
#define MOBA_QK(T, C0, C1) do { const LAS unsigned char* kb_ = lds + ((T) & 3) * 16384 + rK; \
        _Pragma("unroll") for (int s = 0; s < 4; ++s) { \
            const h16x8 k0_ = *(const LAS h16x8*)(kb_ + (((2 * s + hi) ^ rsw) << 4)), k1_ = *(const LAS h16x8*)(kb_ + 4096 + (((2 * s + hi) ^ rsw) << 4)); \
            C0 = __builtin_amdgcn_mfma_f32_32x32x16_f16(k0_, qf[s], C0, 0, 0, 0); C1 = __builtin_amdgcn_mfma_f32_32x32x16_f16(k1_, qf[s], C1, 0, 0, 0); } } while (0)
#define MOBA_DECIDE(T, C0, C1) do { float m_ = __builtin_fmaxf(C0[0], C1[0]); \
        _Pragma("unroll") for (int i = 1; i < 16; ++i) m_ = __builtin_fmaxf(__builtin_fmaxf(m_, C0[i]), C1[i]); \
        m_ = xhalf_max(m_); \
        const int kp_ = j * 256 + 192 - 64 * (T); const bool fst_ = ((kp_ >> 8) == j) && (((kp_ >> 6) & 3) == wdiag); \
        if (fst_ || __any(m_ > MOBA_THR)) { const float dl_ = fst_ ? m_ : __builtin_fmaxf(m_, 0.f); const float f_ = fst_ ? 1.0f : __builtin_amdgcn_exp2f(-dl_); mref += dl_; lsum *= f_; \
            _Pragma("unroll") for (int i = 0; i < 16; ++i) { C0[i] -= dl_; C1[i] -= dl_; o0[i] *= f_; o1[i] *= f_; } } } while (0)
#define MOBA_STEP(T, TE, P0, P1, N0, N1) do { \
        if ((T) + 3 < (TE)) MOBA_DMA((T) + 3); \
        MOBA_CIN((T) + 1, N0, N1); MOBA_QK((T) + 1, N0, N1); \
        float ps_ = 0.f; \
        _Pragma("unroll") for (int i = 0; i < 16; ++i) { P0[i] = __builtin_amdgcn_exp2f(P0[i]); P1[i] = __builtin_amdgcn_exp2f(P1[i]); ps_ += P0[i] + P1[i]; } \
        lsum += ps_; \
        h16x8 pf_[4]; \
        _Pragma("unroll") for (int k = 0; k < 8; ++k) { pf_[0][k] = (h16)P0[k]; pf_[1][k] = (h16)P0[8 + k]; pf_[2][k] = (h16)P1[k]; pf_[3][k] = (h16)P1[8 + k]; } \
        { const LAS unsigned char* vb_ = lds + ((T) & 3) * 16384 + rV; \
          _Pragma("unroll") for (int t = 0; t < 4; ++t) { const h16x8 v0_ = tr_frag(vb_ + t * 1024), v1_ = tr_frag(vb_ + 4096 + t * 1024); \
            o0 = __builtin_amdgcn_mfma_f32_32x32x16_f16(v0_, pf_[t], o0, 0, 0, 0); o1 = __builtin_amdgcn_mfma_f32_32x32x16_f16(v1_, pf_[t], o1, 0, 0, 0); } } \
        if ((T) + 1 < (TE)) MOBA_DECIDE((T) + 1, N0, N1); \
        if ((T) + 3 < (TE)) MOBA_WAIT_BAR(2); else MOBA_WAIT_BAR(0); } while (0)
    f32x16 cA0, cA1, cB0, cB1;
    int te = nt;
    MOBA_WAIT_BAR(0);
    MOBA_DMA(0); MOBA_DMA(1); MOBA_DMA(2);
    MOBA_WAIT_BAR(2);
    MOBA_CIN(0, cA0, cA1); MOBA_QK(0, cA0, cA1); MOBA_DECIDE(0, cA0, cA1);
    MOBA_STEP(0, te, cA0, cA1, cB0, cB1); MOBA_STEP(1, te, cB0, cB1, cA0, cA1); MOBA_STEP(2, te, cA0, cA1, cB0, cB1);
    if (j > 0) {
        float marg = qbound - mref;
#pragma unroll
        for (int o = 1; o < 64; o <<= 1) marg = fmaxf(marg, __shfl_xor(marg, o));
        LAS float* xs = (LAS float*)(lds + 65536);
        if (lane == 0) xs[wid] = marg;
        MOBA_WAIT_BAR(2);
        float M = xs[0];
#pragma unroll
        for (int k = 1; k < 8; ++k) M = fmaxf(M, xs[k]);
        const float num = M + 50.0f - slope2;
        int cnt = (num >= 0.f) ? ((int)(num / (64.0f * slope2)) + 1) : 0;
        cnt = max(min(cnt, 4 * j), 2); cnt = (cnt + 1) & ~1;
        te = 4 + __builtin_amdgcn_readfirstlane(cnt);
    }
    MOBA_STEP(3, te, cB0, cB1, cA0, cA1);
#pragma unroll 1
    for (int tt = 4; tt < te; tt += 2) { MOBA_STEP(tt, te, cA0, cA1, cB0, cB1); MOBA_STEP(tt + 1, te, cB0, cB1, cA0, cA1); }
    MOBA_WAIT_BAR(0);
#undef MOBA_RUN
#undef MOBA_CIN
#undef MOBA_QK
#undef MOBA_DECIDE
#undef MOBA_STEP
#undef MOBA_DMA
#undef MOBA_WAIT_BAR
    {
        const float inv = 1.0f / xhalf_sum(lsum);
        const h16* gp = projb + (size_t)qrow * NIN + C_MGATE + hh * 64 + 4 * hi; h16* dst = mix + ((size_t)b * SEQ + qrow) * DM + 512 + hh * 64 + 4 * hi;
#pragma unroll
        for (int g = 0; g < 4; ++g) {
            const h16x4 ga = *(const h16x4*)(gp + 8 * g), gb = *(const h16x4*)(gp + 32 + 8 * g); h16x4 oa, ob;
#pragma unroll
            for (int k = 0; k < 4; ++k) { oa[k] = (h16)(o0[4 * g + k] * inv * silu_f((float)ga[k])); ob[k] = (h16)(o1[4 * g + k] * inv * silu_f((float)gb[k])); }
            *(h16x4*)(dst + 8 * g) = oa; *(h16x4*)(dst + 32 + 8 * g) = ob;
        }
    }
}

__device__ __forceinline__ void ret_scan_shares(const Params& p, int layer) {
    const float* kv = (const float*)(p.ws + WS_KV); h16* rst = (h16*)(p.ws + WS_RST);
    const int tid = threadIdx.x; unsigned done = 0u;
#pragma unroll 1
    for (int s = blockIdx.x; s < 256; s += gridDim.x) {
        const int bh = s >> 3, e = (s & 7) * 512 + tid, hh = bh & 3;
        const float gam = 1.0f - exp2f(-5.0f - (float)hh); const float g = expf(logf(gam) * 128.0f);
        const float* kvb = kv + (size_t)bh * 32 * 4096 + e; h16* rb = rst + (size_t)bh * 32 * 4096 + e;
        float r = 0.f; rb[0] = (h16)0.f;
#pragma unroll 1
        for (int m0 = 0; m0 < 31; m0 += 8) {
            float kvv[8];
#pragma unroll
            for (int k = 0; k < 8; ++k) kvv[k] = (m0 + k < 31) ? kvb[(size_t)(m0 + k) * 4096] : 0.f;
#pragma unroll
            for (int k = 0; k < 8; ++k) if (m0 + k < 31) { r = r * g + kvv[k]; rb[(size_t)(m0 + k + 1) * 4096] = (h16)(r * gam); }
        }
        ++done;
    }
    asm volatile("s_waitcnt vmcnt(0)" ::: "memory");
    __syncthreads();
    if (tid == 0) { __builtin_amdgcn_fence(__ATOMIC_RELEASE, "agent"); asm volatile("s_waitcnt vmcnt(0)" ::: "memory");
        __hip_atomic_fetch_add((unsigned*)(p.ws + WS_CTL + 16384) + 64 * layer, done, __ATOMIC_RELAXED, __HIP_MEMORY_SCOPE_AGENT); }
}
__device__ __forceinline__ void ret_scan_wait(const Params& p, int layer) {
    if (threadIdx.x == 0) {
        unsigned* c = (unsigned*)(p.ws + WS_CTL + 16384) + 64 * layer; unsigned sp = 0u;
        while (__hip_atomic_load(c, __ATOMIC_RELAXED, __HIP_MEMORY_SCOPE_AGENT) < 256u) { __builtin_amdgcn_s_sleep(2); if (++sp > (1u << 22)) break; }
        __builtin_amdgcn_fence(__ATOMIC_ACQUIRE, "agent"); asm volatile("s_waitcnt vmcnt(0)" ::: "memory");
    }
    __syncthreads();
}

__device__ __forceinline__ int queue_pop(unsigned* counter, LAS unsigned* slot) {
    __syncthreads();
    if (threadIdx.x == 0) slot[0] = __hip_atomic_fetch_add(counter, 1u, __ATOMIC_RELAXED, __HIP_MEMORY_SCOPE_AGENT);
    __syncthreads();
    return (int)slot[0];
}
__device__ __forceinline__ void phase_mixers(const Params& p, int layer, unsigned char* lds) {
    static constexpr unsigned char MOBA_ORDER[128] = {111,127,110,126,109,125,93,94,95,92,108,124,91,107,123,90,106,122,89,105,121,88,104,120,87,103,119,71,72,73,74,75,76,77,78,79,70,86,102,118,69,85,101,117,68,84,100,116,52,53,54,55,56,57,58,59,60,61,62,63,51,67,83,99,115,50,66,82,98,114,34,35,36,37,38,39,40,41,42,43,44,45,46,47,17,18,19,20,21,22,23,24,25,26,27,28,29,30,31,33,49,65,81,97,113,1,2,3,4,5,6,7,8,9,10,11,12,13,14,15,0,16,32,48,64,80,96,112};
    unsigned* qc = (unsigned*)(p.ws + WS_CTL + 24576) + layer * 256;
    LAS unsigned* slot = (LAS unsigned*)((LAS unsigned char*)lds + BAR_LDS_OFF + 16);
    ret_scan_shares(p, layer);
#define QUEUE_LOOP(CNT, N, BODY) do { int cur = queue_pop(CNT, slot); \
        _Pragma("unroll 1") while (cur < (N)) { unsigned nxt_ = 0u; if (threadIdx.x == 0) nxt_ = __hip_atomic_fetch_add(CNT, 1u, __ATOMIC_RELAXED, __HIP_MEMORY_SCOPE_AGENT); \
            { BODY; } \
            __syncthreads(); if (threadIdx.x == 0) slot[0] = nxt_; __syncthreads(); cur = (int)slot[0]; } } while (0)
    QUEUE_LOOP(qc, 1024, const int hj = MOBA_ORDER[cur >> 3]; moba_unit(p, layer, cur & 7, hj >> 4, hj & 15, lds));
    ret_scan_wait(p, layer);
    QUEUE_LOOP(qc + 64, 1024, ret_unit(p, cur >> 7, (cur >> 5) & 3, cur & 31, lds));
    QUEUE_LOOP(qc + 128, 512, conv_unit(p, layer, cur >> 6, cur & 63, lds));
#undef QUEUE_LOOP
}

__device__ __forceinline__ void phase_final(const Params& p) {
    const float* rowss = (const float*)(p.ws + WS_ROWSS);
    const int lane = threadIdx.x & 63, wid = threadIdx.x >> 6;
    f32x4 g[4];
#pragma unroll
    for (int j = 0; j < 4; ++j) g[j] = *((const f32x4*)p.final_g + lane + 64 * j);
    for (int row = blockIdx.x * 8 + wid; row < MROWS; row += gridDim.x * 8) {
        const f32x4* rs = (const f32x4*)(rowss + (size_t)row * NPART); const f32x4 s0 = rs[0], s1 = rs[1], s2 = rs[2], s3 = rs[3];
        const float tot = ((s0[0] + s0[1]) + (s0[2] + s0[3])) + ((s1[0] + s1[1]) + (s1[2] + s1[3])) + ((s2[0] + s2[1]) + (s2[2] + s2[3])) + ((s3[0] + s3[1]) + (s3[2] + s3[3]));
        const float rstd = rsqrtf(tot * (1.0f / DM) + 1e-6f);
        f32x4* xr = (f32x4*)(p.out + (size_t)row * DM) + lane;
#pragma unroll
        for (int j = 0; j < 4; ++j) { f32x4 v = xr[64 * j]; v = v * rstd * g[j]; xr[64 * j] = v; }
    }
}

#define XB_TMO      128
#define XB_XCNT(j)  (256  + 64 * (j))
#define XB_XSUB(j)  (1280 + 64 * (j))
#define XB_XGEN(j)  (2304 + 64 * (j))
#define XB_TOP      3328
#define XB_TOPGEN   3392
#define XCD_BAR_WORDS 3456
#define XB_SPIN_CAP (1u << 18)

__device__ __forceinline__ unsigned xb_ld(unsigned* p)              { return __hip_atomic_load(p, __ATOMIC_RELAXED, __HIP_MEMORY_SCOPE_AGENT); }
__device__ __forceinline__ unsigned xb_add(unsigned* p, unsigned v) { return __hip_atomic_fetch_add(p, v, __ATOMIC_RELAXED, __HIP_MEMORY_SCOPE_AGENT); }
__device__ __forceinline__ unsigned xb_xcc_id() { return (unsigned)__builtin_amdgcn_s_getreg((3 << 11) | 20) & 0xFu; }
#define XB_SPIN(cond, bar) do { unsigned _sp = 0; while (cond) { __builtin_amdgcn_s_sleep(1); \
    if ((++_sp & 255u) == 0u) { if (xb_ld(&(bar)[XB_TMO])) break; if (_sp > XB_SPIN_CAP) { atomicAdd(&(bar)[XB_TMO], 1u); break; } } } } while (0)

struct XcdBarrier {
    unsigned* bar; unsigned x;
    volatile LAS unsigned* st;
};

__device__ __forceinline__ XcdBarrier xcd_barrier_post(unsigned* bar, volatile LAS unsigned* st) {
    XcdBarrier b; b.bar = bar; b.x = xb_xcc_id(); b.st = st;
    if (threadIdx.x == 0) (void)xb_add(&bar[XB_XCNT(b.x)], 1u);
    return b;
}
__device__ __forceinline__ void xcd_barrier_complete(unsigned* bar, unsigned x, unsigned& nloc, unsigned& nx) {
    const unsigned G = gridDim.x * gridDim.y * gridDim.z;
    unsigned sum, cnt, mine, sp = 0u;
    for (;;) {
        sum = 0u; cnt = 0u; mine = 0u;
#pragma unroll
        for (unsigned j = 0; j < 16; ++j) { const unsigned c = xb_ld(&bar[XB_XCNT(j)]); sum += c; cnt += (c > 0u) ? 1u : 0u; mine = (j == x) ? c : mine; }
        if (sum == G) break;
        __builtin_amdgcn_s_sleep(1);
        if ((++sp & 255u) == 0u) { if (xb_ld(&bar[XB_TMO])) break; if (sp > XB_SPIN_CAP) { atomicAdd(&bar[XB_TMO], 1u); break; } }
    }
    nloc = mine > 0u ? mine : 1u; nx = cnt > 0u ? cnt : 1u;
}

__device__ __forceinline__ void xcd_barrier(const XcdBarrier& b) {
    asm volatile("s_waitcnt vmcnt(0)" ::: "memory");
    __syncthreads();
    if (threadIdx.x == 0) {
        unsigned* bar = b.bar;
        __builtin_amdgcn_s_waitcnt(0);
        unsigned nloc = b.st[0], nx = b.st[1];
        if (nloc == 0u) { xcd_barrier_complete(bar, b.x, nloc, nx); b.st[0] = nloc; b.st[1] = nx; }
        const unsigned old = xb_add(&bar[XB_XSUB(b.x)], 1u);
        const unsigned gen = old / nloc;
        if (old + 1u == (gen + 1u) * nloc) {
            __builtin_amdgcn_fence(__ATOMIC_RELEASE, "agent");
            asm volatile("s_waitcnt vmcnt(0)" ::: "memory");
            const unsigned og = xb_add(&bar[XB_TOP], 1u);
            const unsigned tg = og / nx;
            if (og + 1u == (tg + 1u) * nx) xb_add(&bar[XB_TOPGEN], 1u);
            else XB_SPIN(xb_ld(&bar[XB_TOPGEN]) == tg, bar);
            __builtin_amdgcn_fence(__ATOMIC_ACQUIRE, "agent");
            xb_add(&bar[XB_XGEN(b.x)], 1u);
            asm volatile("s_waitcnt vmcnt(0)" ::: "memory");
        } else {
            XB_SPIN(xb_ld(&bar[XB_XGEN(b.x)]) == gen, bar);
            __builtin_amdgcn_fence(__ATOMIC_ACQUIRE, "agent");
            asm volatile("s_waitcnt vmcnt(0)" ::: "memory");
        }
    }
    __syncthreads();
}


__global__ void __launch_bounds__(NTHREADS) hymba_fwd(Params p) {
    extern __shared__ __attribute__((aligned(16))) unsigned char lds[];
    cg::grid_group grid = cg::this_grid();
    volatile LAS unsigned* bst = (volatile LAS unsigned*)((LAS unsigned char*)lds + BAR_LDS_OFF);
    if (threadIdx.x < 2) bst[threadIdx.x] = 0u;
    __syncthreads();
    XcdBarrier xbar = xcd_barrier_post((unsigned*)(p.ws + WS_CTL), bst);
#define RUN_PHASE(k, body) do { if (p.ph_lo <= (k) && (k) < p.ph_hi) { body; if ((k) + 1 < p.ph_hi) { xcd_barrier(xbar); } } } while (0)
    RUN_PHASE(0, phase_prologue(p, lds));
    RUN_PHASE(1, gemm_in(p, 0, lds));
    RUN_PHASE(2, phase_stats(p, 0, lds));
    RUN_PHASE(3, phase_mixers(p, 0, lds));
    RUN_PHASE(4, gemm_out<0>(p, lds));
    RUN_PHASE(5, gemm_in(p, 1, lds));
    RUN_PHASE(6, phase_stats(p, 1, lds));
    RUN_PHASE(7, phase_mixers(p, 1, lds));
    RUN_PHASE(8, gemm_out<1>(p, lds));
    RUN_PHASE(9, phase_final(p));
#undef RUN_PHASE
}

extern "C" void kernel_launch(void* const* d_in, const int* in_sizes, int n_in, void* d_out, int out_size, void* d_ws, size_t ws_size, hipStream_t stream) {
    static int grid_blocks = 0;
    if (!grid_blocks) {
        int dev = 0, cus = 0, per_cu = 0;
        hipGetDevice(&dev);
        hipDeviceGetAttribute(&cus, hipDeviceAttributeMultiprocessorCount, dev);
        hipFuncSetAttribute((const void*)hymba_fwd, hipFuncAttributeMaxDynamicSharedMemorySize, LDS_BYTES);
        hipOccupancyMaxActiveBlocksPerMultiprocessor(&per_cu, (const void*)hymba_fwd, NTHREADS, LDS_BYTES);
        if (per_cu < 1) per_cu = 1;
        grid_blocks = cus * per_cu;
        if (ws_size < WS_END) fprintf(stderr, "kernel_launch: workspace too small (%zu < %zu)\n", ws_size, (size_t)WS_END);
    }
    Params p{};
    p.x = (const float*)d_in[0]; p.norm_g = (const float*)d_in[1]; p.w_in = (const float*)d_in[2]; p.conv_w = (const float*)d_in[3]; p.conv_b = (const float*)d_in[4];
    p.ln_g = (const float*)d_in[5]; p.ln_b = (const float*)d_in[6]; p.pw_w = (const float*)d_in[7]; p.pw_b = (const float*)d_in[8]; p.w_out = (const float*)d_in[9];
    p.final_g = (const float*)d_in[10]; p.out = (float*)d_out; p.ws = (unsigned char*)d_ws;
    (void)hipMemsetAsync((char*)d_ws + WS_CTL, 0, 32768, stream);
#if ONE_LAUNCH
    p.ph_lo = 0; p.ph_hi = NPHASES;
    { void* args[] = {&p};
      hipError_t e = hipLaunchCooperativeKernel((const void*)hymba_fwd, dim3(grid_blocks), dim3(NTHREADS), args, LDS_BYTES, stream);
      if (e != hipSuccess) fprintf(stderr, "cooperative launch failed: %s (grid %d)\n", hipGetErrorString(e), grid_blocks); }
#else
    for (int ph = 0; ph < NPHASES; ++ph) {
        p.ph_lo = ph; p.ph_hi = ph + 1; void* args[] = {&p};
        hipError_t e = hipLaunchCooperativeKernel((const void*)hymba_fwd, dim3(grid_blocks), dim3(NTHREADS), args, LDS_BYTES, stream);
        if (e != hipSuccess) { fprintf(stderr, "cooperative launch failed: %s (grid %d, phase %d)\n", hipGetErrorString(e), grid_blocks, ph); break; }
    }
#endif
}
```

```cpp
#include <hip/hip_runtime.h>
#include <hip/hip_cooperative_groups.h>
#include <cstdio>
#include <cstdint>
namespace cg = cooperative_groups;

#ifndef ONE_LAUNCH
#define ONE_LAUNCH 1
#endif

typedef _Float16 h16;
typedef _Float16 h16x8 __attribute__((ext_vector_type(8)));
typedef _Float16 h16x4 __attribute__((ext_vector_type(4)));
typedef float f32x16 __attribute__((ext_vector_type(16)));
typedef float f32x4 __attribute__((ext_vector_type(4)));
typedef unsigned u32x4 __attribute__((ext_vector_type(4)));

constexpr int BATCH = 8, SEQ = 4096, DM = 1024, MROWS = BATCH * SEQ, NIN = 3840, DEPTH = 2;
constexpr int C_AVAL = 0, C_AGLU = 256, C_AGATE = 512, C_RQ = 768, C_RK = 1024, C_RV = 1280, C_RGATE = 1536, C_MQ = 1792, C_MK = 2304, C_MV = 2816, C_MGATE = 3328;
constexpr int NPART = 16;
constexpr int NTHREADS = 512;
constexpr int LDS_BYTES = 147456;
constexpr int NPHASES = 8;

constexpr size_t MiB = 1u << 20;
constexpr size_t WS_XH = 0, WS_PROJ = 64 * MiB, WS_MIX = 304 * MiB, WS_WIN = 368 * MiB, WS_WOUT = 383 * MiB, WS_WPW = 387 * MiB,
                 WS_KV = 388 * MiB, WS_KMEAN = 404 * MiB  , WS_ROWSS = 405 * MiB, WS_CTL = 408 * MiB  , WS_RST = 409 * MiB  , WS_END = 417 * MiB;
constexpr int BAR_LDS_OFF = LDS_BYTES - 64;

struct Params {
    const float *x, *norm_g, *w_in, *conv_w, *conv_b, *ln_g, *ln_b, *pw_w, *pw_b, *w_out, *final_g;
    float* out; unsigned char* ws;
    int ph_lo, ph_hi;
};

__device__ __forceinline__ float silu_f(float v) { return v * __builtin_amdgcn_rcpf(1.0f + __expf(-v)); }
__device__ __forceinline__ int crow(int r, int h) { return (r & 3) + 8 * (r >> 2) + 4 * h; }
__device__ __forceinline__ float wave_sum(float v) {
#pragma unroll
    for (int o = 1; o < 64; o <<= 1) v += __shfl_xor(v, o);
    return v;
}

__device__ __forceinline__ void transpose_unit(const float* W, int K, int N, h16* WT, const float* g, int k0, int n0, float* tile) {
    const int tid = threadIdx.x;
    __syncthreads();
#pragma unroll
    for (int i = 0; i < 8; ++i) { const int k = i * 8 + (tid >> 6), n = tid & 63; float v = W[(size_t)(k0 + k) * N + n0 + n]; if (g) v *= g[k0 + k]; tile[k * 65 + n] = v; }
    __syncthreads();
    { const int n = tid >> 3, kc = tid & 7; h16x8 w;
#pragma unroll
        for (int i = 0; i < 8; ++i) w[i] = (h16)tile[(kc * 8 + i) * 65 + n];
        *(h16x8*)(WT + (size_t)(n0 + n) * K + k0 + kc * 8) = w; }
}

__device__ __forceinline__ void phase_prologue(const Params& p, unsigned char* lds) {
    float* tile = (float*)lds;
    h16* win = (h16*)(p.ws + WS_WIN);
    constexpr int U_IN = 16 * 60;
    for (int r = blockIdx.x; r < U_IN; r += gridDim.x)
        transpose_unit(p.w_in, DM, NIN, win, p.norm_g, (r / 60) * 64, (r % 60) * 64, tile);
    h16* xh = (h16*)(p.ws + WS_XH); float* rowss = (float*)(p.ws + WS_ROWSS);
    const int lane = threadIdx.x & 63, wid = threadIdx.x >> 6;
    for (int row = blockIdx.x * 8 + wid; row < MROWS; row += gridDim.x * 8) {
        const f32x4* xr = (const f32x4*)(p.x + (size_t)row * DM) + lane;
        float ss = 0.f;
#pragma unroll
        for (int j = 0; j < 4; ++j) { const f32x4 v = xr[64 * j]; ss += v.x * v.x + v.y * v.y + v.z * v.z + v.w * v.w;
            h16x4 o; o.x = (h16)v.x; o.y = (h16)v.y; o.z = (h16)v.z; o.w = (h16)v.w; *((h16x4*)(xh + (size_t)row * DM) + lane + 64 * j) = o; }
        ss = wave_sum(ss);
        if (lane < NPART) rowss[(size_t)row * NPART + lane] = (lane == 0) ? ss : 0.f;
    }
}

typedef short s16x4 __attribute__((ext_vector_type(4)));
#define LAS __attribute__((address_space(3)))
__device__ __forceinline__ float xhalf_max(float v) { auto rr = __builtin_amdgcn_permlane32_swap(__float_as_uint(v), __float_as_uint(v), false, false); return fmaxf(__uint_as_float(rr[0]), __uint_as_float(rr[1])); }
__device__ __forceinline__ float xhalf_sum(float v) { auto rr = __builtin_amdgcn_permlane32_swap(__float_as_uint(v), __float_as_uint(v), false, false); return __uint_as_float(rr[0]) + __uint_as_float(rr[1]); }
__device__ __forceinline__ h16x8 tr_frag(const LAS unsigned char* a) {
    const s16x4 lo = __builtin_amdgcn_ds_read_tr16_b64_v4i16((LAS s16x4*)a), hi = __builtin_amdgcn_ds_read_tr16_b64_v4i16((LAS s16x4*)(a + 512));
    typedef short s16x8 __attribute__((ext_vector_type(8)));
    const s16x8 v = __builtin_shufflevector(lo, hi, 0, 1, 2, 3, 4, 5, 6, 7);
    return __builtin_bit_cast(h16x8, v);
}
#define CROW0(i) (((i) & 3) + 8 * ((i) >> 2))
__device__ __forceinline__ void glds16(const void* gsrc, unsigned lds_dst) { unsigned keep;
    asm volatile("s_mov_b32 %0, m0\n\ts_mov_b32 m0, %2\n\ts_nop 0\n\tglobal_load_lds_dwordx4 %1, off\n\ts_mov_b32 m0, %0" : "=&s"(keep) : "v"(gsrc), "s"(lds_dst) : "memory"); }

namespace pg8 {
#define PG8_LAS __attribute__((address_space(3)))
typedef _Float16 bf16_t;
typedef _Float16 bf16x8 __attribute__((ext_vector_type(8)));
typedef float f32x4 __attribute__((ext_vector_type(4)));
typedef unsigned u32x4 __attribute__((ext_vector_type(4)));
constexpr int BM = 256, BK = 64, HALF = 128, HTB = HALF * BK * 2  , STAGE_BYTES = 8 * HTB, NXCD = 8, WGM = 8;

__host__ __device__ __forceinline__ int lds_byte(int r, int c) { const int st = (r >> 4) * 2 + (c >> 5), rr = r & 15, cc = c & 31, ob = rr * 64 + cc * 2; return st * 1024 + (ob ^ (((ob >> 9) & 1) << 5)); }
__host__ __device__ __forceinline__ void stage_rc(int b, int& R, int& C) { const int st = b / 1024, sb = b % 1024, swz = sb ^ (((sb >> 9) & 1) << 5); R = (st >> 1) * 16 + swz / 64; C = (st & 1) * 32 + (swz % 64) / 2; }
__host__ __device__ __forceinline__ int perm32(int rho) { const int n = rho >> 4, i = rho & 15; return 8 * (i >> 2) + 4 * n + (i & 3); }

struct Unit { int pm, pn; };
struct Gemm { const bf16_t* A; const bf16_t* Bt; int M, N, K; };

struct StaticOrder {
    int nM, nN, nwg, G, c;
    __host__ __device__ void init(int M, int N, int G_, int c_) { nM = M / BM; nN = N / BM; nwg = nM * nN; G = G_; c = c_; }
    __host__ __device__ bool next(int i, Unit& u) const {
        const long L = (long)i * G + c; if (L >= nwg) return false;
        int wgid = (int)L; { const int q = nwg / NXCD, r = nwg % NXCD, xcd = wgid % NXCD, off = wgid / NXCD; wgid = (xcd < r ? xcd * (q + 1) : r * (q + 1) + (xcd - r) * q) + off; }
        const int nig = WGM * nN, gid = wgid / nig, fm = gid * WGM, gsz = (nM - fm) < WGM ? (nM - fm) : WGM;
        u.pm = fm + ((wgid % nig) % gsz); u.pn = (wgid % nig) / gsz; return true;
    }
    __device__ __forceinline__ void a_ready(const Unit&) const {}
    __device__ __forceinline__ void done(const Unit&) const {}
};

template <class Epi, class Sched, bool ALIGN_EPI = false, bool SP2 = false>
__device__ __forceinline__ void gemm_phase(PG8_LAS unsigned char* lds, const Gemm g, const Sched& S, const Epi& E) {
    const int tid = threadIdx.x, wid = __builtin_amdgcn_readfirstlane(tid >> 6), lane = tid & 63, wr = wid >> 2, wc = wid & 3, fr = lane & 15, fq = lane >> 4;
    const int K = g.K, nt = K / BK;
    unsigned voffA[2], voffB[2];
#pragma unroll
    for (int i = 0; i < 2; ++i) { int R, C; stage_rc(tid * 16 + i * 8192, R, C); const int Rb = Epi::PERM ? ((R & ~31) + perm32(R & 31)) : R;
        voffA[i] = (unsigned)(R * K + C) * 2u; voffB[i] = (unsigned)(Rb * K + C) * 2u; }
    const size_t kstep = (size_t)(BK * 2);
    const size_t hstep = (size_t)HALF * K * 2;
    const size_t tstep = 2 * hstep;
    const unsigned ldsw = (unsigned)wid * 1024u;
    const int aoff = lds_byte(wr * 64 + fr, fq * 8), boff = lds_byte(wc * 32 + fr, fq * 8);
#define PG8_SA(b, h) (((b) * 2 + (h)) * HTB)
#define PG8_SB(b, h) ((4 + (b) * 2 + (h)) * HTB)
#define PG8_STAGE(bufoff, gbase, voff) do { _Pragma("unroll") for (int _i = 0; _i < 2; ++_i) \
        __builtin_amdgcn_global_load_lds((const unsigned*)((const char*)(gbase) + (voff)[_i]), (PG8_LAS unsigned*)(lds + (bufoff) + ldsw + _i * 8192), 16, 0, 0); } while (0)
#define PG8_LDA(dst, b, h) do { _Pragma("unroll") for (int m = 0; m < 4; ++m) _Pragma("unroll") for (int k = 0; k < 2; ++k) dst[m][k] = *(const PG8_LAS bf16x8*)(lds + PG8_SA(b, h) + aoff + m * 2048 + k * 1024); } while (0)
#define PG8_LDB(dst, b, h) do { _Pragma("unroll") for (int n = 0; n < 2; ++n) _Pragma("unroll") for (int k = 0; k < 2; ++k) dst[n][k] = *(const PG8_LAS bf16x8*)(lds + PG8_SB(b, h) + boff + n * 2048 + k * 1024); } while (0)
#define PG8_MMA(ai, bj, At, Bt) do { __builtin_amdgcn_s_setprio(1); _Pragma("unroll") for (int m = 0; m < 4; ++m) _Pragma("unroll") for (int n = 0; n < 2; ++n) _Pragma("unroll") for (int k = 0; k < 2; ++k) \
        acc[ai][bj][m][n] = __builtin_amdgcn_mfma_f32_16x16x32_f16(Bt[n][k], At[m][k], acc[ai][bj][m][n], 0, 0, 0); __builtin_amdgcn_s_setprio(0); } while (0)
#define PG8_WAIT_V(n) asm volatile("s_waitcnt vmcnt(" #n ")" ::: "memory")
#define PG8_WAIT_L(n) asm volatile("s_waitcnt lgkmcnt(" #n ")" ::: "memory")
#define PG8_BAR __builtin_amdgcn_s_barrier()
#define PG8_SCHED __builtin_amdgcn_sched_barrier(0)
    Unit cur, nxt; int ui = 0;
    if (!S.next(0, cur)) return;
    f32x4 acc[2][2][4][2];
#pragma unroll
    for (int a = 0; a < 2; ++a)
#pragma unroll
        for (int b = 0; b < 2; ++b)
#pragma unroll
            for (int m = 0; m < 4; ++m)
#pragma unroll
                for (int n = 0; n < 2; ++n) acc[a][b][m][n] = (f32x4){0.f, 0.f, 0.f, 0.f};
    bf16x8 At[4][2], B0[2][2], B1[2][2];
    const char* cA = (const char*)g.A + (size_t)cur.pm * tstep; const char* cB = (const char*)g.Bt + (size_t)cur.pn * tstep;
    S.a_ready(cur);
    if constexpr (SP2) {
        PG8_STAGE(PG8_SB(0, 0), cB, voffB); PG8_STAGE(PG8_SB(0, 1), cB + hstep, voffB); PG8_STAGE(PG8_SA(0, 0), cA, voffA); PG8_STAGE(PG8_SA(0, 1), cA + hstep, voffA);
        if (wr == 1) PG8_BAR;
        PG8_WAIT_V(2); PG8_BAR;
        PG8_STAGE(PG8_SB(1, 0), cB + kstep, voffB); PG8_STAGE(PG8_SA(1, 0), cA + kstep, voffA); PG8_STAGE(PG8_SB(1, 1), cB + hstep + kstep, voffB);
        PG8_WAIT_V(6); PG8_BAR;
    } else {
        PG8_STAGE(PG8_SB(0, 0), cB, voffB); PG8_STAGE(PG8_SA(0, 0), cA, voffA); PG8_STAGE(PG8_SB(0, 1), cB + hstep, voffB); PG8_STAGE(PG8_SA(0, 1), cA + hstep, voffA);
        if (wr == 1) PG8_BAR;
        PG8_WAIT_V(4); PG8_BAR;
        PG8_STAGE(PG8_SB(1, 0), cB + kstep, voffB); PG8_STAGE(PG8_SA(1, 0), cA + kstep, voffA); PG8_STAGE(PG8_SB(1, 1), cB + hstep + kstep, voffB);
        PG8_WAIT_V(6); PG8_BAR;
    }
    for (;;) {
        const bool has_next = S.next(ui + 1, nxt);
        const char* nA = has_next ? (const char*)g.A + (size_t)nxt.pm * tstep : cA; const char* nB = has_next ? (const char*)g.Bt + (size_t)nxt.pn * tstep : cB;
        for (int t = 0; t < nt; t += 2) {
            const bool last = (t == nt - 2);
            const char* a1 = cA + (size_t)(t + 1) * kstep;
            const char* a2 = last ? nA : cA + (size_t)(t + 2) * kstep; const char* b2 = last ? nB : cB + (size_t)(t + 2) * kstep;
            const char* a3 = a2 + kstep; const char* b3 = b2 + kstep;
            if (last && has_next) S.a_ready(nxt);
            if constexpr (SP2) {
            PG8_LDB(B0, 0, 0); PG8_LDB(B1, 0, 1); PG8_SCHED; PG8_LDA(At, 0, 0); PG8_STAGE(PG8_SA(1, 1), a1 + hstep, voffA);
            PG8_WAIT_V(8); PG8_WAIT_L(0); PG8_BAR; PG8_MMA(0, 0, At, B0); PG8_MMA(0, 1, At, B1); PG8_BAR; PG8_SCHED;
            PG8_LDA(At, 0, 1); PG8_STAGE(PG8_SB(0, 0), b2, voffB); PG8_STAGE(PG8_SB(0, 1), b2 + hstep, voffB); PG8_STAGE(PG8_SA(0, 0), a2, voffA);
            PG8_WAIT_V(8); PG8_WAIT_L(0); PG8_BAR; PG8_MMA(1, 0, At, B0); PG8_MMA(1, 1, At, B1); PG8_BAR; PG8_SCHED;
            PG8_LDB(B0, 1, 0); PG8_LDB(B1, 1, 1); PG8_SCHED; PG8_LDA(At, 1, 0); PG8_STAGE(PG8_SA(0, 1), a2 + hstep, voffA);
            PG8_WAIT_V(8); PG8_WAIT_L(0); PG8_BAR; PG8_MMA(0, 0, At, B0); PG8_MMA(0, 1, At, B1); PG8_BAR; PG8_SCHED;
            PG8_LDA(At, 1, 1); PG8_STAGE(PG8_SB(1, 0), b3, voffB); PG8_STAGE(PG8_SB(1, 1), b3 + hstep, voffB); PG8_STAGE(PG8_SA(1, 0), a3, voffA);
            PG8_WAIT_V(8); PG8_WAIT_L(0); PG8_BAR; PG8_MMA(1, 0, At, B0); PG8_MMA(1, 1, At, B1); PG8_BAR; PG8_SCHED;
            } else {
            PG8_LDB(B0, 0, 0); PG8_SCHED; PG8_LDA(At, 0, 0); PG8_STAGE(PG8_SA(1, 1), a1 + hstep, voffA);
            PG8_WAIT_L(8); PG8_BAR; PG8_WAIT_L(0); PG8_MMA(0, 0, At, B0); PG8_BAR; PG8_SCHED;
            PG8_LDB(B1, 0, 1); PG8_STAGE(PG8_SB(0, 0), b2, voffB);
            PG8_BAR; PG8_WAIT_L(0); PG8_MMA(0, 1, At, B1); PG8_BAR;
            PG8_LDA(At, 0, 1); PG8_STAGE(PG8_SA(0, 0), a2, voffA);
            PG8_BAR; PG8_WAIT_L(0); PG8_MMA(1, 0, At, B0); PG8_BAR; PG8_SCHED;
            PG8_STAGE(PG8_SB(0, 1), b2 + hstep, voffB);
            PG8_WAIT_V(6); PG8_BAR; PG8_MMA(1, 1, At, B1); PG8_BAR;
            PG8_LDB(B0, 1, 0); PG8_SCHED; PG8_LDA(At, 1, 0); PG8_STAGE(PG8_SA(0, 1), a2 + hstep, voffA);
            PG8_WAIT_L(8); PG8_BAR; PG8_WAIT_L(0); PG8_MMA(0, 0, At, B0); PG8_BAR; PG8_SCHED;
            PG8_LDB(B1, 1, 1); PG8_STAGE(PG8_SB(1, 0), b3, voffB);
            PG8_BAR; PG8_WAIT_L(0); PG8_MMA(0, 1, At, B1); PG8_BAR;
            PG8_LDA(At, 1, 1); PG8_STAGE(PG8_SA(1, 0), a3, voffA);
            PG8_BAR; PG8_WAIT_L(0); PG8_MMA(1, 0, At, B0); PG8_BAR; PG8_SCHED;
            PG8_STAGE(PG8_SB(1, 1), b3 + hstep, voffB);
            PG8_WAIT_V(6); PG8_BAR; PG8_MMA(1, 1, At, B1); PG8_BAR;
            }
        }
        if constexpr (ALIGN_EPI) { if (wr == 0) PG8_BAR; }
        if constexpr (!Epi::AFTER_DRAIN) { E(acc, cur, wr, wc, fr, fq); S.done(cur); }
        if (!has_next) break;
#pragma unroll
        for (int a = 0; a < 2; ++a)
#pragma unroll
            for (int b = 0; b < 2; ++b)
#pragma unroll
                for (int m = 0; m < 4; ++m)
#pragma unroll
                    for (int n = 0; n < 2; ++n) acc[a][b][m][n] = (f32x4){0.f, 0.f, 0.f, 0.f};
        cur = nxt; cA = nA; cB = nB; ++ui;
        if constexpr (ALIGN_EPI) { if (wr == 1) PG8_BAR; }
    }
    PG8_WAIT_V(0);
    if constexpr (!ALIGN_EPI) { if (wr == 0) PG8_BAR; }
    PG8_BAR;
    if constexpr (Epi::AFTER_DRAIN) { E.fused(acc, cur, wr, wc, fr, fq, lds, wid, lane); S.done(cur); }
#undef PG8_SA
#undef PG8_SB
#undef PG8_STAGE
#undef PG8_LDA
#undef PG8_LDB
#undef PG8_MMA
#undef PG8_WAIT_V
#undef PG8_WAIT_L
#undef PG8_BAR
#undef PG8_SCHED
}

struct EpiProj {
    static constexpr bool PERM = true, AFTER_DRAIN = false;
    bf16_t* O; const float* rowss; float* kmpart;
    __device__ __forceinline__ void operator()(const f32x4 (&acc)[2][2][4][2], const Unit& u, int wr, int wc, int fr, int fq) const {
        const int row0 = u.pm * BM + wr * 64 + fr, col0 = u.pn * BM + wc * 32 + 8 * fq;
        const bool want_km = (u.pn == 9) || (u.pn == 10);
        f32x4 cs[2][2];
#pragma unroll
        for (int bj = 0; bj < 2; ++bj)
#pragma unroll
            for (int n = 0; n < 2; ++n) cs[bj][n] = (f32x4){0.f, 0.f, 0.f, 0.f};
#pragma unroll
        for (int ai = 0; ai < 2; ++ai)
#pragma unroll
            for (int m = 0; m < 4; ++m) { const size_t row = (size_t)(row0 + ai * HALF + m * 16);
                const f32x4* rs = (const f32x4*)(rowss + row * 16); const f32x4 s0 = rs[0], s1 = rs[1], s2 = rs[2], s3 = rs[3];
                const float tot = ((s0[0] + s0[1]) + (s0[2] + s0[3])) + ((s1[0] + s1[1]) + (s1[2] + s1[3])) + ((s2[0] + s2[1]) + (s2[2] + s2[3])) + ((s3[0] + s3[1]) + (s3[2] + s3[3]));
                const float rstd = rsqrtf(tot * (1.0f / 1024.0f) + 1e-6f);
                bf16_t* rowp = O + row * 3840 + col0;
#pragma unroll
                for (int bj = 0; bj < 2; ++bj) { const f32x4 v0 = acc[ai][bj][m][0] * rstd, v1 = acc[ai][bj][m][1] * rstd; bf16x8 w;
                    w[0] = (bf16_t)v0[0]; w[1] = (bf16_t)v0[1]; w[2] = (bf16_t)v0[2]; w[3] = (bf16_t)v0[3]; w[4] = (bf16_t)v1[0]; w[5] = (bf16_t)v1[1]; w[6] = (bf16_t)v1[2]; w[7] = (bf16_t)v1[3];
                    *(bf16x8*)(rowp + bj * HALF) = w; cs[bj][0] += v0; cs[bj][1] += v1; } }
        if (want_km) {
#pragma unroll
            for (int bj = 0; bj < 2; ++bj)
#pragma unroll
                for (int n = 0; n < 2; ++n)
#pragma unroll
                    for (int k = 0; k < 4; ++k) { float v = cs[bj][n][k]; v += __shfl_xor(v, 1); v += __shfl_xor(v, 2); v += __shfl_xor(v, 4); v += __shfl_xor(v, 8); cs[bj][n][k] = v * (1.0f / 256.0f); }
            if (fr == 0) {
#pragma unroll
                for (int bj = 0; bj < 2; ++bj)
#pragma unroll
                    for (int n = 0; n < 2; ++n) { const int cm = col0 + bj * HALF + 4 * n - 2304;
                        *(f32x4*)(kmpart + ((size_t)((wr * 8 + (u.pm >> 4)) * 8 + (cm >> 6)) * 16 + (u.pm & 15)) * 64 + (cm & 63)) = cs[bj][n]; }
            }
        }
    }
};
template <int LAYER> struct EpiRes {
    static constexpr bool PERM = true, AFTER_DRAIN = false;
    const float* x0; float* xout; bf16_t* xh; float* rowss;
    __device__ __forceinline__ void operator()(const f32x4 (&acc)[2][2][4][2], const Unit& u, int wr, int wc, int fr, int fq) const {
        const int row0 = u.pm * BM + wr * 64 + fr, col0 = u.pn * BM + wc * 32 + 8 * fq;
#pragma unroll
        for (int ai = 0; ai < 2; ++ai)
#pragma unroll
            for (int m = 0; m < 4; ++m) { const size_t row = (size_t)(row0 + ai * HALF + m * 16); float ss = 0.f;
#pragma unroll
                for (int bj = 0; bj < 2; ++bj) { const size_t off = row * 1024 + col0 + bj * HALF; f32x4 v0, v1;
                    if (LAYER == 0) { v0 = *(const f32x4*)(x0 + off) + acc[ai][bj][m][0]; v1 = *(const f32x4*)(x0 + off + 4) + acc[ai][bj][m][1];
                        bf16x8 w; w[0] = (bf16_t)v0[0]; w[1] = (bf16_t)v0[1]; w[2] = (bf16_t)v0[2]; w[3] = (bf16_t)v0[3]; w[4] = (bf16_t)v1[0]; w[5] = (bf16_t)v1[1]; w[6] = (bf16_t)v1[2]; w[7] = (bf16_t)v1[3];
                        *(bf16x8*)(xh + off) = w; }
                    else { const bf16x8 xp = *(const bf16x8*)(xh + off);
                        v0 = (f32x4){(float)xp[0], (float)xp[1], (float)xp[2], (float)xp[3]} + acc[ai][bj][m][0]; v1 = (f32x4){(float)xp[4], (float)xp[5], (float)xp[6], (float)xp[7]} + acc[ai][bj][m][1];
                        *(f32x4*)(xout + off) = v0; *(f32x4*)(xout + off + 4) = v1; }
                    ss += ((v0[0] * v0[0] + v0[1] * v0[1]) + (v0[2] * v0[2] + v0[3] * v0[3])) + ((v1[0] * v1[0] + v1[1] * v1[1]) + (v1[2] * v1[2] + v1[3] * v1[3])); }
                ss += __shfl_xor(ss, 16); ss += __shfl_xor(ss, 32);
                if (fq == 0) rowss[row * 16 + u.pn * 4 + wc] = ss; }
    }
};
}


__device__ __forceinline__ void deferred_transposes(const Params& p, unsigned char* lds, int id, int n) {
    float* tile = (float*)lds;
    h16* win = (h16*)(p.ws + WS_WIN); h16* wout = (h16*)(p.ws + WS_WOUT); h16* wpw = (h16*)(p.ws + WS_WPW);
    constexpr int U_IN = 16 * 60, U_OUT = 16 * 16, U_PW = 4 * 4;
    for (int u = id; u < U_IN + 2 * U_OUT + 2 * U_PW; u += n) {
        int r = u;
        if (r < U_IN) { transpose_unit(p.w_in + (size_t)DM * NIN, DM, NIN, win + (size_t)NIN * DM, p.norm_g + DM, (r / 60) * 64, (r % 60) * 64, tile); continue; }
        r -= U_IN;
        if (r < 2 * U_OUT) { const int layer = r / U_OUT; r %= U_OUT; transpose_unit(p.w_out + (size_t)layer * DM * DM, DM, DM, wout + (size_t)layer * DM * DM, nullptr, (r / 16) * 64, (r % 16) * 64, tile); continue; }
        r -= 2 * U_OUT;
        { const int layer = r / U_PW; r %= U_PW; transpose_unit(p.pw_w + (size_t)layer * 256 * 256, 256, 256, wpw + (size_t)layer * 256 * 256, nullptr, (r / 4) * 64, (r % 4) * 64, tile); }
    }
}

__device__ __forceinline__ void gemm_in(const Params& p, int layer, unsigned char* lds) {
    pg8::Gemm g{(const h16*)(p.ws + WS_XH), (const h16*)(p.ws + WS_WIN) + (size_t)layer * NIN * DM, MROWS, NIN, DM};
    pg8::StaticOrder S; S.init(MROWS, NIN, (int)gridDim.x, (int)blockIdx.x);
    pg8::EpiProj E{(h16*)(p.ws + WS_PROJ), (const float*)(p.ws + WS_ROWSS), (float*)(p.ws + WS_KMEAN)};
    pg8::gemm_phase<pg8::EpiProj, pg8::StaticOrder, true, true>((PG8_LAS unsigned char*)lds, g, S, E);
    if (layer == 0) { const int G = (int)gridDim.x, nfull = (MROWS / 256) * (NIN / 256) % G;
        if (nfull == 0) deferred_transposes(p, lds, (int)blockIdx.x, G); else if ((int)blockIdx.x >= nfull) deferred_transposes(p, lds, (int)blockIdx.x - nfull, G - nfull); }
}
template <int LAYER> __device__ __forceinline__ void gemm_out(const Params& p, unsigned char* lds) {
    pg8::Gemm g{(const h16*)(p.ws + WS_MIX), (const h16*)(p.ws + WS_WOUT) + (size_t)LAYER * DM * DM, MROWS, DM, DM};
    pg8::StaticOrder S; S.init(MROWS, DM, (int)gridDim.x, (int)blockIdx.x);
    pg8::EpiRes<LAYER> E{p.x, p.out, (h16*)(p.ws + WS_XH), (float*)(p.ws + WS_ROWSS)};
    pg8::gemm_phase<pg8::EpiRes<LAYER>, pg8::StaticOrder, true, true>((PG8_LAS unsigned char*)lds, g, S, E);
}

__device__ __forceinline__ void phase_stats(const Params& p, int layer, unsigned char* lds_g) {
    LAS unsigned char* lds = (LAS unsigned char*)lds_g;
    const h16* proj = (const h16*)(p.ws + WS_PROJ); float* kv = (float*)(p.ws + WS_KV);
    const int tid = threadIdx.x, lane = tid & 63, wid = __builtin_amdgcn_readfirstlane(tid >> 6), r = lane & 31, hi = lane >> 5;
    const int lanepart = (4 * hi + ((lane & 15) >> 2)) * 64 + ((lane >> 4) & 1) * 32 + (lane & 3) * 8;
#pragma unroll 1
    for (int u = blockIdx.x; u < 512; u += gridDim.x) {
        const int b = u >> 6, hh = (u >> 4) & 3, np = u & 15;
        const float log_g = logf(1.0f - exp2f(-5.0f - (float)hh));
        __syncthreads();
#pragma unroll
        for (int it = 0; it < 4; ++it) {
            const int pc = tid + 512 * it, cn = pc >> 10, key = (pc >> 3) & 127, ch = pc & 7;
            const h16* src = proj + (size_t)(b * SEQ + (2 * np + cn) * 128 + key) * NIN + hh * 64 + ch * 8;
            h16x8 kk = *(const h16x8*)(src + C_RK); const h16x8 vv = *(const h16x8*)(src + C_RV);
            const float z = __expf(log_g * (float)(127 - key)) * 0.125f;
#pragma unroll
            for (int k = 0; k < 8; ++k) kk[k] = (h16)((float)kk[k] * z);
            const int off = cn * 32768 + (ch >> 2) * 8192 + (key >> 4) * 1024 + (key & 15) * 64 + (ch & 3) * 16;
            *(LAS h16x8*)(lds + off) = kk; *(LAS h16x8*)(lds + off + 16384) = vv;
        }
        __syncthreads();
        const int cn = wid >> 2, eb = (wid >> 1) & 1, dbk = wid & 1;
        const LAS unsigned char* kimg = lds + cn * 32768 + dbk * 8192 + lanepart; const LAS unsigned char* vimg = lds + cn * 32768 + 16384 + eb * 8192 + lanepart;
        f32x16 acc;
#pragma unroll
        for (int i = 0; i < 16; ++i) acc[i] = 0.f;
#pragma unroll
        for (int ks = 0; ks < 8; ++ks) acc = __builtin_amdgcn_mfma_f32_32x32x16_f16(tr_frag(vimg + ks * 1024), tr_frag(kimg + ks * 1024), acc, 0, 0, 0);
        float* dst = kv + ((size_t)((b * 4 + hh) * 32 + 2 * np + cn)) * 4096 + (32 * eb + 4 * hi) * 64 + 32 * dbk + r;
#pragma unroll
        for (int i = 0; i < 16; ++i) dst[CROW0(i) * 64] = acc[i];
    }
#pragma unroll 1
    for (int u = blockIdx.x; u < 1024; u += gridDim.x) {
        const int b = u >> 7, row = (u & 127) * 32 + (tid >> 4), part = tid & 15;
        const h16* src = proj + (size_t)(b * SEQ + row) * NIN + C_MK + part * 32;
        float ss = 0.f;
#pragma unroll
        for (int k = 0; k < 4; ++k) { const h16x8 kk = *(const h16x8*)(src + k * 8);
#pragma unroll
            for (int d = 0; d < 8; ++d) ss += (float)kk[d] * (float)kk[d]; }
        ss += __shfl_xor(ss, 1);
        ss = fmaxf(ss, __shfl_xor(ss, 16)); ss = fmaxf(ss, __shfl_xor(ss, 32));
        if ((lane & 0x31) == 0) atomicMax((unsigned*)(p.ws + WS_CTL + 20480) + layer * 64 + b * 8 + (part >> 1), __float_as_uint(ss));
    }
}

typedef _Float16 h16x2 __attribute__((ext_vector_type(2)));
typedef float f32x2 __attribute__((ext_vector_type(2)));
__device__ __forceinline__ void conv_unit(const Params& p, int layer, int b, int tt, unsigned char* lds_g) {
    LAS unsigned char* lds = (LAS unsigned char*)lds_g;
    const h16* projb = (const h16*)(p.ws + WS_PROJ) + (size_t)b * SEQ * NIN; h16* mix = (h16*)(p.ws + WS_MIX);
    const int tid = threadIdx.x, lane = tid & 63, wid = __builtin_amdgcn_readfirstlane(tid >> 6), r = lane & 31, hi = lane >> 5;
    const int cp = tid & 127, tg = __builtin_amdgcn_readfirstlane(tid >> 7), t0 = tt * 64, tb0 = t0 + 16 * tg - 30;
    constexpr int YS = 0, SIMG = 65536;
    float y0[16], y1[16];
    {
        float w0[31], w1[31]; const float* cw = p.conv_w + (size_t)layer * 31 * 256 + 2 * cp;
#pragma unroll
        for (int jj = 0; jj < 31; ++jj) { const f32x2 wv = *(const f32x2*)(cw + jj * 256); w0[jj] = wv[0]; w1[jj] = wv[1]; }
        const f32x2 cbv = *(const f32x2*)(p.conv_b + layer * 256 + 2 * cp);
#pragma unroll
        for (int tl = 0; tl < 16; ++tl) { y0[tl] = cbv[0]; y1[tl] = cbv[1]; }
#pragma unroll
        for (int rr = 0; rr < 46; ++rr) {
            const int t = tb0 + rr; float a0 = 0.f, a1 = 0.f;
            if (t >= 0) { const h16x2 av = *(const h16x2*)(projb + (size_t)t * NIN + C_AVAL + 2 * cp), gv = *(const h16x2*)(projb + (size_t)t * NIN + C_AGLU + 2 * cp);
                a0 = (float)av[0] * __builtin_amdgcn_rcpf(1.0f + __expf(-(float)gv[0])); a1 = (float)av[1] * __builtin_amdgcn_rcpf(1.0f + __expf(-(float)gv[1])); }
#pragma unroll
            for (int tl = 0; tl < 16; ++tl) { const int jj = rr - tl; if (jj >= 0 && jj < 31) { y0[tl] += w0[jj] * a0; y1[tl] += w1[jj] * a1; } }
        }
    }
    __syncthreads();
#pragma unroll
    for (int tl = 0; tl < 16; ++tl) *(LAS f32x2*)(lds + YS + ((16 * tg + tl) * 256 + 2 * cp) * 4) = (f32x2){y0[tl], y1[tl]};
    h16x8 wf[16];
    {
        const h16* wp = (const h16*)(p.ws + WS_WPW) + (size_t)layer * 65536 + (size_t)(32 * wid + r) * 256 + 8 * hi;
#pragma unroll
        for (int ks = 0; ks < 16; ++ks) wf[ks] = *(const h16x8*)(wp + 16 * ks);
    }
    __syncthreads();
    {
        const f32x4 lg = *(const f32x4*)(p.ln_g + layer * 256 + lane * 4), lb = *(const f32x4*)(p.ln_b + layer * 256 + lane * 4);
#pragma unroll 1
        for (int kb = 0; kb < 8; kb += 4) {
        f32x4 v[4]; float s1[4], s2[4];
#pragma unroll
        for (int k = 0; k < 4; ++k) { v[k] = *(const LAS f32x4*)(lds + YS + ((wid * 8 + kb + k) * 256 + lane * 4) * 4);
            s1[k] = (v[k][0] + v[k][1]) + (v[k][2] + v[k][3]); s2[k] = (v[k][0] * v[k][0] + v[k][1] * v[k][1]) + (v[k][2] * v[k][2] + v[k][3] * v[k][3]); }
#pragma unroll
        for (int o = 1; o < 64; o <<= 1)
#pragma unroll
            for (int k = 0; k < 4; ++k) { s1[k] += __shfl_xor(s1[k], o); s2[k] += __shfl_xor(s2[k], o); }
#pragma unroll
        for (int k = 0; k < 4; ++k) { const int t = wid * 8 + kb + k; const float mu = s1[k] * (1.0f / 256.0f); const float var = fmaxf(s2[k] * (1.0f / 256.0f) - mu * mu, 0.f); const float rs = rsqrtf(var + 1e-5f);
            h16x4 o; o[0] = (h16)silu_f((v[k][0] - mu) * rs * lg[0] + lb[0]); o[1] = (h16)silu_f((v[k][1] - mu) * rs * lg[1] + lb[1]); o[2] = (h16)silu_f((v[k][2] - mu) * rs * lg[2] + lb[2]); o[3] = (h16)silu_f((v[k][3] - mu) * rs * lg[3] + lb[3]);
            *(LAS h16x4*)(lds + SIMG + t * 512 + (((lane >> 1) ^ (t & 15)) << 4) + 8 * (lane & 1)) = o; }
        }
    }
    __syncthreads();
#pragma unroll
    for (int tb = 0; tb < 2; ++tb) {
        f32x16 acc;
#pragma unroll
        for (int i = 0; i < 16; ++i) acc[i] = 0.f;
#pragma unroll
        for (int ks = 0; ks < 16; ++ks) acc = __builtin_amdgcn_mfma_f32_32x32x16_f16(wf[ks], *(const LAS h16x8*)(lds + SIMG + (32 * tb + r) * 512 + (((2 * ks + hi) ^ (r & 15)) << 4)), acc, 0, 0, 0);
        const int t = t0 + 32 * tb + r, n0 = 32 * wid + 4 * hi;
        const h16* gp = projb + (size_t)t * NIN + C_AGATE + n0; h16* dst = mix + ((size_t)b * SEQ + t) * DM + n0; const float* pb = p.pw_b + layer * 256 + n0;
#pragma unroll
        for (int g = 0; g < 4; ++g) { const h16x4 ga = *(const h16x4*)(gp + 8 * g); const f32x4 bb = *(const f32x4*)(pb + 8 * g); h16x4 oa;
#pragma unroll
            for (int k = 0; k < 4; ++k) oa[k] = (h16)((acc[4 * g + k] + bb[k]) * silu_f((float)ga[k]));
            *(h16x4*)(dst + 8 * g) = oa; }
    }
}

__device__ __forceinline__ void ret_unit(const Params& p, int b, int hh, int n, unsigned char* lds_g) {
    LAS unsigned char* lds = (LAS unsigned char*)lds_g;
    const h16* projb = (const h16*)(p.ws + WS_PROJ) + (size_t)(b * SEQ + n * 128) * NIN; h16* mix = (h16*)(p.ws + WS_MIX); const float* kv = (const float*)(p.ws + WS_KV);
    const int tid = threadIdx.x, lane = tid & 63, wid = __builtin_amdgcn_readfirstlane(tid >> 6), r = lane & 31, hi = lane >> 5, g4 = wid & 3, eh = wid >> 2;
    const float log_g = logf(1.0f - exp2f(-5.0f - (float)hh));
    constexpr int KIMG = 0, VIMG = 16384, RIMG = 32768, XS = 40960;
    const h16x8 rr = *(const h16x8*)((const h16*)(p.ws + WS_RST) + ((size_t)((b * 4 + hh) * 32 + n)) * 4096 + tid * 8);
    __syncthreads();
    {
        const int e = tid >> 3, ch = tid & 7;
        *(LAS h16x8*)(lds + RIMG + e * 128 + ((ch ^ ((e >> 1) & 7)) << 4)) = rr;
#pragma unroll
        for (int it = 0; it < 2; ++it) {
            const int key = (tid >> 3) + 64 * it;
            h16x8 kk = *(const h16x8*)(projb + (size_t)key * NIN + C_RK + hh * 64 + ch * 8); const h16x8 vv = *(const h16x8*)(projb + (size_t)key * NIN + C_RV + hh * 64 + ch * 8);
            const float z = __expf(-log_g * (float)key) * 0.125f;
#pragma unroll
            for (int k = 0; k < 8; ++k) kk[k] = (h16)((float)kk[k] * z);
            *(LAS h16x8*)(lds + KIMG + key * 128 + ((ch ^ ((key >> 1) & 7)) << 4)) = kk;
            *(LAS h16x8*)(lds + VIMG + (ch >> 2) * 8192 + (key >> 4) * 1024 + (key & 15) * 64 + (ch & 3) * 16) = vv;
        }
    }
    const int qi = 32 * g4 + r;
    h16x8 qf[4];
    {
        const float zq = __expf(log_g * (float)qi);
#pragma unroll
        for (int s = 0; s < 4; ++s) { qf[s] = *(const h16x8*)(projb + (size_t)qi * NIN + C_RQ + hh * 64 + 16 * s + 8 * hi);
#pragma unroll
            for (int k = 0; k < 8; ++k) qf[s][k] = (h16)((float)qf[s][k] * zq); }
    }
    __syncthreads();
    const int rsw = (r >> 1) & 7;
    const int lanepart = (4 * hi + ((lane & 15) >> 2)) * 64 + ((lane >> 4) & 1) * 32 + (lane & 3) * 8;
    f32x16 o;
#pragma unroll
    for (int i = 0; i < 16; ++i) o[i] = 0.f;
#pragma unroll 1
    for (int jb = 0; jb <= g4; ++jb) {
        f32x16 c;
#pragma unroll
        for (int i = 0; i < 16; ++i) c[i] = 0.f;
#pragma unroll
        for (int s = 0; s < 4; ++s) c = __builtin_amdgcn_mfma_f32_32x32x16_f16(*(const LAS h16x8*)(lds + KIMG + (32 * jb + r) * 128 + (((2 * s + hi) ^ rsw) << 4)), qf[s], c, 0, 0, 0);
        if (jb == g4) {
#pragma unroll
            for (int i = 0; i < 16; ++i) if (CROW0(i) + 4 * hi > r) c[i] = 0.f;
        }
        h16x8 pf0, pf1;
#pragma unroll
        for (int k = 0; k < 8; ++k) { pf0[k] = (h16)c[k]; pf1[k] = (h16)c[8 + k]; }
        o = __builtin_amdgcn_mfma_f32_32x32x16_f16(tr_frag(lds + VIMG + eh * 8192 + (2 * jb) * 1024 + lanepart), pf0, o, 0, 0, 0);
        o = __builtin_amdgcn_mfma_f32_32x32x16_f16(tr_frag(lds + VIMG + eh * 8192 + (2 * jb + 1) * 1024 + lanepart), pf1, o, 0, 0, 0);
    }
#pragma unroll
    for (int s = 0; s < 4; ++s) o = __builtin_amdgcn_mfma_f32_32x32x16_f16(*(const LAS h16x8*)(lds + RIMG + (32 * eh + r) * 128 + (((2 * s + hi) ^ rsw) << 4)), qf[s], o, 0, 0, 0);
    float s1 = 0.f, s2 = 0.f;
#pragma unroll
    for (int i = 0; i < 16; ++i) { s1 += o[i]; s2 += o[i] * o[i]; }
    s1 = xhalf_sum(s1); s2 = xhalf_sum(s2);
    LAS float* xs = (LAS float*)(lds + XS);
    if (hi == 0) { xs[(wid * 32 + r) * 2] = s1; xs[(wid * 32 + r) * 2 + 1] = s2; }
    __syncthreads();
    {
        const float t1 = xs[((wid ^ 4) * 32 + r) * 2], t2 = xs[((wid ^ 4) * 32 + r) * 2 + 1];
        const float a1 = (eh == 0) ? (s1 + t1) : (t1 + s1), a2 = (eh == 0) ? (s2 + t2) : (t2 + s2);
        const float mu = a1 * (1.0f / 64.0f); const float var = fmaxf(a2 * (1.0f / 64.0f) - mu * mu, 0.f); const float rs = rsqrtf(var + 1e-5f);
        const int col = hh * 64 + 32 * eh + 4 * hi;
        const h16* gp = projb + (size_t)qi * NIN + C_RGATE + col; h16* dst = mix + ((size_t)(b * SEQ + n * 128 + qi)) * DM + 256 + col;
#pragma unroll
        for (int g = 0; g < 4; ++g) { const h16x4 ga = *(const h16x4*)(gp + 8 * g); h16x4 oa;
#pragma unroll
            for (int k = 0; k < 4; ++k) oa[k] = (h16)((o[4 * g + k] - mu) * rs * silu_f((float)ga[k]));
            *(h16x4*)(dst + 8 * g) = oa; }
    }
}

constexpr float MOBA_THR = 8.0f;
__device__ __forceinline__ void moba_unit(const Params& p, int layer, int b, int hh, int j, unsigned char* lds_g) {
    LAS unsigned char* lds = (LAS unsigned char*)lds_g;
    const int tid = threadIdx.x, lane = tid & 63, wid = __builtin_amdgcn_readfirstlane(tid >> 6), r = lane & 31, hi = lane >> 5;
    const h16* projb = (const h16*)(p.ws + WS_PROJ) + (size_t)b * SEQ * NIN; h16* mix = (h16*)(p.ws + WS_MIX);
    const int qrow = j * 256 + wid * 32 + r;
    h16x8 qf[4];
#pragma unroll
    for (int s = 0; s < 4; ++s) qf[s] = *(const h16x8*)(projb + (size_t)qrow * NIN + C_MQ + hh * 64 + 16 * s + 8 * hi);
    unsigned selmask = 0u;
    if (j <= 3) selmask = (1u << j) - 1u;
    else {
        const float* km = (const float*)(p.ws + WS_KMEAN) + ((size_t)(b * 8 + hh) * 16 + (r & 15)) * 64 + 8 * hi;
        f32x16 g;
#pragma unroll
        for (int i = 0; i < 16; ++i) g[i] = 0.f;
#pragma unroll
        for (int s = 0; s < 4; ++s) {
            f32x4 a0 = (f32x4){0.f, 0.f, 0.f, 0.f}, a1 = a0;
            if (r < j) { a0 = *(const f32x4*)(km + 16 * s) + *(const f32x4*)(km + 65536 + 16 * s); a1 = *(const f32x4*)(km + 16 * s + 4) + *(const f32x4*)(km + 65536 + 16 * s + 4); }
            h16x8 ah, al;
#pragma unroll
            for (int k = 0; k < 4; ++k) { const h16 h0 = (h16)a0[k], h1 = (h16)a1[k]; ah[k] = h0; ah[4 + k] = h1; al[k] = (h16)(a0[k] - (float)h0); al[4 + k] = (h16)(a1[k] - (float)h1); }
            g = __builtin_amdgcn_mfma_f32_32x32x16_f16(ah, qf[s], g, 0, 0, 0);
            g = __builtin_amdgcn_mfma_f32_32x32x16_f16(al, qf[s], g, 0, 0, 0);
        }
        float gate[16];
#pragma unroll
        for (int i = 0; i < 8; ++i) { auto rr = __builtin_amdgcn_permlane32_swap(__float_as_uint(g[i]), __float_as_uint(g[i]), false, false);
            gate[(i & 3) + 8 * (i >> 2)] = __uint_as_float(rr[0]); gate[(i & 3) + 8 * (i >> 2) + 4] = __uint_as_float(rr[1]); }
        float g0 = -3.0e38f, g1 = -3.0e38f, g2 = -3.0e38f; int i0 = 0, i1 = 0, i2 = 0;
#pragma unroll
        for (int n = 0; n < 15; ++n) { const float s = (n < j) ? gate[n] : -3.0e38f;
            if (s > g0) { g2 = g1; i2 = i1; g1 = g0; i1 = i0; g0 = s; i0 = n; }
            else if (s > g1) { g2 = g1; i2 = i1; g1 = s; i1 = n; }
            else if (s > g2) { g2 = s; i2 = n; } }
        selmask = (1u << i0) | (1u << i1) | (1u << i2);
    }
    constexpr float C2 = 0.125f * 1.4426950408889634f;
    float qn2 = 0.f;
#pragma unroll
    for (int s = 0; s < 4; ++s)
#pragma unroll
        for (int k = 0; k < 8; ++k) { qf[s][k] = (h16)((float)qf[s][k] * C2); qn2 += (float)qf[s][k] * (float)qf[s][k]; }
    const float qbound = sqrtf(xhalf_sum(qn2)) * sqrtf(__uint_as_float(__hip_atomic_load((const unsigned*)(p.ws + WS_CTL + 20480) + layer * 64 + b * 8 + hh, __ATOMIC_RELAXED, __HIP_MEMORY_SCOPE_AGENT))) * 1.001f;
    const float slope2 = exp2f(-(float)(hh + 1)) * 1.4426950408889634f;
    f32x16 o0, o1;
#pragma unroll
    for (int i = 0; i < 16; ++i) { o0[i] = 0.f; o1[i] = 0.f; }
    float mref = 0.f, lsum = 0.f; bool first = true;
    const unsigned lds0 = (unsigned)(__UINTPTR_TYPE__)lds;
    const int dkey = 8 * wid + (lane >> 3);
    const h16* ksrc = projb + (size_t)dkey * NIN + C_MK + hh * 64 + (((lane & 7) ^ ((dkey >> 1) & 7)) << 3);
    const h16* vsrc = projb + (size_t)(16 * (wid & 3) + (lane >> 2)) * NIN + C_MV + hh * 64 + (wid >> 2) * 32 + (lane & 3) * 8;
    const unsigned kdst = lds0 + wid * 1024, vdst = lds0 + 8192 + (wid >> 2) * 4096 + (wid & 3) * 1024;
#define MOBA_DMA(tile) do { const int kp_ = j * 256 + 192 - 64 * (tile); const unsigned so_ = (unsigned)(((tile) & 7) * 16384); \
        glds16(ksrc + (size_t)kp_ * NIN, (unsigned)__builtin_amdgcn_readfirstlane(kdst + so_)); glds16(vsrc + (size_t)kp_ * NIN, (unsigned)__builtin_amdgcn_readfirstlane(vdst + so_)); } while (0)
#define MOBA_WAIT_BAR(N) asm volatile("s_waitcnt vmcnt(" #N ") lgkmcnt(0)\n\ts_barrier" ::: "memory")
    const int rK = r * 128, rsw = (r >> 1) & 7;
    const int rV = 8192 + (4 * hi + ((lane & 15) >> 2)) * 64 + ((lane >> 4) & 1) * 32 + (lane & 3) * 8;
    const int nt = 4 * (j + 1);
    const int wdiag = wid >> 1;
#define MOBA_CIN(T, C0, C1) do { const int kp_ = j * 256 + 192 - 64 * (T); const int nb_ = kp_ >> 8, tl_ = (kp_ >> 6) & 3; const bool own_ = (nb_ == j); \
        const bool val_ = own_ ? true : (((selmask >> (nb_ & 31)) & 1u) != 0u); \
        const float tbh_ = val_ ? (slope2 * (float)(kp_ - qrow + 4 * hi) - mref) : -INFINITY; \
        _Pragma("unroll") for (int i = 0; i < 16; ++i) { C0[i] = fmaf(slope2, (float)CROW0(i), tbh_); C1[i] = fmaf(slope2, (float)(CROW0(i) + 32), tbh_); } \
        if (own_ && tl_ >= wdiag) { const int lim2_ = 32 * wid - 64 * tl_ + r - 4 * hi; \
            _Pragma("unroll") for (int i = 0; i < 16; ++i) { if (CROW0(i) > lim2_) C0[i] = -INFINITY; if (CROW0(i) + 32 > lim2_) C1[i] = -INFINITY; } } } while (0)
#define MOBA_QK(T, C0, C1) do { const LAS unsigned char* kb_ = lds + ((T) & 7) * 16384 + rK; \
        _Pragma("unroll") for (int s = 0; s < 4; ++s) { \
            const h16x8 k0_ = *(const LAS h16x8*)(kb_ + (((2 * s + hi) ^ rsw) << 4)), k1_ = *(const LAS h16x8*)(kb_ + 4096 + (((2 * s + hi) ^ rsw) << 4)); \
            C0 = __builtin_amdgcn_mfma_f32_32x32x16_f16(k0_, qf[s], C0, 0, 0, 0); C1 = __builtin_amdgcn_mfma_f32_32x32x16_f16(k1_, qf[s], C1, 0, 0, 0); } } while (0)
#define MOBA_DECIDE(T, C0, C1) do { float m_ = __builtin_fmaxf(C0[0], C1[0]); \
        _Pragma("unroll") for (int i = 1; i < 16; ++i) m_ = __builtin_fmaxf(__builtin_fmaxf(m_, C0[i]), C1[i]); \
        m_ = xhalf_max(m_); \
        const int kp_ = j * 256 + 192 - 64 * (T); const bool fst_ = ((kp_ >> 8) == j) && (((kp_ >> 6) & 3) == wdiag); \
        if (fst_ || __any(m_ > MOBA_THR)) { const float dl_ = fst_ ? m_ : __builtin_fmaxf(m_, 0.f); const float f_ = fst_ ? 1.0f : __builtin_amdgcn_exp2f(-dl_); mref += dl_; lsum *= f_; \
            _Pragma("unroll") for (int i = 0; i < 16; ++i) { C0[i] -= dl_; C1[i] -= dl_; o0[i] *= f_; o1[i] *= f_; } } } while (0)
#define MOBA_STEP(T, TE, P0, P1, N0, N1) do { \
        MOBA_CIN((T) + 1, N0, N1); MOBA_QK((T) + 1, N0, N1); \
        float ps_ = 0.f; \
        _Pragma("unroll") for (int i = 0; i < 16; ++i) { P0[i] = __builtin_amdgcn_exp2f(P0[i]); P1[i] = __builtin_amdgcn_exp2f(P1[i]); ps_ += P0[i] + P1[i]; } \
        lsum += ps_; \
        h16x8 pf_[4]; \
        _Pragma("unroll") for (int k = 0; k < 8; ++k) { pf_[0][k] = (h16)P0[k]; pf_[1][k] = (h16)P0[8 + k]; pf_[2][k] = (h16)P1[k]; pf_[3][k] = (h16)P1[8 + k]; } \
        { const LAS unsigned char* vb_ = lds + ((T) & 7) * 16384 + rV; \
          _Pragma("unroll") for (int t = 0; t < 4; ++t) { const h16x8 v0_ = tr_frag(vb_ + t * 1024), v1_ = tr_frag(vb_ + 4096 + t * 1024); \
            o0 = __builtin_amdgcn_mfma_f32_32x32x16_f16(v0_, pf_[t], o0, 0, 0, 0); o1 = __builtin_amdgcn_mfma_f32_32x32x16_f16(v1_, pf_[t], o1, 0, 0, 0); } } \
        if ((T) + 1 < (TE)) MOBA_DECIDE((T) + 1, N0, N1); } while (0)
    f32x16 cA0, cA1, cB0, cB1;
    int te = nt;
    LAS float* xs = (LAS float*)(lds + 131072);
    MOBA_WAIT_BAR(0);
    MOBA_DMA(0); MOBA_DMA(1); MOBA_DMA(2);
    MOBA_WAIT_BAR(0);
    MOBA_DMA(3); if (4 < te) MOBA_DMA(4);
    MOBA_CIN(0, cA0, cA1); MOBA_QK(0, cA0, cA1); MOBA_DECIDE(0, cA0, cA1);
#pragma unroll 1
    for (int tt = 0; tt < te; tt += 2) {
        MOBA_STEP(tt, te, cA0, cA1, cB0, cB1);
        if (tt == 2 && j > 0) { float marg = qbound - mref;
#pragma unroll
            for (int o = 1; o < 64; o <<= 1) marg = fmaxf(marg, __shfl_xor(marg, o));
            if (lane == 0) xs[wid] = marg; }
        MOBA_STEP(tt + 1, te, cB0, cB1, cA0, cA1);
        MOBA_WAIT_BAR(0);
        if (tt == 2 && j > 0) { float M = xs[0];
#pragma unroll
            for (int k = 1; k < 8; ++k) M = fmaxf(M, xs[k]);
            const float num = M + 40.0f - slope2;
            int cnt = (num >= 0.f) ? ((int)(num / (64.0f * slope2)) + 1) : 0;
            cnt = max(min(cnt, 4 * j), 2); cnt = (cnt + 1) & ~1;
            te = 4 + __builtin_amdgcn_readfirstlane(cnt); }
        if (tt + 5 < te) MOBA_DMA(tt + 5);
        if (tt + 6 < te) MOBA_DMA(tt + 6);
    }
    MOBA_WAIT_BAR(0);
#undef MOBA_RUN
#undef MOBA_CIN
#undef MOBA_QK
#undef MOBA_DECIDE
#undef MOBA_STEP
#undef MOBA_DMA
#undef MOBA_WAIT_BAR
    {
        const float inv = 1.0f / xhalf_sum(lsum);
        const h16* gp = projb + (size_t)qrow * NIN + C_MGATE + hh * 64 + 4 * hi; h16* dst = mix + ((size_t)b * SEQ + qrow) * DM + 512 + hh * 64 + 4 * hi;
#pragma unroll
        for (int g = 0; g < 4; ++g) {
            const h16x4 ga = *(const h16x4*)(gp + 8 * g), gb = *(const h16x4*)(gp + 32 + 8 * g); h16x4 oa, ob;
#pragma unroll
            for (int k = 0; k < 4; ++k) { oa[k] = (h16)(o0[4 * g + k] * inv * silu_f((float)ga[k])); ob[k] = (h16)(o1[4 * g + k] * inv * silu_f((float)gb[k])); }
            *(h16x4*)(dst + 8 * g) = oa; *(h16x4*)(dst + 32 + 8 * g) = ob;
        }
    }
}

__device__ __forceinline__ void ret_scan_shares(const Params& p, int layer) {
    const float* kv = (const float*)(p.ws + WS_KV); h16* rst = (h16*)(p.ws + WS_RST);
    const int tid = threadIdx.x; unsigned done = 0u;
#pragma unroll 1
    for (int s = blockIdx.x; s < 256; s += gridDim.x) {
        const int bh = s >> 3, e = (s & 7) * 512 + tid, hh = bh & 3;
        const float gam = 1.0f - exp2f(-5.0f - (float)hh); const float g = expf(logf(gam) * 128.0f);
        const float* kvb = kv + (size_t)bh * 32 * 4096 + e; h16* rb = rst + (size_t)bh * 32 * 4096 + e;
        float r = 0.f; rb[0] = (h16)0.f;
#pragma unroll 1
        for (int m0 = 0; m0 < 31; m0 += 8) {
            float kvv[8];
#pragma unroll
            for (int k = 0; k < 8; ++k) kvv[k] = (m0 + k < 31) ? kvb[(size_t)(m0 + k) * 4096] : 0.f;
#pragma unroll
            for (int k = 0; k < 8; ++k) if (m0 + k < 31) { r = r * g + kvv[k]; rb[(size_t)(m0 + k + 1) * 4096] = (h16)(r * gam); }
        }
        ++done;
    }
    asm volatile("s_waitcnt vmcnt(0)" ::: "memory");
    __syncthreads();
    if (tid == 0) { __builtin_amdgcn_fence(__ATOMIC_RELEASE, "agent"); asm volatile("s_waitcnt vmcnt(0)" ::: "memory");
        __hip_atomic_fetch_add((unsigned*)(p.ws + WS_CTL + 16384) + 64 * layer, done, __ATOMIC_RELAXED, __HIP_MEMORY_SCOPE_AGENT); }
}
__device__ __forceinline__ void ret_scan_wait(const Params& p, int layer) {
    if (threadIdx.x == 0) {
        unsigned* c = (unsigned*)(p.ws + WS_CTL + 16384) + 64 * layer; unsigned sp = 0u;
        while (__hip_atomic_load(c, __ATOMIC_RELAXED, __HIP_MEMORY_SCOPE_AGENT) < 256u) { __builtin_amdgcn_s_sleep(2); if (++sp > (1u << 22)) break; }
        __builtin_amdgcn_fence(__ATOMIC_ACQUIRE, "agent"); asm volatile("s_waitcnt vmcnt(0)" ::: "memory");
    }
    __syncthreads();
}

__device__ __forceinline__ void publish_count(unsigned* c, unsigned n) {
    asm volatile("s_waitcnt vmcnt(0)" ::: "memory");
    __syncthreads();
    if (threadIdx.x == 0) { __builtin_amdgcn_fence(__ATOMIC_RELEASE, "agent"); asm volatile("s_waitcnt vmcnt(0)" ::: "memory"); __hip_atomic_fetch_add(c, n, __ATOMIC_RELAXED, __HIP_MEMORY_SCOPE_AGENT); }
}
__device__ __forceinline__ void wait_count(unsigned* c, unsigned want) {
    if (threadIdx.x == 0) { unsigned sp = 0u;
        while (__hip_atomic_load(c, __ATOMIC_RELAXED, __HIP_MEMORY_SCOPE_AGENT) < want) { __builtin_amdgcn_s_sleep(2); if (++sp > (1u << 22)) break; }
        __builtin_amdgcn_fence(__ATOMIC_ACQUIRE, "agent"); asm volatile("s_waitcnt vmcnt(0)" ::: "memory"); }
    __syncthreads();
}
__device__ __forceinline__ int queue_pop(unsigned* counter, LAS unsigned* slot) {
    __syncthreads();
    if (threadIdx.x == 0) slot[0] = __hip_atomic_fetch_add(counter, 1u, __ATOMIC_RELAXED, __HIP_MEMORY_SCOPE_AGENT);
    __syncthreads();
    return (int)slot[0];
}
__device__ __forceinline__ void phase_mixers(const Params& p, int layer, unsigned char* lds) {
    static constexpr unsigned char MOBA_ORDER[128] = {111,127,110,126,109,125,93,94,95,92,108,124,91,107,123,90,106,122,89,105,121,88,104,120,87,103,119,71,72,73,74,75,76,77,78,79,70,86,102,118,69,85,101,117,68,84,100,116,52,53,54,55,56,57,58,59,60,61,62,63,51,67,83,99,115,50,66,82,98,114,34,35,36,37,38,39,40,41,42,43,44,45,46,47,17,18,19,20,21,22,23,24,25,26,27,28,29,30,31,33,49,65,81,97,113,1,2,3,4,5,6,7,8,9,10,11,12,13,14,15,0,16,32,48,64,80,96,112};
    unsigned* qc = (unsigned*)(p.ws + WS_CTL + 24576) + layer * 256;
    LAS unsigned* slot = (LAS unsigned*)((LAS unsigned char*)lds + BAR_LDS_OFF + 16);
    phase_stats(p, layer, lds);
    publish_count((unsigned*)(p.ws + WS_CTL + 16384) + 64 * (2 + layer), 1u);
#define QUEUE_LOOP(CNT, N, BODY) do { int cur = queue_pop(CNT, slot); \
        _Pragma("unroll 1") while (cur < (N)) { unsigned nxt_ = 0u; if (threadIdx.x == 0) nxt_ = __hip_atomic_fetch_add(CNT, 1u, __ATOMIC_RELAXED, __HIP_MEMORY_SCOPE_AGENT); \
            { BODY; } \
            __syncthreads(); if (threadIdx.x == 0) slot[0] = nxt_; __syncthreads(); cur = (int)slot[0]; } } while (0)
    QUEUE_LOOP(qc + 128, 512, conv_unit(p, layer, cur >> 6, cur & 63, lds));
    wait_count((unsigned*)(p.ws + WS_CTL + 16384) + 64 * (2 + layer), gridDim.x);
    ret_scan_shares(p, layer);
    QUEUE_LOOP(qc, 1024, const int hj = MOBA_ORDER[cur >> 3]; moba_unit(p, layer, cur & 7, hj >> 4, hj & 15, lds));
    ret_scan_wait(p, layer);
    QUEUE_LOOP(qc + 64, 1024, ret_unit(p, cur >> 7, (cur >> 5) & 3, cur & 31, lds));
#undef QUEUE_LOOP
}

__device__ __forceinline__ void phase_final(const Params& p) {
    const float* rowss = (const float*)(p.ws + WS_ROWSS);
    const int lane = threadIdx.x & 63, wid = threadIdx.x >> 6;
    f32x4 g[4];
#pragma unroll
    for (int j = 0; j < 4; ++j) g[j] = *((const f32x4*)p.final_g + lane + 64 * j);
    for (int row = blockIdx.x * 8 + wid; row < MROWS; row += gridDim.x * 8) {
        const f32x4* rs = (const f32x4*)(rowss + (size_t)row * NPART); const f32x4 s0 = rs[0], s1 = rs[1], s2 = rs[2], s3 = rs[3];
        const float tot = ((s0[0] + s0[1]) + (s0[2] + s0[3])) + ((s1[0] + s1[1]) + (s1[2] + s1[3])) + ((s2[0] + s2[1]) + (s2[2] + s2[3])) + ((s3[0] + s3[1]) + (s3[2] + s3[3]));
        const float rstd = rsqrtf(tot * (1.0f / DM) + 1e-6f);
        f32x4* xr = (f32x4*)(p.out + (size_t)row * DM) + lane;
#pragma unroll
        for (int j = 0; j < 4; ++j) { f32x4 v = xr[64 * j]; v = v * rstd * g[j]; xr[64 * j] = v; }
    }
}

#define XB_TMO      128
#define XB_XCNT(j)  (256  + 64 * (j))
#define XB_XSUB(j)  (1280 + 64 * (j))
#define XB_XGEN(j)  (2304 + 64 * (j))
#define XB_TOP      3328
#define XB_TOPGEN   3392
#define XCD_BAR_WORDS 3456
#define XB_SPIN_CAP (1u << 18)

__device__ __forceinline__ unsigned xb_ld(unsigned* p)              { return __hip_atomic_load(p, __ATOMIC_RELAXED, __HIP_MEMORY_SCOPE_AGENT); }
__device__ __forceinline__ unsigned xb_add(unsigned* p, unsigned v) { return __hip_atomic_fetch_add(p, v, __ATOMIC_RELAXED, __HIP_MEMORY_SCOPE_AGENT); }
__device__ __forceinline__ unsigned xb_xcc_id() { return (unsigned)__builtin_amdgcn_s_getreg((3 << 11) | 20) & 0xFu; }
#define XB_SPIN(cond, bar) do { unsigned _sp = 0; while (cond) { __builtin_amdgcn_s_sleep(1); \
    if ((++_sp & 255u) == 0u) { if (xb_ld(&(bar)[XB_TMO])) break; if (_sp > XB_SPIN_CAP) { atomicAdd(&(bar)[XB_TMO], 1u); break; } } } } while (0)

struct XcdBarrier {
    unsigned* bar; unsigned x;
    volatile LAS unsigned* st;
};

__device__ __forceinline__ XcdBarrier xcd_barrier_post(unsigned* bar, volatile LAS unsigned* st) {
    XcdBarrier b; b.bar = bar; b.x = xb_xcc_id(); b.st = st;
    if (threadIdx.x == 0) (void)xb_add(&bar[XB_XCNT(b.x)], 1u);
    return b;
}
__device__ __forceinline__ void xcd_barrier_complete(unsigned* bar, unsigned x, unsigned& nloc, unsigned& nx) {
    const unsigned G = gridDim.x * gridDim.y * gridDim.z;
    unsigned sum, cnt, mine, sp = 0u;
    for (;;) {
        sum = 0u; cnt = 0u; mine = 0u;
#pragma unroll
        for (unsigned j = 0; j < 16; ++j) { const unsigned c = xb_ld(&bar[XB_XCNT(j)]); sum += c; cnt += (c > 0u) ? 1u : 0u; mine = (j == x) ? c : mine; }
        if (sum == G) break;
        __builtin_amdgcn_s_sleep(1);
        if ((++sp & 255u) == 0u) { if (xb_ld(&bar[XB_TMO])) break; if (sp > XB_SPIN_CAP) { atomicAdd(&bar[XB_TMO], 1u); break; } }
    }
    nloc = mine > 0u ? mine : 1u; nx = cnt > 0u ? cnt : 1u;
}

__device__ __forceinline__ void xcd_barrier(const XcdBarrier& b) {
    asm volatile("s_waitcnt vmcnt(0)" ::: "memory");
    __syncthreads();
    if (threadIdx.x == 0) {
        unsigned* bar = b.bar;
        __builtin_amdgcn_s_waitcnt(0);
        unsigned nloc = b.st[0], nx = b.st[1];
        if (nloc == 0u) { xcd_barrier_complete(bar, b.x, nloc, nx); b.st[0] = nloc; b.st[1] = nx; }
        const unsigned old = xb_add(&bar[XB_XSUB(b.x)], 1u);
        const unsigned gen = old / nloc;
        if (old + 1u == (gen + 1u) * nloc) {
            __builtin_amdgcn_fence(__ATOMIC_RELEASE, "agent");
            asm volatile("s_waitcnt vmcnt(0)" ::: "memory");
            const unsigned og = xb_add(&bar[XB_TOP], 1u);
            const unsigned tg = og / nx;
            if (og + 1u == (tg + 1u) * nx) xb_add(&bar[XB_TOPGEN], 1u);
            else XB_SPIN(xb_ld(&bar[XB_TOPGEN]) == tg, bar);
            __builtin_amdgcn_fence(__ATOMIC_ACQUIRE, "agent");
            xb_add(&bar[XB_XGEN(b.x)], 1u);
            asm volatile("s_waitcnt vmcnt(0)" ::: "memory");
        } else {
            XB_SPIN(xb_ld(&bar[XB_XGEN(b.x)]) == gen, bar);
            __builtin_amdgcn_fence(__ATOMIC_ACQUIRE, "agent");
            asm volatile("s_waitcnt vmcnt(0)" ::: "memory");
        }
    }
    __syncthreads();
}


__global__ void __launch_bounds__(NTHREADS) hymba_fwd(Params p) {
    extern __shared__ __attribute__((aligned(16))) unsigned char lds[];
    cg::grid_group grid = cg::this_grid();
    volatile LAS unsigned* bst = (volatile LAS unsigned*)((LAS unsigned char*)lds + BAR_LDS_OFF);
    if (threadIdx.x < 2) bst[threadIdx.x] = 0u;
    __syncthreads();
    XcdBarrier xbar = xcd_barrier_post((unsigned*)(p.ws + WS_CTL), bst);
#define RUN_PHASE(k, body) do { if (p.ph_lo <= (k) && (k) < p.ph_hi) { body; if ((k) + 1 < p.ph_hi) { xcd_barrier(xbar); } } } while (0)
    RUN_PHASE(0, phase_prologue(p, lds));
    RUN_PHASE(1, gemm_in(p, 0, lds));
    RUN_PHASE(2, phase_mixers(p, 0, lds));
    RUN_PHASE(3, gemm_out<0>(p, lds));
    RUN_PHASE(4, gemm_in(p, 1, lds));
    RUN_PHASE(5, phase_mixers(p, 1, lds));
    RUN_PHASE(6, gemm_out<1>(p, lds));
    RUN_PHASE(7, phase_final(p));
#undef RUN_PHASE
}

extern "C" void kernel_launch(void* const* d_in, const int* in_sizes, int n_in, void* d_out, int out_size, void* d_ws, size_t ws_size, hipStream_t stream) {
    static int grid_blocks = 0;
    if (!grid_blocks) {
        int dev = 0, cus = 0, per_cu = 0;
        hipGetDevice(&dev);
        hipDeviceGetAttribute(&cus, hipDeviceAttributeMultiprocessorCount, dev);
        hipFuncSetAttribute((const void*)hymba_fwd, hipFuncAttributeMaxDynamicSharedMemorySize, LDS_BYTES);
        hipOccupancyMaxActiveBlocksPerMultiprocessor(&per_cu, (const void*)hymba_fwd, NTHREADS, LDS_BYTES);
        if (per_cu < 1) per_cu = 1;
        grid_blocks = cus * per_cu;
        if (ws_size < WS_END) fprintf(stderr, "kernel_launch: workspace too small (%zu < %zu)\n", ws_size, (size_t)WS_END);
    }
    Params p{};
    p.x = (const float*)d_in[0]; p.norm_g = (const float*)d_in[1]; p.w_in = (const float*)d_in[2]; p.conv_w = (const float*)d_in[3]; p.conv_b = (const float*)d_in[4];
    p.ln_g = (const float*)d_in[5]; p.ln_b = (const float*)d_in[6]; p.pw_w = (const float*)d_in[7]; p.pw_b = (const float*)d_in[8]; p.w_out = (const float*)d_in[9];
    p.final_g = (const float*)d_in[10]; p.out = (float*)d_out; p.ws = (unsigned char*)d_ws;
    (void)hipMemsetAsync((char*)d_ws + WS_CTL, 0, 32768, stream);
#if ONE_LAUNCH
    p.ph_lo = 0; p.ph_hi = NPHASES;
    { void* args[] = {&p};
      hipError_t e = hipLaunchCooperativeKernel((const void*)hymba_fwd, dim3(grid_blocks), dim3(NTHREADS), args, LDS_BYTES, stream);
      if (e != hipSuccess) fprintf(stderr, "cooperative launch failed: %s (grid %d)\n", hipGetErrorString(e), grid_blocks); }
#else
    for (int ph = 0; ph < NPHASES; ++ph) {
        p.ph_lo = ph; p.ph_hi = ph + 1; void* args[] = {&p};
        hipError_t e = hipLaunchCooperativeKernel((const void*)hymba_fwd, dim3(grid_blocks), dim3(NTHREADS), args, LDS_BYTES, stream);
        if (e != hipSuccess) { fprintf(stderr, "cooperative launch failed: %s (grid %d, phase %d)\n", hipGetErrorString(e), grid_blocks, ph); break; }
    }
#endif
}
```

```cpp
#include <hip/hip_runtime.h>
#include <hip/hip_cooperative_groups.h>
#include <cstdio>
#include <cstdint>
namespace cg = cooperative_groups;

#ifndef ONE_LAUNCH
#define ONE_LAUNCH 1
#endif

typedef _Float16 h16;
typedef _Float16 h16x8 __attribute__((ext_vector_type(8)));
typedef _Float16 h16x4 __attribute__((ext_vector_type(4)));
typedef float f32x16 __attribute__((ext_vector_type(16)));
typedef float f32x4 __attribute__((ext_vector_type(4)));
typedef unsigned u32x4 __attribute__((ext_vector_type(4)));

constexpr int BATCH = 8, SEQ = 4096, DM = 1024, MROWS = BATCH * SEQ, NIN = 3840, DEPTH = 2;
constexpr int C_AVAL = 0, C_AGLU = 256, C_AGATE = 512, C_RQ = 768, C_RK = 1024, C_RV = 1280, C_RGATE = 1536, C_MQ = 1792, C_MK = 2304, C_MV = 2816, C_MGATE = 3328;
constexpr int NPART = 16;
constexpr int NTHREADS = 512;
constexpr int LDS_BYTES = 147456;
constexpr int NPHASES = 8;

constexpr size_t MiB = 1u << 20;
constexpr size_t WS_XH = 0, WS_PROJ = 64 * MiB, WS_MIX = 304 * MiB, WS_WIN = 368 * MiB, WS_WOUT = 383 * MiB, WS_WPW = 387 * MiB,
                 WS_KV = 388 * MiB, WS_KMEAN = 404 * MiB  , WS_ROWSS = 405 * MiB, WS_CTL = 408 * MiB  , WS_RST = 409 * MiB  , WS_END = 417 * MiB;
constexpr int BAR_LDS_OFF = LDS_BYTES - 64;

struct Params {
    const float *x, *norm_g, *w_in, *conv_w, *conv_b, *ln_g, *ln_b, *pw_w, *pw_b, *w_out, *final_g;
    float* out; unsigned char* ws;
    int ph_lo, ph_hi;
};

__device__ __forceinline__ float silu_f(float v) { return v * __builtin_amdgcn_rcpf(1.0f + __expf(-v)); }
__device__ __forceinline__ int crow(int r, int h) { return (r & 3) + 8 * (r >> 2) + 4 * h; }
__device__ __forceinline__ float wave_sum(float v) {
#pragma unroll
    for (int o = 1; o < 64; o <<= 1) v += __shfl_xor(v, o);
    return v;
}

__device__ __forceinline__ void transpose_unit(const float* W, int K, int N, h16* WT, const float* g, int k0, int n0, float* tile) {
    const int tid = threadIdx.x;
    __syncthreads();
#pragma unroll
    for (int i = 0; i < 8; ++i) { const int k = i * 8 + (tid >> 6), n = tid & 63; float v = W[(size_t)(k0 + k) * N + n0 + n]; if (g) v *= g[k0 + k]; tile[k * 65 + n] = v; }
    __syncthreads();
    { const int n = tid >> 3, kc = tid & 7; h16x8 w;
#pragma unroll
        for (int i = 0; i < 8; ++i) w[i] = (h16)tile[(kc * 8 + i) * 65 + n];
        *(h16x8*)(WT + (size_t)(n0 + n) * K + k0 + kc * 8) = w; }
}

__device__ __forceinline__ void phase_prologue(const Params& p, unsigned char* lds) {
    float* tile = (float*)lds;
    h16* win = (h16*)(p.ws + WS_WIN);
    constexpr int U_IN = 16 * 60;
    for (int r = blockIdx.x; r < U_IN; r += gridDim.x)
        transpose_unit(p.w_in, DM, NIN, win, p.norm_g, (r / 60) * 64, (r % 60) * 64, tile);
    h16* xh = (h16*)(p.ws + WS_XH); float* rowss = (float*)(p.ws + WS_ROWSS);
    const int lane = threadIdx.x & 63, wid = threadIdx.x >> 6;
    for (int row = blockIdx.x * 8 + wid; row < MROWS; row += gridDim.x * 8) {
        const f32x4* xr = (const f32x4*)(p.x + (size_t)row * DM) + lane;
        float ss = 0.f;
#pragma unroll
        for (int j = 0; j < 4; ++j) { const f32x4 v = xr[64 * j]; ss += v.x * v.x + v.y * v.y + v.z * v.z + v.w * v.w;
            h16x4 o; o.x = (h16)v.x; o.y = (h16)v.y; o.z = (h16)v.z; o.w = (h16)v.w; *((h16x4*)(xh + (size_t)row * DM) + lane + 64 * j) = o; }
        ss = wave_sum(ss);
        if (lane < NPART) rowss[(size_t)row * NPART + lane] = (lane == 0) ? ss : 0.f;
    }
}

typedef short s16x4 __attribute__((ext_vector_type(4)));
#define LAS __attribute__((address_space(3)))
__device__ __forceinline__ float xhalf_max(float v) { auto rr = __builtin_amdgcn_permlane32_swap(__float_as_uint(v), __float_as_uint(v), false, false); return fmaxf(__uint_as_float(rr[0]), __uint_as_float(rr[1])); }
__device__ __forceinline__ float xhalf_sum(float v) { auto rr = __builtin_amdgcn_permlane32_swap(__float_as_uint(v), __float_as_uint(v), false, false); return __uint_as_float(rr[0]) + __uint_as_float(rr[1]); }
__device__ __forceinline__ h16x8 tr_frag(const LAS unsigned char* a) {
    const s16x4 lo = __builtin_amdgcn_ds_read_tr16_b64_v4i16((LAS s16x4*)a), hi = __builtin_amdgcn_ds_read_tr16_b64_v4i16((LAS s16x4*)(a + 512));
    typedef short s16x8 __attribute__((ext_vector_type(8)));
    const s16x8 v = __builtin_shufflevector(lo, hi, 0, 1, 2, 3, 4, 5, 6, 7);
    return __builtin_bit_cast(h16x8, v);
}
#define CROW0(i) (((i) & 3) + 8 * ((i) >> 2))
__device__ __forceinline__ void glds16(const void* gsrc, unsigned lds_dst) { unsigned keep;
    asm volatile("s_mov_b32 %0, m0\n\ts_mov_b32 m0, %2\n\ts_nop 0\n\tglobal_load_lds_dwordx4 %1, off\n\ts_mov_b32 m0, %0" : "=&s"(keep) : "v"(gsrc), "s"(lds_dst) : "memory"); }

namespace pg8 {
#define PG8_LAS __attribute__((address_space(3)))
typedef _Float16 bf16_t;
typedef _Float16 bf16x8 __attribute__((ext_vector_type(8)));
typedef float f32x4 __attribute__((ext_vector_type(4)));
typedef unsigned u32x4 __attribute__((ext_vector_type(4)));
constexpr int BM = 256, BK = 64, HALF = 128, HTB = HALF * BK * 2  , STAGE_BYTES = 8 * HTB, NXCD = 8, WGM = 8;

__host__ __device__ __forceinline__ int lds_byte(int r, int c) { const int st = (r >> 4) * 2 + (c >> 5), rr = r & 15, cc = c & 31, ob = rr * 64 + cc * 2; return st * 1024 + (ob ^ (((ob >> 9) & 1) << 5)); }
__host__ __device__ __forceinline__ void stage_rc(int b, int& R, int& C) { const int st = b / 1024, sb = b % 1024, swz = sb ^ (((sb >> 9) & 1) << 5); R = (st >> 1) * 16 + swz / 64; C = (st & 1) * 32 + (swz % 64) / 2; }
__host__ __device__ __forceinline__ int perm32(int rho) { const int n = rho >> 4, i = rho & 15; return 8 * (i >> 2) + 4 * n + (i & 3); }

struct Unit { int pm, pn; };
struct Gemm { const bf16_t* A; const bf16_t* Bt; int M, N, K; };

struct StaticOrder {
    int nM, nN, nwg, G, c;
    __host__ __device__ void init(int M, int N, int G_, int c_) { nM = M / BM; nN = N / BM; nwg = nM * nN; G = G_; c = c_; }
    __host__ __device__ bool next(int i, Unit& u) const {
        const long L = (long)i * G + c; if (L >= nwg) return false;
        int wgid = (int)L; { const int q = nwg / NXCD, r = nwg % NXCD, xcd = wgid % NXCD, off = wgid / NXCD; wgid = (xcd < r ? xcd * (q + 1) : r * (q + 1) + (xcd - r) * q) + off; }
        const int nig = WGM * nN, gid = wgid / nig, fm = gid * WGM, gsz = (nM - fm) < WGM ? (nM - fm) : WGM;
        u.pm = fm + ((wgid % nig) % gsz); u.pn = (wgid % nig) / gsz; return true;
    }
    __device__ __forceinline__ void a_ready(const Unit&) const {}
    __device__ __forceinline__ void done(const Unit&) const {}
};

template <class Epi, class Sched, bool ALIGN_EPI = false, bool SP2 = false>
__device__ __forceinline__ void gemm_phase(PG8_LAS unsigned char* lds, const Gemm g, const Sched& S, const Epi& E) {
    const int tid = threadIdx.x, wid = __builtin_amdgcn_readfirstlane(tid >> 6), lane = tid & 63, wr = wid >> 2, wc = wid & 3, fr = lane & 15, fq = lane >> 4;
    const int K = g.K, nt = K / BK;
    unsigned voffA[2], voffB[2];
#pragma unroll
    for (int i = 0; i < 2; ++i) { int R, C; stage_rc(tid * 16 + i * 8192, R, C); const int Rb = Epi::PERM ? ((R & ~31) + perm32(R & 31)) : R;
        voffA[i] = (unsigned)(R * K + C) * 2u; voffB[i] = (unsigned)(Rb * K + C) * 2u; }
    const size_t kstep = (size_t)(BK * 2);
    const size_t hstep = (size_t)HALF * K * 2;
    const size_t tstep = 2 * hstep;
    const unsigned ldsw = (unsigned)wid * 1024u;
    const int aoff = lds_byte(wr * 64 + fr, fq * 8), boff = lds_byte(wc * 32 + fr, fq * 8);
#define PG8_SA(b, h) (((b) * 2 + (h)) * HTB)
#define PG8_SB(b, h) ((4 + (b) * 2 + (h)) * HTB)
#define PG8_STAGE(bufoff, gbase, voff) do { _Pragma("unroll") for (int _i = 0; _i < 2; ++_i) \
        __builtin_amdgcn_global_load_lds((const unsigned*)((const char*)(gbase) + (voff)[_i]), (PG8_LAS unsigned*)(lds + (bufoff) + ldsw + _i * 8192), 16, 0, 0); } while (0)
#define PG8_LDA(dst, b, h) do { _Pragma("unroll") for (int m = 0; m < 4; ++m) _Pragma("unroll") for (int k = 0; k < 2; ++k) dst[m][k] = *(const PG8_LAS bf16x8*)(lds + PG8_SA(b, h) + aoff + m * 2048 + k * 1024); } while (0)
#define PG8_LDB(dst, b, h) do { _Pragma("unroll") for (int n = 0; n < 2; ++n) _Pragma("unroll") for (int k = 0; k < 2; ++k) dst[n][k] = *(const PG8_LAS bf16x8*)(lds + PG8_SB(b, h) + boff + n * 2048 + k * 1024); } while (0)
#define PG8_MMA(ai, bj, At, Bt) do { __builtin_amdgcn_s_setprio(1); _Pragma("unroll") for (int m = 0; m < 4; ++m) _Pragma("unroll") for (int n = 0; n < 2; ++n) _Pragma("unroll") for (int k = 0; k < 2; ++k) \
        acc[ai][bj][m][n] = __builtin_amdgcn_mfma_f32_16x16x32_f16(Bt[n][k], At[m][k], acc[ai][bj][m][n], 0, 0, 0); __builtin_amdgcn_s_setprio(0); } while (0)
#define PG8_WAIT_V(n) asm volatile("s_waitcnt vmcnt(" #n ")" ::: "memory")
#define PG8_WAIT_L(n) asm volatile("s_waitcnt lgkmcnt(" #n ")" ::: "memory")
#define PG8_BAR __builtin_amdgcn_s_barrier()
#define PG8_SCHED __builtin_amdgcn_sched_barrier(0)
    Unit cur, nxt; int ui = 0;
    if (!S.next(0, cur)) return;
    f32x4 acc[2][2][4][2];
#pragma unroll
    for (int a = 0; a < 2; ++a)
#pragma unroll
        for (int b = 0; b < 2; ++b)
#pragma unroll
            for (int m = 0; m < 4; ++m)
#pragma unroll
                for (int n = 0; n < 2; ++n) acc[a][b][m][n] = (f32x4){0.f, 0.f, 0.f, 0.f};
    bf16x8 At[4][2], B0[2][2], B1[2][2];
    const char* cA = (const char*)g.A + (size_t)cur.pm * tstep; const char* cB = (const char*)g.Bt + (size_t)cur.pn * tstep;
    S.a_ready(cur);
    if constexpr (SP2) {
        PG8_STAGE(PG8_SB(0, 0), cB, voffB); PG8_STAGE(PG8_SB(0, 1), cB + hstep, voffB); PG8_STAGE(PG8_SA(0, 0), cA, voffA); PG8_STAGE(PG8_SA(0, 1), cA + hstep, voffA);
        if (wr == 1) PG8_BAR;
        PG8_WAIT_V(2); PG8_BAR;
        PG8_STAGE(PG8_SB(1, 0), cB + kstep, voffB); PG8_STAGE(PG8_SA(1, 0), cA + kstep, voffA); PG8_STAGE(PG8_SB(1, 1), cB + hstep + kstep, voffB);
        PG8_WAIT_V(6); PG8_BAR;
    } else {
        PG8_STAGE(PG8_SB(0, 0), cB, voffB); PG8_STAGE(PG8_SA(0, 0), cA, voffA); PG8_STAGE(PG8_SB(0, 1), cB + hstep, voffB); PG8_STAGE(PG8_SA(0, 1), cA + hstep, voffA);
        if (wr == 1) PG8_BAR;
        PG8_WAIT_V(4); PG8_BAR;
        PG8_STAGE(PG8_SB(1, 0), cB + kstep, voffB); PG8_STAGE(PG8_SA(1, 0), cA + kstep, voffA); PG8_STAGE(PG8_SB(1, 1), cB + hstep + kstep, voffB);
        PG8_WAIT_V(6); PG8_BAR;
    }
    for (;;) {
        const bool has_next = S.next(ui + 1, nxt);
        const char* nA = has_next ? (const char*)g.A + (size_t)nxt.pm * tstep : cA; const char* nB = has_next ? (const char*)g.Bt + (size_t)nxt.pn * tstep : cB;
        for (int t = 0; t < nt; t += 2) {
            const bool last = (t == nt - 2);
            const char* a1 = cA + (size_t)(t + 1) * kstep;
            const char* a2 = last ? nA : cA + (size_t)(t + 2) * kstep; const char* b2 = last ? nB : cB + (size_t)(t + 2) * kstep;
            const char* a3 = a2 + kstep; const char* b3 = b2 + kstep;
            if (last && has_next) S.a_ready(nxt);
            if constexpr (SP2) {
            PG8_LDB(B0, 0, 0); PG8_LDB(B1, 0, 1); PG8_SCHED; PG8_LDA(At, 0, 0); PG8_STAGE(PG8_SA(1, 1), a1 + hstep, voffA);
            PG8_WAIT_V(8); PG8_WAIT_L(0); PG8_BAR; PG8_MMA(0, 0, At, B0); PG8_MMA(0, 1, At, B1); PG8_BAR; PG8_SCHED;
            PG8_LDA(At, 0, 1); PG8_STAGE(PG8_SB(0, 0), b2, voffB); PG8_STAGE(PG8_SB(0, 1), b2 + hstep, voffB); PG8_STAGE(PG8_SA(0, 0), a2, voffA);
            PG8_WAIT_V(8); PG8_WAIT_L(0); PG8_BAR; PG8_MMA(1, 0, At, B0); PG8_MMA(1, 1, At, B1); PG8_BAR; PG8_SCHED;
            PG8_LDB(B0, 1, 0); PG8_LDB(B1, 1, 1); PG8_SCHED; PG8_LDA(At, 1, 0); PG8_STAGE(PG8_SA(0, 1), a2 + hstep, voffA);
            PG8_WAIT_V(8); PG8_WAIT_L(0); PG8_BAR; PG8_MMA(0, 0, At, B0); PG8_MMA(0, 1, At, B1); PG8_BAR; PG8_SCHED;
            PG8_LDA(At, 1, 1); PG8_STAGE(PG8_SB(1, 0), b3, voffB); PG8_STAGE(PG8_SB(1, 1), b3 + hstep, voffB); PG8_STAGE(PG8_SA(1, 0), a3, voffA);
            PG8_WAIT_V(8); PG8_WAIT_L(0); PG8_BAR; PG8_MMA(1, 0, At, B0); PG8_MMA(1, 1, At, B1); PG8_BAR; PG8_SCHED;
            } else {
            PG8_LDB(B0, 0, 0); PG8_SCHED; PG8_LDA(At, 0, 0); PG8_STAGE(PG8_SA(1, 1), a1 + hstep, voffA);
            PG8_WAIT_L(8); PG8_BAR; PG8_WAIT_L(0); PG8_MMA(0, 0, At, B0); PG8_BAR; PG8_SCHED;
            PG8_LDB(B1, 0, 1); PG8_STAGE(PG8_SB(0, 0), b2, voffB);
            PG8_BAR; PG8_WAIT_L(0); PG8_MMA(0, 1, At, B1); PG8_BAR;
            PG8_LDA(At, 0, 1); PG8_STAGE(PG8_SA(0, 0), a2, voffA);
            PG8_BAR; PG8_WAIT_L(0); PG8_MMA(1, 0, At, B0); PG8_BAR; PG8_SCHED;
            PG8_STAGE(PG8_SB(0, 1), b2 + hstep, voffB);
            PG8_WAIT_V(6); PG8_BAR; PG8_MMA(1, 1, At, B1); PG8_BAR;
            PG8_LDB(B0, 1, 0); PG8_SCHED; PG8_LDA(At, 1, 0); PG8_STAGE(PG8_SA(0, 1), a2 + hstep, voffA);
            PG8_WAIT_L(8); PG8_BAR; PG8_WAIT_L(0); PG8_MMA(0, 0, At, B0); PG8_BAR; PG8_SCHED;
            PG8_LDB(B1, 1, 1); PG8_STAGE(PG8_SB(1, 0), b3, voffB);
            PG8_BAR; PG8_WAIT_L(0); PG8_MMA(0, 1, At, B1); PG8_BAR;
            PG8_LDA(At, 1, 1); PG8_STAGE(PG8_SA(1, 0), a3, voffA);
            PG8_BAR; PG8_WAIT_L(0); PG8_MMA(1, 0, At, B0); PG8_BAR; PG8_SCHED;
            PG8_STAGE(PG8_SB(1, 1), b3 + hstep, voffB);
            PG8_WAIT_V(6); PG8_BAR; PG8_MMA(1, 1, At, B1); PG8_BAR;
            }
        }
        if constexpr (ALIGN_EPI) { if (wr == 0) PG8_BAR; }
        if constexpr (!Epi::AFTER_DRAIN) { E(acc, cur, wr, wc, fr, fq); S.done(cur); }
        if (!has_next) break;
#pragma unroll
        for (int a = 0; a < 2; ++a)
#pragma unroll
            for (int b = 0; b < 2; ++b)
#pragma unroll
                for (int m = 0; m < 4; ++m)
#pragma unroll
                    for (int n = 0; n < 2; ++n) acc[a][b][m][n] = (f32x4){0.f, 0.f, 0.f, 0.f};
        cur = nxt; cA = nA; cB = nB; ++ui;
        if constexpr (ALIGN_EPI) { if (wr == 1) PG8_BAR; }
    }
    PG8_WAIT_V(0);
    if constexpr (!ALIGN_EPI) { if (wr == 0) PG8_BAR; }
    PG8_BAR;
    if constexpr (Epi::AFTER_DRAIN) { E.fused(acc, cur, wr, wc, fr, fq, lds, wid, lane); S.done(cur); }
#undef PG8_SA
#undef PG8_SB
#undef PG8_STAGE
#undef PG8_LDA
#undef PG8_LDB
#undef PG8_MMA
#undef PG8_WAIT_V
#undef PG8_WAIT_L
#undef PG8_BAR
#undef PG8_SCHED
}

struct EpiProj {
    static constexpr bool PERM = true, AFTER_DRAIN = false;
    bf16_t* O; const float* rowss; float* kmpart;
    __device__ __forceinline__ void operator()(const f32x4 (&acc)[2][2][4][2], const Unit& u, int wr, int wc, int fr, int fq) const {
        const int row0 = u.pm * BM + wr * 64 + fr, col0 = u.pn * BM + wc * 32 + 8 * fq;
        const bool want_km = (u.pn == 9) || (u.pn == 10);
        f32x4 cs[2][2];
#pragma unroll
        for (int bj = 0; bj < 2; ++bj)
#pragma unroll
            for (int n = 0; n < 2; ++n) cs[bj][n] = (f32x4){0.f, 0.f, 0.f, 0.f};
#pragma unroll
        for (int ai = 0; ai < 2; ++ai)
#pragma unroll
            for (int m = 0; m < 4; ++m) { const size_t row = (size_t)(row0 + ai * HALF + m * 16);
                const f32x4* rs = (const f32x4*)(rowss + row * 16); const f32x4 s0 = rs[0], s1 = rs[1], s2 = rs[2], s3 = rs[3];
                const float tot = ((s0[0] + s0[1]) + (s0[2] + s0[3])) + ((s1[0] + s1[1]) + (s1[2] + s1[3])) + ((s2[0] + s2[1]) + (s2[2] + s2[3])) + ((s3[0] + s3[1]) + (s3[2] + s3[3]));
                const float rstd = rsqrtf(tot * (1.0f / 1024.0f) + 1e-6f);
                bf16_t* rowp = O + row * 3840 + col0;
#pragma unroll
                for (int bj = 0; bj < 2; ++bj) { const f32x4 v0 = acc[ai][bj][m][0] * rstd, v1 = acc[ai][bj][m][1] * rstd; bf16x8 w;
                    w[0] = (bf16_t)v0[0]; w[1] = (bf16_t)v0[1]; w[2] = (bf16_t)v0[2]; w[3] = (bf16_t)v0[3]; w[4] = (bf16_t)v1[0]; w[5] = (bf16_t)v1[1]; w[6] = (bf16_t)v1[2]; w[7] = (bf16_t)v1[3];
                    *(bf16x8*)(rowp + bj * HALF) = w; cs[bj][0] += v0; cs[bj][1] += v1; } }
        if (want_km) {
#pragma unroll
            for (int bj = 0; bj < 2; ++bj)
#pragma unroll
                for (int n = 0; n < 2; ++n)
#pragma unroll
                    for (int k = 0; k < 4; ++k) { float v = cs[bj][n][k]; v += __shfl_xor(v, 1); v += __shfl_xor(v, 2); v += __shfl_xor(v, 4); v += __shfl_xor(v, 8); cs[bj][n][k] = v * (1.0f / 256.0f); }
            if (fr == 0) {
#pragma unroll
                for (int bj = 0; bj < 2; ++bj)
#pragma unroll
                    for (int n = 0; n < 2; ++n) { const int cm = col0 + bj * HALF + 4 * n - 2304;
                        *(f32x4*)(kmpart + ((size_t)((wr * 8 + (u.pm >> 4)) * 8 + (cm >> 6)) * 16 + (u.pm & 15)) * 64 + (cm & 63)) = cs[bj][n]; }
            }
        }
    }
};
template <int LAYER> struct EpiRes {
    static constexpr bool PERM = true, AFTER_DRAIN = false;
    const float* x0; float* xout; bf16_t* xh; float* rowss;
    __device__ __forceinline__ void operator()(const f32x4 (&acc)[2][2][4][2], const Unit& u, int wr, int wc, int fr, int fq) const {
        const int row0 = u.pm * BM + wr * 64 + fr, col0 = u.pn * BM + wc * 32 + 8 * fq;
#pragma unroll
        for (int ai = 0; ai < 2; ++ai)
#pragma unroll
            for (int m = 0; m < 4; ++m) { const size_t row = (size_t)(row0 + ai * HALF + m * 16); float ss = 0.f;
#pragma unroll
                for (int bj = 0; bj < 2; ++bj) { const size_t off = row * 1024 + col0 + bj * HALF; f32x4 v0, v1;
                    if (LAYER == 0) { const bf16x8 xq = *(const bf16x8*)(xh + off);
                        v0 = (f32x4){(float)xq[0], (float)xq[1], (float)xq[2], (float)xq[3]} + acc[ai][bj][m][0]; v1 = (f32x4){(float)xq[4], (float)xq[5], (float)xq[6], (float)xq[7]} + acc[ai][bj][m][1];
                        bf16x8 w; w[0] = (bf16_t)v0[0]; w[1] = (bf16_t)v0[1]; w[2] = (bf16_t)v0[2]; w[3] = (bf16_t)v0[3]; w[4] = (bf16_t)v1[0]; w[5] = (bf16_t)v1[1]; w[6] = (bf16_t)v1[2]; w[7] = (bf16_t)v1[3];
                        *(bf16x8*)(xh + off) = w; }
                    else { const bf16x8 xp = *(const bf16x8*)(xh + off);
                        v0 = (f32x4){(float)xp[0], (float)xp[1], (float)xp[2], (float)xp[3]} + acc[ai][bj][m][0]; v1 = (f32x4){(float)xp[4], (float)xp[5], (float)xp[6], (float)xp[7]} + acc[ai][bj][m][1];
                        bf16x8 w; w[0] = (bf16_t)v0[0]; w[1] = (bf16_t)v0[1]; w[2] = (bf16_t)v0[2]; w[3] = (bf16_t)v0[3]; w[4] = (bf16_t)v1[0]; w[5] = (bf16_t)v1[1]; w[6] = (bf16_t)v1[2]; w[7] = (bf16_t)v1[3];
                        *(bf16x8*)(xh + off) = w; }
                    ss += ((v0[0] * v0[0] + v0[1] * v0[1]) + (v0[2] * v0[2] + v0[3] * v0[3])) + ((v1[0] * v1[0] + v1[1] * v1[1]) + (v1[2] * v1[2] + v1[3] * v1[3])); }
                ss += __shfl_xor(ss, 16); ss += __shfl_xor(ss, 32);
                if (fq == 0) rowss[row * 16 + u.pn * 4 + wc] = ss; }
    }
};
}


__device__ __forceinline__ void deferred_transposes(const Params& p, unsigned char* lds, int id, int n) {
    float* tile = (float*)lds;
    h16* win = (h16*)(p.ws + WS_WIN); h16* wout = (h16*)(p.ws + WS_WOUT); h16* wpw = (h16*)(p.ws + WS_WPW);
    constexpr int U_IN = 16 * 60, U_OUT = 16 * 16, U_PW = 4 * 4;
    for (int u = id; u < U_IN + 2 * U_OUT + 2 * U_PW; u += n) {
        int r = u;
        if (r < U_IN) { transpose_unit(p.w_in + (size_t)DM * NIN, DM, NIN, win + (size_t)NIN * DM, p.norm_g + DM, (r / 60) * 64, (r % 60) * 64, tile); continue; }
        r -= U_IN;
        if (r < 2 * U_OUT) { const int layer = r / U_OUT; r %= U_OUT; transpose_unit(p.w_out + (size_t)layer * DM * DM, DM, DM, wout + (size_t)layer * DM * DM, nullptr, (r / 16) * 64, (r % 16) * 64, tile); continue; }
        r -= 2 * U_OUT;
        { const int layer = r / U_PW; r %= U_PW; transpose_unit(p.pw_w + (size_t)layer * 256 * 256, 256, 256, wpw + (size_t)layer * 256 * 256, nullptr, (r / 4) * 64, (r % 4) * 64, tile); }
    }
}

__device__ __forceinline__ void gemm_in(const Params& p, int layer, unsigned char* lds) {
    pg8::Gemm g{(const h16*)(p.ws + WS_XH), (const h16*)(p.ws + WS_WIN) + (size_t)layer * NIN * DM, MROWS, NIN, DM};
    pg8::StaticOrder S; S.init(MROWS, NIN, (int)gridDim.x, (int)blockIdx.x);
    pg8::EpiProj E{(h16*)(p.ws + WS_PROJ), (const float*)(p.ws + WS_ROWSS), (float*)(p.ws + WS_KMEAN)};
    pg8::gemm_phase<pg8::EpiProj, pg8::StaticOrder, true, true>((PG8_LAS unsigned char*)lds, g, S, E);
    if (layer == 0) { const int G = (int)gridDim.x, nfull = (MROWS / 256) * (NIN / 256) % G;
        if (nfull == 0) deferred_transposes(p, lds, (int)blockIdx.x, G); else if ((int)blockIdx.x >= nfull) deferred_transposes(p, lds, (int)blockIdx.x - nfull, G - nfull); }
}
template <int LAYER> __device__ __forceinline__ void gemm_out(const Params& p, unsigned char* lds) {
    pg8::Gemm g{(const h16*)(p.ws + WS_MIX), (const h16*)(p.ws + WS_WOUT) + (size_t)LAYER * DM * DM, MROWS, DM, DM};
    pg8::StaticOrder S; S.init(MROWS, DM, (int)gridDim.x, (int)blockIdx.x);
    pg8::EpiRes<LAYER> E{p.x, p.out, (h16*)(p.ws + WS_XH), (float*)(p.ws + WS_ROWSS)};
    pg8::gemm_phase<pg8::EpiRes<LAYER>, pg8::StaticOrder, true, true>((PG8_LAS unsigned char*)lds, g, S, E);
}

__device__ __forceinline__ void phase_stats(const Params& p, int layer, unsigned char* lds_g) {
    LAS unsigned char* lds = (LAS unsigned char*)lds_g;
    const h16* proj = (const h16*)(p.ws + WS_PROJ); float* kv = (float*)(p.ws + WS_KV);
    const int tid = threadIdx.x, lane = tid & 63, wid = __builtin_amdgcn_readfirstlane(tid >> 6), r = lane & 31, hi = lane >> 5;
    const int lanepart = (4 * hi + ((lane & 15) >> 2)) * 64 + ((lane >> 4) & 1) * 32 + (lane & 3) * 8;
#pragma unroll 1
    for (int u = blockIdx.x; u < 512; u += gridDim.x) {
        const int b = u >> 6, hh = (u >> 4) & 3, np = u & 15;
        const float log_g = logf(1.0f - exp2f(-5.0f - (float)hh));
        __syncthreads();
#pragma unroll
        for (int it = 0; it < 4; ++it) {
            const int pc = tid + 512 * it, cn = pc >> 10, key = (pc >> 3) & 127, ch = pc & 7;
            const h16* src = proj + (size_t)(b * SEQ + (2 * np + cn) * 128 + key) * NIN + hh * 64 + ch * 8;
            h16x8 kk = *(const h16x8*)(src + C_RK); const h16x8 vv = *(const h16x8*)(src + C_RV);
            const float z = __expf(log_g * (float)(127 - key)) * 0.125f;
#pragma unroll
            for (int k = 0; k < 8; ++k) kk[k] = (h16)((float)kk[k] * z);
            const int off = cn * 32768 + (ch >> 2) * 8192 + (key >> 4) * 1024 + (key & 15) * 64 + (ch & 3) * 16;
            *(LAS h16x8*)(lds + off) = kk; *(LAS h16x8*)(lds + off + 16384) = vv;
        }
        __syncthreads();
        const int cn = wid >> 2, eb = (wid >> 1) & 1, dbk = wid & 1;
        const LAS unsigned char* kimg = lds + cn * 32768 + dbk * 8192 + lanepart; const LAS unsigned char* vimg = lds + cn * 32768 + 16384 + eb * 8192 + lanepart;
        f32x16 acc;
#pragma unroll
        for (int i = 0; i < 16; ++i) acc[i] = 0.f;
#pragma unroll
        for (int ks = 0; ks < 8; ++ks) acc = __builtin_amdgcn_mfma_f32_32x32x16_f16(tr_frag(vimg + ks * 1024), tr_frag(kimg + ks * 1024), acc, 0, 0, 0);
        float* dst = kv + ((size_t)((b * 4 + hh) * 32 + 2 * np + cn)) * 4096 + (32 * eb + 4 * hi) * 64 + 32 * dbk + r;
#pragma unroll
        for (int i = 0; i < 16; ++i) dst[CROW0(i) * 64] = acc[i];
    }
#pragma unroll 1
    for (int u = blockIdx.x; u < 1024; u += gridDim.x) {
        const int b = u >> 7, row = (u & 127) * 32 + (tid >> 4), part = tid & 15;
        const h16* src = proj + (size_t)(b * SEQ + row) * NIN + C_MK + part * 32;
        float ss = 0.f;
#pragma unroll
        for (int k = 0; k < 4; ++k) { const h16x8 kk = *(const h16x8*)(src + k * 8);
#pragma unroll
            for (int d = 0; d < 8; ++d) ss += (float)kk[d] * (float)kk[d]; }
        ss += __shfl_xor(ss, 1);
        ss = fmaxf(ss, __shfl_xor(ss, 16)); ss = fmaxf(ss, __shfl_xor(ss, 32));
        if ((lane & 0x31) == 0) atomicMax((unsigned*)(p.ws + WS_CTL + 20480) + layer * 64 + b * 8 + (part >> 1), __float_as_uint(ss));
    }
}

typedef _Float16 h16x2 __attribute__((ext_vector_type(2)));
typedef float f32x2 __attribute__((ext_vector_type(2)));
__device__ __forceinline__ void conv_unit(const Params& p, int layer, int b, int tt, unsigned char* lds_g) {
    LAS unsigned char* lds = (LAS unsigned char*)lds_g;
    const h16* projb = (const h16*)(p.ws + WS_PROJ) + (size_t)b * SEQ * NIN; h16* mix = (h16*)(p.ws + WS_MIX);
    const int tid = threadIdx.x, lane = tid & 63, wid = __builtin_amdgcn_readfirstlane(tid >> 6), r = lane & 31, hi = lane >> 5;
    const int cp = tid & 127, tg = __builtin_amdgcn_readfirstlane(tid >> 7), t0 = tt * 64, tb0 = t0 + 16 * tg - 30;
    constexpr int YS = 0, SIMG = 65536;
    float y0[16], y1[16];
    {
        float w0[31], w1[31]; const float* cw = p.conv_w + (size_t)layer * 31 * 256 + 2 * cp;
#pragma unroll
        for (int jj = 0; jj < 31; ++jj) { const f32x2 wv = *(const f32x2*)(cw + jj * 256); w0[jj] = wv[0]; w1[jj] = wv[1]; }
        const f32x2 cbv = *(const f32x2*)(p.conv_b + layer * 256 + 2 * cp);
#pragma unroll
        for (int tl = 0; tl < 16; ++tl) { y0[tl] = cbv[0]; y1[tl] = cbv[1]; }
#pragma unroll
        for (int rr = 0; rr < 46; ++rr) {
            const int t = tb0 + rr; float a0 = 0.f, a1 = 0.f;
            if (t >= 0) { const h16x2 av = *(const h16x2*)(projb + (size_t)t * NIN + C_AVAL + 2 * cp), gv = *(const h16x2*)(projb + (size_t)t * NIN + C_AGLU + 2 * cp);
                a0 = (float)av[0] * __builtin_amdgcn_rcpf(1.0f + __expf(-(float)gv[0])); a1 = (float)av[1] * __builtin_amdgcn_rcpf(1.0f + __expf(-(float)gv[1])); }
#pragma unroll
            for (int tl = 0; tl < 16; ++tl) { const int jj = rr - tl; if (jj >= 0 && jj < 31) { y0[tl] += w0[jj] * a0; y1[tl] += w1[jj] * a1; } }
        }
    }
    __syncthreads();
#pragma unroll
    for (int tl = 0; tl < 16; ++tl) *(LAS f32x2*)(lds + YS + ((16 * tg + tl) * 256 + 2 * cp) * 4) = (f32x2){y0[tl], y1[tl]};
    h16x8 wf[16];
    {
        const h16* wp = (const h16*)(p.ws + WS_WPW) + (size_t)layer * 65536 + (size_t)(32 * wid + r) * 256 + 8 * hi;
#pragma unroll
        for (int ks = 0; ks < 16; ++ks) wf[ks] = *(const h16x8*)(wp + 16 * ks);
    }
    __syncthreads();
    {
        const f32x4 lg = *(const f32x4*)(p.ln_g + layer * 256 + lane * 4), lb = *(const f32x4*)(p.ln_b + layer * 256 + lane * 4);
#pragma unroll 1
        for (int kb = 0; kb < 8; kb += 4) {
        f32x4 v[4]; float s1[4], s2[4];
#pragma unroll
        for (int k = 0; k < 4; ++k) { v[k] = *(const LAS f32x4*)(lds + YS + ((wid * 8 + kb + k) * 256 + lane * 4) * 4);
            s1[k] = (v[k][0] + v[k][1]) + (v[k][2] + v[k][3]); s2[k] = (v[k][0] * v[k][0] + v[k][1] * v[k][1]) + (v[k][2] * v[k][2] + v[k][3] * v[k][3]); }
#pragma unroll
        for (int o = 1; o < 64; o <<= 1)
#pragma unroll
            for (int k = 0; k < 4; ++k) { s1[k] += __shfl_xor(s1[k], o); s2[k] += __shfl_xor(s2[k], o); }
#pragma unroll
        for (int k = 0; k < 4; ++k) { const int t = wid * 8 + kb + k; const float mu = s1[k] * (1.0f / 256.0f); const float var = fmaxf(s2[k] * (1.0f / 256.0f) - mu * mu, 0.f); const float rs = rsqrtf(var + 1e-5f);
            h16x4 o; o[0] = (h16)silu_f((v[k][0] - mu) * rs * lg[0] + lb[0]); o[1] = (h16)silu_f((v[k][1] - mu) * rs * lg[1] + lb[1]); o[2] = (h16)silu_f((v[k][2] - mu) * rs * lg[2] + lb[2]); o[3] = (h16)silu_f((v[k][3] - mu) * rs * lg[3] + lb[3]);
            *(LAS h16x4*)(lds + SIMG + t * 512 + (((lane >> 1) ^ (t & 15)) << 4) + 8 * (lane & 1)) = o; }
        }
    }
    __syncthreads();
#pragma unroll
    for (int tb = 0; tb < 2; ++tb) {
        f32x16 acc;
#pragma unroll
        for (int i = 0; i < 16; ++i) acc[i] = 0.f;
#pragma unroll
        for (int ks = 0; ks < 16; ++ks) acc = __builtin_amdgcn_mfma_f32_32x32x16_f16(wf[ks], *(const LAS h16x8*)(lds + SIMG + (32 * tb + r) * 512 + (((2 * ks + hi) ^ (r & 15)) << 4)), acc, 0, 0, 0);
        const int t = t0 + 32 * tb + r, n0 = 32 * wid + 4 * hi;
        const h16* gp = projb + (size_t)t * NIN + C_AGATE + n0; h16* dst = mix + ((size_t)b * SEQ + t) * DM + n0; const float* pb = p.pw_b + layer * 256 + n0;
#pragma unroll
        for (int g = 0; g < 4; ++g) { const h16x4 ga = *(const h16x4*)(gp + 8 * g); const f32x4 bb = *(const f32x4*)(pb + 8 * g); h16x4 oa;
#pragma unroll
            for (int k = 0; k < 4; ++k) oa[k] = (h16)((acc[4 * g + k] + bb[k]) * silu_f((float)ga[k]));
            *(h16x4*)(dst + 8 * g) = oa; }
    }
}

__device__ __forceinline__ void ret_unit(const Params& p, int b, int hh, int n, unsigned char* lds_g) {
    LAS unsigned char* lds = (LAS unsigned char*)lds_g;
    const h16* projb = (const h16*)(p.ws + WS_PROJ) + (size_t)(b * SEQ + n * 128) * NIN; h16* mix = (h16*)(p.ws + WS_MIX); const float* kv = (const float*)(p.ws + WS_KV);
    const int tid = threadIdx.x, lane = tid & 63, wid = __builtin_amdgcn_readfirstlane(tid >> 6), r = lane & 31, hi = lane >> 5, g4 = wid & 3, eh = wid >> 2;
    const float log_g = logf(1.0f - exp2f(-5.0f - (float)hh));
    constexpr int KIMG = 0, VIMG = 16384, RIMG = 32768, XS = 40960;
    const h16x8 rr = *(const h16x8*)((const h16*)(p.ws + WS_RST) + ((size_t)((b * 4 + hh) * 32 + n)) * 4096 + tid * 8);
    __syncthreads();
    {
        const int e = tid >> 3, ch = tid & 7;
        *(LAS h16x8*)(lds + RIMG + e * 128 + ((ch ^ ((e >> 1) & 7)) << 4)) = rr;
#pragma unroll
        for (int it = 0; it < 2; ++it) {
            const int key = (tid >> 3) + 64 * it;
            h16x8 kk = *(const h16x8*)(projb + (size_t)key * NIN + C_RK + hh * 64 + ch * 8); const h16x8 vv = *(const h16x8*)(projb + (size_t)key * NIN + C_RV + hh * 64 + ch * 8);
            const float z = __expf(-log_g * (float)key) * 0.125f;
#pragma unroll
            for (int k = 0; k < 8; ++k) kk[k] = (h16)((float)kk[k] * z);
            *(LAS h16x8*)(lds + KIMG + key * 128 + ((ch ^ ((key >> 1) & 7)) << 4)) = kk;
            *(LAS h16x8*)(lds + VIMG + (ch >> 2) * 8192 + (key >> 4) * 1024 + (key & 15) * 64 + (ch & 3) * 16) = vv;
        }
    }
    const int qi = 32 * g4 + r;
    h16x8 qf[4];
    {
        const float zq = __expf(log_g * (float)qi);
#pragma unroll
        for (int s = 0; s < 4; ++s) { qf[s] = *(const h16x8*)(projb + (size_t)qi * NIN + C_RQ + hh * 64 + 16 * s + 8 * hi);
#pragma unroll
            for (int k = 0; k < 8; ++k) qf[s][k] = (h16)((float)qf[s][k] * zq); }
    }
    __syncthreads();
    const int rsw = (r >> 1) & 7;
    const int lanepart = (4 * hi + ((lane & 15) >> 2)) * 64 + ((lane >> 4) & 1) * 32 + (lane & 3) * 8;
    f32x16 o;
#pragma unroll
    for (int i = 0; i < 16; ++i) o[i] = 0.f;
#pragma unroll 1
    for (int jb = 0; jb <= g4; ++jb) {
        f32x16 c;
#pragma unroll
        for (int i = 0; i < 16; ++i) c[i] = 0.f;
#pragma unroll
        for (int s = 0; s < 4; ++s) c = __builtin_amdgcn_mfma_f32_32x32x16_f16(*(const LAS h16x8*)(lds + KIMG + (32 * jb + r) * 128 + (((2 * s + hi) ^ rsw) << 4)), qf[s], c, 0, 0, 0);
        if (jb == g4) {
#pragma unroll
            for (int i = 0; i < 16; ++i) if (CROW0(i) + 4 * hi > r) c[i] = 0.f;
        }
        h16x8 pf0, pf1;
#pragma unroll
        for (int k = 0; k < 8; ++k) { pf0[k] = (h16)c[k]; pf1[k] = (h16)c[8 + k]; }
        o = __builtin_amdgcn_mfma_f32_32x32x16_f16(tr_frag(lds + VIMG + eh * 8192 + (2 * jb) * 1024 + lanepart), pf0, o, 0, 0, 0);
        o = __builtin_amdgcn_mfma_f32_32x32x16_f16(tr_frag(lds + VIMG + eh * 8192 + (2 * jb + 1) * 1024 + lanepart), pf1, o, 0, 0, 0);
    }
#pragma unroll
    for (int s = 0; s < 4; ++s) o = __builtin_amdgcn_mfma_f32_32x32x16_f16(*(const LAS h16x8*)(lds + RIMG + (32 * eh + r) * 128 + (((2 * s + hi) ^ rsw) << 4)), qf[s], o, 0, 0, 0);
    float s1 = 0.f, s2 = 0.f;
#pragma unroll
    for (int i = 0; i < 16; ++i) { s1 += o[i]; s2 += o[i] * o[i]; }
    s1 = xhalf_sum(s1); s2 = xhalf_sum(s2);
    LAS float* xs = (LAS float*)(lds + XS);
    if (hi == 0) { xs[(wid * 32 + r) * 2] = s1; xs[(wid * 32 + r) * 2 + 1] = s2; }
    __syncthreads();
    {
        const float t1 = xs[((wid ^ 4) * 32 + r) * 2], t2 = xs[((wid ^ 4) * 32 + r) * 2 + 1];
        const float a1 = (eh == 0) ? (s1 + t1) : (t1 + s1), a2 = (eh == 0) ? (s2 + t2) : (t2 + s2);
        const float mu = a1 * (1.0f / 64.0f); const float var = fmaxf(a2 * (1.0f / 64.0f) - mu * mu, 0.f); const float rs = rsqrtf(var + 1e-5f);
        const int col = hh * 64 + 32 * eh + 4 * hi;
        const h16* gp = projb + (size_t)qi * NIN + C_RGATE + col; h16* dst = mix + ((size_t)(b * SEQ + n * 128 + qi)) * DM + 256 + col;
#pragma unroll
        for (int g = 0; g < 4; ++g) { const h16x4 ga = *(const h16x4*)(gp + 8 * g); h16x4 oa;
#pragma unroll
            for (int k = 0; k < 4; ++k) oa[k] = (h16)((o[4 * g + k] - mu) * rs * silu_f((float)ga[k]));
            *(h16x4*)(dst + 8 * g) = oa; }
    }
}

constexpr float MOBA_THR = 8.0f;
__device__ __forceinline__ void moba_unit(const Params& p, int layer, int b, int hh, int j, unsigned char* lds_g) {
    LAS unsigned char* lds = (LAS unsigned char*)lds_g;
    const int tid = threadIdx.x, lane = tid & 63, wid = __builtin_amdgcn_readfirstlane(tid >> 6), r = lane & 31, hi = lane >> 5;
    const h16* projb = (const h16*)(p.ws + WS_PROJ) + (size_t)b * SEQ * NIN; h16* mix = (h16*)(p.ws + WS_MIX);
    const int qrow = j * 256 + wid * 32 + r;
    h16x8 qf[4];
#pragma unroll
    for (int s = 0; s < 4; ++s) qf[s] = *(const h16x8*)(projb + (size_t)qrow * NIN + C_MQ + hh * 64 + 16 * s + 8 * hi);
    const unsigned lds0 = (unsigned)(__UINTPTR_TYPE__)lds;
    const int dkey = 8 * wid + (lane >> 3);
    const h16* ksrc = projb + (size_t)dkey * NIN + C_MK + hh * 64 + (((lane & 7) ^ ((dkey >> 1) & 7)) << 3);
    const h16* vsrc = projb + (size_t)(16 * (wid & 3) + (lane >> 2)) * NIN + C_MV + hh * 64 + (wid >> 2) * 32 + (lane & 3) * 8;
    const unsigned kdst = lds0 + wid * 1024, vdst = lds0 + 8192 + (wid >> 2) * 4096 + (wid & 3) * 1024;
#define MOBA_DMA(tile) do { const int kp_ = j * 256 + 192 - 64 * (tile); const unsigned so_ = (unsigned)(((tile) & 7) * 16384); \
        glds16(ksrc + (size_t)kp_ * NIN, (unsigned)__builtin_amdgcn_readfirstlane(kdst + so_)); glds16(vsrc + (size_t)kp_ * NIN, (unsigned)__builtin_amdgcn_readfirstlane(vdst + so_)); } while (0)
#define MOBA_WAIT_BAR(N) asm volatile("s_waitcnt vmcnt(" #N ") lgkmcnt(0)\n\ts_barrier" ::: "memory")
    MOBA_WAIT_BAR(0);
    MOBA_DMA(0); MOBA_DMA(1); MOBA_DMA(2);
    unsigned selmask = 0u;
    if (j <= 3) selmask = (1u << j) - 1u;
    else {
        const float* km = (const float*)(p.ws + WS_KMEAN) + ((size_t)(b * 8 + hh) * 16 + (r & 15)) * 64 + 8 * hi;
        f32x16 g;
#pragma unroll
        for (int i = 0; i < 16; ++i) g[i] = 0.f;
#pragma unroll
        for (int s = 0; s < 4; ++s) {
            f32x4 a0 = (f32x4){0.f, 0.f, 0.f, 0.f}, a1 = a0;
            if (r < j) { a0 = *(const f32x4*)(km + 16 * s) + *(const f32x4*)(km + 65536 + 16 * s); a1 = *(const f32x4*)(km + 16 * s + 4) + *(const f32x4*)(km + 65536 + 16 * s + 4); }
            h16x8 ah, al;
#pragma unroll
            for (int k = 0; k < 4; ++k) { const h16 h0 = (h16)a0[k], h1 = (h16)a1[k]; ah[k] = h0; ah[4 + k] = h1; al[k] = (h16)(a0[k] - (float)h0); al[4 + k] = (h16)(a1[k] - (float)h1); }
            g = __builtin_amdgcn_mfma_f32_32x32x16_f16(ah, qf[s], g, 0, 0, 0);
            g = __builtin_amdgcn_mfma_f32_32x32x16_f16(al, qf[s], g, 0, 0, 0);
        }
        float gate[16];
#pragma unroll
        for (int i = 0; i < 8; ++i) { auto rr = __builtin_amdgcn_permlane32_swap(__float_as_uint(g[i]), __float_as_uint(g[i]), false, false);
            gate[(i & 3) + 8 * (i >> 2)] = __uint_as_float(rr[0]); gate[(i & 3) + 8 * (i >> 2) + 4] = __uint_as_float(rr[1]); }
        float g0 = -3.0e38f, g1 = -3.0e38f, g2 = -3.0e38f; int i0 = 0, i1 = 0, i2 = 0;
#pragma unroll
        for (int n = 0; n < 15; ++n) { const float s = (n < j) ? gate[n] : -3.0e38f;
            if (s > g0) { g2 = g1; i2 = i1; g1 = g0; i1 = i0; g0 = s; i0 = n; }
            else if (s > g1) { g2 = g1; i2 = i1; g1 = s; i1 = n; }
            else if (s > g2) { g2 = s; i2 = n; } }
        selmask = (1u << i0) | (1u << i1) | (1u << i2);
    }
    constexpr float C2 = 0.125f * 1.4426950408889634f;
    float qn2 = 0.f;
#pragma unroll
    for (int s = 0; s < 4; ++s)
#pragma unroll
        for (int k = 0; k < 8; ++k) { qf[s][k] = (h16)((float)qf[s][k] * C2); qn2 += (float)qf[s][k] * (float)qf[s][k]; }
    const float qbound = sqrtf(xhalf_sum(qn2)) * sqrtf(__uint_as_float(__hip_atomic_load((const unsigned*)(p.ws + WS_CTL + 20480) + layer * 64 + b * 8 + hh, __ATOMIC_RELAXED, __HIP_MEMORY_SCOPE_AGENT))) * 1.001f;
    const float slope2 = exp2f(-(float)(hh + 1)) * 1.4426950408889634f;
    f32x16 o0, o1;
#pragma unroll
    for (int i = 0; i < 16; ++i) { o0[i] = 0.f; o1[i] = 0.f; }
    float mref = 0.f, lsum = 0.f; bool first = true;
    const int rK = r * 128, rsw = (r >> 1) & 7;
    const int rV = 8192 + (4 * hi + ((lane & 15) >> 2)) * 64 + ((lane >> 4) & 1) * 32 + (lane & 3) * 8;
    const int nt = 4 * (j + 1);
    const int wdiag = wid >> 1;
#define MOBA_CIN(T, C0, C1) do { const int kp_ = j * 256 + 192 - 64 * (T); const int nb_ = kp_ >> 8, tl_ = (kp_ >> 6) & 3; const bool own_ = (nb_ == j); \
        const bool val_ = own_ ? true : (((selmask >> (nb_ & 31)) & 1u) != 0u); \
        const float tbh_ = val_ ? (slope2 * (float)(kp_ - qrow + 4 * hi) - mref) : -INFINITY; \
        _Pragma("unroll") for (int i = 0; i < 16; ++i) { C0[i] = fmaf(slope2, (float)CROW0(i), tbh_); C1[i] = fmaf(slope2, (float)(CROW0(i) + 32), tbh_); } \
        if (own_ && tl_ >= wdiag) { const int lim2_ = 32 * wid - 64 * tl_ + r - 4 * hi; \
            _Pragma("unroll") for (int i = 0; i < 16; ++i) { if (CROW0(i) > lim2_) C0[i] = -INFINITY; if (CROW0(i) + 32 > lim2_) C1[i] = -INFINITY; } } } while (0)
#define MOBA_QK(T, C0, C1) do { const LAS unsigned char* kb_ = lds + ((T) & 7) * 16384 + rK; \
        _Pragma("unroll") for (int s = 0; s < 4; ++s) { \
            const h16x8 k0_ = *(const LAS h16x8*)(kb_ + (((2 * s + hi) ^ rsw) << 4)), k1_ = *(const LAS h16x8*)(kb_ + 4096 + (((2 * s + hi) ^ rsw) << 4)); \
            C0 = __builtin_amdgcn_mfma_f32_32x32x16_f16(k0_, qf[s], C0, 0, 0, 0); C1 = __builtin_amdgcn_mfma_f32_32x32x16_f16(k1_, qf[s], C1, 0, 0, 0); } } while (0)
#define MOBA_DECIDE(T, C0, C1) do { float m_ = __builtin_fmaxf(C0[0], C1[0]); \
        _Pragma("unroll") for (int i = 1; i < 16; ++i) m_ = __builtin_fmaxf(__builtin_fmaxf(m_, C0[i]), C1[i]); \
        m_ = xhalf_max(m_); \
        const int kp_ = j * 256 + 192 - 64 * (T); const bool fst_ = ((kp_ >> 8) == j) && (((kp_ >> 6) & 3) == wdiag); \
        if (fst_ || __any(m_ > MOBA_THR)) { const float dl_ = fst_ ? m_ : __builtin_fmaxf(m_, 0.f); const float f_ = fst_ ? 1.0f : __builtin_amdgcn_exp2f(-dl_); mref += dl_; lsum *= f_; \
            _Pragma("unroll") for (int i = 0; i < 16; ++i) { C0[i] -= dl_; C1[i] -= dl_; o0[i] *= f_; o1[i] *= f_; } } } while (0)
#define MOBA_STEP(T, TE, P0, P1, N0, N1) do { \
        MOBA_CIN((T) + 1, N0, N1); MOBA_QK((T) + 1, N0, N1); \
        float ps_ = 0.f; \
        _Pragma("unroll") for (int i = 0; i < 16; ++i) { P0[i] = __builtin_amdgcn_exp2f(P0[i]); P1[i] = __builtin_amdgcn_exp2f(P1[i]); ps_ += P0[i] + P1[i]; } \
        lsum += ps_; \
        h16x8 pf_[4]; \
        _Pragma("unroll") for (int k = 0; k < 8; ++k) { pf_[0][k] = (h16)P0[k]; pf_[1][k] = (h16)P0[8 + k]; pf_[2][k] = (h16)P1[k]; pf_[3][k] = (h16)P1[8 + k]; } \
        { const LAS unsigned char* vb_ = lds + ((T) & 7) * 16384 + rV; \
          _Pragma("unroll") for (int t = 0; t < 4; ++t) { const h16x8 v0_ = tr_frag(vb_ + t * 1024), v1_ = tr_frag(vb_ + 4096 + t * 1024); \
            o0 = __builtin_amdgcn_mfma_f32_32x32x16_f16(v0_, pf_[t], o0, 0, 0, 0); o1 = __builtin_amdgcn_mfma_f32_32x32x16_f16(v1_, pf_[t], o1, 0, 0, 0); } } \
        if ((T) + 1 < (TE)) MOBA_DECIDE((T) + 1, N0, N1); } while (0)
    f32x16 cA0, cA1, cB0, cB1;
    int te = nt;
    LAS float* xs = (LAS float*)(lds + 131072);
    MOBA_WAIT_BAR(0);
    MOBA_DMA(3); if (4 < te) MOBA_DMA(4);
    MOBA_CIN(0, cA0, cA1); MOBA_QK(0, cA0, cA1); MOBA_DECIDE(0, cA0, cA1);
#pragma unroll 1
    for (int tt = 0; tt < te; tt += 2) {
        MOBA_STEP(tt, te, cA0, cA1, cB0, cB1);
        if (tt == 2 && j > 0) { float marg = qbound - mref;
#pragma unroll
            for (int o = 1; o < 64; o <<= 1) marg = fmaxf(marg, __shfl_xor(marg, o));
            if (lane == 0) xs[wid] = marg; }
        MOBA_STEP(tt + 1, te, cB0, cB1, cA0, cA1);
        MOBA_WAIT_BAR(0);
        if (tt == 2 && j > 0) { float M = xs[0];
#pragma unroll
            for (int k = 1; k < 8; ++k) M = fmaxf(M, xs[k]);
            const float num = M + 40.0f - slope2;
            int cnt = (num >= 0.f) ? ((int)(num / (64.0f * slope2)) + 1) : 0;
            cnt = max(min(cnt, 4 * j), 2); cnt = (cnt + 1) & ~1;
            te = 4 + __builtin_amdgcn_readfirstlane(cnt); }
        if (tt + 5 < te) MOBA_DMA(tt + 5);
        if (tt + 6 < te) MOBA_DMA(tt + 6);
    }
    MOBA_WAIT_BAR(0);
#undef MOBA_RUN
#undef MOBA_CIN
#undef MOBA_QK
#undef MOBA_DECIDE
#undef MOBA_STEP
#undef MOBA_DMA
#undef MOBA_WAIT_BAR
    {
        const float inv = 1.0f / xhalf_sum(lsum);
        const h16* gp = projb + (size_t)qrow * NIN + C_MGATE + hh * 64 + 4 * hi; h16* dst = mix + ((size_t)b * SEQ + qrow) * DM + 512 + hh * 64 + 4 * hi;
#pragma unroll
        for (int g = 0; g < 4; ++g) {
            const h16x4 ga = *(const h16x4*)(gp + 8 * g), gb = *(const h16x4*)(gp + 32 + 8 * g); h16x4 oa, ob;
#pragma unroll
            for (int k = 0; k < 4; ++k) { oa[k] = (h16)(o0[4 * g + k] * inv * silu_f((float)ga[k])); ob[k] = (h16)(o1[4 * g + k] * inv * silu_f((float)gb[k])); }
            *(h16x4*)(dst + 8 * g) = oa; *(h16x4*)(dst + 32 + 8 * g) = ob;
        }
    }
}

__device__ __forceinline__ void ret_scan_shares(const Params& p, int layer) {
    const float* kv = (const float*)(p.ws + WS_KV); h16* rst = (h16*)(p.ws + WS_RST);
    const int tid = threadIdx.x; unsigned done = 0u;
#pragma unroll 1
    for (int s = blockIdx.x; s < 256; s += gridDim.x) {
        const int bh = s >> 3, e = (s & 7) * 512 + tid, hh = bh & 3;
        const float gam = 1.0f - exp2f(-5.0f - (float)hh); const float g = expf(logf(gam) * 128.0f);
        const float* kvb = kv + (size_t)bh * 32 * 4096 + e; h16* rb = rst + (size_t)bh * 32 * 4096 + e;
        float r = 0.f; rb[0] = (h16)0.f;
#pragma unroll 1
        for (int m0 = 0; m0 < 31; m0 += 8) {
            float kvv[8];
#pragma unroll
            for (int k = 0; k < 8; ++k) kvv[k] = (m0 + k < 31) ? kvb[(size_t)(m0 + k) * 4096] : 0.f;
#pragma unroll
            for (int k = 0; k < 8; ++k) if (m0 + k < 31) { r = r * g + kvv[k]; rb[(size_t)(m0 + k + 1) * 4096] = (h16)(r * gam); }
        }
        ++done;
    }
    asm volatile("s_waitcnt vmcnt(0)" ::: "memory");
    __syncthreads();
    if (tid == 0) { __builtin_amdgcn_fence(__ATOMIC_RELEASE, "agent"); asm volatile("s_waitcnt vmcnt(0)" ::: "memory");
        __hip_atomic_fetch_add((unsigned*)(p.ws + WS_CTL + 16384) + 64 * layer, done, __ATOMIC_RELAXED, __HIP_MEMORY_SCOPE_AGENT); }
}
__device__ __forceinline__ void ret_scan_wait(const Params& p, int layer) {
    if (threadIdx.x == 0) {
        unsigned* c = (unsigned*)(p.ws + WS_CTL + 16384) + 64 * layer; unsigned sp = 0u;
        while (__hip_atomic_load(c, __ATOMIC_RELAXED, __HIP_MEMORY_SCOPE_AGENT) < 256u) { __builtin_amdgcn_s_sleep(2); if (++sp > (1u << 22)) break; }
        __builtin_amdgcn_fence(__ATOMIC_ACQUIRE, "agent"); asm volatile("s_waitcnt vmcnt(0)" ::: "memory");
    }
    __syncthreads();
}

__device__ __forceinline__ void publish_count(unsigned* c, unsigned n) {
    asm volatile("s_waitcnt vmcnt(0)" ::: "memory");
    __syncthreads();
    if (threadIdx.x == 0) { __builtin_amdgcn_fence(__ATOMIC_RELEASE, "agent"); asm volatile("s_waitcnt vmcnt(0)" ::: "memory"); __hip_atomic_fetch_add(c, n, __ATOMIC_RELAXED, __HIP_MEMORY_SCOPE_AGENT); }
}
__device__ __forceinline__ void wait_count(unsigned* c, unsigned want) {
    if (threadIdx.x == 0) { unsigned sp = 0u;
        while (__hip_atomic_load(c, __ATOMIC_RELAXED, __HIP_MEMORY_SCOPE_AGENT) < want) { __builtin_amdgcn_s_sleep(2); if (++sp > (1u << 22)) break; }
        __builtin_amdgcn_fence(__ATOMIC_ACQUIRE, "agent"); asm volatile("s_waitcnt vmcnt(0)" ::: "memory"); }
    __syncthreads();
}
__device__ __forceinline__ int queue_pop(unsigned* counter, LAS unsigned* slot) {
    __syncthreads();
    if (threadIdx.x == 0) slot[0] = __hip_atomic_fetch_add(counter, 1u, __ATOMIC_RELAXED, __HIP_MEMORY_SCOPE_AGENT);
    __syncthreads();
    return (int)slot[0];
}
__device__ __forceinline__ void phase_mixers(const Params& p, int layer, unsigned char* lds) {
    static constexpr unsigned char MOBA_ORDER[128] = {111,127,110,126,109,125,93,94,95,92,108,124,91,107,123,90,106,122,89,105,121,88,104,120,87,103,119,71,72,73,74,75,76,77,78,79,70,86,102,118,69,85,101,117,68,84,100,116,52,53,54,55,56,57,58,59,60,61,62,63,51,67,83,99,115,50,66,82,98,114,34,35,36,37,38,39,40,41,42,43,44,45,46,47,17,18,19,20,21,22,23,24,25,26,27,28,29,30,31,33,49,65,81,97,113,1,2,3,4,5,6,7,8,9,10,11,12,13,14,15,0,16,32,48,64,80,96,112};
    unsigned* qc = (unsigned*)(p.ws + WS_CTL + 24576) + layer * 256;
    LAS unsigned* slot = (LAS unsigned*)((LAS unsigned char*)lds + BAR_LDS_OFF + 16);
    phase_stats(p, layer, lds);
    publish_count((unsigned*)(p.ws + WS_CTL + 16384) + 64 * (2 + layer), 1u);
#define QUEUE_LOOP(CNT, N, BODY) do { int cur = queue_pop(CNT, slot); \
        _Pragma("unroll 1") while (cur < (N)) { unsigned nxt_ = 0u; if (threadIdx.x == 0) nxt_ = __hip_atomic_fetch_add(CNT, 1u, __ATOMIC_RELAXED, __HIP_MEMORY_SCOPE_AGENT); \
            { BODY; } \
            __syncthreads(); if (threadIdx.x == 0) slot[0] = nxt_; __syncthreads(); cur = (int)slot[0]; } } while (0)
    QUEUE_LOOP(qc + 128, 512, conv_unit(p, layer, cur >> 6, cur & 63, lds));
    wait_count((unsigned*)(p.ws + WS_CTL + 16384) + 64 * (2 + layer), gridDim.x);
    ret_scan_shares(p, layer);
    QUEUE_LOOP(qc, 1024, const int hj = MOBA_ORDER[cur >> 3]; moba_unit(p, layer, cur & 7, hj >> 4, hj & 15, lds));
    ret_scan_wait(p, layer);
    QUEUE_LOOP(qc + 64, 1024, ret_unit(p, cur >> 7, (cur >> 5) & 3, cur & 31, lds));
#undef QUEUE_LOOP
}

__device__ __forceinline__ void phase_final(const Params& p) {
    const float* rowss = (const float*)(p.ws + WS_ROWSS); const h16* xh = (const h16*)(p.ws + WS_XH);
    const int lane = threadIdx.x & 63, wid = threadIdx.x >> 6;
    f32x4 g[4];
#pragma unroll
    for (int j = 0; j < 4; ++j) g[j] = *((const f32x4*)p.final_g + lane + 64 * j);
    for (int row = blockIdx.x * 8 + wid; row < MROWS; row += gridDim.x * 8) {
        const f32x4* rs = (const f32x4*)(rowss + (size_t)row * NPART); const f32x4 s0 = rs[0], s1 = rs[1], s2 = rs[2], s3 = rs[3];
        const float tot = ((s0[0] + s0[1]) + (s0[2] + s0[3])) + ((s1[0] + s1[1]) + (s1[2] + s1[3])) + ((s2[0] + s2[1]) + (s2[2] + s2[3])) + ((s3[0] + s3[1]) + (s3[2] + s3[3]));
        const float rstd = rsqrtf(tot * (1.0f / DM) + 1e-6f);
        const h16x4* xr = (const h16x4*)(xh + (size_t)row * DM) + lane; f32x4* orow = (f32x4*)(p.out + (size_t)row * DM) + lane;
#pragma unroll
        for (int j = 0; j < 4; ++j) { const h16x4 v = xr[64 * j]; orow[64 * j] = (f32x4){(float)v[0], (float)v[1], (float)v[2], (float)v[3]} * rstd * g[j]; }
    }
}

#define XB_TMO      128
#define XB_XCNT(j)  (256  + 64 * (j))
#define XB_XSUB(j)  (1280 + 64 * (j))
#define XB_XGEN(j)  (2304 + 64 * (j))
#define XB_TOP      3328
#define XB_TOPGEN   3392
#define XCD_BAR_WORDS 3456
#define XB_SPIN_CAP (1u << 18)

__device__ __forceinline__ unsigned xb_ld(unsigned* p)              { return __hip_atomic_load(p, __ATOMIC_RELAXED, __HIP_MEMORY_SCOPE_AGENT); }
__device__ __forceinline__ unsigned xb_add(unsigned* p, unsigned v) { return __hip_atomic_fetch_add(p, v, __ATOMIC_RELAXED, __HIP_MEMORY_SCOPE_AGENT); }
__device__ __forceinline__ unsigned xb_xcc_id() { return (unsigned)__builtin_amdgcn_s_getreg((3 << 11) | 20) & 0xFu; }
#define XB_SPIN(cond, bar) do { unsigned _sp = 0; while (cond) { __builtin_amdgcn_s_sleep(1); \
    if ((++_sp & 255u) == 0u) { if (xb_ld(&(bar)[XB_TMO])) break; if (_sp > XB_SPIN_CAP) { atomicAdd(&(bar)[XB_TMO], 1u); break; } } } } while (0)

struct XcdBarrier {
    unsigned* bar; unsigned x;
    volatile LAS unsigned* st;
};

__device__ __forceinline__ XcdBarrier xcd_barrier_post(unsigned* bar, volatile LAS unsigned* st) {
    XcdBarrier b; b.bar = bar; b.x = xb_xcc_id(); b.st = st;
    if (threadIdx.x == 0) (void)xb_add(&bar[XB_XCNT(b.x)], 1u);
    return b;
}
__device__ __forceinline__ void xcd_barrier_complete(unsigned* bar, unsigned x, unsigned& nloc, unsigned& nx) {
    const unsigned G = gridDim.x * gridDim.y * gridDim.z;
    unsigned sum, cnt, mine, sp = 0u;
    for (;;) {
        sum = 0u; cnt = 0u; mine = 0u;
#pragma unroll
        for (unsigned j = 0; j < 16; ++j) { const unsigned c = xb_ld(&bar[XB_XCNT(j)]); sum += c; cnt += (c > 0u) ? 1u : 0u; mine = (j == x) ? c : mine; }
        if (sum == G) break;
        __builtin_amdgcn_s_sleep(1);
        if ((++sp & 255u) == 0u) { if (xb_ld(&bar[XB_TMO])) break; if (sp > XB_SPIN_CAP) { atomicAdd(&bar[XB_TMO], 1u); break; } }
    }
    nloc = mine > 0u ? mine : 1u; nx = cnt > 0u ? cnt : 1u;
}

__device__ __forceinline__ void xcd_barrier(const XcdBarrier& b) {
    asm volatile("s_waitcnt vmcnt(0)" ::: "memory");
    __syncthreads();
    if (threadIdx.x == 0) {
        unsigned* bar = b.bar;
        __builtin_amdgcn_s_waitcnt(0);
        unsigned nloc = b.st[0], nx = b.st[1];
        if (nloc == 0u) { xcd_barrier_complete(bar, b.x, nloc, nx); b.st[0] = nloc; b.st[1] = nx; }
        const unsigned old = xb_add(&bar[XB_XSUB(b.x)], 1u);
        const unsigned gen = old / nloc;
        if (old + 1u == (gen + 1u) * nloc) {
            __builtin_amdgcn_fence(__ATOMIC_RELEASE, "agent");
            asm volatile("s_waitcnt vmcnt(0)" ::: "memory");
            const unsigned og = xb_add(&bar[XB_TOP], 1u);
            const unsigned tg = og / nx;
            if (og + 1u == (tg + 1u) * nx) xb_add(&bar[XB_TOPGEN], 1u);
            else XB_SPIN(xb_ld(&bar[XB_TOPGEN]) == tg, bar);
            __builtin_amdgcn_fence(__ATOMIC_ACQUIRE, "agent");
            xb_add(&bar[XB_XGEN(b.x)], 1u);
            asm volatile("s_waitcnt vmcnt(0)" ::: "memory");
        } else {
            XB_SPIN(xb_ld(&bar[XB_XGEN(b.x)]) == gen, bar);
            __builtin_amdgcn_fence(__ATOMIC_ACQUIRE, "agent");
            asm volatile("s_waitcnt vmcnt(0)" ::: "memory");
        }
    }
    __syncthreads();
}


__global__ void __launch_bounds__(NTHREADS) hymba_fwd(Params p) {
    extern __shared__ __attribute__((aligned(16))) unsigned char lds[];
    cg::grid_group grid = cg::this_grid();
    volatile LAS unsigned* bst = (volatile LAS unsigned*)((LAS unsigned char*)lds + BAR_LDS_OFF);
    if (threadIdx.x < 2) bst[threadIdx.x] = 0u;
    __syncthreads();
    XcdBarrier xbar = xcd_barrier_post((unsigned*)(p.ws + WS_CTL), bst);
#define RUN_PHASE(k, body) do { if (p.ph_lo <= (k) && (k) < p.ph_hi) { body; if ((k) + 1 < p.ph_hi) { xcd_barrier(xbar); } } } while (0)
    RUN_PHASE(0, phase_prologue(p, lds));
    RUN_PHASE(1, gemm_in(p, 0, lds));
    RUN_PHASE(2, phase_mixers(p, 0, lds));
    RUN_PHASE(3, gemm_out<0>(p, lds));
    RUN_PHASE(4, gemm_in(p, 1, lds));
    RUN_PHASE(5, phase_mixers(p, 1, lds));
    RUN_PHASE(6, gemm_out<1>(p, lds));
    RUN_PHASE(7, phase_final(p));
#undef RUN_PHASE
}

extern "C" void kernel_launch(void* const* d_in, const int* in_sizes, int n_in, void* d_out, int out_size, void* d_ws, size_t ws_size, hipStream_t stream) {
    static int grid_blocks = 0;
    if (!grid_blocks) {
        int dev = 0, cus = 0, per_cu = 0;
        hipGetDevice(&dev);
        hipDeviceGetAttribute(&cus, hipDeviceAttributeMultiprocessorCount, dev);
        hipFuncSetAttribute((const void*)hymba_fwd, hipFuncAttributeMaxDynamicSharedMemorySize, LDS_BYTES);
        hipOccupancyMaxActiveBlocksPerMultiprocessor(&per_cu, (const void*)hymba_fwd, NTHREADS, LDS_BYTES);
        if (per_cu < 1) per_cu = 1;
        grid_blocks = cus * per_cu;
        if (ws_size < WS_END) fprintf(stderr, "kernel_launch: workspace too small (%zu < %zu)\n", ws_size, (size_t)WS_END);
    }
    Params p{};
    p.x = (const float*)d_in[0]; p.norm_g = (const float*)d_in[1]; p.w_in = (const float*)d_in[2]; p.conv_w = (const float*)d_in[3]; p.conv_b = (const float*)d_in[4];
    p.ln_g = (const float*)d_in[5]; p.ln_b = (const float*)d_in[6]; p.pw_w = (const float*)d_in[7]; p.pw_b = (const float*)d_in[8]; p.w_out = (const float*)d_in[9];
    p.final_g = (const float*)d_in[10]; p.out = (float*)d_out; p.ws = (unsigned char*)d_ws;
    (void)hipMemsetAsync((char*)d_ws + WS_CTL, 0, 32768, stream);
#if ONE_LAUNCH
    p.ph_lo = 0; p.ph_hi = NPHASES;
    { void* args[] = {&p};
      hipError_t e = hipLaunchCooperativeKernel((const void*)hymba_fwd, dim3(grid_blocks), dim3(NTHREADS), args, LDS_BYTES, stream);
      if (e != hipSuccess) fprintf(stderr, "cooperative launch failed: %s (grid %d)\n", hipGetErrorString(e), grid_blocks); }
#else
    for (int ph = 0; ph < NPHASES; ++ph) {
        p.ph_lo = ph; p.ph_hi = ph + 1; void* args[] = {&p};
        hipError_t e = hipLaunchCooperativeKernel((const void*)hymba_fwd, dim3(grid_blocks), dim3(NTHREADS), args, LDS_BYTES, stream);
        if (e != hipSuccess) { fprintf(stderr, "cooperative launch failed: %s (grid %d, phase %d)\n", hipGetErrorString(e), grid_blocks, ph); break; }
    }
#endif
}
```

```cpp
#include <hip/hip_runtime.h>
#include <hip/hip_cooperative_groups.h>
#include <cstdio>
#include <cstdint>
namespace cg = cooperative_groups;

#ifndef ONE_LAUNCH
#define ONE_LAUNCH 1
#endif

typedef _Float16 h16;
typedef _Float16 h16x8 __attribute__((ext_vector_type(8)));
typedef _Float16 h16x4 __attribute__((ext_vector_type(4)));
typedef float f32x16 __attribute__((ext_vector_type(16)));
typedef float f32x4 __attribute__((ext_vector_type(4)));
typedef unsigned u32x4 __attribute__((ext_vector_type(4)));

constexpr int BATCH = 8, SEQ = 4096, DM = 1024, MROWS = BATCH * SEQ, NIN = 3840, DEPTH = 2;
constexpr int C_AVAL = 0, C_AGLU = 256, C_AGATE = 512, C_RQ = 768, C_RK = 1024, C_RV = 1280, C_RGATE = 1536, C_MQ = 1792, C_MK = 2304, C_MV = 2816, C_MGATE = 3328;
constexpr int NPART = 16;
constexpr int NTHREADS = 512;
constexpr int LDS_BYTES = 147456;
constexpr int NPHASES = 8;

constexpr size_t MiB = 1u << 20;
constexpr size_t WS_XH = 0, WS_PROJ = 64 * MiB, WS_MIX = 304 * MiB, WS_WIN = 368 * MiB, WS_WOUT = 383 * MiB, WS_WPW = 387 * MiB,
                 WS_KV = 388 * MiB, WS_KMEAN = 404 * MiB  , WS_ROWSS = 405 * MiB, WS_CTL = 408 * MiB  , WS_RST = 409 * MiB  , WS_END = 417 * MiB;
constexpr int BAR_LDS_OFF = LDS_BYTES - 64;

struct Params {
    const float *x, *norm_g, *w_in, *conv_w, *conv_b, *ln_g, *ln_b, *pw_w, *pw_b, *w_out, *final_g;
    float* out; unsigned char* ws;
    int ph_lo, ph_hi;
};

__device__ __forceinline__ float silu_f(float v) { return v * __builtin_amdgcn_rcpf(1.0f + __expf(-v)); }
__device__ __forceinline__ int crow(int r, int h) { return (r & 3) + 8 * (r >> 2) + 4 * h; }
__device__ __forceinline__ float wave_sum(float v) {
#pragma unroll
    for (int o = 1; o < 64; o <<= 1) v += __shfl_xor(v, o);
    return v;
}

__device__ __forceinline__ void transpose_unit(const float* W, int K, int N, h16* WT, const float* g, int k0, int n0, float* tile) {
    const int tid = threadIdx.x;
    __syncthreads();
#pragma unroll
    for (int i = 0; i < 8; ++i) { const int k = i * 8 + (tid >> 6), n = tid & 63; float v = W[(size_t)(k0 + k) * N + n0 + n]; if (g) v *= g[k0 + k]; tile[k * 65 + n] = v; }
    __syncthreads();
    { const int n = tid >> 3, kc = tid & 7; h16x8 w;
#pragma unroll
        for (int i = 0; i < 8; ++i) w[i] = (h16)tile[(kc * 8 + i) * 65 + n];
        *(h16x8*)(WT + (size_t)(n0 + n) * K + k0 + kc * 8) = w; }
}

__device__ __forceinline__ void phase_prologue(const Params& p, unsigned char* lds) {
    float* tile = (float*)lds;
    h16* win = (h16*)(p.ws + WS_WIN);
    constexpr int U_IN = 16 * 60;
    for (int r = blockIdx.x; r < U_IN; r += gridDim.x)
        transpose_unit(p.w_in, DM, NIN, win, p.norm_g, (r / 60) * 64, (r % 60) * 64, tile);
    h16* xh = (h16*)(p.ws + WS_XH); float* rowss = (float*)(p.ws + WS_ROWSS);
    const int lane = threadIdx.x & 63, wid = threadIdx.x >> 6;
    for (int row = blockIdx.x * 8 + wid; row < MROWS; row += gridDim.x * 8) {
        const f32x4* xr = (const f32x4*)(p.x + (size_t)row * DM) + lane;
        float ss = 0.f;
#pragma unroll
        for (int j = 0; j < 4; ++j) { const f32x4 v = xr[64 * j]; ss += v.x * v.x + v.y * v.y + v.z * v.z + v.w * v.w;
            h16x4 o; o.x = (h16)v.x; o.y = (h16)v.y; o.z = (h16)v.z; o.w = (h16)v.w; *((h16x4*)(xh + (size_t)row * DM) + lane + 64 * j) = o; }
        ss = wave_sum(ss);
        if (lane < NPART) rowss[(size_t)row * NPART + lane] = (lane == 0) ? ss : 0.f;
    }
}

typedef short s16x4 __attribute__((ext_vector_type(4)));
#define LAS __attribute__((address_space(3)))
__device__ __forceinline__ float xhalf_max(float v) { auto rr = __builtin_amdgcn_permlane32_swap(__float_as_uint(v), __float_as_uint(v), false, false); return fmaxf(__uint_as_float(rr[0]), __uint_as_float(rr[1])); }
__device__ __forceinline__ float xhalf_sum(float v) { auto rr = __builtin_amdgcn_permlane32_swap(__float_as_uint(v), __float_as_uint(v), false, false); return __uint_as_float(rr[0]) + __uint_as_float(rr[1]); }
__device__ __forceinline__ h16x8 tr_frag(const LAS unsigned char* a) {
    const s16x4 lo = __builtin_amdgcn_ds_read_tr16_b64_v4i16((LAS s16x4*)a), hi = __builtin_amdgcn_ds_read_tr16_b64_v4i16((LAS s16x4*)(a + 512));
    typedef short s16x8 __attribute__((ext_vector_type(8)));
    const s16x8 v = __builtin_shufflevector(lo, hi, 0, 1, 2, 3, 4, 5, 6, 7);
    return __builtin_bit_cast(h16x8, v);
}
#define CROW0(i) (((i) & 3) + 8 * ((i) >> 2))
__device__ __forceinline__ void glds16(const void* gsrc, unsigned lds_dst) { unsigned keep;
    asm volatile("s_mov_b32 %0, m0\n\ts_mov_b32 m0, %2\n\ts_nop 0\n\tglobal_load_lds_dwordx4 %1, off\n\ts_mov_b32 m0, %0" : "=&s"(keep) : "v"(gsrc), "s"(lds_dst) : "memory"); }

namespace pg8 {
#define PG8_LAS __attribute__((address_space(3)))
typedef _Float16 bf16_t;
typedef _Float16 bf16x8 __attribute__((ext_vector_type(8)));
typedef float f32x4 __attribute__((ext_vector_type(4)));
typedef unsigned u32x4 __attribute__((ext_vector_type(4)));
constexpr int BM = 256, BK = 64, HALF = 128, HTB = HALF * BK * 2  , STAGE_BYTES = 8 * HTB, NXCD = 8, WGM = 8;

__host__ __device__ __forceinline__ int lds_byte(int r, int c) { const int st = (r >> 4) * 2 + (c >> 5), rr = r & 15, cc = c & 31, ob = rr * 64 + cc * 2; return st * 1024 + (ob ^ (((ob >> 9) & 1) << 5)); }
__host__ __device__ __forceinline__ void stage_rc(int b, int& R, int& C) { const int st = b / 1024, sb = b % 1024, swz = sb ^ (((sb >> 9) & 1) << 5); R = (st >> 1) * 16 + swz / 64; C = (st & 1) * 32 + (swz % 64) / 2; }
__host__ __device__ __forceinline__ int perm32(int rho) { const int n = rho >> 4, i = rho & 15; return 8 * (i >> 2) + 4 * n + (i & 3); }

struct Unit { int pm, pn; };
struct Gemm { const bf16_t* A; const bf16_t* Bt; int M, N, K; };

struct StaticOrder {
    int nM, nN, nwg, G, c;
    __host__ __device__ void init(int M, int N, int G_, int c_) { nM = M / BM; nN = N / BM; nwg = nM * nN; G = G_; c = c_; }
    __host__ __device__ bool next(int i, Unit& u) const {
        const long L = (long)i * G + c; if (L >= nwg) return false;
        int wgid = (int)L; { const int q = nwg / NXCD, r = nwg % NXCD, xcd = wgid % NXCD, off = wgid / NXCD; wgid = (xcd < r ? xcd * (q + 1) : r * (q + 1) + (xcd - r) * q) + off; }
        const int nig = WGM * nN, gid = wgid / nig, fm = gid * WGM, gsz = (nM - fm) < WGM ? (nM - fm) : WGM;
        u.pm = fm + ((wgid % nig) % gsz); u.pn = (wgid % nig) / gsz; return true;
    }
    __device__ __forceinline__ void a_ready(const Unit&) const {}
    __device__ __forceinline__ void done(const Unit&) const {}
};

template <class Epi, class Sched, bool ALIGN_EPI = false, bool SP2 = false>
__device__ __forceinline__ void gemm_phase(PG8_LAS unsigned char* lds, const Gemm g, const Sched& S, const Epi& E) {
    const int tid = threadIdx.x, wid = __builtin_amdgcn_readfirstlane(tid >> 6), lane = tid & 63, wr = wid >> 2, wc = wid & 3, fr = lane & 15, fq = lane >> 4;
    const int K = g.K, nt = K / BK;
    unsigned voffA[2], voffB[2];
#pragma unroll
    for (int i = 0; i < 2; ++i) { int R, C; stage_rc(tid * 16 + i * 8192, R, C); const int Rb = Epi::PERM ? ((R & ~31) + perm32(R & 31)) : R;
        voffA[i] = (unsigned)(R * K + C) * 2u; voffB[i] = (unsigned)(Rb * K + C) * 2u; }
    const size_t kstep = (size_t)(BK * 2);
    const size_t hstep = (size_t)HALF * K * 2;
    const size_t tstep = 2 * hstep;
    const unsigned ldsw = (unsigned)wid * 1024u;
    const int aoff = lds_byte(wr * 64 + fr, fq * 8), boff = lds_byte(wc * 32 + fr, fq * 8);
#define PG8_SA(b, h) (((b) * 2 + (h)) * HTB)
#define PG8_SB(b, h) ((4 + (b) * 2 + (h)) * HTB)
#define PG8_STAGE(bufoff, gbase, voff) do { _Pragma("unroll") for (int _i = 0; _i < 2; ++_i) \
        __builtin_amdgcn_global_load_lds((const unsigned*)((const char*)(gbase) + (voff)[_i]), (PG8_LAS unsigned*)(lds + (bufoff) + ldsw + _i * 8192), 16, 0, 0); } while (0)
#define PG8_LDA(dst, b, h) do { _Pragma("unroll") for (int m = 0; m < 4; ++m) _Pragma("unroll") for (int k = 0; k < 2; ++k) dst[m][k] = *(const PG8_LAS bf16x8*)(lds + PG8_SA(b, h) + aoff + m * 2048 + k * 1024); } while (0)
#define PG8_LDB(dst, b, h) do { _Pragma("unroll") for (int n = 0; n < 2; ++n) _Pragma("unroll") for (int k = 0; k < 2; ++k) dst[n][k] = *(const PG8_LAS bf16x8*)(lds + PG8_SB(b, h) + boff + n * 2048 + k * 1024); } while (0)
#define PG8_MMA(ai, bj, At, Bt) do { __builtin_amdgcn_s_setprio(1); _Pragma("unroll") for (int m = 0; m < 4; ++m) _Pragma("unroll") for (int n = 0; n < 2; ++n) _Pragma("unroll") for (int k = 0; k < 2; ++k) \
        acc[ai][bj][m][n] = __builtin_amdgcn_mfma_f32_16x16x32_f16(Bt[n][k], At[m][k], acc[ai][bj][m][n], 0, 0, 0); __builtin_amdgcn_s_setprio(0); } while (0)
#define PG8_WAIT_V(n) asm volatile("s_waitcnt vmcnt(" #n ")" ::: "memory")
#define PG8_WAIT_L(n) asm volatile("s_waitcnt lgkmcnt(" #n ")" ::: "memory")
#define PG8_BAR __builtin_amdgcn_s_barrier()
#define PG8_SCHED __builtin_amdgcn_sched_barrier(0)
    Unit cur, nxt; int ui = 0;
    if (!S.next(0, cur)) return;
    f32x4 acc[2][2][4][2];
#pragma unroll
    for (int a = 0; a < 2; ++a)
#pragma unroll
        for (int b = 0; b < 2; ++b)
#pragma unroll
            for (int m = 0; m < 4; ++m)
#pragma unroll
                for (int n = 0; n < 2; ++n) acc[a][b][m][n] = (f32x4){0.f, 0.f, 0.f, 0.f};
    bf16x8 At[4][2], B0[2][2], B1[2][2];
    const char* cA = (const char*)g.A + (size_t)cur.pm * tstep; const char* cB = (const char*)g.Bt + (size_t)cur.pn * tstep;
    S.a_ready(cur);
    if constexpr (SP2) {
        PG8_STAGE(PG8_SB(0, 0), cB, voffB); PG8_STAGE(PG8_SB(0, 1), cB + hstep, voffB); PG8_STAGE(PG8_SA(0, 0), cA, voffA); PG8_STAGE(PG8_SA(0, 1), cA + hstep, voffA);
        if (wr == 1) PG8_BAR;
        PG8_WAIT_V(2); PG8_BAR;
        PG8_STAGE(PG8_SB(1, 0), cB + kstep, voffB); PG8_STAGE(PG8_SA(1, 0), cA + kstep, voffA); PG8_STAGE(PG8_SB(1, 1), cB + hstep + kstep, voffB);
        PG8_WAIT_V(6); PG8_BAR;
    } else {
        PG8_STAGE(PG8_SB(0, 0), cB, voffB); PG8_STAGE(PG8_SA(0, 0), cA, voffA); PG8_STAGE(PG8_SB(0, 1), cB + hstep, voffB); PG8_STAGE(PG8_SA(0, 1), cA + hstep, voffA);
        if (wr == 1) PG8_BAR;
        PG8_WAIT_V(4); PG8_BAR;
        PG8_STAGE(PG8_SB(1, 0), cB + kstep, voffB); PG8_STAGE(PG8_SA(1, 0), cA + kstep, voffA); PG8_STAGE(PG8_SB(1, 1), cB + hstep + kstep, voffB);
        PG8_WAIT_V(6); PG8_BAR;
    }
    for (;;) {
        const bool has_next = S.next(ui + 1, nxt);
        const char* nA = has_next ? (const char*)g.A + (size_t)nxt.pm * tstep : cA; const char* nB = has_next ? (const char*)g.Bt + (size_t)nxt.pn * tstep : cB;
        for (int t = 0; t < nt; t += 2) {
            const bool last = (t == nt - 2);
            const char* a1 = cA + (size_t)(t + 1) * kstep;
            const char* a2 = last ? nA : cA + (size_t)(t + 2) * kstep; const char* b2 = last ? nB : cB + (size_t)(t + 2) * kstep;
            const char* a3 = a2 + kstep; const char* b3 = b2 + kstep;
            if (last && has_next) S.a_ready(nxt);
            if constexpr (SP2) {
            PG8_LDB(B0, 0, 0); PG8_LDB(B1, 0, 1); PG8_SCHED; PG8_LDA(At, 0, 0); PG8_STAGE(PG8_SA(1, 1), a1 + hstep, voffA);
            PG8_WAIT_V(8); PG8_WAIT_L(0); PG8_BAR; PG8_MMA(0, 0, At, B0); PG8_MMA(0, 1, At, B1); PG8_BAR; PG8_SCHED;
            PG8_LDA(At, 0, 1); PG8_STAGE(PG8_SB(0, 0), b2, voffB); PG8_STAGE(PG8_SB(0, 1), b2 + hstep, voffB); PG8_STAGE(PG8_SA(0, 0), a2, voffA);
            PG8_WAIT_V(8); PG8_WAIT_L(0); PG8_BAR; PG8_MMA(1, 0, At, B0); PG8_MMA(1, 1, At, B1); PG8_BAR; PG8_SCHED;
            PG8_LDB(B0, 1, 0); PG8_LDB(B1, 1, 1); PG8_SCHED; PG8_LDA(At, 1, 0); PG8_STAGE(PG8_SA(0, 1), a2 + hstep, voffA);
            PG8_WAIT_V(8); PG8_WAIT_L(0); PG8_BAR; PG8_MMA(0, 0, At, B0); PG8_MMA(0, 1, At, B1); PG8_BAR; PG8_SCHED;
            PG8_LDA(At, 1, 1); PG8_STAGE(PG8_SB(1, 0), b3, voffB); PG8_STAGE(PG8_SB(1, 1), b3 + hstep, voffB); PG8_STAGE(PG8_SA(1, 0), a3, voffA);
            PG8_WAIT_V(8); PG8_WAIT_L(0); PG8_BAR; PG8_MMA(1, 0, At, B0); PG8_MMA(1, 1, At, B1); PG8_BAR; PG8_SCHED;
            } else {
            PG8_LDB(B0, 0, 0); PG8_SCHED; PG8_LDA(At, 0, 0); PG8_STAGE(PG8_SA(1, 1), a1 + hstep, voffA);
            PG8_WAIT_L(8); PG8_BAR; PG8_WAIT_L(0); PG8_MMA(0, 0, At, B0); PG8_BAR; PG8_SCHED;
            PG8_LDB(B1, 0, 1); PG8_STAGE(PG8_SB(0, 0), b2, voffB);
            PG8_BAR; PG8_WAIT_L(0); PG8_MMA(0, 1, At, B1); PG8_BAR;
            PG8_LDA(At, 0, 1); PG8_STAGE(PG8_SA(0, 0), a2, voffA);
            PG8_BAR; PG8_WAIT_L(0); PG8_MMA(1, 0, At, B0); PG8_BAR; PG8_SCHED;
            PG8_STAGE(PG8_SB(0, 1), b2 + hstep, voffB);
            PG8_WAIT_V(6); PG8_BAR; PG8_MMA(1, 1, At, B1); PG8_BAR;
            PG8_LDB(B0, 1, 0); PG8_SCHED; PG8_LDA(At, 1, 0); PG8_STAGE(PG8_SA(0, 1), a2 + hstep, voffA);
            PG8_WAIT_L(8); PG8_BAR; PG8_WAIT_L(0); PG8_MMA(0, 0, At, B0); PG8_BAR; PG8_SCHED;
            PG8_LDB(B1, 1, 1); PG8_STAGE(PG8_SB(1, 0), b3, voffB);
            PG8_BAR; PG8_WAIT_L(0); PG8_MMA(0, 1, At, B1); PG8_BAR;
            PG8_LDA(At, 1, 1); PG8_STAGE(PG8_SA(1, 0), a3, voffA);
            PG8_BAR; PG8_WAIT_L(0); PG8_MMA(1, 0, At, B0); PG8_BAR; PG8_SCHED;
            PG8_STAGE(PG8_SB(1, 1), b3 + hstep, voffB);
            PG8_WAIT_V(6); PG8_BAR; PG8_MMA(1, 1, At, B1); PG8_BAR;
            }
        }
        if constexpr (ALIGN_EPI) { if (wr == 0) PG8_BAR; }
        if constexpr (!Epi::AFTER_DRAIN) { E(acc, cur, wr, wc, fr, fq); S.done(cur); }
        if (!has_next) break;
#pragma unroll
        for (int a = 0; a < 2; ++a)
#pragma unroll
            for (int b = 0; b < 2; ++b)
#pragma unroll
                for (int m = 0; m < 4; ++m)
#pragma unroll
                    for (int n = 0; n < 2; ++n) acc[a][b][m][n] = (f32x4){0.f, 0.f, 0.f, 0.f};
        cur = nxt; cA = nA; cB = nB; ++ui;
        if constexpr (ALIGN_EPI) { if (wr == 1) PG8_BAR; }
    }
    PG8_WAIT_V(0);
    if constexpr (!ALIGN_EPI) { if (wr == 0) PG8_BAR; }
    PG8_BAR;
    if constexpr (Epi::AFTER_DRAIN) { E.fused(acc, cur, wr, wc, fr, fq, lds, wid, lane); S.done(cur); }
#undef PG8_SA
#undef PG8_SB
#undef PG8_STAGE
#undef PG8_LDA
#undef PG8_LDB
#undef PG8_MMA
#undef PG8_WAIT_V
#undef PG8_WAIT_L
#undef PG8_BAR
#undef PG8_SCHED
}

struct EpiProj {
    static constexpr bool PERM = true, AFTER_DRAIN = false;
    bf16_t* O; const float* rowss; float* kmpart; unsigned* kmaxh;
    __device__ __forceinline__ void operator()(const f32x4 (&acc)[2][2][4][2], const Unit& u, int wr, int wc, int fr, int fq) const {
        const int row0 = u.pm * BM + wr * 64 + fr, col0 = u.pn * BM + wc * 32 + 8 * fq;
        const bool want_km = (u.pn == 9) || (u.pn == 10);
        float kn[2] = {0.f, 0.f};
        f32x4 cs[2][2];
#pragma unroll
        for (int bj = 0; bj < 2; ++bj)
#pragma unroll
            for (int n = 0; n < 2; ++n) cs[bj][n] = (f32x4){0.f, 0.f, 0.f, 0.f};
#pragma unroll
        for (int ai = 0; ai < 2; ++ai)
#pragma unroll
            for (int m = 0; m < 4; ++m) { const size_t row = (size_t)(row0 + ai * HALF + m * 16);
                const f32x4* rs = (const f32x4*)(rowss + row * 16); const f32x4 s0 = rs[0], s1 = rs[1], s2 = rs[2], s3 = rs[3];
                const float tot = ((s0[0] + s0[1]) + (s0[2] + s0[3])) + ((s1[0] + s1[1]) + (s1[2] + s1[3])) + ((s2[0] + s2[1]) + (s2[2] + s2[3])) + ((s3[0] + s3[1]) + (s3[2] + s3[3]));
                const float rstd = rsqrtf(tot * (1.0f / 1024.0f) + 1e-6f);
                bf16_t* rowp = O + row * 3840 + col0;
#pragma unroll
                for (int bj = 0; bj < 2; ++bj) { const f32x4 v0 = acc[ai][bj][m][0] * rstd, v1 = acc[ai][bj][m][1] * rstd; bf16x8 w;
                    w[0] = (bf16_t)v0[0]; w[1] = (bf16_t)v0[1]; w[2] = (bf16_t)v0[2]; w[3] = (bf16_t)v0[3]; w[4] = (bf16_t)v1[0]; w[5] = (bf16_t)v1[1]; w[6] = (bf16_t)v1[2]; w[7] = (bf16_t)v1[3];
                    *(bf16x8*)(rowp + bj * HALF) = w; cs[bj][0] += v0; cs[bj][1] += v1;
                    if (want_km) { float q = ((v0[0] * v0[0] + v0[1] * v0[1]) + (v0[2] * v0[2] + v0[3] * v0[3])) + ((v1[0] * v1[0] + v1[1] * v1[1]) + (v1[2] * v1[2] + v1[3] * v1[3]));
                        q += __shfl_xor(q, 16); q += __shfl_xor(q, 32); kn[bj] = fmaxf(kn[bj], q); } } }
        if (want_km) {
#pragma unroll
            for (int bj = 0; bj < 2; ++bj)
#pragma unroll
                for (int n = 0; n < 2; ++n)
#pragma unroll
                    for (int k = 0; k < 4; ++k) { float v = cs[bj][n][k]; v += __shfl_xor(v, 1); v += __shfl_xor(v, 2); v += __shfl_xor(v, 4); v += __shfl_xor(v, 8); cs[bj][n][k] = v * (1.0f / 256.0f); }
#pragma unroll
            for (int bj = 0; bj < 2; ++bj) { float q = kn[bj]; q = fmaxf(q, __shfl_xor(q, 1)); q = fmaxf(q, __shfl_xor(q, 2)); q = fmaxf(q, __shfl_xor(q, 4)); q = fmaxf(q, __shfl_xor(q, 8));
                if (fr == 0 && fq == 0) atomicMax(kmaxh + (((u.pm >> 4) * 8 + (u.pn - 9) * 4 + bj * 2 + (wc >> 1)) * 2 + (wc & 1)), __float_as_uint(q)); }
            if (fr == 0) {
#pragma unroll
                for (int bj = 0; bj < 2; ++bj)
#pragma unroll
                    for (int n = 0; n < 2; ++n) { const int cm = col0 + bj * HALF + 4 * n - 2304;
                        *(f32x4*)(kmpart + ((size_t)((wr * 8 + (u.pm >> 4)) * 8 + (cm >> 6)) * 16 + (u.pm & 15)) * 64 + (cm & 63)) = cs[bj][n]; }
            }
        }
    }
};
template <int LAYER> struct EpiRes {
    static constexpr bool PERM = true, AFTER_DRAIN = false;
    const float* x0; float* xout; bf16_t* xh; float* rowss;
    __device__ __forceinline__ void operator()(const f32x4 (&acc)[2][2][4][2], const Unit& u, int wr, int wc, int fr, int fq) const {
        const int row0 = u.pm * BM + wr * 64 + fr, col0 = u.pn * BM + wc * 32 + 8 * fq;
#pragma unroll
        for (int ai = 0; ai < 2; ++ai)
#pragma unroll
            for (int m = 0; m < 4; ++m) { const size_t row = (size_t)(row0 + ai * HALF + m * 16); float ss = 0.f;
#pragma unroll
                for (int bj = 0; bj < 2; ++bj) { const size_t off = row * 1024 + col0 + bj * HALF; f32x4 v0, v1;
                    if (LAYER == 0) { const bf16x8 xq = *(const bf16x8*)(xh + off);
                        v0 = (f32x4){(float)xq[0], (float)xq[1], (float)xq[2], (float)xq[3]} + acc[ai][bj][m][0]; v1 = (f32x4){(float)xq[4], (float)xq[5], (float)xq[6], (float)xq[7]} + acc[ai][bj][m][1];
                        bf16x8 w; w[0] = (bf16_t)v0[0]; w[1] = (bf16_t)v0[1]; w[2] = (bf16_t)v0[2]; w[3] = (bf16_t)v0[3]; w[4] = (bf16_t)v1[0]; w[5] = (bf16_t)v1[1]; w[6] = (bf16_t)v1[2]; w[7] = (bf16_t)v1[3];
                        *(bf16x8*)(xh + off) = w; }
                    else { const bf16x8 xp = *(const bf16x8*)(xh + off);
                        v0 = (f32x4){(float)xp[0], (float)xp[1], (float)xp[2], (float)xp[3]} + acc[ai][bj][m][0]; v1 = (f32x4){(float)xp[4], (float)xp[5], (float)xp[6], (float)xp[7]} + acc[ai][bj][m][1];
                        bf16x8 w; w[0] = (bf16_t)v0[0]; w[1] = (bf16_t)v0[1]; w[2] = (bf16_t)v0[2]; w[3] = (bf16_t)v0[3]; w[4] = (bf16_t)v1[0]; w[5] = (bf16_t)v1[1]; w[6] = (bf16_t)v1[2]; w[7] = (bf16_t)v1[3];
                        *(bf16x8*)(xh + off) = w; }
                    ss += ((v0[0] * v0[0] + v0[1] * v0[1]) + (v0[2] * v0[2] + v0[3] * v0[3])) + ((v1[0] * v1[0] + v1[1] * v1[1]) + (v1[2] * v1[2] + v1[3] * v1[3])); }
                ss += __shfl_xor(ss, 16); ss += __shfl_xor(ss, 32);
                if (fq == 0) rowss[row * 16 + u.pn * 4 + wc] = ss; }
    }
};
}


__device__ __forceinline__ void deferred_transposes(const Params& p, unsigned char* lds, int id, int n) {
    float* tile = (float*)lds;
    h16* win = (h16*)(p.ws + WS_WIN); h16* wout = (h16*)(p.ws + WS_WOUT); h16* wpw = (h16*)(p.ws + WS_WPW);
    constexpr int U_IN = 16 * 60, U_OUT = 16 * 16, U_PW = 4 * 4;
    for (int u = id; u < U_IN + 2 * U_OUT + 2 * U_PW; u += n) {
        int r = u;
        if (r < U_IN) { transpose_unit(p.w_in + (size_t)DM * NIN, DM, NIN, win + (size_t)NIN * DM, p.norm_g + DM, (r / 60) * 64, (r % 60) * 64, tile); continue; }
        r -= U_IN;
        if (r < 2 * U_OUT) { const int layer = r / U_OUT; r %= U_OUT; transpose_unit(p.w_out + (size_t)layer * DM * DM, DM, DM, wout + (size_t)layer * DM * DM, nullptr, (r / 16) * 64, (r % 16) * 64, tile); continue; }
        r -= 2 * U_OUT;
        { const int layer = r / U_PW; r %= U_PW; transpose_unit(p.pw_w + (size_t)layer * 256 * 256, 256, 256, wpw + (size_t)layer * 256 * 256, nullptr, (r / 4) * 64, (r % 4) * 64, tile); }
    }
}

__device__ __forceinline__ void gemm_in(const Params& p, int layer, unsigned char* lds) {
    pg8::Gemm g{(const h16*)(p.ws + WS_XH), (const h16*)(p.ws + WS_WIN) + (size_t)layer * NIN * DM, MROWS, NIN, DM};
    pg8::StaticOrder S; S.init(MROWS, NIN, (int)gridDim.x, (int)blockIdx.x);
    pg8::EpiProj E{(h16*)(p.ws + WS_PROJ), (const float*)(p.ws + WS_ROWSS), (float*)(p.ws + WS_KMEAN), (unsigned*)(p.ws + WS_CTL + 20480) + layer * 128};
    pg8::gemm_phase<pg8::EpiProj, pg8::StaticOrder, true, true>((PG8_LAS unsigned char*)lds, g, S, E);
    if (layer == 0) { const int G = (int)gridDim.x, nfull = (MROWS / 256) * (NIN / 256) % G;
        if (nfull == 0) deferred_transposes(p, lds, (int)blockIdx.x, G); else if ((int)blockIdx.x >= nfull) deferred_transposes(p, lds, (int)blockIdx.x - nfull, G - nfull); }
}
template <int LAYER> __device__ __forceinline__ void gemm_out(const Params& p, unsigned char* lds) {
    pg8::Gemm g{(const h16*)(p.ws + WS_MIX), (const h16*)(p.ws + WS_WOUT) + (size_t)LAYER * DM * DM, MROWS, DM, DM};
    pg8::StaticOrder S; S.init(MROWS, DM, (int)gridDim.x, (int)blockIdx.x);
    pg8::EpiRes<LAYER> E{p.x, p.out, (h16*)(p.ws + WS_XH), (float*)(p.ws + WS_ROWSS)};
    pg8::gemm_phase<pg8::EpiRes<LAYER>, pg8::StaticOrder, true, true>((PG8_LAS unsigned char*)lds, g, S, E);
}

__device__ __forceinline__ void phase_stats(const Params& p, int layer, unsigned char* lds_g) {
    LAS unsigned char* lds = (LAS unsigned char*)lds_g;
    const h16* proj = (const h16*)(p.ws + WS_PROJ); float* kv = (float*)(p.ws + WS_KV);
    const int tid = threadIdx.x, lane = tid & 63, wid = __builtin_amdgcn_readfirstlane(tid >> 6), r = lane & 31, hi = lane >> 5;
    const int lanepart = (4 * hi + ((lane & 15) >> 2)) * 64 + ((lane >> 4) & 1) * 32 + (lane & 3) * 8;
#pragma unroll 1
    for (int u = blockIdx.x; u < 256; u += gridDim.x) {
        const int b = u >> 5, hh = (u >> 3) & 3, nq = u & 7;
        const float log_g = logf(1.0f - exp2f(-5.0f - (float)hh));
        h16x8 kk[8], vv[8];
#pragma unroll
        for (int it = 0; it < 8; ++it) {
            const int pc = tid + 512 * it, cn = pc >> 10, key = (pc >> 3) & 127, ch = pc & 7;
            const h16* src = proj + (size_t)(b * SEQ + (4 * nq + cn) * 128 + key) * NIN + hh * 64 + ch * 8;
            kk[it] = *(const h16x8*)(src + C_RK); vv[it] = *(const h16x8*)(src + C_RV);
        }
        __syncthreads();
#pragma unroll
        for (int it = 0; it < 8; ++it) {
            const int pc = tid + 512 * it, cn = pc >> 10, key = (pc >> 3) & 127, ch = pc & 7;
            const float z = __expf(log_g * (float)(127 - key)) * 0.125f;
#pragma unroll
            for (int k = 0; k < 8; ++k) kk[it][k] = (h16)((float)kk[it][k] * z);
            const int off = cn * 32768 + (ch >> 2) * 8192 + (key >> 4) * 1024 + (key & 15) * 64 + (ch & 3) * 16;
            *(LAS h16x8*)(lds + off) = kk[it]; *(LAS h16x8*)(lds + off + 16384) = vv[it];
        }
        __syncthreads();
#pragma unroll
        for (int half = 0; half < 2; ++half) {
            const int cn = 2 * half + (wid >> 2), eb = (wid >> 1) & 1, dbk = wid & 1;
            const LAS unsigned char* kimg = lds + cn * 32768 + dbk * 8192 + lanepart; const LAS unsigned char* vimg = lds + cn * 32768 + 16384 + eb * 8192 + lanepart;
            f32x16 acc;
#pragma unroll
            for (int i = 0; i < 16; ++i) acc[i] = 0.f;
#pragma unroll
            for (int ks = 0; ks < 8; ++ks) acc = __builtin_amdgcn_mfma_f32_32x32x16_f16(tr_frag(vimg + ks * 1024), tr_frag(kimg + ks * 1024), acc, 0, 0, 0);
            float* dst = kv + ((size_t)((b * 4 + hh) * 32 + 4 * nq + cn)) * 4096 + (32 * eb + 4 * hi) * 64 + 32 * dbk + r;
#pragma unroll
            for (int i = 0; i < 16; ++i) dst[CROW0(i) * 64] = acc[i];
        }
    }
}

typedef _Float16 h16x2 __attribute__((ext_vector_type(2)));
typedef float f32x2 __attribute__((ext_vector_type(2)));
__device__ __forceinline__ void conv_unit(const Params& p, int layer, int b, int tt, unsigned char* lds_g) {
    LAS unsigned char* lds = (LAS unsigned char*)lds_g;
    const h16* projb = (const h16*)(p.ws + WS_PROJ) + (size_t)b * SEQ * NIN; h16* mix = (h16*)(p.ws + WS_MIX);
    const int tid = threadIdx.x, lane = tid & 63, wid = __builtin_amdgcn_readfirstlane(tid >> 6), r = lane & 31, hi = lane >> 5;
    const int cp = tid & 127, tg = __builtin_amdgcn_readfirstlane(tid >> 7), t0 = tt * 64;
    constexpr int UIMG = 0  , SIMG = 0, YS = 49152  ;
    {
        h16x8 av[6], gv[6];
#pragma unroll
        for (int it = 0; it < 6; ++it) { const int pi = tid + 512 * it, row = pi >> 5, c8 = pi & 31; const int t = t0 - 30 + row;
            const size_t ro = (size_t)((row < 94 && t >= 0) ? t : 0) * NIN + 8 * c8;
            av[it] = *(const h16x8*)(projb + ro + C_AVAL); gv[it] = *(const h16x8*)(projb + ro + C_AGLU); }
        __syncthreads();
#pragma unroll
        for (int it = 0; it < 6; ++it) { const int pi = tid + 512 * it, row = pi >> 5, c8 = pi & 31; const bool ok = (t0 - 30 + row >= 0);
            h16x8 u;
#pragma unroll
            for (int k = 0; k < 8; ++k) u[k] = ok ? (h16)((float)av[it][k] * __builtin_amdgcn_rcpf(1.0f + __expf(-(float)gv[it][k]))) : (h16)0.f;
            if (row < 94) *(LAS h16x8*)(lds + UIMG + row * 512 + c8 * 16) = u; }
    }
    float y0[16], y1[16];
    {
        float w0[31], w1[31]; const float* cw = p.conv_w + (size_t)layer * 31 * 256 + 2 * cp;
#pragma unroll
        for (int jj = 0; jj < 31; ++jj) { const f32x2 wv = *(const f32x2*)(cw + jj * 256); w0[jj] = wv[0]; w1[jj] = wv[1]; }
        const f32x2 cbv = *(const f32x2*)(p.conv_b + layer * 256 + 2 * cp);
#pragma unroll
        for (int tl = 0; tl < 16; ++tl) { y0[tl] = cbv[0]; y1[tl] = cbv[1]; }
        __syncthreads();
        const LAS unsigned char* ub = lds + UIMG + (16 * tg) * 512 + 4 * cp;
#pragma unroll
        for (int rr = 0; rr < 46; ++rr) { const h16x2 uv = *(const LAS h16x2*)(ub + rr * 512); const float a0 = (float)uv[0], a1 = (float)uv[1];
#pragma unroll
            for (int tl = 0; tl < 16; ++tl) { const int jj = rr - tl; if (jj >= 0 && jj < 31) { y0[tl] += w0[jj] * a0; y1[tl] += w1[jj] * a1; } } }
    }
#pragma unroll
    for (int tl = 0; tl < 16; ++tl) *(LAS f32x2*)(lds + YS + ((16 * tg + tl) * 256 + 2 * cp) * 4) = (f32x2){y0[tl], y1[tl]};
    h16x8 wf[16]; h16x4 gpre[2][4];
    {
        const h16* wp = (const h16*)(p.ws + WS_WPW) + (size_t)layer * 65536 + (size_t)(32 * wid + r) * 256 + 8 * hi;
#pragma unroll
        for (int ks = 0; ks < 16; ++ks) wf[ks] = *(const h16x8*)(wp + 16 * ks);
#pragma unroll
        for (int tb = 0; tb < 2; ++tb) { const h16* gp = projb + (size_t)(t0 + 32 * tb + r) * NIN + C_AGATE + 32 * wid + 4 * hi;
#pragma unroll
            for (int g = 0; g < 4; ++g) gpre[tb][g] = *(const h16x4*)(gp + 8 * g); }
    }
    __syncthreads();
    {
        const f32x4 lg = *(const f32x4*)(p.ln_g + layer * 256 + lane * 4), lb = *(const f32x4*)(p.ln_b + layer * 256 + lane * 4);
#pragma unroll 1
        for (int kb = 0; kb < 8; kb += 4) {
        f32x4 v[4]; float s1[4], s2[4];
#pragma unroll
        for (int k = 0; k < 4; ++k) { v[k] = *(const LAS f32x4*)(lds + YS + ((wid * 8 + kb + k) * 256 + lane * 4) * 4);
            s1[k] = (v[k][0] + v[k][1]) + (v[k][2] + v[k][3]); s2[k] = (v[k][0] * v[k][0] + v[k][1] * v[k][1]) + (v[k][2] * v[k][2] + v[k][3] * v[k][3]); }
#pragma unroll
        for (int o = 1; o < 64; o <<= 1)
#pragma unroll
            for (int k = 0; k < 4; ++k) { s1[k] += __shfl_xor(s1[k], o); s2[k] += __shfl_xor(s2[k], o); }
#pragma unroll
        for (int k = 0; k < 4; ++k) { const int t = wid * 8 + kb + k; const float mu = s1[k] * (1.0f / 256.0f); const float var = fmaxf(s2[k] * (1.0f / 256.0f) - mu * mu, 0.f); const float rs = rsqrtf(var + 1e-5f);
            h16x4 o; o[0] = (h16)silu_f((v[k][0] - mu) * rs * lg[0] + lb[0]); o[1] = (h16)silu_f((v[k][1] - mu) * rs * lg[1] + lb[1]); o[2] = (h16)silu_f((v[k][2] - mu) * rs * lg[2] + lb[2]); o[3] = (h16)silu_f((v[k][3] - mu) * rs * lg[3] + lb[3]);
            *(LAS h16x4*)(lds + SIMG + t * 512 + (((lane >> 1) ^ (t & 15)) << 4) + 8 * (lane & 1)) = o; }
        }
    }
    __syncthreads();
#pragma unroll
    for (int tb = 0; tb < 2; ++tb) {
        f32x16 acc;
#pragma unroll
        for (int i = 0; i < 16; ++i) acc[i] = 0.f;
#pragma unroll
        for (int ks = 0; ks < 16; ++ks) acc = __builtin_amdgcn_mfma_f32_32x32x16_f16(wf[ks], *(const LAS h16x8*)(lds + SIMG + (32 * tb + r) * 512 + (((2 * ks + hi) ^ (r & 15)) << 4)), acc, 0, 0, 0);
        const int t = t0 + 32 * tb + r, n0 = 32 * wid + 4 * hi;
        h16* dst = mix + ((size_t)b * SEQ + t) * DM + n0; const float* pb = p.pw_b + layer * 256 + n0;
#pragma unroll
        for (int g = 0; g < 4; ++g) { const h16x4 ga = gpre[tb][g]; const f32x4 bb = *(const f32x4*)(pb + 8 * g); h16x4 oa;
#pragma unroll
            for (int k = 0; k < 4; ++k) oa[k] = (h16)((acc[4 * g + k] + bb[k]) * silu_f((float)ga[k]));
            *(h16x4*)(dst + 8 * g) = oa; }
    }
}

__device__ __forceinline__ void ret_unit(const Params& p, int b, int hh, int n, unsigned char* lds_g) {
    LAS unsigned char* lds = (LAS unsigned char*)lds_g;
    const h16* projb = (const h16*)(p.ws + WS_PROJ) + (size_t)(b * SEQ + n * 128) * NIN; h16* mix = (h16*)(p.ws + WS_MIX); const float* kv = (const float*)(p.ws + WS_KV);
    const int tid = threadIdx.x, lane = tid & 63, wid = __builtin_amdgcn_readfirstlane(tid >> 6), r = lane & 31, hi = lane >> 5, g4 = wid & 3, eh = wid >> 2;
    const float log_g = logf(1.0f - exp2f(-5.0f - (float)hh));
    constexpr int KIMG = 0, VIMG = 16384, RIMG = 32768, XS = 40960;
    const h16x8 rr = *(const h16x8*)((const h16*)(p.ws + WS_RST) + ((size_t)((b * 4 + hh) * 32 + n)) * 4096 + tid * 8);
    __syncthreads();
    {
        const int e = tid >> 3, ch = tid & 7;
        *(LAS h16x8*)(lds + RIMG + e * 128 + ((ch ^ ((e >> 1) & 7)) << 4)) = rr;
#pragma unroll
        for (int it = 0; it < 2; ++it) {
            const int key = (tid >> 3) + 64 * it;
            h16x8 kk = *(const h16x8*)(projb + (size_t)key * NIN + C_RK + hh * 64 + ch * 8); const h16x8 vv = *(const h16x8*)(projb + (size_t)key * NIN + C_RV + hh * 64 + ch * 8);
            const float z = __expf(-log_g * (float)key) * 0.125f;
#pragma unroll
            for (int k = 0; k < 8; ++k) kk[k] = (h16)((float)kk[k] * z);
            *(LAS h16x8*)(lds + KIMG + key * 128 + ((ch ^ ((key >> 1) & 7)) << 4)) = kk;
            *(LAS h16x8*)(lds + VIMG + (ch >> 2) * 8192 + (key >> 4) * 1024 + (key & 15) * 64 + (ch & 3) * 16) = vv;
        }
    }
    const int qi = 32 * g4 + r;
    h16x8 qf[4];
    {
        const float zq = __expf(log_g * (float)qi);
#pragma unroll
        for (int s = 0; s < 4; ++s) { qf[s] = *(const h16x8*)(projb + (size_t)qi * NIN + C_RQ + hh * 64 + 16 * s + 8 * hi);
#pragma unroll
            for (int k = 0; k < 8; ++k) qf[s][k] = (h16)((float)qf[s][k] * zq); }
    }
    __syncthreads();
    const int rsw = (r >> 1) & 7;
    const int lanepart = (4 * hi + ((lane & 15) >> 2)) * 64 + ((lane >> 4) & 1) * 32 + (lane & 3) * 8;
    f32x16 o;
#pragma unroll
    for (int i = 0; i < 16; ++i) o[i] = 0.f;
#pragma unroll 1
    for (int jb = 0; jb <= g4; ++jb) {
        f32x16 c;
#pragma unroll
        for (int i = 0; i < 16; ++i) c[i] = 0.f;
#pragma unroll
        for (int s = 0; s < 4; ++s) c = __builtin_amdgcn_mfma_f32_32x32x16_f16(*(const LAS h16x8*)(lds + KIMG + (32 * jb + r) * 128 + (((2 * s + hi) ^ rsw) << 4)), qf[s], c, 0, 0, 0);
        if (jb == g4) {
#pragma unroll
            for (int i = 0; i < 16; ++i) if (CROW0(i) + 4 * hi > r) c[i] = 0.f;
        }
        h16x8 pf0, pf1;
#pragma unroll
        for (int k = 0; k < 8; ++k) { pf0[k] = (h16)c[k]; pf1[k] = (h16)c[8 + k]; }
        o = __builtin_amdgcn_mfma_f32_32x32x16_f16(tr_frag(lds + VIMG + eh * 8192 + (2 * jb) * 1024 + lanepart), pf0, o, 0, 0, 0);
        o = __builtin_amdgcn_mfma_f32_32x32x16_f16(tr_frag(lds + VIMG + eh * 8192 + (2 * jb + 1) * 1024 + lanepart), pf1, o, 0, 0, 0);
    }
#pragma unroll
    for (int s = 0; s < 4; ++s) o = __builtin_amdgcn_mfma_f32_32x32x16_f16(*(const LAS h16x8*)(lds + RIMG + (32 * eh + r) * 128 + (((2 * s + hi) ^ rsw) << 4)), qf[s], o, 0, 0, 0);
    float s1 = 0.f, s2 = 0.f;
#pragma unroll
    for (int i = 0; i < 16; ++i) { s1 += o[i]; s2 += o[i] * o[i]; }
    s1 = xhalf_sum(s1); s2 = xhalf_sum(s2);
    LAS float* xs = (LAS float*)(lds + XS);
    if (hi == 0) { xs[(wid * 32 + r) * 2] = s1; xs[(wid * 32 + r) * 2 + 1] = s2; }
    __syncthreads();
    {
        const float t1 = xs[((wid ^ 4) * 32 + r) * 2], t2 = xs[((wid ^ 4) * 32 + r) * 2 + 1];
        const float a1 = (eh == 0) ? (s1 + t1) : (t1 + s1), a2 = (eh == 0) ? (s2 + t2) : (t2 + s2);
        const float mu = a1 * (1.0f / 64.0f); const float var = fmaxf(a2 * (1.0f / 64.0f) - mu * mu, 0.f); const float rs = rsqrtf(var + 1e-5f);
        const int col = hh * 64 + 32 * eh + 4 * hi;
        const h16* gp = projb + (size_t)qi * NIN + C_RGATE + col; h16* dst = mix + ((size_t)(b * SEQ + n * 128 + qi)) * DM + 256 + col;
#pragma unroll
        for (int g = 0; g < 4; ++g) { const h16x4 ga = *(const h16x4*)(gp + 8 * g); h16x4 oa;
#pragma unroll
            for (int k = 0; k < 4; ++k) oa[k] = (h16)((o[4 * g + k] - mu) * rs * silu_f((float)ga[k]));
            *(h16x4*)(dst + 8 * g) = oa; }
    }
}

constexpr float MOBA_THR = 8.0f;
__device__ __forceinline__ void moba_unit(const Params& p, int layer, int b, int hh, int j, unsigned char* lds_g) {
    LAS unsigned char* lds = (LAS unsigned char*)lds_g;
    const int tid = threadIdx.x, lane = tid & 63, wid = __builtin_amdgcn_readfirstlane(tid >> 6), r = lane & 31, hi = lane >> 5;
    const h16* projb = (const h16*)(p.ws + WS_PROJ) + (size_t)b * SEQ * NIN; h16* mix = (h16*)(p.ws + WS_MIX);
    const int qrow = j * 256 + wid * 32 + r;
    h16x8 qf[4];
#pragma unroll
    for (int s = 0; s < 4; ++s) qf[s] = *(const h16x8*)(projb + (size_t)qrow * NIN + C_MQ + hh * 64 + 16 * s + 8 * hi);
    const unsigned lds0 = (unsigned)(__UINTPTR_TYPE__)lds;
    const int dkey = 8 * wid + (lane >> 3);
    const h16* ksrc = projb + (size_t)dkey * NIN + C_MK + hh * 64 + (((lane & 7) ^ ((dkey >> 1) & 7)) << 3);
    const h16* vsrc = projb + (size_t)(16 * (wid & 3) + (lane >> 2)) * NIN + C_MV + hh * 64 + (wid >> 2) * 32 + (lane & 3) * 8;
    const unsigned kdst = lds0 + wid * 1024, vdst = lds0 + 8192 + (wid >> 2) * 4096 + (wid & 3) * 1024;
#define MOBA_DMA(tile) do { const int kp_ = j * 256 + 192 - 64 * (tile); const unsigned so_ = (unsigned)(((tile) & 7) * 16384); \
        glds16(ksrc + (size_t)kp_ * NIN, (unsigned)__builtin_amdgcn_readfirstlane(kdst + so_)); glds16(vsrc + (size_t)kp_ * NIN, (unsigned)__builtin_amdgcn_readfirstlane(vdst + so_)); } while (0)
#define MOBA_WAIT_BAR(N) asm volatile("s_waitcnt vmcnt(" #N ") lgkmcnt(0)\n\ts_barrier" ::: "memory")
    MOBA_WAIT_BAR(0);
    MOBA_DMA(0); MOBA_DMA(1); MOBA_DMA(2);
    unsigned selmask = 0u;
    if (j <= 3) selmask = (1u << j) - 1u;
    else {
        const float* km = (const float*)(p.ws + WS_KMEAN) + ((size_t)(b * 8 + hh) * 16 + (r & 15)) * 64 + 8 * hi;
        f32x16 g;
#pragma unroll
        for (int i = 0; i < 16; ++i) g[i] = 0.f;
#pragma unroll
        for (int s = 0; s < 4; ++s) {
            f32x4 a0 = (f32x4){0.f, 0.f, 0.f, 0.f}, a1 = a0;
            if (r < j) { a0 = *(const f32x4*)(km + 16 * s) + *(const f32x4*)(km + 65536 + 16 * s); a1 = *(const f32x4*)(km + 16 * s + 4) + *(const f32x4*)(km + 65536 + 16 * s + 4); }
            h16x8 ah, al;
#pragma unroll
            for (int k = 0; k < 4; ++k) { const h16 h0 = (h16)a0[k], h1 = (h16)a1[k]; ah[k] = h0; ah[4 + k] = h1; al[k] = (h16)(a0[k] - (float)h0); al[4 + k] = (h16)(a1[k] - (float)h1); }
            g = __builtin_amdgcn_mfma_f32_32x32x16_f16(ah, qf[s], g, 0, 0, 0);
            g = __builtin_amdgcn_mfma_f32_32x32x16_f16(al, qf[s], g, 0, 0, 0);
        }
        float gate[16];
#pragma unroll
        for (int i = 0; i < 8; ++i) { auto rr = __builtin_amdgcn_permlane32_swap(__float_as_uint(g[i]), __float_as_uint(g[i]), false, false);
            gate[(i & 3) + 8 * (i >> 2)] = __uint_as_float(rr[0]); gate[(i & 3) + 8 * (i >> 2) + 4] = __uint_as_float(rr[1]); }
        float g0 = -3.0e38f, g1 = -3.0e38f, g2 = -3.0e38f; int i0 = 0, i1 = 0, i2 = 0;
#pragma unroll
        for (int n = 0; n < 15; ++n) { const float s = (n < j) ? gate[n] : -3.0e38f;
            if (s > g0) { g2 = g1; i2 = i1; g1 = g0; i1 = i0; g0 = s; i0 = n; }
            else if (s > g1) { g2 = g1; i2 = i1; g1 = s; i1 = n; }
            else if (s > g2) { g2 = s; i2 = n; } }
        selmask = (1u << i0) | (1u << i1) | (1u << i2);
    }
    constexpr float C2 = 0.125f * 1.4426950408889634f;
    float qn2 = 0.f;
#pragma unroll
    for (int s = 0; s < 4; ++s)
#pragma unroll
        for (int k = 0; k < 8; ++k) { qf[s][k] = (h16)((float)qf[s][k] * C2); qn2 += (float)qf[s][k] * (float)qf[s][k]; }
    const unsigned* kmh = (const unsigned*)(p.ws + WS_CTL + 20480) + layer * 128 + (b * 8 + hh) * 2;
    const float qbound = sqrtf(xhalf_sum(qn2)) * sqrtf(__uint_as_float(__hip_atomic_load(kmh, __ATOMIC_RELAXED, __HIP_MEMORY_SCOPE_AGENT)) + __uint_as_float(__hip_atomic_load(kmh + 1, __ATOMIC_RELAXED, __HIP_MEMORY_SCOPE_AGENT))) * 1.002f;
    const float slope2 = exp2f(-(float)(hh + 1)) * 1.4426950408889634f;
    f32x16 o0, o1;
#pragma unroll
    for (int i = 0; i < 16; ++i) { o0[i] = 0.f; o1[i] = 0.f; }
    float mref = 0.f, lsum = 0.f; bool first = true;
    const int rK = r * 128, rsw = (r >> 1) & 7;
    const int rV = 8192 + (4 * hi + ((lane & 15) >> 2)) * 64 + ((lane >> 4) & 1) * 32 + (lane & 3) * 8;
    const int nt = 4 * (j + 1);
    const int wdiag = wid >> 1;
#define MOBA_CIN(T, C0, C1) do { const int kp_ = j * 256 + 192 - 64 * (T); const int nb_ = kp_ >> 8, tl_ = (kp_ >> 6) & 3; const bool own_ = (nb_ == j); \
        const bool val_ = own_ ? true : (((selmask >> (nb_ & 31)) & 1u) != 0u); \
        const float tbh_ = val_ ? (slope2 * (float)(kp_ - qrow + 4 * hi) - mref) : -INFINITY; \
        _Pragma("unroll") for (int i = 0; i < 16; ++i) { C0[i] = fmaf(slope2, (float)CROW0(i), tbh_); C1[i] = fmaf(slope2, (float)(CROW0(i) + 32), tbh_); } \
        if (own_ && tl_ >= wdiag) { const int lim2_ = 32 * wid - 64 * tl_ + r - 4 * hi; \
            _Pragma("unroll") for (int i = 0; i < 16; ++i) { if (CROW0(i) > lim2_) C0[i] = -INFINITY; if (CROW0(i) + 32 > lim2_) C1[i] = -INFINITY; } } } while (0)
#define MOBA_QK(T, C0, C1) do { const LAS unsigned char* kb_ = lds + ((T) & 7) * 16384 + rK; \
        _Pragma("unroll") for (int s = 0; s < 4; ++s) { \
            const h16x8 k0_ = *(const LAS h16x8*)(kb_ + (((2 * s + hi) ^ rsw) << 4)), k1_ = *(const LAS h16x8*)(kb_ + 4096 + (((2 * s + hi) ^ rsw) << 4)); \
            C0 = __builtin_amdgcn_mfma_f32_32x32x16_f16(k0_, qf[s], C0, 0, 0, 0); C1 = __builtin_amdgcn_mfma_f32_32x32x16_f16(k1_, qf[s], C1, 0, 0, 0); } } while (0)
#define MOBA_DECIDE(T, C0, C1) do { float m_ = __builtin_fmaxf(C0[0], C1[0]); \
        _Pragma("unroll") for (int i = 1; i < 16; ++i) m_ = __builtin_fmaxf(__builtin_fmaxf(m_, C0[i]), C1[i]); \
        m_ = xhalf_max(m_); \
        const int kp_ = j * 256 + 192 - 64 * (T); const bool fst_ = ((kp_ >> 8) == j) && (((kp_ >> 6) & 3) == wdiag); \
        if (fst_ || __any(m_ > MOBA_THR)) { const float dl_ = fst_ ? m_ : __builtin_fmaxf(m_, 0.f); const float f_ = fst_ ? 1.0f : __builtin_amdgcn_exp2f(-dl_); mref += dl_; lsum *= f_; \
            _Pragma("unroll") for (int i = 0; i < 16; ++i) { C0[i] -= dl_; C1[i] -= dl_; o0[i] *= f_; o1[i] *= f_; } } } while (0)
#define MOBA_STEP(T, TE, P0, P1, N0, N1) do { \
        MOBA_CIN((T) + 1, N0, N1); MOBA_QK((T) + 1, N0, N1); \
        float ps_ = 0.f; \
        _Pragma("unroll") for (int i = 0; i < 16; ++i) { P0[i] = __builtin_amdgcn_exp2f(P0[i]); P1[i] = __builtin_amdgcn_exp2f(P1[i]); ps_ += P0[i] + P1[i]; } \
        lsum += ps_; \
        h16x8 pf_[4]; \
        _Pragma("unroll") for (int k = 0; k < 8; ++k) { pf_[0][k] = (h16)P0[k]; pf_[1][k] = (h16)P0[8 + k]; pf_[2][k] = (h16)P1[k]; pf_[3][k] = (h16)P1[8 + k]; } \
        { const LAS unsigned char* vb_ = lds + ((T) & 7) * 16384 + rV; \
          _Pragma("unroll") for (int t = 0; t < 4; ++t) { const h16x8 v0_ = tr_frag(vb_ + t * 1024), v1_ = tr_frag(vb_ + 4096 + t * 1024); \
            o0 = __builtin_amdgcn_mfma_f32_32x32x16_f16(v0_, pf_[t], o0, 0, 0, 0); o1 = __builtin_amdgcn_mfma_f32_32x32x16_f16(v1_, pf_[t], o1, 0, 0, 0); } } \
        if ((T) + 1 < (TE)) MOBA_DECIDE((T) + 1, N0, N1); } while (0)
    f32x16 cA0, cA1, cB0, cB1;
    int te = nt;
    LAS float* xs = (LAS float*)(lds + 131072);
    MOBA_WAIT_BAR(0);
    MOBA_DMA(3); if (4 < te) MOBA_DMA(4);
    MOBA_CIN(0, cA0, cA1); MOBA_QK(0, cA0, cA1); MOBA_DECIDE(0, cA0, cA1);
#pragma unroll 1
    for (int tt = 0; tt < te; tt += 2) {
        MOBA_STEP(tt, te, cA0, cA1, cB0, cB1);
        if (tt == 2 && j > 0) { float marg = qbound - mref;
#pragma unroll
            for (int o = 1; o < 64; o <<= 1) marg = fmaxf(marg, __shfl_xor(marg, o));
            if (lane == 0) xs[wid] = marg; }
        MOBA_STEP(tt + 1, te, cB0, cB1, cA0, cA1);
        MOBA_WAIT_BAR(0);
        if (tt == 2 && j > 0) { float M = xs[0];
#pragma unroll
            for (int k = 1; k < 8; ++k) M = fmaxf(M, xs[k]);
            const float num = M + 40.0f - slope2;
            int cnt = (num >= 0.f) ? ((int)(num / (64.0f * slope2)) + 1) : 0;
            cnt = max(min(cnt, 4 * j), 2); cnt = (cnt + 1) & ~1;
            te = 4 + __builtin_amdgcn_readfirstlane(cnt); }
        if (tt + 5 < te) MOBA_DMA(tt + 5);
        if (tt + 6 < te) MOBA_DMA(tt + 6);
    }
    MOBA_WAIT_BAR(0);
#undef MOBA_RUN
#undef MOBA_CIN
#undef MOBA_QK
#undef MOBA_DECIDE
#undef MOBA_STEP
#undef MOBA_DMA
#undef MOBA_WAIT_BAR
    {
        const float inv = 1.0f / xhalf_sum(lsum);
        const h16* gp = projb + (size_t)qrow * NIN + C_MGATE + hh * 64 + 4 * hi; h16* dst = mix + ((size_t)b * SEQ + qrow) * DM + 512 + hh * 64 + 4 * hi;
#pragma unroll
        for (int g = 0; g < 4; ++g) {
            const h16x4 ga = *(const h16x4*)(gp + 8 * g), gb = *(const h16x4*)(gp + 32 + 8 * g); h16x4 oa, ob;
#pragma unroll
            for (int k = 0; k < 4; ++k) { oa[k] = (h16)(o0[4 * g + k] * inv * silu_f((float)ga[k])); ob[k] = (h16)(o1[4 * g + k] * inv * silu_f((float)gb[k])); }
            *(h16x4*)(dst + 8 * g) = oa; *(h16x4*)(dst + 32 + 8 * g) = ob;
        }
    }
}

__device__ __forceinline__ void ret_scan_shares(const Params& p, int layer) {
    const float* kv = (const float*)(p.ws + WS_KV); h16* rst = (h16*)(p.ws + WS_RST);
    const int tid = threadIdx.x; unsigned done = 0u;
#pragma unroll 1
    for (int s = blockIdx.x; s < 256; s += gridDim.x) {
        const int bh = s >> 3, e = (s & 7) * 512 + tid, hh = bh & 3;
        const float gam = 1.0f - exp2f(-5.0f - (float)hh); const float g = expf(logf(gam) * 128.0f);
        const float* kvb = kv + (size_t)bh * 32 * 4096 + e; h16* rb = rst + (size_t)bh * 32 * 4096 + e;
        float r = 0.f; rb[0] = (h16)0.f;
        float kvv[31];
#pragma unroll
        for (int m = 0; m < 31; ++m) kvv[m] = kvb[(size_t)m * 4096];
#pragma unroll
        for (int m = 0; m < 31; ++m) { r = r * g + kvv[m]; rb[(size_t)(m + 1) * 4096] = (h16)(r * gam); }
        ++done;
    }
    asm volatile("s_waitcnt vmcnt(0)" ::: "memory");
    __syncthreads();
    if (tid == 0) { __builtin_amdgcn_fence(__ATOMIC_RELEASE, "agent"); asm volatile("s_waitcnt vmcnt(0)" ::: "memory");
        __hip_atomic_fetch_add((unsigned*)(p.ws + WS_CTL + 16384) + 64 * layer, done, __ATOMIC_RELAXED, __HIP_MEMORY_SCOPE_AGENT); }
}
__device__ __forceinline__ void ret_scan_wait(const Params& p, int layer) {
    if (threadIdx.x == 0) {
        unsigned* c = (unsigned*)(p.ws + WS_CTL + 16384) + 64 * layer; unsigned sp = 0u;
        while (__hip_atomic_load(c, __ATOMIC_RELAXED, __HIP_MEMORY_SCOPE_AGENT) < 256u) { __builtin_amdgcn_s_sleep(2); if (++sp > (1u << 22)) break; }
        __builtin_amdgcn_fence(__ATOMIC_ACQUIRE, "agent"); asm volatile("s_waitcnt vmcnt(0)" ::: "memory");
    }
    __syncthreads();
}

__device__ __forceinline__ void publish_count(unsigned* c, unsigned n) {
    asm volatile("s_waitcnt vmcnt(0)" ::: "memory");
    __syncthreads();
    if (threadIdx.x == 0) { __builtin_amdgcn_fence(__ATOMIC_RELEASE, "agent"); asm volatile("s_waitcnt vmcnt(0)" ::: "memory"); __hip_atomic_fetch_add(c, n, __ATOMIC_RELAXED, __HIP_MEMORY_SCOPE_AGENT); }
}
__device__ __forceinline__ void wait_count(unsigned* c, unsigned want) {
    if (threadIdx.x == 0) { unsigned sp = 0u;
        while (__hip_atomic_load(c, __ATOMIC_RELAXED, __HIP_MEMORY_SCOPE_AGENT) < want) { __builtin_amdgcn_s_sleep(2); if (++sp > (1u << 22)) break; }
        __builtin_amdgcn_fence(__ATOMIC_ACQUIRE, "agent"); asm volatile("s_waitcnt vmcnt(0)" ::: "memory"); }
    __syncthreads();
}
__device__ __forceinline__ int queue_pop(unsigned* counter, LAS unsigned* slot) {
    __syncthreads();
    if (threadIdx.x == 0) slot[0] = __hip_atomic_fetch_add(counter, 1u, __ATOMIC_RELAXED, __HIP_MEMORY_SCOPE_AGENT);
    __syncthreads();
    return (int)slot[0];
}
__device__ __forceinline__ void phase_mixers(const Params& p, int layer, unsigned char* lds) {
    static constexpr unsigned char MOBA_ORDER[128] = {111,127,110,126,109,125,93,94,95,92,108,124,91,107,123,90,106,122,89,105,121,88,104,120,87,103,119,71,72,73,74,75,76,77,78,79,70,86,102,118,69,85,101,117,68,84,100,116,52,53,54,55,56,57,58,59,60,61,62,63,51,67,83,99,115,50,66,82,98,114,34,35,36,37,38,39,40,41,42,43,44,45,46,47,17,18,19,20,21,22,23,24,25,26,27,28,29,30,31,33,49,65,81,97,113,1,2,3,4,5,6,7,8,9,10,11,12,13,14,15,0,16,32,48,64,80,96,112};
    unsigned* qc = (unsigned*)(p.ws + WS_CTL + 24576) + layer * 256;
    LAS unsigned* slot = (LAS unsigned*)((LAS unsigned char*)lds + BAR_LDS_OFF + 16);
    phase_stats(p, layer, lds);
    publish_count((unsigned*)(p.ws + WS_CTL + 16384) + 64 * (2 + layer), 1u);
#define QUEUE_LOOP(CNT, N, BODY) do { int cur = queue_pop(CNT, slot); \
        _Pragma("unroll 1") while (cur < (N)) { unsigned nxt_ = 0u; if (threadIdx.x == 0) nxt_ = __hip_atomic_fetch_add(CNT, 1u, __ATOMIC_RELAXED, __HIP_MEMORY_SCOPE_AGENT); \
            { BODY; } \
            __syncthreads(); if (threadIdx.x == 0) slot[0] = nxt_; __syncthreads(); cur = (int)slot[0]; } } while (0)
    QUEUE_LOOP(qc + 128, 512, conv_unit(p, layer, cur >> 6, cur & 63, lds));
    wait_count((unsigned*)(p.ws + WS_CTL + 16384) + 64 * (2 + layer), gridDim.x);
    ret_scan_shares(p, layer);
    QUEUE_LOOP(qc, 1024, const int hj = MOBA_ORDER[cur >> 3]; moba_unit(p, layer, cur & 7, hj >> 4, hj & 15, lds));
    ret_scan_wait(p, layer);
    QUEUE_LOOP(qc + 64, 1024, ret_unit(p, cur >> 7, (cur >> 5) & 3, cur & 31, lds));
#undef QUEUE_LOOP
}

__device__ __forceinline__ void phase_final(const Params& p) {
    const float* rowss = (const float*)(p.ws + WS_ROWSS); const h16* xh = (const h16*)(p.ws + WS_XH);
    const int lane = threadIdx.x & 63, wid = threadIdx.x >> 6;
    f32x4 g[4];
#pragma unroll
    for (int j = 0; j < 4; ++j) g[j] = *((const f32x4*)p.final_g + lane + 64 * j);
    for (int row = blockIdx.x * 8 + wid; row < MROWS; row += gridDim.x * 8) {
        const f32x4* rs = (const f32x4*)(rowss + (size_t)row * NPART); const f32x4 s0 = rs[0], s1 = rs[1], s2 = rs[2], s3 = rs[3];
        const float tot = ((s0[0] + s0[1]) + (s0[2] + s0[3])) + ((s1[0] + s1[1]) + (s1[2] + s1[3])) + ((s2[0] + s2[1]) + (s2[2] + s2[3])) + ((s3[0] + s3[1]) + (s3[2] + s3[3]));
        const float rstd = rsqrtf(tot * (1.0f / DM) + 1e-6f);
        const h16x4* xr = (const h16x4*)(xh + (size_t)row * DM) + lane; f32x4* orow = (f32x4*)(p.out + (size_t)row * DM) + lane;
#pragma unroll
        for (int j = 0; j < 4; ++j) { const h16x4 v = xr[64 * j]; orow[64 * j] = (f32x4){(float)v[0], (float)v[1], (float)v[2], (float)v[3]} * rstd * g[j]; }
    }
}

#define XB_TMO      128
#define XB_XCNT(j)  (256  + 64 * (j))
#define XB_XSUB(j)  (1280 + 64 * (j))
#define XB_XGEN(j)  (2304 + 64 * (j))
#define XB_TOP      3328
#define XB_TOPGEN   3392
#define XCD_BAR_WORDS 3456
#define XB_SPIN_CAP (1u << 18)

__device__ __forceinline__ unsigned xb_ld(unsigned* p)              { return __hip_atomic_load(p, __ATOMIC_RELAXED, __HIP_MEMORY_SCOPE_AGENT); }
__device__ __forceinline__ unsigned xb_add(unsigned* p, unsigned v) { return __hip_atomic_fetch_add(p, v, __ATOMIC_RELAXED, __HIP_MEMORY_SCOPE_AGENT); }
__device__ __forceinline__ unsigned xb_xcc_id() { return (unsigned)__builtin_amdgcn_s_getreg((3 << 11) | 20) & 0xFu; }
#define XB_SPIN(cond, bar) do { unsigned _sp = 0; while (cond) { __builtin_amdgcn_s_sleep(1); \
    if ((++_sp & 255u) == 0u) { if (xb_ld(&(bar)[XB_TMO])) break; if (_sp > XB_SPIN_CAP) { atomicAdd(&(bar)[XB_TMO], 1u); break; } } } } while (0)

struct XcdBarrier {
    unsigned* bar; unsigned x;
    volatile LAS unsigned* st;
};

__device__ __forceinline__ XcdBarrier xcd_barrier_post(unsigned* bar, volatile LAS unsigned* st) {
    XcdBarrier b; b.bar = bar; b.x = xb_xcc_id(); b.st = st;
    if (threadIdx.x == 0) (void)xb_add(&bar[XB_XCNT(b.x)], 1u);
    return b;
}
__device__ __forceinline__ void xcd_barrier_complete(unsigned* bar, unsigned x, unsigned& nloc, unsigned& nx) {
    const unsigned G = gridDim.x * gridDim.y * gridDim.z;
    unsigned sum, cnt, mine, sp = 0u;
    for (;;) {
        sum = 0u; cnt = 0u; mine = 0u;
#pragma unroll
        for (unsigned j = 0; j < 16; ++j) { const unsigned c = xb_ld(&bar[XB_XCNT(j)]); sum += c; cnt += (c > 0u) ? 1u : 0u; mine = (j == x) ? c : mine; }
        if (sum == G) break;
        __builtin_amdgcn_s_sleep(1);
        if ((++sp & 255u) == 0u) { if (xb_ld(&bar[XB_TMO])) break; if (sp > XB_SPIN_CAP) { atomicAdd(&bar[XB_TMO], 1u); break; } }
    }
    nloc = mine > 0u ? mine : 1u; nx = cnt > 0u ? cnt : 1u;
}

__device__ __forceinline__ void xcd_barrier(const XcdBarrier& b) {
    asm volatile("s_waitcnt vmcnt(0)" ::: "memory");
    __syncthreads();
    if (threadIdx.x == 0) {
        unsigned* bar = b.bar;
        __builtin_amdgcn_s_waitcnt(0);
        unsigned nloc = b.st[0], nx = b.st[1];
        if (nloc == 0u) { xcd_barrier_complete(bar, b.x, nloc, nx); b.st[0] = nloc; b.st[1] = nx; }
        const unsigned old = xb_add(&bar[XB_XSUB(b.x)], 1u);
        const unsigned gen = old / nloc;
        if (old + 1u == (gen + 1u) * nloc) {
            __builtin_amdgcn_fence(__ATOMIC_RELEASE, "agent");
            asm volatile("s_waitcnt vmcnt(0)" ::: "memory");
            const unsigned og = xb_add(&bar[XB_TOP], 1u);
            const unsigned tg = og / nx;
            if (og + 1u == (tg + 1u) * nx) xb_add(&bar[XB_TOPGEN], 1u);
            else XB_SPIN(xb_ld(&bar[XB_TOPGEN]) == tg, bar);
            __builtin_amdgcn_fence(__ATOMIC_ACQUIRE, "agent");
            xb_add(&bar[XB_XGEN(b.x)], 1u);
            asm volatile("s_waitcnt vmcnt(0)" ::: "memory");
        } else {
            XB_SPIN(xb_ld(&bar[XB_XGEN(b.x)]) == gen, bar);
            __builtin_amdgcn_fence(__ATOMIC_ACQUIRE, "agent");
            asm volatile("s_waitcnt vmcnt(0)" ::: "memory");
        }
    }
    __syncthreads();
}


__global__ void __launch_bounds__(NTHREADS) hymba_fwd(Params p) {
    extern __shared__ __attribute__((aligned(16))) unsigned char lds[];
    cg::grid_group grid = cg::this_grid();
    volatile LAS unsigned* bst = (volatile LAS unsigned*)((LAS unsigned char*)lds + BAR_LDS_OFF);
    if (threadIdx.x < 2) bst[threadIdx.x] = 0u;
    __syncthreads();
    XcdBarrier xbar = xcd_barrier_post((unsigned*)(p.ws + WS_CTL), bst);
#define RUN_PHASE(k, body) do { if (p.ph_lo <= (k) && (k) < p.ph_hi) { body; if ((k) + 1 < p.ph_hi) { xcd_barrier(xbar); } } } while (0)
    RUN_PHASE(0, phase_prologue(p, lds));
    RUN_PHASE(1, gemm_in(p, 0, lds));
    RUN_PHASE(2, phase_mixers(p, 0, lds));
    RUN_PHASE(3, gemm_out<0>(p, lds));
    RUN_PHASE(4, gemm_in(p, 1, lds));
    RUN_PHASE(5, phase_mixers(p, 1, lds));
    RUN_PHASE(6, gemm_out<1>(p, lds));
    RUN_PHASE(7, phase_final(p));
#undef RUN_PHASE
}

extern "C" void kernel_launch(void* const* d_in, const int* in_sizes, int n_in, void* d_out, int out_size, void* d_ws, size_t ws_size, hipStream_t stream) {
    static int grid_blocks = 0;
    if (!grid_blocks) {
        int dev = 0, cus = 0, per_cu = 0;
        hipGetDevice(&dev);
        hipDeviceGetAttribute(&cus, hipDeviceAttributeMultiprocessorCount, dev);
        hipFuncSetAttribute((const void*)hymba_fwd, hipFuncAttributeMaxDynamicSharedMemorySize, LDS_BYTES);
        hipOccupancyMaxActiveBlocksPerMultiprocessor(&per_cu, (const void*)hymba_fwd, NTHREADS, LDS_BYTES);
        if (per_cu < 1) per_cu = 1;
        grid_blocks = cus * per_cu;
        if (ws_size < WS_END) fprintf(stderr, "kernel_launch: workspace too small (%zu < %zu)\n", ws_size, (size_t)WS_END);
    }
    Params p{};
    p.x = (const float*)d_in[0]; p.norm_g = (const float*)d_in[1]; p.w_in = (const float*)d_in[2]; p.conv_w = (const float*)d_in[3]; p.conv_b = (const float*)d_in[4];
    p.ln_g = (const float*)d_in[5]; p.ln_b = (const float*)d_in[6]; p.pw_w = (const float*)d_in[7]; p.pw_b = (const float*)d_in[8]; p.w_out = (const float*)d_in[9];
    p.final_g = (const float*)d_in[10]; p.out = (float*)d_out; p.ws = (unsigned char*)d_ws;
    (void)hipMemsetAsync((char*)d_ws + WS_CTL, 0, 32768, stream);
#if ONE_LAUNCH
    p.ph_lo = 0; p.ph_hi = NPHASES;
    { void* args[] = {&p};
      hipError_t e = hipLaunchCooperativeKernel((const void*)hymba_fwd, dim3(grid_blocks), dim3(NTHREADS), args, LDS_BYTES, stream);
      if (e != hipSuccess) fprintf(stderr, "cooperative launch failed: %s (grid %d)\n", hipGetErrorString(e), grid_blocks); }
#else
    for (int ph = 0; ph < NPHASES; ++ph) {
        p.ph_lo = ph; p.ph_hi = ph + 1; void* args[] = {&p};
        hipError_t e = hipLaunchCooperativeKernel((const void*)hymba_fwd, dim3(grid_blocks), dim3(NTHREADS), args, LDS_BYTES, stream);
        if (e != hipSuccess) { fprintf(stderr, "cooperative launch failed: %s (grid %d, phase %d)\n", hipGetErrorString(e), grid_blocks, ph); break; }
    }
#endif
}
```

```cpp
#include <hip/hip_runtime.h>
#include <hip/hip_cooperative_groups.h>
#include <cstdio>
#include <cstdint>
namespace cg = cooperative_groups;

#ifndef ONE_LAUNCH
#define ONE_LAUNCH 1
#endif

typedef _Float16 h16;
typedef _Float16 h16x8 __attribute__((ext_vector_type(8)));
typedef _Float16 h16x4 __attribute__((ext_vector_type(4)));
typedef float f32x16 __attribute__((ext_vector_type(16)));
typedef float f32x4 __attribute__((ext_vector_type(4)));
typedef unsigned u32x4 __attribute__((ext_vector_type(4)));

constexpr int BATCH = 8, SEQ = 4096, DM = 1024, MROWS = BATCH * SEQ, NIN = 3840, DEPTH = 2;
constexpr int C_AVAL = 0, C_AGLU = 256, C_AGATE = 512, C_RQ = 768, C_RK = 1024, C_RV = 1280, C_RGATE = 1536, C_MQ = 1792, C_MK = 2304, C_MV = 2816, C_MGATE = 3328;
constexpr int NPART = 16;
constexpr int NTHREADS = 512;
constexpr int LDS_BYTES = 147456;
constexpr int NPHASES = 8;

constexpr size_t MiB = 1u << 20;
constexpr size_t WS_XH = 0, WS_PROJ = 64 * MiB, WS_MIX = 304 * MiB, WS_WIN = 368 * MiB, WS_WOUT = 383 * MiB, WS_WPW = 387 * MiB,
                 WS_KV = 388 * MiB, WS_KMEAN = 404 * MiB  , WS_ROWSS = 405 * MiB, WS_CTL = 408 * MiB  , WS_RST = 409 * MiB  , WS_END = 417 * MiB;
constexpr int BAR_LDS_OFF = LDS_BYTES - 64;

struct Params {
    const float *x, *norm_g, *w_in, *conv_w, *conv_b, *ln_g, *ln_b, *pw_w, *pw_b, *w_out, *final_g;
    float* out; unsigned char* ws;
    int ph_lo, ph_hi;
};

__device__ __forceinline__ float silu_f(float v) { return v * __builtin_amdgcn_rcpf(1.0f + __expf(-v)); }
__device__ __forceinline__ int crow(int r, int h) { return (r & 3) + 8 * (r >> 2) + 4 * h; }
__device__ __forceinline__ float wave_sum(float v) {
#pragma unroll
    for (int o = 1; o < 64; o <<= 1) v += __shfl_xor(v, o);
    return v;
}

__device__ __forceinline__ void transpose_unit(const float* W, int K, int N, h16* WT, const float* g, int k0, int n0, float* tile) {
    const int tid = threadIdx.x;
    __syncthreads();
#pragma unroll
    for (int i = 0; i < 8; ++i) { const int k = i * 8 + (tid >> 6), n = tid & 63; float v = W[(size_t)(k0 + k) * N + n0 + n]; if (g) v *= g[k0 + k]; tile[k * 65 + n] = v; }
    __syncthreads();
    { const int n = tid >> 3, kc = tid & 7; h16x8 w;
#pragma unroll
        for (int i = 0; i < 8; ++i) w[i] = (h16)tile[(kc * 8 + i) * 65 + n];
        *(h16x8*)(WT + (size_t)(n0 + n) * K + k0 + kc * 8) = w; }
}

__device__ __forceinline__ void phase_prologue(const Params& p, unsigned char* lds) {
    float* tile = (float*)lds;
    h16* win = (h16*)(p.ws + WS_WIN);
    constexpr int U_IN = 16 * 60;
    for (int r = blockIdx.x; r < U_IN; r += gridDim.x)
        transpose_unit(p.w_in, DM, NIN, win, p.norm_g, (r / 60) * 64, (r % 60) * 64, tile);
    h16* xh = (h16*)(p.ws + WS_XH); float* rowss = (float*)(p.ws + WS_ROWSS);
    const int lane = threadIdx.x & 63, wid = threadIdx.x >> 6;
    for (int row = blockIdx.x * 8 + wid; row < MROWS; row += gridDim.x * 8) {
        const f32x4* xr = (const f32x4*)(p.x + (size_t)row * DM) + lane;
        float ss = 0.f;
#pragma unroll
        for (int j = 0; j < 4; ++j) { const f32x4 v = xr[64 * j]; ss += v.x * v.x + v.y * v.y + v.z * v.z + v.w * v.w;
            h16x4 o; o.x = (h16)v.x; o.y = (h16)v.y; o.z = (h16)v.z; o.w = (h16)v.w; *((h16x4*)(xh + (size_t)row * DM) + lane + 64 * j) = o; }
        ss = wave_sum(ss);
        if (lane < NPART) rowss[(size_t)row * NPART + lane] = (lane == 0) ? ss : 0.f;
    }
}

typedef short s16x4 __attribute__((ext_vector_type(4)));
#define LAS __attribute__((address_space(3)))
__device__ __forceinline__ float xhalf_max(float v) { auto rr = __builtin_amdgcn_permlane32_swap(__float_as_uint(v), __float_as_uint(v), false, false); return fmaxf(__uint_as_float(rr[0]), __uint_as_float(rr[1])); }
__device__ __forceinline__ float xhalf_sum(float v) { auto rr = __builtin_amdgcn_permlane32_swap(__float_as_uint(v), __float_as_uint(v), false, false); return __uint_as_float(rr[0]) + __uint_as_float(rr[1]); }
__device__ __forceinline__ h16x8 tr_frag(const LAS unsigned char* a) {
    const s16x4 lo = __builtin_amdgcn_ds_read_tr16_b64_v4i16((LAS s16x4*)a), hi = __builtin_amdgcn_ds_read_tr16_b64_v4i16((LAS s16x4*)(a + 512));
    typedef short s16x8 __attribute__((ext_vector_type(8)));
    const s16x8 v = __builtin_shufflevector(lo, hi, 0, 1, 2, 3, 4, 5, 6, 7);
    return __builtin_bit_cast(h16x8, v);
}
#define CROW0(i) (((i) & 3) + 8 * ((i) >> 2))
__device__ __forceinline__ float fadd_s(float a, float b) { float r; asm("v_add_f32_e32 %0, %1, %2" : "=v"(r) : "v"(a), "v"(b)); return r; }
__device__ __forceinline__ void glds16(const void* gsrc, unsigned lds_dst) { unsigned keep;
    asm volatile("s_mov_b32 %0, m0\n\ts_mov_b32 m0, %2\n\ts_nop 0\n\tglobal_load_lds_dwordx4 %1, off\n\ts_mov_b32 m0, %0" : "=&s"(keep) : "v"(gsrc), "s"(lds_dst) : "memory"); }

namespace pg8 {
#define PG8_LAS __attribute__((address_space(3)))
typedef _Float16 bf16_t;
typedef _Float16 bf16x8 __attribute__((ext_vector_type(8)));
typedef float f32x4 __attribute__((ext_vector_type(4)));
typedef unsigned u32x4 __attribute__((ext_vector_type(4)));
constexpr int BM = 256, BK = 64, HALF = 128, HTB = HALF * BK * 2  , STAGE_BYTES = 8 * HTB, NXCD = 8, WGM = 8;

__host__ __device__ __forceinline__ int lds_byte(int r, int c) { const int st = (r >> 4) * 2 + (c >> 5), rr = r & 15, cc = c & 31, ob = rr * 64 + cc * 2; return st * 1024 + (ob ^ (((ob >> 9) & 1) << 5)); }
__host__ __device__ __forceinline__ void stage_rc(int b, int& R, int& C) { const int st = b / 1024, sb = b % 1024, swz = sb ^ (((sb >> 9) & 1) << 5); R = (st >> 1) * 16 + swz / 64; C = (st & 1) * 32 + (swz % 64) / 2; }
__host__ __device__ __forceinline__ int perm32(int rho) { const int n = rho >> 4, i = rho & 15; return 8 * (i >> 2) + 4 * n + (i & 3); }

struct Unit { int pm, pn; };
struct Gemm { const bf16_t* A; const bf16_t* Bt; int M, N, K; };

struct StaticOrder {
    int nM, nN, nwg, G, c;
    __host__ __device__ void init(int M, int N, int G_, int c_) { nM = M / BM; nN = N / BM; nwg = nM * nN; G = G_; c = c_; }
    __host__ __device__ bool next(int i, Unit& u) const {
        const long L = (long)i * G + c; if (L >= nwg) return false;
        int wgid = (int)L; { const int q = nwg / NXCD, r = nwg % NXCD, xcd = wgid % NXCD, off = wgid / NXCD; wgid = (xcd < r ? xcd * (q + 1) : r * (q + 1) + (xcd - r) * q) + off; }
        const int nig = WGM * nN, gid = wgid / nig, fm = gid * WGM, gsz = (nM - fm) < WGM ? (nM - fm) : WGM;
        u.pm = fm + ((wgid % nig) % gsz); u.pn = (wgid % nig) / gsz; return true;
    }
    __device__ __forceinline__ void a_ready(const Unit&) const {}
    __device__ __forceinline__ void done(const Unit&) const {}
};

template <class Epi, class Sched, bool ALIGN_EPI = false, bool SP2 = false>
__device__ __forceinline__ void gemm_phase(PG8_LAS unsigned char* lds, const Gemm g, const Sched& S, const Epi& E) {
    const int tid = threadIdx.x, wid = __builtin_amdgcn_readfirstlane(tid >> 6), lane = tid & 63, wr = wid >> 2, wc = wid & 3, fr = lane & 15, fq = lane >> 4;
    const int K = g.K, nt = K / BK;
    unsigned voffA[2], voffB[2];
#pragma unroll
    for (int i = 0; i < 2; ++i) { int R, C; stage_rc(tid * 16 + i * 8192, R, C); const int Rb = Epi::PERM ? ((R & ~31) + perm32(R & 31)) : R;
        voffA[i] = (unsigned)(R * K + C) * 2u; voffB[i] = (unsigned)(Rb * K + C) * 2u; }
    const size_t kstep = (size_t)(BK * 2);
    const size_t hstep = (size_t)HALF * K * 2;
    const size_t tstep = 2 * hstep;
    const unsigned ldsw = (unsigned)wid * 1024u;
    const int aoff = lds_byte(wr * 64 + fr, fq * 8), boff = lds_byte(wc * 32 + fr, fq * 8);
#define PG8_SA(b, h) (((b) * 2 + (h)) * HTB)
#define PG8_SB(b, h) ((4 + (b) * 2 + (h)) * HTB)
#define PG8_STAGE(bufoff, gbase, voff) do { _Pragma("unroll") for (int _i = 0; _i < 2; ++_i) \
        __builtin_amdgcn_global_load_lds((const unsigned*)((const char*)(gbase) + (voff)[_i]), (PG8_LAS unsigned*)(lds + (bufoff) + ldsw + _i * 8192), 16, 0, 0); } while (0)
#define PG8_LDA(dst, b, h) do { _Pragma("unroll") for (int m = 0; m < 4; ++m) _Pragma("unroll") for (int k = 0; k < 2; ++k) dst[m][k] = *(const PG8_LAS bf16x8*)(lds + PG8_SA(b, h) + aoff + m * 2048 + k * 1024); } while (0)
#define PG8_LDB(dst, b, h) do { _Pragma("unroll") for (int n = 0; n < 2; ++n) _Pragma("unroll") for (int k = 0; k < 2; ++k) dst[n][k] = *(const PG8_LAS bf16x8*)(lds + PG8_SB(b, h) + boff + n * 2048 + k * 1024); } while (0)
#define PG8_MMA(ai, bj, At, Bt) do { __builtin_amdgcn_s_setprio(1); _Pragma("unroll") for (int m = 0; m < 4; ++m) _Pragma("unroll") for (int n = 0; n < 2; ++n) _Pragma("unroll") for (int k = 0; k < 2; ++k) \
        acc[ai][bj][m][n] = __builtin_amdgcn_mfma_f32_16x16x32_f16(Bt[n][k], At[m][k], acc[ai][bj][m][n], 0, 0, 0); __builtin_amdgcn_s_setprio(0); } while (0)
#define PG8_WAIT_V(n) asm volatile("s_waitcnt vmcnt(" #n ")" ::: "memory")
#define PG8_WAIT_L(n) asm volatile("s_waitcnt lgkmcnt(" #n ")" ::: "memory")
#define PG8_BAR __builtin_amdgcn_s_barrier()
#define PG8_SCHED __builtin_amdgcn_sched_barrier(0)
    Unit cur, nxt; int ui = 0;
    if (!S.next(0, cur)) return;
    f32x4 acc[2][2][4][2];
#pragma unroll
    for (int a = 0; a < 2; ++a)
#pragma unroll
        for (int b = 0; b < 2; ++b)
#pragma unroll
            for (int m = 0; m < 4; ++m)
#pragma unroll
                for (int n = 0; n < 2; ++n) acc[a][b][m][n] = (f32x4){0.f, 0.f, 0.f, 0.f};
    bf16x8 At[4][2], B0[2][2], B1[2][2];
    const char* cA = (const char*)g.A + (size_t)cur.pm * tstep; const char* cB = (const char*)g.Bt + (size_t)cur.pn * tstep;
    S.a_ready(cur);
    if constexpr (SP2) {
        PG8_STAGE(PG8_SB(0, 0), cB, voffB); PG8_STAGE(PG8_SB(0, 1), cB + hstep, voffB); PG8_STAGE(PG8_SA(0, 0), cA, voffA); PG8_STAGE(PG8_SA(0, 1), cA + hstep, voffA);
        if (wr == 1) PG8_BAR;
        PG8_WAIT_V(2); PG8_BAR;
        PG8_STAGE(PG8_SB(1, 0), cB + kstep, voffB); PG8_STAGE(PG8_SA(1, 0), cA + kstep, voffA); PG8_STAGE(PG8_SB(1, 1), cB + hstep + kstep, voffB);
        PG8_WAIT_V(6); PG8_BAR;
    } else {
        PG8_STAGE(PG8_SB(0, 0), cB, voffB); PG8_STAGE(PG8_SA(0, 0), cA, voffA); PG8_STAGE(PG8_SB(0, 1), cB + hstep, voffB); PG8_STAGE(PG8_SA(0, 1), cA + hstep, voffA);
        if (wr == 1) PG8_BAR;
        PG8_WAIT_V(4); PG8_BAR;
        PG8_STAGE(PG8_SB(1, 0), cB + kstep, voffB); PG8_STAGE(PG8_SA(1, 0), cA + kstep, voffA); PG8_STAGE(PG8_SB(1, 1), cB + hstep + kstep, voffB);
        PG8_WAIT_V(6); PG8_BAR;
    }
    for (;;) {
        const bool has_next = S.next(ui + 1, nxt);
        const char* nA = has_next ? (const char*)g.A + (size_t)nxt.pm * tstep : cA; const char* nB = has_next ? (const char*)g.Bt + (size_t)nxt.pn * tstep : cB;
        for (int t = 0; t < nt; t += 2) {
            const bool last = (t == nt - 2);
            const char* a1 = cA + (size_t)(t + 1) * kstep;
            const char* a2 = last ? nA : cA + (size_t)(t + 2) * kstep; const char* b2 = last ? nB : cB + (size_t)(t + 2) * kstep;
            const char* a3 = a2 + kstep; const char* b3 = b2 + kstep;
            if (last && has_next) S.a_ready(nxt);
            if constexpr (SP2) {
            PG8_LDB(B0, 0, 0); PG8_LDB(B1, 0, 1); PG8_SCHED; PG8_LDA(At, 0, 0); PG8_STAGE(PG8_SA(1, 1), a1 + hstep, voffA);
            PG8_WAIT_V(8); PG8_WAIT_L(0); PG8_BAR; PG8_MMA(0, 0, At, B0); PG8_MMA(0, 1, At, B1); PG8_BAR; PG8_SCHED;
            PG8_LDA(At, 0, 1); PG8_STAGE(PG8_SB(0, 0), b2, voffB); PG8_STAGE(PG8_SB(0, 1), b2 + hstep, voffB); PG8_STAGE(PG8_SA(0, 0), a2, voffA);
            PG8_WAIT_V(8); PG8_WAIT_L(0); PG8_BAR; PG8_MMA(1, 0, At, B0); PG8_MMA(1, 1, At, B1); PG8_BAR; PG8_SCHED;
            PG8_LDB(B0, 1, 0); PG8_LDB(B1, 1, 1); PG8_SCHED; PG8_LDA(At, 1, 0); PG8_STAGE(PG8_SA(0, 1), a2 + hstep, voffA);
            PG8_WAIT_V(8); PG8_WAIT_L(0); PG8_BAR; PG8_MMA(0, 0, At, B0); PG8_MMA(0, 1, At, B1); PG8_BAR; PG8_SCHED;
            PG8_LDA(At, 1, 1); PG8_STAGE(PG8_SB(1, 0), b3, voffB); PG8_STAGE(PG8_SB(1, 1), b3 + hstep, voffB); PG8_STAGE(PG8_SA(1, 0), a3, voffA);
            PG8_WAIT_V(8); PG8_WAIT_L(0); PG8_BAR; PG8_MMA(1, 0, At, B0); PG8_MMA(1, 1, At, B1); PG8_BAR; PG8_SCHED;
            } else {
            PG8_LDB(B0, 0, 0); PG8_SCHED; PG8_LDA(At, 0, 0); PG8_STAGE(PG8_SA(1, 1), a1 + hstep, voffA);
            PG8_WAIT_L(8); PG8_BAR; PG8_WAIT_L(0); PG8_MMA(0, 0, At, B0); PG8_BAR; PG8_SCHED;
            PG8_LDB(B1, 0, 1); PG8_STAGE(PG8_SB(0, 0), b2, voffB);
            PG8_BAR; PG8_WAIT_L(0); PG8_MMA(0, 1, At, B1); PG8_BAR;
            PG8_LDA(At, 0, 1); PG8_STAGE(PG8_SA(0, 0), a2, voffA);
            PG8_BAR; PG8_WAIT_L(0); PG8_MMA(1, 0, At, B0); PG8_BAR; PG8_SCHED;
            PG8_STAGE(PG8_SB(0, 1), b2 + hstep, voffB);
            PG8_WAIT_V(6); PG8_BAR; PG8_MMA(1, 1, At, B1); PG8_BAR;
            PG8_LDB(B0, 1, 0); PG8_SCHED; PG8_LDA(At, 1, 0); PG8_STAGE(PG8_SA(0, 1), a2 + hstep, voffA);
            PG8_WAIT_L(8); PG8_BAR; PG8_WAIT_L(0); PG8_MMA(0, 0, At, B0); PG8_BAR; PG8_SCHED;
            PG8_LDB(B1, 1, 1); PG8_STAGE(PG8_SB(1, 0), b3, voffB);
            PG8_BAR; PG8_WAIT_L(0); PG8_MMA(0, 1, At, B1); PG8_BAR;
            PG8_LDA(At, 1, 1); PG8_STAGE(PG8_SA(1, 0), a3, voffA);
            PG8_BAR; PG8_WAIT_L(0); PG8_MMA(1, 0, At, B0); PG8_BAR; PG8_SCHED;
            PG8_STAGE(PG8_SB(1, 1), b3 + hstep, voffB);
            PG8_WAIT_V(6); PG8_BAR; PG8_MMA(1, 1, At, B1); PG8_BAR;
            }
        }
        if constexpr (ALIGN_EPI) { if (wr == 0) PG8_BAR; }
        if constexpr (!Epi::AFTER_DRAIN) { E(acc, cur, wr, wc, fr, fq); S.done(cur); }
        if (!has_next) break;
#pragma unroll
        for (int a = 0; a < 2; ++a)
#pragma unroll
            for (int b = 0; b < 2; ++b)
#pragma unroll
                for (int m = 0; m < 4; ++m)
#pragma unroll
                    for (int n = 0; n < 2; ++n) acc[a][b][m][n] = (f32x4){0.f, 0.f, 0.f, 0.f};
        cur = nxt; cA = nA; cB = nB; ++ui;
        if constexpr (ALIGN_EPI) { if (wr == 1) PG8_BAR; }
    }
    PG8_WAIT_V(0);
    if constexpr (!ALIGN_EPI) { if (wr == 0) PG8_BAR; }
    PG8_BAR;
    if constexpr (Epi::AFTER_DRAIN) { E.fused(acc, cur, wr, wc, fr, fq, lds, wid, lane); S.done(cur); }
#undef PG8_SA
#undef PG8_SB
#undef PG8_STAGE
#undef PG8_LDA
#undef PG8_LDB
#undef PG8_MMA
#undef PG8_WAIT_V
#undef PG8_WAIT_L
#undef PG8_BAR
#undef PG8_SCHED
}

struct EpiProj {
    static constexpr bool PERM = true, AFTER_DRAIN = false;
    bf16_t* O; const float* rowss; float* kmpart; unsigned* kmaxh;
    __device__ __forceinline__ void operator()(const f32x4 (&acc)[2][2][4][2], const Unit& u, int wr, int wc, int fr, int fq) const {
        const int row0 = u.pm * BM + wr * 64 + fr, col0 = u.pn * BM + wc * 32 + 8 * fq;
        const bool want_km = (u.pn == 9) || (u.pn == 10);
        float kn[2] = {0.f, 0.f};
        f32x4 cs[2][2];
#pragma unroll
        for (int bj = 0; bj < 2; ++bj)
#pragma unroll
            for (int n = 0; n < 2; ++n) cs[bj][n] = (f32x4){0.f, 0.f, 0.f, 0.f};
#pragma unroll
        for (int ai = 0; ai < 2; ++ai)
#pragma unroll
            for (int m = 0; m < 4; ++m) { const size_t row = (size_t)(row0 + ai * HALF + m * 16);
                const f32x4* rs = (const f32x4*)(rowss + row * 16); const f32x4 s0 = rs[0], s1 = rs[1], s2 = rs[2], s3 = rs[3];
                const float tot = ((s0[0] + s0[1]) + (s0[2] + s0[3])) + ((s1[0] + s1[1]) + (s1[2] + s1[3])) + ((s2[0] + s2[1]) + (s2[2] + s2[3])) + ((s3[0] + s3[1]) + (s3[2] + s3[3]));
                const float rstd = rsqrtf(tot * (1.0f / 1024.0f) + 1e-6f);
                bf16_t* rowp = O + row * 3840 + col0;
#pragma unroll
                for (int bj = 0; bj < 2; ++bj) { const f32x4 v0 = acc[ai][bj][m][0] * rstd, v1 = acc[ai][bj][m][1] * rstd; bf16x8 w;
                    w[0] = (bf16_t)v0[0]; w[1] = (bf16_t)v0[1]; w[2] = (bf16_t)v0[2]; w[3] = (bf16_t)v0[3]; w[4] = (bf16_t)v1[0]; w[5] = (bf16_t)v1[1]; w[6] = (bf16_t)v1[2]; w[7] = (bf16_t)v1[3];
                    *(bf16x8*)(rowp + bj * HALF) = w; cs[bj][0] += v0; cs[bj][1] += v1;
                    if (want_km) { float q = ((v0[0] * v0[0] + v0[1] * v0[1]) + (v0[2] * v0[2] + v0[3] * v0[3])) + ((v1[0] * v1[0] + v1[1] * v1[1]) + (v1[2] * v1[2] + v1[3] * v1[3]));
                        q += __shfl_xor(q, 16); q += __shfl_xor(q, 32); kn[bj] = fmaxf(kn[bj], q); } } }
        if (want_km) {
#pragma unroll
            for (int bj = 0; bj < 2; ++bj)
#pragma unroll
                for (int n = 0; n < 2; ++n)
#pragma unroll
                    for (int k = 0; k < 4; ++k) { float v = cs[bj][n][k]; v += __shfl_xor(v, 1); v += __shfl_xor(v, 2); v += __shfl_xor(v, 4); v += __shfl_xor(v, 8); cs[bj][n][k] = v * (1.0f / 256.0f); }
#pragma unroll
            for (int bj = 0; bj < 2; ++bj) { float q = kn[bj]; q = fmaxf(q, __shfl_xor(q, 1)); q = fmaxf(q, __shfl_xor(q, 2)); q = fmaxf(q, __shfl_xor(q, 4)); q = fmaxf(q, __shfl_xor(q, 8));
                if (fr == 0 && fq == 0) atomicMax(kmaxh + (((u.pm >> 4) * 8 + (u.pn - 9) * 4 + bj * 2 + (wc >> 1)) * 2 + (wc & 1)), __float_as_uint(q)); }
            if (fr == 0) {
#pragma unroll
                for (int bj = 0; bj < 2; ++bj)
#pragma unroll
                    for (int n = 0; n < 2; ++n) { const int cm = col0 + bj * HALF + 4 * n - 2304;
                        *(f32x4*)(kmpart + ((size_t)((wr * 8 + (u.pm >> 4)) * 8 + (cm >> 6)) * 16 + (u.pm & 15)) * 64 + (cm & 63)) = cs[bj][n]; }
            }
        }
    }
};
template <int LAYER> struct EpiRes {
    static constexpr bool PERM = true, AFTER_DRAIN = false;
    const float* x0; float* xout; bf16_t* xh; float* rowss;
    __device__ __forceinline__ void operator()(const f32x4 (&acc)[2][2][4][2], const Unit& u, int wr, int wc, int fr, int fq) const {
        const int row0 = u.pm * BM + wr * 64 + fr, col0 = u.pn * BM + wc * 32 + 8 * fq;
#pragma unroll
        for (int ai = 0; ai < 2; ++ai) {
            bf16x8 xq[4][2];
#pragma unroll
            for (int m = 0; m < 4; ++m)
#pragma unroll
                for (int bj = 0; bj < 2; ++bj) xq[m][bj] = *(const bf16x8*)(xh + (size_t)(row0 + ai * HALF + m * 16) * 1024 + col0 + bj * HALF);
#pragma unroll
            for (int m = 0; m < 4; ++m) { const size_t row = (size_t)(row0 + ai * HALF + m * 16); float ss = 0.f;
#pragma unroll
                for (int bj = 0; bj < 2; ++bj) { const size_t off = row * 1024 + col0 + bj * HALF; const bf16x8 xp = xq[m][bj];
                    const f32x4 v0 = (f32x4){(float)xp[0], (float)xp[1], (float)xp[2], (float)xp[3]} + acc[ai][bj][m][0], v1 = (f32x4){(float)xp[4], (float)xp[5], (float)xp[6], (float)xp[7]} + acc[ai][bj][m][1];
                    bf16x8 w; w[0] = (bf16_t)v0[0]; w[1] = (bf16_t)v0[1]; w[2] = (bf16_t)v0[2]; w[3] = (bf16_t)v0[3]; w[4] = (bf16_t)v1[0]; w[5] = (bf16_t)v1[1]; w[6] = (bf16_t)v1[2]; w[7] = (bf16_t)v1[3];
                    *(bf16x8*)(xh + off) = w;
                    ss += ((v0[0] * v0[0] + v0[1] * v0[1]) + (v0[2] * v0[2] + v0[3] * v0[3])) + ((v1[0] * v1[0] + v1[1] * v1[1]) + (v1[2] * v1[2] + v1[3] * v1[3])); }
                ss += __shfl_xor(ss, 16); ss += __shfl_xor(ss, 32);
                if (fq == 0) rowss[row * 16 + u.pn * 4 + wc] = ss; }
            asm volatile("" ::: "memory");
        }
    }
};
}


__device__ __forceinline__ void deferred_transposes(const Params& p, unsigned char* lds, int id, int n) {
    float* tile = (float*)lds;
    h16* win = (h16*)(p.ws + WS_WIN); h16* wout = (h16*)(p.ws + WS_WOUT); h16* wpw = (h16*)(p.ws + WS_WPW);
    constexpr int U_IN = 16 * 60, U_OUT = 16 * 16, U_PW = 4 * 4;
    for (int u = id; u < U_IN + 2 * U_OUT + 2 * U_PW; u += n) {
        int r = u;
        if (r < U_IN) { transpose_unit(p.w_in + (size_t)DM * NIN, DM, NIN, win + (size_t)NIN * DM, p.norm_g + DM, (r / 60) * 64, (r % 60) * 64, tile); continue; }
        r -= U_IN;
        if (r < 2 * U_OUT) { const int layer = r / U_OUT; r %= U_OUT; transpose_unit(p.w_out + (size_t)layer * DM * DM, DM, DM, wout + (size_t)layer * DM * DM, nullptr, (r / 16) * 64, (r % 16) * 64, tile); continue; }
        r -= 2 * U_OUT;
        { const int layer = r / U_PW; r %= U_PW; transpose_unit(p.pw_w + (size_t)layer * 256 * 256, 256, 256, wpw + (size_t)layer * 256 * 256, nullptr, (r / 4) * 64, (r % 4) * 64, tile); }
    }
}

__device__ __forceinline__ void gemm_in(const Params& p, int layer, unsigned char* lds) {
    pg8::Gemm g{(const h16*)(p.ws + WS_XH), (const h16*)(p.ws + WS_WIN) + (size_t)layer * NIN * DM, MROWS, NIN, DM};
    pg8::StaticOrder S; S.init(MROWS, NIN, (int)gridDim.x, (int)blockIdx.x);
    pg8::EpiProj E{(h16*)(p.ws + WS_PROJ), (const float*)(p.ws + WS_ROWSS), (float*)(p.ws + WS_KMEAN), (unsigned*)(p.ws + WS_CTL + 20480) + layer * 128};
    pg8::gemm_phase<pg8::EpiProj, pg8::StaticOrder, true, true>((PG8_LAS unsigned char*)lds, g, S, E);
    if (layer == 0) { const int G = (int)gridDim.x, nfull = (MROWS / 256) * (NIN / 256) % G;
        if (nfull == 0) deferred_transposes(p, lds, (int)blockIdx.x, G); else if ((int)blockIdx.x >= nfull) deferred_transposes(p, lds, (int)blockIdx.x - nfull, G - nfull); }
}
template <int LAYER> __device__ __forceinline__ void gemm_out(const Params& p, unsigned char* lds) {
    pg8::Gemm g{(const h16*)(p.ws + WS_MIX), (const h16*)(p.ws + WS_WOUT) + (size_t)LAYER * DM * DM, MROWS, DM, DM};
    pg8::StaticOrder S; S.init(MROWS, DM, (int)gridDim.x, (int)blockIdx.x);
    pg8::EpiRes<LAYER> E{p.x, p.out, (h16*)(p.ws + WS_XH), (float*)(p.ws + WS_ROWSS)};
    pg8::gemm_phase<pg8::EpiRes<LAYER>, pg8::StaticOrder, true, true>((PG8_LAS unsigned char*)lds, g, S, E);
}

__device__ __forceinline__ void phase_stats(const Params& p, int layer, unsigned char* lds_g) {
    LAS unsigned char* lds = (LAS unsigned char*)lds_g;
    const h16* proj = (const h16*)(p.ws + WS_PROJ); float* kv = (float*)(p.ws + WS_KV);
    const int tid = threadIdx.x, lane = tid & 63, wid = __builtin_amdgcn_readfirstlane(tid >> 6), r = lane & 31, hi = lane >> 5;
    const int lanepart = (4 * hi + ((lane & 15) >> 2)) * 64 + ((lane >> 4) & 1) * 32 + (lane & 3) * 8;
#pragma unroll 1
    for (int u = blockIdx.x; u < 256; u += gridDim.x) {
        const int b = u >> 5, hh = (u >> 3) & 3, nq = u & 7;
        const float log_g = logf(1.0f - exp2f(-5.0f - (float)hh));
        h16x8 kk[8], vv[8];
#pragma unroll
        for (int it = 0; it < 8; ++it) {
            const int pc = tid + 512 * it, cn = pc >> 10, key = (pc >> 3) & 127, ch = pc & 7;
            const h16* src = proj + (size_t)(b * SEQ + (4 * nq + cn) * 128 + key) * NIN + hh * 64 + ch * 8;
            kk[it] = *(const h16x8*)(src + C_RK); vv[it] = *(const h16x8*)(src + C_RV);
        }
        __syncthreads();
#pragma unroll
        for (int it = 0; it < 8; ++it) {
            const int pc = tid + 512 * it, cn = pc >> 10, key = (pc >> 3) & 127, ch = pc & 7;
            const float z = __expf(log_g * (float)(127 - key)) * 0.125f;
#pragma unroll
            for (int k = 0; k < 8; ++k) kk[it][k] = (h16)((float)kk[it][k] * z);
            const int off = cn * 32768 + (ch >> 2) * 8192 + (key >> 4) * 1024 + (key & 15) * 64 + (ch & 3) * 16;
            *(LAS h16x8*)(lds + off) = kk[it]; *(LAS h16x8*)(lds + off + 16384) = vv[it];
        }
        __syncthreads();
#pragma unroll
        for (int half = 0; half < 2; ++half) {
            const int cn = 2 * half + (wid >> 2), eb = (wid >> 1) & 1, dbk = wid & 1;
            const LAS unsigned char* kimg = lds + cn * 32768 + dbk * 8192 + lanepart; const LAS unsigned char* vimg = lds + cn * 32768 + 16384 + eb * 8192 + lanepart;
            f32x16 acc;
#pragma unroll
            for (int i = 0; i < 16; ++i) acc[i] = 0.f;
#pragma unroll
            for (int ks = 0; ks < 8; ++ks) acc = __builtin_amdgcn_mfma_f32_32x32x16_f16(tr_frag(vimg + ks * 1024), tr_frag(kimg + ks * 1024), acc, 0, 0, 0);
            float* dst = kv + ((size_t)((b * 4 + hh) * 32 + 4 * nq + cn)) * 4096 + (32 * eb + 4 * hi) * 64 + 32 * dbk + r;
#pragma unroll
            for (int i = 0; i < 16; ++i) dst[CROW0(i) * 64] = acc[i];
        }
    }
}

typedef _Float16 h16x2 __attribute__((ext_vector_type(2)));
typedef float f32x2 __attribute__((ext_vector_type(2)));
__device__ __forceinline__ void conv_unit(const Params& p, int layer, int b, int tt, unsigned char* lds_g) {
    LAS unsigned char* lds = (LAS unsigned char*)lds_g;
    const h16* projb = (const h16*)(p.ws + WS_PROJ) + (size_t)b * SEQ * NIN; h16* mix = (h16*)(p.ws + WS_MIX);
    const int tid = threadIdx.x, lane = tid & 63, wid = __builtin_amdgcn_readfirstlane(tid >> 6), r = lane & 31, hi = lane >> 5;
    const int cp = tid & 127, tg = __builtin_amdgcn_readfirstlane(tid >> 7), t0 = tt * 64;
    constexpr int UIMG = 0  , SIMG = 0, YS = 49152  ;
    {
        h16x8 av[6], gv[6];
#pragma unroll
        for (int it = 0; it < 6; ++it) { const int pi = tid + 512 * it, row = pi >> 5, c8 = pi & 31; const int t = t0 - 30 + row;
            const size_t ro = (size_t)((row < 94 && t >= 0) ? t : 0) * NIN + 8 * c8;
            av[it] = *(const h16x8*)(projb + ro + C_AVAL); gv[it] = *(const h16x8*)(projb + ro + C_AGLU); }
        __syncthreads();
#pragma unroll
        for (int it = 0; it < 6; ++it) { const int pi = tid + 512 * it, row = pi >> 5, c8 = pi & 31; const bool ok = (t0 - 30 + row >= 0);
            h16x8 u;
#pragma unroll
            for (int k = 0; k < 8; ++k) u[k] = ok ? (h16)((float)av[it][k] * __builtin_amdgcn_rcpf(1.0f + __expf(-(float)gv[it][k]))) : (h16)0.f;
            if (row < 94) *(LAS h16x8*)(lds + UIMG + row * 512 + c8 * 16) = u; }
    }
    float y0[16], y1[16];
    {
        float w0[31], w1[31]; const float* cw = p.conv_w + (size_t)layer * 31 * 256 + 2 * cp;
#pragma unroll
        for (int jj = 0; jj < 31; ++jj) { const f32x2 wv = *(const f32x2*)(cw + jj * 256); w0[jj] = wv[0]; w1[jj] = wv[1]; }
        const f32x2 cbv = *(const f32x2*)(p.conv_b + layer * 256 + 2 * cp);
#pragma unroll
        for (int tl = 0; tl < 16; ++tl) { y0[tl] = cbv[0]; y1[tl] = cbv[1]; }
        __syncthreads();
        const LAS unsigned char* ub = lds + UIMG + (16 * tg) * 512 + 4 * cp;
#pragma unroll
        for (int rr = 0; rr < 46; ++rr) { const h16x2 uv = *(const LAS h16x2*)(ub + rr * 512); const float a0 = (float)uv[0], a1 = (float)uv[1];
#pragma unroll
            for (int tl = 0; tl < 16; ++tl) { const int jj = rr - tl; if (jj >= 0 && jj < 31) { y0[tl] += w0[jj] * a0; y1[tl] += w1[jj] * a1; } } }
    }
#pragma unroll
    for (int tl = 0; tl < 16; ++tl) *(LAS f32x2*)(lds + YS + ((16 * tg + tl) * 256 + 2 * cp) * 4) = (f32x2){y0[tl], y1[tl]};
    h16x8 wf[16]; h16x4 gpre[2][4];
    {
        const h16* wp = (const h16*)(p.ws + WS_WPW) + (size_t)layer * 65536 + (size_t)(32 * wid + r) * 256 + 8 * hi;
#pragma unroll
        for (int ks = 0; ks < 16; ++ks) wf[ks] = *(const h16x8*)(wp + 16 * ks);
#pragma unroll
        for (int tb = 0; tb < 2; ++tb) { const h16* gp = projb + (size_t)(t0 + 32 * tb + r) * NIN + C_AGATE + 32 * wid + 4 * hi;
#pragma unroll
            for (int g = 0; g < 4; ++g) gpre[tb][g] = *(const h16x4*)(gp + 8 * g); }
    }
    __syncthreads();
    {
        const f32x4 lg = *(const f32x4*)(p.ln_g + layer * 256 + lane * 4), lb = *(const f32x4*)(p.ln_b + layer * 256 + lane * 4);
#pragma unroll 1
        for (int kb = 0; kb < 8; kb += 4) {
        f32x4 v[4]; float s1[4], s2[4];
#pragma unroll
        for (int k = 0; k < 4; ++k) { v[k] = *(const LAS f32x4*)(lds + YS + ((wid * 8 + kb + k) * 256 + lane * 4) * 4);
            s1[k] = (v[k][0] + v[k][1]) + (v[k][2] + v[k][3]); s2[k] = (v[k][0] * v[k][0] + v[k][1] * v[k][1]) + (v[k][2] * v[k][2] + v[k][3] * v[k][3]); }
#pragma unroll
        for (int o = 1; o < 64; o <<= 1)
#pragma unroll
            for (int k = 0; k < 4; ++k) { s1[k] += __shfl_xor(s1[k], o); s2[k] += __shfl_xor(s2[k], o); }
#pragma unroll
        for (int k = 0; k < 4; ++k) { const int t = wid * 8 + kb + k; const float mu = s1[k] * (1.0f / 256.0f); const float var = fmaxf(s2[k] * (1.0f / 256.0f) - mu * mu, 0.f); const float rs = rsqrtf(var + 1e-5f);
            h16x4 o; o[0] = (h16)silu_f((v[k][0] - mu) * rs * lg[0] + lb[0]); o[1] = (h16)silu_f((v[k][1] - mu) * rs * lg[1] + lb[1]); o[2] = (h16)silu_f((v[k][2] - mu) * rs * lg[2] + lb[2]); o[3] = (h16)silu_f((v[k][3] - mu) * rs * lg[3] + lb[3]);
            *(LAS h16x4*)(lds + SIMG + t * 512 + (((lane >> 1) ^ (t & 15)) << 4) + 8 * (lane & 1)) = o; }
        }
    }
    __syncthreads();
#pragma unroll
    for (int tb = 0; tb < 2; ++tb) {
        f32x16 acc;
#pragma unroll
        for (int i = 0; i < 16; ++i) acc[i] = 0.f;
#pragma unroll
        for (int ks = 0; ks < 16; ++ks) acc = __builtin_amdgcn_mfma_f32_32x32x16_f16(wf[ks], *(const LAS h16x8*)(lds + SIMG + (32 * tb + r) * 512 + (((2 * ks + hi) ^ (r & 15)) << 4)), acc, 0, 0, 0);
        const int t = t0 + 32 * tb + r, n0 = 32 * wid + 4 * hi;
        h16* dst = mix + ((size_t)b * SEQ + t) * DM + n0; const float* pb = p.pw_b + layer * 256 + n0;
#pragma unroll
        for (int g = 0; g < 4; ++g) { const h16x4 ga = gpre[tb][g]; const f32x4 bb = *(const f32x4*)(pb + 8 * g); h16x4 oa;
#pragma unroll
            for (int k = 0; k < 4; ++k) oa[k] = (h16)((acc[4 * g + k] + bb[k]) * silu_f((float)ga[k]));
            *(h16x4*)(dst + 8 * g) = oa; }
    }
}

__device__ __forceinline__ void ret_unit(const Params& p, int b, int hh, int n, unsigned char* lds_g) {
    LAS unsigned char* lds = (LAS unsigned char*)lds_g;
    const h16* projb = (const h16*)(p.ws + WS_PROJ) + (size_t)(b * SEQ + n * 128) * NIN; h16* mix = (h16*)(p.ws + WS_MIX); const float* kv = (const float*)(p.ws + WS_KV);
    const int tid = threadIdx.x, lane = tid & 63, wid = __builtin_amdgcn_readfirstlane(tid >> 6), r = lane & 31, hi = lane >> 5, g4 = wid & 3, eh = wid >> 2;
    const float log_g = logf(1.0f - exp2f(-5.0f - (float)hh));
    constexpr int KIMG = 0, VIMG = 16384, RIMG = 32768, XS = 40960;
    const h16x8 rr = *(const h16x8*)((const h16*)(p.ws + WS_RST) + ((size_t)((b * 4 + hh) * 32 + n)) * 4096 + tid * 8);
    h16x4 gpre[4];
    { const h16* gp0 = projb + (size_t)(32 * g4 + r) * NIN + C_RGATE + hh * 64 + 32 * eh + 4 * hi;
#pragma unroll
      for (int g = 0; g < 4; ++g) gpre[g] = *(const h16x4*)(gp0 + 8 * g); }
    __syncthreads();
    {
        const int e = tid >> 3, ch = tid & 7;
        *(LAS h16x8*)(lds + RIMG + e * 128 + ((ch ^ ((e >> 1) & 7)) << 4)) = rr;
#pragma unroll
        for (int it = 0; it < 2; ++it) {
            const int key = (tid >> 3) + 64 * it;
            h16x8 kk = *(const h16x8*)(projb + (size_t)key * NIN + C_RK + hh * 64 + ch * 8); const h16x8 vv = *(const h16x8*)(projb + (size_t)key * NIN + C_RV + hh * 64 + ch * 8);
            const float z = __expf(-log_g * (float)key) * 0.125f;
#pragma unroll
            for (int k = 0; k < 8; ++k) kk[k] = (h16)((float)kk[k] * z);
            *(LAS h16x8*)(lds + KIMG + key * 128 + ((ch ^ ((key >> 1) & 7)) << 4)) = kk;
            *(LAS h16x8*)(lds + VIMG + (ch >> 2) * 8192 + (key >> 4) * 1024 + (key & 15) * 64 + (ch & 3) * 16) = vv;
        }
    }
    const int qi = 32 * g4 + r;
    h16x8 qf[4];
    {
        const float zq = __expf(log_g * (float)qi);
#pragma unroll
        for (int s = 0; s < 4; ++s) { qf[s] = *(const h16x8*)(projb + (size_t)qi * NIN + C_RQ + hh * 64 + 16 * s + 8 * hi);
#pragma unroll
            for (int k = 0; k < 8; ++k) qf[s][k] = (h16)((float)qf[s][k] * zq); }
    }
    __syncthreads();
    const int rsw = (r >> 1) & 7;
    const int lanepart = (4 * hi + ((lane & 15) >> 2)) * 64 + ((lane >> 4) & 1) * 32 + (lane & 3) * 8;
    f32x16 o;
#pragma unroll
    for (int i = 0; i < 16; ++i) o[i] = 0.f;
#pragma unroll 1
    for (int jb = 0; jb <= g4; ++jb) {
        f32x16 c;
#pragma unroll
        for (int i = 0; i < 16; ++i) c[i] = 0.f;
#pragma unroll
        for (int s = 0; s < 4; ++s) c = __builtin_amdgcn_mfma_f32_32x32x16_f16(*(const LAS h16x8*)(lds + KIMG + (32 * jb + r) * 128 + (((2 * s + hi) ^ rsw) << 4)), qf[s], c, 0, 0, 0);
        if (jb == g4) {
#pragma unroll
            for (int i = 0; i < 16; ++i) if (CROW0(i) + 4 * hi > r) c[i] = 0.f;
        }
        h16x8 pf0, pf1;
#pragma unroll
        for (int k = 0; k < 8; ++k) { pf0[k] = (h16)c[k]; pf1[k] = (h16)c[8 + k]; }
        o = __builtin_amdgcn_mfma_f32_32x32x16_f16(tr_frag(lds + VIMG + eh * 8192 + (2 * jb) * 1024 + lanepart), pf0, o, 0, 0, 0);
        o = __builtin_amdgcn_mfma_f32_32x32x16_f16(tr_frag(lds + VIMG + eh * 8192 + (2 * jb + 1) * 1024 + lanepart), pf1, o, 0, 0, 0);
    }
#pragma unroll
    for (int s = 0; s < 4; ++s) o = __builtin_amdgcn_mfma_f32_32x32x16_f16(*(const LAS h16x8*)(lds + RIMG + (32 * eh + r) * 128 + (((2 * s + hi) ^ rsw) << 4)), qf[s], o, 0, 0, 0);
    float s1 = 0.f, s2 = 0.f;
#pragma unroll
    for (int i = 0; i < 16; ++i) { s1 += o[i]; s2 += o[i] * o[i]; }
    s1 = xhalf_sum(s1); s2 = xhalf_sum(s2);
    LAS float* xs = (LAS float*)(lds + XS);
    if (hi == 0) { xs[(wid * 32 + r) * 2] = s1; xs[(wid * 32 + r) * 2 + 1] = s2; }
    __syncthreads();
    {
        const float t1 = xs[((wid ^ 4) * 32 + r) * 2], t2 = xs[((wid ^ 4) * 32 + r) * 2 + 1];
        const float a1 = (eh == 0) ? (s1 + t1) : (t1 + s1), a2 = (eh == 0) ? (s2 + t2) : (t2 + s2);
        const float mu = a1 * (1.0f / 64.0f); const float var = fmaxf(a2 * (1.0f / 64.0f) - mu * mu, 0.f); const float rs = rsqrtf(var + 1e-5f);
        const int col = hh * 64 + 32 * eh + 4 * hi;
        h16* dst = mix + ((size_t)(b * SEQ + n * 128 + qi)) * DM + 256 + col;
#pragma unroll
        for (int g = 0; g < 4; ++g) { const h16x4 ga = gpre[g]; h16x4 oa;
#pragma unroll
            for (int k = 0; k < 4; ++k) oa[k] = (h16)((o[4 * g + k] - mu) * rs * silu_f((float)ga[k]));
            *(h16x4*)(dst + 8 * g) = oa; }
    }
}

constexpr float MOBA_THR = 8.0f;
__device__ __forceinline__ void moba_unit(const Params& p, int layer, int b, int hh, int j, unsigned char* lds_g) {
    LAS unsigned char* lds = (LAS unsigned char*)lds_g;
    const int tid = threadIdx.x, lane = tid & 63, wid = __builtin_amdgcn_readfirstlane(tid >> 6), r = lane & 31, hi = lane >> 5;
    const h16* projb = (const h16*)(p.ws + WS_PROJ) + (size_t)b * SEQ * NIN; h16* mix = (h16*)(p.ws + WS_MIX);
    const int qrow = j * 256 + wid * 32 + r;
    h16x8 qf[4];
#pragma unroll
    for (int s = 0; s < 4; ++s) qf[s] = *(const h16x8*)(projb + (size_t)qrow * NIN + C_MQ + hh * 64 + 16 * s + 8 * hi);
    const unsigned lds0 = (unsigned)(__UINTPTR_TYPE__)lds;
    const int dkey = 8 * wid + (lane >> 3);
    const h16* ksrc = projb + (size_t)dkey * NIN + C_MK + hh * 64 + (((lane & 7) ^ ((dkey >> 1) & 7)) << 3);
    const h16* vsrc = projb + (size_t)(16 * (wid & 3) + (lane >> 2)) * NIN + C_MV + hh * 64 + (wid >> 2) * 32 + (lane & 3) * 8;
    const unsigned kdst = lds0 + wid * 1024, vdst = lds0 + 8192 + (wid >> 2) * 4096 + (wid & 3) * 1024;
#define MOBA_DMA(tile) do { const int kp_ = j * 256 + 192 - 64 * (tile); const unsigned so_ = (unsigned)(((tile) & 7) * 16384); \
        glds16(ksrc + (size_t)kp_ * NIN, (unsigned)__builtin_amdgcn_readfirstlane(kdst + so_)); glds16(vsrc + (size_t)kp_ * NIN, (unsigned)__builtin_amdgcn_readfirstlane(vdst + so_)); } while (0)
#define MOBA_WAIT_BAR(N) asm volatile("s_waitcnt vmcnt(" #N ") lgkmcnt(0)\n\ts_barrier" ::: "memory")
    MOBA_WAIT_BAR(0);
    MOBA_DMA(0); MOBA_DMA(1); MOBA_DMA(2);
    unsigned selmask = 0u;
    if (j <= 3) selmask = (1u << j) - 1u;
    else {
        const float* km = (const float*)(p.ws + WS_KMEAN) + ((size_t)(b * 8 + hh) * 16 + (r & 15)) * 64 + 8 * hi;
        f32x16 g;
#pragma unroll
        for (int i = 0; i < 16; ++i) g[i] = 0.f;
#pragma unroll
        for (int s = 0; s < 4; ++s) {
            f32x4 a0 = (f32x4){0.f, 0.f, 0.f, 0.f}, a1 = a0;
            if (r < j) { a0 = *(const f32x4*)(km + 16 * s) + *(const f32x4*)(km + 65536 + 16 * s); a1 = *(const f32x4*)(km + 16 * s + 4) + *(const f32x4*)(km + 65536 + 16 * s + 4); }
            h16x8 ah, al;
#pragma unroll
            for (int k = 0; k < 4; ++k) { const h16 h0 = (h16)a0[k], h1 = (h16)a1[k]; ah[k] = h0; ah[4 + k] = h1; al[k] = (h16)(a0[k] - (float)h0); al[4 + k] = (h16)(a1[k] - (float)h1); }
            g = __builtin_amdgcn_mfma_f32_32x32x16_f16(ah, qf[s], g, 0, 0, 0);
            g = __builtin_amdgcn_mfma_f32_32x32x16_f16(al, qf[s], g, 0, 0, 0);
        }
        float gate[16];
#pragma unroll
        for (int i = 0; i < 8; ++i) { auto rr = __builtin_amdgcn_permlane32_swap(__float_as_uint(g[i]), __float_as_uint(g[i]), false, false);
            gate[(i & 3) + 8 * (i >> 2)] = __uint_as_float(rr[0]); gate[(i & 3) + 8 * (i >> 2) + 4] = __uint_as_float(rr[1]); }
        float g0 = -3.0e38f, g1 = -3.0e38f, g2 = -3.0e38f; int i0 = 0, i1 = 0, i2 = 0;
#pragma unroll
        for (int n = 0; n < 15; ++n) { const float s = (n < j) ? gate[n] : -3.0e38f;
            if (s > g0) { g2 = g1; i2 = i1; g1 = g0; i1 = i0; g0 = s; i0 = n; }
            else if (s > g1) { g2 = g1; i2 = i1; g1 = s; i1 = n; }
            else if (s > g2) { g2 = s; i2 = n; } }
        selmask = (1u << i0) | (1u << i1) | (1u << i2);
    }
    constexpr float C2 = 0.125f * 1.4426950408889634f;
    float qn2 = 0.f;
#pragma unroll
    for (int s = 0; s < 4; ++s)
#pragma unroll
        for (int k = 0; k < 8; ++k) { qf[s][k] = (h16)((float)qf[s][k] * C2); qn2 += (float)qf[s][k] * (float)qf[s][k]; }
    const unsigned* kmh = (const unsigned*)(p.ws + WS_CTL + 20480) + layer * 128 + (b * 8 + hh) * 2;
    const float qbound = sqrtf(xhalf_sum(qn2)) * sqrtf(__uint_as_float(__hip_atomic_load(kmh, __ATOMIC_RELAXED, __HIP_MEMORY_SCOPE_AGENT)) + __uint_as_float(__hip_atomic_load(kmh + 1, __ATOMIC_RELAXED, __HIP_MEMORY_SCOPE_AGENT))) * 1.002f;
    const float slope2 = exp2f(-(float)(hh + 1)) * 1.4426950408889634f;
    float kb[16];
#pragma unroll
    for (int i = 0; i < 16; ++i) kb[i] = slope2 * (float)CROW0(i);
    f32x16 o0, o1;
#pragma unroll
    for (int i = 0; i < 16; ++i) { o0[i] = 0.f; o1[i] = 0.f; }
    float mref = 0.f, lsum = 0.f; bool first = true;
    const int rK = r * 128, rsw = (r >> 1) & 7;
    const int rV = 8192 + (4 * hi + ((lane & 15) >> 2)) * 64 + ((lane >> 4) & 1) * 32 + (lane & 3) * 8;
    const int nt = 4 * (j + 1);
    const int wdiag = wid >> 1;
#define MOBA_CIN(T, C0, C1) do { const int kp_ = j * 256 + 192 - 64 * (T); const int nb_ = kp_ >> 8, tl_ = (kp_ >> 6) & 3; const bool own_ = (nb_ == j); \
        const bool val_ = own_ ? true : (((selmask >> (nb_ & 31)) & 1u) != 0u); \
        const float tbh_ = val_ ? (slope2 * (float)(kp_ - qrow + 4 * hi) - mref) : -INFINITY; \
        const float tbh32_ = val_ ? (tbh_ + 32.0f * slope2) : -INFINITY; \
        _Pragma("unroll") for (int i = 0; i < 16; ++i) { C0[i] = fadd_s(kb[i], tbh_); C1[i] = fadd_s(kb[i], tbh32_); } \
        asm volatile("s_nop 1" : "+v"(C0), "+v"(C1));        \
        if (own_ && tl_ >= wdiag) { const int lim2_ = 32 * wid - 64 * tl_ + r - 4 * hi; \
            _Pragma("unroll") for (int i = 0; i < 16; ++i) { if (CROW0(i) > lim2_) C0[i] = -INFINITY; if (CROW0(i) + 32 > lim2_) C1[i] = -INFINITY; } } } while (0)
#define MOBA_QK(T, C0, C1) do { const LAS unsigned char* kb_ = lds + ((T) & 7) * 16384 + rK; \
        _Pragma("unroll") for (int s = 0; s < 4; ++s) { \
            const h16x8 k0_ = *(const LAS h16x8*)(kb_ + (((2 * s + hi) ^ rsw) << 4)), k1_ = *(const LAS h16x8*)(kb_ + 4096 + (((2 * s + hi) ^ rsw) << 4)); \
            C0 = __builtin_amdgcn_mfma_f32_32x32x16_f16(k0_, qf[s], C0, 0, 0, 0); C1 = __builtin_amdgcn_mfma_f32_32x32x16_f16(k1_, qf[s], C1, 0, 0, 0); } } while (0)
#define MOBA_DECIDE(T, C0, C1) do { float m_ = __builtin_fmaxf(C0[0], C1[0]); \
        _Pragma("unroll") for (int i = 1; i < 16; ++i) m_ = __builtin_fmaxf(__builtin_fmaxf(m_, C0[i]), C1[i]); \
        m_ = xhalf_max(m_); \
        const int kp_ = j * 256 + 192 - 64 * (T); const bool fst_ = ((kp_ >> 8) == j) && (((kp_ >> 6) & 3) == wdiag); \
        if (fst_ || __any(m_ > MOBA_THR)) { const float dl_ = fst_ ? m_ : __builtin_fmaxf(m_, 0.f); const float f_ = fst_ ? 1.0f : __builtin_amdgcn_exp2f(-dl_); mref += dl_; lsum *= f_; \
            _Pragma("unroll") for (int i = 0; i < 16; ++i) { C0[i] -= dl_; C1[i] -= dl_; o0[i] *= f_; o1[i] *= f_; } } } while (0)
#define MOBA_STEP(T, TE, P0, P1, N0, N1) do { \
        MOBA_CIN((T) + 1, N0, N1); MOBA_QK((T) + 1, N0, N1); \
        float pa_ = 0.f, pb_ = 0.f, pc_ = 0.f, pd_ = 0.f; \
        _Pragma("unroll") for (int i = 0; i < 16; ++i) { P0[i] = __builtin_amdgcn_exp2f(P0[i]); P1[i] = __builtin_amdgcn_exp2f(P1[i]); } \
        _Pragma("unroll") for (int i = 0; i < 16; i += 2) { pa_ = fadd_s(pa_, P0[i]); pb_ = fadd_s(pb_, P1[i]); pc_ = fadd_s(pc_, P0[i + 1]); pd_ = fadd_s(pd_, P1[i + 1]); } \
        lsum += fadd_s(fadd_s(pa_, pb_), fadd_s(pc_, pd_)); \
        h16x8 pf_[4]; \
        _Pragma("unroll") for (int k = 0; k < 8; ++k) { pf_[0][k] = (h16)P0[k]; pf_[1][k] = (h16)P0[8 + k]; pf_[2][k] = (h16)P1[k]; pf_[3][k] = (h16)P1[8 + k]; } \
        { const LAS unsigned char* vb_ = lds + ((T) & 7) * 16384 + rV; \
          _Pragma("unroll") for (int t = 0; t < 4; ++t) { const h16x8 v0_ = tr_frag(vb_ + t * 1024), v1_ = tr_frag(vb_ + 4096 + t * 1024); \
            o0 = __builtin_amdgcn_mfma_f32_32x32x16_f16(v0_, pf_[t], o0, 0, 0, 0); o1 = __builtin_amdgcn_mfma_f32_32x32x16_f16(v1_, pf_[t], o1, 0, 0, 0); } } \
        if ((T) + 1 < (TE)) MOBA_DECIDE((T) + 1, N0, N1); } while (0)
    f32x16 cA0, cA1, cB0, cB1;
    int te = nt;
    LAS float* xs = (LAS float*)(lds + 131072);
    MOBA_WAIT_BAR(0);
    MOBA_DMA(3); if (4 < te) MOBA_DMA(4);
    MOBA_CIN(0, cA0, cA1); MOBA_QK(0, cA0, cA1); MOBA_DECIDE(0, cA0, cA1);
#pragma unroll 1
    for (int tt = 0; tt < te; tt += 2) {
        MOBA_STEP(tt, te, cA0, cA1, cB0, cB1);
        if (tt == 2 && j > 0) { float marg = qbound - mref;
#pragma unroll
            for (int o = 1; o < 64; o <<= 1) marg = fmaxf(marg, __shfl_xor(marg, o));
            if (lane == 0) xs[wid] = marg; }
        MOBA_STEP(tt + 1, te, cB0, cB1, cA0, cA1);
        MOBA_WAIT_BAR(0);
        if (tt == 2 && j > 0) { float M = xs[0];
#pragma unroll
            for (int k = 1; k < 8; ++k) M = fmaxf(M, xs[k]);
            const float num = M + 40.0f - slope2;
            int cnt = (num >= 0.f) ? ((int)(num / (64.0f * slope2)) + 1) : 0;
            cnt = max(min(cnt, 4 * j), 2); cnt = (cnt + 1) & ~1;
            te = 4 + __builtin_amdgcn_readfirstlane(cnt); }
        if (tt + 5 < te) MOBA_DMA(tt + 5);
        if (tt + 6 < te) MOBA_DMA(tt + 6);
    }
    MOBA_WAIT_BAR(0);
#undef MOBA_RUN
#undef MOBA_CIN
#undef MOBA_QK
#undef MOBA_DECIDE
#undef MOBA_STEP
#undef MOBA_DMA
#undef MOBA_WAIT_BAR
    {
        const float inv = 1.0f / xhalf_sum(lsum);
        const h16* gp = projb + (size_t)qrow * NIN + C_MGATE + hh * 64 + 4 * hi; h16* dst = mix + ((size_t)b * SEQ + qrow) * DM + 512 + hh * 64 + 4 * hi;
#pragma unroll
        for (int g = 0; g < 4; ++g) {
            const h16x4 ga = *(const h16x4*)(gp + 8 * g), gb = *(const h16x4*)(gp + 32 + 8 * g); h16x4 oa, ob;
#pragma unroll
            for (int k = 0; k < 4; ++k) { oa[k] = (h16)(o0[4 * g + k] * inv * silu_f((float)ga[k])); ob[k] = (h16)(o1[4 * g + k] * inv * silu_f((float)gb[k])); }
            *(h16x4*)(dst + 8 * g) = oa; *(h16x4*)(dst + 32 + 8 * g) = ob;
        }
    }
}

__device__ __forceinline__ void ret_scan_shares(const Params& p, int layer) {
    const float* kv = (const float*)(p.ws + WS_KV); h16* rst = (h16*)(p.ws + WS_RST);
    const int tid = threadIdx.x; unsigned done = 0u;
#pragma unroll 1
    for (int s = blockIdx.x; s < 256; s += gridDim.x) {
        const int bh = s >> 3, e = (s & 7) * 512 + tid, hh = bh & 3;
        const float gam = 1.0f - exp2f(-5.0f - (float)hh); const float g = expf(logf(gam) * 128.0f);
        const float* kvb = kv + (size_t)bh * 32 * 4096 + e; h16* rb = rst + (size_t)bh * 32 * 4096 + e;
        float r = 0.f; rb[0] = (h16)0.f;
        float kvv[31];
#pragma unroll
        for (int m = 0; m < 31; ++m) kvv[m] = kvb[(size_t)m * 4096];
#pragma unroll
        for (int m = 0; m < 31; ++m) { r = r * g + kvv[m]; rb[(size_t)(m + 1) * 4096] = (h16)(r * gam); }
        ++done;
    }
    asm volatile("s_waitcnt vmcnt(0)" ::: "memory");
    __syncthreads();
    if (tid == 0) { __builtin_amdgcn_fence(__ATOMIC_RELEASE, "agent"); asm volatile("s_waitcnt vmcnt(0)" ::: "memory");
        __hip_atomic_fetch_add((unsigned*)(p.ws + WS_CTL + 16384) + 64 * layer, done, __ATOMIC_RELAXED, __HIP_MEMORY_SCOPE_AGENT); }
}
__device__ __forceinline__ void ret_scan_wait(const Params& p, int layer) {
    if (threadIdx.x == 0) {
        unsigned* c = (unsigned*)(p.ws + WS_CTL + 16384) + 64 * layer; unsigned sp = 0u;
        while (__hip_atomic_load(c, __ATOMIC_RELAXED, __HIP_MEMORY_SCOPE_AGENT) < 256u) { __builtin_amdgcn_s_sleep(2); if (++sp > (1u << 22)) break; }
        __builtin_amdgcn_fence(__ATOMIC_ACQUIRE, "agent"); asm volatile("s_waitcnt vmcnt(0)" ::: "memory");
    }
    __syncthreads();
}

__device__ __forceinline__ void publish_count(unsigned* c, unsigned n) {
    asm volatile("s_waitcnt vmcnt(0)" ::: "memory");
    __syncthreads();
    if (threadIdx.x == 0) { __builtin_amdgcn_fence(__ATOMIC_RELEASE, "agent"); asm volatile("s_waitcnt vmcnt(0)" ::: "memory"); __hip_atomic_fetch_add(c, n, __ATOMIC_RELAXED, __HIP_MEMORY_SCOPE_AGENT); }
}
__device__ __forceinline__ void wait_count(unsigned* c, unsigned want) {
    if (threadIdx.x == 0) { unsigned sp = 0u;
        while (__hip_atomic_load(c, __ATOMIC_RELAXED, __HIP_MEMORY_SCOPE_AGENT) < want) { __builtin_amdgcn_s_sleep(2); if (++sp > (1u << 22)) break; }
        __builtin_amdgcn_fence(__ATOMIC_ACQUIRE, "agent"); asm volatile("s_waitcnt vmcnt(0)" ::: "memory"); }
    __syncthreads();
}
__device__ __forceinline__ int queue_pop(unsigned* counter, LAS unsigned* slot) {
    __syncthreads();
    if (threadIdx.x == 0) slot[0] = __hip_atomic_fetch_add(counter, 1u, __ATOMIC_RELAXED, __HIP_MEMORY_SCOPE_AGENT);
    __syncthreads();
    return (int)slot[0];
}
__device__ __forceinline__ void phase_mixers(const Params& p, int layer, unsigned char* lds) {
    static constexpr unsigned char MOBA_ORDER[128] = {111,127,110,126,109,125,93,94,95,92,108,124,91,107,123,90,106,122,89,105,121,88,104,120,87,103,119,71,72,73,74,75,76,77,78,79,70,86,102,118,69,85,101,117,68,84,100,116,52,53,54,55,56,57,58,59,60,61,62,63,51,67,83,99,115,50,66,82,98,114,34,35,36,37,38,39,40,41,42,43,44,45,46,47,17,18,19,20,21,22,23,24,25,26,27,28,29,30,31,33,49,65,81,97,113,1,2,3,4,5,6,7,8,9,10,11,12,13,14,15,0,16,32,48,64,80,96,112};
    unsigned* qc = (unsigned*)(p.ws + WS_CTL + 24576) + layer * 256;
    LAS unsigned* slot = (LAS unsigned*)((LAS unsigned char*)lds + BAR_LDS_OFF + 16);
    phase_stats(p, layer, lds);
    publish_count((unsigned*)(p.ws + WS_CTL + 16384) + 64 * (2 + layer), 1u);
#define QUEUE_LOOP(CNT, N, BODY) do { int cur = queue_pop(CNT, slot); \
        _Pragma("unroll 1") while (cur < (N)) { unsigned nxt_ = 0u; if (threadIdx.x == 0) nxt_ = __hip_atomic_fetch_add(CNT, 1u, __ATOMIC_RELAXED, __HIP_MEMORY_SCOPE_AGENT); \
            { BODY; } \
            __syncthreads(); if (threadIdx.x == 0) slot[0] = nxt_; __syncthreads(); cur = (int)slot[0]; } } while (0)
    QUEUE_LOOP(qc + 128, 512, conv_unit(p, layer, cur >> 6, cur & 63, lds));
    wait_count((unsigned*)(p.ws + WS_CTL + 16384) + 64 * (2 + layer), gridDim.x);
    ret_scan_shares(p, layer);
    QUEUE_LOOP(qc, 1024, const int hj = MOBA_ORDER[cur >> 3]; moba_unit(p, layer, cur & 7, hj >> 4, hj & 15, lds));
    ret_scan_wait(p, layer);
    QUEUE_LOOP(qc + 64, 1024, ret_unit(p, cur >> 7, (cur >> 5) & 3, cur & 31, lds));
#undef QUEUE_LOOP
}

__device__ __forceinline__ void phase_final(const Params& p) {
    const float* rowss = (const float*)(p.ws + WS_ROWSS); const h16* xh = (const h16*)(p.ws + WS_XH);
    const int lane = threadIdx.x & 63, wid = threadIdx.x >> 6;
    f32x4 g[4];
#pragma unroll
    for (int j = 0; j < 4; ++j) g[j] = *((const f32x4*)p.final_g + lane + 64 * j);
    for (int row = blockIdx.x * 8 + wid; row < MROWS; row += gridDim.x * 8) {
        const f32x4* rs = (const f32x4*)(rowss + (size_t)row * NPART); const f32x4 s0 = rs[0], s1 = rs[1], s2 = rs[2], s3 = rs[3];
        const float tot = ((s0[0] + s0[1]) + (s0[2] + s0[3])) + ((s1[0] + s1[1]) + (s1[2] + s1[3])) + ((s2[0] + s2[1]) + (s2[2] + s2[3])) + ((s3[0] + s3[1]) + (s3[2] + s3[3]));
        const float rstd = rsqrtf(tot * (1.0f / DM) + 1e-6f);
        const h16x4* xr = (const h16x4*)(xh + (size_t)row * DM) + lane; f32x4* orow = (f32x4*)(p.out + (size_t)row * DM) + lane;
#pragma unroll
        for (int j = 0; j < 4; ++j) { const h16x4 v = xr[64 * j]; orow[64 * j] = (f32x4){(float)v[0], (float)v[1], (float)v[2], (float)v[3]} * rstd * g[j]; }
    }
}

#define XB_TMO      128
#define XB_XCNT(j)  (256  + 64 * (j))
#define XB_XSUB(j)  (1280 + 64 * (j))
#define XB_XGEN(j)  (2304 + 64 * (j))
#define XB_TOP      3328
#define XB_TOPGEN   3392
#define XCD_BAR_WORDS 3456
#define XB_SPIN_CAP (1u << 18)

__device__ __forceinline__ unsigned xb_ld(unsigned* p)              { return __hip_atomic_load(p, __ATOMIC_RELAXED, __HIP_MEMORY_SCOPE_AGENT); }
__device__ __forceinline__ unsigned xb_add(unsigned* p, unsigned v) { return __hip_atomic_fetch_add(p, v, __ATOMIC_RELAXED, __HIP_MEMORY_SCOPE_AGENT); }
__device__ __forceinline__ unsigned xb_xcc_id() { return (unsigned)__builtin_amdgcn_s_getreg((3 << 11) | 20) & 0xFu; }
#define XB_SPIN(cond, bar) do { unsigned _sp = 0; while (cond) { __builtin_amdgcn_s_sleep(1); \
    if ((++_sp & 255u) == 0u) { if (xb_ld(&(bar)[XB_TMO])) break; if (_sp > XB_SPIN_CAP) { atomicAdd(&(bar)[XB_TMO], 1u); break; } } } } while (0)

struct XcdBarrier {
    unsigned* bar; unsigned x;
    volatile LAS unsigned* st;
};

__device__ __forceinline__ XcdBarrier xcd_barrier_post(unsigned* bar, volatile LAS unsigned* st) {
    XcdBarrier b; b.bar = bar; b.x = xb_xcc_id(); b.st = st;
    if (threadIdx.x == 0) (void)xb_add(&bar[XB_XCNT(b.x)], 1u);
    return b;
}
__device__ __forceinline__ void xcd_barrier_complete(unsigned* bar, unsigned x, unsigned& nloc, unsigned& nx) {
    const unsigned G = gridDim.x * gridDim.y * gridDim.z;
    unsigned sum, cnt, mine, sp = 0u;
    for (;;) {
        sum = 0u; cnt = 0u; mine = 0u;
#pragma unroll
        for (unsigned j = 0; j < 16; ++j) { const unsigned c = xb_ld(&bar[XB_XCNT(j)]); sum += c; cnt += (c > 0u) ? 1u : 0u; mine = (j == x) ? c : mine; }
        if (sum == G) break;
        __builtin_amdgcn_s_sleep(1);
        if ((++sp & 255u) == 0u) { if (xb_ld(&bar[XB_TMO])) break; if (sp > XB_SPIN_CAP) { atomicAdd(&bar[XB_TMO], 1u); break; } }
    }
    nloc = mine > 0u ? mine : 1u; nx = cnt > 0u ? cnt : 1u;
}

__device__ __forceinline__ void xcd_barrier(const XcdBarrier& b) {
    asm volatile("s_waitcnt vmcnt(0)" ::: "memory");
    __syncthreads();
    if (threadIdx.x == 0) {
        unsigned* bar = b.bar;
        __builtin_amdgcn_s_waitcnt(0);
        unsigned nloc = b.st[0], nx = b.st[1];
        if (nloc == 0u) { xcd_barrier_complete(bar, b.x, nloc, nx); b.st[0] = nloc; b.st[1] = nx; }
        const unsigned old = xb_add(&bar[XB_XSUB(b.x)], 1u);
        const unsigned gen = old / nloc;
        if (old + 1u == (gen + 1u) * nloc) {
            __builtin_amdgcn_fence(__ATOMIC_RELEASE, "agent");
            asm volatile("s_waitcnt vmcnt(0)" ::: "memory");
            const unsigned og = xb_add(&bar[XB_TOP], 1u);
            const unsigned tg = og / nx;
            if (og + 1u == (tg + 1u) * nx) xb_add(&bar[XB_TOPGEN], 1u);
            else XB_SPIN(xb_ld(&bar[XB_TOPGEN]) == tg, bar);
            __builtin_amdgcn_fence(__ATOMIC_ACQUIRE, "agent");
            xb_add(&bar[XB_XGEN(b.x)], 1u);
            asm volatile("s_waitcnt vmcnt(0)" ::: "memory");
        } else {
            XB_SPIN(xb_ld(&bar[XB_XGEN(b.x)]) == gen, bar);
            __builtin_amdgcn_fence(__ATOMIC_ACQUIRE, "agent");
            asm volatile("s_waitcnt vmcnt(0)" ::: "memory");
        }
    }
    __syncthreads();
}


__global__ void __launch_bounds__(NTHREADS) hymba_fwd(Params p) {
    extern __shared__ __attribute__((aligned(16))) unsigned char lds[];
    cg::grid_group grid = cg::this_grid();
    volatile LAS unsigned* bst = (volatile LAS unsigned*)((LAS unsigned char*)lds + BAR_LDS_OFF);
    if (threadIdx.x < 2) bst[threadIdx.x] = 0u;
    __syncthreads();
    XcdBarrier xbar = xcd_barrier_post((unsigned*)(p.ws + WS_CTL), bst);
#define RUN_PHASE(k, body) do { if (p.ph_lo <= (k) && (k) < p.ph_hi) { body; if ((k) + 1 < p.ph_hi) { xcd_barrier(xbar); } } } while (0)
    RUN_PHASE(0, phase_prologue(p, lds));
    RUN_PHASE(1, gemm_in(p, 0, lds));
    RUN_PHASE(2, phase_mixers(p, 0, lds));
    RUN_PHASE(3, gemm_out<0>(p, lds));
    RUN_PHASE(4, gemm_in(p, 1, lds));
    RUN_PHASE(5, phase_mixers(p, 1, lds));
    RUN_PHASE(6, gemm_out<1>(p, lds));
    RUN_PHASE(7, phase_final(p));
#undef RUN_PHASE
}

extern "C" void kernel_launch(void* const* d_in, const int* in_sizes, int n_in, void* d_out, int out_size, void* d_ws, size_t ws_size, hipStream_t stream) {
    static int grid_blocks = 0;
    if (!grid_blocks) {
        int dev = 0, cus = 0, per_cu = 0;
        hipGetDevice(&dev);
        hipDeviceGetAttribute(&cus, hipDeviceAttributeMultiprocessorCount, dev);
        hipFuncSetAttribute((const void*)hymba_fwd, hipFuncAttributeMaxDynamicSharedMemorySize, LDS_BYTES);
        hipOccupancyMaxActiveBlocksPerMultiprocessor(&per_cu, (const void*)hymba_fwd, NTHREADS, LDS_BYTES);
        if (per_cu < 1) per_cu = 1;
        grid_blocks = cus * per_cu;
        if (ws_size < WS_END) fprintf(stderr, "kernel_launch: workspace too small (%zu < %zu)\n", ws_size, (size_t)WS_END);
    }
    Params p{};
    p.x = (const float*)d_in[0]; p.norm_g = (const float*)d_in[1]; p.w_in = (const float*)d_in[2]; p.conv_w = (const float*)d_in[3]; p.conv_b = (const float*)d_in[4];
    p.ln_g = (const float*)d_in[5]; p.ln_b = (const float*)d_in[6]; p.pw_w = (const float*)d_in[7]; p.pw_b = (const float*)d_in[8]; p.w_out = (const float*)d_in[9];
    p.final_g = (const float*)d_in[10]; p.out = (float*)d_out; p.ws = (unsigned char*)d_ws;
    (void)hipMemsetAsync((char*)d_ws + WS_CTL, 0, 32768, stream);
#if ONE_LAUNCH
    p.ph_lo = 0; p.ph_hi = NPHASES;
    { void* args[] = {&p};
      hipError_t e = hipLaunchCooperativeKernel((const void*)hymba_fwd, dim3(grid_blocks), dim3(NTHREADS), args, LDS_BYTES, stream);
      if (e != hipSuccess) fprintf(stderr, "cooperative launch failed: %s (grid %d)\n", hipGetErrorString(e), grid_blocks); }
#else
    for (int ph = 0; ph < NPHASES; ++ph) {
        p.ph_lo = ph; p.ph_hi = ph + 1; void* args[] = {&p};
        hipError_t e = hipLaunchCooperativeKernel((const void*)hymba_fwd, dim3(grid_blocks), dim3(NTHREADS), args, LDS_BYTES, stream);
        if (e != hipSuccess) { fprintf(stderr, "cooperative launch failed: %s (grid %d, phase %d)\n", hipGetErrorString(e), grid_blocks, ph); break; }
    }
#endif
}
```

```cpp
#include <hip/hip_runtime.h>
#include <hip/hip_cooperative_groups.h>
#include <cstdio>
#include <cstdint>
namespace cg = cooperative_groups;

#ifndef ONE_LAUNCH
#define ONE_LAUNCH 1
#endif

typedef _Float16 h16;
typedef _Float16 h16x8 __attribute__((ext_vector_type(8)));
typedef _Float16 h16x4 __attribute__((ext_vector_type(4)));
typedef __bf16 b16x8 __attribute__((ext_vector_type(8)));
typedef float f32x16 __attribute__((ext_vector_type(16)));
typedef float f32x4 __attribute__((ext_vector_type(4)));
typedef unsigned u32x4 __attribute__((ext_vector_type(4)));

constexpr int BATCH = 8, SEQ = 4096, DM = 1024, MROWS = BATCH * SEQ, NIN = 3840, DEPTH = 2;
constexpr int C_AVAL = 0, C_AGLU = 256, C_AGATE = 512, C_RQ = 768, C_RK = 1024, C_RV = 1280, C_RGATE = 1536, C_MQ = 1792, C_MK = 2304, C_MV = 2816, C_MGATE = 3328;
constexpr int NPART = 16;
constexpr int NTHREADS = 512;
constexpr int LDS_BYTES = 147456;
constexpr int NPHASES = 8;

constexpr size_t MiB = 1u << 20;
constexpr size_t WS_XH = 0, WS_PROJ = 64 * MiB, WS_MIX = 304 * MiB, WS_WIN = 368 * MiB, WS_WOUT = 383 * MiB, WS_WPW = 387 * MiB,
                 WS_KV = 388 * MiB, WS_KMEAN = 404 * MiB  , WS_ROWSS = 405 * MiB, WS_CTL = 408 * MiB  , WS_RST = 409 * MiB  , WS_END = 417 * MiB;
constexpr int BAR_LDS_OFF = LDS_BYTES - 64;

struct Params {
    const float *x, *norm_g, *w_in, *conv_w, *conv_b, *ln_g, *ln_b, *pw_w, *pw_b, *w_out, *final_g;
    float* out; unsigned char* ws;
    int ph_lo, ph_hi;
};

__device__ __forceinline__ float silu_f(float v) { return v * __builtin_amdgcn_rcpf(1.0f + __expf(-v)); }
__device__ __forceinline__ int crow(int r, int h) { return (r & 3) + 8 * (r >> 2) + 4 * h; }
__device__ __forceinline__ float wave_sum(float v) {
#pragma unroll
    for (int o = 1; o < 64; o <<= 1) v += __shfl_xor(v, o);
    return v;
}

__device__ __forceinline__ void transpose_unit(const float* W, int K, int N, h16* WT, const float* g, int k0, int n0, float* tile) {
    const int tid = threadIdx.x;
    __syncthreads();
#pragma unroll
    for (int i = 0; i < 8; ++i) { const int k = i * 8 + (tid >> 6), n = tid & 63; float v = W[(size_t)(k0 + k) * N + n0 + n]; if (g) v *= g[k0 + k]; tile[k * 65 + n] = v; }
    __syncthreads();
    { const int n = tid >> 3, kc = tid & 7; h16x8 w;
#pragma unroll
        for (int i = 0; i < 8; ++i) w[i] = (h16)tile[(kc * 8 + i) * 65 + n];
        *(h16x8*)(WT + (size_t)(n0 + n) * K + k0 + kc * 8) = w; }
}

__device__ __forceinline__ void phase_prologue(const Params& p, unsigned char* lds) {
    float* tile = (float*)lds;
    h16* win = (h16*)(p.ws + WS_WIN);
    constexpr int U_IN = 16 * 60;
    for (int r = blockIdx.x; r < U_IN; r += gridDim.x)
        transpose_unit(p.w_in, DM, NIN, win, p.norm_g, (r / 60) * 64, (r % 60) * 64, tile);
    h16* xh = (h16*)(p.ws + WS_XH); float* rowss = (float*)(p.ws + WS_ROWSS);
    const int lane = threadIdx.x & 63, wid = threadIdx.x >> 6;
    for (int row = blockIdx.x * 8 + wid; row < MROWS; row += gridDim.x * 8) {
        const f32x4* xr = (const f32x4*)(p.x + (size_t)row * DM) + lane;
        float ss = 0.f;
#pragma unroll
        for (int j = 0; j < 4; ++j) { const f32x4 v = xr[64 * j]; ss += v.x * v.x + v.y * v.y + v.z * v.z + v.w * v.w;
            h16x4 o; o.x = (h16)v.x; o.y = (h16)v.y; o.z = (h16)v.z; o.w = (h16)v.w; *((h16x4*)(xh + (size_t)row * DM) + lane + 64 * j) = o; }
        ss = wave_sum(ss);
        if (lane < NPART) rowss[(size_t)row * NPART + lane] = (lane == 0) ? ss : 0.f;
    }
}

typedef short s16x4 __attribute__((ext_vector_type(4)));
#define LAS __attribute__((address_space(3)))
__device__ __forceinline__ float xhalf_max(float v) { auto rr = __builtin_amdgcn_permlane32_swap(__float_as_uint(v), __float_as_uint(v), false, false); return fmaxf(__uint_as_float(rr[0]), __uint_as_float(rr[1])); }
__device__ __forceinline__ float xhalf_sum(float v) { auto rr = __builtin_amdgcn_permlane32_swap(__float_as_uint(v), __float_as_uint(v), false, false); return __uint_as_float(rr[0]) + __uint_as_float(rr[1]); }
__device__ __forceinline__ h16x8 tr_frag(const LAS unsigned char* a) {
    const s16x4 lo = __builtin_amdgcn_ds_read_tr16_b64_v4i16((LAS s16x4*)a), hi = __builtin_amdgcn_ds_read_tr16_b64_v4i16((LAS s16x4*)(a + 512));
    typedef short s16x8 __attribute__((ext_vector_type(8)));
    const s16x8 v = __builtin_shufflevector(lo, hi, 0, 1, 2, 3, 4, 5, 6, 7);
    return __builtin_bit_cast(h16x8, v);
}
#define CROW0(i) (((i) & 3) + 8 * ((i) >> 2))
__device__ __forceinline__ float fadd_s(float a, float b) { float r; asm("v_add_f32_e32 %0, %1, %2" : "=v"(r) : "v"(a), "v"(b)); return r; }
__device__ __forceinline__ void glds16(const void* gsrc, unsigned lds_dst) { unsigned keep;
    asm volatile("s_mov_b32 %0, m0\n\ts_mov_b32 m0, %2\n\ts_nop 0\n\tglobal_load_lds_dwordx4 %1, off\n\ts_mov_b32 m0, %0" : "=&s"(keep) : "v"(gsrc), "s"(lds_dst) : "memory"); }

__device__ __forceinline__ unsigned cvt_pk_bf16(float lo, float hi) { unsigned r; asm("v_cvt_pk_bf16_f32 %0, %1, %2" : "=v"(r) : "v"(lo), "v"(hi)); return r; }
namespace pg8 {
#define PG8_LAS __attribute__((address_space(3)))
typedef _Float16 bf16_t;
typedef _Float16 bf16x8 __attribute__((ext_vector_type(8)));
typedef float f32x4 __attribute__((ext_vector_type(4)));
typedef unsigned u32x4 __attribute__((ext_vector_type(4)));
constexpr int BM = 256, BK = 64, HALF = 128, HTB = HALF * BK * 2  , STAGE_BYTES = 8 * HTB, NXCD = 8, WGM = 8;

__host__ __device__ __forceinline__ int lds_byte(int r, int c) { const int st = (r >> 4) * 2 + (c >> 5), rr = r & 15, cc = c & 31, ob = rr * 64 + cc * 2; return st * 1024 + (ob ^ (((ob >> 9) & 1) << 5)); }
__host__ __device__ __forceinline__ void stage_rc(int b, int& R, int& C) { const int st = b / 1024, sb = b % 1024, swz = sb ^ (((sb >> 9) & 1) << 5); R = (st >> 1) * 16 + swz / 64; C = (st & 1) * 32 + (swz % 64) / 2; }
__host__ __device__ __forceinline__ int perm32(int rho) { const int n = rho >> 4, i = rho & 15; return 8 * (i >> 2) + 4 * n + (i & 3); }

struct Unit { int pm, pn; };
struct Gemm { const bf16_t* A; const bf16_t* Bt; int M, N, K; };

struct StaticOrder {
    int nM, nN, nwg, G, c;
    __host__ __device__ void init(int M, int N, int G_, int c_) { nM = M / BM; nN = N / BM; nwg = nM * nN; G = G_; c = c_; }
    __host__ __device__ bool next(int i, Unit& u) const {
        const long L = (long)i * G + c; if (L >= nwg) return false;
        int wgid = (int)L; { const int q = nwg / NXCD, r = nwg % NXCD, xcd = wgid % NXCD, off = wgid / NXCD; wgid = (xcd < r ? xcd * (q + 1) : r * (q + 1) + (xcd - r) * q) + off; }
        const int nig = WGM * nN, gid = wgid / nig, fm = gid * WGM, gsz = (nM - fm) < WGM ? (nM - fm) : WGM;
        u.pm = fm + ((wgid % nig) % gsz); u.pn = (wgid % nig) / gsz; return true;
    }
    __device__ __forceinline__ void a_ready(const Unit&) const {}
    __device__ __forceinline__ void done(const Unit&) const {}
};

template <class Epi, class Sched, bool ALIGN_EPI = false, bool SP2 = false>
__device__ __forceinline__ void gemm_phase(PG8_LAS unsigned char* lds, const Gemm g, const Sched& S, const Epi& E) {
    const int tid = threadIdx.x, wid = __builtin_amdgcn_readfirstlane(tid >> 6), lane = tid & 63, wr = wid >> 2, wc = wid & 3, fr = lane & 15, fq = lane >> 4;
    const int K = g.K, nt = K / BK;
    unsigned voffA[2], voffB[2];
#pragma unroll
    for (int i = 0; i < 2; ++i) { int R, C; stage_rc(tid * 16 + i * 8192, R, C); const int Rb = Epi::PERM ? ((R & ~31) + perm32(R & 31)) : R;
        voffA[i] = (unsigned)(R * K + C) * 2u; voffB[i] = (unsigned)(Rb * K + C) * 2u; }
    const size_t kstep = (size_t)(BK * 2);
    const size_t hstep = (size_t)HALF * K * 2;
    const size_t tstep = 2 * hstep;
    const unsigned ldsw = (unsigned)wid * 1024u;
    const int aoff = lds_byte(wr * 64 + fr, fq * 8), boff = lds_byte(wc * 32 + fr, fq * 8);
#define PG8_SA(b, h) (((b) * 2 + (h)) * HTB)
#define PG8_SB(b, h) ((4 + (b) * 2 + (h)) * HTB)
#define PG8_STAGE(bufoff, gbase, voff) do { _Pragma("unroll") for (int _i = 0; _i < 2; ++_i) \
        __builtin_amdgcn_global_load_lds((const unsigned*)((const char*)(gbase) + (voff)[_i]), (PG8_LAS unsigned*)(lds + (bufoff) + ldsw + _i * 8192), 16, 0, 0); } while (0)
#define PG8_LDA(dst, b, h) do { _Pragma("unroll") for (int m = 0; m < 4; ++m) _Pragma("unroll") for (int k = 0; k < 2; ++k) dst[m][k] = *(const PG8_LAS bf16x8*)(lds + PG8_SA(b, h) + aoff + m * 2048 + k * 1024); } while (0)
#define PG8_LDB(dst, b, h) do { _Pragma("unroll") for (int n = 0; n < 2; ++n) _Pragma("unroll") for (int k = 0; k < 2; ++k) dst[n][k] = *(const PG8_LAS bf16x8*)(lds + PG8_SB(b, h) + boff + n * 2048 + k * 1024); } while (0)
#define PG8_MMA(ai, bj, At, Bt) do { __builtin_amdgcn_s_setprio(1); _Pragma("unroll") for (int m = 0; m < 4; ++m) _Pragma("unroll") for (int n = 0; n < 2; ++n) _Pragma("unroll") for (int k = 0; k < 2; ++k) \
        acc[ai][bj][m][n] = __builtin_amdgcn_mfma_f32_16x16x32_f16(Bt[n][k], At[m][k], acc[ai][bj][m][n], 0, 0, 0); __builtin_amdgcn_s_setprio(0); } while (0)
#define PG8_WAIT_V(n) asm volatile("s_waitcnt vmcnt(" #n ")" ::: "memory")
#define PG8_WAIT_L(n) asm volatile("s_waitcnt lgkmcnt(" #n ")" ::: "memory")
#define PG8_BAR __builtin_amdgcn_s_barrier()
#define PG8_SCHED __builtin_amdgcn_sched_barrier(0)
    Unit cur, nxt; int ui = 0;
    if (!S.next(0, cur)) return;
    f32x4 acc[2][2][4][2];
#pragma unroll
    for (int a = 0; a < 2; ++a)
#pragma unroll
        for (int b = 0; b < 2; ++b)
#pragma unroll
            for (int m = 0; m < 4; ++m)
#pragma unroll
                for (int n = 0; n < 2; ++n) acc[a][b][m][n] = (f32x4){0.f, 0.f, 0.f, 0.f};
    bf16x8 At[4][2], B0[2][2], B1[2][2];
    const char* cA = (const char*)g.A + (size_t)cur.pm * tstep; const char* cB = (const char*)g.Bt + (size_t)cur.pn * tstep;
    S.a_ready(cur);
    if constexpr (SP2) {
        PG8_STAGE(PG8_SB(0, 0), cB, voffB); PG8_STAGE(PG8_SB(0, 1), cB + hstep, voffB); PG8_STAGE(PG8_SA(0, 0), cA, voffA); PG8_STAGE(PG8_SA(0, 1), cA + hstep, voffA);
        if (wr == 1) PG8_BAR;
        PG8_WAIT_V(2); PG8_BAR;
        PG8_STAGE(PG8_SB(1, 0), cB + kstep, voffB); PG8_STAGE(PG8_SA(1, 0), cA + kstep, voffA); PG8_STAGE(PG8_SB(1, 1), cB + hstep + kstep, voffB);
        PG8_WAIT_V(6); PG8_BAR;
    } else {
        PG8_STAGE(PG8_SB(0, 0), cB, voffB); PG8_STAGE(PG8_SA(0, 0), cA, voffA); PG8_STAGE(PG8_SB(0, 1), cB + hstep, voffB); PG8_STAGE(PG8_SA(0, 1), cA + hstep, voffA);
        if (wr == 1) PG8_BAR;
        PG8_WAIT_V(4); PG8_BAR;
        PG8_STAGE(PG8_SB(1, 0), cB + kstep, voffB); PG8_STAGE(PG8_SA(1, 0), cA + kstep, voffA); PG8_STAGE(PG8_SB(1, 1), cB + hstep + kstep, voffB);
        PG8_WAIT_V(6); PG8_BAR;
    }
    for (;;) {
        const bool has_next = S.next(ui + 1, nxt);
        const char* nA = has_next ? (const char*)g.A + (size_t)nxt.pm * tstep : cA; const char* nB = has_next ? (const char*)g.Bt + (size_t)nxt.pn * tstep : cB;
        for (int t = 0; t < nt; t += 2) {
            const bool last = (t == nt - 2);
            const char* a1 = cA + (size_t)(t + 1) * kstep;
            const char* a2 = last ? nA : cA + (size_t)(t + 2) * kstep; const char* b2 = last ? nB : cB + (size_t)(t + 2) * kstep;
            const char* a3 = a2 + kstep; const char* b3 = b2 + kstep;
            if (last && has_next) S.a_ready(nxt);
            if constexpr (SP2) {
            PG8_LDB(B0, 0, 0); PG8_LDB(B1, 0, 1); PG8_SCHED; PG8_LDA(At, 0, 0); PG8_STAGE(PG8_SA(1, 1), a1 + hstep, voffA);
            PG8_WAIT_V(8); PG8_WAIT_L(0); PG8_BAR; PG8_MMA(0, 0, At, B0); PG8_MMA(0, 1, At, B1); PG8_BAR; PG8_SCHED;
            PG8_LDA(At, 0, 1); PG8_STAGE(PG8_SB(0, 0), b2, voffB); PG8_STAGE(PG8_SB(0, 1), b2 + hstep, voffB); PG8_STAGE(PG8_SA(0, 0), a2, voffA);
            PG8_WAIT_V(8); PG8_WAIT_L(0); PG8_BAR; PG8_MMA(1, 0, At, B0); PG8_MMA(1, 1, At, B1); PG8_BAR; PG8_SCHED;
            PG8_LDB(B0, 1, 0); PG8_LDB(B1, 1, 1); PG8_SCHED; PG8_LDA(At, 1, 0); PG8_STAGE(PG8_SA(0, 1), a2 + hstep, voffA);
            PG8_WAIT_V(8); PG8_WAIT_L(0); PG8_BAR; PG8_MMA(0, 0, At, B0); PG8_MMA(0, 1, At, B1); PG8_BAR; PG8_SCHED;
            PG8_LDA(At, 1, 1); PG8_STAGE(PG8_SB(1, 0), b3, voffB); PG8_STAGE(PG8_SB(1, 1), b3 + hstep, voffB); PG8_STAGE(PG8_SA(1, 0), a3, voffA);
            PG8_WAIT_V(8); PG8_WAIT_L(0); PG8_BAR; PG8_MMA(1, 0, At, B0); PG8_MMA(1, 1, At, B1); PG8_BAR; PG8_SCHED;
            } else {
            PG8_LDB(B0, 0, 0); PG8_SCHED; PG8_LDA(At, 0, 0); PG8_STAGE(PG8_SA(1, 1), a1 + hstep, voffA);
            PG8_WAIT_L(8); PG8_BAR; PG8_WAIT_L(0); PG8_MMA(0, 0, At, B0); PG8_BAR; PG8_SCHED;
            PG8_LDB(B1, 0, 1); PG8_STAGE(PG8_SB(0, 0), b2, voffB);
            PG8_BAR; PG8_WAIT_L(0); PG8_MMA(0, 1, At, B1); PG8_BAR;
            PG8_LDA(At, 0, 1); PG8_STAGE(PG8_SA(0, 0), a2, voffA);
            PG8_BAR; PG8_WAIT_L(0); PG8_MMA(1, 0, At, B0); PG8_BAR; PG8_SCHED;
            PG8_STAGE(PG8_SB(0, 1), b2 + hstep, voffB);
            PG8_WAIT_V(6); PG8_BAR; PG8_MMA(1, 1, At, B1); PG8_BAR;
            PG8_LDB(B0, 1, 0); PG8_SCHED; PG8_LDA(At, 1, 0); PG8_STAGE(PG8_SA(0, 1), a2 + hstep, voffA);
            PG8_WAIT_L(8); PG8_BAR; PG8_WAIT_L(0); PG8_MMA(0, 0, At, B0); PG8_BAR; PG8_SCHED;
            PG8_LDB(B1, 1, 1); PG8_STAGE(PG8_SB(1, 0), b3, voffB);
            PG8_BAR; PG8_WAIT_L(0); PG8_MMA(0, 1, At, B1); PG8_BAR;
            PG8_LDA(At, 1, 1); PG8_STAGE(PG8_SA(1, 0), a3, voffA);
            PG8_BAR; PG8_WAIT_L(0); PG8_MMA(1, 0, At, B0); PG8_BAR; PG8_SCHED;
            PG8_STAGE(PG8_SB(1, 1), b3 + hstep, voffB);
            PG8_WAIT_V(6); PG8_BAR; PG8_MMA(1, 1, At, B1); PG8_BAR;
            }
        }
        if constexpr (ALIGN_EPI) { if (wr == 0) PG8_BAR; }
        if constexpr (!Epi::AFTER_DRAIN) { E(acc, cur, wr, wc, fr, fq); S.done(cur); }
        if (!has_next) break;
#pragma unroll
        for (int a = 0; a < 2; ++a)
#pragma unroll
            for (int b = 0; b < 2; ++b)
#pragma unroll
                for (int m = 0; m < 4; ++m)
#pragma unroll
                    for (int n = 0; n < 2; ++n) acc[a][b][m][n] = (f32x4){0.f, 0.f, 0.f, 0.f};
        cur = nxt; cA = nA; cB = nB; ++ui;
        if constexpr (ALIGN_EPI) { if (wr == 1) PG8_BAR; }
    }
    PG8_WAIT_V(0);
    if constexpr (!ALIGN_EPI) { if (wr == 0) PG8_BAR; }
    PG8_BAR;
    if constexpr (Epi::AFTER_DRAIN) { E.fused(acc, cur, wr, wc, fr, fq, lds, wid, lane); S.done(cur); }
#undef PG8_SA
#undef PG8_SB
#undef PG8_STAGE
#undef PG8_LDA
#undef PG8_LDB
#undef PG8_MMA
#undef PG8_WAIT_V
#undef PG8_WAIT_L
#undef PG8_BAR
#undef PG8_SCHED
}

struct EpiProj {
    static constexpr bool PERM = true, AFTER_DRAIN = false;
    bf16_t* O; const float* rowss; float* kmpart; unsigned* kmaxh;
    __device__ __forceinline__ void operator()(const f32x4 (&acc)[2][2][4][2], const Unit& u, int wr, int wc, int fr, int fq) const {
        const int row0 = u.pm * BM + wr * 64 + fr, col0 = u.pn * BM + wc * 32 + 8 * fq;
        const bool want_km = (u.pn == 9) || (u.pn == 10);
        const bool as_bf16 = (u.pn == 11) || (u.pn == 12);
        float kn[2] = {0.f, 0.f};
        f32x4 cs[2][2];
#pragma unroll
        for (int bj = 0; bj < 2; ++bj)
#pragma unroll
            for (int n = 0; n < 2; ++n) cs[bj][n] = (f32x4){0.f, 0.f, 0.f, 0.f};
#pragma unroll
        for (int ai = 0; ai < 2; ++ai)
#pragma unroll
            for (int m = 0; m < 4; ++m) { const size_t row = (size_t)(row0 + ai * HALF + m * 16);
                const f32x4* rs = (const f32x4*)(rowss + row * 16); const f32x4 s0 = rs[0], s1 = rs[1], s2 = rs[2], s3 = rs[3];
                const float tot = ((s0[0] + s0[1]) + (s0[2] + s0[3])) + ((s1[0] + s1[1]) + (s1[2] + s1[3])) + ((s2[0] + s2[1]) + (s2[2] + s2[3])) + ((s3[0] + s3[1]) + (s3[2] + s3[3]));
                const float rstd = rsqrtf(tot * (1.0f / 1024.0f) + 1e-6f);
                bf16_t* rowp = O + row * 3840 + col0;
#pragma unroll
                for (int bj = 0; bj < 2; ++bj) { const f32x4 v0 = acc[ai][bj][m][0] * rstd, v1 = acc[ai][bj][m][1] * rstd;
                    if (as_bf16) { const u32x4 wb = {cvt_pk_bf16(v0[0], v0[1]), cvt_pk_bf16(v0[2], v0[3]), cvt_pk_bf16(v1[0], v1[1]), cvt_pk_bf16(v1[2], v1[3])}; *(u32x4*)(rowp + bj * HALF) = wb; }
                    else { bf16x8 w;
                    w[0] = (bf16_t)v0[0]; w[1] = (bf16_t)v0[1]; w[2] = (bf16_t)v0[2]; w[3] = (bf16_t)v0[3]; w[4] = (bf16_t)v1[0]; w[5] = (bf16_t)v1[1]; w[6] = (bf16_t)v1[2]; w[7] = (bf16_t)v1[3];
                    *(bf16x8*)(rowp + bj * HALF) = w; }
                    cs[bj][0] += v0; cs[bj][1] += v1;
                    if (want_km) { float q = ((v0[0] * v0[0] + v0[1] * v0[1]) + (v0[2] * v0[2] + v0[3] * v0[3])) + ((v1[0] * v1[0] + v1[1] * v1[1]) + (v1[2] * v1[2] + v1[3] * v1[3]));
                        q += __shfl_xor(q, 16); q += __shfl_xor(q, 32); kn[bj] = fmaxf(kn[bj], q); } } }
        if (want_km) {
#pragma unroll
            for (int bj = 0; bj < 2; ++bj)
#pragma unroll
                for (int n = 0; n < 2; ++n)
#pragma unroll
                    for (int k = 0; k < 4; ++k) { float v = cs[bj][n][k]; v += __shfl_xor(v, 1); v += __shfl_xor(v, 2); v += __shfl_xor(v, 4); v += __shfl_xor(v, 8); cs[bj][n][k] = v * (1.0f / 256.0f); }
#pragma unroll
            for (int bj = 0; bj < 2; ++bj) { float q = kn[bj]; q = fmaxf(q, __shfl_xor(q, 1)); q = fmaxf(q, __shfl_xor(q, 2)); q = fmaxf(q, __shfl_xor(q, 4)); q = fmaxf(q, __shfl_xor(q, 8));
                if (fr == 0 && fq == 0) atomicMax(kmaxh + (((u.pm >> 4) * 8 + (u.pn - 9) * 4 + bj * 2 + (wc >> 1)) * 2 + (wc & 1)), __float_as_uint(q)); }
            if (fr == 0) {
#pragma unroll
                for (int bj = 0; bj < 2; ++bj)
#pragma unroll
                    for (int n = 0; n < 2; ++n) { const int cm = col0 + bj * HALF + 4 * n - 2304;
                        *(f32x4*)(kmpart + ((size_t)((wr * 8 + (u.pm >> 4)) * 8 + (cm >> 6)) * 16 + (u.pm & 15)) * 64 + (cm & 63)) = cs[bj][n]; }
            }
        }
    }
};
template <int LAYER> struct EpiRes {
    static constexpr bool PERM = true, AFTER_DRAIN = false;
    const float* x0; float* xout; bf16_t* xh; float* rowss;
    __device__ __forceinline__ void operator()(const f32x4 (&acc)[2][2][4][2], const Unit& u, int wr, int wc, int fr, int fq) const {
        const int row0 = u.pm * BM + wr * 64 + fr, col0 = u.pn * BM + wc * 32 + 8 * fq;
#pragma unroll
        for (int ai = 0; ai < 2; ++ai) {
            bf16x8 xq[4][2];
#pragma unroll
            for (int m = 0; m < 4; ++m)
#pragma unroll
                for (int bj = 0; bj < 2; ++bj) xq[m][bj] = *(const bf16x8*)(xh + (size_t)(row0 + ai * HALF + m * 16) * 1024 + col0 + bj * HALF);
#pragma unroll
            for (int m = 0; m < 4; ++m) { const size_t row = (size_t)(row0 + ai * HALF + m * 16); float ss = 0.f;
#pragma unroll
                for (int bj = 0; bj < 2; ++bj) { const size_t off = row * 1024 + col0 + bj * HALF; const bf16x8 xp = xq[m][bj];
                    const f32x4 v0 = (f32x4){(float)xp[0], (float)xp[1], (float)xp[2], (float)xp[3]} + acc[ai][bj][m][0], v1 = (f32x4){(float)xp[4], (float)xp[5], (float)xp[6], (float)xp[7]} + acc[ai][bj][m][1];
                    bf16x8 w; w[0] = (bf16_t)v0[0]; w[1] = (bf16_t)v0[1]; w[2] = (bf16_t)v0[2]; w[3] = (bf16_t)v0[3]; w[4] = (bf16_t)v1[0]; w[5] = (bf16_t)v1[1]; w[6] = (bf16_t)v1[2]; w[7] = (bf16_t)v1[3];
                    *(bf16x8*)(xh + off) = w;
                    ss += ((v0[0] * v0[0] + v0[1] * v0[1]) + (v0[2] * v0[2] + v0[3] * v0[3])) + ((v1[0] * v1[0] + v1[1] * v1[1]) + (v1[2] * v1[2] + v1[3] * v1[3])); }
                ss += __shfl_xor(ss, 16); ss += __shfl_xor(ss, 32);
                if (fq == 0) rowss[row * 16 + u.pn * 4 + wc] = ss; }
            asm volatile("" ::: "memory");
        }
    }
};
}


__device__ __forceinline__ void deferred_transposes(const Params& p, unsigned char* lds, int id, int n) {
    float* tile = (float*)lds;
    h16* win = (h16*)(p.ws + WS_WIN); h16* wout = (h16*)(p.ws + WS_WOUT); h16* wpw = (h16*)(p.ws + WS_WPW);
    constexpr int U_IN = 16 * 60, U_OUT = 16 * 16, U_PW = 4 * 4;
    for (int u = id; u < U_IN + 2 * U_OUT + 2 * U_PW; u += n) {
        int r = u;
        if (r < U_IN) { transpose_unit(p.w_in + (size_t)DM * NIN, DM, NIN, win + (size_t)NIN * DM, p.norm_g + DM, (r / 60) * 64, (r % 60) * 64, tile); continue; }
        r -= U_IN;
        if (r < 2 * U_OUT) { const int layer = r / U_OUT; r %= U_OUT; transpose_unit(p.w_out + (size_t)layer * DM * DM, DM, DM, wout + (size_t)layer * DM * DM, nullptr, (r / 16) * 64, (r % 16) * 64, tile); continue; }
        r -= 2 * U_OUT;
        { const int layer = r / U_PW; r %= U_PW; transpose_unit(p.pw_w + (size_t)layer * 256 * 256, 256, 256, wpw + (size_t)layer * 256 * 256, nullptr, (r / 4) * 64, (r % 4) * 64, tile); }
    }
}

__device__ __forceinline__ void gemm_in(const Params& p, int layer, unsigned char* lds) {
    pg8::Gemm g{(const h16*)(p.ws + WS_XH), (const h16*)(p.ws + WS_WIN) + (size_t)layer * NIN * DM, MROWS, NIN, DM};
    pg8::StaticOrder S; S.init(MROWS, NIN, (int)gridDim.x, (int)blockIdx.x);
    pg8::EpiProj E{(h16*)(p.ws + WS_PROJ), (const float*)(p.ws + WS_ROWSS), (float*)(p.ws + WS_KMEAN), (unsigned*)(p.ws + WS_CTL + 20480) + layer * 128};
    pg8::gemm_phase<pg8::EpiProj, pg8::StaticOrder, true, true>((PG8_LAS unsigned char*)lds, g, S, E);
    if (layer == 0) { const int G = (int)gridDim.x, nfull = (MROWS / 256) * (NIN / 256) % G;
        if (nfull == 0) deferred_transposes(p, lds, (int)blockIdx.x, G); else if ((int)blockIdx.x >= nfull) deferred_transposes(p, lds, (int)blockIdx.x - nfull, G - nfull); }
}
template <int LAYER> __device__ __forceinline__ void gemm_out(const Params& p, unsigned char* lds) {
    pg8::Gemm g{(const h16*)(p.ws + WS_MIX), (const h16*)(p.ws + WS_WOUT) + (size_t)LAYER * DM * DM, MROWS, DM, DM};
    pg8::StaticOrder S; S.init(MROWS, DM, (int)gridDim.x, (int)blockIdx.x);
    pg8::EpiRes<LAYER> E{p.x, p.out, (h16*)(p.ws + WS_XH), (float*)(p.ws + WS_ROWSS)};
    pg8::gemm_phase<pg8::EpiRes<LAYER>, pg8::StaticOrder, true, true>((PG8_LAS unsigned char*)lds, g, S, E);
}

__device__ __forceinline__ void phase_stats(const Params& p, int layer, unsigned char* lds_g) {
    LAS unsigned char* lds = (LAS unsigned char*)lds_g;
    const h16* proj = (const h16*)(p.ws + WS_PROJ); float* kv = (float*)(p.ws + WS_KV);
    const int tid = threadIdx.x, lane = tid & 63, wid = __builtin_amdgcn_readfirstlane(tid >> 6), r = lane & 31, hi = lane >> 5;
    const int lanepart = (4 * hi + ((lane & 15) >> 2)) * 64 + ((lane >> 4) & 1) * 32 + (lane & 3) * 8;
#pragma unroll 1
    for (int u = blockIdx.x; u < 256; u += gridDim.x) {
        const int b = u >> 5, hh = (u >> 3) & 3, nq = u & 7;
        const float log_g = logf(1.0f - exp2f(-5.0f - (float)hh));
        h16x8 kk[8], vv[8];
#pragma unroll
        for (int it = 0; it < 8; ++it) {
            const int pc = tid + 512 * it, cn = pc >> 10, key = (pc >> 3) & 127, ch = pc & 7;
            const h16* src = proj + (size_t)(b * SEQ + (4 * nq + cn) * 128 + key) * NIN + hh * 64 + ch * 8;
            kk[it] = *(const h16x8*)(src + C_RK); vv[it] = *(const h16x8*)(src + C_RV);
        }
        __syncthreads();
#pragma unroll
        for (int it = 0; it < 8; ++it) {
            const int pc = tid + 512 * it, cn = pc >> 10, key = (pc >> 3) & 127, ch = pc & 7;
            const float z = __expf(log_g * (float)(127 - key)) * 0.125f;
#pragma unroll
            for (int k = 0; k < 8; ++k) kk[it][k] = (h16)((float)kk[it][k] * z);
            const int off = cn * 32768 + (ch >> 2) * 8192 + (key >> 4) * 1024 + (key & 15) * 64 + (ch & 3) * 16;
            *(LAS h16x8*)(lds + off) = kk[it]; *(LAS h16x8*)(lds + off + 16384) = vv[it];
        }
        __syncthreads();
#pragma unroll
        for (int half = 0; half < 2; ++half) {
            const int cn = 2 * half + (wid >> 2), eb = (wid >> 1) & 1, dbk = wid & 1;
            const LAS unsigned char* kimg = lds + cn * 32768 + dbk * 8192 + lanepart; const LAS unsigned char* vimg = lds + cn * 32768 + 16384 + eb * 8192 + lanepart;
            f32x16 acc;
#pragma unroll
            for (int i = 0; i < 16; ++i) acc[i] = 0.f;
#pragma unroll
            for (int ks = 0; ks < 8; ++ks) acc = __builtin_amdgcn_mfma_f32_32x32x16_f16(tr_frag(vimg + ks * 1024), tr_frag(kimg + ks * 1024), acc, 0, 0, 0);
            float* dst = kv + ((size_t)((b * 4 + hh) * 32 + 4 * nq + cn)) * 4096 + (32 * eb + 4 * hi) * 64 + 32 * dbk + r;
#pragma unroll
            for (int i = 0; i < 16; ++i) dst[CROW0(i) * 64] = acc[i];
        }
    }
}

typedef _Float16 h16x2 __attribute__((ext_vector_type(2)));
typedef float f32x2 __attribute__((ext_vector_type(2)));
__device__ __forceinline__ void conv_unit(const Params& p, int layer, int b, int tt, unsigned char* lds_g) {
    LAS unsigned char* lds = (LAS unsigned char*)lds_g;
    const h16* projb = (const h16*)(p.ws + WS_PROJ) + (size_t)b * SEQ * NIN; h16* mix = (h16*)(p.ws + WS_MIX);
    const int tid = threadIdx.x, lane = tid & 63, wid = __builtin_amdgcn_readfirstlane(tid >> 6), r = lane & 31, hi = lane >> 5;
    const int cp = tid & 127, tg = __builtin_amdgcn_readfirstlane(tid >> 7), t0 = tt * 64;
    constexpr int UIMG = 0  , SIMG = 0, YS = 49152  ;
    {
        h16x8 av[6], gv[6];
#pragma unroll
        for (int it = 0; it < 6; ++it) { const int pi = tid + 512 * it, row = pi >> 5, c8 = pi & 31; const int t = t0 - 30 + row;
            const size_t ro = (size_t)((row < 94 && t >= 0) ? t : 0) * NIN + 8 * c8;
            av[it] = *(const h16x8*)(projb + ro + C_AVAL); gv[it] = *(const h16x8*)(projb + ro + C_AGLU); }
        __syncthreads();
#pragma unroll
        for (int it = 0; it < 6; ++it) { const int pi = tid + 512 * it, row = pi >> 5, c8 = pi & 31; const bool ok = (t0 - 30 + row >= 0);
            h16x8 u;
#pragma unroll
            for (int k = 0; k < 8; ++k) u[k] = ok ? (h16)((float)av[it][k] * __builtin_amdgcn_rcpf(1.0f + __expf(-(float)gv[it][k]))) : (h16)0.f;
            if (row < 94) *(LAS h16x8*)(lds + UIMG + row * 512 + c8 * 16) = u; }
    }
    float y0[16], y1[16];
    {
        float w0[31], w1[31]; const float* cw = p.conv_w + (size_t)layer * 31 * 256 + 2 * cp;
#pragma unroll
        for (int jj = 0; jj < 31; ++jj) { const f32x2 wv = *(const f32x2*)(cw + jj * 256); w0[jj] = wv[0]; w1[jj] = wv[1]; }
        const f32x2 cbv = *(const f32x2*)(p.conv_b + layer * 256 + 2 * cp);
#pragma unroll
        for (int tl = 0; tl < 16; ++tl) { y0[tl] = cbv[0]; y1[tl] = cbv[1]; }
        __syncthreads();
        const LAS unsigned char* ub = lds + UIMG + (16 * tg) * 512 + 4 * cp;
#pragma unroll
        for (int rr = 0; rr < 46; ++rr) { const h16x2 uv = *(const LAS h16x2*)(ub + rr * 512); const float a0 = (float)uv[0], a1 = (float)uv[1];
#pragma unroll
            for (int tl = 0; tl < 16; ++tl) { const int jj = rr - tl; if (jj >= 0 && jj < 31) { y0[tl] += w0[jj] * a0; y1[tl] += w1[jj] * a1; } } }
    }
#pragma unroll
    for (int tl = 0; tl < 16; ++tl) *(LAS f32x2*)(lds + YS + ((16 * tg + tl) * 256 + 2 * cp) * 4) = (f32x2){y0[tl], y1[tl]};
    h16x8 wf[16]; h16x4 gpre[2][4];
    {
        const h16* wp = (const h16*)(p.ws + WS_WPW) + (size_t)layer * 65536 + (size_t)(32 * wid + r) * 256 + 8 * hi;
#pragma unroll
        for (int ks = 0; ks < 16; ++ks) wf[ks] = *(const h16x8*)(wp + 16 * ks);
#pragma unroll
        for (int tb = 0; tb < 2; ++tb) { const h16* gp = projb + (size_t)(t0 + 32 * tb + r) * NIN + C_AGATE + 32 * wid + 4 * hi;
#pragma unroll
            for (int g = 0; g < 4; ++g) gpre[tb][g] = *(const h16x4*)(gp + 8 * g); }
    }
    __syncthreads();
    {
        const f32x4 lg = *(const f32x4*)(p.ln_g + layer * 256 + lane * 4), lb = *(const f32x4*)(p.ln_b + layer * 256 + lane * 4);
#pragma unroll 1
        for (int kb = 0; kb < 8; kb += 4) {
        f32x4 v[4]; float s1[4], s2[4];
#pragma unroll
        for (int k = 0; k < 4; ++k) { v[k] = *(const LAS f32x4*)(lds + YS + ((wid * 8 + kb + k) * 256 + lane * 4) * 4);
            s1[k] = (v[k][0] + v[k][1]) + (v[k][2] + v[k][3]); s2[k] = (v[k][0] * v[k][0] + v[k][1] * v[k][1]) + (v[k][2] * v[k][2] + v[k][3] * v[k][3]); }
#pragma unroll
        for (int o = 1; o < 64; o <<= 1)
#pragma unroll
            for (int k = 0; k < 4; ++k) { s1[k] += __shfl_xor(s1[k], o); s2[k] += __shfl_xor(s2[k], o); }
#pragma unroll
        for (int k = 0; k < 4; ++k) { const int t = wid * 8 + kb + k; const float mu = s1[k] * (1.0f / 256.0f); const float var = fmaxf(s2[k] * (1.0f / 256.0f) - mu * mu, 0.f); const float rs = rsqrtf(var + 1e-5f);
            h16x4 o; o[0] = (h16)silu_f((v[k][0] - mu) * rs * lg[0] + lb[0]); o[1] = (h16)silu_f((v[k][1] - mu) * rs * lg[1] + lb[1]); o[2] = (h16)silu_f((v[k][2] - mu) * rs * lg[2] + lb[2]); o[3] = (h16)silu_f((v[k][3] - mu) * rs * lg[3] + lb[3]);
            *(LAS h16x4*)(lds + SIMG + t * 512 + (((lane >> 1) ^ (t & 15)) << 4) + 8 * (lane & 1)) = o; }
        }
    }
    __syncthreads();
#pragma unroll
    for (int tb = 0; tb < 2; ++tb) {
        f32x16 acc;
#pragma unroll
        for (int i = 0; i < 16; ++i) acc[i] = 0.f;
#pragma unroll
        for (int ks = 0; ks < 16; ++ks) acc = __builtin_amdgcn_mfma_f32_32x32x16_f16(wf[ks], *(const LAS h16x8*)(lds + SIMG + (32 * tb + r) * 512 + (((2 * ks + hi) ^ (r & 15)) << 4)), acc, 0, 0, 0);
        const int t = t0 + 32 * tb + r, n0 = 32 * wid + 4 * hi;
        h16* dst = mix + ((size_t)b * SEQ + t) * DM + n0; const float* pb = p.pw_b + layer * 256 + n0;
#pragma unroll
        for (int g = 0; g < 4; ++g) { const h16x4 ga = gpre[tb][g]; const f32x4 bb = *(const f32x4*)(pb + 8 * g); h16x4 oa;
#pragma unroll
            for (int k = 0; k < 4; ++k) oa[k] = (h16)((acc[4 * g + k] + bb[k]) * silu_f((float)ga[k]));
            *(h16x4*)(dst + 8 * g) = oa; }
    }
}

__device__ __forceinline__ void ret_unit(const Params& p, int b, int hh, int n, unsigned char* lds_g) {
    LAS unsigned char* lds = (LAS unsigned char*)lds_g;
    const h16* projb = (const h16*)(p.ws + WS_PROJ) + (size_t)(b * SEQ + n * 128) * NIN; h16* mix = (h16*)(p.ws + WS_MIX); const float* kv = (const float*)(p.ws + WS_KV);
    const int tid = threadIdx.x, lane = tid & 63, wid = __builtin_amdgcn_readfirstlane(tid >> 6), r = lane & 31, hi = lane >> 5, g4 = wid & 3, eh = wid >> 2;
    const float log_g = logf(1.0f - exp2f(-5.0f - (float)hh));
    constexpr int KIMG = 0, VIMG = 16384, RIMG = 32768, XS = 40960;
    const h16x8 rr = *(const h16x8*)((const h16*)(p.ws + WS_RST) + ((size_t)((b * 4 + hh) * 32 + n)) * 4096 + tid * 8);
    h16x4 gpre[4];
    { const h16* gp0 = projb + (size_t)(32 * g4 + r) * NIN + C_RGATE + hh * 64 + 32 * eh + 4 * hi;
#pragma unroll
      for (int g = 0; g < 4; ++g) gpre[g] = *(const h16x4*)(gp0 + 8 * g); }
    __syncthreads();
    {
        const int e = tid >> 3, ch = tid & 7;
        *(LAS h16x8*)(lds + RIMG + e * 128 + ((ch ^ ((e >> 1) & 7)) << 4)) = rr;
#pragma unroll
        for (int it = 0; it < 2; ++it) {
            const int key = (tid >> 3) + 64 * it;
            h16x8 kk = *(const h16x8*)(projb + (size_t)key * NIN + C_RK + hh * 64 + ch * 8); const h16x8 vv = *(const h16x8*)(projb + (size_t)key * NIN + C_RV + hh * 64 + ch * 8);
            const float z = __expf(-log_g * (float)key) * 0.125f;
#pragma unroll
            for (int k = 0; k < 8; ++k) kk[k] = (h16)((float)kk[k] * z);
            *(LAS h16x8*)(lds + KIMG + key * 128 + ((ch ^ ((key >> 1) & 7)) << 4)) = kk;
            *(LAS h16x8*)(lds + VIMG + (ch >> 2) * 8192 + (key >> 4) * 1024 + (key & 15) * 64 + (ch & 3) * 16) = vv;
        }
    }
    const int qi = 32 * g4 + r;
    h16x8 qf[4];
    {
        const float zq = __expf(log_g * (float)qi);
#pragma unroll
        for (int s = 0; s < 4; ++s) { qf[s] = *(const h16x8*)(projb + (size_t)qi * NIN + C_RQ + hh * 64 + 16 * s + 8 * hi);
#pragma unroll
            for (int k = 0; k < 8; ++k) qf[s][k] = (h16)((float)qf[s][k] * zq); }
    }
    __syncthreads();
    const int rsw = (r >> 1) & 7;
    const int lanepart = (4 * hi + ((lane & 15) >> 2)) * 64 + ((lane >> 4) & 1) * 32 + (lane & 3) * 8;
    f32x16 o;
#pragma unroll
    for (int i = 0; i < 16; ++i) o[i] = 0.f;
#pragma unroll 1
    for (int jb = 0; jb <= g4; ++jb) {
        f32x16 c;
#pragma unroll
        for (int i = 0; i < 16; ++i) c[i] = 0.f;
#pragma unroll
        for (int s = 0; s < 4; ++s) c = __builtin_amdgcn_mfma_f32_32x32x16_f16(*(const LAS h16x8*)(lds + KIMG + (32 * jb + r) * 128 + (((2 * s + hi) ^ rsw) << 4)), qf[s], c, 0, 0, 0);
        if (jb == g4) {
#pragma unroll
            for (int i = 0; i < 16; ++i) if (CROW0(i) + 4 * hi > r) c[i] = 0.f;
        }
        h16x8 pf0, pf1;
#pragma unroll
        for (int k = 0; k < 8; ++k) { pf0[k] = (h16)c[k]; pf1[k] = (h16)c[8 + k]; }
        o = __builtin_amdgcn_mfma_f32_32x32x16_f16(tr_frag(lds + VIMG + eh * 8192 + (2 * jb) * 1024 + lanepart), pf0, o, 0, 0, 0);
        o = __builtin_amdgcn_mfma_f32_32x32x16_f16(tr_frag(lds + VIMG + eh * 8192 + (2 * jb + 1) * 1024 + lanepart), pf1, o, 0, 0, 0);
    }
#pragma unroll
    for (int s = 0; s < 4; ++s) o = __builtin_amdgcn_mfma_f32_32x32x16_f16(*(const LAS h16x8*)(lds + RIMG + (32 * eh + r) * 128 + (((2 * s + hi) ^ rsw) << 4)), qf[s], o, 0, 0, 0);
    float s1 = 0.f, s2 = 0.f;
#pragma unroll
    for (int i = 0; i < 16; ++i) { s1 += o[i]; s2 += o[i] * o[i]; }
    s1 = xhalf_sum(s1); s2 = xhalf_sum(s2);
    LAS float* xs = (LAS float*)(lds + XS);
    if (hi == 0) { xs[(wid * 32 + r) * 2] = s1; xs[(wid * 32 + r) * 2 + 1] = s2; }
    __syncthreads();
    {
        const float t1 = xs[((wid ^ 4) * 32 + r) * 2], t2 = xs[((wid ^ 4) * 32 + r) * 2 + 1];
        const float a1 = (eh == 0) ? (s1 + t1) : (t1 + s1), a2 = (eh == 0) ? (s2 + t2) : (t2 + s2);
        const float mu = a1 * (1.0f / 64.0f); const float var = fmaxf(a2 * (1.0f / 64.0f) - mu * mu, 0.f); const float rs = rsqrtf(var + 1e-5f);
        const int col = hh * 64 + 32 * eh + 4 * hi;
        h16* dst = mix + ((size_t)(b * SEQ + n * 128 + qi)) * DM + 256 + col;
#pragma unroll
        for (int g = 0; g < 4; ++g) { const h16x4 ga = gpre[g]; h16x4 oa;
#pragma unroll
            for (int k = 0; k < 4; ++k) oa[k] = (h16)((o[4 * g + k] - mu) * rs * silu_f((float)ga[k]));
            *(h16x4*)(dst + 8 * g) = oa; }
    }
}

constexpr float MOBA_THR = 8.0f;
__device__ __forceinline__ void moba_unit(const Params& p, int layer, int b, int hh, int j, unsigned char* lds_g) {
    LAS unsigned char* lds = (LAS unsigned char*)lds_g;
    const int tid = threadIdx.x, lane = tid & 63, wid = __builtin_amdgcn_readfirstlane(tid >> 6), r = lane & 31, hi = lane >> 5;
    const h16* projb = (const h16*)(p.ws + WS_PROJ) + (size_t)b * SEQ * NIN; h16* mix = (h16*)(p.ws + WS_MIX);
    const int qrow = j * 256 + wid * 32 + r;
    h16x8 qf[4];
#pragma unroll
    for (int s = 0; s < 4; ++s) qf[s] = *(const h16x8*)(projb + (size_t)qrow * NIN + C_MQ + hh * 64 + 16 * s + 8 * hi);
    const unsigned lds0 = (unsigned)(__UINTPTR_TYPE__)lds;
    const int dkey = 8 * wid + (lane >> 3);
    const h16* ksrc = projb + (size_t)dkey * NIN + C_MK + hh * 64 + (((lane & 7) ^ ((dkey >> 1) & 7)) << 3);
    const h16* vsrc = projb + (size_t)(16 * (wid & 3) + (lane >> 2)) * NIN + C_MV + hh * 64 + (wid >> 2) * 32 + (lane & 3) * 8;
    const unsigned kdst = lds0 + wid * 1024, vdst = lds0 + 8192 + (wid >> 2) * 4096 + (wid & 3) * 1024;
#define MOBA_DMA(tile) do { const int kp_ = j * 256 + 192 - 64 * (tile); const unsigned so_ = (unsigned)(((tile) & 7) * 16384); \
        glds16(ksrc + (size_t)kp_ * NIN, (unsigned)__builtin_amdgcn_readfirstlane(kdst + so_)); glds16(vsrc + (size_t)kp_ * NIN, (unsigned)__builtin_amdgcn_readfirstlane(vdst + so_)); } while (0)
#define MOBA_WAIT_BAR(N) asm volatile("s_waitcnt vmcnt(" #N ") lgkmcnt(0)\n\ts_barrier" ::: "memory")
    MOBA_WAIT_BAR(0);
    MOBA_DMA(0); MOBA_DMA(1); MOBA_DMA(2);
    unsigned selmask = 0u;
    if (j <= 3) selmask = (1u << j) - 1u;
    else {
        const float* km = (const float*)(p.ws + WS_KMEAN) + ((size_t)(b * 8 + hh) * 16 + (r & 15)) * 64 + 8 * hi;
        f32x16 g;
#pragma unroll
        for (int i = 0; i < 16; ++i) g[i] = 0.f;
#pragma unroll
        for (int s = 0; s < 4; ++s) {
            f32x4 a0 = (f32x4){0.f, 0.f, 0.f, 0.f}, a1 = a0;
            if (r < j) { a0 = *(const f32x4*)(km + 16 * s) + *(const f32x4*)(km + 65536 + 16 * s); a1 = *(const f32x4*)(km + 16 * s + 4) + *(const f32x4*)(km + 65536 + 16 * s + 4); }
            h16x8 ah, al;
#pragma unroll
            for (int k = 0; k < 4; ++k) { const h16 h0 = (h16)a0[k], h1 = (h16)a1[k]; ah[k] = h0; ah[4 + k] = h1; al[k] = (h16)(a0[k] - (float)h0); al[4 + k] = (h16)(a1[k] - (float)h1); }
            g = __builtin_amdgcn_mfma_f32_32x32x16_f16(ah, qf[s], g, 0, 0, 0);
            g = __builtin_amdgcn_mfma_f32_32x32x16_f16(al, qf[s], g, 0, 0, 0);
        }
        float gate[16];
#pragma unroll
        for (int i = 0; i < 8; ++i) { auto rr = __builtin_amdgcn_permlane32_swap(__float_as_uint(g[i]), __float_as_uint(g[i]), false, false);
            gate[(i & 3) + 8 * (i >> 2)] = __uint_as_float(rr[0]); gate[(i & 3) + 8 * (i >> 2) + 4] = __uint_as_float(rr[1]); }
        float g0 = -3.0e38f, g1 = -3.0e38f, g2 = -3.0e38f; int i0 = 0, i1 = 0, i2 = 0;
#pragma unroll
        for (int n = 0; n < 15; ++n) { const float s = (n < j) ? gate[n] : -3.0e38f;
            if (s > g0) { g2 = g1; i2 = i1; g1 = g0; i1 = i0; g0 = s; i0 = n; }
            else if (s > g1) { g2 = g1; i2 = i1; g1 = s; i1 = n; }
            else if (s > g2) { g2 = s; i2 = n; } }
        selmask = (1u << i0) | (1u << i1) | (1u << i2);
    }
    constexpr float C2 = 0.125f * 1.4426950408889634f;
    float qn2 = 0.f;
#pragma unroll
    for (int s = 0; s < 4; ++s)
#pragma unroll
        for (int k = 0; k < 8; ++k) { qf[s][k] = (h16)((float)qf[s][k] * C2); qn2 += (float)qf[s][k] * (float)qf[s][k]; }
    const unsigned* kmh = (const unsigned*)(p.ws + WS_CTL + 20480) + layer * 128 + (b * 8 + hh) * 2;
    const float qbound = sqrtf(xhalf_sum(qn2)) * sqrtf(__uint_as_float(__hip_atomic_load(kmh, __ATOMIC_RELAXED, __HIP_MEMORY_SCOPE_AGENT)) + __uint_as_float(__hip_atomic_load(kmh + 1, __ATOMIC_RELAXED, __HIP_MEMORY_SCOPE_AGENT))) * 1.002f;
    const float slope2 = exp2f(-(float)(hh + 1)) * 1.4426950408889634f;
    float kb[16];
#pragma unroll
    for (int i = 0; i < 16; ++i) kb[i] = slope2 * (float)CROW0(i);
    f32x16 o0, o1;
#pragma unroll
    for (int i = 0; i < 16; ++i) { o0[i] = 0.f; o1[i] = 0.f; }
    float mref = 0.f, lsum = 0.f; bool first = true;
    const int rK = r * 128, rsw = (r >> 1) & 7;
    const int rV = 8192 + (4 * hi + ((lane & 15) >> 2)) * 64 + ((lane >> 4) & 1) * 32 + (lane & 3) * 8;
    const int nt = 4 * (j + 1);
    const int wdiag = wid >> 1;
#define MOBA_CIN(T, C0, C1) do { const int kp_ = j * 256 + 192 - 64 * (T); const int nb_ = kp_ >> 8, tl_ = (kp_ >> 6) & 3; const bool own_ = (nb_ == j); \
        const bool val_ = own_ ? true : (((selmask >> (nb_ & 31)) & 1u) != 0u); \
        const float tbh_ = val_ ? (slope2 * (float)(kp_ - qrow + 4 * hi) - mref) : -INFINITY; \
        const float tbh32_ = val_ ? (tbh_ + 32.0f * slope2) : -INFINITY; \
        _Pragma("unroll") for (int i = 0; i < 16; ++i) { C0[i] = fadd_s(kb[i], tbh_); C1[i] = fadd_s(kb[i], tbh32_); } \
        asm volatile("s_nop 1" : "+v"(C0), "+v"(C1));        \
        if (own_ && tl_ >= wdiag) { const int lim2_ = 32 * wid - 64 * tl_ + r - 4 * hi; \
            _Pragma("unroll") for (int i = 0; i < 16; ++i) { if (CROW0(i) > lim2_) C0[i] = -INFINITY; if (CROW0(i) + 32 > lim2_) C1[i] = -INFINITY; } } } while (0)
#define MOBA_QK(T, C0, C1) do { const LAS unsigned char* kb_ = lds + ((T) & 7) * 16384 + rK; \
        _Pragma("unroll") for (int s = 0; s < 4; ++s) { \
            const h16x8 k0_ = *(const LAS h16x8*)(kb_ + (((2 * s + hi) ^ rsw) << 4)), k1_ = *(const LAS h16x8*)(kb_ + 4096 + (((2 * s + hi) ^ rsw) << 4)); \
            C0 = __builtin_amdgcn_mfma_f32_32x32x16_f16(k0_, qf[s], C0, 0, 0, 0); C1 = __builtin_amdgcn_mfma_f32_32x32x16_f16(k1_, qf[s], C1, 0, 0, 0); } } while (0)
#define MOBA_DECIDE(T, C0, C1) do { float m_ = __builtin_fmaxf(C0[0], C1[0]); \
        _Pragma("unroll") for (int i = 1; i < 16; ++i) m_ = __builtin_fmaxf(__builtin_fmaxf(m_, C0[i]), C1[i]); \
        m_ = xhalf_max(m_); \
        const int kp_ = j * 256 + 192 - 64 * (T); const bool fst_ = ((kp_ >> 8) == j) && (((kp_ >> 6) & 3) == wdiag); \
        if (fst_ || __any(m_ > MOBA_THR)) { const float dl_ = fst_ ? m_ : __builtin_fmaxf(m_, 0.f); const float f_ = fst_ ? 1.0f : __builtin_amdgcn_exp2f(-dl_); mref += dl_; lsum *= f_; \
            _Pragma("unroll") for (int i = 0; i < 16; ++i) { C0[i] -= dl_; C1[i] -= dl_; o0[i] *= f_; o1[i] *= f_; } } } while (0)
#define MOBA_STEP(T, TE, P0, P1, N0, N1) do { \
        MOBA_CIN((T) + 1, N0, N1); MOBA_QK((T) + 1, N0, N1); \
        float pa_ = 0.f, pb_ = 0.f, pc_ = 0.f, pd_ = 0.f; \
        _Pragma("unroll") for (int i = 0; i < 16; ++i) { P0[i] = __builtin_amdgcn_exp2f(P0[i]); P1[i] = __builtin_amdgcn_exp2f(P1[i]); } \
        _Pragma("unroll") for (int i = 0; i < 16; i += 2) { pa_ = fadd_s(pa_, P0[i]); pb_ = fadd_s(pb_, P1[i]); pc_ = fadd_s(pc_, P0[i + 1]); pd_ = fadd_s(pd_, P1[i + 1]); } \
        lsum += fadd_s(fadd_s(pa_, pb_), fadd_s(pc_, pd_)); \
        b16x8 pf_[4]; \
        { \
            u32x4 w0_ = {cvt_pk_bf16(P0[0], P0[1]), cvt_pk_bf16(P0[2], P0[3]), cvt_pk_bf16(P0[4], P0[5]), cvt_pk_bf16(P0[6], P0[7])}; \
            u32x4 w1_ = {cvt_pk_bf16(P0[8], P0[9]), cvt_pk_bf16(P0[10], P0[11]), cvt_pk_bf16(P0[12], P0[13]), cvt_pk_bf16(P0[14], P0[15])}; \
            u32x4 w2_ = {cvt_pk_bf16(P1[0], P1[1]), cvt_pk_bf16(P1[2], P1[3]), cvt_pk_bf16(P1[4], P1[5]), cvt_pk_bf16(P1[6], P1[7])}; \
            u32x4 w3_ = {cvt_pk_bf16(P1[8], P1[9]), cvt_pk_bf16(P1[10], P1[11]), cvt_pk_bf16(P1[12], P1[13]), cvt_pk_bf16(P1[14], P1[15])}; \
            asm volatile("s_nop 1" : "+v"(w0_), "+v"(w1_), "+v"(w2_), "+v"(w3_));        \
            pf_[0] = __builtin_bit_cast(b16x8, w0_); pf_[1] = __builtin_bit_cast(b16x8, w1_); pf_[2] = __builtin_bit_cast(b16x8, w2_); pf_[3] = __builtin_bit_cast(b16x8, w3_); } \
        { const LAS unsigned char* vb_ = lds + ((T) & 7) * 16384 + rV; \
          _Pragma("unroll") for (int t = 0; t < 4; ++t) { const b16x8 v0_ = __builtin_bit_cast(b16x8, tr_frag(vb_ + t * 1024)), v1_ = __builtin_bit_cast(b16x8, tr_frag(vb_ + 4096 + t * 1024)); \
            o0 = __builtin_amdgcn_mfma_f32_32x32x16_bf16(v0_, pf_[t], o0, 0, 0, 0); o1 = __builtin_amdgcn_mfma_f32_32x32x16_bf16(v1_, pf_[t], o1, 0, 0, 0); } } \
        if ((T) + 1 < (TE) && dec) MOBA_DECIDE((T) + 1, N0, N1); } while (0)
    f32x16 cA0, cA1, cB0, cB1;
    int te = nt; bool dec = true;
    LAS float* xs = (LAS float*)(lds + 131072);
    MOBA_WAIT_BAR(0);
    MOBA_DMA(3); if (4 < te) MOBA_DMA(4);
    MOBA_CIN(0, cA0, cA1); MOBA_QK(0, cA0, cA1); MOBA_DECIDE(0, cA0, cA1);
#pragma unroll 1
    for (int tt = 0; tt < te; tt += 2) {
        MOBA_STEP(tt, te, cA0, cA1, cB0, cB1);
        if (tt == 2 && j > 0) { float marg = qbound - mref;
#pragma unroll
            for (int o = 1; o < 64; o <<= 1) marg = fmaxf(marg, __shfl_xor(marg, o));
            if (lane == 0) xs[wid] = marg; }
        MOBA_STEP(tt + 1, te, cB0, cB1, cA0, cA1);
        MOBA_WAIT_BAR(0);
        if (tt == 2 && j > 0) { float M = xs[0];
#pragma unroll
            for (int k = 1; k < 8; ++k) M = fmaxf(M, xs[k]);
            const float num = M + 40.0f - slope2;
            int cnt = (num >= 0.f) ? ((int)(num / (64.0f * slope2)) + 1) : 0;
            cnt = max(min(cnt, 4 * j), 2); cnt = (cnt + 1) & ~1;
            te = 4 + __builtin_amdgcn_readfirstlane(cnt);
            dec = !(M < 100.0f); }
        if (tt + 5 < te) MOBA_DMA(tt + 5);
        if (tt + 6 < te) MOBA_DMA(tt + 6);
    }
    MOBA_WAIT_BAR(0);
#undef MOBA_RUN
#undef MOBA_CIN
#undef MOBA_QK
#undef MOBA_DECIDE
#undef MOBA_STEP
#undef MOBA_DMA
#undef MOBA_WAIT_BAR
    {
        const float inv = 1.0f / xhalf_sum(lsum);
        const h16* gp = projb + (size_t)qrow * NIN + C_MGATE + hh * 64 + 4 * hi; h16* dst = mix + ((size_t)b * SEQ + qrow) * DM + 512 + hh * 64 + 4 * hi;
#pragma unroll
        for (int g = 0; g < 4; ++g) {
            const h16x4 ga = *(const h16x4*)(gp + 8 * g), gb = *(const h16x4*)(gp + 32 + 8 * g); h16x4 oa, ob;
#pragma unroll
            for (int k = 0; k < 4; ++k) { oa[k] = (h16)(o0[4 * g + k] * inv * silu_f((float)ga[k])); ob[k] = (h16)(o1[4 * g + k] * inv * silu_f((float)gb[k])); }
            *(h16x4*)(dst + 8 * g) = oa; *(h16x4*)(dst + 32 + 8 * g) = ob;
        }
    }
}

__device__ __forceinline__ void ret_scan_shares(const Params& p, int layer) {
    const float* kv = (const float*)(p.ws + WS_KV); h16* rst = (h16*)(p.ws + WS_RST);
    const int tid = threadIdx.x; unsigned done = 0u;
#pragma unroll 1
    for (int s = blockIdx.x; s < 256; s += gridDim.x) {
        const int bh = s >> 3, e = (s & 7) * 512 + tid, hh = bh & 3;
        const float gam = 1.0f - exp2f(-5.0f - (float)hh); const float g = expf(logf(gam) * 128.0f);
        const float* kvb = kv + (size_t)bh * 32 * 4096 + e; h16* rb = rst + (size_t)bh * 32 * 4096 + e;
        float r = 0.f; rb[0] = (h16)0.f;
        float kvv[31];
#pragma unroll
        for (int m = 0; m < 31; ++m) kvv[m] = kvb[(size_t)m * 4096];
#pragma unroll
        for (int m = 0; m < 31; ++m) { r = r * g + kvv[m]; rb[(size_t)(m + 1) * 4096] = (h16)(r * gam); }
        ++done;
    }
    asm volatile("s_waitcnt vmcnt(0)" ::: "memory");
    __syncthreads();
    if (tid == 0) { __builtin_amdgcn_fence(__ATOMIC_RELEASE, "agent"); asm volatile("s_waitcnt vmcnt(0)" ::: "memory");
        __hip_atomic_fetch_add((unsigned*)(p.ws + WS_CTL + 16384) + 64 * layer, done, __ATOMIC_RELAXED, __HIP_MEMORY_SCOPE_AGENT); }
}
__device__ __forceinline__ void ret_scan_wait(const Params& p, int layer) {
    if (threadIdx.x == 0) {
        unsigned* c = (unsigned*)(p.ws + WS_CTL + 16384) + 64 * layer; unsigned sp = 0u;
        while (__hip_atomic_load(c, __ATOMIC_RELAXED, __HIP_MEMORY_SCOPE_AGENT) < 256u) { __builtin_amdgcn_s_sleep(2); if (++sp > (1u << 22)) break; }
        __builtin_amdgcn_fence(__ATOMIC_ACQUIRE, "agent"); asm volatile("s_waitcnt vmcnt(0)" ::: "memory");
    }
    __syncthreads();
}

__device__ __forceinline__ void publish_count(unsigned* c, unsigned n) {
    asm volatile("s_waitcnt vmcnt(0)" ::: "memory");
    __syncthreads();
    if (threadIdx.x == 0) { __builtin_amdgcn_fence(__ATOMIC_RELEASE, "agent"); asm volatile("s_waitcnt vmcnt(0)" ::: "memory"); __hip_atomic_fetch_add(c, n, __ATOMIC_RELAXED, __HIP_MEMORY_SCOPE_AGENT); }
}
__device__ __forceinline__ void wait_count(unsigned* c, unsigned want) {
    if (threadIdx.x == 0) { unsigned sp = 0u;
        while (__hip_atomic_load(c, __ATOMIC_RELAXED, __HIP_MEMORY_SCOPE_AGENT) < want) { __builtin_amdgcn_s_sleep(2); if (++sp > (1u << 22)) break; }
        __builtin_amdgcn_fence(__ATOMIC_ACQUIRE, "agent"); asm volatile("s_waitcnt vmcnt(0)" ::: "memory"); }
    __syncthreads();
}
__device__ __forceinline__ int queue_pop(unsigned* counter, LAS unsigned* slot) {
    __syncthreads();
    if (threadIdx.x == 0) slot[0] = __hip_atomic_fetch_add(counter, 1u, __ATOMIC_RELAXED, __HIP_MEMORY_SCOPE_AGENT);
    __syncthreads();
    return (int)slot[0];
}
__device__ __forceinline__ void phase_mixers(const Params& p, int layer, unsigned char* lds) {
    static constexpr unsigned char MOBA_ORDER[128] = {111,127,110,126,109,125,93,94,95,92,108,124,91,107,123,90,106,122,89,105,121,88,104,120,87,103,119,71,72,73,74,75,76,77,78,79,70,86,102,118,69,85,101,117,68,84,100,116,52,53,54,55,56,57,58,59,60,61,62,63,51,67,83,99,115,50,66,82,98,114,34,35,36,37,38,39,40,41,42,43,44,45,46,47,17,18,19,20,21,22,23,24,25,26,27,28,29,30,31,33,49,65,81,97,113,1,2,3,4,5,6,7,8,9,10,11,12,13,14,15,0,16,32,48,64,80,96,112};
    unsigned* qc = (unsigned*)(p.ws + WS_CTL + 24576) + layer * 256;
    LAS unsigned* slot = (LAS unsigned*)((LAS unsigned char*)lds + BAR_LDS_OFF + 16);
    phase_stats(p, layer, lds);
    publish_count((unsigned*)(p.ws + WS_CTL + 16384) + 64 * (2 + layer), 1u);
#define QUEUE_LOOP(CNT, N, BODY) do { int cur = queue_pop(CNT, slot); \
        _Pragma("unroll 1") while (cur < (N)) { unsigned nxt_ = 0u; if (threadIdx.x == 0) nxt_ = __hip_atomic_fetch_add(CNT, 1u, __ATOMIC_RELAXED, __HIP_MEMORY_SCOPE_AGENT); \
            { BODY; } \
            __syncthreads(); if (threadIdx.x == 0) slot[0] = nxt_; __syncthreads(); cur = (int)slot[0]; } } while (0)
    QUEUE_LOOP(qc + 128, 512, conv_unit(p, layer, cur >> 6, cur & 63, lds));
    wait_count((unsigned*)(p.ws + WS_CTL + 16384) + 64 * (2 + layer), gridDim.x);
    ret_scan_shares(p, layer);
    QUEUE_LOOP(qc, 1024, const int hj = MOBA_ORDER[cur >> 3]; moba_unit(p, layer, cur & 7, hj >> 4, hj & 15, lds));
    ret_scan_wait(p, layer);
    QUEUE_LOOP(qc + 64, 1024, ret_unit(p, cur >> 7, (cur >> 5) & 3, cur & 31, lds));
#undef QUEUE_LOOP
}

__device__ __forceinline__ void phase_final(const Params& p) {
    const float* rowss = (const float*)(p.ws + WS_ROWSS); const h16* xh = (const h16*)(p.ws + WS_XH);
    const int lane = threadIdx.x & 63, wid = threadIdx.x >> 6;
    f32x4 g[4];
#pragma unroll
    for (int j = 0; j < 4; ++j) g[j] = *((const f32x4*)p.final_g + lane + 64 * j);
    for (int row = blockIdx.x * 8 + wid; row < MROWS; row += gridDim.x * 8) {
        const f32x4* rs = (const f32x4*)(rowss + (size_t)row * NPART); const f32x4 s0 = rs[0], s1 = rs[1], s2 = rs[2], s3 = rs[3];
        const float tot = ((s0[0] + s0[1]) + (s0[2] + s0[3])) + ((s1[0] + s1[1]) + (s1[2] + s1[3])) + ((s2[0] + s2[1]) + (s2[2] + s2[3])) + ((s3[0] + s3[1]) + (s3[2] + s3[3]));
        const float rstd = rsqrtf(tot * (1.0f / DM) + 1e-6f);
        const h16x4* xr = (const h16x4*)(xh + (size_t)row * DM) + lane; f32x4* orow = (f32x4*)(p.out + (size_t)row * DM) + lane;
#pragma unroll
        for (int j = 0; j < 4; ++j) { const h16x4 v = xr[64 * j]; orow[64 * j] = (f32x4){(float)v[0], (float)v[1], (float)v[2], (float)v[3]} * rstd * g[j]; }
    }
}

#define XB_TMO      128
#define XB_XCNT(j)  (256  + 64 * (j))
#define XB_XSUB(j)  (1280 + 64 * (j))
#define XB_XGEN(j)  (2304 + 64 * (j))
#define XB_TOP      3328
#define XB_TOPGEN   3392
#define XCD_BAR_WORDS 3456
#define XB_SPIN_CAP (1u << 18)

__device__ __forceinline__ unsigned xb_ld(unsigned* p)              { return __hip_atomic_load(p, __ATOMIC_RELAXED, __HIP_MEMORY_SCOPE_AGENT); }
__device__ __forceinline__ unsigned xb_add(unsigned* p, unsigned v) { return __hip_atomic_fetch_add(p, v, __ATOMIC_RELAXED, __HIP_MEMORY_SCOPE_AGENT); }
__device__ __forceinline__ unsigned xb_xcc_id() { return (unsigned)__builtin_amdgcn_s_getreg((3 << 11) | 20) & 0xFu; }
#define XB_SPIN(cond, bar) do { unsigned _sp = 0; while (cond) { __builtin_amdgcn_s_sleep(1); \
    if ((++_sp & 255u) == 0u) { if (xb_ld(&(bar)[XB_TMO])) break; if (_sp > XB_SPIN_CAP) { atomicAdd(&(bar)[XB_TMO], 1u); break; } } } } while (0)

struct XcdBarrier {
    unsigned* bar; unsigned x;
    volatile LAS unsigned* st;
};

__device__ __forceinline__ XcdBarrier xcd_barrier_post(unsigned* bar, volatile LAS unsigned* st) {
    XcdBarrier b; b.bar = bar; b.x = xb_xcc_id(); b.st = st;
    if (threadIdx.x == 0) (void)xb_add(&bar[XB_XCNT(b.x)], 1u);
    return b;
}
__device__ __forceinline__ void xcd_barrier_complete(unsigned* bar, unsigned x, unsigned& nloc, unsigned& nx) {
    const unsigned G = gridDim.x * gridDim.y * gridDim.z;
    unsigned sum, cnt, mine, sp = 0u;
    for (;;) {
        sum = 0u; cnt = 0u; mine = 0u;
#pragma unroll
        for (unsigned j = 0; j < 16; ++j) { const unsigned c = xb_ld(&bar[XB_XCNT(j)]); sum += c; cnt += (c > 0u) ? 1u : 0u; mine = (j == x) ? c : mine; }
        if (sum == G) break;
        __builtin_amdgcn_s_sleep(1);
        if ((++sp & 255u) == 0u) { if (xb_ld(&bar[XB_TMO])) break; if (sp > XB_SPIN_CAP) { atomicAdd(&bar[XB_TMO], 1u); break; } }
    }
    nloc = mine > 0u ? mine : 1u; nx = cnt > 0u ? cnt : 1u;
}

__device__ __forceinline__ void xcd_barrier(const XcdBarrier& b) {
    asm volatile("s_waitcnt vmcnt(0)" ::: "memory");
    __syncthreads();
    if (threadIdx.x == 0) {
        unsigned* bar = b.bar;
        __builtin_amdgcn_s_waitcnt(0);
        unsigned nloc = b.st[0], nx = b.st[1];
        if (nloc == 0u) { xcd_barrier_complete(bar, b.x, nloc, nx); b.st[0] = nloc; b.st[1] = nx; }
        const unsigned old = xb_add(&bar[XB_XSUB(b.x)], 1u);
        const unsigned gen = old / nloc;
        if (old + 1u == (gen + 1u) * nloc) {
            __builtin_amdgcn_fence(__ATOMIC_RELEASE, "agent");
            asm volatile("s_waitcnt vmcnt(0)" ::: "memory");
            const unsigned og = xb_add(&bar[XB_TOP], 1u);
            const unsigned tg = og / nx;
            if (og + 1u == (tg + 1u) * nx) xb_add(&bar[XB_TOPGEN], 1u);
            else XB_SPIN(xb_ld(&bar[XB_TOPGEN]) == tg, bar);
            __builtin_amdgcn_fence(__ATOMIC_ACQUIRE, "agent");
            xb_add(&bar[XB_XGEN(b.x)], 1u);
            asm volatile("s_waitcnt vmcnt(0)" ::: "memory");
        } else {
            XB_SPIN(xb_ld(&bar[XB_XGEN(b.x)]) == gen, bar);
            __builtin_amdgcn_fence(__ATOMIC_ACQUIRE, "agent");
            asm volatile("s_waitcnt vmcnt(0)" ::: "memory");
        }
    }
    __syncthreads();
}


__global__ void __launch_bounds__(NTHREADS) hymba_fwd(Params p) {
    extern __shared__ __attribute__((aligned(16))) unsigned char lds[];
    cg::grid_group grid = cg::this_grid();
    volatile LAS unsigned* bst = (volatile LAS unsigned*)((LAS unsigned char*)lds + BAR_LDS_OFF);
    if (threadIdx.x < 2) bst[threadIdx.x] = 0u;
    __syncthreads();
    XcdBarrier xbar = xcd_barrier_post((unsigned*)(p.ws + WS_CTL), bst);
#define RUN_PHASE(k, body) do { if (p.ph_lo <= (k) && (k) < p.ph_hi) { body; if ((k) + 1 < p.ph_hi) { xcd_barrier(xbar); } } } while (0)
    RUN_PHASE(0, phase_prologue(p, lds));
    RUN_PHASE(1, gemm_in(p, 0, lds));
    RUN_PHASE(2, phase_mixers(p, 0, lds));
    RUN_PHASE(3, gemm_out<0>(p, lds));
    RUN_PHASE(4, gemm_in(p, 1, lds));
    RUN_PHASE(5, phase_mixers(p, 1, lds));
    RUN_PHASE(6, gemm_out<1>(p, lds));
    RUN_PHASE(7, phase_final(p));
#undef RUN_PHASE
}

extern "C" void kernel_launch(void* const* d_in, const int* in_sizes, int n_in, void* d_out, int out_size, void* d_ws, size_t ws_size, hipStream_t stream) {
    static int grid_blocks = 0;
    if (!grid_blocks) {
        int dev = 0, cus = 0, per_cu = 0;
        hipGetDevice(&dev);
        hipDeviceGetAttribute(&cus, hipDeviceAttributeMultiprocessorCount, dev);
        hipFuncSetAttribute((const void*)hymba_fwd, hipFuncAttributeMaxDynamicSharedMemorySize, LDS_BYTES);
        hipOccupancyMaxActiveBlocksPerMultiprocessor(&per_cu, (const void*)hymba_fwd, NTHREADS, LDS_BYTES);
        if (per_cu < 1) per_cu = 1;
        grid_blocks = cus * per_cu;
        if (ws_size < WS_END) fprintf(stderr, "kernel_launch: workspace too small (%zu < %zu)\n", ws_size, (size_t)WS_END);
    }
    Params p{};
    p.x = (const float*)d_in[0]; p.norm_g = (const float*)d_in[1]; p.w_in = (const float*)d_in[2]; p.conv_w = (const float*)d_in[3]; p.conv_b = (const float*)d_in[4];
    p.ln_g = (const float*)d_in[5]; p.ln_b = (const float*)d_in[6]; p.pw_w = (const float*)d_in[7]; p.pw_b = (const float*)d_in[8]; p.w_out = (const float*)d_in[9];
    p.final_g = (const float*)d_in[10]; p.out = (float*)d_out; p.ws = (unsigned char*)d_ws;
    (void)hipMemsetAsync((char*)d_ws + WS_CTL, 0, 32768, stream);
#if ONE_LAUNCH
    p.ph_lo = 0; p.ph_hi = NPHASES;
    { void* args[] = {&p};
      hipError_t e = hipLaunchCooperativeKernel((const void*)hymba_fwd, dim3(grid_blocks), dim3(NTHREADS), args, LDS_BYTES, stream);
      if (e != hipSuccess) fprintf(stderr, "cooperative launch failed: %s (grid %d)\n", hipGetErrorString(e), grid_blocks); }
#else
    for (int ph = 0; ph < NPHASES; ++ph) {
        p.ph_lo = ph; p.ph_hi = ph + 1; void* args[] = {&p};
        hipError_t e = hipLaunchCooperativeKernel((const void*)hymba_fwd, dim3(grid_blocks), dim3(NTHREADS), args, LDS_BYTES, stream);
        if (e != hipSuccess) { fprintf(stderr, "cooperative launch failed: %s (grid %d, phase %d)\n", hipGetErrorString(e), grid_blocks, ph); break; }
    }
#endif
}
```

```cpp
#include <hip/hip_runtime.h>
#include <hip/hip_cooperative_groups.h>
#include <cstdio>
#include <cstdint>
namespace cg = cooperative_groups;

#ifndef ONE_LAUNCH
#define ONE_LAUNCH 1
#endif

typedef _Float16 h16;
typedef _Float16 h16x8 __attribute__((ext_vector_type(8)));
typedef _Float16 h16x4 __attribute__((ext_vector_type(4)));
typedef __bf16 b16x8 __attribute__((ext_vector_type(8)));
typedef float f32x16 __attribute__((ext_vector_type(16)));
typedef float f32x4 __attribute__((ext_vector_type(4)));
typedef unsigned u32x4 __attribute__((ext_vector_type(4)));

constexpr int BATCH = 8, SEQ = 4096, DM = 1024, MROWS = BATCH * SEQ, NIN = 3840, DEPTH = 2;
constexpr int C_AVAL = 0, C_AGLU = 256, C_AGATE = 512, C_RQ = 768, C_RK = 1024, C_RV = 1280, C_RGATE = 1536, C_MQ = 1792, C_MK = 2304, C_MV = 2816, C_MGATE = 3328;
constexpr int NPART = 16;
constexpr int NTHREADS = 512;
constexpr int LDS_BYTES = 147456;
constexpr int NPHASES = 8;

constexpr size_t MiB = 1u << 20;
constexpr size_t WS_XH = 0, WS_PROJ = 64 * MiB, WS_MIX = 304 * MiB, WS_WIN = 368 * MiB, WS_WOUT = 383 * MiB, WS_WPW = 387 * MiB,
                 WS_KV = 388 * MiB, WS_KMEAN = 404 * MiB  , WS_ROWSS = 405 * MiB, WS_CTL = 408 * MiB  , WS_RST = 409 * MiB  , WS_END = 417 * MiB;
constexpr int BAR_LDS_OFF = LDS_BYTES - 64;

struct Params {
    const float *x, *norm_g, *w_in, *conv_w, *conv_b, *ln_g, *ln_b, *pw_w, *pw_b, *w_out, *final_g;
    float* out; unsigned char* ws;
    int ph_lo, ph_hi;
};

__device__ __forceinline__ float silu_f(float v) { return v * __builtin_amdgcn_rcpf(1.0f + __expf(-v)); }
__device__ __forceinline__ int crow(int r, int h) { return (r & 3) + 8 * (r >> 2) + 4 * h; }
__device__ __forceinline__ float wave_sum(float v) {
#pragma unroll
    for (int o = 1; o < 64; o <<= 1) v += __shfl_xor(v, o);
    return v;
}

__device__ __forceinline__ void transpose_unit(const float* W, int K, int N, h16* WT, const float* g, int k0, int n0, float* tile) {
    const int tid = threadIdx.x;
    __syncthreads();
#pragma unroll
    for (int i = 0; i < 8; ++i) { const int k = i * 8 + (tid >> 6), n = tid & 63; float v = W[(size_t)(k0 + k) * N + n0 + n]; if (g) v *= g[k0 + k]; tile[k * 65 + n] = v; }
    __syncthreads();
    { const int n = tid >> 3, kc = tid & 7; h16x8 w;
#pragma unroll
        for (int i = 0; i < 8; ++i) w[i] = (h16)tile[(kc * 8 + i) * 65 + n];
        *(h16x8*)(WT + (size_t)(n0 + n) * K + k0 + kc * 8) = w; }
}

__device__ __forceinline__ void phase_prologue(const Params& p, unsigned char* lds) {
    float* tile = (float*)lds;
    h16* win = (h16*)(p.ws + WS_WIN);
    constexpr int U_IN = 16 * 60;
    for (int r = blockIdx.x; r < U_IN; r += gridDim.x)
        transpose_unit(p.w_in, DM, NIN, win, p.norm_g, (r / 60) * 64, (r % 60) * 64, tile);
    h16* xh = (h16*)(p.ws + WS_XH); float* rowss = (float*)(p.ws + WS_ROWSS);
    const int lane = threadIdx.x & 63, wid = threadIdx.x >> 6;
    for (int row = blockIdx.x * 8 + wid; row < MROWS; row += gridDim.x * 8) {
        const f32x4* xr = (const f32x4*)(p.x + (size_t)row * DM) + lane;
        float ss = 0.f;
#pragma unroll
        for (int j = 0; j < 4; ++j) { const f32x4 v = xr[64 * j]; ss += v.x * v.x + v.y * v.y + v.z * v.z + v.w * v.w;
            h16x4 o; o.x = (h16)v.x; o.y = (h16)v.y; o.z = (h16)v.z; o.w = (h16)v.w; *((h16x4*)(xh + (size_t)row * DM) + lane + 64 * j) = o; }
        ss = wave_sum(ss);
        if (lane < NPART) rowss[(size_t)row * NPART + lane] = (lane == 0) ? ss : 0.f;
    }
}

typedef short s16x4 __attribute__((ext_vector_type(4)));
#define LAS __attribute__((address_space(3)))
__device__ __forceinline__ float xhalf_max(float v) { auto rr = __builtin_amdgcn_permlane32_swap(__float_as_uint(v), __float_as_uint(v), false, false); return fmaxf(__uint_as_float(rr[0]), __uint_as_float(rr[1])); }
__device__ __forceinline__ float xhalf_sum(float v) { auto rr = __builtin_amdgcn_permlane32_swap(__float_as_uint(v), __float_as_uint(v), false, false); return __uint_as_float(rr[0]) + __uint_as_float(rr[1]); }
__device__ __forceinline__ h16x8 tr_frag(const LAS unsigned char* a) {
    const s16x4 lo = __builtin_amdgcn_ds_read_tr16_b64_v4i16((LAS s16x4*)a), hi = __builtin_amdgcn_ds_read_tr16_b64_v4i16((LAS s16x4*)(a + 512));
    typedef short s16x8 __attribute__((ext_vector_type(8)));
    const s16x8 v = __builtin_shufflevector(lo, hi, 0, 1, 2, 3, 4, 5, 6, 7);
    return __builtin_bit_cast(h16x8, v);
}
#define CROW0(i) (((i) & 3) + 8 * ((i) >> 2))
__device__ __forceinline__ float fadd_s(float a, float b) { float r; asm("v_add_f32_e32 %0, %1, %2" : "=v"(r) : "v"(a), "v"(b)); return r; }
__device__ __forceinline__ void glds16(const void* gsrc, unsigned lds_dst) { unsigned keep;
    asm volatile("s_mov_b32 %0, m0\n\ts_mov_b32 m0, %2\n\ts_nop 0\n\tglobal_load_lds_dwordx4 %1, off\n\ts_mov_b32 m0, %0" : "=&s"(keep) : "v"(gsrc), "s"(lds_dst) : "memory"); }

typedef __bf16 b16x2 __attribute__((ext_vector_type(2)));
typedef float f32x2_ __attribute__((ext_vector_type(2)));
__device__ __forceinline__ unsigned pk_bf16(float lo, float hi) { const f32x2_ v = {lo, hi}; return __builtin_bit_cast(unsigned, __builtin_convertvector(v, b16x2)); }
__device__ __forceinline__ unsigned cvt_pk_bf16(float lo, float hi) { unsigned r; asm("v_cvt_pk_bf16_f32 %0, %1, %2" : "=v"(r) : "v"(lo), "v"(hi)); return r; }
namespace pg8 {
#define PG8_LAS __attribute__((address_space(3)))
typedef _Float16 bf16_t;
typedef _Float16 bf16x8 __attribute__((ext_vector_type(8)));
typedef float f32x4 __attribute__((ext_vector_type(4)));
typedef unsigned u32x4 __attribute__((ext_vector_type(4)));
constexpr int BM = 256, BK = 64, HALF = 128, HTB = HALF * BK * 2  , STAGE_BYTES = 8 * HTB, NXCD = 8, WGM = 8;

__host__ __device__ __forceinline__ int lds_byte(int r, int c) { const int st = (r >> 4) * 2 + (c >> 5), rr = r & 15, cc = c & 31, ob = rr * 64 + cc * 2; return st * 1024 + (ob ^ (((ob >> 9) & 1) << 5)); }
__host__ __device__ __forceinline__ void stage_rc(int b, int& R, int& C) { const int st = b / 1024, sb = b % 1024, swz = sb ^ (((sb >> 9) & 1) << 5); R = (st >> 1) * 16 + swz / 64; C = (st & 1) * 32 + (swz % 64) / 2; }
__host__ __device__ __forceinline__ int perm32(int rho) { const int n = rho >> 4, i = rho & 15; return 8 * (i >> 2) + 4 * n + (i & 3); }

struct Unit { int pm, pn; };
struct Gemm { const bf16_t* A; const bf16_t* Bt; int M, N, K; };

struct StaticOrder {
    int nM, nN, nwg, G, c;
    __host__ __device__ void init(int M, int N, int G_, int c_) { nM = M / BM; nN = N / BM; nwg = nM * nN; G = G_; c = c_; }
    __host__ __device__ bool next(int i, Unit& u) const {
        const long L = (long)i * G + c; if (L >= nwg) return false;
        int wgid = (int)L; { const int q = nwg / NXCD, r = nwg % NXCD, xcd = wgid % NXCD, off = wgid / NXCD; wgid = (xcd < r ? xcd * (q + 1) : r * (q + 1) + (xcd - r) * q) + off; }
        const int nig = WGM * nN, gid = wgid / nig, fm = gid * WGM, gsz = (nM - fm) < WGM ? (nM - fm) : WGM;
        u.pm = fm + ((wgid % nig) % gsz); u.pn = (wgid % nig) / gsz; return true;
    }
    __device__ __forceinline__ void a_ready(const Unit&) const {}
    __device__ __forceinline__ void done(const Unit&) const {}
};

template <class Epi, class Sched, bool ALIGN_EPI = false, bool SP2 = false>
__device__ __forceinline__ void gemm_phase(PG8_LAS unsigned char* lds, const Gemm g, const Sched& S, const Epi& E) {
    const int tid = threadIdx.x, wid = __builtin_amdgcn_readfirstlane(tid >> 6), lane = tid & 63, wr = wid >> 2, wc = wid & 3, fr = lane & 15, fq = lane >> 4;
    const int K = g.K, nt = K / BK;
    unsigned voffA[2], voffB[2];
#pragma unroll
    for (int i = 0; i < 2; ++i) { int R, C; stage_rc(tid * 16 + i * 8192, R, C); const int Rb = Epi::PERM ? ((R & ~31) + perm32(R & 31)) : R;
        voffA[i] = (unsigned)(R * K + C) * 2u; voffB[i] = (unsigned)(Rb * K + C) * 2u; }
    const size_t kstep = (size_t)(BK * 2);
    const size_t hstep = (size_t)HALF * K * 2;
    const size_t tstep = 2 * hstep;
    const unsigned ldsw = (unsigned)wid * 1024u;
    const int aoff = lds_byte(wr * 64 + fr, fq * 8), boff = lds_byte(wc * 32 + fr, fq * 8);
#define PG8_SA(b, h) (((b) * 2 + (h)) * HTB)
#define PG8_SB(b, h) ((4 + (b) * 2 + (h)) * HTB)
#define PG8_STAGE(bufoff, gbase, voff) do { _Pragma("unroll") for (int _i = 0; _i < 2; ++_i) \
        __builtin_amdgcn_global_load_lds((const unsigned*)((const char*)(gbase) + (voff)[_i]), (PG8_LAS unsigned*)(lds + (bufoff) + ldsw + _i * 8192), 16, 0, 0); } while (0)
#define PG8_LDA(dst, b, h) do { _Pragma("unroll") for (int m = 0; m < 4; ++m) _Pragma("unroll") for (int k = 0; k < 2; ++k) dst[m][k] = *(const PG8_LAS bf16x8*)(lds + PG8_SA(b, h) + aoff + m * 2048 + k * 1024); } while (0)
#define PG8_LDB(dst, b, h) do { _Pragma("unroll") for (int n = 0; n < 2; ++n) _Pragma("unroll") for (int k = 0; k < 2; ++k) dst[n][k] = *(const PG8_LAS bf16x8*)(lds + PG8_SB(b, h) + boff + n * 2048 + k * 1024); } while (0)
#define PG8_MMA(ai, bj, At, Bt) do { __builtin_amdgcn_s_setprio(1); _Pragma("unroll") for (int m = 0; m < 4; ++m) _Pragma("unroll") for (int n = 0; n < 2; ++n) _Pragma("unroll") for (int k = 0; k < 2; ++k) \
        acc[ai][bj][m][n] = __builtin_amdgcn_mfma_f32_16x16x32_f16(Bt[n][k], At[m][k], acc[ai][bj][m][n], 0, 0, 0); __builtin_amdgcn_s_setprio(0); } while (0)
#define PG8_WAIT_V(n) asm volatile("s_waitcnt vmcnt(" #n ")" ::: "memory")
#define PG8_WAIT_L(n) asm volatile("s_waitcnt lgkmcnt(" #n ")" ::: "memory")
#define PG8_BAR __builtin_amdgcn_s_barrier()
#define PG8_SCHED __builtin_amdgcn_sched_barrier(0)
    Unit cur, nxt; int ui = 0;
    if (!S.next(0, cur)) return;
    f32x4 acc[2][2][4][2];
#pragma unroll
    for (int a = 0; a < 2; ++a)
#pragma unroll
        for (int b = 0; b < 2; ++b)
#pragma unroll
            for (int m = 0; m < 4; ++m)
#pragma unroll
                for (int n = 0; n < 2; ++n) acc[a][b][m][n] = (f32x4){0.f, 0.f, 0.f, 0.f};
    bf16x8 At[4][2], B0[2][2], B1[2][2];
    const char* cA = (const char*)g.A + (size_t)cur.pm * tstep; const char* cB = (const char*)g.Bt + (size_t)cur.pn * tstep;
    S.a_ready(cur);
    if constexpr (SP2) {
        PG8_STAGE(PG8_SB(0, 0), cB, voffB); PG8_STAGE(PG8_SB(0, 1), cB + hstep, voffB); PG8_STAGE(PG8_SA(0, 0), cA, voffA); PG8_STAGE(PG8_SA(0, 1), cA + hstep, voffA);
        if (wr == 1) PG8_BAR;
        PG8_WAIT_V(2); PG8_BAR;
        PG8_STAGE(PG8_SB(1, 0), cB + kstep, voffB); PG8_STAGE(PG8_SA(1, 0), cA + kstep, voffA); PG8_STAGE(PG8_SB(1, 1), cB + hstep + kstep, voffB);
        PG8_WAIT_V(6); PG8_BAR;
    } else {
        PG8_STAGE(PG8_SB(0, 0), cB, voffB); PG8_STAGE(PG8_SA(0, 0), cA, voffA); PG8_STAGE(PG8_SB(0, 1), cB + hstep, voffB); PG8_STAGE(PG8_SA(0, 1), cA + hstep, voffA);
        if (wr == 1) PG8_BAR;
        PG8_WAIT_V(4); PG8_BAR;
        PG8_STAGE(PG8_SB(1, 0), cB + kstep, voffB); PG8_STAGE(PG8_SA(1, 0), cA + kstep, voffA); PG8_STAGE(PG8_SB(1, 1), cB + hstep + kstep, voffB);
        PG8_WAIT_V(6); PG8_BAR;
    }
    for (;;) {
        const bool has_next = S.next(ui + 1, nxt);
        const char* nA = has_next ? (const char*)g.A + (size_t)nxt.pm * tstep : cA; const char* nB = has_next ? (const char*)g.Bt + (size_t)nxt.pn * tstep : cB;
        for (int t = 0; t < nt; t += 2) {
            const bool last = (t == nt - 2);
            const char* a1 = cA + (size_t)(t + 1) * kstep;
            const char* a2 = last ? nA : cA + (size_t)(t + 2) * kstep; const char* b2 = last ? nB : cB + (size_t)(t + 2) * kstep;
            const char* a3 = a2 + kstep; const char* b3 = b2 + kstep;
            if (last && has_next) S.a_ready(nxt);
            if constexpr (SP2) {
            PG8_LDB(B0, 0, 0); PG8_LDB(B1, 0, 1); PG8_SCHED; PG8_LDA(At, 0, 0); PG8_STAGE(PG8_SA(1, 1), a1 + hstep, voffA);
            PG8_WAIT_V(8); PG8_WAIT_L(0); PG8_BAR; PG8_MMA(0, 0, At, B0); PG8_MMA(0, 1, At, B1); PG8_BAR; PG8_SCHED;
            PG8_LDA(At, 0, 1); PG8_STAGE(PG8_SB(0, 0), b2, voffB); PG8_STAGE(PG8_SB(0, 1), b2 + hstep, voffB); PG8_STAGE(PG8_SA(0, 0), a2, voffA);
            PG8_WAIT_V(8); PG8_WAIT_L(0); PG8_BAR; PG8_MMA(1, 0, At, B0); PG8_MMA(1, 1, At, B1); PG8_BAR; PG8_SCHED;
            PG8_LDB(B0, 1, 0); PG8_LDB(B1, 1, 1); PG8_SCHED; PG8_LDA(At, 1, 0); PG8_STAGE(PG8_SA(0, 1), a2 + hstep, voffA);
            PG8_WAIT_V(8); PG8_WAIT_L(0); PG8_BAR; PG8_MMA(0, 0, At, B0); PG8_MMA(0, 1, At, B1); PG8_BAR; PG8_SCHED;
            PG8_LDA(At, 1, 1); PG8_STAGE(PG8_SB(1, 0), b3, voffB); PG8_STAGE(PG8_SB(1, 1), b3 + hstep, voffB); PG8_STAGE(PG8_SA(1, 0), a3, voffA);
            PG8_WAIT_V(8); PG8_WAIT_L(0); PG8_BAR; PG8_MMA(1, 0, At, B0); PG8_MMA(1, 1, At, B1); PG8_BAR; PG8_SCHED;
            } else {
            PG8_LDB(B0, 0, 0); PG8_SCHED; PG8_LDA(At, 0, 0); PG8_STAGE(PG8_SA(1, 1), a1 + hstep, voffA);
            PG8_WAIT_L(8); PG8_BAR; PG8_WAIT_L(0); PG8_MMA(0, 0, At, B0); PG8_BAR; PG8_SCHED;
            PG8_LDB(B1, 0, 1); PG8_STAGE(PG8_SB(0, 0), b2, voffB);
            PG8_BAR; PG8_WAIT_L(0); PG8_MMA(0, 1, At, B1); PG8_BAR;
            PG8_LDA(At, 0, 1); PG8_STAGE(PG8_SA(0, 0), a2, voffA);
            PG8_BAR; PG8_WAIT_L(0); PG8_MMA(1, 0, At, B0); PG8_BAR; PG8_SCHED;
            PG8_STAGE(PG8_SB(0, 1), b2 + hstep, voffB);
            PG8_WAIT_V(6); PG8_BAR; PG8_MMA(1, 1, At, B1); PG8_BAR;
            PG8_LDB(B0, 1, 0); PG8_SCHED; PG8_LDA(At, 1, 0); PG8_STAGE(PG8_SA(0, 1), a2 + hstep, voffA);
            PG8_WAIT_L(8); PG8_BAR; PG8_WAIT_L(0); PG8_MMA(0, 0, At, B0); PG8_BAR; PG8_SCHED;
            PG8_LDB(B1, 1, 1); PG8_STAGE(PG8_SB(1, 0), b3, voffB);
            PG8_BAR; PG8_WAIT_L(0); PG8_MMA(0, 1, At, B1); PG8_BAR;
            PG8_LDA(At, 1, 1); PG8_STAGE(PG8_SA(1, 0), a3, voffA);
            PG8_BAR; PG8_WAIT_L(0); PG8_MMA(1, 0, At, B0); PG8_BAR; PG8_SCHED;
            PG8_STAGE(PG8_SB(1, 1), b3 + hstep, voffB);
            PG8_WAIT_V(6); PG8_BAR; PG8_MMA(1, 1, At, B1); PG8_BAR;
            }
        }
        if constexpr (ALIGN_EPI) { if (wr == 0) PG8_BAR; }
        if constexpr (!Epi::AFTER_DRAIN) { E(acc, cur, wr, wc, fr, fq); S.done(cur); }
        if (!has_next) break;
#pragma unroll
        for (int a = 0; a < 2; ++a)
#pragma unroll
            for (int b = 0; b < 2; ++b)
#pragma unroll
                for (int m = 0; m < 4; ++m)
#pragma unroll
                    for (int n = 0; n < 2; ++n) acc[a][b][m][n] = (f32x4){0.f, 0.f, 0.f, 0.f};
        cur = nxt; cA = nA; cB = nB; ++ui;
        if constexpr (ALIGN_EPI) { if (wr == 1) PG8_BAR; }
    }
    PG8_WAIT_V(0);
    if constexpr (!ALIGN_EPI) { if (wr == 0) PG8_BAR; }
    PG8_BAR;
    if constexpr (Epi::AFTER_DRAIN) { E.fused(acc, cur, wr, wc, fr, fq, lds, wid, lane); S.done(cur); }
#undef PG8_SA
#undef PG8_SB
#undef PG8_STAGE
#undef PG8_LDA
#undef PG8_LDB
#undef PG8_MMA
#undef PG8_WAIT_V
#undef PG8_WAIT_L
#undef PG8_BAR
#undef PG8_SCHED
}

struct EpiProj {
    static constexpr bool PERM = true, AFTER_DRAIN = false;
    bf16_t* O; const float* rowss; float* kmpart; unsigned* kmaxh;
    __device__ __forceinline__ void operator()(const f32x4 (&acc)[2][2][4][2], const Unit& u, int wr, int wc, int fr, int fq) const {
        const int row0 = u.pm * BM + wr * 64 + fr, col0 = u.pn * BM + wc * 32 + 8 * fq;
        const bool want_km = (u.pn == 9) || (u.pn == 10);
        const bool as_bf16 = (u.pn == 11) || (u.pn == 12);
        float kn[2] = {0.f, 0.f};
        f32x4 cs[2][2];
#pragma unroll
        for (int bj = 0; bj < 2; ++bj)
#pragma unroll
            for (int n = 0; n < 2; ++n) cs[bj][n] = (f32x4){0.f, 0.f, 0.f, 0.f};
#pragma unroll
        for (int ai = 0; ai < 2; ++ai)
#pragma unroll
            for (int m = 0; m < 4; ++m) { const size_t row = (size_t)(row0 + ai * HALF + m * 16);
                const f32x4* rs = (const f32x4*)(rowss + row * 16); const f32x4 s0 = rs[0], s1 = rs[1], s2 = rs[2], s3 = rs[3];
                const float tot = ((s0[0] + s0[1]) + (s0[2] + s0[3])) + ((s1[0] + s1[1]) + (s1[2] + s1[3])) + ((s2[0] + s2[1]) + (s2[2] + s2[3])) + ((s3[0] + s3[1]) + (s3[2] + s3[3]));
                const float rstd = rsqrtf(tot * (1.0f / 1024.0f) + 1e-6f);
                bf16_t* rowp = O + row * 3840 + col0;
#pragma unroll
                for (int bj = 0; bj < 2; ++bj) { const f32x4 v0 = acc[ai][bj][m][0] * rstd, v1 = acc[ai][bj][m][1] * rstd;
                    if (as_bf16) { const u32x4 wb = {cvt_pk_bf16(v0[0], v0[1]), cvt_pk_bf16(v0[2], v0[3]), cvt_pk_bf16(v1[0], v1[1]), cvt_pk_bf16(v1[2], v1[3])}; *(u32x4*)(rowp + bj * HALF) = wb; }
                    else { bf16x8 w;
                    w[0] = (bf16_t)v0[0]; w[1] = (bf16_t)v0[1]; w[2] = (bf16_t)v0[2]; w[3] = (bf16_t)v0[3]; w[4] = (bf16_t)v1[0]; w[5] = (bf16_t)v1[1]; w[6] = (bf16_t)v1[2]; w[7] = (bf16_t)v1[3];
                    *(bf16x8*)(rowp + bj * HALF) = w; }
                    cs[bj][0] += v0; cs[bj][1] += v1;
                    if (want_km) { float q = ((v0[0] * v0[0] + v0[1] * v0[1]) + (v0[2] * v0[2] + v0[3] * v0[3])) + ((v1[0] * v1[0] + v1[1] * v1[1]) + (v1[2] * v1[2] + v1[3] * v1[3]));
                        q += __shfl_xor(q, 16); q += __shfl_xor(q, 32); kn[bj] = fmaxf(kn[bj], q); } } }
        if (want_km) {
#pragma unroll
            for (int bj = 0; bj < 2; ++bj)
#pragma unroll
                for (int n = 0; n < 2; ++n)
#pragma unroll
                    for (int k = 0; k < 4; ++k) { float v = cs[bj][n][k]; v += __shfl_xor(v, 1); v += __shfl_xor(v, 2); v += __shfl_xor(v, 4); v += __shfl_xor(v, 8); cs[bj][n][k] = v * (1.0f / 256.0f); }
#pragma unroll
            for (int bj = 0; bj < 2; ++bj) { float q = kn[bj]; q = fmaxf(q, __shfl_xor(q, 1)); q = fmaxf(q, __shfl_xor(q, 2)); q = fmaxf(q, __shfl_xor(q, 4)); q = fmaxf(q, __shfl_xor(q, 8));
                if (fr == 0 && fq == 0) atomicMax(kmaxh + (((u.pm >> 4) * 8 + (u.pn - 9) * 4 + bj * 2 + (wc >> 1)) * 2 + (wc & 1)), __float_as_uint(q)); }
            if (fr == 0) {
#pragma unroll
                for (int bj = 0; bj < 2; ++bj)
#pragma unroll
                    for (int n = 0; n < 2; ++n) { const int cm = col0 + bj * HALF + 4 * n - 2304;
                        *(f32x4*)(kmpart + ((size_t)((wr * 8 + (u.pm >> 4)) * 8 + (cm >> 6)) * 16 + (u.pm & 15)) * 64 + (cm & 63)) = cs[bj][n]; }
            }
        }
    }
};
template <int LAYER> struct EpiRes {
    static constexpr bool PERM = true, AFTER_DRAIN = false;
    const float* x0; float* xout; bf16_t* xh; float* rowss;
    __device__ __forceinline__ void operator()(const f32x4 (&acc)[2][2][4][2], const Unit& u, int wr, int wc, int fr, int fq) const {
        const int row0 = u.pm * BM + wr * 64 + fr, col0 = u.pn * BM + wc * 32 + 8 * fq;
#pragma unroll
        for (int ai = 0; ai < 2; ++ai) {
            bf16x8 xq[4][2];
#pragma unroll
            for (int m = 0; m < 4; ++m)
#pragma unroll
                for (int bj = 0; bj < 2; ++bj) xq[m][bj] = *(const bf16x8*)(xh + (size_t)(row0 + ai * HALF + m * 16) * 1024 + col0 + bj * HALF);
#pragma unroll
            for (int m = 0; m < 4; ++m) { const size_t row = (size_t)(row0 + ai * HALF + m * 16); float ss = 0.f;
#pragma unroll
                for (int bj = 0; bj < 2; ++bj) { const size_t off = row * 1024 + col0 + bj * HALF; const bf16x8 xp = xq[m][bj];
                    const f32x4 v0 = (f32x4){(float)xp[0], (float)xp[1], (float)xp[2], (float)xp[3]} + acc[ai][bj][m][0], v1 = (f32x4){(float)xp[4], (float)xp[5], (float)xp[6], (float)xp[7]} + acc[ai][bj][m][1];
                    bf16x8 w; w[0] = (bf16_t)v0[0]; w[1] = (bf16_t)v0[1]; w[2] = (bf16_t)v0[2]; w[3] = (bf16_t)v0[3]; w[4] = (bf16_t)v1[0]; w[5] = (bf16_t)v1[1]; w[6] = (bf16_t)v1[2]; w[7] = (bf16_t)v1[3];
                    *(bf16x8*)(xh + off) = w;
                    ss += ((v0[0] * v0[0] + v0[1] * v0[1]) + (v0[2] * v0[2] + v0[3] * v0[3])) + ((v1[0] * v1[0] + v1[1] * v1[1]) + (v1[2] * v1[2] + v1[3] * v1[3])); }
                ss += __shfl_xor(ss, 16); ss += __shfl_xor(ss, 32);
                if (fq == 0) rowss[row * 16 + u.pn * 4 + wc] = ss; }
            asm volatile("" ::: "memory");
        }
    }
};
}


__device__ __forceinline__ void deferred_transposes(const Params& p, unsigned char* lds, int id, int n) {
    float* tile = (float*)lds;
    h16* win = (h16*)(p.ws + WS_WIN); h16* wout = (h16*)(p.ws + WS_WOUT); h16* wpw = (h16*)(p.ws + WS_WPW);
    constexpr int U_IN = 16 * 60, U_OUT = 16 * 16, U_PW = 4 * 4;
    for (int u = id; u < U_IN + 2 * U_OUT + 2 * U_PW; u += n) {
        int r = u;
        if (r < U_IN) { transpose_unit(p.w_in + (size_t)DM * NIN, DM, NIN, win + (size_t)NIN * DM, p.norm_g + DM, (r / 60) * 64, (r % 60) * 64, tile); continue; }
        r -= U_IN;
        if (r < 2 * U_OUT) { const int layer = r / U_OUT; r %= U_OUT; transpose_unit(p.w_out + (size_t)layer * DM * DM, DM, DM, wout + (size_t)layer * DM * DM, nullptr, (r / 16) * 64, (r % 16) * 64, tile); continue; }
        r -= 2 * U_OUT;
        { const int layer = r / U_PW; r %= U_PW; transpose_unit(p.pw_w + (size_t)layer * 256 * 256, 256, 256, wpw + (size_t)layer * 256 * 256, nullptr, (r / 4) * 64, (r % 4) * 64, tile); }
    }
}

__device__ __forceinline__ void gemm_in(const Params& p, int layer, unsigned char* lds) {
    pg8::Gemm g{(const h16*)(p.ws + WS_XH), (const h16*)(p.ws + WS_WIN) + (size_t)layer * NIN * DM, MROWS, NIN, DM};
    pg8::StaticOrder S; S.init(MROWS, NIN, (int)gridDim.x, (int)blockIdx.x);
    pg8::EpiProj E{(h16*)(p.ws + WS_PROJ), (const float*)(p.ws + WS_ROWSS), (float*)(p.ws + WS_KMEAN), (unsigned*)(p.ws + WS_CTL + 20480) + layer * 128};
    pg8::gemm_phase<pg8::EpiProj, pg8::StaticOrder, true, true>((PG8_LAS unsigned char*)lds, g, S, E);
    if (layer == 0) { const int G = (int)gridDim.x, nfull = (MROWS / 256) * (NIN / 256) % G;
        if (nfull == 0) deferred_transposes(p, lds, (int)blockIdx.x, G); else if ((int)blockIdx.x >= nfull) deferred_transposes(p, lds, (int)blockIdx.x - nfull, G - nfull); }
}
template <int LAYER> __device__ __forceinline__ void gemm_out(const Params& p, unsigned char* lds) {
    pg8::Gemm g{(const h16*)(p.ws + WS_MIX), (const h16*)(p.ws + WS_WOUT) + (size_t)LAYER * DM * DM, MROWS, DM, DM};
    pg8::StaticOrder S; S.init(MROWS, DM, (int)gridDim.x, (int)blockIdx.x);
    pg8::EpiRes<LAYER> E{p.x, p.out, (h16*)(p.ws + WS_XH), (float*)(p.ws + WS_ROWSS)};
    pg8::gemm_phase<pg8::EpiRes<LAYER>, pg8::StaticOrder, true, true>((PG8_LAS unsigned char*)lds, g, S, E);
}

__device__ __forceinline__ void phase_stats(const Params& p, int layer, unsigned char* lds_g) {
    LAS unsigned char* lds = (LAS unsigned char*)lds_g;
    const h16* proj = (const h16*)(p.ws + WS_PROJ); float* kv = (float*)(p.ws + WS_KV);
    const int tid = threadIdx.x, lane = tid & 63, wid = __builtin_amdgcn_readfirstlane(tid >> 6), r = lane & 31, hi = lane >> 5;
    const int lanepart = (4 * hi + ((lane & 15) >> 2)) * 64 + ((lane >> 4) & 1) * 32 + (lane & 3) * 8;
#pragma unroll 1
    for (int u = blockIdx.x; u < 256; u += gridDim.x) {
        const int b = u >> 5, hh = (u >> 3) & 3, nq = u & 7;
        const float log_g = logf(1.0f - exp2f(-5.0f - (float)hh));
        h16x8 kk[8], vv[8];
#pragma unroll
        for (int it = 0; it < 8; ++it) {
            const int pc = tid + 512 * it, cn = pc >> 10, key = (pc >> 3) & 127, ch = pc & 7;
            const h16* src = proj + (size_t)(b * SEQ + (4 * nq + cn) * 128 + key) * NIN + hh * 64 + ch * 8;
            kk[it] = *(const h16x8*)(src + C_RK); vv[it] = *(const h16x8*)(src + C_RV);
        }
        __syncthreads();
#pragma unroll
        for (int it = 0; it < 8; ++it) {
            const int pc = tid + 512 * it, cn = pc >> 10, key = (pc >> 3) & 127, ch = pc & 7;
            const float z = __expf(log_g * (float)(127 - key)) * 0.125f;
#pragma unroll
            for (int k = 0; k < 8; ++k) kk[it][k] = (h16)((float)kk[it][k] * z);
            const int off = cn * 32768 + (ch >> 2) * 8192 + (key >> 4) * 1024 + (key & 15) * 64 + (ch & 3) * 16;
            *(LAS h16x8*)(lds + off) = kk[it]; *(LAS h16x8*)(lds + off + 16384) = vv[it];
        }
        __syncthreads();
#pragma unroll
        for (int half = 0; half < 2; ++half) {
            const int cn = 2 * half + (wid >> 2), eb = (wid >> 1) & 1, dbk = wid & 1;
            const LAS unsigned char* kimg = lds + cn * 32768 + dbk * 8192 + lanepart; const LAS unsigned char* vimg = lds + cn * 32768 + 16384 + eb * 8192 + lanepart;
            f32x16 acc;
#pragma unroll
            for (int i = 0; i < 16; ++i) acc[i] = 0.f;
#pragma unroll
            for (int ks = 0; ks < 8; ++ks) acc = __builtin_amdgcn_mfma_f32_32x32x16_f16(tr_frag(vimg + ks * 1024), tr_frag(kimg + ks * 1024), acc, 0, 0, 0);
            float* dst = kv + ((size_t)((b * 4 + hh) * 32 + 4 * nq + cn)) * 4096 + (32 * eb + 4 * hi) * 64 + 32 * dbk + r;
#pragma unroll
            for (int i = 0; i < 16; ++i) dst[CROW0(i) * 64] = acc[i];
        }
    }
}

typedef _Float16 h16x2 __attribute__((ext_vector_type(2)));
typedef float f32x2 __attribute__((ext_vector_type(2)));
__device__ __forceinline__ void conv_unit(const Params& p, int layer, int b, int tt, unsigned char* lds_g) {
    LAS unsigned char* lds = (LAS unsigned char*)lds_g;
    const h16* projb = (const h16*)(p.ws + WS_PROJ) + (size_t)b * SEQ * NIN; h16* mix = (h16*)(p.ws + WS_MIX);
    const int tid = threadIdx.x, lane = tid & 63, wid = __builtin_amdgcn_readfirstlane(tid >> 6), r = lane & 31, hi = lane >> 5;
    const int cp = tid & 127, tg = __builtin_amdgcn_readfirstlane(tid >> 7), t0 = tt * 64;
    constexpr int UIMG = 0  , SIMG = 0, YS = 49152  ;
    {
        h16x8 av[6], gv[6];
#pragma unroll
        for (int it = 0; it < 6; ++it) { const int pi = tid + 512 * it, row = pi >> 5, c8 = pi & 31; const int t = t0 - 30 + row;
            const size_t ro = (size_t)((row < 94 && t >= 0) ? t : 0) * NIN + 8 * c8;
            av[it] = *(const h16x8*)(projb + ro + C_AVAL); gv[it] = *(const h16x8*)(projb + ro + C_AGLU); }
        __syncthreads();
#pragma unroll
        for (int it = 0; it < 6; ++it) { const int pi = tid + 512 * it, row = pi >> 5, c8 = pi & 31; const bool ok = (t0 - 30 + row >= 0);
            h16x8 u;
#pragma unroll
            for (int k = 0; k < 8; ++k) u[k] = ok ? (h16)((float)av[it][k] * __builtin_amdgcn_rcpf(1.0f + __expf(-(float)gv[it][k]))) : (h16)0.f;
            if (row < 94) *(LAS h16x8*)(lds + UIMG + row * 512 + c8 * 16) = u; }
    }
    float y0[16], y1[16];
    {
        float w0[31], w1[31]; const float* cw = p.conv_w + (size_t)layer * 31 * 256 + 2 * cp;
#pragma unroll
        for (int jj = 0; jj < 31; ++jj) { const f32x2 wv = *(const f32x2*)(cw + jj * 256); w0[jj] = wv[0]; w1[jj] = wv[1]; }
        const f32x2 cbv = *(const f32x2*)(p.conv_b + layer * 256 + 2 * cp);
#pragma unroll
        for (int tl = 0; tl < 16; ++tl) { y0[tl] = cbv[0]; y1[tl] = cbv[1]; }
        __syncthreads();
        const LAS unsigned char* ub = lds + UIMG + (16 * tg) * 512 + 4 * cp;
#pragma unroll
        for (int rr = 0; rr < 46; ++rr) { const h16x2 uv = *(const LAS h16x2*)(ub + rr * 512); const float a0 = (float)uv[0], a1 = (float)uv[1];
#pragma unroll
            for (int tl = 0; tl < 16; ++tl) { const int jj = rr - tl; if (jj >= 0 && jj < 31) { y0[tl] += w0[jj] * a0; y1[tl] += w1[jj] * a1; } } }
    }
#pragma unroll
    for (int tl = 0; tl < 16; ++tl) *(LAS f32x2*)(lds + YS + ((16 * tg + tl) * 256 + 2 * cp) * 4) = (f32x2){y0[tl], y1[tl]};
    h16x8 wf[16]; h16x4 gpre[2][4];
    {
        const h16* wp = (const h16*)(p.ws + WS_WPW) + (size_t)layer * 65536 + (size_t)(32 * wid + r) * 256 + 8 * hi;
#pragma unroll
        for (int ks = 0; ks < 16; ++ks) wf[ks] = *(const h16x8*)(wp + 16 * ks);
#pragma unroll
        for (int tb = 0; tb < 2; ++tb) { const h16* gp = projb + (size_t)(t0 + 32 * tb + r) * NIN + C_AGATE + 32 * wid + 4 * hi;
#pragma unroll
            for (int g = 0; g < 4; ++g) gpre[tb][g] = *(const h16x4*)(gp + 8 * g); }
    }
    __syncthreads();
    {
        const f32x4 lg = *(const f32x4*)(p.ln_g + layer * 256 + lane * 4), lb = *(const f32x4*)(p.ln_b + layer * 256 + lane * 4);
#pragma unroll 1
        for (int kb = 0; kb < 8; kb += 4) {
        f32x4 v[4]; float s1[4], s2[4];
#pragma unroll
        for (int k = 0; k < 4; ++k) { v[k] = *(const LAS f32x4*)(lds + YS + ((wid * 8 + kb + k) * 256 + lane * 4) * 4);
            s1[k] = (v[k][0] + v[k][1]) + (v[k][2] + v[k][3]); s2[k] = (v[k][0] * v[k][0] + v[k][1] * v[k][1]) + (v[k][2] * v[k][2] + v[k][3] * v[k][3]); }
#pragma unroll
        for (int o = 1; o < 64; o <<= 1)
#pragma unroll
            for (int k = 0; k < 4; ++k) { s1[k] += __shfl_xor(s1[k], o); s2[k] += __shfl_xor(s2[k], o); }
#pragma unroll
        for (int k = 0; k < 4; ++k) { const int t = wid * 8 + kb + k; const float mu = s1[k] * (1.0f / 256.0f); const float var = fmaxf(s2[k] * (1.0f / 256.0f) - mu * mu, 0.f); const float rs = rsqrtf(var + 1e-5f);
            h16x4 o; o[0] = (h16)silu_f((v[k][0] - mu) * rs * lg[0] + lb[0]); o[1] = (h16)silu_f((v[k][1] - mu) * rs * lg[1] + lb[1]); o[2] = (h16)silu_f((v[k][2] - mu) * rs * lg[2] + lb[2]); o[3] = (h16)silu_f((v[k][3] - mu) * rs * lg[3] + lb[3]);
            *(LAS h16x4*)(lds + SIMG + t * 512 + (((lane >> 1) ^ (t & 15)) << 4) + 8 * (lane & 1)) = o; }
        }
    }
    __syncthreads();
#pragma unroll
    for (int tb = 0; tb < 2; ++tb) {
        f32x16 acc;
#pragma unroll
        for (int i = 0; i < 16; ++i) acc[i] = 0.f;
#pragma unroll
        for (int ks = 0; ks < 16; ++ks) acc = __builtin_amdgcn_mfma_f32_32x32x16_f16(wf[ks], *(const LAS h16x8*)(lds + SIMG + (32 * tb + r) * 512 + (((2 * ks + hi) ^ (r & 15)) << 4)), acc, 0, 0, 0);
        const int t = t0 + 32 * tb + r, n0 = 32 * wid + 4 * hi;
        h16* dst = mix + ((size_t)b * SEQ + t) * DM + n0; const float* pb = p.pw_b + layer * 256 + n0;
#pragma unroll
        for (int g = 0; g < 4; ++g) { const h16x4 ga = gpre[tb][g]; const f32x4 bb = *(const f32x4*)(pb + 8 * g); h16x4 oa;
#pragma unroll
            for (int k = 0; k < 4; ++k) oa[k] = (h16)((acc[4 * g + k] + bb[k]) * silu_f((float)ga[k]));
            *(h16x4*)(dst + 8 * g) = oa; }
    }
}

__device__ __forceinline__ void ret_unit(const Params& p, int b, int hh, int n, unsigned char* lds_g) {
    LAS unsigned char* lds = (LAS unsigned char*)lds_g;
    const h16* projb = (const h16*)(p.ws + WS_PROJ) + (size_t)(b * SEQ + n * 128) * NIN; h16* mix = (h16*)(p.ws + WS_MIX); const float* kv = (const float*)(p.ws + WS_KV);
    const int tid = threadIdx.x, lane = tid & 63, wid = __builtin_amdgcn_readfirstlane(tid >> 6), r = lane & 31, hi = lane >> 5, g4 = wid & 3, eh = wid >> 2;
    const float log_g = logf(1.0f - exp2f(-5.0f - (float)hh));
    constexpr int KIMG = 0, VIMG = 16384, RIMG = 32768, XS = 40960;
    const h16x8 rr = *(const h16x8*)((const h16*)(p.ws + WS_RST) + ((size_t)((b * 4 + hh) * 32 + n)) * 4096 + tid * 8);
    h16x4 gpre[4];
    { const h16* gp0 = projb + (size_t)(32 * g4 + r) * NIN + C_RGATE + hh * 64 + 32 * eh + 4 * hi;
#pragma unroll
      for (int g = 0; g < 4; ++g) gpre[g] = *(const h16x4*)(gp0 + 8 * g); }
    __syncthreads();
    {
        const int e = tid >> 3, ch = tid & 7;
        *(LAS h16x8*)(lds + RIMG + e * 128 + ((ch ^ ((e >> 1) & 7)) << 4)) = rr;
#pragma unroll
        for (int it = 0; it < 2; ++it) {
            const int key = (tid >> 3) + 64 * it;
            h16x8 kk = *(const h16x8*)(projb + (size_t)key * NIN + C_RK + hh * 64 + ch * 8); const h16x8 vv = *(const h16x8*)(projb + (size_t)key * NIN + C_RV + hh * 64 + ch * 8);
            const float z = __expf(-log_g * (float)key) * 0.125f;
#pragma unroll
            for (int k = 0; k < 8; ++k) kk[k] = (h16)((float)kk[k] * z);
            *(LAS h16x8*)(lds + KIMG + key * 128 + ((ch ^ ((key >> 1) & 7)) << 4)) = kk;
            *(LAS h16x8*)(lds + VIMG + (ch >> 2) * 8192 + (key >> 4) * 1024 + (key & 15) * 64 + (ch & 3) * 16) = vv;
        }
    }
    const int qi = 32 * g4 + r;
    h16x8 qf[4];
    {
        const float zq = __expf(log_g * (float)qi);
#pragma unroll
        for (int s = 0; s < 4; ++s) { qf[s] = *(const h16x8*)(projb + (size_t)qi * NIN + C_RQ + hh * 64 + 16 * s + 8 * hi);
#pragma unroll
            for (int k = 0; k < 8; ++k) qf[s][k] = (h16)((float)qf[s][k] * zq); }
    }
    __syncthreads();
    const int rsw = (r >> 1) & 7;
    const int lanepart = (4 * hi + ((lane & 15) >> 2)) * 64 + ((lane >> 4) & 1) * 32 + (lane & 3) * 8;
    f32x16 o;
#pragma unroll
    for (int i = 0; i < 16; ++i) o[i] = 0.f;
#pragma unroll 1
    for (int jb = 0; jb <= g4; ++jb) {
        f32x16 c;
#pragma unroll
        for (int i = 0; i < 16; ++i) c[i] = 0.f;
#pragma unroll
        for (int s = 0; s < 4; ++s) c = __builtin_amdgcn_mfma_f32_32x32x16_f16(*(const LAS h16x8*)(lds + KIMG + (32 * jb + r) * 128 + (((2 * s + hi) ^ rsw) << 4)), qf[s], c, 0, 0, 0);
        if (jb == g4) {
#pragma unroll
            for (int i = 0; i < 16; ++i) if (CROW0(i) + 4 * hi > r) c[i] = 0.f;
        }
        h16x8 pf0, pf1;
#pragma unroll
        for (int k = 0; k < 8; ++k) { pf0[k] = (h16)c[k]; pf1[k] = (h16)c[8 + k]; }
        o = __builtin_amdgcn_mfma_f32_32x32x16_f16(tr_frag(lds + VIMG + eh * 8192 + (2 * jb) * 1024 + lanepart), pf0, o, 0, 0, 0);
        o = __builtin_amdgcn_mfma_f32_32x32x16_f16(tr_frag(lds + VIMG + eh * 8192 + (2 * jb + 1) * 1024 + lanepart), pf1, o, 0, 0, 0);
    }
#pragma unroll
    for (int s = 0; s < 4; ++s) o = __builtin_amdgcn_mfma_f32_32x32x16_f16(*(const LAS h16x8*)(lds + RIMG + (32 * eh + r) * 128 + (((2 * s + hi) ^ rsw) << 4)), qf[s], o, 0, 0, 0);
    float s1 = 0.f, s2 = 0.f;
#pragma unroll
    for (int i = 0; i < 16; ++i) { s1 += o[i]; s2 += o[i] * o[i]; }
    s1 = xhalf_sum(s1); s2 = xhalf_sum(s2);
    LAS float* xs = (LAS float*)(lds + XS);
    if (hi == 0) { xs[(wid * 32 + r) * 2] = s1; xs[(wid * 32 + r) * 2 + 1] = s2; }
    __syncthreads();
    {
        const float t1 = xs[((wid ^ 4) * 32 + r) * 2], t2 = xs[((wid ^ 4) * 32 + r) * 2 + 1];
        const float a1 = (eh == 0) ? (s1 + t1) : (t1 + s1), a2 = (eh == 0) ? (s2 + t2) : (t2 + s2);
        const float mu = a1 * (1.0f / 64.0f); const float var = fmaxf(a2 * (1.0f / 64.0f) - mu * mu, 0.f); const float rs = rsqrtf(var + 1e-5f);
        const int col = hh * 64 + 32 * eh + 4 * hi;
        h16* dst = mix + ((size_t)(b * SEQ + n * 128 + qi)) * DM + 256 + col;
#pragma unroll
        for (int g = 0; g < 4; ++g) { const h16x4 ga = gpre[g]; h16x4 oa;
#pragma unroll
            for (int k = 0; k < 4; ++k) oa[k] = (h16)((o[4 * g + k] - mu) * rs * silu_f((float)ga[k]));
            *(h16x4*)(dst + 8 * g) = oa; }
    }
}

constexpr float MOBA_THR = 8.0f;
__device__ __forceinline__ void moba_unit(const Params& p, int layer, int b, int hh, int j, unsigned char* lds_g) {
    LAS unsigned char* lds = (LAS unsigned char*)lds_g;
    const int tid = threadIdx.x, lane = tid & 63, wid = __builtin_amdgcn_readfirstlane(tid >> 6), r = lane & 31, hi = lane >> 5;
    const h16* projb = (const h16*)(p.ws + WS_PROJ) + (size_t)b * SEQ * NIN; h16* mix = (h16*)(p.ws + WS_MIX);
    const int qrow = j * 256 + wid * 32 + r;
    h16x8 qf[4];
#pragma unroll
    for (int s = 0; s < 4; ++s) qf[s] = *(const h16x8*)(projb + (size_t)qrow * NIN + C_MQ + hh * 64 + 16 * s + 8 * hi);
    const unsigned lds0 = (unsigned)(__UINTPTR_TYPE__)lds;
    const int dkey = 8 * wid + (lane >> 3);
    const h16* ksrc = projb + (size_t)dkey * NIN + C_MK + hh * 64 + (((lane & 7) ^ ((dkey >> 1) & 7)) << 3);
    const h16* vsrc = projb + (size_t)(16 * (wid & 3) + (lane >> 2)) * NIN + C_MV + hh * 64 + (wid >> 2) * 32 + (lane & 3) * 8;
    const unsigned kdst = lds0 + wid * 1024, vdst = lds0 + 8192 + (wid >> 2) * 4096 + (wid & 3) * 1024;
#define MOBA_DMA(tile) do { const int kp_ = j * 256 + 192 - 64 * (tile); const unsigned so_ = (unsigned)(((tile) & 7) * 16384); \
        glds16(ksrc + (size_t)kp_ * NIN, (unsigned)__builtin_amdgcn_readfirstlane(kdst + so_)); glds16(vsrc + (size_t)kp_ * NIN, (unsigned)__builtin_amdgcn_readfirstlane(vdst + so_)); } while (0)
#define MOBA_WAIT_BAR(N) asm volatile("s_waitcnt vmcnt(" #N ") lgkmcnt(0)\n\ts_barrier" ::: "memory")
    MOBA_WAIT_BAR(0);
    MOBA_DMA(0); MOBA_DMA(1); MOBA_DMA(2);
    unsigned selmask = 0u;
    if (j <= 3) selmask = (1u << j) - 1u;
    else {
        const float* km = (const float*)(p.ws + WS_KMEAN) + ((size_t)(b * 8 + hh) * 16 + (r & 15)) * 64 + 8 * hi;
        f32x16 g;
#pragma unroll
        for (int i = 0; i < 16; ++i) g[i] = 0.f;
#pragma unroll
        for (int s = 0; s < 4; ++s) {
            f32x4 a0 = (f32x4){0.f, 0.f, 0.f, 0.f}, a1 = a0;
            if (r < j) { a0 = *(const f32x4*)(km + 16 * s) + *(const f32x4*)(km + 65536 + 16 * s); a1 = *(const f32x4*)(km + 16 * s + 4) + *(const f32x4*)(km + 65536 + 16 * s + 4); }
            h16x8 ah, al;
#pragma unroll
            for (int k = 0; k < 4; ++k) { const h16 h0 = (h16)a0[k], h1 = (h16)a1[k]; ah[k] = h0; ah[4 + k] = h1; al[k] = (h16)(a0[k] - (float)h0); al[4 + k] = (h16)(a1[k] - (float)h1); }
            g = __builtin_amdgcn_mfma_f32_32x32x16_f16(ah, qf[s], g, 0, 0, 0);
            g = __builtin_amdgcn_mfma_f32_32x32x16_f16(al, qf[s], g, 0, 0, 0);
        }
        float gate[16];
#pragma unroll
        for (int i = 0; i < 8; ++i) { auto rr = __builtin_amdgcn_permlane32_swap(__float_as_uint(g[i]), __float_as_uint(g[i]), false, false);
            gate[(i & 3) + 8 * (i >> 2)] = __uint_as_float(rr[0]); gate[(i & 3) + 8 * (i >> 2) + 4] = __uint_as_float(rr[1]); }
        float g0 = -3.0e38f, g1 = -3.0e38f, g2 = -3.0e38f; int i0 = 0, i1 = 0, i2 = 0;
#pragma unroll
        for (int n = 0; n < 15; ++n) { const float s = (n < j) ? gate[n] : -3.0e38f;
            if (s > g0) { g2 = g1; i2 = i1; g1 = g0; i1 = i0; g0 = s; i0 = n; }
            else if (s > g1) { g2 = g1; i2 = i1; g1 = s; i1 = n; }
            else if (s > g2) { g2 = s; i2 = n; } }
        selmask = (1u << i0) | (1u << i1) | (1u << i2);
    }
    constexpr float C2 = 0.125f * 1.4426950408889634f;
    float qn2 = 0.f;
#pragma unroll
    for (int s = 0; s < 4; ++s)
#pragma unroll
        for (int k = 0; k < 8; ++k) { qf[s][k] = (h16)((float)qf[s][k] * C2); qn2 += (float)qf[s][k] * (float)qf[s][k]; }
    const unsigned* kmh = (const unsigned*)(p.ws + WS_CTL + 20480) + layer * 128 + (b * 8 + hh) * 2;
    const float qbound = sqrtf(xhalf_sum(qn2)) * sqrtf(__uint_as_float(__hip_atomic_load(kmh, __ATOMIC_RELAXED, __HIP_MEMORY_SCOPE_AGENT)) + __uint_as_float(__hip_atomic_load(kmh + 1, __ATOMIC_RELAXED, __HIP_MEMORY_SCOPE_AGENT))) * 1.002f;
    const float slope2 = exp2f(-(float)(hh + 1)) * 1.4426950408889634f;
    h16x8 aK0, aK1;
#pragma unroll
    for (int k = 0; k < 8; ++k) { aK0[k] = (h16)0.f; aK1[k] = (h16)0.f; }
    if (hi == 0) { aK0[0] = (h16)(float)r; aK0[1] = aK0[0]; aK0[2] = (h16)1.f; aK0[3] = (h16)1.f; aK1[0] = (h16)(float)(32 + r); aK1[1] = aK1[0]; aK1[2] = (h16)1.f; aK1[3] = (h16)1.f; }
    const h16 slh = (h16)slope2, sll = (h16)(slope2 - (float)slh);
    f32x16 zero16;
#pragma unroll
    for (int i = 0; i < 16; ++i) zero16[i] = 0.f;
    f32x16 o0, o1;
#pragma unroll
    for (int i = 0; i < 16; ++i) { o0[i] = 0.f; o1[i] = 0.f; }
    float mref = 0.f, lsum = 0.f; bool first = true;
    const int rK = r * 128, rsw = (r >> 1) & 7;
    const int rV = 8192 + (4 * hi + ((lane & 15) >> 2)) * 64 + ((lane >> 4) & 1) * 32 + (lane & 3) * 8;
    const int nt = 4 * (j + 1);
    const int wdiag = wid >> 1;
#define MOBA_CIN(T, C0, C1) do { const int kp_ = j * 256 + 192 - 64 * (T); const int nb_ = kp_ >> 8; const bool own_ = (nb_ == j); \
        const bool val_ = own_ ? true : (((selmask >> (nb_ & 31)) & 1u) != 0u); \
        const float base_ = val_ ? __builtin_fmaf(slope2, (float)(kp_ - qrow), -mref) : -60000.0f; \
        const h16 bh_ = (h16)base_; const h16 bl_ = (h16)(base_ - (float)bh_); \
        h16x8 bK_; bK_[0] = slh; bK_[1] = sll; bK_[2] = bh_; bK_[3] = bl_; bK_[4] = (h16)0.f; bK_[5] = (h16)0.f; bK_[6] = (h16)0.f; bK_[7] = (h16)0.f; \
        C0 = __builtin_amdgcn_mfma_f32_32x32x16_f16(aK0, bK_, zero16, 0, 0, 0); C1 = __builtin_amdgcn_mfma_f32_32x32x16_f16(aK1, bK_, zero16, 0, 0, 0); } while (0)
#define MOBA_DIAG(T, C0, C1) do { const int kp_ = j * 256 + 192 - 64 * (T); const int tl_ = (kp_ >> 6) & 3; \
        if (((kp_ >> 8) == j) && tl_ >= wdiag) { const int lim2_ = 32 * wid - 64 * tl_ + r - 4 * hi; \
            _Pragma("unroll") for (int i = 0; i < 16; ++i) { if (CROW0(i) > lim2_) C0[i] = -INFINITY; if (CROW0(i) + 32 > lim2_) C1[i] = -INFINITY; } } } while (0)
#define MOBA_QK(T, C0, C1) do { const LAS unsigned char* kb_ = lds + ((T) & 7) * 16384 + rK; \
        _Pragma("unroll") for (int s = 0; s < 4; ++s) { \
            const h16x8 k0_ = *(const LAS h16x8*)(kb_ + (((2 * s + hi) ^ rsw) << 4)), k1_ = *(const LAS h16x8*)(kb_ + 4096 + (((2 * s + hi) ^ rsw) << 4)); \
            C0 = __builtin_amdgcn_mfma_f32_32x32x16_f16(k0_, qf[s], C0, 0, 0, 0); C1 = __builtin_amdgcn_mfma_f32_32x32x16_f16(k1_, qf[s], C1, 0, 0, 0); } } while (0)
#define MOBA_DECIDE(T, C0, C1) do { MOBA_DIAG(T, C0, C1); float m_ = __builtin_fmaxf(C0[0], C1[0]); \
        _Pragma("unroll") for (int i = 1; i < 16; ++i) m_ = __builtin_fmaxf(__builtin_fmaxf(m_, C0[i]), C1[i]); \
        m_ = xhalf_max(m_); \
        const int kp_ = j * 256 + 192 - 64 * (T); const bool fst_ = ((kp_ >> 8) == j) && (((kp_ >> 6) & 3) == wdiag); \
        if (fst_ || __any(m_ > MOBA_THR)) { const float dl_ = fst_ ? m_ : __builtin_fmaxf(m_, 0.f); const float f_ = fst_ ? 1.0f : __builtin_amdgcn_exp2f(-dl_); mref += dl_; lsum *= f_; \
            _Pragma("unroll") for (int i = 0; i < 16; ++i) { C0[i] -= dl_; C1[i] -= dl_; o0[i] *= f_; o1[i] *= f_; } } } while (0)
#define MOBA_STEP(T, TE, P0, P1, N0, N1) do { \
        MOBA_CIN((T) + 1, N0, N1); MOBA_QK((T) + 1, N0, N1); \
        float pa_ = 0.f, pb_ = 0.f, pc_ = 0.f, pd_ = 0.f; \
        _Pragma("unroll") for (int i = 0; i < 16; ++i) { P0[i] = __builtin_amdgcn_exp2f(P0[i]); P1[i] = __builtin_amdgcn_exp2f(P1[i]); } \
        _Pragma("unroll") for (int i = 0; i < 16; i += 2) { pa_ = fadd_s(pa_, P0[i]); pb_ = fadd_s(pb_, P1[i]); pc_ = fadd_s(pc_, P0[i + 1]); pd_ = fadd_s(pd_, P1[i + 1]); } \
        lsum += fadd_s(fadd_s(pa_, pb_), fadd_s(pc_, pd_)); \
        b16x8 pf_[4]; \
        { \
              \
            const u32x4 w0_ = {pk_bf16(P0[0], P0[1]), pk_bf16(P0[2], P0[3]), pk_bf16(P0[4], P0[5]), pk_bf16(P0[6], P0[7])}; \
            const u32x4 w1_ = {pk_bf16(P0[8], P0[9]), pk_bf16(P0[10], P0[11]), pk_bf16(P0[12], P0[13]), pk_bf16(P0[14], P0[15])}; \
            const u32x4 w2_ = {pk_bf16(P1[0], P1[1]), pk_bf16(P1[2], P1[3]), pk_bf16(P1[4], P1[5]), pk_bf16(P1[6], P1[7])}; \
            const u32x4 w3_ = {pk_bf16(P1[8], P1[9]), pk_bf16(P1[10], P1[11]), pk_bf16(P1[12], P1[13]), pk_bf16(P1[14], P1[15])}; \
            pf_[0] = __builtin_bit_cast(b16x8, w0_); pf_[1] = __builtin_bit_cast(b16x8, w1_); pf_[2] = __builtin_bit_cast(b16x8, w2_); pf_[3] = __builtin_bit_cast(b16x8, w3_); } \
        { const LAS unsigned char* vb_ = lds + ((T) & 7) * 16384 + rV; \
          _Pragma("unroll") for (int t = 0; t < 4; ++t) { const b16x8 v0_ = __builtin_bit_cast(b16x8, tr_frag(vb_ + t * 1024)), v1_ = __builtin_bit_cast(b16x8, tr_frag(vb_ + 4096 + t * 1024)); \
            o0 = __builtin_amdgcn_mfma_f32_32x32x16_bf16(v0_, pf_[t], o0, 0, 0, 0); o1 = __builtin_amdgcn_mfma_f32_32x32x16_bf16(v1_, pf_[t], o1, 0, 0, 0); } } \
        if ((T) + 1 < (TE) && dec) MOBA_DECIDE((T) + 1, N0, N1); } while (0)
    f32x16 cA0, cA1, cB0, cB1;
    int te = nt; bool dec = true;
    LAS float* xs = (LAS float*)(lds + 131072);
    MOBA_WAIT_BAR(0);
    MOBA_DMA(3); if (4 < te) MOBA_DMA(4);
    MOBA_CIN(0, cA0, cA1); MOBA_QK(0, cA0, cA1); MOBA_DECIDE(0, cA0, cA1);
#pragma unroll 1
    for (int tt = 0; tt < te; tt += 2) {
        MOBA_STEP(tt, te, cA0, cA1, cB0, cB1);
        if (tt == 2 && j > 0) { float marg = qbound - mref;
#pragma unroll
            for (int o = 1; o < 64; o <<= 1) marg = fmaxf(marg, __shfl_xor(marg, o));
            if (lane == 0) xs[wid] = marg; }
        MOBA_STEP(tt + 1, te, cB0, cB1, cA0, cA1);
        MOBA_WAIT_BAR(0);
        if (tt == 2 && j > 0) { float M = xs[0];
#pragma unroll
            for (int k = 1; k < 8; ++k) M = fmaxf(M, xs[k]);
            const float num = M + 40.0f - slope2;
            int cnt = (num >= 0.f) ? ((int)(num / (64.0f * slope2)) + 1) : 0;
            cnt = max(min(cnt, 4 * j), 2); cnt = (cnt + 1) & ~1;
            te = 4 + __builtin_amdgcn_readfirstlane(cnt);
            dec = !(M < 100.0f); }
        if (tt + 5 < te) MOBA_DMA(tt + 5);
        if (tt + 6 < te) MOBA_DMA(tt + 6);
    }
    MOBA_WAIT_BAR(0);
#undef MOBA_RUN
#undef MOBA_CIN
#undef MOBA_DIAG
#undef MOBA_QK
#undef MOBA_DECIDE
#undef MOBA_STEP
#undef MOBA_DMA
#undef MOBA_WAIT_BAR
    {
        const float inv = 1.0f / xhalf_sum(lsum);
        const h16* gp = projb + (size_t)qrow * NIN + C_MGATE + hh * 64 + 4 * hi; h16* dst = mix + ((size_t)b * SEQ + qrow) * DM + 512 + hh * 64 + 4 * hi;
#pragma unroll
        for (int g = 0; g < 4; ++g) {
            const h16x4 ga = *(const h16x4*)(gp + 8 * g), gb = *(const h16x4*)(gp + 32 + 8 * g); h16x4 oa, ob;
#pragma unroll
            for (int k = 0; k < 4; ++k) { oa[k] = (h16)(o0[4 * g + k] * inv * silu_f((float)ga[k])); ob[k] = (h16)(o1[4 * g + k] * inv * silu_f((float)gb[k])); }
            *(h16x4*)(dst + 8 * g) = oa; *(h16x4*)(dst + 32 + 8 * g) = ob;
        }
    }
}

__device__ __forceinline__ void ret_scan_shares(const Params& p, int layer) {
    const float* kv = (const float*)(p.ws + WS_KV); h16* rst = (h16*)(p.ws + WS_RST);
    const int tid = threadIdx.x; unsigned done = 0u;
#pragma unroll 1
    for (int s = blockIdx.x; s < 256; s += gridDim.x) {
        const int bh = s >> 3, e = (s & 7) * 512 + tid, hh = bh & 3;
        const float gam = 1.0f - exp2f(-5.0f - (float)hh); const float g = expf(logf(gam) * 128.0f);
        const float* kvb = kv + (size_t)bh * 32 * 4096 + e; h16* rb = rst + (size_t)bh * 32 * 4096 + e;
        float r = 0.f; rb[0] = (h16)0.f;
        float kvv[31];
#pragma unroll
        for (int m = 0; m < 31; ++m) kvv[m] = kvb[(size_t)m * 4096];
#pragma unroll
        for (int m = 0; m < 31; ++m) { r = r * g + kvv[m]; rb[(size_t)(m + 1) * 4096] = (h16)(r * gam); }
        ++done;
    }
    asm volatile("s_waitcnt vmcnt(0)" ::: "memory");
    __syncthreads();
    if (tid == 0) { __builtin_amdgcn_fence(__ATOMIC_RELEASE, "agent"); asm volatile("s_waitcnt vmcnt(0)" ::: "memory");
        __hip_atomic_fetch_add((unsigned*)(p.ws + WS_CTL + 16384) + 64 * layer, done, __ATOMIC_RELAXED, __HIP_MEMORY_SCOPE_AGENT); }
}
__device__ __forceinline__ void ret_scan_wait(const Params& p, int layer) {
    if (threadIdx.x == 0) {
        unsigned* c = (unsigned*)(p.ws + WS_CTL + 16384) + 64 * layer; unsigned sp = 0u;
        while (__hip_atomic_load(c, __ATOMIC_RELAXED, __HIP_MEMORY_SCOPE_AGENT) < 256u) { __builtin_amdgcn_s_sleep(2); if (++sp > (1u << 22)) break; }
        __builtin_amdgcn_fence(__ATOMIC_ACQUIRE, "agent"); asm volatile("s_waitcnt vmcnt(0)" ::: "memory");
    }
    __syncthreads();
}

__device__ __forceinline__ void publish_count(unsigned* c, unsigned n) {
    asm volatile("s_waitcnt vmcnt(0)" ::: "memory");
    __syncthreads();
    if (threadIdx.x == 0) { __builtin_amdgcn_fence(__ATOMIC_RELEASE, "agent"); asm volatile("s_waitcnt vmcnt(0)" ::: "memory"); __hip_atomic_fetch_add(c, n, __ATOMIC_RELAXED, __HIP_MEMORY_SCOPE_AGENT); }
}
__device__ __forceinline__ void wait_count(unsigned* c, unsigned want) {
    if (threadIdx.x == 0) { unsigned sp = 0u;
        while (__hip_atomic_load(c, __ATOMIC_RELAXED, __HIP_MEMORY_SCOPE_AGENT) < want) { __builtin_amdgcn_s_sleep(2); if (++sp > (1u << 22)) break; }
        __builtin_amdgcn_fence(__ATOMIC_ACQUIRE, "agent"); asm volatile("s_waitcnt vmcnt(0)" ::: "memory"); }
    __syncthreads();
}
__device__ __forceinline__ int queue_pop(unsigned* counter, LAS unsigned* slot) {
    __syncthreads();
    if (threadIdx.x == 0) slot[0] = __hip_atomic_fetch_add(counter, 1u, __ATOMIC_RELAXED, __HIP_MEMORY_SCOPE_AGENT);
    __syncthreads();
    return (int)slot[0];
}
__device__ __forceinline__ void phase_mixers(const Params& p, int layer, unsigned char* lds) {
    static constexpr unsigned char MOBA_ORDER[128] = {111,127,110,126,109,125,93,94,95,92,108,124,91,107,123,90,106,122,89,105,121,88,104,120,87,103,119,71,72,73,74,75,76,77,78,79,70,86,102,118,69,85,101,117,68,84,100,116,52,53,54,55,56,57,58,59,60,61,62,63,51,67,83,99,115,50,66,82,98,114,34,35,36,37,38,39,40,41,42,43,44,45,46,47,17,18,19,20,21,22,23,24,25,26,27,28,29,30,31,33,49,65,81,97,113,1,2,3,4,5,6,7,8,9,10,11,12,13,14,15,0,16,32,48,64,80,96,112};
    unsigned* qc = (unsigned*)(p.ws + WS_CTL + 24576) + layer * 256;
    LAS unsigned* slot = (LAS unsigned*)((LAS unsigned char*)lds + BAR_LDS_OFF + 16);
    phase_stats(p, layer, lds);
    publish_count((unsigned*)(p.ws + WS_CTL + 16384) + 64 * (2 + layer), 1u);
#define QUEUE_LOOP(CNT, N, BODY) do { int cur = queue_pop(CNT, slot); \
        _Pragma("unroll 1") while (cur < (N)) { unsigned nxt_ = 0u; if (threadIdx.x == 0) nxt_ = __hip_atomic_fetch_add(CNT, 1u, __ATOMIC_RELAXED, __HIP_MEMORY_SCOPE_AGENT); \
            { BODY; } \
            __syncthreads(); if (threadIdx.x == 0) slot[0] = nxt_; __syncthreads(); cur = (int)slot[0]; } } while (0)
    QUEUE_LOOP(qc + 128, 512, conv_unit(p, layer, cur >> 6, cur & 63, lds));
    wait_count((unsigned*)(p.ws + WS_CTL + 16384) + 64 * (2 + layer), gridDim.x);
    ret_scan_shares(p, layer);
    QUEUE_LOOP(qc, 1024, const int hj = MOBA_ORDER[cur >> 3]; moba_unit(p, layer, cur & 7, hj >> 4, hj & 15, lds));
    ret_scan_wait(p, layer);
    QUEUE_LOOP(qc + 64, 1024, ret_unit(p, cur >> 7, (cur >> 5) & 3, cur & 31, lds));
#undef QUEUE_LOOP
}

__device__ __forceinline__ void phase_final(const Params& p) {
    const float* rowss = (const float*)(p.ws + WS_ROWSS); const h16* xh = (const h16*)(p.ws + WS_XH);
    const int lane = threadIdx.x & 63, wid = threadIdx.x >> 6;
    f32x4 g[4];
#pragma unroll
    for (int j = 0; j < 4; ++j) g[j] = *((const f32x4*)p.final_g + lane + 64 * j);
    for (int row = blockIdx.x * 8 + wid; row < MROWS; row += gridDim.x * 8) {
        const f32x4* rs = (const f32x4*)(rowss + (size_t)row * NPART); const f32x4 s0 = rs[0], s1 = rs[1], s2 = rs[2], s3 = rs[3];
        const float tot = ((s0[0] + s0[1]) + (s0[2] + s0[3])) + ((s1[0] + s1[1]) + (s1[2] + s1[3])) + ((s2[0] + s2[1]) + (s2[2] + s2[3])) + ((s3[0] + s3[1]) + (s3[2] + s3[3]));
        const float rstd = rsqrtf(tot * (1.0f / DM) + 1e-6f);
        const h16x4* xr = (const h16x4*)(xh + (size_t)row * DM) + lane; f32x4* orow = (f32x4*)(p.out + (size_t)row * DM) + lane;
#pragma unroll
        for (int j = 0; j < 4; ++j) { const h16x4 v = xr[64 * j]; orow[64 * j] = (f32x4){(float)v[0], (float)v[1], (float)v[2], (float)v[3]} * rstd * g[j]; }
    }
}

#define XB_TMO      128
#define XB_XCNT(j)  (256  + 64 * (j))
#define XB_XSUB(j)  (1280 + 64 * (j))
#define XB_XGEN(j)  (2304 + 64 * (j))
#define XB_TOP      3328
#define XB_TOPGEN   3392
#define XCD_BAR_WORDS 3456
#define XB_SPIN_CAP (1u << 18)

__device__ __forceinline__ unsigned xb_ld(unsigned* p)              { return __hip_atomic_load(p, __ATOMIC_RELAXED, __HIP_MEMORY_SCOPE_AGENT); }
__device__ __forceinline__ unsigned xb_add(unsigned* p, unsigned v) { return __hip_atomic_fetch_add(p, v, __ATOMIC_RELAXED, __HIP_MEMORY_SCOPE_AGENT); }
__device__ __forceinline__ unsigned xb_xcc_id() { return (unsigned)__builtin_amdgcn_s_getreg((3 << 11) | 20) & 0xFu; }
#define XB_SPIN(cond, bar) do { unsigned _sp = 0; while (cond) { __builtin_amdgcn_s_sleep(1); \
    if ((++_sp & 255u) == 0u) { if (xb_ld(&(bar)[XB_TMO])) break; if (_sp > XB_SPIN_CAP) { atomicAdd(&(bar)[XB_TMO], 1u); break; } } } } while (0)

struct XcdBarrier {
    unsigned* bar; unsigned x;
    volatile LAS unsigned* st;
};

__device__ __forceinline__ XcdBarrier xcd_barrier_post(unsigned* bar, volatile LAS unsigned* st) {
    XcdBarrier b; b.bar = bar; b.x = xb_xcc_id(); b.st = st;
    if (threadIdx.x == 0) (void)xb_add(&bar[XB_XCNT(b.x)], 1u);
    return b;
}
__device__ __forceinline__ void xcd_barrier_complete(unsigned* bar, unsigned x, unsigned& nloc, unsigned& nx) {
    const unsigned G = gridDim.x * gridDim.y * gridDim.z;
    unsigned sum, cnt, mine, sp = 0u;
    for (;;) {
        sum = 0u; cnt = 0u; mine = 0u;
#pragma unroll
        for (unsigned j = 0; j < 16; ++j) { const unsigned c = xb_ld(&bar[XB_XCNT(j)]); sum += c; cnt += (c > 0u) ? 1u : 0u; mine = (j == x) ? c : mine; }
        if (sum == G) break;
        __builtin_amdgcn_s_sleep(1);
        if ((++sp & 255u) == 0u) { if (xb_ld(&bar[XB_TMO])) break; if (sp > XB_SPIN_CAP) { atomicAdd(&bar[XB_TMO], 1u); break; } }
    }
    nloc = mine > 0u ? mine : 1u; nx = cnt > 0u ? cnt : 1u;
}

__device__ __forceinline__ void xcd_barrier(const XcdBarrier& b) {
    asm volatile("s_waitcnt vmcnt(0)" ::: "memory");
    __syncthreads();
    if (threadIdx.x == 0) {
        unsigned* bar = b.bar;
        __builtin_amdgcn_s_waitcnt(0);
        unsigned nloc = b.st[0], nx = b.st[1];
        if (nloc == 0u) { xcd_barrier_complete(bar, b.x, nloc, nx); b.st[0] = nloc; b.st[1] = nx; }
        const unsigned old = xb_add(&bar[XB_XSUB(b.x)], 1u);
        const unsigned gen = old / nloc;
        if (old + 1u == (gen + 1u) * nloc) {
            __builtin_amdgcn_fence(__ATOMIC_RELEASE, "agent");
            asm volatile("s_waitcnt vmcnt(0)" ::: "memory");
            const unsigned og = xb_add(&bar[XB_TOP], 1u);
            const unsigned tg = og / nx;
            if (og + 1u == (tg + 1u) * nx) xb_add(&bar[XB_TOPGEN], 1u);
            else XB_SPIN(xb_ld(&bar[XB_TOPGEN]) == tg, bar);
            __builtin_amdgcn_fence(__ATOMIC_ACQUIRE, "agent");
            xb_add(&bar[XB_XGEN(b.x)], 1u);
            asm volatile("s_waitcnt vmcnt(0)" ::: "memory");
        } else {
            XB_SPIN(xb_ld(&bar[XB_XGEN(b.x)]) == gen, bar);
            __builtin_amdgcn_fence(__ATOMIC_ACQUIRE, "agent");
            asm volatile("s_waitcnt vmcnt(0)" ::: "memory");
        }
    }
    __syncthreads();
}


__global__ void __launch_bounds__(NTHREADS) hymba_fwd(Params p) {
    extern __shared__ __attribute__((aligned(16))) unsigned char lds[];
    cg::grid_group grid = cg::this_grid();
    volatile LAS unsigned* bst = (volatile LAS unsigned*)((LAS unsigned char*)lds + BAR_LDS_OFF);
    if (threadIdx.x < 2) bst[threadIdx.x] = 0u;
    __syncthreads();
    XcdBarrier xbar = xcd_barrier_post((unsigned*)(p.ws + WS_CTL), bst);
#define RUN_PHASE(k, body) do { if (p.ph_lo <= (k) && (k) < p.ph_hi) { body; if ((k) + 1 < p.ph_hi) { xcd_barrier(xbar); } } } while (0)
    RUN_PHASE(0, phase_prologue(p, lds));
    RUN_PHASE(1, gemm_in(p, 0, lds));
    RUN_PHASE(2, phase_mixers(p, 0, lds));
    RUN_PHASE(3, gemm_out<0>(p, lds));
    RUN_PHASE(4, gemm_in(p, 1, lds));
    RUN_PHASE(5, phase_mixers(p, 1, lds));
    RUN_PHASE(6, gemm_out<1>(p, lds));
    RUN_PHASE(7, phase_final(p));
#undef RUN_PHASE
}

extern "C" void kernel_launch(void* const* d_in, const int* in_sizes, int n_in, void* d_out, int out_size, void* d_ws, size_t ws_size, hipStream_t stream) {
    static int grid_blocks = 0;
    if (!grid_blocks) {
        int dev = 0, cus = 0, per_cu = 0;
        hipGetDevice(&dev);
        hipDeviceGetAttribute(&cus, hipDeviceAttributeMultiprocessorCount, dev);
        hipFuncSetAttribute((const void*)hymba_fwd, hipFuncAttributeMaxDynamicSharedMemorySize, LDS_BYTES);
        hipOccupancyMaxActiveBlocksPerMultiprocessor(&per_cu, (const void*)hymba_fwd, NTHREADS, LDS_BYTES);
        if (per_cu < 1) per_cu = 1;
        grid_blocks = cus * per_cu;
        if (ws_size < WS_END) fprintf(stderr, "kernel_launch: workspace too small (%zu < %zu)\n", ws_size, (size_t)WS_END);
    }
    Params p{};
    p.x = (const float*)d_in[0]; p.norm_g = (const float*)d_in[1]; p.w_in = (const float*)d_in[2]; p.conv_w = (const float*)d_in[3]; p.conv_b = (const float*)d_in[4];
    p.ln_g = (const float*)d_in[5]; p.ln_b = (const float*)d_in[6]; p.pw_w = (const float*)d_in[7]; p.pw_b = (const float*)d_in[8]; p.w_out = (const float*)d_in[9];
    p.final_g = (const float*)d_in[10]; p.out = (float*)d_out; p.ws = (unsigned char*)d_ws;
    (void)hipMemsetAsync((char*)d_ws + WS_CTL, 0, 32768, stream);
#if ONE_LAUNCH
    p.ph_lo = 0; p.ph_hi = NPHASES;
    { void* args[] = {&p};
      hipError_t e = hipLaunchCooperativeKernel((const void*)hymba_fwd, dim3(grid_blocks), dim3(NTHREADS), args, LDS_BYTES, stream);
      if (e != hipSuccess) fprintf(stderr, "cooperative launch failed: %s (grid %d)\n", hipGetErrorString(e), grid_blocks); }
#else
    for (int ph = 0; ph < NPHASES; ++ph) {
        p.ph_lo = ph; p.ph_hi = ph + 1; void* args[] = {&p};
        hipError_t e = hipLaunchCooperativeKernel((const void*)hymba_fwd, dim3(grid_blocks), dim3(NTHREADS), args, LDS_BYTES, stream);
        if (e != hipSuccess) { fprintf(stderr, "cooperative launch failed: %s (grid %d, phase %d)\n", hipGetErrorString(e), grid_blocks, ph); break; }
    }
#endif
}
```

```cpp
#include <hip/hip_runtime.h>
#include <hip/hip_cooperative_groups.h>
#include <cstdio>
#include <cstdint>
namespace cg = cooperative_groups;

#ifndef ONE_LAUNCH
#define ONE_LAUNCH 1
#endif

typedef _Float16 h16;
typedef _Float16 h16x8 __attribute__((ext_vector_type(8)));
typedef _Float16 h16x4 __attribute__((ext_vector_type(4)));
typedef __bf16 b16x8 __attribute__((ext_vector_type(8)));
typedef float f32x16 __attribute__((ext_vector_type(16)));
typedef float f32x4 __attribute__((ext_vector_type(4)));
typedef unsigned u32x4 __attribute__((ext_vector_type(4)));

constexpr int BATCH = 8, SEQ = 4096, DM = 1024, MROWS = BATCH * SEQ, NIN = 3840, DEPTH = 2;
constexpr int C_AVAL = 0, C_AGLU = 256, C_AGATE = 512, C_RQ = 768, C_RK = 1024, C_RV = 1280, C_RGATE = 1536, C_MQ = 1792, C_MK = 2304, C_MV = 2816, C_MGATE = 3328;
constexpr int NPART = 16;
constexpr int NTHREADS = 512;
constexpr int LDS_BYTES = 147456;
constexpr int NPHASES = 8;

constexpr size_t MiB = 1u << 20;
constexpr size_t WS_XH = 0, WS_PROJ = 64 * MiB, WS_MIX = 304 * MiB, WS_WIN = 368 * MiB, WS_WOUT = 383 * MiB, WS_WPW = 387 * MiB,
                 WS_KV = 388 * MiB, WS_KMEAN = 404 * MiB  , WS_ROWSS = 405 * MiB, WS_CTL = 408 * MiB  , WS_RST = 409 * MiB  , WS_END = 417 * MiB;
constexpr int BAR_LDS_OFF = LDS_BYTES - 64;

struct Params {
    const float *x, *norm_g, *w_in, *conv_w, *conv_b, *ln_g, *ln_b, *pw_w, *pw_b, *w_out, *final_g;
    float* out; unsigned char* ws;
    int ph_lo, ph_hi;
};

__device__ __forceinline__ float silu_f(float v) { return v * __builtin_amdgcn_rcpf(1.0f + __expf(-v)); }
__device__ __forceinline__ int crow(int r, int h) { return (r & 3) + 8 * (r >> 2) + 4 * h; }
__device__ __forceinline__ float wave_sum(float v) {
#pragma unroll
    for (int o = 1; o < 64; o <<= 1) v += __shfl_xor(v, o);
    return v;
}

__device__ __forceinline__ void transpose_unit(const float* W, int K, int N, h16* WT, const float* g, int k0, int n0, float* tile) {
    const int tid = threadIdx.x;
    __syncthreads();
#pragma unroll
    for (int i = 0; i < 8; ++i) { const int k = i * 8 + (tid >> 6), n = tid & 63; float v = W[(size_t)(k0 + k) * N + n0 + n]; if (g) v *= g[k0 + k]; tile[k * 65 + n] = v; }
    __syncthreads();
    { const int n = tid >> 3, kc = tid & 7; h16x8 w;
#pragma unroll
        for (int i = 0; i < 8; ++i) w[i] = (h16)tile[(kc * 8 + i) * 65 + n];
        *(h16x8*)(WT + (size_t)(n0 + n) * K + k0 + kc * 8) = w; }
}

__device__ __forceinline__ void phase_prologue(const Params& p, unsigned char* lds) {
    float* tile = (float*)lds;
    h16* win = (h16*)(p.ws + WS_WIN);
    constexpr int U_IN = 16 * 60;
    for (int r = blockIdx.x; r < U_IN; r += gridDim.x)
        transpose_unit(p.w_in, DM, NIN, win, p.norm_g, (r / 60) * 64, (r % 60) * 64, tile);
    h16* xh = (h16*)(p.ws + WS_XH); float* rowss = (float*)(p.ws + WS_ROWSS);
    const int lane = threadIdx.x & 63, wid = threadIdx.x >> 6;
    for (int row = blockIdx.x * 8 + wid; row < MROWS; row += gridDim.x * 8) {
        const f32x4* xr = (const f32x4*)(p.x + (size_t)row * DM) + lane;
        float ss = 0.f;
#pragma unroll
        for (int j = 0; j < 4; ++j) { const f32x4 v = xr[64 * j]; ss += v.x * v.x + v.y * v.y + v.z * v.z + v.w * v.w;
            h16x4 o; o.x = (h16)v.x; o.y = (h16)v.y; o.z = (h16)v.z; o.w = (h16)v.w; *((h16x4*)(xh + (size_t)row * DM) + lane + 64 * j) = o; }
        ss = wave_sum(ss);
        if (lane < NPART) rowss[(size_t)row * NPART + lane] = (lane == 0) ? ss : 0.f;
    }
}

typedef short s16x4 __attribute__((ext_vector_type(4)));
#define LAS __attribute__((address_space(3)))
__device__ __forceinline__ float xhalf_max(float v) { auto rr = __builtin_amdgcn_permlane32_swap(__float_as_uint(v), __float_as_uint(v), false, false); return fmaxf(__uint_as_float(rr[0]), __uint_as_float(rr[1])); }
__device__ __forceinline__ float xhalf_sum(float v) { auto rr = __builtin_amdgcn_permlane32_swap(__float_as_uint(v), __float_as_uint(v), false, false); return __uint_as_float(rr[0]) + __uint_as_float(rr[1]); }
__device__ __forceinline__ h16x8 tr_frag(const LAS unsigned char* a) {
    const s16x4 lo = __builtin_amdgcn_ds_read_tr16_b64_v4i16((LAS s16x4*)a), hi = __builtin_amdgcn_ds_read_tr16_b64_v4i16((LAS s16x4*)(a + 512));
    typedef short s16x8 __attribute__((ext_vector_type(8)));
    const s16x8 v = __builtin_shufflevector(lo, hi, 0, 1, 2, 3, 4, 5, 6, 7);
    return __builtin_bit_cast(h16x8, v);
}
#define CROW0(i) (((i) & 3) + 8 * ((i) >> 2))
__device__ __forceinline__ float fadd_s(float a, float b) { float r; asm("v_add_f32_e32 %0, %1, %2" : "=v"(r) : "v"(a), "v"(b)); return r; }
__device__ __forceinline__ void glds16(const void* gsrc, unsigned lds_dst) { unsigned keep;
    asm volatile("s_mov_b32 %0, m0\n\ts_mov_b32 m0, %2\n\ts_nop 0\n\tglobal_load_lds_dwordx4 %1, off\n\ts_mov_b32 m0, %0" : "=&s"(keep) : "v"(gsrc), "s"(lds_dst) : "memory"); }

typedef __bf16 b16x2 __attribute__((ext_vector_type(2)));
typedef float f32x2_ __attribute__((ext_vector_type(2)));
__device__ __forceinline__ unsigned pk_bf16(float lo, float hi) { const f32x2_ v = {lo, hi}; return __builtin_bit_cast(unsigned, __builtin_convertvector(v, b16x2)); }
__device__ __forceinline__ unsigned cvt_pk_bf16(float lo, float hi) { unsigned r; asm("v_cvt_pk_bf16_f32 %0, %1, %2" : "=v"(r) : "v"(lo), "v"(hi)); return r; }
namespace pg8 {
#define PG8_LAS __attribute__((address_space(3)))
typedef _Float16 bf16_t;
typedef _Float16 bf16x8 __attribute__((ext_vector_type(8)));
typedef float f32x4 __attribute__((ext_vector_type(4)));
typedef unsigned u32x4 __attribute__((ext_vector_type(4)));
constexpr int BM = 256, BK = 64, HALF = 128, HTB = HALF * BK * 2  , STAGE_BYTES = 8 * HTB, NXCD = 8, WGM = 8;

__host__ __device__ __forceinline__ int lds_byte(int r, int c) { const int st = (r >> 4) * 2 + (c >> 5), rr = r & 15, cc = c & 31, ob = rr * 64 + cc * 2; return st * 1024 + (ob ^ (((ob >> 9) & 1) << 5)); }
__host__ __device__ __forceinline__ void stage_rc(int b, int& R, int& C) { const int st = b / 1024, sb = b % 1024, swz = sb ^ (((sb >> 9) & 1) << 5); R = (st >> 1) * 16 + swz / 64; C = (st & 1) * 32 + (swz % 64) / 2; }
__host__ __device__ __forceinline__ int perm32(int rho) { const int n = rho >> 4, i = rho & 15; return 8 * (i >> 2) + 4 * n + (i & 3); }

struct Unit { int pm, pn; };
struct Gemm { const bf16_t* A; const bf16_t* Bt; int M, N, K; };

struct StaticOrder {
    int nM, nN, nwg, G, c;
    __host__ __device__ void init(int M, int N, int G_, int c_) { nM = M / BM; nN = N / BM; nwg = nM * nN; G = G_; c = c_; }
    __host__ __device__ bool next(int i, Unit& u) const {
        const long L = (long)i * G + c; if (L >= nwg) return false;
        int wgid = (int)L; { const int q = nwg / NXCD, r = nwg % NXCD, xcd = wgid % NXCD, off = wgid / NXCD; wgid = (xcd < r ? xcd * (q + 1) : r * (q + 1) + (xcd - r) * q) + off; }
        const int nig = WGM * nN, gid = wgid / nig, fm = gid * WGM, gsz = (nM - fm) < WGM ? (nM - fm) : WGM;
        u.pm = fm + ((wgid % nig) % gsz); u.pn = (wgid % nig) / gsz; return true;
    }
    __device__ __forceinline__ void a_ready(const Unit&) const {}
    __device__ __forceinline__ void done(const Unit&) const {}
};

template <class Epi, class Sched, bool ALIGN_EPI = false, bool SP2 = false>
__device__ __forceinline__ void gemm_phase(PG8_LAS unsigned char* lds, const Gemm g, const Sched& S, const Epi& E) {
    const int tid = threadIdx.x, wid = __builtin_amdgcn_readfirstlane(tid >> 6), lane = tid & 63, wr = wid >> 2, wc = wid & 3, fr = lane & 15, fq = lane >> 4;
    const int K = g.K, nt = K / BK;
    unsigned voffA[2], voffB[2];
#pragma unroll
    for (int i = 0; i < 2; ++i) { int R, C; stage_rc(tid * 16 + i * 8192, R, C); const int Rb = Epi::PERM ? ((R & ~31) + perm32(R & 31)) : R;
        voffA[i] = (unsigned)(R * K + C) * 2u; voffB[i] = (unsigned)(Rb * K + C) * 2u; }
    const size_t kstep = (size_t)(BK * 2);
    const size_t hstep = (size_t)HALF * K * 2;
    const size_t tstep = 2 * hstep;
    const unsigned ldsw = (unsigned)wid * 1024u;
    const int aoff = lds_byte(wr * 64 + fr, fq * 8), boff = lds_byte(wc * 32 + fr, fq * 8);
#define PG8_SA(b, h) (((b) * 2 + (h)) * HTB)
#define PG8_SB(b, h) ((4 + (b) * 2 + (h)) * HTB)
#define PG8_STAGE(bufoff, gbase, voff) do { _Pragma("unroll") for (int _i = 0; _i < 2; ++_i) \
        __builtin_amdgcn_global_load_lds((const unsigned*)((const char*)(gbase) + (voff)[_i]), (PG8_LAS unsigned*)(lds + (bufoff) + ldsw + _i * 8192), 16, 0, 0); } while (0)
#define PG8_LDA(dst, b, h) do { _Pragma("unroll") for (int m = 0; m < 4; ++m) _Pragma("unroll") for (int k = 0; k < 2; ++k) dst[m][k] = *(const PG8_LAS bf16x8*)(lds + PG8_SA(b, h) + aoff + m * 2048 + k * 1024); } while (0)
#define PG8_LDB(dst, b, h) do { _Pragma("unroll") for (int n = 0; n < 2; ++n) _Pragma("unroll") for (int k = 0; k < 2; ++k) dst[n][k] = *(const PG8_LAS bf16x8*)(lds + PG8_SB(b, h) + boff + n * 2048 + k * 1024); } while (0)
#define PG8_MMA(ai, bj, At, Bt) do { __builtin_amdgcn_s_setprio(1); _Pragma("unroll") for (int m = 0; m < 4; ++m) _Pragma("unroll") for (int n = 0; n < 2; ++n) _Pragma("unroll") for (int k = 0; k < 2; ++k) \
        acc[ai][bj][m][n] = __builtin_amdgcn_mfma_f32_16x16x32_f16(Bt[n][k], At[m][k], acc[ai][bj][m][n], 0, 0, 0); __builtin_amdgcn_s_setprio(0); } while (0)
#define PG8_WAIT_V(n) asm volatile("s_waitcnt vmcnt(" #n ")" ::: "memory")
#define PG8_WAIT_L(n) asm volatile("s_waitcnt lgkmcnt(" #n ")" ::: "memory")
#define PG8_BAR __builtin_amdgcn_s_barrier()
#define PG8_SCHED __builtin_amdgcn_sched_barrier(0)
    Unit cur, nxt; int ui = 0;
    if (!S.next(0, cur)) return;
    f32x4 acc[2][2][4][2];
#pragma unroll
    for (int a = 0; a < 2; ++a)
#pragma unroll
        for (int b = 0; b < 2; ++b)
#pragma unroll
            for (int m = 0; m < 4; ++m)
#pragma unroll
                for (int n = 0; n < 2; ++n) acc[a][b][m][n] = (f32x4){0.f, 0.f, 0.f, 0.f};
    bf16x8 At[4][2], B0[2][2], B1[2][2];
    const char* cA = (const char*)g.A + (size_t)cur.pm * tstep; const char* cB = (const char*)g.Bt + (size_t)cur.pn * tstep;
    S.a_ready(cur);
    if constexpr (SP2) {
        PG8_STAGE(PG8_SB(0, 0), cB, voffB); PG8_STAGE(PG8_SB(0, 1), cB + hstep, voffB); PG8_STAGE(PG8_SA(0, 0), cA, voffA); PG8_STAGE(PG8_SA(0, 1), cA + hstep, voffA);
        if (wr == 1) PG8_BAR;
        PG8_WAIT_V(2); PG8_BAR;
        PG8_STAGE(PG8_SB(1, 0), cB + kstep, voffB); PG8_STAGE(PG8_SA(1, 0), cA + kstep, voffA); PG8_STAGE(PG8_SB(1, 1), cB + hstep + kstep, voffB);
        PG8_WAIT_V(6); PG8_BAR;
    } else {
        PG8_STAGE(PG8_SB(0, 0), cB, voffB); PG8_STAGE(PG8_SA(0, 0), cA, voffA); PG8_STAGE(PG8_SB(0, 1), cB + hstep, voffB); PG8_STAGE(PG8_SA(0, 1), cA + hstep, voffA);
        if (wr == 1) PG8_BAR;
        PG8_WAIT_V(4); PG8_BAR;
        PG8_STAGE(PG8_SB(1, 0), cB + kstep, voffB); PG8_STAGE(PG8_SA(1, 0), cA + kstep, voffA); PG8_STAGE(PG8_SB(1, 1), cB + hstep + kstep, voffB);
        PG8_WAIT_V(6); PG8_BAR;
    }
    for (;;) {
        const bool has_next = S.next(ui + 1, nxt);
        const char* nA = has_next ? (const char*)g.A + (size_t)nxt.pm * tstep : cA; const char* nB = has_next ? (const char*)g.Bt + (size_t)nxt.pn * tstep : cB;
        for (int t = 0; t < nt; t += 2) {
            const bool last = (t == nt - 2);
            const char* a1 = cA + (size_t)(t + 1) * kstep;
            const char* a2 = last ? nA : cA + (size_t)(t + 2) * kstep; const char* b2 = last ? nB : cB + (size_t)(t + 2) * kstep;
            const char* a3 = a2 + kstep; const char* b3 = b2 + kstep;
            if (last && has_next) S.a_ready(nxt);
            if constexpr (SP2) {
            PG8_LDB(B0, 0, 0); PG8_LDB(B1, 0, 1); PG8_SCHED; PG8_LDA(At, 0, 0); PG8_STAGE(PG8_SA(1, 1), a1 + hstep, voffA);
            PG8_WAIT_V(8); PG8_WAIT_L(0); PG8_BAR; PG8_MMA(0, 0, At, B0); PG8_MMA(0, 1, At, B1); PG8_BAR; PG8_SCHED;
            PG8_LDA(At, 0, 1); PG8_STAGE(PG8_SB(0, 0), b2, voffB); PG8_STAGE(PG8_SB(0, 1), b2 + hstep, voffB); PG8_STAGE(PG8_SA(0, 0), a2, voffA);
            PG8_WAIT_V(8); PG8_WAIT_L(0); PG8_BAR; PG8_MMA(1, 0, At, B0); PG8_MMA(1, 1, At, B1); PG8_BAR; PG8_SCHED;
            PG8_LDB(B0, 1, 0); PG8_LDB(B1, 1, 1); PG8_SCHED; PG8_LDA(At, 1, 0); PG8_STAGE(PG8_SA(0, 1), a2 + hstep, voffA);
            PG8_WAIT_V(8); PG8_WAIT_L(0); PG8_BAR; PG8_MMA(0, 0, At, B0); PG8_MMA(0, 1, At, B1); PG8_BAR; PG8_SCHED;
            PG8_LDA(At, 1, 1); PG8_STAGE(PG8_SB(1, 0), b3, voffB); PG8_STAGE(PG8_SB(1, 1), b3 + hstep, voffB); PG8_STAGE(PG8_SA(1, 0), a3, voffA);
            PG8_WAIT_V(8); PG8_WAIT_L(0); PG8_BAR; PG8_MMA(1, 0, At, B0); PG8_MMA(1, 1, At, B1); PG8_BAR; PG8_SCHED;
            } else {
            PG8_LDB(B0, 0, 0); PG8_SCHED; PG8_LDA(At, 0, 0); PG8_STAGE(PG8_SA(1, 1), a1 + hstep, voffA);
            PG8_WAIT_L(8); PG8_BAR; PG8_WAIT_L(0); PG8_MMA(0, 0, At, B0); PG8_BAR; PG8_SCHED;
            PG8_LDB(B1, 0, 1); PG8_STAGE(PG8_SB(0, 0), b2, voffB);
            PG8_BAR; PG8_WAIT_L(0); PG8_MMA(0, 1, At, B1); PG8_BAR;
            PG8_LDA(At, 0, 1); PG8_STAGE(PG8_SA(0, 0), a2, voffA);
            PG8_BAR; PG8_WAIT_L(0); PG8_MMA(1, 0, At, B0); PG8_BAR; PG8_SCHED;
            PG8_STAGE(PG8_SB(0, 1), b2 + hstep, voffB);
            PG8_WAIT_V(6); PG8_BAR; PG8_MMA(1, 1, At, B1); PG8_BAR;
            PG8_LDB(B0, 1, 0); PG8_SCHED; PG8_LDA(At, 1, 0); PG8_STAGE(PG8_SA(0, 1), a2 + hstep, voffA);
            PG8_WAIT_L(8); PG8_BAR; PG8_WAIT_L(0); PG8_MMA(0, 0, At, B0); PG8_BAR; PG8_SCHED;
            PG8_LDB(B1, 1, 1); PG8_STAGE(PG8_SB(1, 0), b3, voffB);
            PG8_BAR; PG8_WAIT_L(0); PG8_MMA(0, 1, At, B1); PG8_BAR;
            PG8_LDA(At, 1, 1); PG8_STAGE(PG8_SA(1, 0), a3, voffA);
            PG8_BAR; PG8_WAIT_L(0); PG8_MMA(1, 0, At, B0); PG8_BAR; PG8_SCHED;
            PG8_STAGE(PG8_SB(1, 1), b3 + hstep, voffB);
            PG8_WAIT_V(6); PG8_BAR; PG8_MMA(1, 1, At, B1); PG8_BAR;
            }
        }
        if constexpr (ALIGN_EPI) { if (wr == 0) PG8_BAR; }
        if constexpr (!Epi::AFTER_DRAIN) { E(acc, cur, wr, wc, fr, fq); S.done(cur); }
        if (!has_next) break;
#pragma unroll
        for (int a = 0; a < 2; ++a)
#pragma unroll
            for (int b = 0; b < 2; ++b)
#pragma unroll
                for (int m = 0; m < 4; ++m)
#pragma unroll
                    for (int n = 0; n < 2; ++n) acc[a][b][m][n] = (f32x4){0.f, 0.f, 0.f, 0.f};
        cur = nxt; cA = nA; cB = nB; ++ui;
        if constexpr (ALIGN_EPI) { if (wr == 1) PG8_BAR; }
    }
    PG8_WAIT_V(0);
    if constexpr (!ALIGN_EPI) { if (wr == 0) PG8_BAR; }
    PG8_BAR;
    if constexpr (Epi::AFTER_DRAIN) { E.fused(acc, cur, wr, wc, fr, fq, lds, wid, lane); S.done(cur); }
#undef PG8_SA
#undef PG8_SB
#undef PG8_STAGE
#undef PG8_LDA
#undef PG8_LDB
#undef PG8_MMA
#undef PG8_WAIT_V
#undef PG8_WAIT_L
#undef PG8_BAR
#undef PG8_SCHED
}

struct EpiProj {
    static constexpr bool PERM = true, AFTER_DRAIN = false;
    bf16_t* O; const PG8_LAS float* rs_lds; int pmA; float* kmpart; unsigned* kmaxh;
    __device__ __forceinline__ void operator()(const f32x4 (&acc)[2][2][4][2], const Unit& u, int wr, int wc, int fr, int fq) const {
        const int row0 = u.pm * BM + wr * 64 + fr, col0 = u.pn * BM + wc * 32 + 8 * fq;
        const bool want_km = (u.pn == 9) || (u.pn == 10);
        const bool as_bf16 = (u.pn == 11) || (u.pn == 12);
        float kn[2] = {0.f, 0.f};
        f32x4 cs[2][2];
#pragma unroll
        for (int bj = 0; bj < 2; ++bj)
#pragma unroll
            for (int n = 0; n < 2; ++n) cs[bj][n] = (f32x4){0.f, 0.f, 0.f, 0.f};
        const PG8_LAS float* rsl = rs_lds + ((u.pm == pmA) ? 0 : 256) + wr * 64 + fr;
        float rstd8[2][4];
#pragma unroll
        for (int ai = 0; ai < 2; ++ai)
#pragma unroll
            for (int m = 0; m < 4; ++m) rstd8[ai][m] = rsl[ai * HALF + m * 16];
#pragma unroll
        for (int ai = 0; ai < 2; ++ai)
#pragma unroll
            for (int m = 0; m < 4; ++m) { const size_t row = (size_t)(row0 + ai * HALF + m * 16);
                const float rstd = rstd8[ai][m];
                bf16_t* rowp = O + row * 3840 + col0;
#pragma unroll
                for (int bj = 0; bj < 2; ++bj) { const f32x4 v0 = acc[ai][bj][m][0] * rstd, v1 = acc[ai][bj][m][1] * rstd;
                    if (as_bf16) { const u32x4 wb = {cvt_pk_bf16(v0[0], v0[1]), cvt_pk_bf16(v0[2], v0[3]), cvt_pk_bf16(v1[0], v1[1]), cvt_pk_bf16(v1[2], v1[3])}; *(u32x4*)(rowp + bj * HALF) = wb; }
                    else { bf16x8 w;
                    w[0] = (bf16_t)v0[0]; w[1] = (bf16_t)v0[1]; w[2] = (bf16_t)v0[2]; w[3] = (bf16_t)v0[3]; w[4] = (bf16_t)v1[0]; w[5] = (bf16_t)v1[1]; w[6] = (bf16_t)v1[2]; w[7] = (bf16_t)v1[3];
                    *(bf16x8*)(rowp + bj * HALF) = w; }
                    cs[bj][0] += v0; cs[bj][1] += v1;
                    if (want_km) { float q = ((v0[0] * v0[0] + v0[1] * v0[1]) + (v0[2] * v0[2] + v0[3] * v0[3])) + ((v1[0] * v1[0] + v1[1] * v1[1]) + (v1[2] * v1[2] + v1[3] * v1[3]));
                        q += __shfl_xor(q, 16); q += __shfl_xor(q, 32); kn[bj] = fmaxf(kn[bj], q); } } }
        if (want_km) {
#pragma unroll
            for (int bj = 0; bj < 2; ++bj)
#pragma unroll
                for (int n = 0; n < 2; ++n)
#pragma unroll
                    for (int k = 0; k < 4; ++k) { float v = cs[bj][n][k]; v += __shfl_xor(v, 1); v += __shfl_xor(v, 2); v += __shfl_xor(v, 4); v += __shfl_xor(v, 8); cs[bj][n][k] = v * (1.0f / 256.0f); }
#pragma unroll
            for (int bj = 0; bj < 2; ++bj) { float q = kn[bj]; q = fmaxf(q, __shfl_xor(q, 1)); q = fmaxf(q, __shfl_xor(q, 2)); q = fmaxf(q, __shfl_xor(q, 4)); q = fmaxf(q, __shfl_xor(q, 8));
                if (fr == 0 && fq == 0) atomicMax(kmaxh + (((u.pm >> 4) * 8 + (u.pn - 9) * 4 + bj * 2 + (wc >> 1)) * 2 + (wc & 1)), __float_as_uint(q)); }
            if (fr == 0) {
#pragma unroll
                for (int bj = 0; bj < 2; ++bj)
#pragma unroll
                    for (int n = 0; n < 2; ++n) { const int cm = col0 + bj * HALF + 4 * n - 2304;
                        *(f32x4*)(kmpart + ((size_t)((wr * 8 + (u.pm >> 4)) * 8 + (cm >> 6)) * 16 + (u.pm & 15)) * 64 + (cm & 63)) = cs[bj][n]; }
            }
        }
    }
};
template <int LAYER> struct EpiRes {
    static constexpr bool PERM = true, AFTER_DRAIN = false;
    const float* x0; float* xout; bf16_t* xh; float* rowss;
    __device__ __forceinline__ void operator()(const f32x4 (&acc)[2][2][4][2], const Unit& u, int wr, int wc, int fr, int fq) const {
        const int row0 = u.pm * BM + wr * 64 + fr, col0 = u.pn * BM + wc * 32 + 8 * fq;
#pragma unroll
        for (int ai = 0; ai < 2; ++ai) {
            bf16x8 xq[4][2];
#pragma unroll
            for (int m = 0; m < 4; ++m)
#pragma unroll
                for (int bj = 0; bj < 2; ++bj) xq[m][bj] = *(const bf16x8*)(xh + (size_t)(row0 + ai * HALF + m * 16) * 1024 + col0 + bj * HALF);
#pragma unroll
            for (int m = 0; m < 4; ++m) { const size_t row = (size_t)(row0 + ai * HALF + m * 16); float ss = 0.f;
#pragma unroll
                for (int bj = 0; bj < 2; ++bj) { const size_t off = row * 1024 + col0 + bj * HALF; const bf16x8 xp = xq[m][bj];
                    const f32x4 v0 = (f32x4){(float)xp[0], (float)xp[1], (float)xp[2], (float)xp[3]} + acc[ai][bj][m][0], v1 = (f32x4){(float)xp[4], (float)xp[5], (float)xp[6], (float)xp[7]} + acc[ai][bj][m][1];
                    bf16x8 w; w[0] = (bf16_t)v0[0]; w[1] = (bf16_t)v0[1]; w[2] = (bf16_t)v0[2]; w[3] = (bf16_t)v0[3]; w[4] = (bf16_t)v1[0]; w[5] = (bf16_t)v1[1]; w[6] = (bf16_t)v1[2]; w[7] = (bf16_t)v1[3];
                    *(bf16x8*)(xh + off) = w;
                    ss += ((v0[0] * v0[0] + v0[1] * v0[1]) + (v0[2] * v0[2] + v0[3] * v0[3])) + ((v1[0] * v1[0] + v1[1] * v1[1]) + (v1[2] * v1[2] + v1[3] * v1[3])); }
                ss += __shfl_xor(ss, 16); ss += __shfl_xor(ss, 32);
                if (fq == 0) rowss[row * 16 + u.pn * 4 + wc] = ss; }
            asm volatile("" ::: "memory");
        }
    }
};
}


__device__ __forceinline__ void deferred_transposes(const Params& p, unsigned char* lds, int id, int n) {
    float* tile = (float*)lds;
    h16* win = (h16*)(p.ws + WS_WIN); h16* wout = (h16*)(p.ws + WS_WOUT); h16* wpw = (h16*)(p.ws + WS_WPW);
    constexpr int U_IN = 16 * 60, U_OUT = 16 * 16, U_PW = 4 * 4;
    for (int u = id; u < U_IN + 2 * U_OUT + 2 * U_PW; u += n) {
        int r = u;
        if (r < U_IN) { transpose_unit(p.w_in + (size_t)DM * NIN, DM, NIN, win + (size_t)NIN * DM, p.norm_g + DM, (r / 60) * 64, (r % 60) * 64, tile); continue; }
        r -= U_IN;
        if (r < 2 * U_OUT) { const int layer = r / U_OUT; r %= U_OUT; transpose_unit(p.w_out + (size_t)layer * DM * DM, DM, DM, wout + (size_t)layer * DM * DM, nullptr, (r / 16) * 64, (r % 16) * 64, tile); continue; }
        r -= 2 * U_OUT;
        { const int layer = r / U_PW; r %= U_PW; transpose_unit(p.pw_w + (size_t)layer * 256 * 256, 256, 256, wpw + (size_t)layer * 256 * 256, nullptr, (r / 4) * 64, (r % 4) * 64, tile); }
    }
}

__device__ __forceinline__ void gemm_in(const Params& p, int layer, unsigned char* lds) {
    pg8::Gemm g{(const h16*)(p.ws + WS_XH), (const h16*)(p.ws + WS_WIN) + (size_t)layer * NIN * DM, MROWS, NIN, DM};
    pg8::StaticOrder S; S.init(MROWS, NIN, (int)gridDim.x, (int)blockIdx.x);
    PG8_LAS float* rs_lds = (PG8_LAS float*)((PG8_LAS unsigned char*)lds + pg8::STAGE_BYTES);
    int pmA = 0, pmB = 0;
    { pg8::Unit u; if (S.next(0, u)) { pmA = u.pm; pmB = u.pm; for (int i = 1; S.next(i, u); ++i) pmB = u.pm; }
      const int t = threadIdx.x; const size_t row = (size_t)((t >> 8) ? pmB : pmA) * 256 + (t & 255);
      const f32x4* rs = (const f32x4*)((const float*)(p.ws + WS_ROWSS) + row * 16); const f32x4 s0 = rs[0], s1 = rs[1], s2 = rs[2], s3 = rs[3];
      const float tot = ((s0[0] + s0[1]) + (s0[2] + s0[3])) + ((s1[0] + s1[1]) + (s1[2] + s1[3])) + ((s2[0] + s2[1]) + (s2[2] + s2[3])) + ((s3[0] + s3[1]) + (s3[2] + s3[3]));
      rs_lds[t] = rsqrtf(tot * (1.0f / 1024.0f) + 1e-6f);
      __syncthreads(); }
    pg8::EpiProj E{(h16*)(p.ws + WS_PROJ), rs_lds, pmA, (float*)(p.ws + WS_KMEAN), (unsigned*)(p.ws + WS_CTL + 20480) + layer * 128};
    pg8::gemm_phase<pg8::EpiProj, pg8::StaticOrder, true, true>((PG8_LAS unsigned char*)lds, g, S, E);
    if (layer == 0) { const int G = (int)gridDim.x, nfull = (MROWS / 256) * (NIN / 256) % G;
        if (nfull == 0) deferred_transposes(p, lds, (int)blockIdx.x, G); else if ((int)blockIdx.x >= nfull) deferred_transposes(p, lds, (int)blockIdx.x - nfull, G - nfull); }
}
template <int LAYER> __device__ __forceinline__ void gemm_out(const Params& p, unsigned char* lds) {
    pg8::Gemm g{(const h16*)(p.ws + WS_MIX), (const h16*)(p.ws + WS_WOUT) + (size_t)LAYER * DM * DM, MROWS, DM, DM};
    pg8::StaticOrder S; S.init(MROWS, DM, (int)gridDim.x, (int)blockIdx.x);
    pg8::EpiRes<LAYER> E{p.x, p.out, (h16*)(p.ws + WS_XH), (float*)(p.ws + WS_ROWSS)};
    pg8::gemm_phase<pg8::EpiRes<LAYER>, pg8::StaticOrder, true, true>((PG8_LAS unsigned char*)lds, g, S, E);
}

__device__ __forceinline__ void phase_stats(const Params& p, int layer, unsigned char* lds_g) {
    LAS unsigned char* lds = (LAS unsigned char*)lds_g;
    const h16* proj = (const h16*)(p.ws + WS_PROJ); float* kv = (float*)(p.ws + WS_KV);
    const int tid = threadIdx.x, lane = tid & 63, wid = __builtin_amdgcn_readfirstlane(tid >> 6), r = lane & 31, hi = lane >> 5;
    const int lanepart = (4 * hi + ((lane & 15) >> 2)) * 64 + ((lane >> 4) & 1) * 32 + (lane & 3) * 8;
#pragma unroll 1
    for (int u = blockIdx.x; u < 256; u += gridDim.x) {
        const int b = u >> 5, hh = (u >> 3) & 3, nq = u & 7;
        const float log_g = logf(1.0f - exp2f(-5.0f - (float)hh));
        h16x8 kk[8], vv[8];
#pragma unroll
        for (int it = 0; it < 8; ++it) {
            const int pc = tid + 512 * it, cn = pc >> 10, key = (pc >> 3) & 127, ch = pc & 7;
            const h16* src = proj + (size_t)(b * SEQ + (4 * nq + cn) * 128 + key) * NIN + hh * 64 + ch * 8;
            kk[it] = *(const h16x8*)(src + C_RK); vv[it] = *(const h16x8*)(src + C_RV);
        }
        __syncthreads();
#pragma unroll
        for (int it = 0; it < 8; ++it) {
            const int pc = tid + 512 * it, cn = pc >> 10, key = (pc >> 3) & 127, ch = pc & 7;
            const float z = __expf(log_g * (float)(127 - key)) * 0.125f;
#pragma unroll
            for (int k = 0; k < 8; ++k) kk[it][k] = (h16)((float)kk[it][k] * z);
            const int off = cn * 32768 + (ch >> 2) * 8192 + (key >> 4) * 1024 + (key & 15) * 64 + (ch & 3) * 16;
            *(LAS h16x8*)(lds + off) = kk[it]; *(LAS h16x8*)(lds + off + 16384) = vv[it];
        }
        __syncthreads();
#pragma unroll
        for (int half = 0; half < 2; ++half) {
            const int cn = 2 * half + (wid >> 2), eb = (wid >> 1) & 1, dbk = wid & 1;
            const LAS unsigned char* kimg = lds + cn * 32768 + dbk * 8192 + lanepart; const LAS unsigned char* vimg = lds + cn * 32768 + 16384 + eb * 8192 + lanepart;
            f32x16 acc;
#pragma unroll
            for (int i = 0; i < 16; ++i) acc[i] = 0.f;
#pragma unroll
            for (int ks = 0; ks < 8; ++ks) acc = __builtin_amdgcn_mfma_f32_32x32x16_f16(tr_frag(vimg + ks * 1024), tr_frag(kimg + ks * 1024), acc, 0, 0, 0);
            float* dst = kv + ((size_t)((b * 4 + hh) * 32 + 4 * nq + cn)) * 4096 + (32 * eb + 4 * hi) * 64 + 32 * dbk + r;
#pragma unroll
            for (int i = 0; i < 16; ++i) dst[CROW0(i) * 64] = acc[i];
        }
    }
}

typedef _Float16 h16x2 __attribute__((ext_vector_type(2)));
typedef float f32x2 __attribute__((ext_vector_type(2)));
__device__ __forceinline__ void conv_unit(const Params& p, int layer, int b, int tt, unsigned char* lds_g) {
    LAS unsigned char* lds = (LAS unsigned char*)lds_g;
    const h16* projb = (const h16*)(p.ws + WS_PROJ) + (size_t)b * SEQ * NIN; h16* mix = (h16*)(p.ws + WS_MIX);
    const int tid = threadIdx.x, lane = tid & 63, wid = __builtin_amdgcn_readfirstlane(tid >> 6), r = lane & 31, hi = lane >> 5;
    const int cp = tid & 127, tg = __builtin_amdgcn_readfirstlane(tid >> 7), t0 = tt * 64;
    constexpr int UIMG = 0  , SIMG = 0, YS = 49152  ;
    {
        h16x8 av[6], gv[6];
#pragma unroll
        for (int it = 0; it < 6; ++it) { const int pi = tid + 512 * it, row = pi >> 5, c8 = pi & 31; const int t = t0 - 30 + row;
            const size_t ro = (size_t)((row < 94 && t >= 0) ? t : 0) * NIN + 8 * c8;
            av[it] = *(const h16x8*)(projb + ro + C_AVAL); gv[it] = *(const h16x8*)(projb + ro + C_AGLU); }
        __syncthreads();
#pragma unroll
        for (int it = 0; it < 6; ++it) { const int pi = tid + 512 * it, row = pi >> 5, c8 = pi & 31; const bool ok = (t0 - 30 + row >= 0);
            h16x8 u;
#pragma unroll
            for (int k = 0; k < 8; ++k) u[k] = ok ? (h16)((float)av[it][k] * __builtin_amdgcn_rcpf(1.0f + __expf(-(float)gv[it][k]))) : (h16)0.f;
            if (row < 94) *(LAS h16x8*)(lds + UIMG + row * 512 + c8 * 16) = u; }
    }
    float y0[16], y1[16];
    {
        float w0[31], w1[31]; const float* cw = p.conv_w + (size_t)layer * 31 * 256 + 2 * cp;
#pragma unroll
        for (int jj = 0; jj < 31; ++jj) { const f32x2 wv = *(const f32x2*)(cw + jj * 256); w0[jj] = wv[0]; w1[jj] = wv[1]; }
        const f32x2 cbv = *(const f32x2*)(p.conv_b + layer * 256 + 2 * cp);
#pragma unroll
        for (int tl = 0; tl < 16; ++tl) { y0[tl] = cbv[0]; y1[tl] = cbv[1]; }
        __syncthreads();
        const LAS unsigned char* ub = lds + UIMG + (16 * tg) * 512 + 4 * cp;
#pragma unroll
        for (int rr = 0; rr < 46; ++rr) { const h16x2 uv = *(const LAS h16x2*)(ub + rr * 512); const float a0 = (float)uv[0], a1 = (float)uv[1];
#pragma unroll
            for (int tl = 0; tl < 16; ++tl) { const int jj = rr - tl; if (jj >= 0 && jj < 31) { y0[tl] += w0[jj] * a0; y1[tl] += w1[jj] * a1; } } }
    }
#pragma unroll
    for (int tl = 0; tl < 16; ++tl) *(LAS f32x2*)(lds + YS + ((16 * tg + tl) * 256 + 2 * cp) * 4) = (f32x2){y0[tl], y1[tl]};
    h16x8 wf[16]; h16x4 gpre[2][4];
    {
        const h16* wp = (const h16*)(p.ws + WS_WPW) + (size_t)layer * 65536 + (size_t)(32 * wid + r) * 256 + 8 * hi;
#pragma unroll
        for (int ks = 0; ks < 16; ++ks) wf[ks] = *(const h16x8*)(wp + 16 * ks);
#pragma unroll
        for (int tb = 0; tb < 2; ++tb) { const h16* gp = projb + (size_t)(t0 + 32 * tb + r) * NIN + C_AGATE + 32 * wid + 4 * hi;
#pragma unroll
            for (int g = 0; g < 4; ++g) gpre[tb][g] = *(const h16x4*)(gp + 8 * g); }
    }
    __syncthreads();
    {
        const f32x4 lg = *(const f32x4*)(p.ln_g + layer * 256 + lane * 4), lb = *(const f32x4*)(p.ln_b + layer * 256 + lane * 4);
#pragma unroll 1
        for (int kb = 0; kb < 8; kb += 4) {
        f32x4 v[4]; float s1[4], s2[4];
#pragma unroll
        for (int k = 0; k < 4; ++k) { v[k] = *(const LAS f32x4*)(lds + YS + ((wid * 8 + kb + k) * 256 + lane * 4) * 4);
            s1[k] = (v[k][0] + v[k][1]) + (v[k][2] + v[k][3]); s2[k] = (v[k][0] * v[k][0] + v[k][1] * v[k][1]) + (v[k][2] * v[k][2] + v[k][3] * v[k][3]); }
#pragma unroll
        for (int o = 1; o < 64; o <<= 1)
#pragma unroll
            for (int k = 0; k < 4; ++k) { s1[k] += __shfl_xor(s1[k], o); s2[k] += __shfl_xor(s2[k], o); }
#pragma unroll
        for (int k = 0; k < 4; ++k) { const int t = wid * 8 + kb + k; const float mu = s1[k] * (1.0f / 256.0f); const float var = fmaxf(s2[k] * (1.0f / 256.0f) - mu * mu, 0.f); const float rs = rsqrtf(var + 1e-5f);
            h16x4 o; o[0] = (h16)silu_f((v[k][0] - mu) * rs * lg[0] + lb[0]); o[1] = (h16)silu_f((v[k][1] - mu) * rs * lg[1] + lb[1]); o[2] = (h16)silu_f((v[k][2] - mu) * rs * lg[2] + lb[2]); o[3] = (h16)silu_f((v[k][3] - mu) * rs * lg[3] + lb[3]);
            *(LAS h16x4*)(lds + SIMG + t * 512 + (((lane >> 1) ^ (t & 15)) << 4) + 8 * (lane & 1)) = o; }
        }
    }
    __syncthreads();
#pragma unroll
    for (int tb = 0; tb < 2; ++tb) {
        f32x16 acc;
#pragma unroll
        for (int i = 0; i < 16; ++i) acc[i] = 0.f;
#pragma unroll
        for (int ks = 0; ks < 16; ++ks) acc = __builtin_amdgcn_mfma_f32_32x32x16_f16(wf[ks], *(const LAS h16x8*)(lds + SIMG + (32 * tb + r) * 512 + (((2 * ks + hi) ^ (r & 15)) << 4)), acc, 0, 0, 0);
        const int t = t0 + 32 * tb + r, n0 = 32 * wid + 4 * hi;
        h16* dst = mix + ((size_t)b * SEQ + t) * DM + n0; const float* pb = p.pw_b + layer * 256 + n0;
#pragma unroll
        for (int g = 0; g < 4; ++g) { const h16x4 ga = gpre[tb][g]; const f32x4 bb = *(const f32x4*)(pb + 8 * g); h16x4 oa;
#pragma unroll
            for (int k = 0; k < 4; ++k) oa[k] = (h16)((acc[4 * g + k] + bb[k]) * silu_f((float)ga[k]));
            *(h16x4*)(dst + 8 * g) = oa; }
    }
}

__device__ __forceinline__ void ret_unit(const Params& p, int b, int hh, int n, unsigned char* lds_g) {
    LAS unsigned char* lds = (LAS unsigned char*)lds_g;
    const h16* projb = (const h16*)(p.ws + WS_PROJ) + (size_t)(b * SEQ + n * 128) * NIN; h16* mix = (h16*)(p.ws + WS_MIX); const float* kv = (const float*)(p.ws + WS_KV);
    const int tid = threadIdx.x, lane = tid & 63, wid = __builtin_amdgcn_readfirstlane(tid >> 6), r = lane & 31, hi = lane >> 5, g4 = wid & 3, eh = wid >> 2;
    const float log_g = logf(1.0f - exp2f(-5.0f - (float)hh));
    constexpr int KIMG = 0, VIMG = 16384, RIMG = 32768, XS = 40960;
    const h16x8 rr = *(const h16x8*)((const h16*)(p.ws + WS_RST) + ((size_t)((b * 4 + hh) * 32 + n)) * 4096 + tid * 8);
    h16x4 gpre[4];
    { const h16* gp0 = projb + (size_t)(32 * g4 + r) * NIN + C_RGATE + hh * 64 + 32 * eh + 4 * hi;
#pragma unroll
      for (int g = 0; g < 4; ++g) gpre[g] = *(const h16x4*)(gp0 + 8 * g); }
    __syncthreads();
    {
        const int e = tid >> 3, ch = tid & 7;
        *(LAS h16x8*)(lds + RIMG + e * 128 + ((ch ^ ((e >> 1) & 7)) << 4)) = rr;
#pragma unroll
        for (int it = 0; it < 2; ++it) {
            const int key = (tid >> 3) + 64 * it;
            h16x8 kk = *(const h16x8*)(projb + (size_t)key * NIN + C_RK + hh * 64 + ch * 8); const h16x8 vv = *(const h16x8*)(projb + (size_t)key * NIN + C_RV + hh * 64 + ch * 8);
            const float z = __expf(-log_g * (float)key) * 0.125f;
#pragma unroll
            for (int k = 0; k < 8; ++k) kk[k] = (h16)((float)kk[k] * z);
            *(LAS h16x8*)(lds + KIMG + key * 128 + ((ch ^ ((key >> 1) & 7)) << 4)) = kk;
            *(LAS h16x8*)(lds + VIMG + (ch >> 2) * 8192 + (key >> 4) * 1024 + (key & 15) * 64 + (ch & 3) * 16) = vv;
        }
    }
    const int qi = 32 * g4 + r;
    h16x8 qf[4];
    {
        const float zq = __expf(log_g * (float)qi);
#pragma unroll
        for (int s = 0; s < 4; ++s) { qf[s] = *(const h16x8*)(projb + (size_t)qi * NIN + C_RQ + hh * 64 + 16 * s + 8 * hi);
#pragma unroll
            for (int k = 0; k < 8; ++k) qf[s][k] = (h16)((float)qf[s][k] * zq); }
    }
    __syncthreads();
    const int rsw = (r >> 1) & 7;
    const int lanepart = (4 * hi + ((lane & 15) >> 2)) * 64 + ((lane >> 4) & 1) * 32 + (lane & 3) * 8;
    f32x16 o;
#pragma unroll
    for (int i = 0; i < 16; ++i) o[i] = 0.f;
#pragma unroll 1
    for (int jb = 0; jb <= g4; ++jb) {
        f32x16 c;
#pragma unroll
        for (int i = 0; i < 16; ++i) c[i] = 0.f;
#pragma unroll
        for (int s = 0; s < 4; ++s) c = __builtin_amdgcn_mfma_f32_32x32x16_f16(*(const LAS h16x8*)(lds + KIMG + (32 * jb + r) * 128 + (((2 * s + hi) ^ rsw) << 4)), qf[s], c, 0, 0, 0);
        if (jb == g4) {
#pragma unroll
            for (int i = 0; i < 16; ++i) if (CROW0(i) + 4 * hi > r) c[i] = 0.f;
        }
        h16x8 pf0, pf1;
#pragma unroll
        for (int k = 0; k < 8; ++k) { pf0[k] = (h16)c[k]; pf1[k] = (h16)c[8 + k]; }
        o = __builtin_amdgcn_mfma_f32_32x32x16_f16(tr_frag(lds + VIMG + eh * 8192 + (2 * jb) * 1024 + lanepart), pf0, o, 0, 0, 0);
        o = __builtin_amdgcn_mfma_f32_32x32x16_f16(tr_frag(lds + VIMG + eh * 8192 + (2 * jb + 1) * 1024 + lanepart), pf1, o, 0, 0, 0);
    }
#pragma unroll
    for (int s = 0; s < 4; ++s) o = __builtin_amdgcn_mfma_f32_32x32x16_f16(*(const LAS h16x8*)(lds + RIMG + (32 * eh + r) * 128 + (((2 * s + hi) ^ rsw) << 4)), qf[s], o, 0, 0, 0);
    float s1 = 0.f, s2 = 0.f;
#pragma unroll
    for (int i = 0; i < 16; ++i) { s1 += o[i]; s2 += o[i] * o[i]; }
    s1 = xhalf_sum(s1); s2 = xhalf_sum(s2);
    LAS float* xs = (LAS float*)(lds + XS);
    if (hi == 0) { xs[(wid * 32 + r) * 2] = s1; xs[(wid * 32 + r) * 2 + 1] = s2; }
    __syncthreads();
    {
        const float t1 = xs[((wid ^ 4) * 32 + r) * 2], t2 = xs[((wid ^ 4) * 32 + r) * 2 + 1];
        const float a1 = (eh == 0) ? (s1 + t1) : (t1 + s1), a2 = (eh == 0) ? (s2 + t2) : (t2 + s2);
        const float mu = a1 * (1.0f / 64.0f); const float var = fmaxf(a2 * (1.0f / 64.0f) - mu * mu, 0.f); const float rs = rsqrtf(var + 1e-5f);
        const int col = hh * 64 + 32 * eh + 4 * hi;
        h16* dst = mix + ((size_t)(b * SEQ + n * 128 + qi)) * DM + 256 + col;
#pragma unroll
        for (int g = 0; g < 4; ++g) { const h16x4 ga = gpre[g]; h16x4 oa;
#pragma unroll
            for (int k = 0; k < 4; ++k) oa[k] = (h16)((o[4 * g + k] - mu) * rs * silu_f((float)ga[k]));
            *(h16x4*)(dst + 8 * g) = oa; }
    }
}

constexpr float MOBA_THR = 8.0f;
__device__ __forceinline__ void moba_unit(const Params& p, int layer, int b, int hh, int j, unsigned char* lds_g) {
    LAS unsigned char* lds = (LAS unsigned char*)lds_g;
    const int tid = threadIdx.x, lane = tid & 63, wid = __builtin_amdgcn_readfirstlane(tid >> 6), r = lane & 31, hi = lane >> 5;
    const h16* projb = (const h16*)(p.ws + WS_PROJ) + (size_t)b * SEQ * NIN; h16* mix = (h16*)(p.ws + WS_MIX);
    const int qrow = j * 256 + wid * 32 + r;
    h16x8 qf[4];
#pragma unroll
    for (int s = 0; s < 4; ++s) qf[s] = *(const h16x8*)(projb + (size_t)qrow * NIN + C_MQ + hh * 64 + 16 * s + 8 * hi);
    const unsigned lds0 = (unsigned)(__UINTPTR_TYPE__)lds;
    const int dkey = 8 * wid + (lane >> 3);
    const h16* ksrc = projb + (size_t)dkey * NIN + C_MK + hh * 64 + (((lane & 7) ^ ((dkey >> 1) & 7)) << 3);
    const h16* vsrc = projb + (size_t)(16 * (wid & 3) + (lane >> 2)) * NIN + C_MV + hh * 64 + (wid >> 2) * 32 + (lane & 3) * 8;
    const unsigned kdst = lds0 + wid * 1024, vdst = lds0 + 8192 + (wid >> 2) * 4096 + (wid & 3) * 1024;
#define MOBA_DMA(tile) do { const int kp_ = j * 256 + 192 - 64 * (tile); const unsigned so_ = (unsigned)(((tile) & 7) * 16384); \
        glds16(ksrc + (size_t)kp_ * NIN, (unsigned)__builtin_amdgcn_readfirstlane(kdst + so_)); glds16(vsrc + (size_t)kp_ * NIN, (unsigned)__builtin_amdgcn_readfirstlane(vdst + so_)); } while (0)
#define MOBA_WAIT_BAR(N) asm volatile("s_waitcnt vmcnt(" #N ") lgkmcnt(0)\n\ts_barrier" ::: "memory")
    MOBA_DMA(0); MOBA_DMA(1); MOBA_DMA(2);
    f32x4 kmr[4][4];
    { const float* km = (const float*)(p.ws + WS_KMEAN) + ((size_t)(b * 8 + hh) * 16 + (r & 15)) * 64 + 8 * hi;
#pragma unroll
      for (int s = 0; s < 4; ++s) {
#pragma unroll
          for (int c = 0; c < 4; ++c) kmr[s][c] = (f32x4){0.f, 0.f, 0.f, 0.f};
          if (j > 3 && r < j) { kmr[s][0] = *(const f32x4*)(km + 16 * s); kmr[s][1] = *(const f32x4*)(km + 65536 + 16 * s); kmr[s][2] = *(const f32x4*)(km + 16 * s + 4); kmr[s][3] = *(const f32x4*)(km + 65536 + 16 * s + 4); } } }
    const unsigned* kmh = (const unsigned*)(p.ws + WS_CTL + 20480) + layer * 128 + (b * 8 + hh) * 2;
    const float kmax2 = __uint_as_float(__hip_atomic_load(kmh, __ATOMIC_RELAXED, __HIP_MEMORY_SCOPE_AGENT)) + __uint_as_float(__hip_atomic_load(kmh + 1, __ATOMIC_RELAXED, __HIP_MEMORY_SCOPE_AGENT));
    h16x4 gpre[8];
    { const h16* gp = projb + (size_t)qrow * NIN + C_MGATE + hh * 64 + 4 * hi;
#pragma unroll
      for (int g = 0; g < 4; ++g) { gpre[2 * g] = *(const h16x4*)(gp + 8 * g); gpre[2 * g + 1] = *(const h16x4*)(gp + 32 + 8 * g); } }
    MOBA_WAIT_BAR(0);
    MOBA_DMA(3); if (4 < 4 * (j + 1)) MOBA_DMA(4);
    unsigned selmask = 0u;
    if (j <= 3) selmask = (1u << j) - 1u;
    else {
        f32x16 g;
#pragma unroll
        for (int i = 0; i < 16; ++i) g[i] = 0.f;
#pragma unroll
        for (int s = 0; s < 4; ++s) {
            const f32x4 a0 = kmr[s][0] + kmr[s][1], a1 = kmr[s][2] + kmr[s][3];
            h16x8 ah, al;
#pragma unroll
            for (int k = 0; k < 4; ++k) { const h16 h0 = (h16)a0[k], h1 = (h16)a1[k]; ah[k] = h0; ah[4 + k] = h1; al[k] = (h16)(a0[k] - (float)h0); al[4 + k] = (h16)(a1[k] - (float)h1); }
            g = __builtin_amdgcn_mfma_f32_32x32x16_f16(ah, qf[s], g, 0, 0, 0);
            g = __builtin_amdgcn_mfma_f32_32x32x16_f16(al, qf[s], g, 0, 0, 0);
        }
        float gate[16];
#pragma unroll
        for (int i = 0; i < 8; ++i) { auto rr = __builtin_amdgcn_permlane32_swap(__float_as_uint(g[i]), __float_as_uint(g[i]), false, false);
            gate[(i & 3) + 8 * (i >> 2)] = __uint_as_float(rr[0]); gate[(i & 3) + 8 * (i >> 2) + 4] = __uint_as_float(rr[1]); }
        float g0 = -3.0e38f, g1 = -3.0e38f, g2 = -3.0e38f; int i0 = 0, i1 = 0, i2 = 0;
#pragma unroll
        for (int n = 0; n < 15; ++n) { const float s = (n < j) ? gate[n] : -3.0e38f;
            if (s > g0) { g2 = g1; i2 = i1; g1 = g0; i1 = i0; g0 = s; i0 = n; }
            else if (s > g1) { g2 = g1; i2 = i1; g1 = s; i1 = n; }
            else if (s > g2) { g2 = s; i2 = n; } }
        selmask = (1u << i0) | (1u << i1) | (1u << i2);
    }
    constexpr float C2 = 0.125f * 1.4426950408889634f;
    float qn2 = 0.f;
#pragma unroll
    for (int s = 0; s < 4; ++s)
#pragma unroll
        for (int k = 0; k < 8; ++k) { qf[s][k] = (h16)((float)qf[s][k] * C2); qn2 += (float)qf[s][k] * (float)qf[s][k]; }
    const float qbound = sqrtf(xhalf_sum(qn2)) * sqrtf(kmax2) * 1.002f;
    const float slope2 = exp2f(-(float)(hh + 1)) * 1.4426950408889634f;
    h16x8 aK0, aK1;
#pragma unroll
    for (int k = 0; k < 8; ++k) { aK0[k] = (h16)0.f; aK1[k] = (h16)0.f; }
    if (hi == 0) { aK0[0] = (h16)(float)r; aK0[1] = aK0[0]; aK0[2] = (h16)1.f; aK0[3] = (h16)1.f; aK1[0] = (h16)(float)(32 + r); aK1[1] = aK1[0]; aK1[2] = (h16)1.f; aK1[3] = (h16)1.f; }
    const h16 slh = (h16)slope2, sll = (h16)(slope2 - (float)slh);
    f32x16 zero16;
#pragma unroll
    for (int i = 0; i < 16; ++i) zero16[i] = 0.f;
    f32x16 o0, o1;
#pragma unroll
    for (int i = 0; i < 16; ++i) { o0[i] = 0.f; o1[i] = 0.f; }
    float mref = 0.f, lsum = 0.f; bool first = true;
    const int rK = r * 128, rsw = (r >> 1) & 7;
    const int rV = 8192 + (4 * hi + ((lane & 15) >> 2)) * 64 + ((lane >> 4) & 1) * 32 + (lane & 3) * 8;
    const int nt = 4 * (j + 1);
    const int wdiag = wid >> 1;
#define MOBA_CIN(T, C0, C1) do { const int kp_ = j * 256 + 192 - 64 * (T); const int nb_ = kp_ >> 8; const bool own_ = (nb_ == j); \
        const bool val_ = own_ ? true : (((selmask >> (nb_ & 31)) & 1u) != 0u); \
        const float base_ = val_ ? __builtin_fmaf(slope2, (float)(kp_ - qrow), -mref) : -60000.0f; \
        const h16 bh_ = (h16)base_; const h16 bl_ = (h16)(base_ - (float)bh_); \
        h16x8 bK_; bK_[0] = slh; bK_[1] = sll; bK_[2] = bh_; bK_[3] = bl_; bK_[4] = (h16)0.f; bK_[5] = (h16)0.f; bK_[6] = (h16)0.f; bK_[7] = (h16)0.f; \
        C0 = __builtin_amdgcn_mfma_f32_32x32x16_f16(aK0, bK_, zero16, 0, 0, 0); C1 = __builtin_amdgcn_mfma_f32_32x32x16_f16(aK1, bK_, zero16, 0, 0, 0); } while (0)
#define MOBA_DIAG(T, C0, C1) do { const int kp_ = j * 256 + 192 - 64 * (T); const int tl_ = (kp_ >> 6) & 3; \
        if (((kp_ >> 8) == j) && tl_ >= wdiag) { const int lim2_ = 32 * wid - 64 * tl_ + r - 4 * hi; \
            _Pragma("unroll") for (int i = 0; i < 16; ++i) { if (CROW0(i) > lim2_) C0[i] = -INFINITY; if (CROW0(i) + 32 > lim2_) C1[i] = -INFINITY; } } } while (0)
#define MOBA_QK(T, C0, C1) do { const LAS unsigned char* kb_ = lds + ((T) & 7) * 16384 + rK; \
        _Pragma("unroll") for (int s = 0; s < 4; ++s) { \
            const h16x8 k0_ = *(const LAS h16x8*)(kb_ + (((2 * s + hi) ^ rsw) << 4)), k1_ = *(const LAS h16x8*)(kb_ + 4096 + (((2 * s + hi) ^ rsw) << 4)); \
            C0 = __builtin_amdgcn_mfma_f32_32x32x16_f16(k0_, qf[s], C0, 0, 0, 0); C1 = __builtin_amdgcn_mfma_f32_32x32x16_f16(k1_, qf[s], C1, 0, 0, 0); } } while (0)
#define MOBA_DECIDE(T, C0, C1) do { MOBA_DIAG(T, C0, C1); float m_ = __builtin_fmaxf(C0[0], C1[0]); \
        _Pragma("unroll") for (int i = 1; i < 16; ++i) m_ = __builtin_fmaxf(__builtin_fmaxf(m_, C0[i]), C1[i]); \
        m_ = xhalf_max(m_); \
        const int kp_ = j * 256 + 192 - 64 * (T); const bool fst_ = ((kp_ >> 8) == j) && (((kp_ >> 6) & 3) == wdiag); \
        if (fst_ || __any(m_ > MOBA_THR)) { const float dl_ = fst_ ? m_ : __builtin_fmaxf(m_, 0.f); const float f_ = fst_ ? 1.0f : __builtin_amdgcn_exp2f(-dl_); mref += dl_; lsum *= f_; \
            _Pragma("unroll") for (int i = 0; i < 16; ++i) { C0[i] -= dl_; C1[i] -= dl_; o0[i] *= f_; o1[i] *= f_; } } } while (0)
#define MOBA_STEP(T, TE, P0, P1, N0, N1) do { \
        MOBA_CIN((T) + 1, N0, N1); MOBA_QK((T) + 1, N0, N1); \
        float pa_ = 0.f, pb_ = 0.f, pc_ = 0.f, pd_ = 0.f; \
        _Pragma("unroll") for (int i = 0; i < 16; ++i) { P0[i] = __builtin_amdgcn_exp2f(P0[i]); P1[i] = __builtin_amdgcn_exp2f(P1[i]); } \
        _Pragma("unroll") for (int i = 0; i < 16; i += 2) { pa_ = fadd_s(pa_, P0[i]); pb_ = fadd_s(pb_, P1[i]); pc_ = fadd_s(pc_, P0[i + 1]); pd_ = fadd_s(pd_, P1[i + 1]); } \
        lsum += fadd_s(fadd_s(pa_, pb_), fadd_s(pc_, pd_)); \
        b16x8 pf_[4]; \
        { \
              \
            const u32x4 w0_ = {pk_bf16(P0[0], P0[1]), pk_bf16(P0[2], P0[3]), pk_bf16(P0[4], P0[5]), pk_bf16(P0[6], P0[7])}; \
            const u32x4 w1_ = {pk_bf16(P0[8], P0[9]), pk_bf16(P0[10], P0[11]), pk_bf16(P0[12], P0[13]), pk_bf16(P0[14], P0[15])}; \
            const u32x4 w2_ = {pk_bf16(P1[0], P1[1]), pk_bf16(P1[2], P1[3]), pk_bf16(P1[4], P1[5]), pk_bf16(P1[6], P1[7])}; \
            const u32x4 w3_ = {pk_bf16(P1[8], P1[9]), pk_bf16(P1[10], P1[11]), pk_bf16(P1[12], P1[13]), pk_bf16(P1[14], P1[15])}; \
            pf_[0] = __builtin_bit_cast(b16x8, w0_); pf_[1] = __builtin_bit_cast(b16x8, w1_); pf_[2] = __builtin_bit_cast(b16x8, w2_); pf_[3] = __builtin_bit_cast(b16x8, w3_); } \
        { const LAS unsigned char* vb_ = lds + ((T) & 7) * 16384 + rV; \
          _Pragma("unroll") for (int t = 0; t < 4; ++t) { const b16x8 v0_ = __builtin_bit_cast(b16x8, tr_frag(vb_ + t * 1024)), v1_ = __builtin_bit_cast(b16x8, tr_frag(vb_ + 4096 + t * 1024)); \
            o0 = __builtin_amdgcn_mfma_f32_32x32x16_bf16(v0_, pf_[t], o0, 0, 0, 0); o1 = __builtin_amdgcn_mfma_f32_32x32x16_bf16(v1_, pf_[t], o1, 0, 0, 0); } } \
        if ((T) + 1 < (TE) && dec) MOBA_DECIDE((T) + 1, N0, N1); } while (0)
    f32x16 cA0, cA1, cB0, cB1;
    int te = nt; bool dec = true;
    LAS float* xs = (LAS float*)(lds + 131072);
    MOBA_CIN(0, cA0, cA1); MOBA_QK(0, cA0, cA1); MOBA_DECIDE(0, cA0, cA1);
#pragma unroll 1
    for (int tt = 0; tt < te; tt += 2) {
        MOBA_STEP(tt, te, cA0, cA1, cB0, cB1);
        if (tt == 2 && j > 0) { float marg = qbound - mref;
#pragma unroll
            for (int o = 1; o < 64; o <<= 1) marg = fmaxf(marg, __shfl_xor(marg, o));
            if (lane == 0) xs[wid] = marg; }
        MOBA_STEP(tt + 1, te, cB0, cB1, cA0, cA1);
        MOBA_WAIT_BAR(0);
        if (tt == 2 && j > 0) { float M = xs[0];
#pragma unroll
            for (int k = 1; k < 8; ++k) M = fmaxf(M, xs[k]);
            const float num = M + 40.0f - slope2;
            int cnt = (num >= 0.f) ? ((int)(num / (64.0f * slope2)) + 1) : 0;
            cnt = max(min(cnt, 4 * j), 2); cnt = (cnt + 1) & ~1;
            te = 4 + __builtin_amdgcn_readfirstlane(cnt);
            dec = !(M < 100.0f); }
        if (tt + 5 < te) MOBA_DMA(tt + 5);
        if (tt + 6 < te) MOBA_DMA(tt + 6);
    }
    MOBA_WAIT_BAR(0);
#undef MOBA_RUN
#undef MOBA_CIN
#undef MOBA_DIAG
#undef MOBA_QK
#undef MOBA_DECIDE
#undef MOBA_STEP
#undef MOBA_DMA
#undef MOBA_WAIT_BAR
    {
        const float inv = 1.0f / xhalf_sum(lsum);
        h16* dst = mix + ((size_t)b * SEQ + qrow) * DM + 512 + hh * 64 + 4 * hi;
#pragma unroll
        for (int g = 0; g < 4; ++g) {
            const h16x4 ga = gpre[2 * g], gb = gpre[2 * g + 1]; h16x4 oa, ob;
#pragma unroll
            for (int k = 0; k < 4; ++k) { oa[k] = (h16)(o0[4 * g + k] * inv * silu_f((float)ga[k])); ob[k] = (h16)(o1[4 * g + k] * inv * silu_f((float)gb[k])); }
            *(h16x4*)(dst + 8 * g) = oa; *(h16x4*)(dst + 32 + 8 * g) = ob;
        }
    }
}

__device__ __forceinline__ void ret_scan_shares(const Params& p, int layer) {
    const float* kv = (const float*)(p.ws + WS_KV); h16* rst = (h16*)(p.ws + WS_RST);
    const int tid = threadIdx.x; unsigned done = 0u;
#pragma unroll 1
    for (int s = blockIdx.x; s < 256; s += gridDim.x) {
        const int bh = s >> 3, e = (s & 7) * 512 + tid, hh = bh & 3;
        const float gam = 1.0f - exp2f(-5.0f - (float)hh); const float g = expf(logf(gam) * 128.0f);
        const float* kvb = kv + (size_t)bh * 32 * 4096 + e; h16* rb = rst + (size_t)bh * 32 * 4096 + e;
        float r = 0.f; rb[0] = (h16)0.f;
        float kvv[31];
#pragma unroll
        for (int m = 0; m < 31; ++m) kvv[m] = kvb[(size_t)m * 4096];
#pragma unroll
        for (int m = 0; m < 31; ++m) { r = r * g + kvv[m]; rb[(size_t)(m + 1) * 4096] = (h16)(r * gam); }
        ++done;
    }
    asm volatile("s_waitcnt vmcnt(0)" ::: "memory");
    __syncthreads();
    if (tid == 0) { __builtin_amdgcn_fence(__ATOMIC_RELEASE, "agent"); asm volatile("s_waitcnt vmcnt(0)" ::: "memory");
        __hip_atomic_fetch_add((unsigned*)(p.ws + WS_CTL + 16384) + 64 * layer, done, __ATOMIC_RELAXED, __HIP_MEMORY_SCOPE_AGENT); }
}
__device__ __forceinline__ void ret_scan_wait(const Params& p, int layer) {
    if (threadIdx.x == 0) {
        unsigned* c = (unsigned*)(p.ws + WS_CTL + 16384) + 64 * layer; unsigned sp = 0u;
        while (__hip_atomic_load(c, __ATOMIC_RELAXED, __HIP_MEMORY_SCOPE_AGENT) < 256u) { __builtin_amdgcn_s_sleep(2); if (++sp > (1u << 22)) break; }
        __builtin_amdgcn_fence(__ATOMIC_ACQUIRE, "agent"); asm volatile("s_waitcnt vmcnt(0)" ::: "memory");
    }
    __syncthreads();
}

__device__ __forceinline__ void publish_count(unsigned* c, unsigned n) {
    asm volatile("s_waitcnt vmcnt(0)" ::: "memory");
    __syncthreads();
    if (threadIdx.x == 0) { __builtin_amdgcn_fence(__ATOMIC_RELEASE, "agent"); asm volatile("s_waitcnt vmcnt(0)" ::: "memory"); __hip_atomic_fetch_add(c, n, __ATOMIC_RELAXED, __HIP_MEMORY_SCOPE_AGENT); }
}
__device__ __forceinline__ void wait_count(unsigned* c, unsigned want) {
    if (threadIdx.x == 0) { unsigned sp = 0u;
        while (__hip_atomic_load(c, __ATOMIC_RELAXED, __HIP_MEMORY_SCOPE_AGENT) < want) { __builtin_amdgcn_s_sleep(2); if (++sp > (1u << 22)) break; }
        __builtin_amdgcn_fence(__ATOMIC_ACQUIRE, "agent"); asm volatile("s_waitcnt vmcnt(0)" ::: "memory"); }
    __syncthreads();
}
__device__ __forceinline__ int queue_pop(unsigned* counter, LAS unsigned* slot) {
    __syncthreads();
    if (threadIdx.x == 0) slot[0] = __hip_atomic_fetch_add(counter, 1u, __ATOMIC_RELAXED, __HIP_MEMORY_SCOPE_AGENT);
    __syncthreads();
    return (int)slot[0];
}
__device__ __forceinline__ void phase_mixers(const Params& p, int layer, unsigned char* lds) {
    static constexpr unsigned char MOBA_ORDER[128] = {111,127,110,126,109,125,93,94,95,92,108,124,91,107,123,90,106,122,89,105,121,88,104,120,87,103,119,71,72,73,74,75,76,77,78,79,70,86,102,118,69,85,101,117,68,84,100,116,52,53,54,55,56,57,58,59,60,61,62,63,51,67,83,99,115,50,66,82,98,114,34,35,36,37,38,39,40,41,42,43,44,45,46,47,17,18,19,20,21,22,23,24,25,26,27,28,29,30,31,33,49,65,81,97,113,1,2,3,4,5,6,7,8,9,10,11,12,13,14,15,0,16,32,48,64,80,96,112};
    unsigned* qc = (unsigned*)(p.ws + WS_CTL + 24576) + layer * 256;
    LAS unsigned* slot = (LAS unsigned*)((LAS unsigned char*)lds + BAR_LDS_OFF + 16);
    phase_stats(p, layer, lds);
    publish_count((unsigned*)(p.ws + WS_CTL + 16384) + 64 * (2 + layer), 1u);
#define QUEUE_LOOP(CNT, N, BODY) do { int cur = queue_pop(CNT, slot); \
        _Pragma("unroll 1") while (cur < (N)) { unsigned nxt_ = 0u; if (threadIdx.x == 0) nxt_ = __hip_atomic_fetch_add(CNT, 1u, __ATOMIC_RELAXED, __HIP_MEMORY_SCOPE_AGENT); \
            { BODY; } \
            __syncthreads(); if (threadIdx.x == 0) slot[0] = nxt_; __syncthreads(); cur = (int)slot[0]; } } while (0)
    QUEUE_LOOP(qc + 128, 512, conv_unit(p, layer, cur >> 6, cur & 63, lds));
    wait_count((unsigned*)(p.ws + WS_CTL + 16384) + 64 * (2 + layer), gridDim.x);
    ret_scan_shares(p, layer);
    QUEUE_LOOP(qc, 1024, const int hj = MOBA_ORDER[cur >> 3]; moba_unit(p, layer, cur & 7, hj >> 4, hj & 15, lds));
    ret_scan_wait(p, layer);
    QUEUE_LOOP(qc + 64, 1024, ret_unit(p, cur >> 7, (cur >> 5) & 3, cur & 31, lds));
#undef QUEUE_LOOP
}

__device__ __forceinline__ void phase_final(const Params& p) {
    const float* rowss = (const float*)(p.ws + WS_ROWSS); const h16* xh = (const h16*)(p.ws + WS_XH);
    const int lane = threadIdx.x & 63, wid = threadIdx.x >> 6;
    f32x4 g[4];
#pragma unroll
    for (int j = 0; j < 4; ++j) g[j] = *((const f32x4*)p.final_g + lane + 64 * j);
    for (int row = blockIdx.x * 8 + wid; row < MROWS; row += gridDim.x * 8) {
        const f32x4* rs = (const f32x4*)(rowss + (size_t)row * NPART); const f32x4 s0 = rs[0], s1 = rs[1], s2 = rs[2], s3 = rs[3];
        const float tot = ((s0[0] + s0[1]) + (s0[2] + s0[3])) + ((s1[0] + s1[1]) + (s1[2] + s1[3])) + ((s2[0] + s2[1]) + (s2[2] + s2[3])) + ((s3[0] + s3[1]) + (s3[2] + s3[3]));
        const float rstd = rsqrtf(tot * (1.0f / DM) + 1e-6f);
        const h16x4* xr = (const h16x4*)(xh + (size_t)row * DM) + lane; f32x4* orow = (f32x4*)(p.out + (size_t)row * DM) + lane;
#pragma unroll
        for (int j = 0; j < 4; ++j) { const h16x4 v = xr[64 * j]; orow[64 * j] = (f32x4){(float)v[0], (float)v[1], (float)v[2], (float)v[3]} * rstd * g[j]; }
    }
}

#define XB_TMO      128
#define XB_XCNT(j)  (256  + 64 * (j))
#define XB_XSUB(j)  (1280 + 64 * (j))
#define XB_XGEN(j)  (2304 + 64 * (j))
#define XB_TOP      3328
#define XB_TOPGEN   3392
#define XCD_BAR_WORDS 3456
#define XB_SPIN_CAP (1u << 18)

__device__ __forceinline__ unsigned xb_ld(unsigned* p)              { return __hip_atomic_load(p, __ATOMIC_RELAXED, __HIP_MEMORY_SCOPE_AGENT); }
__device__ __forceinline__ unsigned xb_add(unsigned* p, unsigned v) { return __hip_atomic_fetch_add(p, v, __ATOMIC_RELAXED, __HIP_MEMORY_SCOPE_AGENT); }
__device__ __forceinline__ unsigned xb_xcc_id() { return (unsigned)__builtin_amdgcn_s_getreg((3 << 11) | 20) & 0xFu; }
#define XB_SPIN(cond, bar) do { unsigned _sp = 0; while (cond) { __builtin_amdgcn_s_sleep(1); \
    if ((++_sp & 255u) == 0u) { if (xb_ld(&(bar)[XB_TMO])) break; if (_sp > XB_SPIN_CAP) { atomicAdd(&(bar)[XB_TMO], 1u); break; } } } } while (0)

struct XcdBarrier {
    unsigned* bar; unsigned x;
    volatile LAS unsigned* st;
};

__device__ __forceinline__ XcdBarrier xcd_barrier_post(unsigned* bar, volatile LAS unsigned* st) {
    XcdBarrier b; b.bar = bar; b.x = xb_xcc_id(); b.st = st;
    if (threadIdx.x == 0) (void)xb_add(&bar[XB_XCNT(b.x)], 1u);
    return b;
}
__device__ __forceinline__ void xcd_barrier_complete(unsigned* bar, unsigned x, unsigned& nloc, unsigned& nx) {
    const unsigned G = gridDim.x * gridDim.y * gridDim.z;
    unsigned sum, cnt, mine, sp = 0u;
    for (;;) {
        sum = 0u; cnt = 0u; mine = 0u;
#pragma unroll
        for (unsigned j = 0; j < 16; ++j) { const unsigned c = xb_ld(&bar[XB_XCNT(j)]); sum += c; cnt += (c > 0u) ? 1u : 0u; mine = (j == x) ? c : mine; }
        if (sum == G) break;
        __builtin_amdgcn_s_sleep(1);
        if ((++sp & 255u) == 0u) { if (xb_ld(&bar[XB_TMO])) break; if (sp > XB_SPIN_CAP) { atomicAdd(&bar[XB_TMO], 1u); break; } }
    }
    nloc = mine > 0u ? mine : 1u; nx = cnt > 0u ? cnt : 1u;
}

__device__ __forceinline__ void xcd_barrier(const XcdBarrier& b) {
    asm volatile("s_waitcnt vmcnt(0)" ::: "memory");
    __syncthreads();
    if (threadIdx.x == 0) {
        unsigned* bar = b.bar;
        __builtin_amdgcn_s_waitcnt(0);
        unsigned nloc = b.st[0], nx = b.st[1];
        if (nloc == 0u) { xcd_barrier_complete(bar, b.x, nloc, nx); b.st[0] = nloc; b.st[1] = nx; }
        const unsigned old = xb_add(&bar[XB_XSUB(b.x)], 1u);
        const unsigned gen = old / nloc;
        if (old + 1u == (gen + 1u) * nloc) {
            __builtin_amdgcn_fence(__ATOMIC_RELEASE, "agent");
            asm volatile("s_waitcnt vmcnt(0)" ::: "memory");
            const unsigned og = xb_add(&bar[XB_TOP], 1u);
            const unsigned tg = og / nx;
            if (og + 1u == (tg + 1u) * nx) xb_add(&bar[XB_TOPGEN], 1u);
            else XB_SPIN(xb_ld(&bar[XB_TOPGEN]) == tg, bar);
            __builtin_amdgcn_fence(__ATOMIC_ACQUIRE, "agent");
            xb_add(&bar[XB_XGEN(b.x)], 1u);
            asm volatile("s_waitcnt vmcnt(0)" ::: "memory");
        } else {
            XB_SPIN(xb_ld(&bar[XB_XGEN(b.x)]) == gen, bar);
            __builtin_amdgcn_fence(__ATOMIC_ACQUIRE, "agent");
            asm volatile("s_waitcnt vmcnt(0)" ::: "memory");
        }
    }
    __syncthreads();
}


__global__ void __launch_bounds__(NTHREADS) hymba_fwd(Params p) {
    extern __shared__ __attribute__((aligned(16))) unsigned char lds[];
    cg::grid_group grid = cg::this_grid();
    volatile LAS unsigned* bst = (volatile LAS unsigned*)((LAS unsigned char*)lds + BAR_LDS_OFF);
    if (threadIdx.x < 2) bst[threadIdx.x] = 0u;
    __syncthreads();
    XcdBarrier xbar = xcd_barrier_post((unsigned*)(p.ws + WS_CTL), bst);
#define RUN_PHASE(k, body) do { if (p.ph_lo <= (k) && (k) < p.ph_hi) { body; if ((k) + 1 < p.ph_hi) { xcd_barrier(xbar); } } } while (0)
    RUN_PHASE(0, phase_prologue(p, lds));
    RUN_PHASE(1, gemm_in(p, 0, lds));
    RUN_PHASE(2, phase_mixers(p, 0, lds));
    RUN_PHASE(3, gemm_out<0>(p, lds));
    RUN_PHASE(4, gemm_in(p, 1, lds));
    RUN_PHASE(5, phase_mixers(p, 1, lds));
    RUN_PHASE(6, gemm_out<1>(p, lds));
    RUN_PHASE(7, phase_final(p));
#undef RUN_PHASE
}

extern "C" void kernel_launch(void* const* d_in, const int* in_sizes, int n_in, void* d_out, int out_size, void* d_ws, size_t ws_size, hipStream_t stream) {
    static int grid_blocks = 0;
    if (!grid_blocks) {
        int dev = 0, cus = 0, per_cu = 0;
        hipGetDevice(&dev);
        hipDeviceGetAttribute(&cus, hipDeviceAttributeMultiprocessorCount, dev);
        hipFuncSetAttribute((const void*)hymba_fwd, hipFuncAttributeMaxDynamicSharedMemorySize, LDS_BYTES);
        hipOccupancyMaxActiveBlocksPerMultiprocessor(&per_cu, (const void*)hymba_fwd, NTHREADS, LDS_BYTES);
        if (per_cu < 1) per_cu = 1;
        grid_blocks = cus * per_cu;
        if (ws_size < WS_END) fprintf(stderr, "kernel_launch: workspace too small (%zu < %zu)\n", ws_size, (size_t)WS_END);
    }
    Params p{};
    p.x = (const float*)d_in[0]; p.norm_g = (const float*)d_in[1]; p.w_in = (const float*)d_in[2]; p.conv_w = (const float*)d_in[3]; p.conv_b = (const float*)d_in[4];
    p.ln_g = (const float*)d_in[5]; p.ln_b = (const float*)d_in[6]; p.pw_w = (const float*)d_in[7]; p.pw_b = (const float*)d_in[8]; p.w_out = (const float*)d_in[9];
    p.final_g = (const float*)d_in[10]; p.out = (float*)d_out; p.ws = (unsigned char*)d_ws;
    (void)hipMemsetAsync((char*)d_ws + WS_CTL, 0, 32768, stream);
#if ONE_LAUNCH
    p.ph_lo = 0; p.ph_hi = NPHASES;
    { void* args[] = {&p};
      hipError_t e = hipLaunchCooperativeKernel((const void*)hymba_fwd, dim3(grid_blocks), dim3(NTHREADS), args, LDS_BYTES, stream);
      if (e != hipSuccess) fprintf(stderr, "cooperative launch failed: %s (grid %d)\n", hipGetErrorString(e), grid_blocks); }
#else
    for (int ph = 0; ph < NPHASES; ++ph) {
        p.ph_lo = ph; p.ph_hi = ph + 1; void* args[] = {&p};
        hipError_t e = hipLaunchCooperativeKernel((const void*)hymba_fwd, dim3(grid_blocks), dim3(NTHREADS), args, LDS_BYTES, stream);
        if (e != hipSuccess) { fprintf(stderr, "cooperative launch failed: %s (grid %d, phase %d)\n", hipGetErrorString(e), grid_blocks, ph); break; }
    }
#endif
}
```
